# Optimizing an MI355X kernel written in HIP

```python
import math
import jax, jax.numpy as jnp
from jax import lax
import numpy as np

D_MODEL = 1024
BATCH = 16
SEQ = 2048
DEPTH = 4

CHUNK = 64
D_MIX = D_MODEL
N_GROUPS = 4
GROUP_W = D_MIX // N_GROUPS
CONV_W = 3
GMLP_HEADS = 4
GMLP_HD = GROUP_W // GMLP_HEADS
GMLP_BLOCK = 128
DIFF_HEADS = 4
DIFF_VD = GROUP_W // DIFF_HEADS
DIFF_QD = DIFF_VD // 2
DSA_HEADS = 4
DSA_HD = GROUP_W // DSA_HEADS
IDX_HEADS = 4
IDX_HD = 32
DSA_TOPK_MAX = 256
Q_BLOCK = 128
EPS = 1e-6

COL_SIZES = (
    GROUP_W, GROUP_W, GROUP_W, GROUP_W,
    GROUP_W, GROUP_W, GROUP_W,
    GROUP_W, GROUP_W, GROUP_W, GROUP_W,
    GROUP_W, DSA_HD, DSA_HD, GROUP_W,
    IDX_HEADS * IDX_HD, IDX_HD, IDX_HEADS,
)
N_IN = sum(COL_SIZES)

kernel_name = "hybrid_chunk_causal_parallel_groups"


def rms_norm(x, g):
    xf = x.astype(jnp.float32)
    y = xf * lax.rsqrt(jnp.mean(xf * xf, axis=-1, keepdims=True) + EPS)
    return (y * g.astype(jnp.float32)).astype(x.dtype)


def split_cols(y, sizes):
    out, off = [], 0
    for s in sizes:
        out.append(y[..., off:off + s])
        off += s
    return out


def alibi_slopes():
    n = DIFF_HEADS + DSA_HEADS
    s = (2.0 ** (-8.0 * np.arange(1, n + 1) / n)).astype(np.float32)
    return jnp.asarray(s[0::2]), jnp.asarray(s[1::2])


def chunk_mask(qpos, kpos):
    return (qpos[:, None] // CHUNK) >= (kpos[None, :] // CHUNK)


def short_conv_mixer(h, b_gate, c_gate, w, bias):
    u = c_gate * h
    T = u.shape[1]
    up = jnp.pad(u, ((0, 0), (CONV_W - 1, 0), (0, 0)))
    y = up[:, 0:T] * w[0]
    for j in range(1, CONV_W):
        y = y + up[:, j:j + T] * w[j]
    return b_gate * (y + bias)


def gmlp_mixer(u, v, g, ws, bs):
    Bn, T, _ = u.shape
    u = jax.nn.gelu(u, approximate=False)
    v = jax.nn.gelu(v, approximate=False)
    vh = rms_norm(v.reshape(Bn, T, GMLP_HEADS, GMLP_HD), g.reshape(GMLP_HEADS, GMLP_HD))
    vh = vh.reshape(Bn, T // GMLP_BLOCK, GMLP_BLOCK, GMLP_HEADS, GMLP_HD)
    pos = jnp.arange(GMLP_BLOCK)
    wm = jnp.where(chunk_mask(pos, pos)[None], ws, jnp.zeros_like(ws))
    s = jnp.einsum('hts,bnshd->bnthd', wm, vh) + bs.T[:, :, None]
    return u * s.reshape(Bn, T, GROUP_W)


def diff_attention(q, k, v, q_g, k_g, lam_p, sub_g, slopes, layer_idx):
    Bn, T, _ = q.shape
    q = rms_norm(q.reshape(Bn, T, DIFF_HEADS, 2, DIFF_QD), q_g)
    k = rms_norm(k.reshape(Bn, T, DIFF_HEADS, 2, DIFF_QD), k_g)
    v = v.reshape(Bn, T, DIFF_HEADS, DIFF_VD)
    lam_init = 0.8 - 0.6 * math.exp(-0.3 * layer_idx)
    lp = lam_p.astype(jnp.float32)
    lam = jnp.exp(jnp.sum(lp[0] * lp[1])) - jnp.exp(jnp.sum(lp[2] * lp[3])) + lam_init
    scale = DIFF_QD ** -0.5
    kpos = jnp.arange(T)
    nb = T // Q_BLOCK
    qb = q.reshape(Bn, nb, Q_BLOCK, DIFF_HEADS, 2, DIFF_QD).swapaxes(0, 1)

    def block(args):
        qi, bi = args
        qpos = bi * Q_BLOCK + jnp.arange(Q_BLOCK)
        s = jnp.einsum('bthjd,bshjd->bhjts', qi, k).astype(jnp.float32) * scale
        dist = jnp.abs(qpos[:, None] - kpos[None, :]).astype(jnp.float32)
        s = s - (slopes[:, None, None] * dist)[:, None]
        s = jnp.where(chunk_mask(qpos, kpos), s, -jnp.inf)
        p = jax.nn.softmax(s, axis=-1)
        pd = (p[:, :, 0] - lam * p[:, :, 1]).astype(v.dtype)
        return jnp.einsum('bhts,bshd->bthd', pd, v)

    o = lax.map(block, (qb, jnp.arange(nb)))
    o = o.swapaxes(0, 1).reshape(Bn, T, DIFF_HEADS, DIFF_VD)
    o = rms_norm(o, sub_g.reshape(DIFF_HEADS, DIFF_VD)) * (1.0 - lam_init)
    return o.reshape(Bn, T, GROUP_W)


def dsa_attention(q, k, v, iq, ik, iw, q_g, k_g, slopes):
    Bn, T, _ = q.shape
    q = rms_norm(q.reshape(Bn, T, DSA_HEADS, DSA_HD), q_g)
    k = rms_norm(k, k_g)
    iq = iq.reshape(Bn, T, IDX_HEADS, IDX_HD)
    topk = min(DSA_TOPK_MAX, T // 4)
    scale = DSA_HD ** -0.5
    kpos = jnp.arange(T)
    nb = T // Q_BLOCK
    qb = q.reshape(Bn, nb, Q_BLOCK, DSA_HEADS, DSA_HD).swapaxes(0, 1)
    iqb = iq.reshape(Bn, nb, Q_BLOCK, IDX_HEADS, IDX_HD).swapaxes(0, 1)
    iwb = iw.reshape(Bn, nb, Q_BLOCK, IDX_HEADS).swapaxes(0, 1)

    def block(args):
        qi, iqi, iwi, bi = args
        qpos = bi * Q_BLOCK + jnp.arange(Q_BLOCK)
        logits = jnp.einsum('bthd,bsd->bths', iqi, ik).astype(jnp.float32) * (IDX_HD ** -0.5)
        score = jnp.einsum('bths,bth->bts', jax.nn.relu(logits), iwi.astype(jnp.float32)) * (IDX_HEADS ** -0.5)
        score = jnp.where(chunk_mask(qpos, kpos)[None], score, -jnp.inf)
        _, idx = lax.top_k(score, topk)
        valid = (idx // CHUNK) <= (qpos[None, :, None] // CHUNK)
        kg = jax.vmap(lambda kb, ib: kb[ib])(k, idx)
        vg = jax.vmap(lambda vb, ib: vb[ib])(v, idx)
        s = jnp.einsum('bthd,btkd->bhtk', qi, kg).astype(jnp.float32) * scale
        dist = jnp.abs(qpos[None, :, None] - idx).astype(jnp.float32)
        s = s - slopes[None, :, None, None] * dist[:, None]
        s = jnp.where(valid[:, None], s, -jnp.inf)
        p = jax.nn.softmax(s, axis=-1).astype(v.dtype)
        return jnp.einsum('bhtk,btkd->bthd', p, vg)

    o = lax.map(block, (qb, iqb, iwb, jnp.arange(nb)))
    return o.swapaxes(0, 1).reshape(Bn, T, GROUP_W)


def setup_inputs(seed: int = 0) -> dict:
    key = jax.random.key(seed)
    ks = jax.random.split(key, 16)
    f32 = jnp.float32
    nrm = lambda k, shp: jax.random.normal(k, shp, f32)
    return {
        "x": nrm(ks[0], (BATCH, SEQ, D_MODEL)),
        "norm_g": 1.0 + 0.02 * nrm(ks[1], (DEPTH, D_MODEL)),
        "w_in": nrm(ks[2], (DEPTH, D_MODEL, N_IN)) * (D_MODEL ** -0.5),
        "conv_w": nrm(ks[3], (DEPTH, CONV_W, GROUP_W)) * (CONV_W ** -0.5),
        "conv_b": 0.02 * nrm(ks[4], (DEPTH, GROUP_W)),
        "gmlp_g": 1.0 + 0.02 * nrm(ks[5], (DEPTH, GROUP_W)),
        "gmlp_ws": nrm(ks[6], (DEPTH, GMLP_HEADS, GMLP_BLOCK, GMLP_BLOCK)) * (0.5 * GMLP_BLOCK ** -0.5),
        "gmlp_b": 1.0 + 0.1 * nrm(ks[7], (DEPTH, GMLP_HEADS, GMLP_BLOCK)),
        "diff_qg": 1.0 + 0.02 * nrm(ks[8], (DEPTH, DIFF_QD)),
        "diff_kg": 1.0 + 0.02 * nrm(ks[9], (DEPTH, DIFF_QD)),
        "diff_lam": 0.1 * nrm(ks[10], (DEPTH, 4, DIFF_QD)),
        "diff_subg": 1.0 + 0.02 * nrm(ks[11], (DEPTH, GROUP_W)),
        "dsa_qg": 1.0 + 0.02 * nrm(ks[12], (DEPTH, DSA_HD)),
        "dsa_kg": 1.0 + 0.02 * nrm(ks[13], (DEPTH, DSA_HD)),
        "w_out": nrm(ks[14], (DEPTH, D_MIX, D_MODEL)) * (0.5 * D_MIX ** -0.5),
    }


def reference(x, norm_g, w_in, conv_w, conv_b, gmlp_g, gmlp_ws, gmlp_b, diff_qg, diff_kg,
              diff_lam, diff_subg, dsa_qg, dsa_kg, w_out):
    slopes_c, slopes_d = alibi_slopes()
    for l in range(DEPTH):
        xn = rms_norm(x, norm_g[l])
        y = jnp.einsum('btd,dn->btn', xn, w_in[l])
        (a_h, a_b, a_c, a_z,
         g_u, g_v, g_z,
         c_q, c_k, c_v, c_z,
         d_q, d_k, d_v, d_z,
         i_q, i_k, i_w) = split_cols(y, COL_SIZES)
        ya = short_conv_mixer(a_h, a_b, a_c, conv_w[l], conv_b[l]) * jax.nn.silu(a_z)
        yb = gmlp_mixer(g_u, g_v, gmlp_g[l], gmlp_ws[l], gmlp_b[l]) * jax.nn.silu(g_z)
        yc = diff_attention(c_q, c_k, c_v, diff_qg[l], diff_kg[l], diff_lam[l], diff_subg[l],
                            slopes_c, l) * jax.nn.silu(c_z)
        yd = dsa_attention(d_q, d_k, d_v, i_q, i_k, i_w, dsa_qg[l], dsa_kg[l], slopes_d) * jax.nn.silu(d_z)
        mix = jnp.concatenate([ya, yb, yc, yd], axis=-1)
        x = x + jnp.einsum('btm,md->btd', mix, w_out[l])
    return x
```

```cpp
#include <hip/hip_runtime.h>
#include <hip/hip_cooperative_groups.h>
#include <math.h>
#include <stdint.h>
#include <stdio.h>

#ifndef ONE_LAUNCH
#define ONE_LAUNCH 0
#endif

namespace cg = cooperative_groups;

constexpr int DM = 1024, SEQ = 2048, BATCH = 16, DEPTH = 4, NIN = 3620, NTOK = BATCH * SEQ;
constexpr int HALF_ROWS = NTOK / 2;
constexpr float EPS = 1e-6f;
constexpr int A_H = 0, A_B = 256, A_C = 512, A_Z = 768, B_U = 1024, B_V = 1280, B_Z = 1536, C_Q = 1792, C_K = 2048, C_V = 2304,
              C_Z = 2560, D_Q = 2816, D_K = 3072, D_V = 3136, D_Z = 3200, I_Q = 3456, I_K = 3584, I_W = 3616;
constexpr int TOPK = 256;
constexpr int NT = 256;

struct Params {
    const float* x; const float* norm_g; const float* w_in; const float* conv_w; const float* conv_b;
    const float* gmlp_g; const float* gmlp_ws; const float* gmlp_b; const float* diff_qg; const float* diff_kg;
    const float* diff_lam; const float* diff_subg; const float* dsa_qg; const float* dsa_kg; const float* w_out;
    float* out; float* y; float* mix; float* rstd;
};

__device__ __forceinline__ float wave_sum(float v) {
#pragma unroll
    for (int o = 32; o > 0; o >>= 1) v += __shfl_xor(v, o);
    return v;
}
__device__ __forceinline__ float wave_max(float v) {
#pragma unroll
    for (int o = 32; o > 0; o >>= 1) v = fmaxf(v, __shfl_xor(v, o));
    return v;
}
__device__ __forceinline__ int wave_sumi(int v) {
#pragma unroll
    for (int o = 32; o > 0; o >>= 1) v += __shfl_xor(v, o);
    return v;
}
__device__ __forceinline__ float block_sum(float v, float* red) {
    v = wave_sum(v);
    __syncthreads();
    if ((threadIdx.x & 63) == 0) red[threadIdx.x >> 6] = v;
    __syncthreads();
    return (red[0] + red[1]) + (red[2] + red[3]);
}
__device__ __forceinline__ float block_max(float v, float* red) {
    v = wave_max(v);
    __syncthreads();
    if ((threadIdx.x & 63) == 0) red[threadIdx.x >> 6] = v;
    __syncthreads();
    return fmaxf(fmaxf(red[0], red[1]), fmaxf(red[2], red[3]));
}
__device__ __forceinline__ int block_sumi(int v, int* red) {
    v = wave_sumi(v);
    __syncthreads();
    if ((threadIdx.x & 63) == 0) red[threadIdx.x >> 6] = v;
    __syncthreads();
    return (red[0] + red[1]) + (red[2] + red[3]);
}
__device__ __forceinline__ int block_excl_scan(int v, int* red, int* tot) {
    const int lane = threadIdx.x & 63, w = threadIdx.x >> 6;
    int inc = v;
#pragma unroll
    for (int o = 1; o < 64; o <<= 1) { int n = __shfl_up(inc, o); if (lane >= o) inc += n; }
    __syncthreads();
    if (lane == 63) red[w] = inc;
    __syncthreads();
    int base = 0;
    for (int i = 0; i < w; ++i) base += red[i];
    *tot = red[0] + red[1] + red[2] + red[3];
    return base + inc - v;
}

__device__ void ph_rstd(const float* xin, float* rstd, int row0, int nrows, int vb, int nvb) {
    const int lane = threadIdx.x & 63, gw = vb * 4 + (threadIdx.x >> 6), ngw = nvb * 4;
    for (int r = gw; r < nrows; r += ngw) {
        const float4* xr = (const float4*)(xin + (size_t)(row0 + r) * DM);
        float s = 0.f;
#pragma unroll
        for (int j = 0; j < 4; ++j) { float4 v = xr[lane + 64 * j]; s += v.x * v.x + v.y * v.y + v.z * v.z + v.w * v.w; }
        s = wave_sum(s);
        if (lane == 0) rstd[row0 + r] = rsqrtf(s * (1.f / DM) + EPS);
    }
}

__device__ void gemm_tile(const float* A, int lda, const float* ks, const float* rs, const float* B, int ldb, int N, int K,
                          float* C, int ldc, const float* res, int tm, int tn, float* smem) {
    float (*As)[68] = (float (*)[68])smem;
    float (*Bs)[68] = (float (*)[68])(smem + 16 * 68);
    const int tid = threadIdx.x, tx = tid & 15, ty = tid >> 4;
    const int row0 = tm * 64, col0 = tn * 64;
    float acc[4][4];
#pragma unroll
    for (int i = 0; i < 4; ++i)
#pragma unroll
        for (int j = 0; j < 4; ++j) acc[i][j] = 0.f;
    for (int k0 = 0; k0 < K; k0 += 16) {
        {
            const int r = tid >> 2, kq = (tid & 3) * 4;
            float4 a = *(const float4*)(A + (size_t)(row0 + r) * lda + k0 + kq);
            if (ks) { const float4 g = *(const float4*)(ks + k0 + kq); a.x *= g.x; a.y *= g.y; a.z *= g.z; a.w *= g.w; }
            As[kq + 0][r] = a.x; As[kq + 1][r] = a.y; As[kq + 2][r] = a.z; As[kq + 3][r] = a.w;
        }
        {
            const int kk = tid >> 4, n = (tid & 15) * 4;
            float4 b = make_float4(0.f, 0.f, 0.f, 0.f);
            if (col0 + n < N) b = *(const float4*)(B + (size_t)(k0 + kk) * ldb + col0 + n);
            *(float4*)&Bs[kk][n] = b;
        }
        __syncthreads();
#pragma unroll
        for (int kk = 0; kk < 16; ++kk) {
            const float4 a = *(const float4*)&As[kk][ty * 4];
            const float4 b = *(const float4*)&Bs[kk][tx * 4];
            const float av[4] = {a.x, a.y, a.z, a.w}, bv[4] = {b.x, b.y, b.z, b.w};
#pragma unroll
            for (int i = 0; i < 4; ++i)
#pragma unroll
                for (int j = 0; j < 4; ++j) acc[i][j] = fmaf(av[i], bv[j], acc[i][j]);
        }
        __syncthreads();
    }
#pragma unroll
    for (int i = 0; i < 4; ++i) {
        const int r = row0 + ty * 4 + i;
        const float sc = rs ? rs[r] : 1.f;
#pragma unroll
        for (int j = 0; j < 4; ++j) {
            const int c = col0 + tx * 4 + j;
            if (c < N) {
                float v = acc[i][j] * sc;
                if (res) v += res[(size_t)r * ldc + c];
                C[(size_t)r * ldc + c] = v;
            }
        }
    }
}

__device__ void ph_gemm_in(const Params& p, int l, const float* xin, int row0, int nrows, int vb, int nvb, float* smem) {
    const int ntn = (NIN + 63) / 64, ntiles = (nrows / 64) * ntn;
    for (int t = vb; t < ntiles; t += nvb) {
        const int tm = t / ntn, tn = t % ntn;
        gemm_tile(xin + (size_t)row0 * DM, DM, p.norm_g + l * DM, p.rstd + row0, p.w_in + (size_t)l * DM * NIN, NIN, NIN, DM,
                  p.y, NIN, nullptr, tm, tn, smem);
    }
}
__device__ void ph_gemm_out(const Params& p, int l, const float* xin, int row0, int nrows, int vb, int nvb, float* smem) {
    const int ntn = DM / 64, ntiles = (nrows / 64) * ntn;
    for (int t = vb; t < ntiles; t += nvb) {
        const int tm = t / ntn, tn = t % ntn;
        gemm_tile(p.mix + (size_t)row0 * DM, DM, nullptr, nullptr, p.w_out + (size_t)l * DM * DM, DM, DM, DM,
                  p.out + (size_t)row0 * DM, DM, xin + (size_t)row0 * DM, tm, tn, smem);
    }
}

__device__ __forceinline__ float gelu_exact(float v) { return 0.5f * v * (1.f + erff(v * 0.70710678118654752f)); }
__device__ __forceinline__ float silu(float v) { return v / (1.f + expf(-v)); }
__device__ void ph_post(const Params& p, int l, int nrows, int vb, int nvb) {
    const int t = threadIdx.x;
    for (int r = vb; r < nrows; r += nvb) {
        float* yr = p.y + (size_t)r * NIN;
        yr[B_U + t] = gelu_exact(yr[B_U + t]);
        {
            float v = gelu_exact(yr[B_V + t]);
            const float ss = wave_sum(v * v);
            yr[B_V + t] = v * rsqrtf(ss * (1.f / 64) + EPS) * p.gmlp_g[l * 256 + t];
        }
        yr[A_Z + t] = silu(yr[A_Z + t]);
        yr[B_Z + t] = silu(yr[B_Z + t]);
        yr[C_Z + t] = silu(yr[C_Z + t]);
        yr[D_Z + t] = silu(yr[D_Z + t]);
        {
            float v = yr[C_Q + t]; float ss = v * v;
#pragma unroll
            for (int o = 16; o > 0; o >>= 1) ss += __shfl_xor(ss, o);
            yr[C_Q + t] = v * rsqrtf(ss * (1.f / 32) + EPS) * p.diff_qg[l * 32 + (t & 31)];
        }
        {
            float v = yr[C_K + t]; float ss = v * v;
#pragma unroll
            for (int o = 16; o > 0; o >>= 1) ss += __shfl_xor(ss, o);
            yr[C_K + t] = v * rsqrtf(ss * (1.f / 32) + EPS) * p.diff_kg[l * 32 + (t & 31)];
        }
        {
            float v = yr[D_Q + t];
            const float ss = wave_sum(v * v);
            yr[D_Q + t] = v * rsqrtf(ss * (1.f / 64) + EPS) * p.dsa_qg[l * 64 + (t & 63)];
        }
        if (t < 64) {
            float v = yr[D_K + t];
            const float ss = wave_sum(v * v);
            yr[D_K + t] = v * rsqrtf(ss * (1.f / 64) + EPS) * p.dsa_kg[l * 64 + t];
        }
    }
}

__device__ void ph_mixAB(const Params& p, int l, int row0, int nrows, int vb, int nvb) {
    const int c = threadIdx.x;
    for (int r = vb; r < nrows; r += nvb) {
        const int pos = (row0 + r) & (SEQ - 1);
        const float* yr = p.y + (size_t)r * NIN;
        float* mr = p.mix + (size_t)(row0 + r) * DM;
        {
            const float u0 = yr[A_C + c] * yr[A_H + c];
            const float u1 = pos >= 1 ? yr[A_C + c - NIN] * yr[A_H + c - NIN] : 0.f;
            const float u2 = pos >= 2 ? yr[A_C + c - 2 * NIN] * yr[A_H + c - 2 * NIN] : 0.f;
            const float* w = p.conv_w + l * 768;
            const float conv = w[c] * u2 + w[256 + c] * u1 + w[512 + c] * u0;
            mr[c] = yr[A_B + c] * (conv + p.conv_b[l * 256 + c]) * yr[A_Z + c];
        }
        {
            const int h = c >> 6, tt = pos & 127, smax = tt < 64 ? 64 : 128;
            const float* wrow = p.gmlp_ws + ((size_t)(l * 4 + h) * 128 + tt) * 128;
            const float* vb0 = yr - (size_t)tt * NIN + B_V + c;
            float s = 0.f;
            for (int sp = 0; sp < smax; ++sp) s = fmaf(wrow[sp], vb0[(size_t)sp * NIN], s);
            s += p.gmlp_b[(l * 4 + h) * 128 + tt];
            mr[256 + c] = yr[B_U + c] * s * yr[B_Z + c];
        }
    }
}

__device__ void ph_mixC(const Params& p, int l, int row0, int nrows, int vb, int nvb, float* smem) {
    float* l1 = smem;
    float* l2 = smem + 2048;
    float* qs = smem + 4096;
    float* part = smem + 4160;
    float* red = smem + 4416;
    const int tid = threadIdx.x;
    const float lam_init = 0.8f - 0.6f * expf(-0.3f * (float)l);
    const float* lp = p.diff_lam + l * 128;
    float d1 = 0.f, d2 = 0.f;
    for (int i = 0; i < 32; ++i) { d1 += lp[i] * lp[32 + i]; d2 += lp[64 + i] * lp[96 + i]; }
    const float lam = expf(d1) - expf(d2) + lam_init;
    const float scale = 0.17677669529663687f;
    const int nitems = nrows * 4;
    for (int it = vb; it < nitems; it += nvb) {
        const int r = it >> 2, h = it & 3;
        const int pos = (row0 + r) & (SEQ - 1);
        const int nk = ((pos >> 6) + 1) * 64;
        const float slope = exp2f(-(float)(2 * h + 1));
        const float* yr = p.y + (size_t)r * NIN;
        const float* yb = yr - (size_t)pos * NIN;
        __syncthreads();
        if (tid < 64) qs[tid] = yr[C_Q + h * 64 + tid];
        __syncthreads();
        float m1 = -INFINITY, m2 = -INFINITY;
        for (int s = tid; s < nk; s += NT) {
            const float* kr = yb + (size_t)s * NIN + C_K + h * 64;
            float a1 = 0.f, a2 = 0.f;
#pragma unroll 8
            for (int d = 0; d < 32; ++d) { a1 = fmaf(qs[d], kr[d], a1); a2 = fmaf(qs[32 + d], kr[32 + d], a2); }
            const float dist = fabsf((float)(pos - s));
            a1 = a1 * scale - slope * dist; a2 = a2 * scale - slope * dist;
            l1[s] = a1; l2[s] = a2;
            m1 = fmaxf(m1, a1); m2 = fmaxf(m2, a2);
        }
        m1 = block_max(m1, red); m2 = block_max(m2, red);
        float s1 = 0.f, s2 = 0.f;
        for (int s = tid; s < nk; s += NT) {
            const float e1 = expf(l1[s] - m1), e2 = expf(l2[s] - m2);
            l1[s] = e1; l2[s] = e2; s1 += e1; s2 += e2;
        }
        s1 = block_sum(s1, red); s2 = block_sum(s2, red);
        const float i1 = 1.f / s1, i2 = lam / s2;
        for (int s = tid; s < nk; s += NT) l1[s] = l1[s] * i1 - l2[s] * i2;
        __syncthreads();
        {
            const int d = tid & 63, pr = tid >> 6;
            const float* vr = yb + C_V + h * 64 + d;
            float acc = 0.f;
            for (int s = pr; s < nk; s += 4) acc = fmaf(l1[s], vr[(size_t)s * NIN], acc);
            part[tid] = acc;
        }
        __syncthreads();
        if (tid < 64) {
            float o = (part[tid] + part[64 + tid]) + (part[128 + tid] + part[192 + tid]);
            const float ss = wave_sum(o * o);
            o = o * rsqrtf(ss * (1.f / 64) + EPS) * p.diff_subg[l * 256 + h * 64 + tid] * (1.f - lam_init);
            p.mix[(size_t)(row0 + r) * DM + 512 + h * 64 + tid] = o * yr[C_Z + h * 64 + tid];
        }
    }
}

__device__ __forceinline__ unsigned fkey(float f) { const unsigned u = __float_as_uint(f); return (u & 0x80000000u) ? ~u : (u | 0x80000000u); }
__device__ void ph_mixD(const Params& p, int l, int row0, int nrows, int vb, int nvb, float* smem) {
    float* sc = smem;
    float* pp = smem + 2048;
    int* sel = (int*)(smem + 3072);
    float* qd = smem + 3328;
    float* iq = smem + 3584;
    float* red = smem + 3712;
    int* redi = (int*)(smem + 3716);
    const int tid = threadIdx.x;
    for (int r = vb; r < nrows; r += nvb) {
        const int pos = (row0 + r) & (SEQ - 1);
        const int nk = ((pos >> 6) + 1) * 64;
        const float* yr = p.y + (size_t)r * NIN;
        const float* yb = yr - (size_t)pos * NIN;
        __syncthreads();
        qd[tid] = yr[D_Q + tid];
        if (tid < 128) iq[tid] = yr[I_Q + tid];
        __syncthreads();
        int nsel;
        if (nk <= TOPK) {
            nsel = nk;
            if (tid < nk) sel[tid] = tid;
        } else {
            const float w0 = yr[I_W + 0], w1 = yr[I_W + 1], w2 = yr[I_W + 2], w3 = yr[I_W + 3];
            const float isc = 0.17677669529663687f;
            for (int s = tid; s < nk; s += NT) {
                const float* kr = yb + (size_t)s * NIN + I_K;
                float a0 = 0.f, a1 = 0.f, a2 = 0.f, a3 = 0.f;
#pragma unroll 8
                for (int d = 0; d < 32; ++d) { const float kv = kr[d]; a0 = fmaf(iq[d], kv, a0); a1 = fmaf(iq[32 + d], kv, a1); a2 = fmaf(iq[64 + d], kv, a2); a3 = fmaf(iq[96 + d], kv, a3); }
                float v = fmaxf(a0 * isc, 0.f) * w0 + fmaxf(a1 * isc, 0.f) * w1 + fmaxf(a2 * isc, 0.f) * w2 + fmaxf(a3 * isc, 0.f) * w3;
                v *= 0.5f;
                if (v == 0.f) v = 0.f;
                sc[s] = v;
            }
            __syncthreads();
            unsigned key[8];
#pragma unroll
            for (int j = 0; j < 8; ++j) { const int s = tid * 8 + j; key[j] = s < nk ? fkey(sc[s]) : 0u; }
            unsigned prefix = 0u;
            for (int bit = 31; bit >= 0; --bit) {
                const unsigned cand = prefix | (1u << bit);
                int cnt = 0;
#pragma unroll
                for (int j = 0; j < 8; ++j) cnt += key[j] >= cand ? 1 : 0;
                cnt = block_sumi(cnt, redi);
                if (cnt >= TOPK) prefix = cand;
            }
            int cgt = 0, ceq = 0;
#pragma unroll
            for (int j = 0; j < 8; ++j) { cgt += key[j] > prefix ? 1 : 0; ceq += key[j] == prefix ? 1 : 0; }
            const int tot_gt = block_sumi(cgt, redi);
            const int need = TOPK - tot_gt;
            int tot_eq;
            int eqbase = block_excl_scan(ceq, redi, &tot_eq);
            unsigned selmask = 0u; int nmine = 0;
#pragma unroll
            for (int j = 0; j < 8; ++j) {
                bool take = key[j] > prefix;
                if (key[j] == prefix) { take = eqbase < need; ++eqbase; }
                if (take) { selmask |= 1u << j; ++nmine; }
            }
            int tot_sel;
            int sbase = block_excl_scan(nmine, redi, &tot_sel);
#pragma unroll
            for (int j = 0; j < 8; ++j) if (selmask & (1u << j)) { if (sbase < TOPK) sel[sbase] = tid * 8 + j; ++sbase; }
            nsel = tot_sel < TOPK ? tot_sel : TOPK;
        }
        __syncthreads();
        float lg[4] = {-INFINITY, -INFINITY, -INFINITY, -INFINITY};
        if (tid < nsel) {
            const int s = sel[tid];
            const float* kr = yb + (size_t)s * NIN + D_K;
            float a0 = 0.f, a1 = 0.f, a2 = 0.f, a3 = 0.f;
#pragma unroll 8
            for (int d = 0; d < 64; ++d) { const float kv = kr[d]; a0 = fmaf(qd[d], kv, a0); a1 = fmaf(qd[64 + d], kv, a1); a2 = fmaf(qd[128 + d], kv, a2); a3 = fmaf(qd[192 + d], kv, a3); }
            const float dist = fabsf((float)(pos - s));
            lg[0] = a0 * 0.125f - 0.25f * dist;
            lg[1] = a1 * 0.125f - 0.0625f * dist;
            lg[2] = a2 * 0.125f - 0.015625f * dist;
            lg[3] = a3 * 0.125f - 0.00390625f * dist;
        }
        float inv[4];
#pragma unroll
        for (int h = 0; h < 4; ++h) {
            const float m = block_max(lg[h], red);
            const float e = tid < nsel ? expf(lg[h] - m) : 0.f;
            const float ssum = block_sum(e, red);
            pp[h * 256 + tid] = e;
            inv[h] = 1.f / ssum;
        }
        __syncthreads();
        {
            const int h = tid >> 6, d = tid & 63;
            const float* vr = yb + D_V + d;
            float acc = 0.f;
            for (int j = 0; j < nsel; ++j) acc = fmaf(pp[h * 256 + j], vr[(size_t)sel[j] * NIN], acc);
            const float invh = h == 0 ? inv[0] : h == 1 ? inv[1] : h == 2 ? inv[2] : inv[3];
            p.mix[(size_t)(row0 + r) * DM + 768 + tid] = acc * invh * yr[D_Z + tid];
        }
    }
}

constexpr int SMEM_FLOATS = 4480;
#if !ONE_LAUNCH
__global__ void __launch_bounds__(NT) k_rstd(Params p, const float* xin, int row0, int nrows) { ph_rstd(xin, p.rstd, row0, nrows, blockIdx.x, gridDim.x); }
__global__ void __launch_bounds__(NT) k_gemm_in(Params p, int l, const float* xin, int row0, int nrows) { __shared__ __attribute__((aligned(16))) float smem[SMEM_FLOATS]; ph_gemm_in(p, l, xin, row0, nrows, blockIdx.x, gridDim.x, smem); }
__global__ void __launch_bounds__(NT) k_post(Params p, int l, int nrows) { ph_post(p, l, nrows, blockIdx.x, gridDim.x); }
__global__ void __launch_bounds__(NT) k_mixAB(Params p, int l, int row0, int nrows) { ph_mixAB(p, l, row0, nrows, blockIdx.x, gridDim.x); }
__global__ void __launch_bounds__(NT) k_mixC(Params p, int l, int row0, int nrows) { __shared__ __attribute__((aligned(16))) float smem[SMEM_FLOATS]; ph_mixC(p, l, row0, nrows, blockIdx.x, gridDim.x, smem); }
__global__ void __launch_bounds__(NT) k_mixD(Params p, int l, int row0, int nrows) { __shared__ __attribute__((aligned(16))) float smem[SMEM_FLOATS]; ph_mixD(p, l, row0, nrows, blockIdx.x, gridDim.x, smem); }
__global__ void __launch_bounds__(NT) k_gemm_out(Params p, int l, const float* xin, int row0, int nrows) { __shared__ __attribute__((aligned(16))) float smem[SMEM_FLOATS]; ph_gemm_out(p, l, xin, row0, nrows, blockIdx.x, gridDim.x, smem); }
#else
__global__ void __launch_bounds__(NT) k_fwd(Params p) {
    __shared__ __attribute__((aligned(16))) float smem[SMEM_FLOATS];
    cg::grid_group grid = cg::this_grid();
    const int vb = blockIdx.x, nvb = gridDim.x;
    for (int l = 0; l < DEPTH; ++l) {
        const float* xin = l == 0 ? p.x : p.out;
        ph_rstd(xin, p.rstd, 0, NTOK, vb, nvb);
        grid.sync();
        for (int half = 0; half < 2; ++half) {
            const int row0 = half * HALF_ROWS;
            ph_gemm_in(p, l, xin, row0, HALF_ROWS, vb, nvb, smem);
            grid.sync();
            ph_post(p, l, HALF_ROWS, vb, nvb);
            grid.sync();
            ph_mixAB(p, l, row0, HALF_ROWS, vb, nvb);
            ph_mixC(p, l, row0, HALF_ROWS, vb, nvb, smem);
            ph_mixD(p, l, row0, HALF_ROWS, vb, nvb, smem);
            grid.sync();
        }
        ph_gemm_out(p, l, xin, 0, NTOK, vb, nvb, smem);
        grid.sync();
    }
}
#endif

extern "C" void kernel_launch(void* const* d_in, const int* in_sizes, int n_in, void* d_out, int out_size, void* d_ws, size_t ws_size,
                              hipStream_t stream) {
    Params p{};
    p.x = (const float*)d_in[0]; p.norm_g = (const float*)d_in[1]; p.w_in = (const float*)d_in[2]; p.conv_w = (const float*)d_in[3];
    p.conv_b = (const float*)d_in[4]; p.gmlp_g = (const float*)d_in[5]; p.gmlp_ws = (const float*)d_in[6]; p.gmlp_b = (const float*)d_in[7];
    p.diff_qg = (const float*)d_in[8]; p.diff_kg = (const float*)d_in[9]; p.diff_lam = (const float*)d_in[10]; p.diff_subg = (const float*)d_in[11];
    p.dsa_qg = (const float*)d_in[12]; p.dsa_kg = (const float*)d_in[13]; p.w_out = (const float*)d_in[14];
    p.out = (float*)d_out;
    char* ws = (char*)d_ws;
    p.y = (float*)ws;
    p.mix = (float*)(ws + (size_t)HALF_ROWS * NIN * 4);
    p.rstd = (float*)(ws + (size_t)HALF_ROWS * NIN * 4 + (size_t)NTOK * DM * 4);
#if !ONE_LAUNCH
    for (int l = 0; l < DEPTH; ++l) {
        const float* xin = l == 0 ? p.x : p.out;
        k_rstd<<<2048, NT, 0, stream>>>(p, xin, 0, NTOK);
        for (int half = 0; half < 2; ++half) {
            const int row0 = half * HALF_ROWS;
            k_gemm_in<<<(HALF_ROWS / 64) * 57, NT, 0, stream>>>(p, l, xin, row0, HALF_ROWS);
            k_post<<<HALF_ROWS, NT, 0, stream>>>(p, l, HALF_ROWS);
            k_mixAB<<<HALF_ROWS, NT, 0, stream>>>(p, l, row0, HALF_ROWS);
            k_mixC<<<HALF_ROWS * 4, NT, 0, stream>>>(p, l, row0, HALF_ROWS);
            k_mixD<<<HALF_ROWS, NT, 0, stream>>>(p, l, row0, HALF_ROWS);
        }
        k_gemm_out<<<(NTOK / 64) * 16, NT, 0, stream>>>(p, l, xin, 0, NTOK);
    }
#else
    static int grid_blocks = 0;
    if (!grid_blocks) {
        int dev = 0, cus = 0, per_cu = 0;
        hipGetDevice(&dev);
        hipDeviceGetAttribute(&cus, hipDeviceAttributeMultiprocessorCount, dev);
        hipOccupancyMaxActiveBlocksPerMultiprocessor(&per_cu, k_fwd, NT, 0);
        if (per_cu > 4) per_cu = 4;
        grid_blocks = cus * per_cu;
    }
    void* args[] = {&p};
    hipError_t e = hipLaunchCooperativeKernel((void*)k_fwd, dim3(grid_blocks), dim3(NT), args, 0, stream);
    if (e != hipSuccess) fprintf(stderr, "cooperative launch failed: %s (grid %d)\n", hipGetErrorString(e), grid_blocks);
#endif
}
```

```cpp
#include <hip/hip_runtime.h>
#include <hip/hip_cooperative_groups.h>
#include <math.h>
#include <stdint.h>
#include <stdio.h>

#ifndef ONE_LAUNCH
#define ONE_LAUNCH 1
#endif

namespace cg = cooperative_groups;

constexpr int DM = 1024, SEQ = 2048, BATCH = 16, DEPTH = 4, NIN = 3620, NTOK = BATCH * SEQ;
constexpr int HALF_ROWS = NTOK / 2;
constexpr float EPS = 1e-6f;
constexpr int A_H = 0, A_B = 256, A_C = 512, A_Z = 768, B_U = 1024, B_V = 1280, B_Z = 1536, C_Q = 1792, C_K = 2048, C_V = 2304,
              C_Z = 2560, D_Q = 2816, D_K = 3072, D_V = 3136, D_Z = 3200, I_Q = 3456, I_K = 3584, I_W = 3616;
constexpr int TOPK = 256;
constexpr int NT = 256;

struct Params {
    const float* x; const float* norm_g; const float* w_in; const float* conv_w; const float* conv_b;
    const float* gmlp_g; const float* gmlp_ws; const float* gmlp_b; const float* diff_qg; const float* diff_kg;
    const float* diff_lam; const float* diff_subg; const float* dsa_qg; const float* dsa_kg; const float* w_out;
    float* out; float* y; float* mix; float* rstd;
};

__device__ __forceinline__ float wave_sum(float v) {
#pragma unroll
    for (int o = 32; o > 0; o >>= 1) v += __shfl_xor(v, o);
    return v;
}
__device__ __forceinline__ float wave_max(float v) {
#pragma unroll
    for (int o = 32; o > 0; o >>= 1) v = fmaxf(v, __shfl_xor(v, o));
    return v;
}
__device__ __forceinline__ int wave_sumi(int v) {
#pragma unroll
    for (int o = 32; o > 0; o >>= 1) v += __shfl_xor(v, o);
    return v;
}
__device__ __forceinline__ float block_sum(float v, float* red) {
    v = wave_sum(v);
    __syncthreads();
    if ((threadIdx.x & 63) == 0) red[threadIdx.x >> 6] = v;
    __syncthreads();
    return (red[0] + red[1]) + (red[2] + red[3]);
}
__device__ __forceinline__ float block_max(float v, float* red) {
    v = wave_max(v);
    __syncthreads();
    if ((threadIdx.x & 63) == 0) red[threadIdx.x >> 6] = v;
    __syncthreads();
    return fmaxf(fmaxf(red[0], red[1]), fmaxf(red[2], red[3]));
}
__device__ __forceinline__ int block_sumi(int v, int* red) {
    v = wave_sumi(v);
    __syncthreads();
    if ((threadIdx.x & 63) == 0) red[threadIdx.x >> 6] = v;
    __syncthreads();
    return (red[0] + red[1]) + (red[2] + red[3]);
}
__device__ __forceinline__ int block_excl_scan(int v, int* red, int* tot) {
    const int lane = threadIdx.x & 63, w = threadIdx.x >> 6;
    int inc = v;
#pragma unroll
    for (int o = 1; o < 64; o <<= 1) { int n = __shfl_up(inc, o); if (lane >= o) inc += n; }
    __syncthreads();
    if (lane == 63) red[w] = inc;
    __syncthreads();
    int base = 0;
    for (int i = 0; i < w; ++i) base += red[i];
    *tot = red[0] + red[1] + red[2] + red[3];
    return base + inc - v;
}

__device__ void ph_rstd(const float* xin, float* rstd, int row0, int nrows, int vb, int nvb) {
    const int lane = threadIdx.x & 63, gw = vb * 4 + (threadIdx.x >> 6), ngw = nvb * 4;
    for (int r = gw; r < nrows; r += ngw) {
        const float4* xr = (const float4*)(xin + (size_t)(row0 + r) * DM);
        float s = 0.f;
#pragma unroll
        for (int j = 0; j < 4; ++j) { float4 v = xr[lane + 64 * j]; s += v.x * v.x + v.y * v.y + v.z * v.z + v.w * v.w; }
        s = wave_sum(s);
        if (lane == 0) rstd[row0 + r] = rsqrtf(s * (1.f / DM) + EPS);
    }
}

__device__ void gemm_tile(const float* A, int lda, const float* ks, const float* rs, const float* B, int ldb, int N, int K,
                          float* C, int ldc, const float* res, int tm, int tn, float* smem) {
    float (*As)[68] = (float (*)[68])smem;
    float (*Bs)[68] = (float (*)[68])(smem + 16 * 68);
    const int tid = threadIdx.x, tx = tid & 15, ty = tid >> 4;
    const int row0 = tm * 64, col0 = tn * 64;
    float acc[4][4];
#pragma unroll
    for (int i = 0; i < 4; ++i)
#pragma unroll
        for (int j = 0; j < 4; ++j) acc[i][j] = 0.f;
    for (int k0 = 0; k0 < K; k0 += 16) {
        {
            const int r = tid >> 2, kq = (tid & 3) * 4;
            float4 a = *(const float4*)(A + (size_t)(row0 + r) * lda + k0 + kq);
            if (ks) { const float4 g = *(const float4*)(ks + k0 + kq); a.x *= g.x; a.y *= g.y; a.z *= g.z; a.w *= g.w; }
            As[kq + 0][r] = a.x; As[kq + 1][r] = a.y; As[kq + 2][r] = a.z; As[kq + 3][r] = a.w;
        }
        {
            const int kk = tid >> 4, n = (tid & 15) * 4;
            float4 b = make_float4(0.f, 0.f, 0.f, 0.f);
            if (col0 + n < N) b = *(const float4*)(B + (size_t)(k0 + kk) * ldb + col0 + n);
            *(float4*)&Bs[kk][n] = b;
        }
        __syncthreads();
#pragma unroll
        for (int kk = 0; kk < 16; ++kk) {
            const float4 a = *(const float4*)&As[kk][ty * 4];
            const float4 b = *(const float4*)&Bs[kk][tx * 4];
            const float av[4] = {a.x, a.y, a.z, a.w}, bv[4] = {b.x, b.y, b.z, b.w};
#pragma unroll
            for (int i = 0; i < 4; ++i)
#pragma unroll
                for (int j = 0; j < 4; ++j) acc[i][j] = fmaf(av[i], bv[j], acc[i][j]);
        }
        __syncthreads();
    }
#pragma unroll
    for (int i = 0; i < 4; ++i) {
        const int r = row0 + ty * 4 + i;
        const float sc = rs ? rs[r] : 1.f;
#pragma unroll
        for (int j = 0; j < 4; ++j) {
            const int c = col0 + tx * 4 + j;
            if (c < N) {
                float v = acc[i][j] * sc;
                if (res) v += res[(size_t)r * ldc + c];
                C[(size_t)r * ldc + c] = v;
            }
        }
    }
}

__device__ void ph_gemm_in(const Params& p, int l, const float* xin, int row0, int nrows, int vb, int nvb, float* smem) {
    const int ntn = (NIN + 63) / 64, ntiles = (nrows / 64) * ntn;
    for (int t = vb; t < ntiles; t += nvb) {
        const int tm = t / ntn, tn = t % ntn;
        gemm_tile(xin + (size_t)row0 * DM, DM, p.norm_g + l * DM, p.rstd + row0, p.w_in + (size_t)l * DM * NIN, NIN, NIN, DM,
                  p.y, NIN, nullptr, tm, tn, smem);
    }
}
__device__ void ph_gemm_out(const Params& p, int l, const float* xin, int row0, int nrows, int vb, int nvb, float* smem) {
    const int ntn = DM / 64, ntiles = (nrows / 64) * ntn;
    for (int t = vb; t < ntiles; t += nvb) {
        const int tm = t / ntn, tn = t % ntn;
        gemm_tile(p.mix + (size_t)row0 * DM, DM, nullptr, nullptr, p.w_out + (size_t)l * DM * DM, DM, DM, DM,
                  p.out + (size_t)row0 * DM, DM, xin + (size_t)row0 * DM, tm, tn, smem);
    }
}

__device__ __forceinline__ float gelu_exact(float v) { return 0.5f * v * (1.f + erff(v * 0.70710678118654752f)); }
__device__ __forceinline__ float silu(float v) { return v / (1.f + expf(-v)); }
__device__ void ph_post(const Params& p, int l, int nrows, int vb, int nvb) {
    const int t = threadIdx.x;
    for (int r = vb; r < nrows; r += nvb) {
        float* yr = p.y + (size_t)r * NIN;
        yr[B_U + t] = gelu_exact(yr[B_U + t]);
        {
            float v = gelu_exact(yr[B_V + t]);
            const float ss = wave_sum(v * v);
            yr[B_V + t] = v * rsqrtf(ss * (1.f / 64) + EPS) * p.gmlp_g[l * 256 + t];
        }
        yr[A_Z + t] = silu(yr[A_Z + t]);
        yr[B_Z + t] = silu(yr[B_Z + t]);
        yr[C_Z + t] = silu(yr[C_Z + t]);
        yr[D_Z + t] = silu(yr[D_Z + t]);
        {
            float v = yr[C_Q + t]; float ss = v * v;
#pragma unroll
            for (int o = 16; o > 0; o >>= 1) ss += __shfl_xor(ss, o);
            yr[C_Q + t] = v * rsqrtf(ss * (1.f / 32) + EPS) * p.diff_qg[l * 32 + (t & 31)];
        }
        {
            float v = yr[C_K + t]; float ss = v * v;
#pragma unroll
            for (int o = 16; o > 0; o >>= 1) ss += __shfl_xor(ss, o);
            yr[C_K + t] = v * rsqrtf(ss * (1.f / 32) + EPS) * p.diff_kg[l * 32 + (t & 31)];
        }
        {
            float v = yr[D_Q + t];
            const float ss = wave_sum(v * v);
            yr[D_Q + t] = v * rsqrtf(ss * (1.f / 64) + EPS) * p.dsa_qg[l * 64 + (t & 63)];
        }
        if (t < 64) {
            float v = yr[D_K + t];
            const float ss = wave_sum(v * v);
            yr[D_K + t] = v * rsqrtf(ss * (1.f / 64) + EPS) * p.dsa_kg[l * 64 + t];
        }
    }
}

__device__ void ph_mixAB(const Params& p, int l, int row0, int nrows, int vb, int nvb) {
    const int c = threadIdx.x;
    for (int r = vb; r < nrows; r += nvb) {
        const int pos = (row0 + r) & (SEQ - 1);
        const float* yr = p.y + (size_t)r * NIN;
        float* mr = p.mix + (size_t)(row0 + r) * DM;
        {
            const float u0 = yr[A_C + c] * yr[A_H + c];
            const float u1 = pos >= 1 ? yr[A_C + c - NIN] * yr[A_H + c - NIN] : 0.f;
            const float u2 = pos >= 2 ? yr[A_C + c - 2 * NIN] * yr[A_H + c - 2 * NIN] : 0.f;
            const float* w = p.conv_w + l * 768;
            const float conv = w[c] * u2 + w[256 + c] * u1 + w[512 + c] * u0;
            mr[c] = yr[A_B + c] * (conv + p.conv_b[l * 256 + c]) * yr[A_Z + c];
        }
        {
            const int h = c >> 6, tt = pos & 127, smax = tt < 64 ? 64 : 128;
            const float* wrow = p.gmlp_ws + ((size_t)(l * 4 + h) * 128 + tt) * 128;
            const float* vb0 = yr - (size_t)tt * NIN + B_V + c;
            float s = 0.f;
            for (int sp = 0; sp < smax; ++sp) s = fmaf(wrow[sp], vb0[(size_t)sp * NIN], s);
            s += p.gmlp_b[(l * 4 + h) * 128 + tt];
            mr[256 + c] = yr[B_U + c] * s * yr[B_Z + c];
        }
    }
}

__device__ void ph_mixC(const Params& p, int l, int row0, int nrows, int vb, int nvb, float* smem) {
    float* l1 = smem;
    float* l2 = smem + 2048;
    float* qs = smem + 4096;
    float* part = smem + 4160;
    float* red = smem + 4416;
    const int tid = threadIdx.x;
    const float lam_init = 0.8f - 0.6f * expf(-0.3f * (float)l);
    const float* lp = p.diff_lam + l * 128;
    float d1 = 0.f, d2 = 0.f;
    for (int i = 0; i < 32; ++i) { d1 += lp[i] * lp[32 + i]; d2 += lp[64 + i] * lp[96 + i]; }
    const float lam = expf(d1) - expf(d2) + lam_init;
    const float scale = 0.17677669529663687f;
    const int nitems = nrows * 4;
    for (int it = vb; it < nitems; it += nvb) {
        const int r = it >> 2, h = it & 3;
        const int pos = (row0 + r) & (SEQ - 1);
        const int nk = ((pos >> 6) + 1) * 64;
        const float slope = exp2f(-(float)(2 * h + 1));
        const float* yr = p.y + (size_t)r * NIN;
        const float* yb = yr - (size_t)pos * NIN;
        __syncthreads();
        if (tid < 64) qs[tid] = yr[C_Q + h * 64 + tid];
        __syncthreads();
        float m1 = -INFINITY, m2 = -INFINITY;
        for (int s = tid; s < nk; s += NT) {
            const float* kr = yb + (size_t)s * NIN + C_K + h * 64;
            float a1 = 0.f, a2 = 0.f;
#pragma unroll 8
            for (int d = 0; d < 32; ++d) { a1 = fmaf(qs[d], kr[d], a1); a2 = fmaf(qs[32 + d], kr[32 + d], a2); }
            const float dist = fabsf((float)(pos - s));
            a1 = a1 * scale - slope * dist; a2 = a2 * scale - slope * dist;
            l1[s] = a1; l2[s] = a2;
            m1 = fmaxf(m1, a1); m2 = fmaxf(m2, a2);
        }
        m1 = block_max(m1, red); m2 = block_max(m2, red);
        float s1 = 0.f, s2 = 0.f;
        for (int s = tid; s < nk; s += NT) {
            const float e1 = expf(l1[s] - m1), e2 = expf(l2[s] - m2);
            l1[s] = e1; l2[s] = e2; s1 += e1; s2 += e2;
        }
        s1 = block_sum(s1, red); s2 = block_sum(s2, red);
        const float i1 = 1.f / s1, i2 = lam / s2;
        for (int s = tid; s < nk; s += NT) l1[s] = l1[s] * i1 - l2[s] * i2;
        __syncthreads();
        {
            const int d = tid & 63, pr = tid >> 6;
            const float* vr = yb + C_V + h * 64 + d;
            float acc = 0.f;
            for (int s = pr; s < nk; s += 4) acc = fmaf(l1[s], vr[(size_t)s * NIN], acc);
            part[tid] = acc;
        }
        __syncthreads();
        if (tid < 64) {
            float o = (part[tid] + part[64 + tid]) + (part[128 + tid] + part[192 + tid]);
            const float ss = wave_sum(o * o);
            o = o * rsqrtf(ss * (1.f / 64) + EPS) * p.diff_subg[l * 256 + h * 64 + tid] * (1.f - lam_init);
            p.mix[(size_t)(row0 + r) * DM + 512 + h * 64 + tid] = o * yr[C_Z + h * 64 + tid];
        }
    }
}

__device__ __forceinline__ unsigned fkey(float f) { const unsigned u = __float_as_uint(f); return (u & 0x80000000u) ? ~u : (u | 0x80000000u); }
__device__ void ph_mixD(const Params& p, int l, int row0, int nrows, int vb, int nvb, float* smem) {
    float* sc = smem;
    float* pp = smem + 2048;
    int* sel = (int*)(smem + 3072);
    float* qd = smem + 3328;
    float* iq = smem + 3584;
    float* red = smem + 3712;
    int* redi = (int*)(smem + 3716);
    const int tid = threadIdx.x;
    for (int r = vb; r < nrows; r += nvb) {
        const int pos = (row0 + r) & (SEQ - 1);
        const int nk = ((pos >> 6) + 1) * 64;
        const float* yr = p.y + (size_t)r * NIN;
        const float* yb = yr - (size_t)pos * NIN;
        __syncthreads();
        qd[tid] = yr[D_Q + tid];
        if (tid < 128) iq[tid] = yr[I_Q + tid];
        __syncthreads();
        int nsel;
        if (nk <= TOPK) {
            nsel = nk;
            if (tid < nk) sel[tid] = tid;
        } else {
            const float w0 = yr[I_W + 0], w1 = yr[I_W + 1], w2 = yr[I_W + 2], w3 = yr[I_W + 3];
            const float isc = 0.17677669529663687f;
            for (int s = tid; s < nk; s += NT) {
                const float* kr = yb + (size_t)s * NIN + I_K;
                float a0 = 0.f, a1 = 0.f, a2 = 0.f, a3 = 0.f;
#pragma unroll 8
                for (int d = 0; d < 32; ++d) { const float kv = kr[d]; a0 = fmaf(iq[d], kv, a0); a1 = fmaf(iq[32 + d], kv, a1); a2 = fmaf(iq[64 + d], kv, a2); a3 = fmaf(iq[96 + d], kv, a3); }
                float v = fmaxf(a0 * isc, 0.f) * w0 + fmaxf(a1 * isc, 0.f) * w1 + fmaxf(a2 * isc, 0.f) * w2 + fmaxf(a3 * isc, 0.f) * w3;
                v *= 0.5f;
                if (v == 0.f) v = 0.f;
                sc[s] = v;
            }
            __syncthreads();
            unsigned key[8];
#pragma unroll
            for (int j = 0; j < 8; ++j) { const int s = tid * 8 + j; key[j] = s < nk ? fkey(sc[s]) : 0u; }
            unsigned prefix = 0u;
            for (int bit = 31; bit >= 0; --bit) {
                const unsigned cand = prefix | (1u << bit);
                int cnt = 0;
#pragma unroll
                for (int j = 0; j < 8; ++j) cnt += key[j] >= cand ? 1 : 0;
                cnt = block_sumi(cnt, redi);
                if (cnt >= TOPK) prefix = cand;
            }
            int cgt = 0, ceq = 0;
#pragma unroll
            for (int j = 0; j < 8; ++j) { cgt += key[j] > prefix ? 1 : 0; ceq += key[j] == prefix ? 1 : 0; }
            const int tot_gt = block_sumi(cgt, redi);
            const int need = TOPK - tot_gt;
            int tot_eq;
            int eqbase = block_excl_scan(ceq, redi, &tot_eq);
            unsigned selmask = 0u; int nmine = 0;
#pragma unroll
            for (int j = 0; j < 8; ++j) {
                bool take = key[j] > prefix;
                if (key[j] == prefix) { take = eqbase < need; ++eqbase; }
                if (take) { selmask |= 1u << j; ++nmine; }
            }
            int tot_sel;
            int sbase = block_excl_scan(nmine, redi, &tot_sel);
#pragma unroll
            for (int j = 0; j < 8; ++j) if (selmask & (1u << j)) { if (sbase < TOPK) sel[sbase] = tid * 8 + j; ++sbase; }
            nsel = tot_sel < TOPK ? tot_sel : TOPK;
        }
        __syncthreads();
        float lg[4] = {-INFINITY, -INFINITY, -INFINITY, -INFINITY};
        if (tid < nsel) {
            const int s = sel[tid];
            const float* kr = yb + (size_t)s * NIN + D_K;
            float a0 = 0.f, a1 = 0.f, a2 = 0.f, a3 = 0.f;
#pragma unroll 8
            for (int d = 0; d < 64; ++d) { const float kv = kr[d]; a0 = fmaf(qd[d], kv, a0); a1 = fmaf(qd[64 + d], kv, a1); a2 = fmaf(qd[128 + d], kv, a2); a3 = fmaf(qd[192 + d], kv, a3); }
            const float dist = fabsf((float)(pos - s));
            lg[0] = a0 * 0.125f - 0.25f * dist;
            lg[1] = a1 * 0.125f - 0.0625f * dist;
            lg[2] = a2 * 0.125f - 0.015625f * dist;
            lg[3] = a3 * 0.125f - 0.00390625f * dist;
        }
        float inv[4];
#pragma unroll
        for (int h = 0; h < 4; ++h) {
            const float m = block_max(lg[h], red);
            const float e = tid < nsel ? expf(lg[h] - m) : 0.f;
            const float ssum = block_sum(e, red);
            pp[h * 256 + tid] = e;
            inv[h] = 1.f / ssum;
        }
        __syncthreads();
        {
            const int h = tid >> 6, d = tid & 63;
            const float* vr = yb + D_V + d;
            float acc = 0.f;
            for (int j = 0; j < nsel; ++j) acc = fmaf(pp[h * 256 + j], vr[(size_t)sel[j] * NIN], acc);
            const float invh = h == 0 ? inv[0] : h == 1 ? inv[1] : h == 2 ? inv[2] : inv[3];
            p.mix[(size_t)(row0 + r) * DM + 768 + tid] = acc * invh * yr[D_Z + tid];
        }
    }
}

constexpr int SMEM_FLOATS = 4480;
#if !ONE_LAUNCH
__global__ void __launch_bounds__(NT) k_rstd(Params p, const float* xin, int row0, int nrows) { ph_rstd(xin, p.rstd, row0, nrows, blockIdx.x, gridDim.x); }
__global__ void __launch_bounds__(NT) k_gemm_in(Params p, int l, const float* xin, int row0, int nrows) { __shared__ __attribute__((aligned(16))) float smem[SMEM_FLOATS]; ph_gemm_in(p, l, xin, row0, nrows, blockIdx.x, gridDim.x, smem); }
__global__ void __launch_bounds__(NT) k_post(Params p, int l, int nrows) { ph_post(p, l, nrows, blockIdx.x, gridDim.x); }
__global__ void __launch_bounds__(NT) k_mixAB(Params p, int l, int row0, int nrows) { ph_mixAB(p, l, row0, nrows, blockIdx.x, gridDim.x); }
__global__ void __launch_bounds__(NT) k_mixC(Params p, int l, int row0, int nrows) { __shared__ __attribute__((aligned(16))) float smem[SMEM_FLOATS]; ph_mixC(p, l, row0, nrows, blockIdx.x, gridDim.x, smem); }
__global__ void __launch_bounds__(NT) k_mixD(Params p, int l, int row0, int nrows) { __shared__ __attribute__((aligned(16))) float smem[SMEM_FLOATS]; ph_mixD(p, l, row0, nrows, blockIdx.x, gridDim.x, smem); }
__global__ void __launch_bounds__(NT) k_gemm_out(Params p, int l, const float* xin, int row0, int nrows) { __shared__ __attribute__((aligned(16))) float smem[SMEM_FLOATS]; ph_gemm_out(p, l, xin, row0, nrows, blockIdx.x, gridDim.x, smem); }
#else
__global__ void __launch_bounds__(NT) k_fwd(Params p) {
    __shared__ __attribute__((aligned(16))) float smem[SMEM_FLOATS];
    cg::grid_group grid = cg::this_grid();
    const int vb = blockIdx.x, nvb = gridDim.x;
    for (int l = 0; l < DEPTH; ++l) {
        const float* xin = l == 0 ? p.x : p.out;
        ph_rstd(xin, p.rstd, 0, NTOK, vb, nvb);
        grid.sync();
        for (int half = 0; half < 2; ++half) {
            const int row0 = half * HALF_ROWS;
            ph_gemm_in(p, l, xin, row0, HALF_ROWS, vb, nvb, smem);
            grid.sync();
            ph_post(p, l, HALF_ROWS, vb, nvb);
            grid.sync();
            ph_mixAB(p, l, row0, HALF_ROWS, vb, nvb);
            ph_mixC(p, l, row0, HALF_ROWS, vb, nvb, smem);
            ph_mixD(p, l, row0, HALF_ROWS, vb, nvb, smem);
            grid.sync();
        }
        ph_gemm_out(p, l, xin, 0, NTOK, vb, nvb, smem);
        grid.sync();
    }
}
#endif

extern "C" void kernel_launch(void* const* d_in, const int* in_sizes, int n_in, void* d_out, int out_size, void* d_ws, size_t ws_size,
                              hipStream_t stream) {
    Params p{};
    p.x = (const float*)d_in[0]; p.norm_g = (const float*)d_in[1]; p.w_in = (const float*)d_in[2]; p.conv_w = (const float*)d_in[3];
    p.conv_b = (const float*)d_in[4]; p.gmlp_g = (const float*)d_in[5]; p.gmlp_ws = (const float*)d_in[6]; p.gmlp_b = (const float*)d_in[7];
    p.diff_qg = (const float*)d_in[8]; p.diff_kg = (const float*)d_in[9]; p.diff_lam = (const float*)d_in[10]; p.diff_subg = (const float*)d_in[11];
    p.dsa_qg = (const float*)d_in[12]; p.dsa_kg = (const float*)d_in[13]; p.w_out = (const float*)d_in[14];
    p.out = (float*)d_out;
    char* ws = (char*)d_ws;
    p.y = (float*)ws;
    p.mix = (float*)(ws + (size_t)HALF_ROWS * NIN * 4);
    p.rstd = (float*)(ws + (size_t)HALF_ROWS * NIN * 4 + (size_t)NTOK * DM * 4);
#if !ONE_LAUNCH
    for (int l = 0; l < DEPTH; ++l) {
        const float* xin = l == 0 ? p.x : p.out;
        k_rstd<<<2048, NT, 0, stream>>>(p, xin, 0, NTOK);
        for (int half = 0; half < 2; ++half) {
            const int row0 = half * HALF_ROWS;
            k_gemm_in<<<(HALF_ROWS / 64) * 57, NT, 0, stream>>>(p, l, xin, row0, HALF_ROWS);
            k_post<<<HALF_ROWS, NT, 0, stream>>>(p, l, HALF_ROWS);
            k_mixAB<<<HALF_ROWS, NT, 0, stream>>>(p, l, row0, HALF_ROWS);
            k_mixC<<<HALF_ROWS * 4, NT, 0, stream>>>(p, l, row0, HALF_ROWS);
            k_mixD<<<HALF_ROWS, NT, 0, stream>>>(p, l, row0, HALF_ROWS);
        }
        k_gemm_out<<<(NTOK / 64) * 16, NT, 0, stream>>>(p, l, xin, 0, NTOK);
    }
#else
    static int grid_blocks = 0;
    if (!grid_blocks) {
        int dev = 0, cus = 0, per_cu = 0;
        hipGetDevice(&dev);
        hipDeviceGetAttribute(&cus, hipDeviceAttributeMultiprocessorCount, dev);
        hipOccupancyMaxActiveBlocksPerMultiprocessor(&per_cu, k_fwd, NT, 0);
        if (per_cu > 4) per_cu = 4;
        grid_blocks = cus * per_cu;
    }
    void* args[] = {&p};
    hipError_t e = hipLaunchCooperativeKernel((void*)k_fwd, dim3(grid_blocks), dim3(NT), args, 0, stream);
    if (e != hipSuccess) fprintf(stderr, "cooperative launch failed: %s (grid %d)\n", hipGetErrorString(e), grid_blocks);
#endif
}
```

```cpp
#include <hip/hip_runtime.h>
#include <hip/hip_cooperative_groups.h>
#include <math.h>
#include <stdint.h>
#include <stdio.h>
namespace cg = cooperative_groups;
namespace pg8 {
#define PG8_LAS __attribute__((address_space(3)))
typedef unsigned short bf16_t;
typedef short bf16x8 __attribute__((ext_vector_type(8)));
typedef float f32x4 __attribute__((ext_vector_type(4)));
typedef unsigned u32x4 __attribute__((ext_vector_type(4)));
constexpr int BM = 256, BK = 64, HALF = 128, HTB = HALF * BK * 2  , STAGE_BYTES = 8 * HTB, NXCD = 8, WGM = 8;

__host__ __device__ __forceinline__ int lds_byte(int r, int c) { const int st = (r >> 4) * 2 + (c >> 5), rr = r & 15, cc = c & 31, ob = rr * 64 + cc * 2; return st * 1024 + (ob ^ (((ob >> 9) & 1) << 5)); }
__host__ __device__ __forceinline__ void stage_rc(int b, int& R, int& C) { const int st = b / 1024, sb = b % 1024, swz = sb ^ (((sb >> 9) & 1) << 5); R = (st >> 1) * 16 + swz / 64; C = (st & 1) * 32 + (swz % 64) / 2; }
__host__ __device__ __forceinline__ int perm32(int rho) { const int n = rho >> 4, i = rho & 15; return 8 * (i >> 2) + 4 * n + (i & 3); }

struct Unit { int pm, pn; };
struct Gemm { const bf16_t* A; const bf16_t* Bt; int M, N, K; };

struct StaticOrder {
    int nM, nN, nwg, G, c;
    __host__ __device__ void init(int M, int N, int G_, int c_) { nM = M / BM; nN = N / BM; nwg = nM * nN; G = G_; c = c_; }
    __host__ __device__ bool next(int i, Unit& u) const {
        const long L = (long)i * G + c; if (L >= nwg) return false;
        int wgid = (int)L; { const int q = nwg / NXCD, r = nwg % NXCD, xcd = wgid % NXCD, off = wgid / NXCD; wgid = (xcd < r ? xcd * (q + 1) : r * (q + 1) + (xcd - r) * q) + off; }
        const int nig = WGM * nN, gid = wgid / nig, fm = gid * WGM, gsz = (nM - fm) < WGM ? (nM - fm) : WGM;
        u.pm = fm + ((wgid % nig) % gsz); u.pn = (wgid % nig) / gsz; return true;
    }
    __device__ __forceinline__ void a_ready(const Unit&) const {}
    __device__ __forceinline__ void done(const Unit&) const {}
};

__device__ __forceinline__ unsigned cvt_pk_bf16(float lo, float hi) { unsigned r; asm volatile("v_cvt_pk_bf16_f32 %0, %1, %2" : "=v"(r) : "v"(lo), "v"(hi)); return r; }
typedef float f32x2 __attribute__((ext_vector_type(2)));
__device__ __forceinline__ f32x2 gelu_pk(f32x2 v) {
    const f32x2 av = __builtin_elementwise_abs(v), d = av * 0.2316418882f + 1.0f;
    f32x2 t; t.x = __builtin_amdgcn_rcpf(d.x); t.y = __builtin_amdgcn_rcpf(d.y);
    f32x2 q = t * 0.5307027145f + (-0.7265760135f); q = q * t + 0.7107068705f; q = q * t + (-0.142248368f); q = q * t + 0.127414796f; q = q * t;
    const f32x2 s = (v * v) * (-0.72134752044f);
    f32x2 e; e.x = __builtin_amdgcn_exp2f(s.x); e.y = __builtin_amdgcn_exp2f(s.y);
    const f32x2 m = v * (q * e), r = v - m;
    f32x2 o; o.x = v.x < 0.f ? m.x : r.x; o.y = v.y < 0.f ? m.y : r.y; return o;
}
template <class Epi, class Sched, bool ALIGN_EPI = false, bool SP2 = false>
__device__ __forceinline__ void gemm_phase(PG8_LAS unsigned char* lds, const Gemm g, const Sched& S, const Epi& E) {
    int tid_ = threadIdx.x; asm volatile("" : "+v"(tid_));
    const int tid = tid_, wid = __builtin_amdgcn_readfirstlane(tid >> 6), lane = tid & 63, wr = wid >> 2, wc = wid & 3, fr = lane & 15, fq = lane >> 4;
    const int K = g.K, nt = K / BK;
    unsigned voffA[2], voffB[2];
#pragma unroll
    for (int i = 0; i < 2; ++i) { int R, C; stage_rc(tid * 16 + i * 8192, R, C); const int Rb = Epi::PERM ? ((R & ~31) + perm32(R & 31)) : R;
        voffA[i] = (unsigned)(R * K + C) * 2u; voffB[i] = (unsigned)(Rb * K + C) * 2u; }
    const size_t kstep = (size_t)(BK * 2);
    const size_t hstep = (size_t)HALF * K * 2;
    const size_t tstep = 2 * hstep;
    const unsigned ldsw = (unsigned)wid * 1024u;
    const int aoff = lds_byte(wr * 64 + fr, fq * 8), boff = lds_byte(wc * 32 + fr, fq * 8);
#define PG8_SA(b, h) (((b) * 2 + (h)) * HTB)
#define PG8_SB(b, h) ((4 + (b) * 2 + (h)) * HTB)
#define PG8_STAGE(bufoff, gbase, voff) do { _Pragma("unroll") for (int _i = 0; _i < 2; ++_i) \
        __builtin_amdgcn_global_load_lds((const unsigned*)((const char*)(gbase) + (voff)[_i]), (PG8_LAS unsigned*)(lds + (bufoff) + ldsw + _i * 8192), 16, 0, 0); } while (0)
#define PG8_LDA(dst, b, h) do { _Pragma("unroll") for (int m = 0; m < 4; ++m) _Pragma("unroll") for (int k = 0; k < 2; ++k) dst[m][k] = *(const PG8_LAS bf16x8*)(lds + PG8_SA(b, h) + aoff + m * 2048 + k * 1024); } while (0)
#define PG8_LDB(dst, b, h) do { _Pragma("unroll") for (int n = 0; n < 2; ++n) _Pragma("unroll") for (int k = 0; k < 2; ++k) dst[n][k] = *(const PG8_LAS bf16x8*)(lds + PG8_SB(b, h) + boff + n * 2048 + k * 1024); } while (0)
#define PG8_MMA(ai, bj, At, Bt) do { __builtin_amdgcn_s_setprio(1); _Pragma("unroll") for (int m = 0; m < 4; ++m) _Pragma("unroll") for (int n = 0; n < 2; ++n) _Pragma("unroll") for (int k = 0; k < 2; ++k) \
        acc[ai][bj][m][n] = __builtin_amdgcn_mfma_f32_16x16x32_bf16(Bt[n][k], At[m][k], acc[ai][bj][m][n], 0, 0, 0); __builtin_amdgcn_s_setprio(0); } while (0)
#define PG8_WAIT_V(n) asm volatile("s_waitcnt vmcnt(" #n ")" ::: "memory")
#define PG8_WAIT_L(n) asm volatile("s_waitcnt lgkmcnt(" #n ")" ::: "memory")
#define PG8_BAR __builtin_amdgcn_s_barrier()
#define PG8_SCHED __builtin_amdgcn_sched_barrier(0)
    Unit cur, nxt; int ui = 0;
    if (!S.next(0, cur)) return;
    f32x4 acc[2][2][4][2];
#pragma unroll
    for (int a = 0; a < 2; ++a)
#pragma unroll
        for (int b = 0; b < 2; ++b)
#pragma unroll
            for (int m = 0; m < 4; ++m)
#pragma unroll
                for (int n = 0; n < 2; ++n) acc[a][b][m][n] = (f32x4){0.f, 0.f, 0.f, 0.f};
    bf16x8 At[4][2], B0[2][2], B1[2][2];
    const char* cA = (const char*)g.A + (size_t)cur.pm * tstep; const char* cB = (const char*)g.Bt + (size_t)cur.pn * tstep;
    S.a_ready(cur);
    if constexpr (SP2) {
        PG8_STAGE(PG8_SB(0, 0), cB, voffB); PG8_STAGE(PG8_SB(0, 1), cB + hstep, voffB); PG8_STAGE(PG8_SA(0, 0), cA, voffA); PG8_STAGE(PG8_SA(0, 1), cA + hstep, voffA);
        if (wr == 1) PG8_BAR;
        PG8_WAIT_V(2); PG8_BAR;
        PG8_STAGE(PG8_SB(1, 0), cB + kstep, voffB); PG8_STAGE(PG8_SA(1, 0), cA + kstep, voffA); PG8_STAGE(PG8_SB(1, 1), cB + hstep + kstep, voffB);
        PG8_WAIT_V(6); PG8_BAR;
    } else {
        PG8_STAGE(PG8_SB(0, 0), cB, voffB); PG8_STAGE(PG8_SA(0, 0), cA, voffA); PG8_STAGE(PG8_SB(0, 1), cB + hstep, voffB); PG8_STAGE(PG8_SA(0, 1), cA + hstep, voffA);
        if (wr == 1) PG8_BAR;
        PG8_WAIT_V(4); PG8_BAR;
        PG8_STAGE(PG8_SB(1, 0), cB + kstep, voffB); PG8_STAGE(PG8_SA(1, 0), cA + kstep, voffA); PG8_STAGE(PG8_SB(1, 1), cB + hstep + kstep, voffB);
        PG8_WAIT_V(6); PG8_BAR;
    }
    for (;;) {
        const bool has_next = S.next(ui + 1, nxt);
        const char* nA = has_next ? (const char*)g.A + (size_t)nxt.pm * tstep : cA; const char* nB = has_next ? (const char*)g.Bt + (size_t)nxt.pn * tstep : cB;
        for (int t = 0; t < nt; t += 2) {
            const bool last = (t == nt - 2);
            const char* a1 = cA + (size_t)(t + 1) * kstep;
            const char* a2 = last ? nA : cA + (size_t)(t + 2) * kstep; const char* b2 = last ? nB : cB + (size_t)(t + 2) * kstep;
            const char* a3 = a2 + kstep; const char* b3 = b2 + kstep;
            if (last && has_next) S.a_ready(nxt);
            if constexpr (SP2) {
            PG8_LDB(B0, 0, 0); PG8_LDB(B1, 0, 1); PG8_SCHED; PG8_LDA(At, 0, 0); PG8_STAGE(PG8_SA(1, 1), a1 + hstep, voffA);
            PG8_WAIT_V(8); PG8_WAIT_L(0); PG8_BAR; PG8_MMA(0, 0, At, B0); PG8_MMA(0, 1, At, B1); PG8_BAR; PG8_SCHED;
            PG8_LDA(At, 0, 1); PG8_STAGE(PG8_SB(0, 0), b2, voffB); PG8_STAGE(PG8_SB(0, 1), b2 + hstep, voffB); PG8_STAGE(PG8_SA(0, 0), a2, voffA);
            PG8_WAIT_V(8); PG8_WAIT_L(0); PG8_BAR; PG8_MMA(1, 0, At, B0); PG8_MMA(1, 1, At, B1); PG8_BAR; PG8_SCHED;
            PG8_LDB(B0, 1, 0); PG8_LDB(B1, 1, 1); PG8_SCHED; PG8_LDA(At, 1, 0); PG8_STAGE(PG8_SA(0, 1), a2 + hstep, voffA);
            PG8_WAIT_V(8); PG8_WAIT_L(0); PG8_BAR; PG8_MMA(0, 0, At, B0); PG8_MMA(0, 1, At, B1); PG8_BAR; PG8_SCHED;
            PG8_LDA(At, 1, 1); PG8_STAGE(PG8_SB(1, 0), b3, voffB); PG8_STAGE(PG8_SB(1, 1), b3 + hstep, voffB); PG8_STAGE(PG8_SA(1, 0), a3, voffA);
            PG8_WAIT_V(8); PG8_WAIT_L(0); PG8_BAR; PG8_MMA(1, 0, At, B0); PG8_MMA(1, 1, At, B1); PG8_BAR; PG8_SCHED;
            } else {
            PG8_LDB(B0, 0, 0); PG8_SCHED; PG8_LDA(At, 0, 0); PG8_STAGE(PG8_SA(1, 1), a1 + hstep, voffA);
            PG8_WAIT_L(8); PG8_BAR; PG8_WAIT_L(0); PG8_MMA(0, 0, At, B0); PG8_BAR; PG8_SCHED;
            PG8_LDB(B1, 0, 1); PG8_STAGE(PG8_SB(0, 0), b2, voffB);
            PG8_BAR; PG8_WAIT_L(0); PG8_MMA(0, 1, At, B1); PG8_BAR;
            PG8_LDA(At, 0, 1); PG8_STAGE(PG8_SA(0, 0), a2, voffA);
            PG8_BAR; PG8_WAIT_L(0); PG8_MMA(1, 0, At, B0); PG8_BAR; PG8_SCHED;
            PG8_STAGE(PG8_SB(0, 1), b2 + hstep, voffB);
            PG8_WAIT_V(6); PG8_BAR; PG8_MMA(1, 1, At, B1); PG8_BAR;
            PG8_LDB(B0, 1, 0); PG8_SCHED; PG8_LDA(At, 1, 0); PG8_STAGE(PG8_SA(0, 1), a2 + hstep, voffA);
            PG8_WAIT_L(8); PG8_BAR; PG8_WAIT_L(0); PG8_MMA(0, 0, At, B0); PG8_BAR; PG8_SCHED;
            PG8_LDB(B1, 1, 1); PG8_STAGE(PG8_SB(1, 0), b3, voffB);
            PG8_BAR; PG8_WAIT_L(0); PG8_MMA(0, 1, At, B1); PG8_BAR;
            PG8_LDA(At, 1, 1); PG8_STAGE(PG8_SA(1, 0), a3, voffA);
            PG8_BAR; PG8_WAIT_L(0); PG8_MMA(1, 0, At, B0); PG8_BAR; PG8_SCHED;
            PG8_STAGE(PG8_SB(1, 1), b3 + hstep, voffB);
            PG8_WAIT_V(6); PG8_BAR; PG8_MMA(1, 1, At, B1); PG8_BAR;
            }
        }
        if constexpr (ALIGN_EPI) { if (wr == 0) PG8_BAR; }
        if constexpr (!Epi::AFTER_DRAIN) { E(acc, cur, wr, wc, fr, fq); S.done(cur); }
        if (!has_next) break;
#pragma unroll
        for (int a = 0; a < 2; ++a)
#pragma unroll
            for (int b = 0; b < 2; ++b)
#pragma unroll
                for (int m = 0; m < 4; ++m)
#pragma unroll
                    for (int n = 0; n < 2; ++n) acc[a][b][m][n] = (f32x4){0.f, 0.f, 0.f, 0.f};
        cur = nxt; cA = nA; cB = nB; ++ui;
        if constexpr (ALIGN_EPI) { if (wr == 1) PG8_BAR; }
    }
    PG8_WAIT_V(0);
    if constexpr (!ALIGN_EPI) { if (wr == 0) PG8_BAR; }
    PG8_BAR;
    if constexpr (Epi::AFTER_DRAIN) { E.fused(acc, cur, wr, wc, fr, fq, lds, wid, lane); S.done(cur); }
#undef PG8_SA
#undef PG8_SB
#undef PG8_STAGE
#undef PG8_LDA
#undef PG8_LDB
#undef PG8_MMA
#undef PG8_WAIT_V
#undef PG8_WAIT_L
#undef PG8_BAR
#undef PG8_SCHED
}
}

using pg8::bf16_t; using pg8::f32x4; using pg8::u32x4; using pg8::Unit;
#define LAS __attribute__((address_space(3)))

constexpr int DM = 1024, SEQ = 2048, BATCH = 16, DEPTH = 4, NIN = 3620, NTOK = BATCH * SEQ, YP = 3840;
constexpr float EPS = 1e-6f;
constexpr int O_DZ = 3200, O_DK = 3072, O_DV = 3136;
constexpr int YA_H = 0, YA_B = 256, YA_C = 512, YA_Z = 768, YB_U = 1024, YB_V = 1280, YB_Z = 1536, YC_Q = 1792, YC_K = 2048, YC_V = 2304,
              YC_Z = 2560, YD_Q = 2816, YD_Z = 3072, YD_K = 3328, YD_V = 3392, YI_Q = 3456, YI_K = 3584, YI_W = 3616;
constexpr int TOPK = 256;
constexpr int NT = 512, NW = 8;
constexpr int LDS_BYTES = 131072 + 4096;

constexpr size_t MiB = 1u << 20;
constexpr size_t WS_WTIN = 1 * MiB;
constexpr size_t WS_WTOUT = WS_WTIN + (size_t)DEPTH * YP * DM * 2;
constexpr size_t WS_SSQ = WS_WTOUT + (size_t)DEPTH * DM * DM * 2;
constexpr size_t WS_XB = WS_SSQ + (size_t)NTOK * 16 * 4;
constexpr size_t WS_Y = WS_XB + (size_t)NTOK * DM * 2;
constexpr size_t WS_MIX = WS_Y + (size_t)NTOK * YP * 2;
constexpr size_t WS_WSB = WS_MIX + (size_t)NTOK * DM * 2;
constexpr size_t WS_END = WS_WSB + (size_t)DEPTH * 4 * 128 * 128 * 2;

struct Params {
    const float* x; const float* norm_g; const float* w_in; const float* conv_w; const float* conv_b;
    const float* gmlp_g; const float* gmlp_ws; const float* gmlp_b; const float* diff_qg; const float* diff_kg;
    const float* diff_lam; const float* diff_subg; const float* dsa_qg; const float* dsa_kg; const float* w_out;
    float* out; bf16_t* wt_in; bf16_t* wt_out; float* ssq; bf16_t* xb; bf16_t* Y; bf16_t* mix; bf16_t* wsb;
};

__device__ __forceinline__ unsigned f2bf(float f) { unsigned u = __float_as_uint(f); return (u + 0x7fffu + ((u >> 16) & 1u)) >> 16; }
__device__ __forceinline__ unsigned pk2(float lo, float hi) { return f2bf(lo) | (f2bf(hi) << 16); }
__device__ __forceinline__ float bf2f(bf16_t b) { return __uint_as_float((unsigned)b << 16); }

__device__ __forceinline__ float wave_sum(float v) {
#pragma unroll
    for (int o = 32; o > 0; o >>= 1) v += __shfl_xor(v, o);
    return v;
}
__device__ __forceinline__ float wave_max(float v) {
#pragma unroll
    for (int o = 32; o > 0; o >>= 1) v = fmaxf(v, __shfl_xor(v, o));
    return v;
}
__device__ __forceinline__ int wave_sumi(int v) {
#pragma unroll
    for (int o = 32; o > 0; o >>= 1) v += __shfl_xor(v, o);
    return v;
}
__device__ __forceinline__ float block_sum(float v, float* red) {
    v = wave_sum(v);
    __syncthreads();
    if ((threadIdx.x & 63) == 0) red[threadIdx.x >> 6] = v;
    __syncthreads();
    float s = 0.f;
#pragma unroll
    for (int i = 0; i < NW; ++i) s += red[i];
    return s;
}
__device__ __forceinline__ float block_max(float v, float* red) {
    v = wave_max(v);
    __syncthreads();
    if ((threadIdx.x & 63) == 0) red[threadIdx.x >> 6] = v;
    __syncthreads();
    float s = red[0];
#pragma unroll
    for (int i = 1; i < NW; ++i) s = fmaxf(s, red[i]);
    return s;
}
__device__ __forceinline__ int block_sumi(int v, int* red) {
    v = wave_sumi(v);
    __syncthreads();
    if ((threadIdx.x & 63) == 0) red[threadIdx.x >> 6] = v;
    __syncthreads();
    int s = 0;
#pragma unroll
    for (int i = 0; i < NW; ++i) s += red[i];
    return s;
}
__device__ __forceinline__ int block_excl_scan(int v, int* red, int* tot) {
    const int lane = threadIdx.x & 63, w = threadIdx.x >> 6;
    int inc = v;
#pragma unroll
    for (int o = 1; o < 64; o <<= 1) { int n = __shfl_up(inc, o); if (lane >= o) inc += n; }
    __syncthreads();
    if (lane == 63) red[w] = inc;
    __syncthreads();
    int base = 0, t = 0;
#pragma unroll
    for (int i = 0; i < NW; ++i) { if (i < w) base += red[i]; t += red[i]; }
    *tot = t;
    return base + inc - v;
}

__device__ __forceinline__ int phys2logical(int n) { const int p = n & 255; return (n & ~255) + 64 * ((p >> 5) & 3) + 32 * (p >> 7) + (p & 31); }
__device__ __forceinline__ int logical2orig(int n) {
    if (n < 3072) return n;
    if (n < YD_K) return n - YD_Z + O_DZ;
    if (n < YD_V) return n - YD_K + O_DK;
    if (n < YI_Q) return n - YD_V + O_DV;
    if (n < NIN) return n;
    return -1;
}
__device__ __forceinline__ void transpose_item(const float* W, int ldn, const float* gk, bf16_t* WT, int k0, int n0, int src, LAS float* scr, int lane) {
#pragma unroll 8
    for (int i = 0; i < 32; ++i) {
        const int kk = 2 * i + (lane >> 5);
        float v = 0.f;
        if (src >= 0) { v = W[(size_t)(k0 + kk) * ldn + src]; if (gk) v *= gk[k0 + kk]; }
        scr[kk * 33 + (lane & 31)] = v;
    }
    asm volatile("s_waitcnt lgkmcnt(0)" ::: "memory");
    const int c = lane & 7;
#pragma unroll
    for (int j = 0; j < 4; ++j) {
        const int n = (lane >> 3) + 8 * j; const LAS float* s = scr + (8 * c) * 33 + n;
        u32x4 o; o.x = pk2(s[0 * 33], s[1 * 33]); o.y = pk2(s[2 * 33], s[3 * 33]); o.z = pk2(s[4 * 33], s[5 * 33]); o.w = pk2(s[6 * 33], s[7 * 33]);
        *(u32x4*)(WT + (size_t)(n0 + n) * DM + k0 + 8 * c) = o;
    }
    asm volatile("s_waitcnt lgkmcnt(0)" ::: "memory");
}
__device__ __forceinline__ void ph_prologue(const Params& p, LAS unsigned char* lds) {
    int tid = threadIdx.x; asm volatile("" : "+v"(tid));
    const int lane = tid & 63, wave = tid >> 6;
    LAS float* scr = (LAS float*)(lds + wave * 8704);
    const int gw = blockIdx.x * NW + wave, ngw = gridDim.x * NW;
    constexpr int I_IN = DEPTH * 16 * (YP / 32), I_OUT = DEPTH * 16 * (DM / 32);
    for (int it = gw; it < I_IN + I_OUT; it += ngw) {
        if (it < I_IN) {
            const int l = it / (16 * (YP / 32)), r = it % (16 * (YP / 32)), kb = r / (YP / 32), nb = r % (YP / 32);
            const int src = logical2orig(phys2logical(nb * 32 + (lane & 31)));
            transpose_item(p.w_in + (size_t)l * DM * NIN, NIN, p.norm_g + l * DM, p.wt_in + (size_t)l * YP * DM, kb * 64, nb * 32, src, scr, lane);
        } else {
            const int q = it - I_IN, l = q / (16 * (DM / 32)), r = q % (16 * (DM / 32)), kb = r / (DM / 32), nb = r % (DM / 32);
            transpose_item(p.w_out + (size_t)l * DM * DM, DM, nullptr, p.wt_out + (size_t)l * DM * DM, kb * 64, nb * 32, nb * 32 + (lane & 31), scr, lane);
        }
    }
    for (int i = (blockIdx.x * NT + tid) * 4; i < DEPTH * 4 * 128 * 128; i += gridDim.x * NT * 4) {
        const f32x4 v = *(const f32x4*)(p.gmlp_ws + i);
        *(unsigned long long*)(p.wsb + i) = (unsigned long long)pk2(v.x, v.y) | ((unsigned long long)pk2(v.z, v.w) << 32);
    }
    for (int r = gw; r < NTOK; r += ngw) {
        const f32x4* xr = (const f32x4*)(p.x + (size_t)r * DM) + lane;
        unsigned long long* o8 = (unsigned long long*)(p.xb + (size_t)r * DM) + lane;
        float s = 0.f;
#pragma unroll
        for (int j = 0; j < 4; ++j) {
            const f32x4 v = xr[64 * j];
            s += (v.x * v.x + v.y * v.y) + (v.z * v.z + v.w * v.w);
            o8[64 * j] = (unsigned long long)pk2(v.x, v.y) | ((unsigned long long)pk2(v.z, v.w) << 32);
        }
        s = wave_sum(s);
        if (lane < 16) p.ssq[(size_t)r * 16 + lane] = lane == 0 ? s : 0.f;
    }
}

__device__ __forceinline__ float silu_f(float v) { return v * __builtin_amdgcn_rcpf(1.f + __builtin_amdgcn_exp2f(-1.4426950408889634f * v)); }
struct EpiIn {
    static constexpr bool PERM = true, AFTER_DRAIN = false;
    bf16_t* Y; const float* ssq; const float* gmlp_g; const float* qg; const float* kg; const float* dqg; const float* dkg;
    __device__ __forceinline__ void operator()(const f32x4 (&acc)[2][2][4][2], const Unit& u, int wr, int wc, int fr, int fq) const {
        const int pn = u.pn;
        int op = 0; const float* g0 = nullptr; const float* g1 = nullptr;
        if (pn == 3 || pn == 6 || pn == 10 || pn == 12) op = 1;
        else if (pn == 4) op = 2;
        else if (pn == 5) { op = 3; g0 = gmlp_g + 64 * wc + 8 * fq; g1 = g0 + 32; }
        else if (pn == 7) { op = 4; g0 = qg + 8 * fq; g1 = g0; }
        else if (pn == 8) { op = 4; g0 = kg + 8 * fq; g1 = g0; }
        else if (pn == 11) { op = 5; g0 = dqg + 8 * fq; g1 = g0 + 32; }
        else if (pn == 13 && wc == 0) { op = 5; g0 = dkg + 8 * fq; g1 = g0 + 32; }
        float gn[16];
#pragma unroll
        for (int i = 0; i < 16; ++i) gn[i] = 1.f;
        if (op >= 3) {
            const f32x4 a = *(const f32x4*)g0, b = *(const f32x4*)(g0 + 4), c = *(const f32x4*)g1, d = *(const f32x4*)(g1 + 4);
            gn[0] = a.x; gn[1] = a.y; gn[2] = a.z; gn[3] = a.w; gn[4] = b.x; gn[5] = b.y; gn[6] = b.z; gn[7] = b.w;
            gn[8] = c.x; gn[9] = c.y; gn[10] = c.z; gn[11] = c.w; gn[12] = d.x; gn[13] = d.y; gn[14] = d.z; gn[15] = d.w;
        }
        const int colb = pn * 256 + 64 * wc + 8 * fq;
#pragma unroll
        for (int ai = 0; ai < 2; ++ai)
#pragma unroll
            for (int m = 0; m < 4; ++m) {
                const int row = u.pm * 256 + ai * 128 + wr * 64 + m * 16 + fr;
                const f32x4* sp = (const f32x4*)(ssq + (size_t)row * 16);
                const f32x4 s0 = sp[0], s1 = sp[1], s2 = sp[2], s3 = sp[3];
                const float tot = ((s0.x + s0.y) + (s0.z + s0.w)) + ((s1.x + s1.y) + (s1.z + s1.w)) + ((s2.x + s2.y) + (s2.z + s2.w)) + ((s3.x + s3.y) + (s3.z + s3.w));
                const float rstd = rsqrtf(tot * (1.f / DM) + EPS);
                float v[16];
#pragma unroll
                for (int bj = 0; bj < 2; ++bj)
#pragma unroll
                    for (int n = 0; n < 2; ++n)
#pragma unroll
                        for (int e = 0; e < 4; ++e) v[bj * 8 + n * 4 + e] = acc[ai][bj][m][n][e] * rstd;
                if (op == 1) {
#pragma unroll
                    for (int i = 0; i < 16; ++i) v[i] = silu_f(v[i]);
                } else if (op == 2 || op == 3) {
#pragma unroll
                    for (int i = 0; i < 16; i += 2) { const pg8::f32x2 r = pg8::gelu_pk((pg8::f32x2){v[i], v[i + 1]}); v[i] = r.x; v[i + 1] = r.y; }
                }
                if (op == 3 || op == 5) {
                    float ss = 0.f;
#pragma unroll
                    for (int i = 0; i < 16; ++i) ss += v[i] * v[i];
                    ss += __shfl_xor(ss, 16); ss += __shfl_xor(ss, 32);
                    const float sc = rsqrtf(ss * (1.f / 64) + EPS);
#pragma unroll
                    for (int i = 0; i < 16; ++i) v[i] *= sc * gn[i];
                } else if (op == 4) {
#pragma unroll
                    for (int bj = 0; bj < 2; ++bj) {
                        float ss = 0.f;
#pragma unroll
                        for (int i = 0; i < 8; ++i) ss += v[bj * 8 + i] * v[bj * 8 + i];
                        ss += __shfl_xor(ss, 16); ss += __shfl_xor(ss, 32);
                        const float sc = rsqrtf(ss * (1.f / 32) + EPS);
#pragma unroll
                        for (int i = 0; i < 8; ++i) v[bj * 8 + i] *= sc * gn[bj * 8 + i];
                    }
                }
                bf16_t* rowp = Y + (size_t)row * YP + colb;
#pragma unroll
                for (int bj = 0; bj < 2; ++bj) {
                    u32x4 w; w.x = pg8::cvt_pk_bf16(v[bj * 8 + 0], v[bj * 8 + 1]); w.y = pg8::cvt_pk_bf16(v[bj * 8 + 2], v[bj * 8 + 3]);
                    w.z = pg8::cvt_pk_bf16(v[bj * 8 + 4], v[bj * 8 + 5]); w.w = pg8::cvt_pk_bf16(v[bj * 8 + 6], v[bj * 8 + 7]);
                    *(u32x4*)(rowp + 32 * bj) = w;
                }
            }
    }
};
struct EpiOut {
    static constexpr bool PERM = false, AFTER_DRAIN = false;
    const float* xin; float* xout; bf16_t* xb; float* ssq;
    __device__ __forceinline__ void operator()(const f32x4 (&acc)[2][2][4][2], const Unit& u, int wr, int wc, int fr, int fq) const {
        const int col0 = u.pn * 256 + wc * 32 + 4 * fq;
#pragma unroll
        for (int ai = 0; ai < 2; ++ai)
#pragma unroll
            for (int m = 0; m < 4; ++m) {
                const int row = u.pm * 256 + ai * 128 + wr * 64 + m * 16 + fr;
                float sq = 0.f;
#pragma unroll
                for (int bj = 0; bj < 2; ++bj)
#pragma unroll
                    for (int n = 0; n < 2; ++n) {
                        const size_t off = (size_t)row * DM + col0 + bj * 128 + n * 16;
                        const f32x4 v = *(const f32x4*)(xin + off) + acc[ai][bj][m][n];
                        *(f32x4*)(xout + off) = v;
                        sq += (v.x * v.x + v.y * v.y) + (v.z * v.z + v.w * v.w);
                        *(unsigned long long*)(xb + off) = (unsigned long long)pg8::cvt_pk_bf16(v.x, v.y) | ((unsigned long long)pg8::cvt_pk_bf16(v.z, v.w) << 32);
                    }
                sq += __shfl_xor(sq, 16); sq += __shfl_xor(sq, 32);
                if (fq == 0) ssq[(size_t)row * 16 + u.pn * 4 + wc] = sq;
            }
    }
};

typedef short bf16x8_t __attribute__((ext_vector_type(8)));
typedef short s16x4_t __attribute__((ext_vector_type(4)));
typedef float f32x16 __attribute__((ext_vector_type(16)));
typedef float f32x2_t __attribute__((ext_vector_type(2)));
typedef __bf16 bf16x2_t __attribute__((ext_vector_type(2)));
#define MFMA32(a, b, c) __builtin_amdgcn_mfma_f32_32x32x16_bf16((a), (b), (c), 0, 0, 0)
__device__ __forceinline__ unsigned cvtpk(float lo, float hi) { f32x2_t v = {lo, hi}; bf16x2_t b = __builtin_convertvector(v, bf16x2_t); return __builtin_bit_cast(unsigned, b); }
__device__ __forceinline__ s16x4_t ds_tr16(const LAS unsigned char* p) { return __builtin_bit_cast(s16x4_t, __builtin_amdgcn_ds_read_tr16_b64_v4i16((LAS s16x4_t*)p)); }
__device__ __forceinline__ bf16x8_t pack_step(const f32x16& x, int s) {
    u32x4 p; p.x = cvtpk(x[8 * s], x[8 * s + 1]); p.y = cvtpk(x[8 * s + 2], x[8 * s + 3]); p.z = cvtpk(x[8 * s + 4], x[8 * s + 5]); p.w = cvtpk(x[8 * s + 6], x[8 * s + 7]);
    return __builtin_bit_cast(bf16x8_t, p);
}
constexpr int KV_STRIDE = 144;
constexpr int KV_TILE = 64 * KV_STRIDE;
__device__ __forceinline__ bf16x8_t vt_frag(const LAS unsigned char* vtile, int ks, int db, int lane) {
    const int i16 = lane & 15, q = i16 >> 2, pp = i16 & 3, blk = (lane >> 4) & 1, hh = lane >> 5;
    const LAS unsigned char* a = vtile + (16 * ks + 4 * hh + q) * KV_STRIDE + (32 * db + 16 * blk + 4 * pp) * 2;
    const s16x4_t lo = ds_tr16(a), hi = ds_tr16(a + 8 * KV_STRIDE);
    return __builtin_shufflevector(lo, hi, 0, 1, 2, 3, 4, 5, 6, 7);
}

__device__ __forceinline__ void mixC_unit(const Params& p, int l, int b, int h, int qt, LAS unsigned char* lds, int tid, float lam, float lam_init) {
    const int lane = tid & 63, wave = __builtin_amdgcn_readfirstlane(tid >> 6), r32 = lane & 31, hh = lane >> 5;
    const size_t rowb = (size_t)b * SEQ;
    const int q0 = qt * 256 + wave * 32;
    const int cw = (q0 >> 6);
    const int jmax = 4 * qt + 3;
    const int pos = q0 + r32;
    const bf16_t* yq = p.Y + (rowb + pos) * YP;
    bf16x8_t qf[2][2];
#pragma unroll
    for (int c = 0; c < 2; ++c)
#pragma unroll
        for (int s = 0; s < 2; ++s) qf[c][s] = *(const bf16x8_t*)(yq + YC_Q + h * 64 + c * 32 + 16 * s + 8 * hh);
    const float c1 = 0.17677669529663687f * 1.4426950408889634f;
    const float sl2 = exp2f(-(float)(2 * h + 1)) * 1.4426950408889634f;
    f32x16 o[2][2];
#pragma unroll
    for (int c = 0; c < 2; ++c)
#pragma unroll
        for (int d = 0; d < 2; ++d)
#pragma unroll
            for (int i = 0; i < 16; ++i) o[c][d][i] = 0.f;
    float mrun[2] = {-INFINITY, -INFINITY}, lrun[2] = {0.f, 0.f};
    const int srow = tid >> 3, sch = tid & 7;
    const bf16_t* ksrc = p.Y + (rowb + srow) * YP + YC_K + h * 64 + sch * 8;
    const bf16_t* vsrc = p.Y + (rowb + srow) * YP + YC_V + h * 64 + sch * 8;
    const int sdst = srow * KV_STRIDE + sch * 16;
    LAS unsigned char* kbuf = lds;
    LAS unsigned char* vbuf = lds + 2 * KV_TILE;
    u32x4 kreg = *(const u32x4*)ksrc, vreg = *(const u32x4*)vsrc;
    __syncthreads();
    *(LAS u32x4*)(kbuf + sdst) = kreg; *(LAS u32x4*)(vbuf + sdst) = vreg;
    __syncthreads();
    for (int j = 0; j <= jmax; ++j) {
        const int cur = j & 1;
        if (j < jmax) { kreg = *(const u32x4*)(ksrc + (size_t)(j + 1) * 64 * YP); vreg = *(const u32x4*)(vsrc + (size_t)(j + 1) * 64 * YP); }
        if (j <= cw) {
            const LAS unsigned char* kt = kbuf + cur * KV_TILE;
            const LAS unsigned char* vt = vbuf + cur * KV_TILE;
            const float pl = (float)(pos - 64 * j - 4 * hh);
            const bool diag = (j == cw);
            bf16x8_t pf[2][4];
#pragma unroll
            for (int c = 0; c < 2; ++c) {
                f32x16 sc[2];
#pragma unroll
                for (int kb = 0; kb < 2; ++kb) {
                    f32x16 a;
#pragma unroll
                    for (int i = 0; i < 16; ++i) a[i] = 0.f;
#pragma unroll
                    for (int s = 0; s < 2; ++s) {
                        const bf16x8_t kf = *(const LAS bf16x8_t*)(kt + (32 * kb + r32) * KV_STRIDE + (c * 32 + 16 * s + 8 * hh) * 2);
                        a = MFMA32(kf, qf[c][s], a);
                    }
                    sc[kb] = a;
                }
                if (!diag) {
#pragma unroll
                    for (int kb = 0; kb < 2; ++kb)
#pragma unroll
                        for (int i = 0; i < 16; ++i) {
                            const float kc = (float)(32 * kb + (i & 3) + 8 * (i >> 2));
                            sc[kb][i] = fmaf(sc[kb][i], c1, fmaf(sl2, kc, -sl2 * pl));
                        }
                } else {
#pragma unroll
                    for (int kb = 0; kb < 2; ++kb)
#pragma unroll
                        for (int i = 0; i < 16; ++i) {
                            const float kc = (float)(32 * kb + (i & 3) + 8 * (i >> 2));
                            sc[kb][i] = fmaf(sc[kb][i], c1, -sl2 * fabsf(pl - kc));
                        }
                }
                float mx = sc[0][0];
#pragma unroll
                for (int i = 1; i < 16; ++i) mx = fmaxf(mx, sc[0][i]);
#pragma unroll
                for (int i = 0; i < 16; ++i) mx = fmaxf(mx, sc[1][i]);
                mx = fmaxf(mx, __shfl_xor(mx, 32));
                const float mnew = fmaxf(mrun[c], mx);
                const float alpha = __builtin_amdgcn_exp2f(mrun[c] - mnew);
                mrun[c] = mnew;
                float ls = 0.f;
#pragma unroll
                for (int kb = 0; kb < 2; ++kb)
#pragma unroll
                    for (int i = 0; i < 16; ++i) { const float e = __builtin_amdgcn_exp2f(sc[kb][i] - mnew); sc[kb][i] = e; ls += e; }
                lrun[c] = lrun[c] * alpha + ls;
#pragma unroll
                for (int d = 0; d < 2; ++d)
#pragma unroll
                    for (int i = 0; i < 16; ++i) o[c][d][i] *= alpha;
#pragma unroll
                for (int ks = 0; ks < 4; ++ks) pf[c][ks] = pack_step(sc[ks >> 1], ks & 1);
            }
#pragma unroll
            for (int ks = 0; ks < 4; ++ks)
#pragma unroll
                for (int db = 0; db < 2; ++db) {
                    const bf16x8_t vf = vt_frag(vt, ks, db, lane);
                    o[0][db] = MFMA32(vf, pf[0][ks], o[0][db]);
                    o[1][db] = MFMA32(vf, pf[1][ks], o[1][db]);
                }
        }
        if (j < jmax) {
            *(LAS u32x4*)(kbuf + (cur ^ 1) * KV_TILE + sdst) = kreg; *(LAS u32x4*)(vbuf + (cur ^ 1) * KV_TILE + sdst) = vreg;
        }
        __syncthreads();
    }
    const float l1 = lrun[0] + __shfl_xor(lrun[0], 32), l2 = lrun[1] + __shfl_xor(lrun[1], 32);
    const float i1 = 1.f / l1, i2 = lam / l2;
    float ss = 0.f;
#pragma unroll
    for (int d = 0; d < 2; ++d)
#pragma unroll
        for (int i = 0; i < 16; ++i) { const float v = o[0][d][i] * i1 - o[1][d][i] * i2; o[0][d][i] = v; ss += v * v; }
    ss += __shfl_xor(ss, 32);
    const float rn = rsqrtf(ss * (1.f / 64) + EPS) * (1.f - lam_init);
    const float* sg = p.diff_subg + l * 256 + h * 64;
    bf16_t* mrow = p.mix + (rowb + pos) * DM + 512 + h * 64;
#pragma unroll
    for (int d = 0; d < 2; ++d)
#pragma unroll
        for (int g = 0; g < 4; ++g) {
            const int d0 = 32 * d + 8 * g + 4 * hh;
            const f32x4 gv = *(const f32x4*)(sg + d0);
            const unsigned long long zz = *(const unsigned long long*)(yq + YC_Z + h * 64 + d0);
            const float z0 = __uint_as_float((unsigned)(zz & 0xffffu) << 16), z1 = __uint_as_float((unsigned)((zz >> 16) & 0xffffu) << 16),
                        z2 = __uint_as_float((unsigned)((zz >> 32) & 0xffffu) << 16), z3 = __uint_as_float((unsigned)((zz >> 48) & 0xffffu) << 16);
            const float v0 = o[0][d][4 * g] * rn * gv.x * z0, v1 = o[0][d][4 * g + 1] * rn * gv.y * z1, v2 = o[0][d][4 * g + 2] * rn * gv.z * z2, v3 = o[0][d][4 * g + 3] * rn * gv.w * z3;
            *(unsigned long long*)(mrow + d0) = (unsigned long long)cvtpk(v0, v1) | ((unsigned long long)cvtpk(v2, v3) << 32);
        }
}
__device__ __forceinline__ void ph_mixC(const Params& p, int l, LAS unsigned char* lds) {
    int tid = threadIdx.x; asm volatile("" : "+v"(tid));
    const float lam_init = 0.8f - 0.6f * expf(-0.3f * (float)l);
    const float* lp = p.diff_lam + l * 128;
    float d1 = 0.f, d2 = 0.f;
    for (int i = 0; i < 32; ++i) { d1 += lp[i] * lp[32 + i]; d2 += lp[64 + i] * lp[96 + i]; }
    const float lam = expf(d1) - expf(d2) + lam_init;
    for (int i = blockIdx.x; i < 256; i += gridDim.x) {
#pragma unroll 1
        for (int k = 0; k < 2; ++k) {
            const int id = k == 0 ? i : 511 - i;
            const int qt = id < 256 ? 7 - (id >> 6) : 3 - ((id - 256) >> 6), bh = id & 63;
            mixC_unit(p, l, bh >> 2, bh & 3, qt, lds, tid, lam, lam_init);
        }
    }
}

constexpr int SC_STRIDE = 2052;
constexpr int SC_BYTES = 16 * SC_STRIDE * 4;
constexpr int IK_STRIDE = 80, IK_TILE = 64 * IK_STRIDE;
__device__ __forceinline__ unsigned fkey(float f) { const unsigned u = __float_as_uint(f); return (u & 0x80000000u) ? ~u : (u | 0x80000000u); }
__device__ __forceinline__ float unfkey(unsigned k) { return __uint_as_float((k & 0x80000000u) ? (k & 0x7fffffffu) : ~k); }
__device__ __forceinline__ f32x16 idx_scores(const bf16x8_t ik0, const bf16x8_t ik1, const bf16x8_t (&iqf)[4][2], const float (&w)[4]) {
    f32x16 sc;
#pragma unroll
    for (int i = 0; i < 16; ++i) sc[i] = 0.f;
#pragma unroll
    for (int hd = 0; hd < 4; ++hd) {
        f32x16 a;
#pragma unroll
        for (int i = 0; i < 16; ++i) a[i] = 0.f;
        a = MFMA32(ik0, iqf[hd][0], a);
        a = MFMA32(ik1, iqf[hd][1], a);
#pragma unroll
        for (int i = 0; i < 16; ++i) sc[i] = fmaf(w[hd], fmaxf(a[i], 0.f), sc[i]);
    }
#pragma unroll
    for (int i = 0; i < 16; ++i) sc[i] = sc[i] + 0.f;
    return sc;
}
__device__ __forceinline__ void select_row(const LAS float* srow, int nslot, int lane, float& Tout, int& kcut_out) {
    unsigned key[32];
#pragma unroll
    for (int j = 0; j < 32; ++j) { const float v = srow[j * 64 + lane]; key[j] = j < nslot ? fkey(v) : 0u; }
    unsigned prefix = 0u; bool exact = false;
#pragma unroll 1
    for (int bit = 31; bit >= 0; --bit) {
        const unsigned cand = prefix | (1u << bit);
        int cnt = 0;
#pragma unroll
        for (int g = 0; g < 4; ++g)
            if (nslot > 8 * g) {
#pragma unroll
                for (int jj = 0; jj < 8; ++jj) cnt += __popcll(__ballot(key[8 * g + jj] >= cand));
            }
        if (cnt >= TOPK) prefix = cand;
        if (cnt == TOPK) { exact = true; break; }
    }
    if (exact) {
        unsigned mn = 0xffffffffu;
#pragma unroll
        for (int j = 0; j < 32; ++j) if (key[j] >= prefix) mn = min(mn, key[j]);
#pragma unroll
        for (int o = 32; o > 0; o >>= 1) mn = min(mn, (unsigned)__shfl_xor((int)mn, o));
        Tout = unfkey(mn); kcut_out = 1 << 20;
    } else {
        int cgt = 0;
#pragma unroll
        for (int j = 0; j < 32; ++j) cgt += __popcll(__ballot(key[j] > prefix));
        int need = TOPK - cgt, kcut = -1;
#pragma unroll
        for (int j = 0; j < 32; ++j) {
            const bool eq = key[j] == prefix;
            const unsigned long long m = __ballot(eq);
            const int c = __popcll(m);
            if (kcut < 0) {
                if (need <= c) {
                    const int rank = __popcll(m & ((1ull << lane) - 1ull));
                    const unsigned long long hm = __ballot(eq && rank == need - 1);
                    kcut = j * 64 + (__ffsll((long long)hm) - 1);
                } else need -= c;
            }
        }
        Tout = unfkey(prefix); kcut_out = kcut;
    }
}
__device__ __forceinline__ void mixD_unit(const Params& p, int b, int c, LAS unsigned char* lds, int tid) {
    const int lane = tid & 63, wave = __builtin_amdgcn_readfirstlane(tid >> 6), r32 = lane & 31, hh = lane >> 5;
    const size_t rowb = (size_t)b * SEQ;
    const int q0 = c * 64, ntile = c + 1;
    LAS float* thr = (LAS float*)(lds + SC_BYTES);
    LAS int* kcs = (LAS int*)(lds + SC_BYTES + 256);
    const bool dosel = c >= 4;
    __syncthreads();
    if (dosel) {
        LAS float* scl = (LAS float*)lds;
#pragma unroll 1
        for (int sp = 0; sp < 4; ++sp) {
            const bf16_t* yq = p.Y + (rowb + q0 + 16 * sp + (r32 & 15)) * YP;
            bf16x8_t iqf[4][2];
#pragma unroll
            for (int hd = 0; hd < 4; ++hd)
#pragma unroll
                for (int s = 0; s < 2; ++s) iqf[hd][s] = *(const bf16x8_t*)(yq + YI_Q + hd * 32 + 16 * s + 8 * hh);
            float w[4];
            {
                const unsigned long long ww = *(const unsigned long long*)(yq + YI_W);
#pragma unroll
                for (int hd = 0; hd < 4; ++hd) w[hd] = __uint_as_float((unsigned)((ww >> (16 * hd)) & 0xffffu) << 16) * (0.17677669529663687f * 0.5f);
            }
            for (int kblk = wave; kblk < 2 * ntile; kblk += NW) {
                const bf16_t* yk = p.Y + (rowb + 32 * kblk + r32) * YP + YI_K + 8 * hh;
                const bf16x8_t ik0 = *(const bf16x8_t*)yk, ik1 = *(const bf16x8_t*)(yk + 16);
                const f32x16 sc = idx_scores(ik0, ik1, iqf, w);
                if (r32 < 16) {
#pragma unroll
                    for (int g = 0; g < 4; ++g)
                        *(LAS f32x4*)(scl + r32 * SC_STRIDE + 32 * kblk + 8 * g + 4 * hh) = (f32x4){sc[4 * g], sc[4 * g + 1], sc[4 * g + 2], sc[4 * g + 3]};
                }
            }
            __syncthreads();
#pragma unroll 1
            for (int rr = 0; rr < 2; ++rr) {
                const int row = 2 * wave + rr;
                float T; int kc;
                select_row(scl + row * SC_STRIDE, ntile, lane, T, kc);
                if (lane == 0) { thr[16 * sp + row] = T; kcs[16 * sp + row] = kc; }
            }
            __syncthreads();
        }
    }
    const int qg = wave >> 2, hd = wave & 3;
    const int pos = q0 + 32 * qg + r32;
    const bf16_t* yq = p.Y + (rowb + pos) * YP;
    bf16x8_t qf[4];
#pragma unroll
    for (int s = 0; s < 4; ++s) qf[s] = *(const bf16x8_t*)(yq + YD_Q + hd * 64 + 16 * s + 8 * hh);
    bf16x8_t iqf[4][2];
    float w[4];
    float T = -INFINITY; int kcut = 1 << 20;
    if (dosel) {
#pragma unroll
        for (int h2 = 0; h2 < 4; ++h2)
#pragma unroll
            for (int s = 0; s < 2; ++s) iqf[h2][s] = *(const bf16x8_t*)(yq + YI_Q + h2 * 32 + 16 * s + 8 * hh);
        const unsigned long long ww = *(const unsigned long long*)(yq + YI_W);
#pragma unroll
        for (int h2 = 0; h2 < 4; ++h2) w[h2] = __uint_as_float((unsigned)((ww >> (16 * h2)) & 0xffffu) << 16) * (0.17677669529663687f * 0.5f);
        T = thr[32 * qg + r32]; kcut = kcs[32 * qg + r32];
    } else {
#pragma unroll
        for (int h2 = 0; h2 < 4; ++h2) { w[h2] = 0.f;
#pragma unroll
            for (int s = 0; s < 2; ++s)
#pragma unroll
                for (int e = 0; e < 8; ++e) iqf[h2][s][e] = 0; }
    }
    const float c1 = 0.125f * 1.4426950408889634f;
    const float sl2 = exp2f(-(float)(2 * hd + 2)) * 1.4426950408889634f;
    f32x16 o[2];
#pragma unroll
    for (int d = 0; d < 2; ++d)
#pragma unroll
        for (int i = 0; i < 16; ++i) o[d][i] = 0.f;
    float mrun = -1e30f, lrun = 0.f;
    const int srow = tid >> 3, sch = tid & 7, irow = tid >> 2, ich = tid & 3;
    const bf16_t* ksrc = p.Y + (rowb + srow) * YP + YD_K + sch * 8;
    const bf16_t* vsrc = p.Y + (rowb + srow) * YP + YD_V + sch * 8;
    const bf16_t* isrc = p.Y + (rowb + (irow & 63)) * YP + YI_K + ich * 8;
    const int sdst = srow * KV_STRIDE + sch * 16, idst = (irow & 63) * IK_STRIDE + ich * 16;
    LAS unsigned char* kbuf = lds;
    LAS unsigned char* vbuf = lds + 2 * KV_TILE;
    LAS unsigned char* ibuf = lds + 4 * KV_TILE;
    u32x4 kreg = *(const u32x4*)ksrc, vreg = *(const u32x4*)vsrc, ireg = *(const u32x4*)isrc;
    __syncthreads();
    *(LAS u32x4*)(kbuf + sdst) = kreg; *(LAS u32x4*)(vbuf + sdst) = vreg; if (tid < 256) *(LAS u32x4*)(ibuf + idst) = ireg;
    __syncthreads();
    for (int j = 0; j < ntile; ++j) {
        const int cur = j & 1;
        if (j + 1 < ntile) { kreg = *(const u32x4*)(ksrc + (size_t)(j + 1) * 64 * YP); vreg = *(const u32x4*)(vsrc + (size_t)(j + 1) * 64 * YP); ireg = *(const u32x4*)(isrc + (size_t)(j + 1) * 64 * YP); }
        {
            const LAS unsigned char* kt = kbuf + cur * KV_TILE;
            const LAS unsigned char* vt = vbuf + cur * KV_TILE;
            const LAS unsigned char* it = ibuf + cur * IK_TILE;
            const float pl = (float)(pos - 64 * j - 4 * hh);
            const int kcl = kcut - 64 * j - 4 * hh;
            const bool diag = (j == c);
            unsigned selb[2] = {0xffffu, 0xffffu};
            if (dosel) {
#pragma unroll
                for (int kb = 0; kb < 2; ++kb) {
                    const bf16x8_t ik0 = *(const LAS bf16x8_t*)(it + (32 * kb + r32) * IK_STRIDE + 16 * hh), ik1 = *(const LAS bf16x8_t*)(it + (32 * kb + r32) * IK_STRIDE + 32 + 16 * hh);
                    const f32x16 ss = idx_scores(ik0, ik1, iqf, w);
                    unsigned bits = 0u;
#pragma unroll
                    for (int i = 0; i < 16; ++i) {
                        const int kci = 32 * kb + (i & 3) + 8 * (i >> 2);
                        const bool sel = (ss[i] > T) || (ss[i] == T && kci <= kcl);
                        bits |= sel ? (1u << i) : 0u;
                    }
                    selb[kb] = bits;
                }
                asm volatile("" : "+v"(selb[0]), "+v"(selb[1]));
            }
            f32x16 sc[2];
#pragma unroll
            for (int kb = 0; kb < 2; ++kb) {
                f32x16 a;
#pragma unroll
                for (int i = 0; i < 16; ++i) a[i] = 0.f;
#pragma unroll
                for (int s = 0; s < 4; ++s) {
                    const bf16x8_t kf = *(const LAS bf16x8_t*)(kt + (32 * kb + r32) * KV_STRIDE + (16 * s + 8 * hh) * 2);
                    a = MFMA32(kf, qf[s], a);
                }
                if (!diag) {
#pragma unroll
                    for (int i = 0; i < 16; ++i) { const float kc = (float)(32 * kb + (i & 3) + 8 * (i >> 2)); a[i] = fmaf(a[i], c1, fmaf(sl2, kc, -sl2 * pl)); }
                } else {
#pragma unroll
                    for (int i = 0; i < 16; ++i) { const float kc = (float)(32 * kb + (i & 3) + 8 * (i >> 2)); a[i] = fmaf(a[i], c1, -sl2 * fabsf(pl - kc)); }
                }
#pragma unroll
                for (int i = 0; i < 16; ++i) a[i] = (selb[kb] & (1u << i)) ? a[i] : -INFINITY;
                sc[kb] = a;
            }
            float mx = sc[0][0];
#pragma unroll
            for (int i = 1; i < 16; ++i) mx = fmaxf(mx, sc[0][i]);
#pragma unroll
            for (int i = 0; i < 16; ++i) mx = fmaxf(mx, sc[1][i]);
            mx = fmaxf(mx, __shfl_xor(mx, 32));
            const float mnew = fmaxf(mrun, mx);
            const float alpha = __builtin_amdgcn_exp2f(mrun - mnew);
            mrun = mnew;
            float ls = 0.f;
#pragma unroll
            for (int kb = 0; kb < 2; ++kb)
#pragma unroll
                for (int i = 0; i < 16; ++i) { const float e = __builtin_amdgcn_exp2f(sc[kb][i] - mnew); sc[kb][i] = e; ls += e; }
            lrun = lrun * alpha + ls;
#pragma unroll
            for (int d = 0; d < 2; ++d)
#pragma unroll
                for (int i = 0; i < 16; ++i) o[d][i] *= alpha;
#pragma unroll
            for (int ks = 0; ks < 4; ++ks) {
                const bf16x8_t pf = pack_step(sc[ks >> 1], ks & 1);
#pragma unroll
                for (int db = 0; db < 2; ++db) o[db] = MFMA32(vt_frag(vt, ks, db, lane), pf, o[db]);
            }
        }
        if (j + 1 < ntile) {
            *(LAS u32x4*)(kbuf + (cur ^ 1) * KV_TILE + sdst) = kreg; *(LAS u32x4*)(vbuf + (cur ^ 1) * KV_TILE + sdst) = vreg;
            if (tid < 256) *(LAS u32x4*)(ibuf + (cur ^ 1) * IK_TILE + idst) = ireg;
        }
        __syncthreads();
    }
    const float inv = 1.f / (lrun + __shfl_xor(lrun, 32));
    bf16_t* mrow = p.mix + (rowb + pos) * DM + 768 + hd * 64;
#pragma unroll
    for (int d = 0; d < 2; ++d)
#pragma unroll
        for (int g = 0; g < 4; ++g) {
            const int d0 = 32 * d + 8 * g + 4 * hh;
            const unsigned long long zz = *(const unsigned long long*)(yq + YD_Z + hd * 64 + d0);
            const float z0 = __uint_as_float((unsigned)(zz & 0xffffu) << 16), z1 = __uint_as_float((unsigned)((zz >> 16) & 0xffffu) << 16),
                        z2 = __uint_as_float((unsigned)((zz >> 32) & 0xffffu) << 16), z3 = __uint_as_float((unsigned)((zz >> 48) & 0xffffu) << 16);
            *(unsigned long long*)(mrow + d0) = (unsigned long long)cvtpk(o[d][4 * g] * inv * z0, o[d][4 * g + 1] * inv * z1) | ((unsigned long long)cvtpk(o[d][4 * g + 2] * inv * z2, o[d][4 * g + 3] * inv * z3) << 32);
        }
}
__device__ __forceinline__ void ph_mixD(const Params& p, LAS unsigned char* lds) {
    int tid = threadIdx.x; asm volatile("" : "+v"(tid));
    for (int i = blockIdx.x; i < 256; i += gridDim.x) {
        const int b = i & 15, cc = i >> 4;
#pragma unroll 1
        for (int k = 0; k < 2; ++k) mixD_unit(p, b, k == 0 ? 31 - cc : cc, lds, tid);
    }
}

constexpr int VN_STRIDE = 528;
__device__ __forceinline__ float bflo(unsigned u) { return __uint_as_float(u << 16); }
__device__ __forceinline__ float bfhi(unsigned u) { return __uint_as_float(u & 0xffff0000u); }
__device__ __forceinline__ void mixAB_unit(const Params& p, int l, int b, int n, LAS unsigned char* lds, int tid) {
    const int lane = tid & 63, wave = __builtin_amdgcn_readfirstlane(tid >> 6), r32 = lane & 31, hh = lane >> 5;
    const size_t row0 = (size_t)b * SEQ + 128 * n;
    __syncthreads();
#pragma unroll
    for (int k = 0; k < 8; ++k) {
        const int ch = tid + 512 * k, r = ch >> 5, c16 = ch & 31;
        *(LAS u32x4*)(lds + r * VN_STRIDE + c16 * 16) = *(const u32x4*)(p.Y + (row0 + r) * YP + YB_V + c16 * 8);
    }
    {
        const int cg8 = (tid & 31) * 8, t0 = (tid >> 5) * 8;
        const int pos0 = 128 * n + t0;
        const float* cw = p.conv_w + l * 768 + cg8;
        float w0[8], w1[8], w2[8], cb[8];
#pragma unroll
        for (int e = 0; e < 8; ++e) { w0[e] = cw[e]; w1[e] = cw[256 + e]; w2[e] = cw[512 + e]; cb[e] = p.conv_b[l * 256 + cg8 + e]; }
        float um2[8], um1[8];
#pragma unroll
        for (int e = 0; e < 8; ++e) { um2[e] = 0.f; um1[e] = 0.f; }
#pragma unroll
        for (int back = 2; back >= 1; --back) {
            if (pos0 - back >= 0) {
                const bf16_t* yr = p.Y + (row0 + t0 - back) * YP;
                const u32x4 hc = *(const u32x4*)(yr + YA_H + cg8), cc = *(const u32x4*)(yr + YA_C + cg8);
                float u[8] = {bflo(hc.x) * bflo(cc.x), bfhi(hc.x) * bfhi(cc.x), bflo(hc.y) * bflo(cc.y), bfhi(hc.y) * bfhi(cc.y),
                              bflo(hc.z) * bflo(cc.z), bfhi(hc.z) * bfhi(cc.z), bflo(hc.w) * bflo(cc.w), bfhi(hc.w) * bfhi(cc.w)};
#pragma unroll
                for (int e = 0; e < 8; ++e) { if (back == 2) um2[e] = u[e]; else um1[e] = u[e]; }
            }
        }
#pragma unroll
        for (int tt = 0; tt < 8; ++tt) {
            const bf16_t* yr = p.Y + (row0 + t0 + tt) * YP;
            const u32x4 hc = *(const u32x4*)(yr + YA_H + cg8), cc = *(const u32x4*)(yr + YA_C + cg8), bg = *(const u32x4*)(yr + YA_B + cg8), zg = *(const u32x4*)(yr + YA_Z + cg8);
            const float u[8] = {bflo(hc.x) * bflo(cc.x), bfhi(hc.x) * bfhi(cc.x), bflo(hc.y) * bflo(cc.y), bfhi(hc.y) * bfhi(cc.y),
                                bflo(hc.z) * bflo(cc.z), bfhi(hc.z) * bfhi(cc.z), bflo(hc.w) * bflo(cc.w), bfhi(hc.w) * bfhi(cc.w)};
            const float bgv[8] = {bflo(bg.x), bfhi(bg.x), bflo(bg.y), bfhi(bg.y), bflo(bg.z), bfhi(bg.z), bflo(bg.w), bfhi(bg.w)};
            const float zgv[8] = {bflo(zg.x), bfhi(zg.x), bflo(zg.y), bfhi(zg.y), bflo(zg.z), bfhi(zg.z), bflo(zg.w), bfhi(zg.w)};
            float ov[8];
#pragma unroll
            for (int e = 0; e < 8; ++e) {
                const float conv = w0[e] * um2[e] + w1[e] * um1[e] + w2[e] * u[e];
                ov[e] = bgv[e] * (conv + cb[e]) * zgv[e];
                um2[e] = um1[e]; um1[e] = u[e];
            }
            u32x4 ow; ow.x = cvtpk(ov[0], ov[1]); ow.y = cvtpk(ov[2], ov[3]); ow.z = cvtpk(ov[4], ov[5]); ow.w = cvtpk(ov[6], ov[7]);
            *(u32x4*)(p.mix + (row0 + t0 + tt) * DM + cg8) = ow;
        }
    }
    __syncthreads();
    {
        const int h = wave >> 1, th = wave & 1;
        const int nks = th == 0 ? 4 : 8;
        f32x16 acc[2][2];
#pragma unroll
        for (int a = 0; a < 2; ++a)
#pragma unroll
            for (int d = 0; d < 2; ++d)
#pragma unroll
                for (int i = 0; i < 16; ++i) acc[a][d][i] = 0.f;
        const bf16_t* wb = p.wsb + ((size_t)(l * 4 + h) * 128 + 64 * th + r32) * 128 + 8 * hh;
        const int i16 = lane & 15, q = i16 >> 2, pp = i16 & 3, blk = (lane >> 4) & 1;
        const LAS unsigned char* va = lds + (8 * hh + q) * VN_STRIDE + (h * 64 + 16 * blk + 4 * pp) * 2;
        for (int ks = 0; ks < nks; ++ks) {
            bf16x8_t bfr[2], afr[2];
#pragma unroll
            for (int tb = 0; tb < 2; ++tb) bfr[tb] = *(const bf16x8_t*)(wb + (size_t)(32 * tb) * 128 + 16 * ks);
#pragma unroll
            for (int db = 0; db < 2; ++db) {
                const LAS unsigned char* a = va + (16 * ks) * VN_STRIDE + (32 * db) * 2;
                const s16x4_t lo = ds_tr16(a), hi = ds_tr16(a + 4 * VN_STRIDE);
                afr[db] = __builtin_shufflevector(lo, hi, 0, 1, 2, 3, 4, 5, 6, 7);
            }
#pragma unroll
            for (int tb = 0; tb < 2; ++tb)
#pragma unroll
                for (int db = 0; db < 2; ++db) acc[tb][db] = MFMA32(afr[db], bfr[tb], acc[tb][db]);
        }
#pragma unroll
        for (int tb = 0; tb < 2; ++tb) {
            const int t = 64 * th + 32 * tb + r32;
            const float bias = p.gmlp_b[(l * 4 + h) * 128 + t];
            const bf16_t* yr = p.Y + (row0 + t) * YP;
            bf16_t* mr = p.mix + (row0 + t) * DM + 256 + h * 64;
#pragma unroll
            for (int db = 0; db < 2; ++db)
#pragma unroll
                for (int g = 0; g < 4; ++g) {
                    const int d0 = 32 * db + 8 * g + 4 * hh;
                    const unsigned long long uu = *(const unsigned long long*)(yr + YB_U + h * 64 + d0), zz = *(const unsigned long long*)(yr + YB_Z + h * 64 + d0);
                    const unsigned u01 = (unsigned)uu, u23 = (unsigned)(uu >> 32), z01 = (unsigned)zz, z23 = (unsigned)(zz >> 32);
                    const float v0 = bflo(u01) * (acc[tb][db][4 * g] + bias) * bflo(z01), v1 = bfhi(u01) * (acc[tb][db][4 * g + 1] + bias) * bfhi(z01);
                    const float v2 = bflo(u23) * (acc[tb][db][4 * g + 2] + bias) * bflo(z23), v3 = bfhi(u23) * (acc[tb][db][4 * g + 3] + bias) * bfhi(z23);
                    *(unsigned long long*)(mr + d0) = (unsigned long long)cvtpk(v0, v1) | ((unsigned long long)cvtpk(v2, v3) << 32);
                }
        }
    }
}
__device__ __forceinline__ void ph_mixAB(const Params& p, int l, LAS unsigned char* lds) {
    int tid = threadIdx.x; asm volatile("" : "+v"(tid));
    for (int i = blockIdx.x; i < 256; i += gridDim.x) mixAB_unit(p, l, i >> 4, i & 15, lds, tid);
}

__global__ void __launch_bounds__(NT, 2) k_fwd(Params p) {
    extern __shared__ __attribute__((aligned(16))) unsigned char lds[];
    cg::grid_group grid = cg::this_grid();
    LAS unsigned char* l3 = (LAS unsigned char*)lds;
    float* smem = (float*)lds;
    ph_prologue(p, l3);
    grid.sync();
    for (int l = 0; l < DEPTH; ++l) {
        const float* xin = l == 0 ? p.x : p.out;
        {
            pg8::Gemm g{p.xb, p.wt_in + (size_t)l * YP * DM, NTOK, YP, DM};
            pg8::StaticOrder S; S.init(NTOK, YP, (int)gridDim.x, (int)blockIdx.x);
            EpiIn E{p.Y, p.ssq, p.gmlp_g + l * 256, p.diff_qg + l * 32, p.diff_kg + l * 32, p.dsa_qg + l * 64, p.dsa_kg + l * 64};
            pg8::gemm_phase<EpiIn, pg8::StaticOrder, true, true>(l3, g, S, E);
        }
        grid.sync();
        ph_mixAB(p, l, l3);
        __syncthreads();
        ph_mixC(p, l, l3);
        __syncthreads();
        ph_mixD(p, l3);
        __syncthreads();
        grid.sync();
        {
            pg8::Gemm g{p.mix, p.wt_out + (size_t)l * DM * DM, NTOK, DM, DM};
            pg8::StaticOrder S; S.init(NTOK, DM, (int)gridDim.x, (int)blockIdx.x);
            EpiOut E{xin, p.out, p.xb, p.ssq};
            pg8::gemm_phase<EpiOut, pg8::StaticOrder, true, true>(l3, g, S, E);
        }
        grid.sync();
    }
}

extern "C" void kernel_launch(void* const* d_in, const int* in_sizes, int n_in, void* d_out, int out_size, void* d_ws, size_t ws_size,
                              hipStream_t stream) {
    static int grid_blocks = 0;
    if (!grid_blocks) {
        int dev = 0, cus = 0, per_cu = 0;
        (void)hipGetDevice(&dev);
        (void)hipDeviceGetAttribute(&cus, hipDeviceAttributeMultiprocessorCount, dev);
        (void)hipFuncSetAttribute((const void*)k_fwd, hipFuncAttributeMaxDynamicSharedMemorySize, LDS_BYTES);
        (void)hipOccupancyMaxActiveBlocksPerMultiprocessor(&per_cu, (const void*)k_fwd, NT, LDS_BYTES);
        if (per_cu < 1) { fprintf(stderr, "kernel_launch: occupancy query returned %d\n", per_cu); per_cu = 1; }
        if (per_cu > 1) per_cu = 1;
        grid_blocks = cus * per_cu;
        if (ws_size < WS_END) fprintf(stderr, "kernel_launch: workspace too small (%zu < %zu)\n", ws_size, (size_t)WS_END);
    }
    Params p{};
    p.x = (const float*)d_in[0]; p.norm_g = (const float*)d_in[1]; p.w_in = (const float*)d_in[2]; p.conv_w = (const float*)d_in[3];
    p.conv_b = (const float*)d_in[4]; p.gmlp_g = (const float*)d_in[5]; p.gmlp_ws = (const float*)d_in[6]; p.gmlp_b = (const float*)d_in[7];
    p.diff_qg = (const float*)d_in[8]; p.diff_kg = (const float*)d_in[9]; p.diff_lam = (const float*)d_in[10]; p.diff_subg = (const float*)d_in[11];
    p.dsa_qg = (const float*)d_in[12]; p.dsa_kg = (const float*)d_in[13]; p.w_out = (const float*)d_in[14];
    p.out = (float*)d_out;
    char* ws = (char*)d_ws;
    p.wt_in = (bf16_t*)(ws + WS_WTIN); p.wt_out = (bf16_t*)(ws + WS_WTOUT); p.ssq = (float*)(ws + WS_SSQ);
    p.xb = (bf16_t*)(ws + WS_XB); p.Y = (bf16_t*)(ws + WS_Y); p.mix = (bf16_t*)(ws + WS_MIX); p.wsb = (bf16_t*)(ws + WS_WSB);
    void* args[] = {&p};
    hipError_t e = hipLaunchCooperativeKernel((void*)k_fwd, dim3(grid_blocks), dim3(NT), args, LDS_BYTES, stream);
    if (e != hipSuccess) fprintf(stderr, "cooperative launch failed: %s (grid %d)\n", hipGetErrorString(e), grid_blocks);
}
```

```cpp
#include <hip/hip_runtime.h>
#include <hip/hip_cooperative_groups.h>
#include <math.h>
#include <stdint.h>
#include <stdio.h>
namespace cg = cooperative_groups;
namespace pg8 {
#define PG8_LAS __attribute__((address_space(3)))
typedef unsigned short bf16_t;
typedef short bf16x8 __attribute__((ext_vector_type(8)));
typedef float f32x4 __attribute__((ext_vector_type(4)));
typedef unsigned u32x4 __attribute__((ext_vector_type(4)));
constexpr int BM = 256, BK = 64, HALF = 128, HTB = HALF * BK * 2  , STAGE_BYTES = 8 * HTB, NXCD = 8, WGM = 8;

__host__ __device__ __forceinline__ int lds_byte(int r, int c) { const int st = (r >> 4) * 2 + (c >> 5), rr = r & 15, cc = c & 31, ob = rr * 64 + cc * 2; return st * 1024 + (ob ^ (((ob >> 9) & 1) << 5)); }
__host__ __device__ __forceinline__ void stage_rc(int b, int& R, int& C) { const int st = b / 1024, sb = b % 1024, swz = sb ^ (((sb >> 9) & 1) << 5); R = (st >> 1) * 16 + swz / 64; C = (st & 1) * 32 + (swz % 64) / 2; }
__host__ __device__ __forceinline__ int perm32(int rho) { const int n = rho >> 4, i = rho & 15; return 8 * (i >> 2) + 4 * n + (i & 3); }

struct Unit { int pm, pn; };
struct Gemm { const bf16_t* A; const bf16_t* Bt; int M, N, K; };

struct StaticOrder {
    int nM, nN, nwg, G, c;
    __host__ __device__ void init(int M, int N, int G_, int c_) { nM = M / BM; nN = N / BM; nwg = nM * nN; G = G_; c = c_; }
    __host__ __device__ bool next(int i, Unit& u) const {
        const long L = (long)i * G + c; if (L >= nwg) return false;
        int wgid = (int)L; { const int q = nwg / NXCD, r = nwg % NXCD, xcd = wgid % NXCD, off = wgid / NXCD; wgid = (xcd < r ? xcd * (q + 1) : r * (q + 1) + (xcd - r) * q) + off; }
        const int nig = WGM * nN, gid = wgid / nig, fm = gid * WGM, gsz = (nM - fm) < WGM ? (nM - fm) : WGM;
        u.pm = fm + ((wgid % nig) % gsz); u.pn = (wgid % nig) / gsz; return true;
    }
    __device__ __forceinline__ void a_ready(const Unit&) const {}
    __device__ __forceinline__ void done(const Unit&) const {}
};

__device__ __forceinline__ unsigned cvt_pk_bf16(float lo, float hi) { unsigned r; asm volatile("v_cvt_pk_bf16_f32 %0, %1, %2" : "=v"(r) : "v"(lo), "v"(hi)); return r; }
typedef float f32x2 __attribute__((ext_vector_type(2)));
__device__ __forceinline__ f32x2 gelu_pk(f32x2 v) {
    const f32x2 av = __builtin_elementwise_abs(v), d = av * 0.2316418882f + 1.0f;
    f32x2 t; t.x = __builtin_amdgcn_rcpf(d.x); t.y = __builtin_amdgcn_rcpf(d.y);
    f32x2 q = t * 0.5307027145f + (-0.7265760135f); q = q * t + 0.7107068705f; q = q * t + (-0.142248368f); q = q * t + 0.127414796f; q = q * t;
    const f32x2 s = (v * v) * (-0.72134752044f);
    f32x2 e; e.x = __builtin_amdgcn_exp2f(s.x); e.y = __builtin_amdgcn_exp2f(s.y);
    const f32x2 m = v * (q * e), r = v - m;
    f32x2 o; o.x = v.x < 0.f ? m.x : r.x; o.y = v.y < 0.f ? m.y : r.y; return o;
}
template <class Epi, class Sched, bool ALIGN_EPI = false, bool SP2 = false>
__device__ __forceinline__ void gemm_phase(PG8_LAS unsigned char* lds, const Gemm g, const Sched& S, const Epi& E) {
    int tid_ = threadIdx.x; asm volatile("" : "+v"(tid_));
    const int tid = tid_, wid = __builtin_amdgcn_readfirstlane(tid >> 6), lane = tid & 63, wr = wid >> 2, wc = wid & 3, fr = lane & 15, fq = lane >> 4;
    const int K = g.K, nt = K / BK;
    unsigned voffA[2], voffB[2];
#pragma unroll
    for (int i = 0; i < 2; ++i) { int R, C; stage_rc(tid * 16 + i * 8192, R, C); const int Rb = Epi::PERM ? ((R & ~31) + perm32(R & 31)) : R;
        voffA[i] = (unsigned)(R * K + C) * 2u; voffB[i] = (unsigned)(Rb * K + C) * 2u; }
    const size_t kstep = (size_t)(BK * 2);
    const size_t hstep = (size_t)HALF * K * 2;
    const size_t tstep = 2 * hstep;
    const unsigned ldsw = (unsigned)wid * 1024u;
    const int aoff = lds_byte(wr * 64 + fr, fq * 8), boff = lds_byte(wc * 32 + fr, fq * 8);
#define PG8_SA(b, h) (((b) * 2 + (h)) * HTB)
#define PG8_SB(b, h) ((4 + (b) * 2 + (h)) * HTB)
#define PG8_STAGE(bufoff, gbase, voff) do { _Pragma("unroll") for (int _i = 0; _i < 2; ++_i) \
        __builtin_amdgcn_global_load_lds((const unsigned*)((const char*)(gbase) + (voff)[_i]), (PG8_LAS unsigned*)(lds + (bufoff) + ldsw + _i * 8192), 16, 0, 0); } while (0)
#define PG8_LDA(dst, b, h) do { _Pragma("unroll") for (int m = 0; m < 4; ++m) _Pragma("unroll") for (int k = 0; k < 2; ++k) dst[m][k] = *(const PG8_LAS bf16x8*)(lds + PG8_SA(b, h) + aoff + m * 2048 + k * 1024); } while (0)
#define PG8_LDB(dst, b, h) do { _Pragma("unroll") for (int n = 0; n < 2; ++n) _Pragma("unroll") for (int k = 0; k < 2; ++k) dst[n][k] = *(const PG8_LAS bf16x8*)(lds + PG8_SB(b, h) + boff + n * 2048 + k * 1024); } while (0)
#define PG8_MMA(ai, bj, At, Bt) do { __builtin_amdgcn_s_setprio(1); _Pragma("unroll") for (int m = 0; m < 4; ++m) _Pragma("unroll") for (int n = 0; n < 2; ++n) _Pragma("unroll") for (int k = 0; k < 2; ++k) \
        acc[ai][bj][m][n] = __builtin_amdgcn_mfma_f32_16x16x32_bf16(Bt[n][k], At[m][k], acc[ai][bj][m][n], 0, 0, 0); __builtin_amdgcn_s_setprio(0); } while (0)
#define PG8_WAIT_V(n) asm volatile("s_waitcnt vmcnt(" #n ")" ::: "memory")
#define PG8_WAIT_L(n) asm volatile("s_waitcnt lgkmcnt(" #n ")" ::: "memory")
#define PG8_BAR __builtin_amdgcn_s_barrier()
#define PG8_SCHED __builtin_amdgcn_sched_barrier(0)
    Unit cur, nxt; int ui = 0;
    if (!S.next(0, cur)) return;
    f32x4 acc[2][2][4][2];
#pragma unroll
    for (int a = 0; a < 2; ++a)
#pragma unroll
        for (int b = 0; b < 2; ++b)
#pragma unroll
            for (int m = 0; m < 4; ++m)
#pragma unroll
                for (int n = 0; n < 2; ++n) acc[a][b][m][n] = (f32x4){0.f, 0.f, 0.f, 0.f};
    bf16x8 At[4][2], B0[2][2], B1[2][2];
    const char* cA = (const char*)g.A + (size_t)cur.pm * tstep; const char* cB = (const char*)g.Bt + (size_t)cur.pn * tstep;
    S.a_ready(cur);
    if constexpr (SP2) {
        PG8_STAGE(PG8_SB(0, 0), cB, voffB); PG8_STAGE(PG8_SB(0, 1), cB + hstep, voffB); PG8_STAGE(PG8_SA(0, 0), cA, voffA); PG8_STAGE(PG8_SA(0, 1), cA + hstep, voffA);
        if (wr == 1) PG8_BAR;
        PG8_WAIT_V(2); PG8_BAR;
        PG8_STAGE(PG8_SB(1, 0), cB + kstep, voffB); PG8_STAGE(PG8_SA(1, 0), cA + kstep, voffA); PG8_STAGE(PG8_SB(1, 1), cB + hstep + kstep, voffB);
        PG8_WAIT_V(6); PG8_BAR;
    } else {
        PG8_STAGE(PG8_SB(0, 0), cB, voffB); PG8_STAGE(PG8_SA(0, 0), cA, voffA); PG8_STAGE(PG8_SB(0, 1), cB + hstep, voffB); PG8_STAGE(PG8_SA(0, 1), cA + hstep, voffA);
        if (wr == 1) PG8_BAR;
        PG8_WAIT_V(4); PG8_BAR;
        PG8_STAGE(PG8_SB(1, 0), cB + kstep, voffB); PG8_STAGE(PG8_SA(1, 0), cA + kstep, voffA); PG8_STAGE(PG8_SB(1, 1), cB + hstep + kstep, voffB);
        PG8_WAIT_V(6); PG8_BAR;
    }
    for (;;) {
        const bool has_next = S.next(ui + 1, nxt);
        const char* nA = has_next ? (const char*)g.A + (size_t)nxt.pm * tstep : cA; const char* nB = has_next ? (const char*)g.Bt + (size_t)nxt.pn * tstep : cB;
        for (int t = 0; t < nt; t += 2) {
            const bool last = (t == nt - 2);
            const char* a1 = cA + (size_t)(t + 1) * kstep;
            const char* a2 = last ? nA : cA + (size_t)(t + 2) * kstep; const char* b2 = last ? nB : cB + (size_t)(t + 2) * kstep;
            const char* a3 = a2 + kstep; const char* b3 = b2 + kstep;
            if (last && has_next) S.a_ready(nxt);
            if constexpr (SP2) {
            PG8_LDB(B0, 0, 0); PG8_LDB(B1, 0, 1); PG8_SCHED; PG8_LDA(At, 0, 0); PG8_STAGE(PG8_SA(1, 1), a1 + hstep, voffA);
            PG8_WAIT_V(8); PG8_WAIT_L(0); PG8_BAR; PG8_MMA(0, 0, At, B0); PG8_MMA(0, 1, At, B1); PG8_BAR; PG8_SCHED;
            PG8_LDA(At, 0, 1); PG8_STAGE(PG8_SB(0, 0), b2, voffB); PG8_STAGE(PG8_SB(0, 1), b2 + hstep, voffB); PG8_STAGE(PG8_SA(0, 0), a2, voffA);
            PG8_WAIT_V(8); PG8_WAIT_L(0); PG8_BAR; PG8_MMA(1, 0, At, B0); PG8_MMA(1, 1, At, B1); PG8_BAR; PG8_SCHED;
            PG8_LDB(B0, 1, 0); PG8_LDB(B1, 1, 1); PG8_SCHED; PG8_LDA(At, 1, 0); PG8_STAGE(PG8_SA(0, 1), a2 + hstep, voffA);
            PG8_WAIT_V(8); PG8_WAIT_L(0); PG8_BAR; PG8_MMA(0, 0, At, B0); PG8_MMA(0, 1, At, B1); PG8_BAR; PG8_SCHED;
            PG8_LDA(At, 1, 1); PG8_STAGE(PG8_SB(1, 0), b3, voffB); PG8_STAGE(PG8_SB(1, 1), b3 + hstep, voffB); PG8_STAGE(PG8_SA(1, 0), a3, voffA);
            PG8_WAIT_V(8); PG8_WAIT_L(0); PG8_BAR; PG8_MMA(1, 0, At, B0); PG8_MMA(1, 1, At, B1); PG8_BAR; PG8_SCHED;
            } else {
            PG8_LDB(B0, 0, 0); PG8_SCHED; PG8_LDA(At, 0, 0); PG8_STAGE(PG8_SA(1, 1), a1 + hstep, voffA);
            PG8_WAIT_L(8); PG8_BAR; PG8_WAIT_L(0); PG8_MMA(0, 0, At, B0); PG8_BAR; PG8_SCHED;
            PG8_LDB(B1, 0, 1); PG8_STAGE(PG8_SB(0, 0), b2, voffB);
            PG8_BAR; PG8_WAIT_L(0); PG8_MMA(0, 1, At, B1); PG8_BAR;
            PG8_LDA(At, 0, 1); PG8_STAGE(PG8_SA(0, 0), a2, voffA);
            PG8_BAR; PG8_WAIT_L(0); PG8_MMA(1, 0, At, B0); PG8_BAR; PG8_SCHED;
            PG8_STAGE(PG8_SB(0, 1), b2 + hstep, voffB);
            PG8_WAIT_V(6); PG8_BAR; PG8_MMA(1, 1, At, B1); PG8_BAR;
            PG8_LDB(B0, 1, 0); PG8_SCHED; PG8_LDA(At, 1, 0); PG8_STAGE(PG8_SA(0, 1), a2 + hstep, voffA);
            PG8_WAIT_L(8); PG8_BAR; PG8_WAIT_L(0); PG8_MMA(0, 0, At, B0); PG8_BAR; PG8_SCHED;
            PG8_LDB(B1, 1, 1); PG8_STAGE(PG8_SB(1, 0), b3, voffB);
            PG8_BAR; PG8_WAIT_L(0); PG8_MMA(0, 1, At, B1); PG8_BAR;
            PG8_LDA(At, 1, 1); PG8_STAGE(PG8_SA(1, 0), a3, voffA);
            PG8_BAR; PG8_WAIT_L(0); PG8_MMA(1, 0, At, B0); PG8_BAR; PG8_SCHED;
            PG8_STAGE(PG8_SB(1, 1), b3 + hstep, voffB);
            PG8_WAIT_V(6); PG8_BAR; PG8_MMA(1, 1, At, B1); PG8_BAR;
            }
        }
        if constexpr (ALIGN_EPI) { if (wr == 0) PG8_BAR; }
        if constexpr (!Epi::AFTER_DRAIN) { E(acc, cur, wr, wc, fr, fq); S.done(cur); }
        if (!has_next) break;
#pragma unroll
        for (int a = 0; a < 2; ++a)
#pragma unroll
            for (int b = 0; b < 2; ++b)
#pragma unroll
                for (int m = 0; m < 4; ++m)
#pragma unroll
                    for (int n = 0; n < 2; ++n) acc[a][b][m][n] = (f32x4){0.f, 0.f, 0.f, 0.f};
        cur = nxt; cA = nA; cB = nB; ++ui;
        if constexpr (ALIGN_EPI) { if (wr == 1) PG8_BAR; }
    }
    PG8_WAIT_V(0);
    if constexpr (!ALIGN_EPI) { if (wr == 0) PG8_BAR; }
    PG8_BAR;
    if constexpr (Epi::AFTER_DRAIN) { E.fused(acc, cur, wr, wc, fr, fq, lds, wid, lane); S.done(cur); }
#undef PG8_SA
#undef PG8_SB
#undef PG8_STAGE
#undef PG8_LDA
#undef PG8_LDB
#undef PG8_MMA
#undef PG8_WAIT_V
#undef PG8_WAIT_L
#undef PG8_BAR
#undef PG8_SCHED
}
}

using pg8::bf16_t; using pg8::f32x4; using pg8::u32x4; using pg8::Unit;
#define LAS __attribute__((address_space(3)))

constexpr int DM = 1024, SEQ = 2048, BATCH = 16, DEPTH = 4, NIN = 3620, NTOK = BATCH * SEQ, YP = 3840;
constexpr float EPS = 1e-6f;
constexpr int O_DZ = 3200, O_DK = 3072, O_DV = 3136;
constexpr int YA_H = 0, YA_B = 256, YA_C = 512, YA_Z = 768, YB_U = 1024, YB_V = 1280, YB_Z = 1536, YC_Q = 1792, YC_K = 2048, YC_V = 2304,
              YC_Z = 2560, YD_Q = 2816, YD_Z = 3072, YD_K = 3328, YD_V = 3392, YI_Q = 3456, YI_K = 3584, YI_W = 3616;
constexpr int TOPK = 256;
constexpr int NT = 512, NW = 8;
constexpr int LDS_BYTES = 131072 + 4096;

constexpr size_t MiB = 1u << 20;
constexpr size_t WS_WTIN = 1 * MiB;
constexpr size_t WS_WTOUT = WS_WTIN + (size_t)DEPTH * YP * DM * 2;
constexpr size_t WS_SSQ = WS_WTOUT + (size_t)DEPTH * DM * DM * 2;
constexpr size_t WS_XB = WS_SSQ + (size_t)NTOK * 16 * 4;
constexpr size_t WS_Y = WS_XB + (size_t)NTOK * DM * 2;
constexpr size_t WS_MIX = WS_Y + (size_t)NTOK * YP * 2;
constexpr size_t WS_WSB = WS_MIX + (size_t)NTOK * DM * 2;
constexpr size_t WS_END = WS_WSB + (size_t)DEPTH * 4 * 128 * 128 * 2;

constexpr size_t WS_SMALL = 65536;
constexpr int SM_CONVW = 0, SM_CONVB = 3072, SM_GMLPG = 4096, SM_GMLPB = 5120, SM_QG = 7168, SM_KG = 7296, SM_LAM = 7424, SM_SUBG = 7936, SM_DQG = 8960, SM_DKG = 9216, SM_END = 9472;
struct Params {
    const float* x; const float* norm_g; const float* w_in; const float* i_conv_w; const float* i_conv_b;
    const float* i_gmlp_g; const float* gmlp_ws; const float* i_gmlp_b; const float* i_diff_qg; const float* i_diff_kg;
    const float* i_diff_lam; const float* i_diff_subg; const float* i_dsa_qg; const float* i_dsa_kg; const float* w_out;
    float* out; unsigned char* ws;
    __device__ __forceinline__ unsigned* ctl() const { return (unsigned*)ws; }
    __device__ __forceinline__ const float* sm(int off) const { return (const float*)(ws + WS_SMALL) + off; }
    __device__ __forceinline__ bf16_t* wt_in() const { return (bf16_t*)(ws + WS_WTIN); }
    __device__ __forceinline__ bf16_t* wt_out() const { return (bf16_t*)(ws + WS_WTOUT); }
    __device__ __forceinline__ float* ssq() const { return (float*)(ws + WS_SSQ); }
    __device__ __forceinline__ bf16_t* xb() const { return (bf16_t*)(ws + WS_XB); }
    __device__ __forceinline__ bf16_t* Y() const { return (bf16_t*)(ws + WS_Y); }
    __device__ __forceinline__ bf16_t* mix() const { return (bf16_t*)(ws + WS_MIX); }
    __device__ __forceinline__ bf16_t* wsb() const { return (bf16_t*)(ws + WS_WSB); }
};

__device__ __forceinline__ unsigned f2bf(float f) { unsigned u = __float_as_uint(f); return (u + 0x7fffu + ((u >> 16) & 1u)) >> 16; }
__device__ __forceinline__ unsigned pk2(float lo, float hi) { return f2bf(lo) | (f2bf(hi) << 16); }
__device__ __forceinline__ float bf2f(bf16_t b) { return __uint_as_float((unsigned)b << 16); }

__device__ __forceinline__ float wave_sum(float v) {
#pragma unroll
    for (int o = 32; o > 0; o >>= 1) v += __shfl_xor(v, o);
    return v;
}
__device__ __forceinline__ float wave_max(float v) {
#pragma unroll
    for (int o = 32; o > 0; o >>= 1) v = fmaxf(v, __shfl_xor(v, o));
    return v;
}
__device__ __forceinline__ int wave_sumi(int v) {
#pragma unroll
    for (int o = 32; o > 0; o >>= 1) v += __shfl_xor(v, o);
    return v;
}
__device__ __forceinline__ float block_sum(float v, float* red) {
    v = wave_sum(v);
    __syncthreads();
    if ((threadIdx.x & 63) == 0) red[threadIdx.x >> 6] = v;
    __syncthreads();
    float s = 0.f;
#pragma unroll
    for (int i = 0; i < NW; ++i) s += red[i];
    return s;
}
__device__ __forceinline__ float block_max(float v, float* red) {
    v = wave_max(v);
    __syncthreads();
    if ((threadIdx.x & 63) == 0) red[threadIdx.x >> 6] = v;
    __syncthreads();
    float s = red[0];
#pragma unroll
    for (int i = 1; i < NW; ++i) s = fmaxf(s, red[i]);
    return s;
}
__device__ __forceinline__ int block_sumi(int v, int* red) {
    v = wave_sumi(v);
    __syncthreads();
    if ((threadIdx.x & 63) == 0) red[threadIdx.x >> 6] = v;
    __syncthreads();
    int s = 0;
#pragma unroll
    for (int i = 0; i < NW; ++i) s += red[i];
    return s;
}
__device__ __forceinline__ int block_excl_scan(int v, int* red, int* tot) {
    const int lane = threadIdx.x & 63, w = threadIdx.x >> 6;
    int inc = v;
#pragma unroll
    for (int o = 1; o < 64; o <<= 1) { int n = __shfl_up(inc, o); if (lane >= o) inc += n; }
    __syncthreads();
    if (lane == 63) red[w] = inc;
    __syncthreads();
    int base = 0, t = 0;
#pragma unroll
    for (int i = 0; i < NW; ++i) { if (i < w) base += red[i]; t += red[i]; }
    *tot = t;
    return base + inc - v;
}

__device__ __forceinline__ int phys2logical(int n) { const int p = n & 255; return (n & ~255) + 64 * ((p >> 5) & 3) + 32 * (p >> 7) + (p & 31); }
__device__ __forceinline__ int logical2orig(int n) {
    if (n < 3072) return n;
    if (n < YD_K) return n - YD_Z + O_DZ;
    if (n < YD_V) return n - YD_K + O_DK;
    if (n < YI_Q) return n - YD_V + O_DV;
    if (n < NIN) return n;
    return -1;
}
__device__ __forceinline__ void transpose_item(const float* W, int ldn, const float* gk, bf16_t* WT, int k0, int n0, int src, LAS float* scr, int lane) {
#pragma unroll 8
    for (int i = 0; i < 32; ++i) {
        const int kk = 2 * i + (lane >> 5);
        float v = 0.f;
        if (src >= 0) { v = W[(size_t)(k0 + kk) * ldn + src]; if (gk) v *= gk[k0 + kk]; }
        scr[kk * 33 + (lane & 31)] = v;
    }
    asm volatile("s_waitcnt lgkmcnt(0)" ::: "memory");
    const int c = lane & 7;
#pragma unroll
    for (int j = 0; j < 4; ++j) {
        const int n = (lane >> 3) + 8 * j; const LAS float* s = scr + (8 * c) * 33 + n;
        u32x4 o; o.x = pk2(s[0 * 33], s[1 * 33]); o.y = pk2(s[2 * 33], s[3 * 33]); o.z = pk2(s[4 * 33], s[5 * 33]); o.w = pk2(s[6 * 33], s[7 * 33]);
        *(u32x4*)(WT + (size_t)(n0 + n) * DM + k0 + 8 * c) = o;
    }
    asm volatile("s_waitcnt lgkmcnt(0)" ::: "memory");
}
__device__ __forceinline__ void ph_prologue(const Params& p, LAS unsigned char* lds) {
    int tid = threadIdx.x; asm volatile("" : "+v"(tid));
    const int lane = tid & 63, wave = tid >> 6;
    LAS float* scr = (LAS float*)(lds + wave * 8704);
    const int gw = blockIdx.x * NW + wave, ngw = gridDim.x * NW;
    constexpr int I_IN = DEPTH * 16 * (YP / 32), I_OUT = DEPTH * 16 * (DM / 32);
    for (int it = gw; it < I_IN + I_OUT; it += ngw) {
        if (it < I_IN) {
            const int l = it / (16 * (YP / 32)), r = it % (16 * (YP / 32)), kb = r / (YP / 32), nb = r % (YP / 32);
            const int src = logical2orig(phys2logical(nb * 32 + (lane & 31)));
            transpose_item(p.w_in + (size_t)l * DM * NIN, NIN, p.norm_g + l * DM, p.wt_in() + (size_t)l * YP * DM, kb * 64, nb * 32, src, scr, lane);
        } else {
            const int q = it - I_IN, l = q / (16 * (DM / 32)), r = q % (16 * (DM / 32)), kb = r / (DM / 32), nb = r % (DM / 32);
            transpose_item(p.w_out + (size_t)l * DM * DM, DM, nullptr, p.wt_out() + (size_t)l * DM * DM, kb * 64, nb * 32, nb * 32 + (lane & 31), scr, lane);
        }
    }
    if (blockIdx.x == 0) {
        float* sm = (float*)(p.ws + WS_SMALL);
        for (int i = tid; i < SM_END; i += NT) {
            float v;
            if (i < SM_CONVB) v = p.i_conv_w[i - SM_CONVW]; else if (i < SM_GMLPG) v = p.i_conv_b[i - SM_CONVB]; else if (i < SM_GMLPB) v = p.i_gmlp_g[i - SM_GMLPG];
            else if (i < SM_QG) v = p.i_gmlp_b[i - SM_GMLPB]; else if (i < SM_KG) v = p.i_diff_qg[i - SM_QG]; else if (i < SM_LAM) v = p.i_diff_kg[i - SM_KG];
            else if (i < SM_SUBG) v = p.i_diff_lam[i - SM_LAM]; else if (i < SM_DQG) v = p.i_diff_subg[i - SM_SUBG]; else if (i < SM_DKG) v = p.i_dsa_qg[i - SM_DQG];
            else v = p.i_dsa_kg[i - SM_DKG];
            sm[i] = v;
        }
    }
    for (int i = (blockIdx.x * NT + tid) * 4; i < DEPTH * 4 * 128 * 128; i += gridDim.x * NT * 4) {
        const f32x4 v = *(const f32x4*)(p.gmlp_ws + i);
        *(unsigned long long*)(p.wsb() + i) = (unsigned long long)pk2(v.x, v.y) | ((unsigned long long)pk2(v.z, v.w) << 32);
    }
    for (int r = gw; r < NTOK; r += ngw) {
        const f32x4* xr = (const f32x4*)(p.x + (size_t)r * DM) + lane;
        unsigned long long* o8 = (unsigned long long*)(p.xb() + (size_t)r * DM) + lane;
        float s = 0.f;
#pragma unroll
        for (int j = 0; j < 4; ++j) {
            const f32x4 v = xr[64 * j];
            s += (v.x * v.x + v.y * v.y) + (v.z * v.z + v.w * v.w);
            o8[64 * j] = (unsigned long long)pk2(v.x, v.y) | ((unsigned long long)pk2(v.z, v.w) << 32);
        }
        s = wave_sum(s);
        if (lane < 16) p.ssq()[(size_t)r * 16 + lane] = lane == 0 ? s : 0.f;
    }
}

__device__ __forceinline__ float silu_f(float v) { return v * __builtin_amdgcn_rcpf(1.f + __builtin_amdgcn_exp2f(-1.4426950408889634f * v)); }
struct EpiIn {
    static constexpr bool PERM = true, AFTER_DRAIN = false;
    unsigned char* ws; int l;
    __device__ __forceinline__ void operator()(const f32x4 (&acc)[2][2][4][2], const Unit& u, int wr, int wc, int fr_, int fq_) const {
        int fr = fr_, fq = fq_; asm volatile("" : "+v"(fr), "+v"(fq));
        const int pn = u.pn;
        bf16_t* Y = (bf16_t*)(ws + WS_Y); const float* ssq = (const float*)(ws + WS_SSQ); const float* smb = (const float*)(ws + WS_SMALL);
        const float* gmlp_g = smb + SM_GMLPG + l * 256; const float* qg = smb + SM_QG + l * 32; const float* kg = smb + SM_KG + l * 32;
        const float* dqg = smb + SM_DQG + l * 64; const float* dkg = smb + SM_DKG + l * 64;
        int op = 0; const float* g0 = nullptr; const float* g1 = nullptr;
        if (pn == 3 || pn == 6 || pn == 10 || pn == 12) op = 1;
        else if (pn == 4) op = 2;
        else if (pn == 5) { op = 3; g0 = gmlp_g + 64 * wc + 8 * fq; g1 = g0 + 32; }
        else if (pn == 7) { op = 4; g0 = qg + 8 * fq; g1 = g0; }
        else if (pn == 8) { op = 4; g0 = kg + 8 * fq; g1 = g0; }
        else if (pn == 11) { op = 5; g0 = dqg + 8 * fq; g1 = g0 + 32; }
        else if (pn == 13 && wc == 0) { op = 5; g0 = dkg + 8 * fq; g1 = g0 + 32; }
        float gn[16];
#pragma unroll
        for (int i = 0; i < 16; ++i) gn[i] = 1.f;
        if (op >= 3) {
            const f32x4 a = *(const f32x4*)g0, b = *(const f32x4*)(g0 + 4), c = *(const f32x4*)g1, d = *(const f32x4*)(g1 + 4);
            gn[0] = a.x; gn[1] = a.y; gn[2] = a.z; gn[3] = a.w; gn[4] = b.x; gn[5] = b.y; gn[6] = b.z; gn[7] = b.w;
            gn[8] = c.x; gn[9] = c.y; gn[10] = c.z; gn[11] = c.w; gn[12] = d.x; gn[13] = d.y; gn[14] = d.z; gn[15] = d.w;
        }
        const int colb = pn * 256 + 64 * wc + 8 * fq;
#pragma unroll
        for (int ai = 0; ai < 2; ++ai)
#pragma unroll
            for (int m = 0; m < 4; ++m) {
                const int row = u.pm * 256 + ai * 128 + wr * 64 + m * 16 + fr;
                const f32x4* sp = (const f32x4*)(ssq + (size_t)row * 16);
                const f32x4 s0 = sp[0], s1 = sp[1], s2 = sp[2], s3 = sp[3];
                const float tot = ((s0.x + s0.y) + (s0.z + s0.w)) + ((s1.x + s1.y) + (s1.z + s1.w)) + ((s2.x + s2.y) + (s2.z + s2.w)) + ((s3.x + s3.y) + (s3.z + s3.w));
                const float rstd = rsqrtf(tot * (1.f / DM) + EPS);
                float v[16];
#pragma unroll
                for (int bj = 0; bj < 2; ++bj)
#pragma unroll
                    for (int n = 0; n < 2; ++n)
#pragma unroll
                        for (int e = 0; e < 4; ++e) v[bj * 8 + n * 4 + e] = acc[ai][bj][m][n][e] * rstd;
                if (op == 1) {
#pragma unroll
                    for (int i = 0; i < 16; ++i) v[i] = silu_f(v[i]);
                } else if (op == 2 || op == 3) {
#pragma unroll
                    for (int i = 0; i < 16; i += 2) { const pg8::f32x2 r = pg8::gelu_pk((pg8::f32x2){v[i], v[i + 1]}); v[i] = r.x; v[i + 1] = r.y; }
                }
                if (op == 3 || op == 5) {
                    float ss = 0.f;
#pragma unroll
                    for (int i = 0; i < 16; ++i) ss += v[i] * v[i];
                    ss += __shfl_xor(ss, 16); ss += __shfl_xor(ss, 32);
                    const float sc = rsqrtf(ss * (1.f / 64) + EPS);
#pragma unroll
                    for (int i = 0; i < 16; ++i) v[i] *= sc * gn[i];
                } else if (op == 4) {
#pragma unroll
                    for (int bj = 0; bj < 2; ++bj) {
                        float ss = 0.f;
#pragma unroll
                        for (int i = 0; i < 8; ++i) ss += v[bj * 8 + i] * v[bj * 8 + i];
                        ss += __shfl_xor(ss, 16); ss += __shfl_xor(ss, 32);
                        const float sc = rsqrtf(ss * (1.f / 32) + EPS);
#pragma unroll
                        for (int i = 0; i < 8; ++i) v[bj * 8 + i] *= sc * gn[bj * 8 + i];
                    }
                }
                bf16_t* rowp = Y + (size_t)row * YP + colb;
#pragma unroll
                for (int bj = 0; bj < 2; ++bj) {
                    u32x4 w; w.x = pg8::cvt_pk_bf16(v[bj * 8 + 0], v[bj * 8 + 1]); w.y = pg8::cvt_pk_bf16(v[bj * 8 + 2], v[bj * 8 + 3]);
                    w.z = pg8::cvt_pk_bf16(v[bj * 8 + 4], v[bj * 8 + 5]); w.w = pg8::cvt_pk_bf16(v[bj * 8 + 6], v[bj * 8 + 7]);
                    *(u32x4*)(rowp + 32 * bj) = w;
                }
                asm volatile("" ::: "memory");
            }
    }
};
struct EpiOut {
    static constexpr bool PERM = false, AFTER_DRAIN = false;
    const float* xin; float* xout; unsigned char* ws;
    __device__ __forceinline__ void operator()(const f32x4 (&acc)[2][2][4][2], const Unit& u, int wr, int wc, int fr_, int fq_) const {
        int fr = fr_, fq = fq_; asm volatile("" : "+v"(fr), "+v"(fq));
        const int col0 = u.pn * 256 + wc * 32 + 4 * fq;
        bf16_t* xb = (bf16_t*)(ws + WS_XB); float* ssq = (float*)(ws + WS_SSQ);
#pragma unroll
        for (int ai = 0; ai < 2; ++ai)
#pragma unroll
            for (int m = 0; m < 4; ++m) {
                const int row = u.pm * 256 + ai * 128 + wr * 64 + m * 16 + fr;
                float sq = 0.f;
#pragma unroll
                for (int bj = 0; bj < 2; ++bj)
#pragma unroll
                    for (int n = 0; n < 2; ++n) {
                        const size_t off = (size_t)row * DM + col0 + bj * 128 + n * 16;
                        const f32x4 v = *(const f32x4*)(xin + off) + acc[ai][bj][m][n];
                        *(f32x4*)(xout + off) = v;
                        sq += (v.x * v.x + v.y * v.y) + (v.z * v.z + v.w * v.w);
                        *(unsigned long long*)(xb + off) = (unsigned long long)pg8::cvt_pk_bf16(v.x, v.y) | ((unsigned long long)pg8::cvt_pk_bf16(v.z, v.w) << 32);
                    }
                sq += __shfl_xor(sq, 16); sq += __shfl_xor(sq, 32);
                if (fq == 0) ssq[(size_t)row * 16 + u.pn * 4 + wc] = sq;
            }
    }
};
#define XB_TMO      128
#define XB_XCNT(j)  (256  + 64 * (j))
#define XB_XSUB(j)  (1280 + 64 * (j))
#define XB_XGEN(j)  (2304 + 64 * (j))
#define XB_TOP      3328
#define XB_TOPGEN   3392
#define XCD_BAR_WORDS 3456
#define XB_SPIN_CAP (1u << 18)

__device__ __forceinline__ unsigned xb_ld(unsigned* p)              { return __hip_atomic_load(p, __ATOMIC_RELAXED, __HIP_MEMORY_SCOPE_AGENT); }
__device__ __forceinline__ unsigned xb_add(unsigned* p, unsigned v) { return __hip_atomic_fetch_add(p, v, __ATOMIC_RELAXED, __HIP_MEMORY_SCOPE_AGENT); }
__device__ __forceinline__ unsigned xb_xcc_id() { return (unsigned)__builtin_amdgcn_s_getreg((3 << 11) | 20) & 0xFu; }
#define XB_SPIN(cond, bar) do { unsigned _sp = 0; while (cond) { __builtin_amdgcn_s_sleep(1); \
    if ((++_sp & 255u) == 0u) { if (xb_ld(&(bar)[XB_TMO])) break; if (_sp > XB_SPIN_CAP) { atomicAdd(&(bar)[XB_TMO], 1u); break; } } } } while (0)

struct XcdBarrier {
    unsigned* bar; unsigned x;
    volatile LAS unsigned* st;
};

__device__ __forceinline__ XcdBarrier xcd_barrier_post(unsigned* bar, volatile LAS unsigned* st) {
    XcdBarrier b; b.bar = bar; b.x = xb_xcc_id(); b.st = st;
    if (threadIdx.x == 0) (void)xb_add(&bar[XB_XCNT(b.x)], 1u);
    return b;
}
__device__ __forceinline__ void xcd_barrier_complete(unsigned* bar, unsigned x, unsigned& nloc, unsigned& nx) {
    const unsigned G = gridDim.x * gridDim.y * gridDim.z;
    unsigned sum, cnt, mine, sp = 0u;
    for (;;) {
        sum = 0u; cnt = 0u; mine = 0u;
#pragma unroll
        for (unsigned j = 0; j < 16; ++j) { const unsigned c = xb_ld(&bar[XB_XCNT(j)]); sum += c; cnt += (c > 0u) ? 1u : 0u; mine = (j == x) ? c : mine; }
        if (sum == G) break;
        __builtin_amdgcn_s_sleep(1);
        if ((++sp & 255u) == 0u) { if (xb_ld(&bar[XB_TMO])) break; if (sp > XB_SPIN_CAP) { atomicAdd(&bar[XB_TMO], 1u); break; } }
    }
    nloc = mine > 0u ? mine : 1u; nx = cnt > 0u ? cnt : 1u;
}

__device__ __forceinline__ void xcd_barrier(const XcdBarrier& b) {
    asm volatile("s_waitcnt vmcnt(0)" ::: "memory");
    __syncthreads();
    int t0_ = threadIdx.x; asm volatile("" : "+v"(t0_));
    if (t0_ == 0) {
        unsigned* bar = b.bar;
        __builtin_amdgcn_s_waitcnt(0);
        unsigned nloc = b.st[0], nx = b.st[1];
        if (nloc == 0u) { xcd_barrier_complete(bar, b.x, nloc, nx); b.st[0] = nloc; b.st[1] = nx; }
        const unsigned old = xb_add(&bar[XB_XSUB(b.x)], 1u);
        const unsigned gen = old / nloc;
        if (old + 1u == (gen + 1u) * nloc) {
            __builtin_amdgcn_fence(__ATOMIC_RELEASE, "agent");
            asm volatile("s_waitcnt vmcnt(0)" ::: "memory");
            const unsigned og = xb_add(&bar[XB_TOP], 1u);
            const unsigned tg = og / nx;
            if (og + 1u == (tg + 1u) * nx) xb_add(&bar[XB_TOPGEN], 1u);
            else XB_SPIN(xb_ld(&bar[XB_TOPGEN]) == tg, bar);
            __builtin_amdgcn_fence(__ATOMIC_ACQUIRE, "agent");
            xb_add(&bar[XB_XGEN(b.x)], 1u);
            asm volatile("s_waitcnt vmcnt(0)" ::: "memory");
        } else {
            XB_SPIN(xb_ld(&bar[XB_XGEN(b.x)]) == gen, bar);
            __builtin_amdgcn_fence(__ATOMIC_ACQUIRE, "agent");
            asm volatile("s_waitcnt vmcnt(0)" ::: "memory");
        }
    }
    __syncthreads();
}

typedef short bf16x8_t __attribute__((ext_vector_type(8)));
typedef short s16x4_t __attribute__((ext_vector_type(4)));
typedef float f32x16 __attribute__((ext_vector_type(16)));
typedef float f32x2_t __attribute__((ext_vector_type(2)));
typedef __bf16 bf16x2_t __attribute__((ext_vector_type(2)));
#define MFMA32(a, b, c) __builtin_amdgcn_mfma_f32_32x32x16_bf16((a), (b), (c), 0, 0, 0)
__device__ __forceinline__ unsigned cvtpk(float lo, float hi) { f32x2_t v = {lo, hi}; bf16x2_t b = __builtin_convertvector(v, bf16x2_t); return __builtin_bit_cast(unsigned, b); }
__device__ __forceinline__ s16x4_t ds_tr16(const LAS unsigned char* p) { return __builtin_bit_cast(s16x4_t, __builtin_amdgcn_ds_read_tr16_b64_v4i16((LAS s16x4_t*)p)); }
__device__ __forceinline__ bf16x8_t pack_step(const f32x16& x, int s) {
    u32x4 p; p.x = cvtpk(x[8 * s], x[8 * s + 1]); p.y = cvtpk(x[8 * s + 2], x[8 * s + 3]); p.z = cvtpk(x[8 * s + 4], x[8 * s + 5]); p.w = cvtpk(x[8 * s + 6], x[8 * s + 7]);
    return __builtin_bit_cast(bf16x8_t, p);
}
constexpr int KV_STRIDE = 144;
constexpr int KV_TILE = 64 * KV_STRIDE;
__device__ __forceinline__ bf16x8_t vt_frag(const LAS unsigned char* vtile, int ks, int db, int lane) {
    const int i16 = lane & 15, q = i16 >> 2, pp = i16 & 3, blk = (lane >> 4) & 1, hh = lane >> 5;
    const LAS unsigned char* a = vtile + (16 * ks + 4 * hh + q) * KV_STRIDE + (32 * db + 16 * blk + 4 * pp) * 2;
    const s16x4_t lo = ds_tr16(a), hi = ds_tr16(a + 8 * KV_STRIDE);
    return __builtin_shufflevector(lo, hi, 0, 1, 2, 3, 4, 5, 6, 7);
}

__device__ __forceinline__ void mixC_unit(const Params& p, int l, int b, int h, int qt, LAS unsigned char* lds, int tid, float lam, float lam_init) {
    const int lane = tid & 63, wave = __builtin_amdgcn_readfirstlane(tid >> 6), r32 = lane & 31, hh = lane >> 5;
    const size_t rowb = (size_t)b * SEQ;
    const int q0 = qt * 256 + wave * 32;
    const int cw = (q0 >> 6);
    const int jmax = 4 * qt + 3;
    const int pos = q0 + r32;
    const bf16_t* yq = p.Y() + (rowb + pos) * YP;
    bf16x8_t qf[2][2];
#pragma unroll
    for (int c = 0; c < 2; ++c)
#pragma unroll
        for (int s = 0; s < 2; ++s) qf[c][s] = *(const bf16x8_t*)(yq + YC_Q + h * 64 + c * 32 + 16 * s + 8 * hh);
    const float c1 = 0.17677669529663687f * 1.4426950408889634f;
    const float sl2 = exp2f(-(float)(2 * h + 1)) * 1.4426950408889634f;
    f32x16 o[2][2];
#pragma unroll
    for (int c = 0; c < 2; ++c)
#pragma unroll
        for (int d = 0; d < 2; ++d)
#pragma unroll
            for (int i = 0; i < 16; ++i) o[c][d][i] = 0.f;
    float mrun[2] = {-INFINITY, -INFINITY}, lrun[2] = {0.f, 0.f};
    const int srow = tid >> 3, sch = tid & 7;
    const bf16_t* ksrc = p.Y() + (rowb + srow) * YP + YC_K + h * 64 + sch * 8;
    const bf16_t* vsrc = p.Y() + (rowb + srow) * YP + YC_V + h * 64 + sch * 8;
    const int sdst = srow * KV_STRIDE + sch * 16;
    LAS unsigned char* kbuf = lds;
    LAS unsigned char* vbuf = lds + 2 * KV_TILE;
    u32x4 kreg = *(const u32x4*)ksrc, vreg = *(const u32x4*)vsrc;
    __syncthreads();
    *(LAS u32x4*)(kbuf + sdst) = kreg; *(LAS u32x4*)(vbuf + sdst) = vreg;
    __syncthreads();
    for (int j = 0; j <= jmax; ++j) {
        const int cur = j & 1;
        if (j < jmax) { kreg = *(const u32x4*)(ksrc + (size_t)(j + 1) * 64 * YP); vreg = *(const u32x4*)(vsrc + (size_t)(j + 1) * 64 * YP); }
        if (j <= cw) {
            const LAS unsigned char* kt = kbuf + cur * KV_TILE;
            const LAS unsigned char* vt = vbuf + cur * KV_TILE;
            const float pl = (float)(pos - 64 * j - 4 * hh);
            const bool diag = (j == cw);
            bf16x8_t pf[2][4];
#pragma unroll
            for (int c = 0; c < 2; ++c) {
                f32x16 sc[2];
#pragma unroll
                for (int kb = 0; kb < 2; ++kb) {
                    f32x16 a;
#pragma unroll
                    for (int i = 0; i < 16; ++i) a[i] = 0.f;
#pragma unroll
                    for (int s = 0; s < 2; ++s) {
                        const bf16x8_t kf = *(const LAS bf16x8_t*)(kt + (32 * kb + r32) * KV_STRIDE + (c * 32 + 16 * s + 8 * hh) * 2);
                        a = MFMA32(kf, qf[c][s], a);
                    }
                    sc[kb] = a;
                }
                if (!diag) {
#pragma unroll
                    for (int kb = 0; kb < 2; ++kb)
#pragma unroll
                        for (int i = 0; i < 16; ++i) {
                            const float kc = (float)(32 * kb + (i & 3) + 8 * (i >> 2));
                            sc[kb][i] = fmaf(sc[kb][i], c1, fmaf(sl2, kc, -sl2 * pl));
                        }
                } else {
#pragma unroll
                    for (int kb = 0; kb < 2; ++kb)
#pragma unroll
                        for (int i = 0; i < 16; ++i) {
                            const float kc = (float)(32 * kb + (i & 3) + 8 * (i >> 2));
                            sc[kb][i] = fmaf(sc[kb][i], c1, -sl2 * fabsf(pl - kc));
                        }
                }
                float mx = sc[0][0];
#pragma unroll
                for (int i = 1; i < 16; ++i) mx = fmaxf(mx, sc[0][i]);
#pragma unroll
                for (int i = 0; i < 16; ++i) mx = fmaxf(mx, sc[1][i]);
                mx = fmaxf(mx, __shfl_xor(mx, 32));
                const float mnew = fmaxf(mrun[c], mx);
                const float alpha = __builtin_amdgcn_exp2f(mrun[c] - mnew);
                mrun[c] = mnew;
                float ls = 0.f;
#pragma unroll
                for (int kb = 0; kb < 2; ++kb)
#pragma unroll
                    for (int i = 0; i < 16; ++i) { const float e = __builtin_amdgcn_exp2f(sc[kb][i] - mnew); sc[kb][i] = e; ls += e; }
                lrun[c] = lrun[c] * alpha + ls;
#pragma unroll
                for (int d = 0; d < 2; ++d)
#pragma unroll
                    for (int i = 0; i < 16; ++i) o[c][d][i] *= alpha;
#pragma unroll
                for (int ks = 0; ks < 4; ++ks) pf[c][ks] = pack_step(sc[ks >> 1], ks & 1);
            }
#pragma unroll
            for (int ks = 0; ks < 4; ++ks)
#pragma unroll
                for (int db = 0; db < 2; ++db) {
                    const bf16x8_t vf = vt_frag(vt, ks, db, lane);
                    o[0][db] = MFMA32(vf, pf[0][ks], o[0][db]);
                    o[1][db] = MFMA32(vf, pf[1][ks], o[1][db]);
                }
        }
        if (j < jmax) {
            *(LAS u32x4*)(kbuf + (cur ^ 1) * KV_TILE + sdst) = kreg; *(LAS u32x4*)(vbuf + (cur ^ 1) * KV_TILE + sdst) = vreg;
        }
        __syncthreads();
    }
    const float l1 = lrun[0] + __shfl_xor(lrun[0], 32), l2 = lrun[1] + __shfl_xor(lrun[1], 32);
    const float i1 = 1.f / l1, i2 = lam / l2;
    float ss = 0.f;
#pragma unroll
    for (int d = 0; d < 2; ++d)
#pragma unroll
        for (int i = 0; i < 16; ++i) { const float v = o[0][d][i] * i1 - o[1][d][i] * i2; o[0][d][i] = v; ss += v * v; }
    ss += __shfl_xor(ss, 32);
    const float rn = rsqrtf(ss * (1.f / 64) + EPS) * (1.f - lam_init);
    const float* sg = p.sm(SM_SUBG) + l * 256 + h * 64;
    bf16_t* mrow = p.mix() + (rowb + pos) * DM + 512 + h * 64;
#pragma unroll
    for (int d = 0; d < 2; ++d)
#pragma unroll
        for (int g = 0; g < 4; ++g) {
            const int d0 = 32 * d + 8 * g + 4 * hh;
            const f32x4 gv = *(const f32x4*)(sg + d0);
            const unsigned long long zz = *(const unsigned long long*)(yq + YC_Z + h * 64 + d0);
            const float z0 = __uint_as_float((unsigned)(zz & 0xffffu) << 16), z1 = __uint_as_float((unsigned)((zz >> 16) & 0xffffu) << 16),
                        z2 = __uint_as_float((unsigned)((zz >> 32) & 0xffffu) << 16), z3 = __uint_as_float((unsigned)((zz >> 48) & 0xffffu) << 16);
            const float v0 = o[0][d][4 * g] * rn * gv.x * z0, v1 = o[0][d][4 * g + 1] * rn * gv.y * z1, v2 = o[0][d][4 * g + 2] * rn * gv.z * z2, v3 = o[0][d][4 * g + 3] * rn * gv.w * z3;
            *(unsigned long long*)(mrow + d0) = (unsigned long long)cvtpk(v0, v1) | ((unsigned long long)cvtpk(v2, v3) << 32);
        }
}
__device__ __forceinline__ void ph_mixC(const Params& p, int l, LAS unsigned char* lds, int bid, int nb) {
    int tid = threadIdx.x; asm volatile("" : "+v"(tid));
    const float lam_init = 0.8f - 0.6f * expf(-0.3f * (float)l);
    const float* lp = p.sm(SM_LAM) + l * 128;
    float d1 = 0.f, d2 = 0.f;
    for (int i = 0; i < 32; ++i) { d1 += lp[i] * lp[32 + i]; d2 += lp[64 + i] * lp[96 + i]; }
    const float lam = expf(d1) - expf(d2) + lam_init;
    for (int i = bid; i < 256; i += nb) {
#pragma unroll 1
        for (int k = 0; k < 2; ++k) {
            const int id = k == 0 ? i : 511 - i;
            const int qt = id < 256 ? 7 - (id >> 6) : 3 - ((id - 256) >> 6), bh = id & 63;
            mixC_unit(p, l, bh >> 2, bh & 3, qt, lds, tid, lam, lam_init);
        }
    }
}

constexpr int SC_STRIDE = 2052;
constexpr int SC_BYTES = 16 * SC_STRIDE * 4;
constexpr int IK_STRIDE = 80, IK_TILE = 64 * IK_STRIDE;
__device__ __forceinline__ unsigned fkey(float f) { const unsigned u = __float_as_uint(f); return (u & 0x80000000u) ? ~u : (u | 0x80000000u); }
__device__ __forceinline__ float unfkey(unsigned k) { return __uint_as_float((k & 0x80000000u) ? (k & 0x7fffffffu) : ~k); }
__device__ __forceinline__ f32x16 idx_scores(const bf16x8_t ik0, const bf16x8_t ik1, const bf16x8_t (&iqf)[4][2], const float (&w)[4]) {
    f32x16 sc;
#pragma unroll
    for (int i = 0; i < 16; ++i) sc[i] = 0.f;
#pragma unroll
    for (int hd = 0; hd < 4; ++hd) {
        f32x16 a;
#pragma unroll
        for (int i = 0; i < 16; ++i) a[i] = 0.f;
        a = MFMA32(ik0, iqf[hd][0], a);
        a = MFMA32(ik1, iqf[hd][1], a);
#pragma unroll
        for (int i = 0; i < 16; ++i) sc[i] = fmaf(w[hd], fmaxf(a[i], 0.f), sc[i]);
    }
#pragma unroll
    for (int i = 0; i < 16; ++i) sc[i] = sc[i] + 0.f;
    return sc;
}
__device__ __forceinline__ void select_row(const LAS float* srow, int nslot, int lane, float& Tout, int& kcut_out) {
    unsigned key[32];
#pragma unroll
    for (int j = 0; j < 32; ++j) { const float v = srow[j * 64 + lane]; key[j] = j < nslot ? fkey(v) : 0u; }
    unsigned prefix = 0u; bool exact = false;
#pragma unroll 1
    for (int bit = 31; bit >= 0; --bit) {
        const unsigned cand = prefix | (1u << bit);
        int cnt = 0;
#pragma unroll
        for (int g = 0; g < 4; ++g)
            if (nslot > 8 * g) {
#pragma unroll
                for (int jj = 0; jj < 8; ++jj) cnt += __popcll(__ballot(key[8 * g + jj] >= cand));
            }
        if (cnt >= TOPK) prefix = cand;
        if (cnt == TOPK) { exact = true; break; }
    }
    if (exact) {
        unsigned mn = 0xffffffffu;
#pragma unroll
        for (int j = 0; j < 32; ++j) if (key[j] >= prefix) mn = min(mn, key[j]);
#pragma unroll
        for (int o = 32; o > 0; o >>= 1) mn = min(mn, (unsigned)__shfl_xor((int)mn, o));
        Tout = unfkey(mn); kcut_out = 1 << 20;
    } else {
        int cgt = 0;
#pragma unroll
        for (int j = 0; j < 32; ++j) cgt += __popcll(__ballot(key[j] > prefix));
        int need = TOPK - cgt, kcut = -1;
#pragma unroll
        for (int j = 0; j < 32; ++j) {
            const bool eq = key[j] == prefix;
            const unsigned long long m = __ballot(eq);
            const int c = __popcll(m);
            if (kcut < 0) {
                if (need <= c) {
                    const int rank = __popcll(m & ((1ull << lane) - 1ull));
                    const unsigned long long hm = __ballot(eq && rank == need - 1);
                    kcut = j * 64 + (__ffsll((long long)hm) - 1);
                } else need -= c;
            }
        }
        Tout = unfkey(prefix); kcut_out = kcut;
    }
}
__device__ __forceinline__ void mixD_unit(const Params& p, int b, int c, LAS unsigned char* lds, int tid) {
    const int lane = tid & 63, wave = __builtin_amdgcn_readfirstlane(tid >> 6), r32 = lane & 31, hh = lane >> 5;
    const size_t rowb = (size_t)b * SEQ;
    const int q0 = c * 64, ntile = c + 1;
    LAS float* thr = (LAS float*)(lds + SC_BYTES);
    LAS int* kcs = (LAS int*)(lds + SC_BYTES + 256);
    const bool dosel = c >= 4;
    __syncthreads();
    if (dosel) {
        LAS float* scl = (LAS float*)lds;
#pragma unroll 1
        for (int sp = 0; sp < 4; ++sp) {
            const bf16_t* yq = p.Y() + (rowb + q0 + 16 * sp + (r32 & 15)) * YP;
            bf16x8_t iqf[4][2];
#pragma unroll
            for (int hd = 0; hd < 4; ++hd)
#pragma unroll
                for (int s = 0; s < 2; ++s) iqf[hd][s] = *(const bf16x8_t*)(yq + YI_Q + hd * 32 + 16 * s + 8 * hh);
            float w[4];
            {
                const unsigned long long ww = *(const unsigned long long*)(yq + YI_W);
#pragma unroll
                for (int hd = 0; hd < 4; ++hd) w[hd] = __uint_as_float((unsigned)((ww >> (16 * hd)) & 0xffffu) << 16) * (0.17677669529663687f * 0.5f);
            }
            for (int kblk = wave; kblk < 2 * ntile; kblk += NW) {
                const bf16_t* yk = p.Y() + (rowb + 32 * kblk + r32) * YP + YI_K + 8 * hh;
                const bf16x8_t ik0 = *(const bf16x8_t*)yk, ik1 = *(const bf16x8_t*)(yk + 16);
                const f32x16 sc = idx_scores(ik0, ik1, iqf, w);
                if (r32 < 16) {
#pragma unroll
                    for (int g = 0; g < 4; ++g)
                        *(LAS f32x4*)(scl + r32 * SC_STRIDE + 32 * kblk + 8 * g + 4 * hh) = (f32x4){sc[4 * g], sc[4 * g + 1], sc[4 * g + 2], sc[4 * g + 3]};
                }
            }
            __syncthreads();
#pragma unroll 1
            for (int rr = 0; rr < 2; ++rr) {
                const int row = 2 * wave + rr;
                float T; int kc;
                select_row(scl + row * SC_STRIDE, ntile, lane, T, kc);
                if (lane == 0) { thr[16 * sp + row] = T; kcs[16 * sp + row] = kc; }
            }
            __syncthreads();
        }
    }
    const int qg = wave >> 2, hd = wave & 3;
    const int pos = q0 + 32 * qg + r32;
    const bf16_t* yq = p.Y() + (rowb + pos) * YP;
    bf16x8_t qf[4];
#pragma unroll
    for (int s = 0; s < 4; ++s) qf[s] = *(const bf16x8_t*)(yq + YD_Q + hd * 64 + 16 * s + 8 * hh);
    bf16x8_t iqf[4][2];
    float w[4];
    float T = -INFINITY; int kcut = 1 << 20;
    if (dosel) {
#pragma unroll
        for (int h2 = 0; h2 < 4; ++h2)
#pragma unroll
            for (int s = 0; s < 2; ++s) iqf[h2][s] = *(const bf16x8_t*)(yq + YI_Q + h2 * 32 + 16 * s + 8 * hh);
        const unsigned long long ww = *(const unsigned long long*)(yq + YI_W);
#pragma unroll
        for (int h2 = 0; h2 < 4; ++h2) w[h2] = __uint_as_float((unsigned)((ww >> (16 * h2)) & 0xffffu) << 16) * (0.17677669529663687f * 0.5f);
        T = thr[32 * qg + r32]; kcut = kcs[32 * qg + r32];
    } else {
#pragma unroll
        for (int h2 = 0; h2 < 4; ++h2) { w[h2] = 0.f;
#pragma unroll
            for (int s = 0; s < 2; ++s)
#pragma unroll
                for (int e = 0; e < 8; ++e) iqf[h2][s][e] = 0; }
    }
    const float c1 = 0.125f * 1.4426950408889634f;
    const float sl2 = exp2f(-(float)(2 * hd + 2)) * 1.4426950408889634f;
    f32x16 o[2];
#pragma unroll
    for (int d = 0; d < 2; ++d)
#pragma unroll
        for (int i = 0; i < 16; ++i) o[d][i] = 0.f;
    float mrun = -1e30f, lrun = 0.f;
    const int srow = tid >> 3, sch = tid & 7, irow = tid >> 2, ich = tid & 3;
    const bf16_t* ksrc = p.Y() + (rowb + srow) * YP + YD_K + sch * 8;
    const bf16_t* vsrc = p.Y() + (rowb + srow) * YP + YD_V + sch * 8;
    const bf16_t* isrc = p.Y() + (rowb + (irow & 63)) * YP + YI_K + ich * 8;
    const int sdst = srow * KV_STRIDE + sch * 16, idst = (irow & 63) * IK_STRIDE + ich * 16;
    LAS unsigned char* kbuf = lds;
    LAS unsigned char* vbuf = lds + 2 * KV_TILE;
    LAS unsigned char* ibuf = lds + 4 * KV_TILE;
    u32x4 kreg = *(const u32x4*)ksrc, vreg = *(const u32x4*)vsrc, ireg = *(const u32x4*)isrc;
    __syncthreads();
    *(LAS u32x4*)(kbuf + sdst) = kreg; *(LAS u32x4*)(vbuf + sdst) = vreg; if (tid < 256) *(LAS u32x4*)(ibuf + idst) = ireg;
    __syncthreads();
    for (int j = 0; j < ntile; ++j) {
        const int cur = j & 1;
        if (j + 1 < ntile) { kreg = *(const u32x4*)(ksrc + (size_t)(j + 1) * 64 * YP); vreg = *(const u32x4*)(vsrc + (size_t)(j + 1) * 64 * YP); ireg = *(const u32x4*)(isrc + (size_t)(j + 1) * 64 * YP); }
        {
            const LAS unsigned char* kt = kbuf + cur * KV_TILE;
            const LAS unsigned char* vt = vbuf + cur * KV_TILE;
            const LAS unsigned char* it = ibuf + cur * IK_TILE;
            const float pl = (float)(pos - 64 * j - 4 * hh);
            const int kcl = kcut - 64 * j - 4 * hh;
            const bool diag = (j == c);
            unsigned selb[2] = {0xffffu, 0xffffu};
            if (dosel) {
#pragma unroll
                for (int kb = 0; kb < 2; ++kb) {
                    const bf16x8_t ik0 = *(const LAS bf16x8_t*)(it + (32 * kb + r32) * IK_STRIDE + 16 * hh), ik1 = *(const LAS bf16x8_t*)(it + (32 * kb + r32) * IK_STRIDE + 32 + 16 * hh);
                    const f32x16 ss = idx_scores(ik0, ik1, iqf, w);
                    unsigned bits = 0u;
#pragma unroll
                    for (int i = 0; i < 16; ++i) {
                        const int kci = 32 * kb + (i & 3) + 8 * (i >> 2);
                        const bool sel = (ss[i] > T) || (ss[i] == T && kci <= kcl);
                        bits |= sel ? (1u << i) : 0u;
                    }
                    selb[kb] = bits;
                }
                asm volatile("" : "+v"(selb[0]), "+v"(selb[1]));
            }
            f32x16 sc[2];
#pragma unroll
            for (int kb = 0; kb < 2; ++kb) {
                f32x16 a;
#pragma unroll
                for (int i = 0; i < 16; ++i) a[i] = 0.f;
#pragma unroll
                for (int s = 0; s < 4; ++s) {
                    const bf16x8_t kf = *(const LAS bf16x8_t*)(kt + (32 * kb + r32) * KV_STRIDE + (16 * s + 8 * hh) * 2);
                    a = MFMA32(kf, qf[s], a);
                }
                if (!diag) {
#pragma unroll
                    for (int i = 0; i < 16; ++i) { const float kc = (float)(32 * kb + (i & 3) + 8 * (i >> 2)); a[i] = fmaf(a[i], c1, fmaf(sl2, kc, -sl2 * pl)); }
                } else {
#pragma unroll
                    for (int i = 0; i < 16; ++i) { const float kc = (float)(32 * kb + (i & 3) + 8 * (i >> 2)); a[i] = fmaf(a[i], c1, -sl2 * fabsf(pl - kc)); }
                }
#pragma unroll
                for (int i = 0; i < 16; ++i) a[i] = (selb[kb] & (1u << i)) ? a[i] : -INFINITY;
                sc[kb] = a;
            }
            float mx = sc[0][0];
#pragma unroll
            for (int i = 1; i < 16; ++i) mx = fmaxf(mx, sc[0][i]);
#pragma unroll
            for (int i = 0; i < 16; ++i) mx = fmaxf(mx, sc[1][i]);
            mx = fmaxf(mx, __shfl_xor(mx, 32));
            const float mnew = fmaxf(mrun, mx);
            const float alpha = __builtin_amdgcn_exp2f(mrun - mnew);
            mrun = mnew;
            float ls = 0.f;
#pragma unroll
            for (int kb = 0; kb < 2; ++kb)
#pragma unroll
                for (int i = 0; i < 16; ++i) { const float e = __builtin_amdgcn_exp2f(sc[kb][i] - mnew); sc[kb][i] = e; ls += e; }
            lrun = lrun * alpha + ls;
#pragma unroll
            for (int d = 0; d < 2; ++d)
#pragma unroll
                for (int i = 0; i < 16; ++i) o[d][i] *= alpha;
#pragma unroll
            for (int ks = 0; ks < 4; ++ks) {
                const bf16x8_t pf = pack_step(sc[ks >> 1], ks & 1);
#pragma unroll
                for (int db = 0; db < 2; ++db) o[db] = MFMA32(vt_frag(vt, ks, db, lane), pf, o[db]);
            }
        }
        if (j + 1 < ntile) {
            *(LAS u32x4*)(kbuf + (cur ^ 1) * KV_TILE + sdst) = kreg; *(LAS u32x4*)(vbuf + (cur ^ 1) * KV_TILE + sdst) = vreg;
            if (tid < 256) *(LAS u32x4*)(ibuf + (cur ^ 1) * IK_TILE + idst) = ireg;
        }
        __syncthreads();
    }
    const float inv = 1.f / (lrun + __shfl_xor(lrun, 32));
    bf16_t* mrow = p.mix() + (rowb + pos) * DM + 768 + hd * 64;
#pragma unroll
    for (int d = 0; d < 2; ++d)
#pragma unroll
        for (int g = 0; g < 4; ++g) {
            const int d0 = 32 * d + 8 * g + 4 * hh;
            const unsigned long long zz = *(const unsigned long long*)(yq + YD_Z + hd * 64 + d0);
            const float z0 = __uint_as_float((unsigned)(zz & 0xffffu) << 16), z1 = __uint_as_float((unsigned)((zz >> 16) & 0xffffu) << 16),
                        z2 = __uint_as_float((unsigned)((zz >> 32) & 0xffffu) << 16), z3 = __uint_as_float((unsigned)((zz >> 48) & 0xffffu) << 16);
            *(unsigned long long*)(mrow + d0) = (unsigned long long)cvtpk(o[d][4 * g] * inv * z0, o[d][4 * g + 1] * inv * z1) | ((unsigned long long)cvtpk(o[d][4 * g + 2] * inv * z2, o[d][4 * g + 3] * inv * z3) << 32);
        }
}
__device__ __forceinline__ void ph_mixD(const Params& p, LAS unsigned char* lds, int bid, int nb) {
    int tid = threadIdx.x; asm volatile("" : "+v"(tid));
    for (int i = bid; i < 256; i += nb) {
        const int b = i & 15, cc = i >> 4;
#pragma unroll 1
        for (int k = 0; k < 2; ++k) mixD_unit(p, b, k == 0 ? 31 - cc : cc, lds, tid);
    }
}

constexpr int VN_STRIDE = 528;
__device__ __forceinline__ float bflo(unsigned u) { return __uint_as_float(u << 16); }
__device__ __forceinline__ float bfhi(unsigned u) { return __uint_as_float(u & 0xffff0000u); }
__device__ __forceinline__ void mixAB_unit(const Params& p, int l, int b, int n, LAS unsigned char* lds, int tid) {
    const int lane = tid & 63, wave = __builtin_amdgcn_readfirstlane(tid >> 6), r32 = lane & 31, hh = lane >> 5;
    const size_t row0 = (size_t)b * SEQ + 128 * n;
    __syncthreads();
#pragma unroll
    for (int k = 0; k < 8; ++k) {
        const int ch = tid + 512 * k, r = ch >> 5, c16 = ch & 31;
        *(LAS u32x4*)(lds + r * VN_STRIDE + c16 * 16) = *(const u32x4*)(p.Y() + (row0 + r) * YP + YB_V + c16 * 8);
    }
    {
        const int cg8 = (tid & 31) * 8, t0 = (tid >> 5) * 8;
        const int pos0 = 128 * n + t0;
        const float* cw = p.sm(SM_CONVW) + l * 768 + cg8;
        float w0[8], w1[8], w2[8], cb[8];
#pragma unroll
        for (int e = 0; e < 8; ++e) { w0[e] = cw[e]; w1[e] = cw[256 + e]; w2[e] = cw[512 + e]; cb[e] = p.sm(SM_CONVB)[l * 256 + cg8 + e]; }
        float um2[8], um1[8];
#pragma unroll
        for (int e = 0; e < 8; ++e) { um2[e] = 0.f; um1[e] = 0.f; }
#pragma unroll
        for (int back = 2; back >= 1; --back) {
            if (pos0 - back >= 0) {
                const bf16_t* yr = p.Y() + (row0 + t0 - back) * YP;
                const u32x4 hc = *(const u32x4*)(yr + YA_H + cg8), cc = *(const u32x4*)(yr + YA_C + cg8);
                float u[8] = {bflo(hc.x) * bflo(cc.x), bfhi(hc.x) * bfhi(cc.x), bflo(hc.y) * bflo(cc.y), bfhi(hc.y) * bfhi(cc.y),
                              bflo(hc.z) * bflo(cc.z), bfhi(hc.z) * bfhi(cc.z), bflo(hc.w) * bflo(cc.w), bfhi(hc.w) * bfhi(cc.w)};
#pragma unroll
                for (int e = 0; e < 8; ++e) { if (back == 2) um2[e] = u[e]; else um1[e] = u[e]; }
            }
        }
#pragma unroll
        for (int tt = 0; tt < 8; ++tt) {
            const bf16_t* yr = p.Y() + (row0 + t0 + tt) * YP;
            const u32x4 hc = *(const u32x4*)(yr + YA_H + cg8), cc = *(const u32x4*)(yr + YA_C + cg8), bg = *(const u32x4*)(yr + YA_B + cg8), zg = *(const u32x4*)(yr + YA_Z + cg8);
            const float u[8] = {bflo(hc.x) * bflo(cc.x), bfhi(hc.x) * bfhi(cc.x), bflo(hc.y) * bflo(cc.y), bfhi(hc.y) * bfhi(cc.y),
                                bflo(hc.z) * bflo(cc.z), bfhi(hc.z) * bfhi(cc.z), bflo(hc.w) * bflo(cc.w), bfhi(hc.w) * bfhi(cc.w)};
            const float bgv[8] = {bflo(bg.x), bfhi(bg.x), bflo(bg.y), bfhi(bg.y), bflo(bg.z), bfhi(bg.z), bflo(bg.w), bfhi(bg.w)};
            const float zgv[8] = {bflo(zg.x), bfhi(zg.x), bflo(zg.y), bfhi(zg.y), bflo(zg.z), bfhi(zg.z), bflo(zg.w), bfhi(zg.w)};
            float ov[8];
#pragma unroll
            for (int e = 0; e < 8; ++e) {
                const float conv = w0[e] * um2[e] + w1[e] * um1[e] + w2[e] * u[e];
                ov[e] = bgv[e] * (conv + cb[e]) * zgv[e];
                um2[e] = um1[e]; um1[e] = u[e];
            }
            u32x4 ow; ow.x = cvtpk(ov[0], ov[1]); ow.y = cvtpk(ov[2], ov[3]); ow.z = cvtpk(ov[4], ov[5]); ow.w = cvtpk(ov[6], ov[7]);
            *(u32x4*)(p.mix() + (row0 + t0 + tt) * DM + cg8) = ow;
        }
    }
    __syncthreads();
    {
        const int h = wave >> 1, th = wave & 1;
        const int nks = th == 0 ? 4 : 8;
        f32x16 acc[2][2];
#pragma unroll
        for (int a = 0; a < 2; ++a)
#pragma unroll
            for (int d = 0; d < 2; ++d)
#pragma unroll
                for (int i = 0; i < 16; ++i) acc[a][d][i] = 0.f;
        const bf16_t* wb = p.wsb() + ((size_t)(l * 4 + h) * 128 + 64 * th + r32) * 128 + 8 * hh;
        const int i16 = lane & 15, q = i16 >> 2, pp = i16 & 3, blk = (lane >> 4) & 1;
        const LAS unsigned char* va = lds + (8 * hh + q) * VN_STRIDE + (h * 64 + 16 * blk + 4 * pp) * 2;
        for (int ks = 0; ks < nks; ++ks) {
            bf16x8_t bfr[2], afr[2];
#pragma unroll
            for (int tb = 0; tb < 2; ++tb) bfr[tb] = *(const bf16x8_t*)(wb + (size_t)(32 * tb) * 128 + 16 * ks);
#pragma unroll
            for (int db = 0; db < 2; ++db) {
                const LAS unsigned char* a = va + (16 * ks) * VN_STRIDE + (32 * db) * 2;
                const s16x4_t lo = ds_tr16(a), hi = ds_tr16(a + 4 * VN_STRIDE);
                afr[db] = __builtin_shufflevector(lo, hi, 0, 1, 2, 3, 4, 5, 6, 7);
            }
#pragma unroll
            for (int tb = 0; tb < 2; ++tb)
#pragma unroll
                for (int db = 0; db < 2; ++db) acc[tb][db] = MFMA32(afr[db], bfr[tb], acc[tb][db]);
        }
#pragma unroll
        for (int tb = 0; tb < 2; ++tb) {
            const int t = 64 * th + 32 * tb + r32;
            const float bias = p.sm(SM_GMLPB)[(l * 4 + h) * 128 + t];
            const bf16_t* yr = p.Y() + (row0 + t) * YP;
            bf16_t* mr = p.mix() + (row0 + t) * DM + 256 + h * 64;
#pragma unroll
            for (int db = 0; db < 2; ++db)
#pragma unroll
                for (int g = 0; g < 4; ++g) {
                    const int d0 = 32 * db + 8 * g + 4 * hh;
                    const unsigned long long uu = *(const unsigned long long*)(yr + YB_U + h * 64 + d0), zz = *(const unsigned long long*)(yr + YB_Z + h * 64 + d0);
                    const unsigned u01 = (unsigned)uu, u23 = (unsigned)(uu >> 32), z01 = (unsigned)zz, z23 = (unsigned)(zz >> 32);
                    const float v0 = bflo(u01) * (acc[tb][db][4 * g] + bias) * bflo(z01), v1 = bfhi(u01) * (acc[tb][db][4 * g + 1] + bias) * bfhi(z01);
                    const float v2 = bflo(u23) * (acc[tb][db][4 * g + 2] + bias) * bflo(z23), v3 = bfhi(u23) * (acc[tb][db][4 * g + 3] + bias) * bfhi(z23);
                    *(unsigned long long*)(mr + d0) = (unsigned long long)cvtpk(v0, v1) | ((unsigned long long)cvtpk(v2, v3) << 32);
                }
        }
    }
}
__device__ __forceinline__ void ph_mixAB(const Params& p, int l, LAS unsigned char* lds, int bid, int nb) {
    int tid = threadIdx.x; asm volatile("" : "+v"(tid));
    for (int i = bid; i < 256; i += nb) mixAB_unit(p, l, i >> 4, i & 15, lds, tid);
}

__global__ void __launch_bounds__(NT, 2) k_fwd(Params p) {
    extern __shared__ __attribute__((aligned(16))) unsigned char lds[];
    cg::grid_group grid = cg::this_grid();
    LAS unsigned char* l3 = (LAS unsigned char*)lds;
    volatile LAS unsigned* bst = (volatile LAS unsigned*)(l3 + LDS_BYTES - 16);
    if (threadIdx.x < 2) bst[threadIdx.x] = 0u;
    __syncthreads();
    const XcdBarrier bar = xcd_barrier_post(p.ctl(), bst);
    ph_prologue(p, l3);
    grid.sync();
#pragma unroll 1
    for (int l = 0; l < DEPTH; ++l) {
        Params q = p; asm volatile("" : "+s"(q.ws), "+s"(q.out), "+s"(q.x));
        int bid = blockIdx.x, nb = gridDim.x; asm volatile("" : "+s"(bid), "+s"(nb));
        const float* xin = l == 0 ? q.x : q.out;
        {
            pg8::Gemm g{q.xb(), q.wt_in() + (size_t)l * YP * DM, NTOK, YP, DM};
            pg8::StaticOrder S; S.init(NTOK, YP, nb, bid);
            EpiIn E{q.ws, l};
            pg8::gemm_phase<EpiIn, pg8::StaticOrder, true, true>(l3, g, S, E);
        }
        xcd_barrier(bar);
        asm volatile("" : "+s"(q.ws), "+s"(bid), "+s"(nb));
        ph_mixAB(q, l, l3, bid, nb);
        __syncthreads();
        ph_mixC(q, l, l3, bid, nb);
        __syncthreads();
        ph_mixD(q, l3, bid, nb);
        __syncthreads();
        xcd_barrier(bar);
        asm volatile("" : "+s"(q.ws), "+s"(q.out), "+s"(bid), "+s"(nb));
        {
            pg8::Gemm g{q.mix(), q.wt_out() + (size_t)l * DM * DM, NTOK, DM, DM};
            pg8::StaticOrder S; S.init(NTOK, DM, nb, bid);
            EpiOut E{xin, q.out, q.ws};
            pg8::gemm_phase<EpiOut, pg8::StaticOrder, true, true>(l3, g, S, E);
        }
        xcd_barrier(bar);
    }
}

extern "C" void kernel_launch(void* const* d_in, const int* in_sizes, int n_in, void* d_out, int out_size, void* d_ws, size_t ws_size,
                              hipStream_t stream) {
    static int grid_blocks = 0;
    if (!grid_blocks) {
        int dev = 0, cus = 0, per_cu = 0;
        (void)hipGetDevice(&dev);
        (void)hipDeviceGetAttribute(&cus, hipDeviceAttributeMultiprocessorCount, dev);
        (void)hipFuncSetAttribute((const void*)k_fwd, hipFuncAttributeMaxDynamicSharedMemorySize, LDS_BYTES);
        (void)hipOccupancyMaxActiveBlocksPerMultiprocessor(&per_cu, (const void*)k_fwd, NT, LDS_BYTES);
        if (per_cu < 1) { fprintf(stderr, "kernel_launch: occupancy query returned %d\n", per_cu); per_cu = 1; }
        if (per_cu > 1) per_cu = 1;
        grid_blocks = cus * per_cu;
        if (ws_size < WS_END) fprintf(stderr, "kernel_launch: workspace too small (%zu < %zu)\n", ws_size, (size_t)WS_END);
    }
    (void)hipMemsetAsync(d_ws, 0, 16384, stream);
    Params p{};
    p.x = (const float*)d_in[0]; p.norm_g = (const float*)d_in[1]; p.w_in = (const float*)d_in[2]; p.i_conv_w = (const float*)d_in[3];
    p.i_conv_b = (const float*)d_in[4]; p.i_gmlp_g = (const float*)d_in[5]; p.gmlp_ws = (const float*)d_in[6]; p.i_gmlp_b = (const float*)d_in[7];
    p.i_diff_qg = (const float*)d_in[8]; p.i_diff_kg = (const float*)d_in[9]; p.i_diff_lam = (const float*)d_in[10]; p.i_diff_subg = (const float*)d_in[11];
    p.i_dsa_qg = (const float*)d_in[12]; p.i_dsa_kg = (const float*)d_in[13]; p.w_out = (const float*)d_in[14];
    p.out = (float*)d_out; p.ws = (unsigned char*)d_ws;
    void* args[] = {&p};
    hipError_t e = hipLaunchCooperativeKernel((void*)k_fwd, dim3(grid_blocks), dim3(NT), args, LDS_BYTES, stream);
    if (e != hipSuccess) fprintf(stderr, "cooperative launch failed: %s (grid %d)\n", hipGetErrorString(e), grid_blocks);
}
```

```cpp
#include <hip/hip_runtime.h>
#include <hip/hip_cooperative_groups.h>
#include <math.h>
#include <stdint.h>
#include <stdio.h>
namespace cg = cooperative_groups;
namespace pg8 {
#define PG8_LAS __attribute__((address_space(3)))
typedef unsigned short bf16_t;
typedef short bf16x8 __attribute__((ext_vector_type(8)));
typedef float f32x4 __attribute__((ext_vector_type(4)));
typedef unsigned u32x4 __attribute__((ext_vector_type(4)));
constexpr int BM = 256, BK = 64, HALF = 128, HTB = HALF * BK * 2  , STAGE_BYTES = 8 * HTB, NXCD = 8, WGM = 8;

__host__ __device__ __forceinline__ int lds_byte(int r, int c) { const int st = (r >> 4) * 2 + (c >> 5), rr = r & 15, cc = c & 31, ob = rr * 64 + cc * 2; return st * 1024 + (ob ^ (((ob >> 9) & 1) << 5)); }
__host__ __device__ __forceinline__ void stage_rc(int b, int& R, int& C) { const int st = b / 1024, sb = b % 1024, swz = sb ^ (((sb >> 9) & 1) << 5); R = (st >> 1) * 16 + swz / 64; C = (st & 1) * 32 + (swz % 64) / 2; }
__host__ __device__ __forceinline__ int perm32(int rho) { const int n = rho >> 4, i = rho & 15; return 8 * (i >> 2) + 4 * n + (i & 3); }

struct Unit { int pm, pn; };
struct Gemm { const bf16_t* A; const bf16_t* Bt; int M, N, K; };

struct StaticOrder {
    int nM, nN, nwg, G, c;
    __host__ __device__ void init(int M, int N, int G_, int c_) { nM = M / BM; nN = N / BM; nwg = nM * nN; G = G_; c = c_; }
    __host__ __device__ bool next(int i, Unit& u) const {
        const long L = (long)i * G + c; if (L >= nwg) return false;
        int wgid = (int)L; { const int q = nwg / NXCD, r = nwg % NXCD, xcd = wgid % NXCD, off = wgid / NXCD; wgid = (xcd < r ? xcd * (q + 1) : r * (q + 1) + (xcd - r) * q) + off; }
        const int nig = WGM * nN, gid = wgid / nig, fm = gid * WGM, gsz = (nM - fm) < WGM ? (nM - fm) : WGM;
        u.pm = fm + ((wgid % nig) % gsz); u.pn = (wgid % nig) / gsz; return true;
    }
    __device__ __forceinline__ void a_ready(const Unit&) const {}
    __device__ __forceinline__ void done(const Unit&) const {}
};

__device__ __forceinline__ unsigned cvt_pk_bf16(float lo, float hi) { unsigned r; asm volatile("v_cvt_pk_bf16_f32 %0, %1, %2" : "=v"(r) : "v"(lo), "v"(hi)); return r; }
typedef float f32x2 __attribute__((ext_vector_type(2)));
__device__ __forceinline__ f32x2 gelu_pk(f32x2 v) {
    const f32x2 av = __builtin_elementwise_abs(v), d = av * 0.2316418882f + 1.0f;
    f32x2 t; t.x = __builtin_amdgcn_rcpf(d.x); t.y = __builtin_amdgcn_rcpf(d.y);
    f32x2 q = t * 0.5307027145f + (-0.7265760135f); q = q * t + 0.7107068705f; q = q * t + (-0.142248368f); q = q * t + 0.127414796f; q = q * t;
    const f32x2 s = (v * v) * (-0.72134752044f);
    f32x2 e; e.x = __builtin_amdgcn_exp2f(s.x); e.y = __builtin_amdgcn_exp2f(s.y);
    const f32x2 m = v * (q * e), r = v - m;
    f32x2 o; o.x = v.x < 0.f ? m.x : r.x; o.y = v.y < 0.f ? m.y : r.y; return o;
}
template <class Epi, class Sched, bool ALIGN_EPI = false, bool SP2 = false>
__device__ __forceinline__ void gemm_phase(PG8_LAS unsigned char* lds, const Gemm g, const Sched& S, const Epi& E, int tid_in) {
    int tid_ = tid_in; asm volatile("" : "+v"(tid_));
    const int tid = tid_, wid = __builtin_amdgcn_readfirstlane(tid >> 6), lane = tid & 63, wr = wid >> 2, wc = wid & 3, fr = lane & 15, fq = lane >> 4;
    const int K = g.K, nt = K / BK;
    unsigned voffA[2], voffB[2];
#pragma unroll
    for (int i = 0; i < 2; ++i) { int R, C; stage_rc(tid * 16 + i * 8192, R, C); const int Rb = Epi::PERM ? ((R & ~31) + perm32(R & 31)) : R;
        voffA[i] = (unsigned)(R * K + C) * 2u; voffB[i] = (unsigned)(Rb * K + C) * 2u; }
    const size_t kstep = (size_t)(BK * 2);
    const size_t hstep = (size_t)HALF * K * 2;
    const size_t tstep = 2 * hstep;
    const unsigned ldsw = (unsigned)wid * 1024u;
    const int aoff = lds_byte(wr * 64 + fr, fq * 8), boff = lds_byte(wc * 32 + fr, fq * 8);
#define PG8_SA(b, h) (((b) * 2 + (h)) * HTB)
#define PG8_SB(b, h) ((4 + (b) * 2 + (h)) * HTB)
#define PG8_STAGE(bufoff, gbase, voff) do { _Pragma("unroll") for (int _i = 0; _i < 2; ++_i) \
        __builtin_amdgcn_global_load_lds((const unsigned*)((const char*)(gbase) + (voff)[_i]), (PG8_LAS unsigned*)(lds + (bufoff) + ldsw + _i * 8192), 16, 0, 0); } while (0)
#define PG8_LDA(dst, b, h) do { _Pragma("unroll") for (int m = 0; m < 4; ++m) _Pragma("unroll") for (int k = 0; k < 2; ++k) dst[m][k] = *(const PG8_LAS bf16x8*)(lds + PG8_SA(b, h) + aoff + m * 2048 + k * 1024); } while (0)
#define PG8_LDB(dst, b, h) do { _Pragma("unroll") for (int n = 0; n < 2; ++n) _Pragma("unroll") for (int k = 0; k < 2; ++k) dst[n][k] = *(const PG8_LAS bf16x8*)(lds + PG8_SB(b, h) + boff + n * 2048 + k * 1024); } while (0)
#define PG8_MMA(ai, bj, At, Bt) do { __builtin_amdgcn_s_setprio(1); _Pragma("unroll") for (int m = 0; m < 4; ++m) _Pragma("unroll") for (int n = 0; n < 2; ++n) _Pragma("unroll") for (int k = 0; k < 2; ++k) \
        acc[ai][bj][m][n] = __builtin_amdgcn_mfma_f32_16x16x32_bf16(Bt[n][k], At[m][k], acc[ai][bj][m][n], 0, 0, 0); __builtin_amdgcn_s_setprio(0); } while (0)
#define PG8_WAIT_V(n) asm volatile("s_waitcnt vmcnt(" #n ")" ::: "memory")
#define PG8_WAIT_L(n) asm volatile("s_waitcnt lgkmcnt(" #n ")" ::: "memory")
#define PG8_BAR __builtin_amdgcn_s_barrier()
#define PG8_SCHED __builtin_amdgcn_sched_barrier(0)
    Unit cur, nxt; int ui = 0;
    if (!S.next(0, cur)) return;
    f32x4 acc[2][2][4][2];
#pragma unroll
    for (int a = 0; a < 2; ++a)
#pragma unroll
        for (int b = 0; b < 2; ++b)
#pragma unroll
            for (int m = 0; m < 4; ++m)
#pragma unroll
                for (int n = 0; n < 2; ++n) acc[a][b][m][n] = (f32x4){0.f, 0.f, 0.f, 0.f};
    bf16x8 At[4][2], B0[2][2], B1[2][2];
    const char* cA = (const char*)g.A + (size_t)cur.pm * tstep; const char* cB = (const char*)g.Bt + (size_t)cur.pn * tstep;
    S.a_ready(cur);
    if constexpr (SP2) {
        PG8_STAGE(PG8_SB(0, 0), cB, voffB); PG8_STAGE(PG8_SB(0, 1), cB + hstep, voffB); PG8_STAGE(PG8_SA(0, 0), cA, voffA); PG8_STAGE(PG8_SA(0, 1), cA + hstep, voffA);
        if (wr == 1) PG8_BAR;
        PG8_WAIT_V(2); PG8_BAR;
        PG8_STAGE(PG8_SB(1, 0), cB + kstep, voffB); PG8_STAGE(PG8_SA(1, 0), cA + kstep, voffA); PG8_STAGE(PG8_SB(1, 1), cB + hstep + kstep, voffB);
        PG8_WAIT_V(6); PG8_BAR;
    } else {
        PG8_STAGE(PG8_SB(0, 0), cB, voffB); PG8_STAGE(PG8_SA(0, 0), cA, voffA); PG8_STAGE(PG8_SB(0, 1), cB + hstep, voffB); PG8_STAGE(PG8_SA(0, 1), cA + hstep, voffA);
        if (wr == 1) PG8_BAR;
        PG8_WAIT_V(4); PG8_BAR;
        PG8_STAGE(PG8_SB(1, 0), cB + kstep, voffB); PG8_STAGE(PG8_SA(1, 0), cA + kstep, voffA); PG8_STAGE(PG8_SB(1, 1), cB + hstep + kstep, voffB);
        PG8_WAIT_V(6); PG8_BAR;
    }
    for (;;) {
        const bool has_next = S.next(ui + 1, nxt);
        const char* nA = has_next ? (const char*)g.A + (size_t)nxt.pm * tstep : cA; const char* nB = has_next ? (const char*)g.Bt + (size_t)nxt.pn * tstep : cB;
        for (int t = 0; t < nt; t += 2) {
            const bool last = (t == nt - 2);
            const char* a1 = cA + (size_t)(t + 1) * kstep;
            const char* a2 = last ? nA : cA + (size_t)(t + 2) * kstep; const char* b2 = last ? nB : cB + (size_t)(t + 2) * kstep;
            const char* a3 = a2 + kstep; const char* b3 = b2 + kstep;
            if (last && has_next) S.a_ready(nxt);
            if constexpr (SP2) {
            PG8_LDB(B0, 0, 0); PG8_LDB(B1, 0, 1); PG8_SCHED; PG8_LDA(At, 0, 0); PG8_STAGE(PG8_SA(1, 1), a1 + hstep, voffA);
            PG8_WAIT_V(8); PG8_WAIT_L(0); PG8_BAR; PG8_MMA(0, 0, At, B0); PG8_MMA(0, 1, At, B1); PG8_BAR; PG8_SCHED;
            PG8_LDA(At, 0, 1); PG8_STAGE(PG8_SB(0, 0), b2, voffB); PG8_STAGE(PG8_SB(0, 1), b2 + hstep, voffB); PG8_STAGE(PG8_SA(0, 0), a2, voffA);
            PG8_WAIT_V(8); PG8_WAIT_L(0); PG8_BAR; PG8_MMA(1, 0, At, B0); PG8_MMA(1, 1, At, B1); PG8_BAR; PG8_SCHED;
            PG8_LDB(B0, 1, 0); PG8_LDB(B1, 1, 1); PG8_SCHED; PG8_LDA(At, 1, 0); PG8_STAGE(PG8_SA(0, 1), a2 + hstep, voffA);
            PG8_WAIT_V(8); PG8_WAIT_L(0); PG8_BAR; PG8_MMA(0, 0, At, B0); PG8_MMA(0, 1, At, B1); PG8_BAR; PG8_SCHED;
            PG8_LDA(At, 1, 1); PG8_STAGE(PG8_SB(1, 0), b3, voffB); PG8_STAGE(PG8_SB(1, 1), b3 + hstep, voffB); PG8_STAGE(PG8_SA(1, 0), a3, voffA);
            PG8_WAIT_V(8); PG8_WAIT_L(0); PG8_BAR; PG8_MMA(1, 0, At, B0); PG8_MMA(1, 1, At, B1); PG8_BAR; PG8_SCHED;
            } else {
            PG8_LDB(B0, 0, 0); PG8_SCHED; PG8_LDA(At, 0, 0); PG8_STAGE(PG8_SA(1, 1), a1 + hstep, voffA);
            PG8_WAIT_L(8); PG8_BAR; PG8_WAIT_L(0); PG8_MMA(0, 0, At, B0); PG8_BAR; PG8_SCHED;
            PG8_LDB(B1, 0, 1); PG8_STAGE(PG8_SB(0, 0), b2, voffB);
            PG8_BAR; PG8_WAIT_L(0); PG8_MMA(0, 1, At, B1); PG8_BAR;
            PG8_LDA(At, 0, 1); PG8_STAGE(PG8_SA(0, 0), a2, voffA);
            PG8_BAR; PG8_WAIT_L(0); PG8_MMA(1, 0, At, B0); PG8_BAR; PG8_SCHED;
            PG8_STAGE(PG8_SB(0, 1), b2 + hstep, voffB);
            PG8_WAIT_V(6); PG8_BAR; PG8_MMA(1, 1, At, B1); PG8_BAR;
            PG8_LDB(B0, 1, 0); PG8_SCHED; PG8_LDA(At, 1, 0); PG8_STAGE(PG8_SA(0, 1), a2 + hstep, voffA);
            PG8_WAIT_L(8); PG8_BAR; PG8_WAIT_L(0); PG8_MMA(0, 0, At, B0); PG8_BAR; PG8_SCHED;
            PG8_LDB(B1, 1, 1); PG8_STAGE(PG8_SB(1, 0), b3, voffB);
            PG8_BAR; PG8_WAIT_L(0); PG8_MMA(0, 1, At, B1); PG8_BAR;
            PG8_LDA(At, 1, 1); PG8_STAGE(PG8_SA(1, 0), a3, voffA);
            PG8_BAR; PG8_WAIT_L(0); PG8_MMA(1, 0, At, B0); PG8_BAR; PG8_SCHED;
            PG8_STAGE(PG8_SB(1, 1), b3 + hstep, voffB);
            PG8_WAIT_V(6); PG8_BAR; PG8_MMA(1, 1, At, B1); PG8_BAR;
            }
        }
        if constexpr (ALIGN_EPI) { if (wr == 0) PG8_BAR; }
        if constexpr (!Epi::AFTER_DRAIN) { E(acc, cur, wr, wc, fr, fq); S.done(cur); }
        if (!has_next) break;
#pragma unroll
        for (int a = 0; a < 2; ++a)
#pragma unroll
            for (int b = 0; b < 2; ++b)
#pragma unroll
                for (int m = 0; m < 4; ++m)
#pragma unroll
                    for (int n = 0; n < 2; ++n) acc[a][b][m][n] = (f32x4){0.f, 0.f, 0.f, 0.f};
        cur = nxt; cA = nA; cB = nB; ++ui;
        if constexpr (ALIGN_EPI) { if (wr == 1) PG8_BAR; }
    }
    PG8_WAIT_V(0);
    if constexpr (!ALIGN_EPI) { if (wr == 0) PG8_BAR; }
    PG8_BAR;
    if constexpr (Epi::AFTER_DRAIN) { E.fused(acc, cur, wr, wc, fr, fq, lds, wid, lane); S.done(cur); }
#undef PG8_SA
#undef PG8_SB
#undef PG8_STAGE
#undef PG8_LDA
#undef PG8_LDB
#undef PG8_MMA
#undef PG8_WAIT_V
#undef PG8_WAIT_L
#undef PG8_BAR
#undef PG8_SCHED
}
}

using pg8::bf16_t; using pg8::f32x4; using pg8::u32x4; using pg8::Unit;
#define LAS __attribute__((address_space(3)))

constexpr int DM = 1024, SEQ = 2048, BATCH = 16, DEPTH = 4, NIN = 3620, NTOK = BATCH * SEQ, YP = 3840;
constexpr float EPS = 1e-6f;
constexpr int O_DZ = 3200, O_DK = 3072, O_DV = 3136;
constexpr int YA_H = 0, YA_B = 256, YA_C = 512, YA_Z = 768, YB_U = 1024, YB_V = 1280, YB_Z = 1536, YC_Q = 1792, YC_K = 2048, YC_V = 2304,
              YC_Z = 2560, YD_Q = 2816, YD_Z = 3072, YD_K = 3328, YD_V = 3392, YI_Q = 3456, YI_K = 3584, YI_W = 3616;
constexpr int TOPK = 256;
constexpr int NT = 512, NW = 8;
constexpr int LDS_BYTES = 131072 + 4096;

constexpr size_t MiB = 1u << 20;
constexpr size_t WS_WTIN = 1 * MiB;
constexpr size_t WS_WTOUT = WS_WTIN + (size_t)DEPTH * YP * DM * 2;
constexpr size_t WS_SSQ = WS_WTOUT + (size_t)DEPTH * DM * DM * 2;
constexpr size_t WS_XB = WS_SSQ + (size_t)NTOK * 16 * 4;
constexpr size_t WS_Y = WS_XB + (size_t)NTOK * DM * 2;
constexpr size_t WS_MIX = WS_Y + (size_t)NTOK * YP * 2;
constexpr size_t WS_WSB = WS_MIX + (size_t)NTOK * DM * 2;
constexpr size_t WS_END = WS_WSB + (size_t)DEPTH * 4 * 128 * 128 * 2;

constexpr size_t WS_SMALL = 65536;
constexpr int SM_CONVW = 0, SM_CONVB = 3072, SM_GMLPG = 4096, SM_GMLPB = 5120, SM_QG = 7168, SM_KG = 7296, SM_LAM = 7424, SM_SUBG = 7936, SM_DQG = 8960, SM_DKG = 9216, SM_END = 9472;
struct Params {
    const float* x; const float* norm_g; const float* w_in; const float* i_conv_w; const float* i_conv_b;
    const float* i_gmlp_g; const float* gmlp_ws; const float* i_gmlp_b; const float* i_diff_qg; const float* i_diff_kg;
    const float* i_diff_lam; const float* i_diff_subg; const float* i_dsa_qg; const float* i_dsa_kg; const float* w_out;
    float* out; unsigned char* ws;
    __device__ __forceinline__ unsigned* ctl() const { return (unsigned*)ws; }
    __device__ __forceinline__ const float* sm(int off) const { return (const float*)(ws + WS_SMALL) + off; }
    __device__ __forceinline__ bf16_t* wt_in() const { return (bf16_t*)(ws + WS_WTIN); }
    __device__ __forceinline__ bf16_t* wt_out() const { return (bf16_t*)(ws + WS_WTOUT); }
    __device__ __forceinline__ float* ssq() const { return (float*)(ws + WS_SSQ); }
    __device__ __forceinline__ bf16_t* xb() const { return (bf16_t*)(ws + WS_XB); }
    __device__ __forceinline__ bf16_t* Y() const { return (bf16_t*)(ws + WS_Y); }
    __device__ __forceinline__ bf16_t* mix() const { return (bf16_t*)(ws + WS_MIX); }
    __device__ __forceinline__ bf16_t* wsb() const { return (bf16_t*)(ws + WS_WSB); }
};

__device__ __forceinline__ unsigned f2bf(float f) { unsigned u = __float_as_uint(f); return (u + 0x7fffu + ((u >> 16) & 1u)) >> 16; }
__device__ __forceinline__ unsigned pk2(float lo, float hi) { return f2bf(lo) | (f2bf(hi) << 16); }
__device__ __forceinline__ float bf2f(bf16_t b) { return __uint_as_float((unsigned)b << 16); }

__device__ __forceinline__ float xsum32(float v) { const auto r = __builtin_amdgcn_permlane32_swap(__float_as_uint(v), __float_as_uint(v), false, false); return __uint_as_float(r[0]) + __uint_as_float(r[1]); }
__device__ __forceinline__ float xmax32(float v) { const auto r = __builtin_amdgcn_permlane32_swap(__float_as_uint(v), __float_as_uint(v), false, false); return fmaxf(__uint_as_float(r[0]), __uint_as_float(r[1])); }
__device__ __forceinline__ int xsum32i(int v) { const auto r = __builtin_amdgcn_permlane32_swap((unsigned)v, (unsigned)v, false, false); return (int)(r[0] + r[1]); }
__device__ __forceinline__ float xsum16(float v) { const auto r = __builtin_amdgcn_permlane16_swap(__float_as_uint(v), __float_as_uint(v), false, false); return __uint_as_float(r[0]) + __uint_as_float(r[1]); }
__device__ __forceinline__ float wave_sum(float v) {
#pragma unroll
    for (int o = 32; o > 0; o >>= 1) v += __shfl_xor(v, o);
    return v;
}
__device__ __forceinline__ float wave_max(float v) {
#pragma unroll
    for (int o = 32; o > 0; o >>= 1) v = fmaxf(v, __shfl_xor(v, o));
    return v;
}
__device__ __forceinline__ int wave_sumi(int v) {
#pragma unroll
    for (int o = 32; o > 0; o >>= 1) v += __shfl_xor(v, o);
    return v;
}
__device__ __forceinline__ float block_sum(float v, float* red) {
    v = wave_sum(v);
    __syncthreads();
    if ((threadIdx.x & 63) == 0) red[threadIdx.x >> 6] = v;
    __syncthreads();
    float s = 0.f;
#pragma unroll
    for (int i = 0; i < NW; ++i) s += red[i];
    return s;
}
__device__ __forceinline__ float block_max(float v, float* red) {
    v = wave_max(v);
    __syncthreads();
    if ((threadIdx.x & 63) == 0) red[threadIdx.x >> 6] = v;
    __syncthreads();
    float s = red[0];
#pragma unroll
    for (int i = 1; i < NW; ++i) s = fmaxf(s, red[i]);
    return s;
}
__device__ __forceinline__ int block_sumi(int v, int* red) {
    v = wave_sumi(v);
    __syncthreads();
    if ((threadIdx.x & 63) == 0) red[threadIdx.x >> 6] = v;
    __syncthreads();
    int s = 0;
#pragma unroll
    for (int i = 0; i < NW; ++i) s += red[i];
    return s;
}
__device__ __forceinline__ int block_excl_scan(int v, int* red, int* tot) {
    const int lane = threadIdx.x & 63, w = threadIdx.x >> 6;
    int inc = v;
#pragma unroll
    for (int o = 1; o < 64; o <<= 1) { int n = __shfl_up(inc, o); if (lane >= o) inc += n; }
    __syncthreads();
    if (lane == 63) red[w] = inc;
    __syncthreads();
    int base = 0, t = 0;
#pragma unroll
    for (int i = 0; i < NW; ++i) { if (i < w) base += red[i]; t += red[i]; }
    *tot = t;
    return base + inc - v;
}

__device__ __forceinline__ int phys2logical(int n) { const int p = n & 255; return (n & ~255) + 64 * ((p >> 5) & 3) + 32 * (p >> 7) + (p & 31); }
__device__ __forceinline__ int logical2orig(int n) {
    if (n < 3072) return n;
    if (n < YD_K) return n - YD_Z + O_DZ;
    if (n < YD_V) return n - YD_K + O_DK;
    if (n < YI_Q) return n - YD_V + O_DV;
    if (n < NIN) return n;
    return -1;
}
__device__ __forceinline__ void transpose_item(const float* W, int ldn, const float* gk, bf16_t* WT, int k0, int n0, int src, LAS float* scr, int lane) {
#pragma unroll 8
    for (int i = 0; i < 32; ++i) {
        const int kk = 2 * i + (lane >> 5);
        float v = 0.f;
        if (src >= 0) { v = W[(size_t)(k0 + kk) * ldn + src]; if (gk) v *= gk[k0 + kk]; }
        scr[kk * 33 + (lane & 31)] = v;
    }
    asm volatile("s_waitcnt lgkmcnt(0)" ::: "memory");
    const int c = lane & 7;
#pragma unroll
    for (int j = 0; j < 4; ++j) {
        const int n = (lane >> 3) + 8 * j; const LAS float* s = scr + (8 * c) * 33 + n;
        u32x4 o; o.x = pk2(s[0 * 33], s[1 * 33]); o.y = pk2(s[2 * 33], s[3 * 33]); o.z = pk2(s[4 * 33], s[5 * 33]); o.w = pk2(s[6 * 33], s[7 * 33]);
        *(u32x4*)(WT + (size_t)(n0 + n) * DM + k0 + 8 * c) = o;
    }
    asm volatile("s_waitcnt lgkmcnt(0)" ::: "memory");
}
__device__ __forceinline__ int tid_now(int wave_s) { int lane; asm volatile("v_mbcnt_lo_u32_b32 %0, -1, 0\n\tv_mbcnt_hi_u32_b32 %0, -1, %0" : "=v"(lane)); return wave_s * 64 + lane; }
__device__ __forceinline__ void ph_prologue(const Params& p, LAS unsigned char* lds, int tid_in) {
    int tid = tid_in; asm volatile("" : "+v"(tid));
    const int lane = tid & 63, wave = tid >> 6;
    LAS float* scr = (LAS float*)(lds + wave * 8704);
    const int gw = blockIdx.x * NW + wave, ngw = gridDim.x * NW;
    constexpr int I_IN = DEPTH * 16 * (YP / 32), I_OUT = DEPTH * 16 * (DM / 32);
    for (int it = gw; it < I_IN + I_OUT; it += ngw) {
        if (it < I_IN) {
            const int l = it / (16 * (YP / 32)), r = it % (16 * (YP / 32)), kb = r / (YP / 32), nb = r % (YP / 32);
            const int src = logical2orig(phys2logical(nb * 32 + (lane & 31)));
            transpose_item(p.w_in + (size_t)l * DM * NIN, NIN, p.norm_g + l * DM, p.wt_in() + (size_t)l * YP * DM, kb * 64, nb * 32, src, scr, lane);
        } else {
            const int q = it - I_IN, l = q / (16 * (DM / 32)), r = q % (16 * (DM / 32)), kb = r / (DM / 32), nb = r % (DM / 32);
            transpose_item(p.w_out + (size_t)l * DM * DM, DM, nullptr, p.wt_out() + (size_t)l * DM * DM, kb * 64, nb * 32, nb * 32 + (lane & 31), scr, lane);
        }
    }
    if (blockIdx.x == 0) {
        float* sm = (float*)(p.ws + WS_SMALL);
        for (int i = tid; i < SM_END; i += NT) {
            float v;
            if (i < SM_CONVB) v = p.i_conv_w[i - SM_CONVW]; else if (i < SM_GMLPG) v = p.i_conv_b[i - SM_CONVB]; else if (i < SM_GMLPB) v = p.i_gmlp_g[i - SM_GMLPG];
            else if (i < SM_QG) v = p.i_gmlp_b[i - SM_GMLPB]; else if (i < SM_KG) v = p.i_diff_qg[i - SM_QG]; else if (i < SM_LAM) v = p.i_diff_kg[i - SM_KG];
            else if (i < SM_SUBG) v = p.i_diff_lam[i - SM_LAM]; else if (i < SM_DQG) v = p.i_diff_subg[i - SM_SUBG]; else if (i < SM_DKG) v = p.i_dsa_qg[i - SM_DQG];
            else v = p.i_dsa_kg[i - SM_DKG];
            sm[i] = v;
        }
    }
    for (int i = (blockIdx.x * NT + tid) * 4; i < DEPTH * 4 * 128 * 128; i += gridDim.x * NT * 4) {
        const f32x4 v = *(const f32x4*)(p.gmlp_ws + i);
        *(unsigned long long*)(p.wsb() + i) = (unsigned long long)pk2(v.x, v.y) | ((unsigned long long)pk2(v.z, v.w) << 32);
    }
    for (int r = gw; r < NTOK; r += ngw) {
        const f32x4* xr = (const f32x4*)(p.x + (size_t)r * DM) + lane;
        unsigned long long* o8 = (unsigned long long*)(p.xb() + (size_t)r * DM) + lane;
        float s = 0.f;
#pragma unroll
        for (int j = 0; j < 4; ++j) {
            const f32x4 v = xr[64 * j];
            s += (v.x * v.x + v.y * v.y) + (v.z * v.z + v.w * v.w);
            o8[64 * j] = (unsigned long long)pk2(v.x, v.y) | ((unsigned long long)pk2(v.z, v.w) << 32);
        }
        s = wave_sum(s);
        if (lane < 16) p.ssq()[(size_t)r * 16 + lane] = lane == 0 ? s : 0.f;
    }
}

__device__ __forceinline__ float silu_f(float v) { return v * __builtin_amdgcn_rcpf(1.f + __builtin_amdgcn_exp2f(-1.4426950408889634f * v)); }
struct EpiIn {
    static constexpr bool PERM = true, AFTER_DRAIN = false;
    unsigned char* ws; int l;
    __device__ __forceinline__ void operator()(const f32x4 (&acc)[2][2][4][2], const Unit& u, int wr, int wc, int fr_, int fq_) const {
        int fr = fr_, fq = fq_; asm volatile("" : "+v"(fr), "+v"(fq));
        const int pn = u.pn;
        bf16_t* Y = (bf16_t*)(ws + WS_Y); const float* ssq = (const float*)(ws + WS_SSQ); const float* smb = (const float*)(ws + WS_SMALL);
        const float* gmlp_g = smb + SM_GMLPG + l * 256; const float* qg = smb + SM_QG + l * 32; const float* kg = smb + SM_KG + l * 32;
        const float* dqg = smb + SM_DQG + l * 64; const float* dkg = smb + SM_DKG + l * 64;
        int op = 0; const float* g0 = nullptr; const float* g1 = nullptr;
        if (pn == 3 || pn == 6 || pn == 10 || pn == 12) op = 1;
        else if (pn == 4) op = 2;
        else if (pn == 5) { op = 3; g0 = gmlp_g + 64 * wc + 8 * fq; g1 = g0 + 32; }
        else if (pn == 7) { op = 4; g0 = qg + 8 * fq; g1 = g0; }
        else if (pn == 8) { op = 4; g0 = kg + 8 * fq; g1 = g0; }
        else if (pn == 11) { op = 5; g0 = dqg + 8 * fq; g1 = g0 + 32; }
        else if (pn == 13 && wc == 0) { op = 5; g0 = dkg + 8 * fq; g1 = g0 + 32; }
        float gn[16];
#pragma unroll
        for (int i = 0; i < 16; ++i) gn[i] = 1.f;
        if (op >= 3) {
            const f32x4 a = *(const f32x4*)g0, b = *(const f32x4*)(g0 + 4), c = *(const f32x4*)g1, d = *(const f32x4*)(g1 + 4);
            gn[0] = a.x; gn[1] = a.y; gn[2] = a.z; gn[3] = a.w; gn[4] = b.x; gn[5] = b.y; gn[6] = b.z; gn[7] = b.w;
            gn[8] = c.x; gn[9] = c.y; gn[10] = c.z; gn[11] = c.w; gn[12] = d.x; gn[13] = d.y; gn[14] = d.z; gn[15] = d.w;
        }
        const int colb = pn * 256 + 64 * wc + 8 * fq;
#pragma unroll
        for (int ai = 0; ai < 2; ++ai)
#pragma unroll
            for (int m = 0; m < 4; ++m) {
                const int row = u.pm * 256 + ai * 128 + wr * 64 + m * 16 + fr;
                const f32x4* sp = (const f32x4*)(ssq + (size_t)row * 16);
                const f32x4 s0 = sp[0], s1 = sp[1], s2 = sp[2], s3 = sp[3];
                const float tot = ((s0.x + s0.y) + (s0.z + s0.w)) + ((s1.x + s1.y) + (s1.z + s1.w)) + ((s2.x + s2.y) + (s2.z + s2.w)) + ((s3.x + s3.y) + (s3.z + s3.w));
                const float rstd = rsqrtf(tot * (1.f / DM) + EPS);
                float v[16];
#pragma unroll
                for (int bj = 0; bj < 2; ++bj)
#pragma unroll
                    for (int n = 0; n < 2; ++n)
#pragma unroll
                        for (int e = 0; e < 4; ++e) v[bj * 8 + n * 4 + e] = acc[ai][bj][m][n][e] * rstd;
                if (op == 1) {
#pragma unroll
                    for (int i = 0; i < 16; ++i) v[i] = silu_f(v[i]);
                } else if (op == 2 || op == 3) {
#pragma unroll
                    for (int i = 0; i < 16; i += 2) { const pg8::f32x2 r = pg8::gelu_pk((pg8::f32x2){v[i], v[i + 1]}); v[i] = r.x; v[i + 1] = r.y; }
                }
                if (op == 3 || op == 5) {
                    float ss = 0.f;
#pragma unroll
                    for (int i = 0; i < 16; ++i) ss += v[i] * v[i];
                    ss = xsum16(ss); ss = xsum32(ss);
                    const float sc = rsqrtf(ss * (1.f / 64) + EPS);
#pragma unroll
                    for (int i = 0; i < 16; ++i) v[i] *= sc * gn[i];
                } else if (op == 4) {
#pragma unroll
                    for (int bj = 0; bj < 2; ++bj) {
                        float ss = 0.f;
#pragma unroll
                        for (int i = 0; i < 8; ++i) ss += v[bj * 8 + i] * v[bj * 8 + i];
                        ss = xsum16(ss); ss = xsum32(ss);
                        const float sc = rsqrtf(ss * (1.f / 32) + EPS);
#pragma unroll
                        for (int i = 0; i < 8; ++i) v[bj * 8 + i] *= sc * gn[bj * 8 + i];
                    }
                }
                bf16_t* rowp = Y + (size_t)row * YP + colb;
#pragma unroll
                for (int bj = 0; bj < 2; ++bj) {
                    u32x4 w; w.x = pg8::cvt_pk_bf16(v[bj * 8 + 0], v[bj * 8 + 1]); w.y = pg8::cvt_pk_bf16(v[bj * 8 + 2], v[bj * 8 + 3]);
                    w.z = pg8::cvt_pk_bf16(v[bj * 8 + 4], v[bj * 8 + 5]); w.w = pg8::cvt_pk_bf16(v[bj * 8 + 6], v[bj * 8 + 7]);
                    *(u32x4*)(rowp + 32 * bj) = w;
                }
                asm volatile("" ::: "memory");
            }
    }
};
struct EpiOut {
    static constexpr bool PERM = false, AFTER_DRAIN = false;
    float* xout; unsigned char* ws;
    __device__ __forceinline__ void operator()(const f32x4 (&acc)[2][2][4][2], const Unit& u, int wr, int wc, int fr_, int fq_) const {
        int fr = fr_, fq = fq_; asm volatile("" : "+v"(fr), "+v"(fq));
        const int col0 = u.pn * 256 + wc * 32 + 4 * fq;
        bf16_t* xb = (bf16_t*)(ws + WS_XB); float* ssq = (float*)(ws + WS_SSQ);
#pragma unroll
        for (int ai = 0; ai < 2; ++ai)
#pragma unroll
            for (int m = 0; m < 4; ++m) {
                const int row = u.pm * 256 + ai * 128 + wr * 64 + m * 16 + fr;
                float sq = 0.f;
#pragma unroll
                for (int bj = 0; bj < 2; ++bj)
#pragma unroll
                    for (int n = 0; n < 2; ++n) {
                        const size_t off = (size_t)row * DM + col0 + bj * 128 + n * 16;
                        const unsigned long long xo = *(const unsigned long long*)(xb + off);
                        f32x4 v = acc[ai][bj][m][n];
                        v.x += __uint_as_float((unsigned)xo << 16); v.y += __uint_as_float((unsigned)xo & 0xffff0000u);
                        v.z += __uint_as_float((unsigned)(xo >> 32) << 16); v.w += __uint_as_float((unsigned)(xo >> 32) & 0xffff0000u);
                        sq += (v.x * v.x + v.y * v.y) + (v.z * v.z + v.w * v.w);
                        if (xout) *(f32x4*)(xout + off) = v;
                        else *(unsigned long long*)(xb + off) = (unsigned long long)pg8::cvt_pk_bf16(v.x, v.y) | ((unsigned long long)pg8::cvt_pk_bf16(v.z, v.w) << 32);
                    }
                sq = xsum16(sq); sq = xsum32(sq);
                if (fq == 0) ssq[(size_t)row * 16 + u.pn * 4 + wc] = sq;
                asm volatile("" ::: "memory");
            }
    }
};
#define XB_TMO      128
#define XB_XCNT(j)  (256  + 64 * (j))
#define XB_XSUB(j)  (1280 + 64 * (j))
#define XB_XGEN(j)  (2304 + 64 * (j))
#define XB_TOP      3328
#define XB_TOPGEN   3392
#define XCD_BAR_WORDS 3456
#define XB_SPIN_CAP (1u << 18)

__device__ __forceinline__ unsigned xb_ld(unsigned* p)              { return __hip_atomic_load(p, __ATOMIC_RELAXED, __HIP_MEMORY_SCOPE_AGENT); }
__device__ __forceinline__ unsigned xb_add(unsigned* p, unsigned v) { return __hip_atomic_fetch_add(p, v, __ATOMIC_RELAXED, __HIP_MEMORY_SCOPE_AGENT); }
__device__ __forceinline__ unsigned xb_xcc_id() { return (unsigned)__builtin_amdgcn_s_getreg((3 << 11) | 20) & 0xFu; }
#define XB_SPIN(cond, bar) do { unsigned _sp = 0; while (cond) { __builtin_amdgcn_s_sleep(1); \
    if ((++_sp & 255u) == 0u) { if (xb_ld(&(bar)[XB_TMO])) break; if (_sp > XB_SPIN_CAP) { atomicAdd(&(bar)[XB_TMO], 1u); break; } } } } while (0)

struct XcdBarrier {
    unsigned* bar; unsigned x;
    volatile LAS unsigned* st;
};

__device__ __forceinline__ XcdBarrier xcd_barrier_post(unsigned* bar, volatile LAS unsigned* st) {
    XcdBarrier b; b.bar = bar; b.x = xb_xcc_id(); b.st = st;
    if (threadIdx.x == 0) (void)xb_add(&bar[XB_XCNT(b.x)], 1u);
    return b;
}
__device__ __forceinline__ void xcd_barrier_complete(unsigned* bar, unsigned x, unsigned& nloc, unsigned& nx) {
    const unsigned G = gridDim.x * gridDim.y * gridDim.z;
    unsigned sum, cnt, mine, sp = 0u;
    for (;;) {
        sum = 0u; cnt = 0u; mine = 0u;
#pragma unroll
        for (unsigned j = 0; j < 16; ++j) { const unsigned c = xb_ld(&bar[XB_XCNT(j)]); sum += c; cnt += (c > 0u) ? 1u : 0u; mine = (j == x) ? c : mine; }
        if (sum == G) break;
        __builtin_amdgcn_s_sleep(1);
        if ((++sp & 255u) == 0u) { if (xb_ld(&bar[XB_TMO])) break; if (sp > XB_SPIN_CAP) { atomicAdd(&bar[XB_TMO], 1u); break; } }
    }
    nloc = mine > 0u ? mine : 1u; nx = cnt > 0u ? cnt : 1u;
}

__device__ __forceinline__ void xcd_barrier(const XcdBarrier& b, int tid_in) {
    asm volatile("s_waitcnt vmcnt(0)" ::: "memory");
    __syncthreads();
    int t0_ = tid_in; asm volatile("" : "+v"(t0_));
    if (t0_ == 0) {
        unsigned* bar = b.bar;
        __builtin_amdgcn_s_waitcnt(0);
        unsigned nloc = b.st[0], nx = b.st[1];
        if (nloc == 0u) { xcd_barrier_complete(bar, b.x, nloc, nx); b.st[0] = nloc; b.st[1] = nx; }
        const unsigned old = xb_add(&bar[XB_XSUB(b.x)], 1u);
        const unsigned gen = old / nloc;
        if (old + 1u == (gen + 1u) * nloc) {
            __builtin_amdgcn_fence(__ATOMIC_RELEASE, "agent");
            asm volatile("s_waitcnt vmcnt(0)" ::: "memory");
            const unsigned og = xb_add(&bar[XB_TOP], 1u);
            const unsigned tg = og / nx;
            if (og + 1u == (tg + 1u) * nx) xb_add(&bar[XB_TOPGEN], 1u);
            else XB_SPIN(xb_ld(&bar[XB_TOPGEN]) == tg, bar);
            __builtin_amdgcn_fence(__ATOMIC_ACQUIRE, "agent");
            xb_add(&bar[XB_XGEN(b.x)], 1u);
            asm volatile("s_waitcnt vmcnt(0)" ::: "memory");
        } else {
            XB_SPIN(xb_ld(&bar[XB_XGEN(b.x)]) == gen, bar);
            __builtin_amdgcn_fence(__ATOMIC_ACQUIRE, "agent");
            asm volatile("s_waitcnt vmcnt(0)" ::: "memory");
        }
    }
    __syncthreads();
}

typedef short bf16x8_t __attribute__((ext_vector_type(8)));
typedef short s16x4_t __attribute__((ext_vector_type(4)));
typedef float f32x16 __attribute__((ext_vector_type(16)));
typedef float f32x2_t __attribute__((ext_vector_type(2)));
typedef __bf16 bf16x2_t __attribute__((ext_vector_type(2)));
#define MFMA32(a, b, c) __builtin_amdgcn_mfma_f32_32x32x16_bf16((a), (b), (c), 0, 0, 0)
__device__ __forceinline__ unsigned cvtpk(float lo, float hi) { f32x2_t v = {lo, hi}; bf16x2_t b = __builtin_convertvector(v, bf16x2_t); return __builtin_bit_cast(unsigned, b); }
__device__ __forceinline__ s16x4_t ds_tr16(const LAS unsigned char* p) { return __builtin_bit_cast(s16x4_t, __builtin_amdgcn_ds_read_tr16_b64_v4i16((LAS s16x4_t*)p)); }
__device__ __forceinline__ bf16x8_t pack_step(const f32x16& x, int s) {
    u32x4 p; p.x = cvtpk(x[8 * s], x[8 * s + 1]); p.y = cvtpk(x[8 * s + 2], x[8 * s + 3]); p.z = cvtpk(x[8 * s + 4], x[8 * s + 5]); p.w = cvtpk(x[8 * s + 6], x[8 * s + 7]);
    return __builtin_bit_cast(bf16x8_t, p);
}
constexpr int KV_STRIDE = 144;
constexpr int KV_TILE = 64 * KV_STRIDE;
__device__ __forceinline__ bf16x8_t vt_frag(const LAS unsigned char* vtile, int ks, int db, int lane) {
    const int i16 = lane & 15, q = i16 >> 2, pp = i16 & 3, blk = (lane >> 4) & 1, hh = lane >> 5;
    const LAS unsigned char* a = vtile + (16 * ks + 4 * hh + q) * KV_STRIDE + (32 * db + 16 * blk + 4 * pp) * 2;
    const s16x4_t lo = ds_tr16(a), hi = ds_tr16(a + 8 * KV_STRIDE);
    return __builtin_shufflevector(lo, hi, 0, 1, 2, 3, 4, 5, 6, 7);
}

__device__ __forceinline__ void mixC_unit(const Params& p, int l, int b, int h, int qt, LAS unsigned char* lds, int wave_s, float lam, float lam_init, float mfix) {
    const int tid = tid_now(wave_s);
    const int lane = tid & 63, wave = __builtin_amdgcn_readfirstlane(tid >> 6), r32 = lane & 31, hh = lane >> 5;
    const size_t rowb = (size_t)b * SEQ;
    const int q0 = qt * 256 + wave * 32;
    const int cw = (q0 >> 6);
    const int jmax = 4 * qt + 3;
    const int pos = q0 + r32;
    const bf16_t* yq = p.Y() + (rowb + pos) * YP;
    bf16x8_t qf[2][2];
#pragma unroll
    for (int c = 0; c < 2; ++c)
#pragma unroll
        for (int s = 0; s < 2; ++s) qf[c][s] = *(const bf16x8_t*)(yq + YC_Q + h * 64 + c * 32 + 16 * s + 8 * hh);
    const float c1 = 0.17677669529663687f * 1.4426950408889634f;
    const float sl2 = exp2f(-(float)(2 * h + 1)) * 1.4426950408889634f;
    f32x16 o[2][2];
#pragma unroll
    for (int c = 0; c < 2; ++c)
#pragma unroll
        for (int d = 0; d < 2; ++d)
#pragma unroll
            for (int i = 0; i < 16; ++i) o[c][d][i] = 0.f;
    float lrun[2] = {0.f, 0.f};
    const int srow = tid >> 3, sch = tid & 7;
    const bf16_t* ksrc = p.Y() + (rowb + srow) * YP + YC_K + h * 64 + sch * 8;
    const bf16_t* vsrc = p.Y() + (rowb + srow) * YP + YC_V + h * 64 + sch * 8;
    const int sdst = srow * KV_STRIDE + sch * 16;
    LAS unsigned char* kbuf = lds;
    LAS unsigned char* vbuf = lds + 2 * KV_TILE;
    u32x4 kreg = *(const u32x4*)ksrc, vreg = *(const u32x4*)vsrc;
    __syncthreads();
    *(LAS u32x4*)(kbuf + sdst) = kreg; *(LAS u32x4*)(vbuf + sdst) = vreg;
    __syncthreads();
    for (int j = 0; j <= jmax; ++j) {
        const int cur = j & 1;
        if (j < jmax) { kreg = *(const u32x4*)(ksrc + (size_t)(j + 1) * 64 * YP); vreg = *(const u32x4*)(vsrc + (size_t)(j + 1) * 64 * YP); }
        if (j <= cw) {
            const LAS unsigned char* kt = kbuf + cur * KV_TILE;
            const LAS unsigned char* vt = vbuf + cur * KV_TILE;
            const float pl = (float)(pos - 64 * j - 4 * hh);
            const bool diag = (j == cw);
#pragma unroll
            for (int c = 0; c < 2; ++c) {
                f32x16 sc[2];
#pragma unroll
                for (int kb = 0; kb < 2; ++kb) {
                    f32x16 a;
#pragma unroll
                    for (int i = 0; i < 16; ++i) a[i] = 0.f;
#pragma unroll
                    for (int s = 0; s < 2; ++s) {
                        const bf16x8_t kf = *(const LAS bf16x8_t*)(kt + (32 * kb + r32) * KV_STRIDE + (c * 32 + 16 * s + 8 * hh) * 2);
                        a = MFMA32(kf, qf[c][s], a);
                    }
                    sc[kb] = a;
                }
                float ls = 0.f;
                if (!diag) {
                    const float rt = -sl2 * pl - mfix;
#pragma unroll
                    for (int kb = 0; kb < 2; ++kb)
#pragma unroll
                        for (int i = 0; i < 16; ++i) {
                            const float kc = (float)(32 * kb + (i & 3) + 8 * (i >> 2));
                            const float e = __builtin_amdgcn_exp2f(fmaf(sc[kb][i], c1, fmaf(sl2, kc, rt)));
                            sc[kb][i] = e; ls += e;
                        }
                } else {
#pragma unroll
                    for (int kb = 0; kb < 2; ++kb)
#pragma unroll
                        for (int i = 0; i < 16; ++i) {
                            const float kc = (float)(32 * kb + (i & 3) + 8 * (i >> 2));
                            const float e = __builtin_amdgcn_exp2f(fmaf(sc[kb][i], c1, fmaf(-sl2, fabsf(pl - kc), -mfix)));
                            sc[kb][i] = e; ls += e;
                        }
                }
                lrun[c] += ls;
#pragma unroll
                for (int ks = 0; ks < 4; ++ks) {
                    const bf16x8_t pf = pack_step(sc[ks >> 1], ks & 1);
#pragma unroll
                    for (int db = 0; db < 2; ++db) o[c][db] = MFMA32(vt_frag(vt, ks, db, lane), pf, o[c][db]);
                }
            }
        }
        if (j < jmax) {
            *(LAS u32x4*)(kbuf + (cur ^ 1) * KV_TILE + sdst) = kreg; *(LAS u32x4*)(vbuf + (cur ^ 1) * KV_TILE + sdst) = vreg;
        }
        __syncthreads();
    }
    const float l1 = xsum32(lrun[0]), l2 = xsum32(lrun[1]);
    const float i1 = 1.f / l1, i2 = lam / l2;
    float ss = 0.f;
#pragma unroll
    for (int d = 0; d < 2; ++d)
#pragma unroll
        for (int i = 0; i < 16; ++i) { const float v = o[0][d][i] * i1 - o[1][d][i] * i2; o[0][d][i] = v; ss += v * v; }
    ss = xsum32(ss);
    const float rn = rsqrtf(ss * (1.f / 64) + EPS) * (1.f - lam_init);
    const float* sg = p.sm(SM_SUBG) + l * 256 + h * 64;
    bf16_t* mrow = p.mix() + (rowb + pos) * DM + 512 + h * 64;
#pragma unroll
    for (int d = 0; d < 2; ++d)
#pragma unroll
        for (int g = 0; g < 4; ++g) {
            const int d0 = 32 * d + 8 * g + 4 * hh;
            const f32x4 gv = *(const f32x4*)(sg + d0);
            const unsigned long long zz = *(const unsigned long long*)(yq + YC_Z + h * 64 + d0);
            const float z0 = __uint_as_float((unsigned)(zz & 0xffffu) << 16), z1 = __uint_as_float((unsigned)((zz >> 16) & 0xffffu) << 16),
                        z2 = __uint_as_float((unsigned)((zz >> 32) & 0xffffu) << 16), z3 = __uint_as_float((unsigned)((zz >> 48) & 0xffffu) << 16);
            const float v0 = o[0][d][4 * g] * rn * gv.x * z0, v1 = o[0][d][4 * g + 1] * rn * gv.y * z1, v2 = o[0][d][4 * g + 2] * rn * gv.z * z2, v3 = o[0][d][4 * g + 3] * rn * gv.w * z3;
            *(unsigned long long*)(mrow + d0) = (unsigned long long)cvtpk(v0, v1) | ((unsigned long long)cvtpk(v2, v3) << 32);
        }
}
__device__ __forceinline__ void ph_mixC(const Params& p, int l, LAS unsigned char* lds, int bid, int nb, int wave_s) {
    const float lam_init = 0.8f - 0.6f * expf(-0.3f * (float)l);
    const float* lp = p.sm(SM_LAM) + l * 128;
    float d1 = 0.f, d2 = 0.f;
    for (int i = 0; i < 32; ++i) { d1 += lp[i] * lp[32 + i]; d2 += lp[64 + i] * lp[96 + i]; }
    const float lam_v = expf(d1) - expf(d2) + lam_init;
    float gq = 0.f, gk = 0.f;
    for (int i = 0; i < 32; ++i) { gq = fmaxf(gq, fabsf(p.sm(SM_QG)[l * 32 + i])); gk = fmaxf(gk, fabsf(p.sm(SM_KG)[l * 32 + i])); }
    const float mfix_v = 0.17677669529663687f * 1.4426950408889634f * 32.f * gq * gk * 1.02f;
    const float lam = __uint_as_float(__builtin_amdgcn_readfirstlane(__float_as_uint(lam_v))), mfix = __uint_as_float(__builtin_amdgcn_readfirstlane(__float_as_uint(mfix_v)));
    const float lam_i = __uint_as_float(__builtin_amdgcn_readfirstlane(__float_as_uint(lam_init)));
    for (int i = bid; i < 256; i += nb) {
#pragma unroll 1
        for (int k = 0; k < 2; ++k) {
            const int id = k == 0 ? i : 511 - i;
            const int qt = id < 256 ? 7 - (id >> 6) : 3 - ((id - 256) >> 6), bh = id & 63;
            mixC_unit(p, l, bh >> 2, bh & 3, qt, lds, wave_s, lam, lam_i, mfix);
        }
    }
}

constexpr int SC_STRIDE = 2052;
constexpr int SC_BYTES = 16 * SC_STRIDE * 4;
constexpr int IK_STRIDE = 80, IK_TILE = 64 * IK_STRIDE;
__device__ __forceinline__ unsigned fkey(float f) { const unsigned u = __float_as_uint(f); return (u & 0x80000000u) ? ~u : (u | 0x80000000u); }
__device__ __forceinline__ float unfkey(unsigned k) { return __uint_as_float((k & 0x80000000u) ? (k & 0x7fffffffu) : ~k); }
__device__ __forceinline__ f32x16 idx_scores(const bf16x8_t ik0, const bf16x8_t ik1, const bf16x8_t (&iqf)[4][2], const float (&w)[4]) {
    f32x16 sc;
#pragma unroll
    for (int i = 0; i < 16; ++i) sc[i] = 0.f;
#pragma unroll
    for (int hd = 0; hd < 4; ++hd) {
        f32x16 a;
#pragma unroll
        for (int i = 0; i < 16; ++i) a[i] = 0.f;
        a = MFMA32(ik0, iqf[hd][0], a);
        a = MFMA32(ik1, iqf[hd][1], a);
#pragma unroll
        for (int i = 0; i < 16; ++i) sc[i] = fmaf(w[hd], fmaxf(a[i], 0.f), sc[i]);
    }
#pragma unroll
    for (int i = 0; i < 16; ++i) sc[i] = sc[i] + 0.f;
    return sc;
}
__device__ __forceinline__ void transpose32(unsigned (&a)[32]) {
#pragma unroll
    for (int s = 0; s < 5; ++s) {
        const int j = 16 >> s;
        const unsigned mk = j == 16 ? 0x0000ffffu : j == 8 ? 0x00ff00ffu : j == 4 ? 0x0f0f0f0fu : j == 2 ? 0x33333333u : 0x55555555u;
#pragma unroll
        for (int k = 0; k < 32; ++k)
            if ((k & j) == 0) { const unsigned t = (a[k] ^ (a[k + j] >> j)) & mk; a[k] ^= t; a[k + j] ^= t << j; asm volatile("" : "+v"(a[k]), "+v"(a[k + j])); }
    }
}
__device__ __forceinline__ int wg_qsum(int cnt, LAS int* cx, int par, int wave, int lane) {
    cnt = xsum32i(cnt);
    LAS int* c = cx + par * 256;
    if (lane < 32) c[wave * 32 + lane] = cnt;
    __syncthreads();
    int tot = 0;
#pragma unroll
    for (int w = 0; w < NW; ++w) tot += c[w * 32 + (lane & 31)];
    return tot;
}
template <int IT>
__device__ __forceinline__ void rs_step(const unsigned (&pl)[4][32], unsigned (&alive)[4], int& above, unsigned& prefix, bool& done, bool& alld, int& par, LAS int* cx, int wave, int lane) {
    if (!alld) {
        int c1 = 0;
#pragma unroll
        for (int j = 0; j < 4; ++j) c1 += __popc(alive[j] & pl[j][IT]);
        const int tot = wg_qsum(above + c1, cx, par, wave, lane); par ^= 1;
        if (!done) {
            const bool ge = tot >= TOPK;
            if (ge) prefix |= 1u << (31 - IT); else above += c1;
#pragma unroll
            for (int j = 0; j < 4; ++j) alive[j] &= ge ? pl[j][IT] : ~pl[j][IT];
            if (tot == TOPK) done = true;
        }
        alld = __all(done);
    }
    if constexpr (IT < 31) rs_step<IT + 1>(pl, alive, above, prefix, done, alld, par, cx, wave, lane);
}
__device__ __forceinline__ void mixD_attend(const Params& p, int b, int c, LAS unsigned char* lds, int wave_s);
__device__ __forceinline__ void mixD_unit(const Params& p, int b, int c, LAS unsigned char* lds, int wave_s) {
    const int tid = tid_now(wave_s);
    const int lane = tid & 63, wave = __builtin_amdgcn_readfirstlane(tid >> 6), r32 = lane & 31, hh = lane >> 5;
    const size_t rowb = (size_t)b * SEQ;
    const int q0 = c * 64, ntile = c + 1;
    LAS float* thr = (LAS float*)(lds + SC_BYTES);
    LAS int* kcs = (LAS int*)(lds + SC_BYTES + 256);
    const bool dosel = c >= 4;
    __syncthreads();
    if (dosel) {
        LAS int* cx = (LAS int*)(lds + SC_BYTES + 512);
        const int nblk = 2 * ntile;
        const int nbw = (nblk - wave + 7) >> 3;
#pragma unroll 1
        for (int sp = 0; sp < 2; ++sp) {
            unsigned pl[4][32];
            unsigned zopq = 0u; asm volatile("" : "+v"(zopq));
            {
                const bf16_t* yq1 = p.Y() + (rowb + q0 + 32 * sp + r32) * YP;
                bf16x8_t iqf[4][2];
#pragma unroll
                for (int hd = 0; hd < 4; ++hd)
#pragma unroll
                    for (int s = 0; s < 2; ++s) iqf[hd][s] = *(const bf16x8_t*)(yq1 + YI_Q + hd * 32 + 16 * s + 8 * hh);
                float w[4];
                const unsigned long long ww = *(const unsigned long long*)(yq1 + YI_W);
#pragma unroll
                for (int hd = 0; hd < 4; ++hd) w[hd] = __uint_as_float((unsigned)((ww >> (16 * hd)) & 0xffffu) << 16) * (0.17677669529663687f * 0.5f);
#pragma unroll
                for (int g = 0; g < 2; ++g) {
                    bf16x8_t ik[4][2];
#pragma unroll
                    for (int i = 0; i < 4; ++i) {
                        const int kb = 4 * g + i < nbw ? wave + 8 * (4 * g + i) : wave;
                        const bf16_t* yk = p.Y() + (rowb + 32 * kb + r32) * YP + YI_K + 8 * hh;
                        ik[i][0] = *(const bf16x8_t*)yk; ik[i][1] = *(const bf16x8_t*)(yk + 16);
                    }
#pragma unroll
                    for (int i = 0; i < 4; ++i) {
                        const int blk = 4 * g + i;
                        if (blk < nbw) {
                            const f32x16 sc = idx_scores(ik[i][0], ik[i][1], iqf, w);
#pragma unroll
                            for (int r = 0; r < 16; ++r) pl[blk >> 1][16 * (blk & 1) + r] = fkey(sc[r]);
                        } else {
#pragma unroll
                            for (int r = 0; r < 16; ++r) pl[blk >> 1][16 * (blk & 1) + r] = zopq;
                        }
                    }
                    asm volatile("" ::: "memory");
                }
            }
#pragma unroll
            for (int j = 0; j < 4; ++j) transpose32(pl[j]);
            unsigned alive[4];
#pragma unroll
            for (int j = 0; j < 4; ++j) alive[j] = (2 * j < nbw ? 0xffff0000u : 0u) | (2 * j + 1 < nbw ? 0x0000ffffu : 0u);
            int above = 0, par = 0; unsigned prefix = 0u; bool done = false;
            bool alld = false;
            rs_step<0>(pl, alive, above, prefix, done, alld, par, cx, wave, lane);
            int kcut = 1 << 20;
            if (!__all(done)) {
                const int need = TOPK - wg_qsum(above, cx, par, wave, lane); par ^= 1;
                int posk = 0;
#pragma unroll 1
                for (int b2 = 10; b2 >= 0; --b2) {
                    const int t = posk | (1 << b2);
                    int c = 0;
#pragma unroll
                    for (int j = 0; j < 4; ++j)
#pragma unroll
                        for (int half = 0; half < 2; ++half) {
                            const int rem = t - (32 * (wave + 8 * (2 * j + half)) + 4 * hh);
                            const int n = rem <= 0 ? 0 : rem >= 28 ? 16 : 4 * (rem >> 3) + min(rem & 7, 4);
                            const unsigned m16 = n == 0 ? 0u : ((0xffffu << (16 - n)) & 0xffffu);
                            c += __popc(alive[j] & (half == 0 ? (m16 << 16) : m16));
                        }
                    const int f = wg_qsum(c, cx, par, wave, lane); par ^= 1;
                    if (f < need) posk = t;
                }
                if (!done) kcut = posk;
            }
            if (wave == 0 && lane < 32) { thr[32 * sp + lane] = unfkey(prefix); kcs[32 * sp + lane] = kcut; }
            __syncthreads();
        }
    }
    mixD_attend(p, b, c, lds, wave_s);
}
__device__ __forceinline__ void mixD_attend(const Params& p, int b, int c, LAS unsigned char* lds, int wave_s) {
    const int tid = tid_now(wave_s);
    const int lane = tid & 63, wave = __builtin_amdgcn_readfirstlane(tid >> 6), r32 = lane & 31, hh = lane >> 5;
    const size_t rowb = (size_t)b * SEQ;
    const int q0 = c * 64, ntile = c + 1;
    LAS float* thr = (LAS float*)(lds + SC_BYTES);
    LAS int* kcs = (LAS int*)(lds + SC_BYTES + 256);
    const bool dosel = c >= 4;
    const int qg = wave >> 2, hd = wave & 3;
    const int pos = q0 + 32 * qg + r32;
    const bf16_t* yq = p.Y() + (rowb + pos) * YP;
    bf16x8_t qf[4];
#pragma unroll
    for (int s = 0; s < 4; ++s) qf[s] = *(const bf16x8_t*)(yq + YD_Q + hd * 64 + 16 * s + 8 * hh);
    bf16x8_t iqf[4][2];
    float w[4];
    float T = -INFINITY; int kcut = 1 << 20;
    if (dosel) {
#pragma unroll
        for (int h2 = 0; h2 < 4; ++h2)
#pragma unroll
            for (int s = 0; s < 2; ++s) iqf[h2][s] = *(const bf16x8_t*)(yq + YI_Q + h2 * 32 + 16 * s + 8 * hh);
        const unsigned long long ww = *(const unsigned long long*)(yq + YI_W);
#pragma unroll
        for (int h2 = 0; h2 < 4; ++h2) w[h2] = __uint_as_float((unsigned)((ww >> (16 * h2)) & 0xffffu) << 16) * (0.17677669529663687f * 0.5f);
        T = thr[32 * qg + r32]; kcut = kcs[32 * qg + r32];
    } else {
#pragma unroll
        for (int h2 = 0; h2 < 4; ++h2) { w[h2] = 0.f;
#pragma unroll
            for (int s = 0; s < 2; ++s)
#pragma unroll
                for (int e = 0; e < 8; ++e) iqf[h2][s][e] = 0; }
    }
    const float c1 = 0.125f * 1.4426950408889634f;
    const float sl2 = exp2f(-(float)(2 * hd + 2)) * 1.4426950408889634f;
    f32x16 o[2];
#pragma unroll
    for (int d = 0; d < 2; ++d)
#pragma unroll
        for (int i = 0; i < 16; ++i) o[d][i] = 0.f;
    float mrun = -1e30f, lrun = 0.f;
    const int npair = (ntile + 1) >> 1;
    const int srow = tid >> 3, sch = tid & 7;
    const bf16_t* ksrc = p.Y() + (rowb + srow) * YP + YD_K + sch * 8;
    const bf16_t* vsrc = p.Y() + (rowb + srow) * YP + YD_V + sch * 8;
    const int sdst = srow * KV_STRIDE + sch * 16;
    LAS unsigned char* kbuf = lds;
    LAS unsigned char* vbuf = lds + 4 * KV_TILE;
    LAS unsigned* mbuf = (LAS unsigned*)(lds + 8 * KV_TILE);
    const int mtile = hd >> 1, mkb = hd & 1;
    u32x4 kreg[2], vreg[2];
    bf16x8_t ikn0, ikn1;
#pragma unroll
    for (int tt = 0; tt < 2; ++tt) {
        const int t = min(tt, ntile - 1);
        kreg[tt] = *(const u32x4*)(ksrc + (size_t)t * 64 * YP); vreg[tt] = *(const u32x4*)(vsrc + (size_t)t * 64 * YP);
    }
    {
        const bf16_t* yk = p.Y() + (rowb + 64 * min(mtile, ntile - 1) + 32 * mkb + r32) * YP + YI_K + 8 * hh;
        ikn0 = *(const bf16x8_t*)yk; ikn1 = *(const bf16x8_t*)(yk + 16);
    }
    __syncthreads();
#pragma unroll
    for (int tt = 0; tt < 2; ++tt) { *(LAS u32x4*)(kbuf + tt * KV_TILE + sdst) = kreg[tt]; *(LAS u32x4*)(vbuf + tt * KV_TILE + sdst) = vreg[tt]; }
    for (int pp = 0; pp < npair; ++pp) {
        const int cur = pp & 1;
        const bool more = pp + 1 < npair;
        if (more) {
#pragma unroll
            for (int tt = 0; tt < 2; ++tt) {
                const int t = min(2 * (pp + 1) + tt, ntile - 1);
                kreg[tt] = *(const u32x4*)(ksrc + (size_t)t * 64 * YP); vreg[tt] = *(const u32x4*)(vsrc + (size_t)t * 64 * YP);
            }
        }
        if (dosel) {
            const int tm = 2 * pp + mtile;
            unsigned bits = 0u;
            if (tm < ntile) {
                const f32x16 ss = idx_scores(ikn0, ikn1, iqf, w);
                const int kcl = kcut - 64 * tm - 4 * hh;
#pragma unroll
                for (int i = 0; i < 16; ++i) {
                    const int kci = 32 * mkb + (i & 3) + 8 * (i >> 2);
                    const bool sel = (ss[i] > T) || (ss[i] == T && kci <= kcl);
                    bits |= sel ? (1u << i) : 0u;
                }
            }
            mbuf[((cur * 2 + qg) * 4 + hd) * 64 + lane] = bits;
            if (more) {
                const bf16_t* yk = p.Y() + (rowb + 64 * min(2 * (pp + 1) + mtile, ntile - 1) + 32 * mkb + r32) * YP + YI_K + 8 * hh;
                ikn0 = *(const bf16x8_t*)yk; ikn1 = *(const bf16x8_t*)(yk + 16);
            }
        }
        __syncthreads();
#pragma unroll 1
        for (int tt = 0; tt < 2; ++tt) {
            const int j = 2 * pp + tt;
            if (j < ntile) {
                const LAS unsigned char* kt = kbuf + (cur * 2 + tt) * KV_TILE;
                const LAS unsigned char* vt = vbuf + (cur * 2 + tt) * KV_TILE;
                const float pl = (float)(pos - 64 * j - 4 * hh);
                const bool diag = (j == c);
                unsigned selb[2] = {0xffffu, 0xffffu};
                if (dosel) { selb[0] = mbuf[((cur * 2 + qg) * 4 + 2 * tt) * 64 + lane]; selb[1] = mbuf[((cur * 2 + qg) * 4 + 2 * tt + 1) * 64 + lane]; }
                f32x16 sc[2];
#pragma unroll
                for (int kb = 0; kb < 2; ++kb) {
                    f32x16 a;
#pragma unroll
                    for (int i = 0; i < 16; ++i) a[i] = 0.f;
#pragma unroll
                    for (int s = 0; s < 4; ++s) {
                        const bf16x8_t kf = *(const LAS bf16x8_t*)(kt + (32 * kb + r32) * KV_STRIDE + (16 * s + 8 * hh) * 2);
                        a = MFMA32(kf, qf[s], a);
                    }
                    if (!diag) {
#pragma unroll
                        for (int i = 0; i < 16; ++i) { const float kc = (float)(32 * kb + (i & 3) + 8 * (i >> 2)); a[i] = fmaf(a[i], c1, fmaf(sl2, kc, -sl2 * pl)); }
                    } else {
#pragma unroll
                        for (int i = 0; i < 16; ++i) { const float kc = (float)(32 * kb + (i & 3) + 8 * (i >> 2)); a[i] = fmaf(a[i], c1, -sl2 * fabsf(pl - kc)); }
                    }
#pragma unroll
                    for (int i = 0; i < 16; ++i) a[i] = (selb[kb] & (1u << i)) ? a[i] : -INFINITY;
                    sc[kb] = a;
                }
                float mx = sc[0][0];
#pragma unroll
                for (int i = 1; i < 16; ++i) mx = fmaxf(mx, sc[0][i]);
#pragma unroll
                for (int i = 0; i < 16; ++i) mx = fmaxf(mx, sc[1][i]);
                mx = xmax32(mx);
                const float mnew = fmaxf(mrun, mx);
                const float alpha = __builtin_amdgcn_exp2f(mrun - mnew);
                mrun = mnew;
                float ls = 0.f;
#pragma unroll
                for (int kb = 0; kb < 2; ++kb)
#pragma unroll
                    for (int i = 0; i < 16; ++i) { const float e = __builtin_amdgcn_exp2f(sc[kb][i] - mnew); sc[kb][i] = e; ls += e; }
                lrun = lrun * alpha + ls;
#pragma unroll
                for (int d = 0; d < 2; ++d)
#pragma unroll
                    for (int i = 0; i < 16; ++i) o[d][i] *= alpha;
#pragma unroll
                for (int ks = 0; ks < 4; ++ks) {
                    const bf16x8_t pf = pack_step(sc[ks >> 1], ks & 1);
#pragma unroll
                    for (int db = 0; db < 2; ++db) o[db] = MFMA32(vt_frag(vt, ks, db, lane), pf, o[db]);
                }
            }
        }
        if (more) {
#pragma unroll
            for (int tt = 0; tt < 2; ++tt) { *(LAS u32x4*)(kbuf + ((cur ^ 1) * 2 + tt) * KV_TILE + sdst) = kreg[tt]; *(LAS u32x4*)(vbuf + ((cur ^ 1) * 2 + tt) * KV_TILE + sdst) = vreg[tt]; }
        }
        __syncthreads();
    }
    const float inv = 1.f / xsum32(lrun);
    bf16_t* mrow = p.mix() + (rowb + pos) * DM + 768 + hd * 64;
#pragma unroll
    for (int d = 0; d < 2; ++d)
#pragma unroll
        for (int g = 0; g < 4; ++g) {
            const int d0 = 32 * d + 8 * g + 4 * hh;
            const unsigned long long zz = *(const unsigned long long*)(yq + YD_Z + hd * 64 + d0);
            const float z0 = __uint_as_float((unsigned)(zz & 0xffffu) << 16), z1 = __uint_as_float((unsigned)((zz >> 16) & 0xffffu) << 16),
                        z2 = __uint_as_float((unsigned)((zz >> 32) & 0xffffu) << 16), z3 = __uint_as_float((unsigned)((zz >> 48) & 0xffffu) << 16);
            *(unsigned long long*)(mrow + d0) = (unsigned long long)cvtpk(o[d][4 * g] * inv * z0, o[d][4 * g + 1] * inv * z1) | ((unsigned long long)cvtpk(o[d][4 * g + 2] * inv * z2, o[d][4 * g + 3] * inv * z3) << 32);
        }
}
__device__ __forceinline__ void ph_mixD(const Params& p, LAS unsigned char* lds, int bid, int nb, int wave_s) {
    for (int i = bid; i < 256; i += nb) {
        const int b = i & 15, cc = i >> 4;
#pragma unroll 1
        for (int k = 0; k < 2; ++k) mixD_unit(p, b, k == 0 ? 31 - cc : cc, lds, wave_s);
    }
}

constexpr int VN_STRIDE = 528;
__device__ __forceinline__ float bflo(unsigned u) { return __uint_as_float(u << 16); }
__device__ __forceinline__ float bfhi(unsigned u) { return __uint_as_float(u & 0xffff0000u); }
__device__ __forceinline__ void mixAB_unit(const Params& p, int l, int b, int n, LAS unsigned char* lds, int tid) {
    const int lane = tid & 63, wave = __builtin_amdgcn_readfirstlane(tid >> 6), r32 = lane & 31, hh = lane >> 5;
    const size_t row0 = (size_t)b * SEQ + 128 * n;
    __syncthreads();
#pragma unroll
    for (int k = 0; k < 8; ++k) {
        const int ch = tid + 512 * k, r = ch >> 5, c16 = ch & 31;
        *(LAS u32x4*)(lds + r * VN_STRIDE + c16 * 16) = *(const u32x4*)(p.Y() + (row0 + r) * YP + YB_V + c16 * 8);
    }
    {
        const int cg8 = (tid & 31) * 8, t0 = (tid >> 5) * 8;
        const int pos0 = 128 * n + t0;
        const float* cw = p.sm(SM_CONVW) + l * 768 + cg8;
        float w0[8], w1[8], w2[8], cb[8];
#pragma unroll
        for (int e = 0; e < 8; ++e) { w0[e] = cw[e]; w1[e] = cw[256 + e]; w2[e] = cw[512 + e]; cb[e] = p.sm(SM_CONVB)[l * 256 + cg8 + e]; }
        float um2[8], um1[8];
#pragma unroll
        for (int e = 0; e < 8; ++e) { um2[e] = 0.f; um1[e] = 0.f; }
#pragma unroll
        for (int back = 2; back >= 1; --back) {
            if (pos0 - back >= 0) {
                const bf16_t* yr = p.Y() + (row0 + t0 - back) * YP;
                const u32x4 hc = *(const u32x4*)(yr + YA_H + cg8), cc = *(const u32x4*)(yr + YA_C + cg8);
                float u[8] = {bflo(hc.x) * bflo(cc.x), bfhi(hc.x) * bfhi(cc.x), bflo(hc.y) * bflo(cc.y), bfhi(hc.y) * bfhi(cc.y),
                              bflo(hc.z) * bflo(cc.z), bfhi(hc.z) * bfhi(cc.z), bflo(hc.w) * bflo(cc.w), bfhi(hc.w) * bfhi(cc.w)};
#pragma unroll
                for (int e = 0; e < 8; ++e) { if (back == 2) um2[e] = u[e]; else um1[e] = u[e]; }
            }
        }
#pragma unroll
        for (int tt = 0; tt < 8; ++tt) {
            const bf16_t* yr = p.Y() + (row0 + t0 + tt) * YP;
            const u32x4 hc = *(const u32x4*)(yr + YA_H + cg8), cc = *(const u32x4*)(yr + YA_C + cg8), bg = *(const u32x4*)(yr + YA_B + cg8), zg = *(const u32x4*)(yr + YA_Z + cg8);
            const float u[8] = {bflo(hc.x) * bflo(cc.x), bfhi(hc.x) * bfhi(cc.x), bflo(hc.y) * bflo(cc.y), bfhi(hc.y) * bfhi(cc.y),
                                bflo(hc.z) * bflo(cc.z), bfhi(hc.z) * bfhi(cc.z), bflo(hc.w) * bflo(cc.w), bfhi(hc.w) * bfhi(cc.w)};
            const float bgv[8] = {bflo(bg.x), bfhi(bg.x), bflo(bg.y), bfhi(bg.y), bflo(bg.z), bfhi(bg.z), bflo(bg.w), bfhi(bg.w)};
            const float zgv[8] = {bflo(zg.x), bfhi(zg.x), bflo(zg.y), bfhi(zg.y), bflo(zg.z), bfhi(zg.z), bflo(zg.w), bfhi(zg.w)};
            float ov[8];
#pragma unroll
            for (int e = 0; e < 8; ++e) {
                const float conv = w0[e] * um2[e] + w1[e] * um1[e] + w2[e] * u[e];
                ov[e] = bgv[e] * (conv + cb[e]) * zgv[e];
                um2[e] = um1[e]; um1[e] = u[e];
            }
            u32x4 ow; ow.x = cvtpk(ov[0], ov[1]); ow.y = cvtpk(ov[2], ov[3]); ow.z = cvtpk(ov[4], ov[5]); ow.w = cvtpk(ov[6], ov[7]);
            *(u32x4*)(p.mix() + (row0 + t0 + tt) * DM + cg8) = ow;
        }
    }
    __syncthreads();
    {
        const int h = wave >> 1, th = wave & 1;
        const int nks = th == 0 ? 4 : 8;
        f32x16 acc[2][2];
#pragma unroll
        for (int a = 0; a < 2; ++a)
#pragma unroll
            for (int d = 0; d < 2; ++d)
#pragma unroll
                for (int i = 0; i < 16; ++i) acc[a][d][i] = 0.f;
        const bf16_t* wb = p.wsb() + ((size_t)(l * 4 + h) * 128 + 64 * th + r32) * 128 + 8 * hh;
        const int i16 = lane & 15, q = i16 >> 2, pp = i16 & 3, blk = (lane >> 4) & 1;
        const LAS unsigned char* va = lds + (8 * hh + q) * VN_STRIDE + (h * 64 + 16 * blk + 4 * pp) * 2;
        for (int ks = 0; ks < nks; ++ks) {
            bf16x8_t bfr[2], afr[2];
#pragma unroll
            for (int tb = 0; tb < 2; ++tb) bfr[tb] = *(const bf16x8_t*)(wb + (size_t)(32 * tb) * 128 + 16 * ks);
#pragma unroll
            for (int db = 0; db < 2; ++db) {
                const LAS unsigned char* a = va + (16 * ks) * VN_STRIDE + (32 * db) * 2;
                const s16x4_t lo = ds_tr16(a), hi = ds_tr16(a + 4 * VN_STRIDE);
                afr[db] = __builtin_shufflevector(lo, hi, 0, 1, 2, 3, 4, 5, 6, 7);
            }
#pragma unroll
            for (int tb = 0; tb < 2; ++tb)
#pragma unroll
                for (int db = 0; db < 2; ++db) acc[tb][db] = MFMA32(afr[db], bfr[tb], acc[tb][db]);
        }
#pragma unroll
        for (int tb = 0; tb < 2; ++tb) {
            const int t = 64 * th + 32 * tb + r32;
            const float bias = p.sm(SM_GMLPB)[(l * 4 + h) * 128 + t];
            const bf16_t* yr = p.Y() + (row0 + t) * YP;
            bf16_t* mr = p.mix() + (row0 + t) * DM + 256 + h * 64;
#pragma unroll
            for (int db = 0; db < 2; ++db)
#pragma unroll
                for (int g = 0; g < 4; ++g) {
                    const int d0 = 32 * db + 8 * g + 4 * hh;
                    const unsigned long long uu = *(const unsigned long long*)(yr + YB_U + h * 64 + d0), zz = *(const unsigned long long*)(yr + YB_Z + h * 64 + d0);
                    const unsigned u01 = (unsigned)uu, u23 = (unsigned)(uu >> 32), z01 = (unsigned)zz, z23 = (unsigned)(zz >> 32);
                    const float v0 = bflo(u01) * (acc[tb][db][4 * g] + bias) * bflo(z01), v1 = bfhi(u01) * (acc[tb][db][4 * g + 1] + bias) * bfhi(z01);
                    const float v2 = bflo(u23) * (acc[tb][db][4 * g + 2] + bias) * bflo(z23), v3 = bfhi(u23) * (acc[tb][db][4 * g + 3] + bias) * bfhi(z23);
                    *(unsigned long long*)(mr + d0) = (unsigned long long)cvtpk(v0, v1) | ((unsigned long long)cvtpk(v2, v3) << 32);
                }
        }
    }
}
__device__ __forceinline__ void ph_mixAB(const Params& p, int l, LAS unsigned char* lds, int bid, int nb, int tid_in) {
    int tid = tid_in; asm volatile("" : "+v"(tid));
    for (int i = bid; i < 256; i += nb) mixAB_unit(p, l, i >> 4, i & 15, lds, tid);
}

__global__ void __launch_bounds__(NT, 2) k_fwd(Params p) {
    extern __shared__ __attribute__((aligned(16))) unsigned char lds[];
    cg::grid_group grid = cg::this_grid();
    LAS unsigned char* l3 = (LAS unsigned char*)lds;
    const int wave_s = __builtin_amdgcn_readfirstlane((int)threadIdx.x >> 6);
    volatile LAS unsigned* bst = (volatile LAS unsigned*)(l3 + LDS_BYTES - 16);
    if (threadIdx.x < 2) bst[threadIdx.x] = 0u;
    __syncthreads();
    const XcdBarrier bar = xcd_barrier_post(p.ctl(), bst);
    ph_prologue(p, l3, tid_now(wave_s));
    grid.sync();
#pragma unroll 1
    for (int l = 0; l < DEPTH; ++l) {
        Params q = p; asm volatile("" : "+s"(q.ws), "+s"(q.out));
        int bid = blockIdx.x, nb = gridDim.x; asm volatile("" : "+s"(bid), "+s"(nb));
        {
            pg8::Gemm g{q.xb(), q.wt_in() + (size_t)l * YP * DM, NTOK, YP, DM};
            pg8::StaticOrder S; S.init(NTOK, YP, nb, bid);
            EpiIn E{q.ws, l};
            pg8::gemm_phase<EpiIn, pg8::StaticOrder, true, true>(l3, g, S, E, tid_now(wave_s));
        }
        xcd_barrier(bar, tid_now(wave_s));
        asm volatile("" : "+s"(q.ws), "+s"(bid), "+s"(nb));
        ph_mixAB(q, l, l3, bid, nb, tid_now(wave_s));
        __syncthreads();
        ph_mixC(q, l, l3, bid, nb, wave_s);
        __syncthreads();
        ph_mixD(q, l3, bid, nb, wave_s);
        __syncthreads();
        xcd_barrier(bar, tid_now(wave_s));
        asm volatile("" : "+s"(q.ws), "+s"(q.out), "+s"(bid), "+s"(nb));
        {
            pg8::Gemm g{q.mix(), q.wt_out() + (size_t)l * DM * DM, NTOK, DM, DM};
            pg8::StaticOrder S; S.init(NTOK, DM, nb, bid);
            EpiOut E{l == DEPTH - 1 ? q.out : nullptr, q.ws};
            pg8::gemm_phase<EpiOut, pg8::StaticOrder, true, true>(l3, g, S, E, tid_now(wave_s));
        }
        xcd_barrier(bar, tid_now(wave_s));
    }
}

extern "C" void kernel_launch(void* const* d_in, const int* in_sizes, int n_in, void* d_out, int out_size, void* d_ws, size_t ws_size,
                              hipStream_t stream) {
    static int grid_blocks = 0;
    if (!grid_blocks) {
        int dev = 0, cus = 0, per_cu = 0;
        (void)hipGetDevice(&dev);
        (void)hipDeviceGetAttribute(&cus, hipDeviceAttributeMultiprocessorCount, dev);
        (void)hipFuncSetAttribute((const void*)k_fwd, hipFuncAttributeMaxDynamicSharedMemorySize, LDS_BYTES);
        (void)hipOccupancyMaxActiveBlocksPerMultiprocessor(&per_cu, (const void*)k_fwd, NT, LDS_BYTES);
        if (per_cu < 1) { fprintf(stderr, "kernel_launch: occupancy query returned %d\n", per_cu); per_cu = 1; }
        if (per_cu > 1) per_cu = 1;
        grid_blocks = cus * per_cu;
        if (ws_size < WS_END) fprintf(stderr, "kernel_launch: workspace too small (%zu < %zu)\n", ws_size, (size_t)WS_END);
    }
    (void)hipMemsetAsync(d_ws, 0, 16384, stream);
    Params p{};
    p.x = (const float*)d_in[0]; p.norm_g = (const float*)d_in[1]; p.w_in = (const float*)d_in[2]; p.i_conv_w = (const float*)d_in[3];
    p.i_conv_b = (const float*)d_in[4]; p.i_gmlp_g = (const float*)d_in[5]; p.gmlp_ws = (const float*)d_in[6]; p.i_gmlp_b = (const float*)d_in[7];
    p.i_diff_qg = (const float*)d_in[8]; p.i_diff_kg = (const float*)d_in[9]; p.i_diff_lam = (const float*)d_in[10]; p.i_diff_subg = (const float*)d_in[11];
    p.i_dsa_qg = (const float*)d_in[12]; p.i_dsa_kg = (const float*)d_in[13]; p.w_out = (const float*)d_in[14];
    p.out = (float*)d_out; p.ws = (unsigned char*)d_ws;
    void* args[] = {&p};
    hipError_t e = hipLaunchCooperativeKernel((void*)k_fwd, dim3(grid_blocks), dim3(NT), args, LDS_BYTES, stream);
    if (e != hipSuccess) fprintf(stderr, "cooperative launch failed: %s (grid %d)\n", hipGetErrorString(e), grid_blocks);
}
```

```cpp
#include <hip/hip_runtime.h>
#include <hip/hip_cooperative_groups.h>
#include <math.h>
#include <stdint.h>
#include <stdio.h>
namespace cg = cooperative_groups;
namespace pg8 {
#define PG8_LAS __attribute__((address_space(3)))
typedef unsigned short bf16_t;
typedef short bf16x8 __attribute__((ext_vector_type(8)));
typedef float f32x4 __attribute__((ext_vector_type(4)));
typedef unsigned u32x4 __attribute__((ext_vector_type(4)));
constexpr int BM = 256, BK = 64, HALF = 128, HTB = HALF * BK * 2  , STAGE_BYTES = 8 * HTB, NXCD = 8, WGM = 8;

__host__ __device__ __forceinline__ int lds_byte(int r, int c) { const int st = (r >> 4) * 2 + (c >> 5), rr = r & 15, cc = c & 31, ob = rr * 64 + cc * 2; return st * 1024 + (ob ^ (((ob >> 9) & 1) << 5)); }
__host__ __device__ __forceinline__ void stage_rc(int b, int& R, int& C) { const int st = b / 1024, sb = b % 1024, swz = sb ^ (((sb >> 9) & 1) << 5); R = (st >> 1) * 16 + swz / 64; C = (st & 1) * 32 + (swz % 64) / 2; }
__host__ __device__ __forceinline__ int perm32(int rho) { const int n = rho >> 4, i = rho & 15; return 8 * (i >> 2) + 4 * n + (i & 3); }

struct Unit { int pm, pn; };
struct Gemm { const bf16_t* A; const bf16_t* Bt; int M, N, K; };

struct StaticOrder {
    int nM, nN, nwg, G, c;
    __host__ __device__ void init(int M, int N, int G_, int c_) { nM = M / BM; nN = N / BM; nwg = nM * nN; G = G_; c = c_; }
    __host__ __device__ bool next(int i, Unit& u) const {
        const long L = (long)i * G + c; if (L >= nwg) return false;
        int wgid = (int)L; { const int q = nwg / NXCD, r = nwg % NXCD, xcd = wgid % NXCD, off = wgid / NXCD; wgid = (xcd < r ? xcd * (q + 1) : r * (q + 1) + (xcd - r) * q) + off; }
        const int nig = WGM * nN, gid = wgid / nig, fm = gid * WGM, gsz = (nM - fm) < WGM ? (nM - fm) : WGM;
        u.pm = fm + ((wgid % nig) % gsz); u.pn = (wgid % nig) / gsz; return true;
    }
    __device__ __forceinline__ void a_ready(const Unit&) const {}
    __device__ __forceinline__ void done(const Unit&) const {}
};

__device__ __forceinline__ unsigned cvt_pk_bf16(float lo, float hi) { unsigned r; asm volatile("v_cvt_pk_bf16_f32 %0, %1, %2" : "=v"(r) : "v"(lo), "v"(hi)); return r; }
typedef float f32x2 __attribute__((ext_vector_type(2)));
__device__ __forceinline__ f32x2 gelu_pk(f32x2 v) {
    const f32x2 av = __builtin_elementwise_abs(v), d = av * 0.2316418882f + 1.0f;
    f32x2 t; t.x = __builtin_amdgcn_rcpf(d.x); t.y = __builtin_amdgcn_rcpf(d.y);
    f32x2 q = t * 0.5307027145f + (-0.7265760135f); q = q * t + 0.7107068705f; q = q * t + (-0.142248368f); q = q * t + 0.127414796f; q = q * t;
    const f32x2 s = (v * v) * (-0.72134752044f);
    f32x2 e; e.x = __builtin_amdgcn_exp2f(s.x); e.y = __builtin_amdgcn_exp2f(s.y);
    const f32x2 m = v * (q * e), r = v - m;
    f32x2 o; o.x = v.x < 0.f ? m.x : r.x; o.y = v.y < 0.f ? m.y : r.y; return o;
}
template <class Epi, class Sched, bool ALIGN_EPI = false, bool SP2 = false>
__device__ __forceinline__ void gemm_phase(PG8_LAS unsigned char* lds, const Gemm g, const Sched& S, const Epi& E, int tid_in) {
    int tid_ = tid_in; asm volatile("" : "+v"(tid_));
    const int tid = tid_, wid = __builtin_amdgcn_readfirstlane(tid >> 6), lane = tid & 63, wr = wid >> 2, wc = wid & 3, fr = lane & 15, fq = lane >> 4;
    const int K = g.K, nt = K / BK;
    unsigned voffA[2], voffB[2];
#pragma unroll
    for (int i = 0; i < 2; ++i) { int R, C; stage_rc(tid * 16 + i * 8192, R, C); const int Rb = Epi::PERM ? ((R & ~31) + perm32(R & 31)) : R;
        voffA[i] = (unsigned)(R * K + C) * 2u; voffB[i] = (unsigned)(Rb * K + C) * 2u; }
    const size_t kstep = (size_t)(BK * 2);
    const size_t hstep = (size_t)HALF * K * 2;
    const size_t tstep = 2 * hstep;
    const unsigned ldsw = (unsigned)wid * 1024u;
    const int aoff = lds_byte(wr * 64 + fr, fq * 8), boff = lds_byte(wc * 32 + fr, fq * 8);
#define PG8_SA(b, h) (((b) * 2 + (h)) * HTB)
#define PG8_SB(b, h) ((4 + (b) * 2 + (h)) * HTB)
#define PG8_STAGE(bufoff, gbase, voff) do { _Pragma("unroll") for (int _i = 0; _i < 2; ++_i) \
        __builtin_amdgcn_global_load_lds((const unsigned*)((const char*)(gbase) + (voff)[_i]), (PG8_LAS unsigned*)(lds + (bufoff) + ldsw + _i * 8192), 16, 0, 0); } while (0)
#define PG8_LDA(dst, b, h) do { _Pragma("unroll") for (int m = 0; m < 4; ++m) _Pragma("unroll") for (int k = 0; k < 2; ++k) dst[m][k] = *(const PG8_LAS bf16x8*)(lds + PG8_SA(b, h) + aoff + m * 2048 + k * 1024); } while (0)
#define PG8_LDB(dst, b, h) do { _Pragma("unroll") for (int n = 0; n < 2; ++n) _Pragma("unroll") for (int k = 0; k < 2; ++k) dst[n][k] = *(const PG8_LAS bf16x8*)(lds + PG8_SB(b, h) + boff + n * 2048 + k * 1024); } while (0)
#define PG8_MMA(ai, bj, At, Bt) do { __builtin_amdgcn_s_setprio(1); _Pragma("unroll") for (int m = 0; m < 4; ++m) _Pragma("unroll") for (int n = 0; n < 2; ++n) _Pragma("unroll") for (int k = 0; k < 2; ++k) \
        acc[ai][bj][m][n] = __builtin_amdgcn_mfma_f32_16x16x32_bf16(Bt[n][k], At[m][k], acc[ai][bj][m][n], 0, 0, 0); __builtin_amdgcn_s_setprio(0); } while (0)
#define PG8_WAIT_V(n) asm volatile("s_waitcnt vmcnt(" #n ")" ::: "memory")
#define PG8_WAIT_L(n) asm volatile("s_waitcnt lgkmcnt(" #n ")" ::: "memory")
#define PG8_BAR __builtin_amdgcn_s_barrier()
#define PG8_SCHED __builtin_amdgcn_sched_barrier(0)
    Unit cur, nxt; int ui = 0;
    if (!S.next(0, cur)) return;
    f32x4 acc[2][2][4][2];
#pragma unroll
    for (int a = 0; a < 2; ++a)
#pragma unroll
        for (int b = 0; b < 2; ++b)
#pragma unroll
            for (int m = 0; m < 4; ++m)
#pragma unroll
                for (int n = 0; n < 2; ++n) acc[a][b][m][n] = (f32x4){0.f, 0.f, 0.f, 0.f};
    bf16x8 At[4][2], B0[2][2], B1[2][2];
    const char* cA = (const char*)g.A + (size_t)cur.pm * tstep; const char* cB = (const char*)g.Bt + (size_t)cur.pn * tstep;
    S.a_ready(cur);
    if constexpr (SP2) {
        PG8_STAGE(PG8_SB(0, 0), cB, voffB); PG8_STAGE(PG8_SB(0, 1), cB + hstep, voffB); PG8_STAGE(PG8_SA(0, 0), cA, voffA); PG8_STAGE(PG8_SA(0, 1), cA + hstep, voffA);
        if (wr == 1) PG8_BAR;
        PG8_WAIT_V(2); PG8_BAR;
        PG8_STAGE(PG8_SB(1, 0), cB + kstep, voffB); PG8_STAGE(PG8_SA(1, 0), cA + kstep, voffA); PG8_STAGE(PG8_SB(1, 1), cB + hstep + kstep, voffB);
        PG8_WAIT_V(6); PG8_BAR;
    } else {
        PG8_STAGE(PG8_SB(0, 0), cB, voffB); PG8_STAGE(PG8_SA(0, 0), cA, voffA); PG8_STAGE(PG8_SB(0, 1), cB + hstep, voffB); PG8_STAGE(PG8_SA(0, 1), cA + hstep, voffA);
        if (wr == 1) PG8_BAR;
        PG8_WAIT_V(4); PG8_BAR;
        PG8_STAGE(PG8_SB(1, 0), cB + kstep, voffB); PG8_STAGE(PG8_SA(1, 0), cA + kstep, voffA); PG8_STAGE(PG8_SB(1, 1), cB + hstep + kstep, voffB);
        PG8_WAIT_V(6); PG8_BAR;
    }
    for (;;) {
        const bool has_next = S.next(ui + 1, nxt);
        const char* nA = has_next ? (const char*)g.A + (size_t)nxt.pm * tstep : cA; const char* nB = has_next ? (const char*)g.Bt + (size_t)nxt.pn * tstep : cB;
        for (int t = 0; t < nt; t += 2) {
            const bool last = (t == nt - 2);
            const char* a1 = cA + (size_t)(t + 1) * kstep;
            const char* a2 = last ? nA : cA + (size_t)(t + 2) * kstep; const char* b2 = last ? nB : cB + (size_t)(t + 2) * kstep;
            const char* a3 = a2 + kstep; const char* b3 = b2 + kstep;
            if (last && has_next) S.a_ready(nxt);
            if constexpr (SP2) {
            PG8_LDB(B0, 0, 0); PG8_LDB(B1, 0, 1); PG8_SCHED; PG8_LDA(At, 0, 0); PG8_STAGE(PG8_SA(1, 1), a1 + hstep, voffA);
            PG8_WAIT_V(8); PG8_WAIT_L(0); PG8_BAR; PG8_MMA(0, 0, At, B0); PG8_MMA(0, 1, At, B1); PG8_BAR; PG8_SCHED;
            PG8_LDA(At, 0, 1); PG8_STAGE(PG8_SB(0, 0), b2, voffB); PG8_STAGE(PG8_SB(0, 1), b2 + hstep, voffB); PG8_STAGE(PG8_SA(0, 0), a2, voffA);
            PG8_WAIT_V(8); PG8_WAIT_L(0); PG8_BAR; PG8_MMA(1, 0, At, B0); PG8_MMA(1, 1, At, B1); PG8_BAR; PG8_SCHED;
            PG8_LDB(B0, 1, 0); PG8_LDB(B1, 1, 1); PG8_SCHED; PG8_LDA(At, 1, 0); PG8_STAGE(PG8_SA(0, 1), a2 + hstep, voffA);
            PG8_WAIT_V(8); PG8_WAIT_L(0); PG8_BAR; PG8_MMA(0, 0, At, B0); PG8_MMA(0, 1, At, B1); PG8_BAR; PG8_SCHED;
            PG8_LDA(At, 1, 1); PG8_STAGE(PG8_SB(1, 0), b3, voffB); PG8_STAGE(PG8_SB(1, 1), b3 + hstep, voffB); PG8_STAGE(PG8_SA(1, 0), a3, voffA);
            PG8_WAIT_V(8); PG8_WAIT_L(0); PG8_BAR; PG8_MMA(1, 0, At, B0); PG8_MMA(1, 1, At, B1); PG8_BAR; PG8_SCHED;
            } else {
            PG8_LDB(B0, 0, 0); PG8_SCHED; PG8_LDA(At, 0, 0); PG8_STAGE(PG8_SA(1, 1), a1 + hstep, voffA);
            PG8_WAIT_L(8); PG8_BAR; PG8_WAIT_L(0); PG8_MMA(0, 0, At, B0); PG8_BAR; PG8_SCHED;
            PG8_LDB(B1, 0, 1); PG8_STAGE(PG8_SB(0, 0), b2, voffB);
            PG8_BAR; PG8_WAIT_L(0); PG8_MMA(0, 1, At, B1); PG8_BAR;
            PG8_LDA(At, 0, 1); PG8_STAGE(PG8_SA(0, 0), a2, voffA);
            PG8_BAR; PG8_WAIT_L(0); PG8_MMA(1, 0, At, B0); PG8_BAR; PG8_SCHED;
            PG8_STAGE(PG8_SB(0, 1), b2 + hstep, voffB);
            PG8_WAIT_V(6); PG8_BAR; PG8_MMA(1, 1, At, B1); PG8_BAR;
            PG8_LDB(B0, 1, 0); PG8_SCHED; PG8_LDA(At, 1, 0); PG8_STAGE(PG8_SA(0, 1), a2 + hstep, voffA);
            PG8_WAIT_L(8); PG8_BAR; PG8_WAIT_L(0); PG8_MMA(0, 0, At, B0); PG8_BAR; PG8_SCHED;
            PG8_LDB(B1, 1, 1); PG8_STAGE(PG8_SB(1, 0), b3, voffB);
            PG8_BAR; PG8_WAIT_L(0); PG8_MMA(0, 1, At, B1); PG8_BAR;
            PG8_LDA(At, 1, 1); PG8_STAGE(PG8_SA(1, 0), a3, voffA);
            PG8_BAR; PG8_WAIT_L(0); PG8_MMA(1, 0, At, B0); PG8_BAR; PG8_SCHED;
            PG8_STAGE(PG8_SB(1, 1), b3 + hstep, voffB);
            PG8_WAIT_V(6); PG8_BAR; PG8_MMA(1, 1, At, B1); PG8_BAR;
            }
        }
        if constexpr (ALIGN_EPI) { if (wr == 0) PG8_BAR; }
        if constexpr (!Epi::AFTER_DRAIN) { E(acc, cur, wr, wc, fr, fq); S.done(cur); }
        if (!has_next) break;
#pragma unroll
        for (int a = 0; a < 2; ++a)
#pragma unroll
            for (int b = 0; b < 2; ++b)
#pragma unroll
                for (int m = 0; m < 4; ++m)
#pragma unroll
                    for (int n = 0; n < 2; ++n) acc[a][b][m][n] = (f32x4){0.f, 0.f, 0.f, 0.f};
        cur = nxt; cA = nA; cB = nB; ++ui;
        if constexpr (ALIGN_EPI) { if (wr == 1) PG8_BAR; }
    }
    PG8_WAIT_V(0);
    if constexpr (!ALIGN_EPI) { if (wr == 0) PG8_BAR; }
    PG8_BAR;
    if constexpr (Epi::AFTER_DRAIN) { E.fused(acc, cur, wr, wc, fr, fq, lds, wid, lane); S.done(cur); }
#undef PG8_SA
#undef PG8_SB
#undef PG8_STAGE
#undef PG8_LDA
#undef PG8_LDB
#undef PG8_MMA
#undef PG8_WAIT_V
#undef PG8_WAIT_L
#undef PG8_BAR
#undef PG8_SCHED
}
}

using pg8::bf16_t; using pg8::f32x4; using pg8::u32x4; using pg8::Unit;
#define LAS __attribute__((address_space(3)))
#define GAS __attribute__((address_space(1)))

constexpr int DM = 1024, SEQ = 2048, BATCH = 16, DEPTH = 4, NIN = 3620, NTOK = BATCH * SEQ, YP = 3840;
constexpr float EPS = 1e-6f;
constexpr int O_DZ = 3200, O_DK = 3072, O_DV = 3136;
constexpr int YA_H = 0, YA_B = 256, YA_C = 512, YA_Z = 768, YB_U = 1024, YB_V = 1280, YB_Z = 1536, YC_Q = 1792, YC_K = 2048, YC_V = 2304,
              YC_Z = 2560, YD_Q = 2816, YD_Z = 3072, YD_K = 3328, YD_V = 3392, YI_Q = 3456, YI_K = 3584, YI_W = 3616;
constexpr int TOPK = 256;
constexpr int NT = 512, NW = 8;
constexpr int LDS_BYTES = 131072 + 4096;

constexpr size_t MiB = 1u << 20;
constexpr size_t WS_WTIN = 1 * MiB;
constexpr size_t WS_WTOUT = WS_WTIN + (size_t)DEPTH * YP * DM * 2;
constexpr size_t WS_SSQ = WS_WTOUT + (size_t)DEPTH * DM * DM * 2;
constexpr size_t WS_XB = WS_SSQ + (size_t)NTOK * 16 * 4;
constexpr size_t WS_Y = WS_XB + (size_t)NTOK * DM * 2;
constexpr size_t WS_MIX = WS_Y + (size_t)NTOK * YP * 2;
constexpr size_t WS_WSB = WS_MIX + (size_t)NTOK * DM * 2;
constexpr size_t WS_END = WS_WSB + (size_t)DEPTH * 4 * 128 * 128 * 2;

constexpr size_t WS_SMALL = 65536;
constexpr int SM_CONVW = 0, SM_CONVB = 3072, SM_GMLPG = 4096, SM_GMLPB = 5120, SM_QG = 7168, SM_KG = 7296, SM_LAM = 7424, SM_SUBG = 7936, SM_DQG = 8960, SM_DKG = 9216, SM_END = 9472;
struct Params {
    const float* x; const float* norm_g; const float* w_in; const float* i_conv_w; const float* i_conv_b;
    const float* i_gmlp_g; const float* gmlp_ws; const float* i_gmlp_b; const float* i_diff_qg; const float* i_diff_kg;
    const float* i_diff_lam; const float* i_diff_subg; const float* i_dsa_qg; const float* i_dsa_kg; const float* w_out;
    float* out; unsigned char* ws;
    __device__ __forceinline__ unsigned* ctl() const { return (unsigned*)ws; }
    __device__ __forceinline__ const GAS float* sm(int off) const { return (const GAS float*)(uintptr_t)(ws + WS_SMALL) + off; }
    __device__ __forceinline__ bf16_t* wt_in() const { return (bf16_t*)(ws + WS_WTIN); }
    __device__ __forceinline__ bf16_t* wt_out() const { return (bf16_t*)(ws + WS_WTOUT); }
    __device__ __forceinline__ float* ssq() const { return (float*)(ws + WS_SSQ); }
    __device__ __forceinline__ bf16_t* xb() const { return (bf16_t*)(ws + WS_XB); }
    __device__ __forceinline__ bf16_t* Y() const { return (bf16_t*)(ws + WS_Y); }
    __device__ __forceinline__ bf16_t* mix() const { return (bf16_t*)(ws + WS_MIX); }
    __device__ __forceinline__ bf16_t* wsb() const { return (bf16_t*)(ws + WS_WSB); }
};

#ifndef TSEG
#define TSEG -1
#endif
constexpr int TCTR_OFF = 131072 + 3072;
#define TB(id, ldsbase, tidv) do { if (TSEG == (id) && blockIdx.x == 0 && (tidv) == 0) *(volatile LAS unsigned long long*)((ldsbase) + TCTR_OFF + 8) = __builtin_amdgcn_s_memrealtime(); } while (0)
#define TE(id, ldsbase, tidv) do { if (TSEG == (id) && blockIdx.x == 0 && (tidv) == 0) { const unsigned _d = (unsigned)(__builtin_amdgcn_s_memrealtime() - *(volatile LAS unsigned long long*)((ldsbase) + TCTR_OFF + 8)); *(volatile LAS unsigned*)((ldsbase) + TCTR_OFF) += _d; } } while (0)
__device__ __forceinline__ unsigned f2bf(float f) { unsigned u = __float_as_uint(f); return (u + 0x7fffu + ((u >> 16) & 1u)) >> 16; }
__device__ __forceinline__ unsigned pk2(float lo, float hi) { return f2bf(lo) | (f2bf(hi) << 16); }
__device__ __forceinline__ float bf2f(bf16_t b) { return __uint_as_float((unsigned)b << 16); }

__device__ __forceinline__ float xsum32(float v) { const auto r = __builtin_amdgcn_permlane32_swap(__float_as_uint(v), __float_as_uint(v), false, false); return __uint_as_float(r[0]) + __uint_as_float(r[1]); }
__device__ __forceinline__ float xmax32(float v) { const auto r = __builtin_amdgcn_permlane32_swap(__float_as_uint(v), __float_as_uint(v), false, false); return fmaxf(__uint_as_float(r[0]), __uint_as_float(r[1])); }
__device__ __forceinline__ int xsum32i(int v) { const auto r = __builtin_amdgcn_permlane32_swap((unsigned)v, (unsigned)v, false, false); return (int)(r[0] + r[1]); }
__device__ __forceinline__ float xsum16(float v) { const auto r = __builtin_amdgcn_permlane16_swap(__float_as_uint(v), __float_as_uint(v), false, false); return __uint_as_float(r[0]) + __uint_as_float(r[1]); }
__device__ __forceinline__ float wave_sum(float v) {
#pragma unroll
    for (int o = 32; o > 0; o >>= 1) v += __shfl_xor(v, o);
    return v;
}
__device__ __forceinline__ float wave_max(float v) {
#pragma unroll
    for (int o = 32; o > 0; o >>= 1) v = fmaxf(v, __shfl_xor(v, o));
    return v;
}
__device__ __forceinline__ int wave_sumi(int v) {
#pragma unroll
    for (int o = 32; o > 0; o >>= 1) v += __shfl_xor(v, o);
    return v;
}
__device__ __forceinline__ float block_sum(float v, float* red) {
    v = wave_sum(v);
    __syncthreads();
    if ((threadIdx.x & 63) == 0) red[threadIdx.x >> 6] = v;
    __syncthreads();
    float s = 0.f;
#pragma unroll
    for (int i = 0; i < NW; ++i) s += red[i];
    return s;
}
__device__ __forceinline__ float block_max(float v, float* red) {
    v = wave_max(v);
    __syncthreads();
    if ((threadIdx.x & 63) == 0) red[threadIdx.x >> 6] = v;
    __syncthreads();
    float s = red[0];
#pragma unroll
    for (int i = 1; i < NW; ++i) s = fmaxf(s, red[i]);
    return s;
}
__device__ __forceinline__ int block_sumi(int v, int* red) {
    v = wave_sumi(v);
    __syncthreads();
    if ((threadIdx.x & 63) == 0) red[threadIdx.x >> 6] = v;
    __syncthreads();
    int s = 0;
#pragma unroll
    for (int i = 0; i < NW; ++i) s += red[i];
    return s;
}
__device__ __forceinline__ int block_excl_scan(int v, int* red, int* tot) {
    const int lane = threadIdx.x & 63, w = threadIdx.x >> 6;
    int inc = v;
#pragma unroll
    for (int o = 1; o < 64; o <<= 1) { int n = __shfl_up(inc, o); if (lane >= o) inc += n; }
    __syncthreads();
    if (lane == 63) red[w] = inc;
    __syncthreads();
    int base = 0, t = 0;
#pragma unroll
    for (int i = 0; i < NW; ++i) { if (i < w) base += red[i]; t += red[i]; }
    *tot = t;
    return base + inc - v;
}

__device__ __forceinline__ int phys2logical(int n) { const int p = n & 255; return (n & ~255) + 64 * ((p >> 5) & 3) + 32 * (p >> 7) + (p & 31); }
__device__ __forceinline__ int logical2orig(int n) {
    if (n < 3072) return n;
    if (n < YD_K) return n - YD_Z + O_DZ;
    if (n < YD_V) return n - YD_K + O_DK;
    if (n < YI_Q) return n - YD_V + O_DV;
    if (n < NIN) return n;
    return -1;
}
__device__ __forceinline__ void transpose_item(const float* W, int ldn, const float* gk, bf16_t* WT, int k0, int n0, int src, LAS float* scr, int lane) {
#pragma unroll 8
    for (int i = 0; i < 32; ++i) {
        const int kk = 2 * i + (lane >> 5);
        float v = 0.f;
        if (src >= 0) { v = W[(size_t)(k0 + kk) * ldn + src]; if (gk) v *= gk[k0 + kk]; }
        scr[kk * 33 + (lane & 31)] = v;
    }
    asm volatile("s_waitcnt lgkmcnt(0)" ::: "memory");
    const int c = lane & 7;
#pragma unroll
    for (int j = 0; j < 4; ++j) {
        const int n = (lane >> 3) + 8 * j; const LAS float* s = scr + (8 * c) * 33 + n;
        u32x4 o; o.x = pk2(s[0 * 33], s[1 * 33]); o.y = pk2(s[2 * 33], s[3 * 33]); o.z = pk2(s[4 * 33], s[5 * 33]); o.w = pk2(s[6 * 33], s[7 * 33]);
        *(GAS u32x4*)(uintptr_t)(WT + (size_t)(n0 + n) * DM + k0 + 8 * c) = o;
    }
    asm volatile("s_waitcnt lgkmcnt(0)" ::: "memory");
}
__device__ __forceinline__ int tid_now(int wave_s) { int lane; asm volatile("v_mbcnt_lo_u32_b32 %0, -1, 0\n\tv_mbcnt_hi_u32_b32 %0, -1, %0" : "=v"(lane)); return wave_s * 64 + lane; }
__device__ __forceinline__ void ph_prologue(const Params& p, LAS unsigned char* lds, int tid_in) {
    int tid = tid_in; asm volatile("" : "+v"(tid));
    const int lane = tid & 63, wave = tid >> 6;
    LAS float* scr = (LAS float*)(lds + wave * 8704);
    const int gw = blockIdx.x * NW + wave, ngw = gridDim.x * NW;
    constexpr int I_IN = DEPTH * 16 * (YP / 32), I_OUT = DEPTH * 16 * (DM / 32);
    for (int it = gw; it < I_IN + I_OUT; it += ngw) {
        if (it < I_IN) {
            const int l = it / (16 * (YP / 32)), r = it % (16 * (YP / 32)), kb = r / (YP / 32), nb = r % (YP / 32);
            const int src = logical2orig(phys2logical(nb * 32 + (lane & 31)));
            transpose_item(p.w_in + (size_t)l * DM * NIN, NIN, p.norm_g + l * DM, p.wt_in() + (size_t)l * YP * DM, kb * 64, nb * 32, src, scr, lane);
        } else {
            const int q = it - I_IN, l = q / (16 * (DM / 32)), r = q % (16 * (DM / 32)), kb = r / (DM / 32), nb = r % (DM / 32);
            transpose_item(p.w_out + (size_t)l * DM * DM, DM, nullptr, p.wt_out() + (size_t)l * DM * DM, kb * 64, nb * 32, nb * 32 + (lane & 31), scr, lane);
        }
    }
    if (blockIdx.x == 0) {
        float* sm = (float*)(p.ws + WS_SMALL);
        for (int i = tid; i < SM_END; i += NT) {
            float v;
            if (i < SM_CONVB) v = p.i_conv_w[i - SM_CONVW]; else if (i < SM_GMLPG) v = p.i_conv_b[i - SM_CONVB]; else if (i < SM_GMLPB) v = p.i_gmlp_g[i - SM_GMLPG];
            else if (i < SM_QG) v = p.i_gmlp_b[i - SM_GMLPB]; else if (i < SM_KG) v = p.i_diff_qg[i - SM_QG]; else if (i < SM_LAM) v = p.i_diff_kg[i - SM_KG];
            else if (i < SM_SUBG) v = p.i_diff_lam[i - SM_LAM]; else if (i < SM_DQG) v = p.i_diff_subg[i - SM_SUBG]; else if (i < SM_DKG) v = p.i_dsa_qg[i - SM_DQG];
            else v = p.i_dsa_kg[i - SM_DKG];
            sm[i] = v;
        }
    }
    for (int i = (blockIdx.x * NT + tid) * 4; i < DEPTH * 4 * 128 * 128; i += gridDim.x * NT * 4) {
        const f32x4 v = *(const GAS f32x4*)(uintptr_t)(p.gmlp_ws + i);
        *(GAS unsigned long long*)(uintptr_t)(p.wsb() + i) = (unsigned long long)pk2(v.x, v.y) | ((unsigned long long)pk2(v.z, v.w) << 32);
    }
    for (int r = gw; r < NTOK; r += ngw) {
        const f32x4* xr = (const f32x4*)(p.x + (size_t)r * DM) + lane;
        unsigned long long* o8 = (unsigned long long*)(p.xb() + (size_t)r * DM) + lane;
        float s = 0.f;
#pragma unroll
        for (int j = 0; j < 4; ++j) {
            const f32x4 v = xr[64 * j];
            s += (v.x * v.x + v.y * v.y) + (v.z * v.z + v.w * v.w);
            o8[64 * j] = (unsigned long long)pk2(v.x, v.y) | ((unsigned long long)pk2(v.z, v.w) << 32);
        }
        s = wave_sum(s);
        if (lane < 16) p.ssq()[(size_t)r * 16 + lane] = lane == 0 ? s : 0.f;
    }
}

__device__ __forceinline__ float silu_f(float v) { return v * __builtin_amdgcn_rcpf(1.f + __builtin_amdgcn_exp2f(-1.4426950408889634f * v)); }
struct EpiIn {
    static constexpr bool PERM = true, AFTER_DRAIN = false;
    unsigned char* ws; int l; LAS float* rs;
    __device__ __forceinline__ void operator()(const f32x4 (&acc)[2][2][4][2], const Unit& u, int wr, int wc, int fr_, int fq_) const {
        int fr = fr_, fq = fq_; asm volatile("" : "+v"(fr), "+v"(fq));
        const int pn = u.pn;
        bf16_t* Y = (bf16_t*)(ws + WS_Y); const float* ssq = (const float*)(ws + WS_SSQ); const float* smb = (const float*)(ws + WS_SMALL);
        const float* gmlp_g = smb + SM_GMLPG + l * 256; const float* qg = smb + SM_QG + l * 32; const float* kg = smb + SM_KG + l * 32;
        const float* dqg = smb + SM_DQG + l * 64; const float* dkg = smb + SM_DKG + l * 64;
        int op = 0; const float* g0 = nullptr; const float* g1 = nullptr;
        if (pn == 3 || pn == 6 || pn == 10 || pn == 12) op = 1;
        else if (pn == 4) op = 2;
        else if (pn == 5) { op = 3; g0 = gmlp_g + 64 * wc + 8 * fq; g1 = g0 + 32; }
        else if (pn == 7) { op = 4; g0 = qg + 8 * fq; g1 = g0; }
        else if (pn == 8) { op = 4; g0 = kg + 8 * fq; g1 = g0; }
        else if (pn == 11) { op = 5; g0 = dqg + 8 * fq; g1 = g0 + 32; }
        else if (pn == 13 && wc == 0) { op = 5; g0 = dkg + 8 * fq; g1 = g0 + 32; }
        float gn[16];
#pragma unroll
        for (int i = 0; i < 16; ++i) gn[i] = 1.f;
        if (op >= 3) {
            const f32x4 a = *(const GAS f32x4*)(uintptr_t)g0, b = *(const GAS f32x4*)(uintptr_t)(g0 + 4), c = *(const GAS f32x4*)(uintptr_t)g1, d = *(const GAS f32x4*)(uintptr_t)(g1 + 4);
            gn[0] = a.x; gn[1] = a.y; gn[2] = a.z; gn[3] = a.w; gn[4] = b.x; gn[5] = b.y; gn[6] = b.z; gn[7] = b.w;
            gn[8] = c.x; gn[9] = c.y; gn[10] = c.z; gn[11] = c.w; gn[12] = d.x; gn[13] = d.y; gn[14] = d.z; gn[15] = d.w;
        }
        const int colb = pn * 256 + 64 * wc + 8 * fq;
        {
            const int t = wr * 256 + wc * 64 + fq * 16 + fr;
            if (t < 256) {
                const f32x4* sp = (const f32x4*)(ssq + (size_t)(u.pm * 256 + t) * 16);
                const f32x4 s0 = sp[0], s1 = sp[1], s2 = sp[2], s3 = sp[3];
                const float tot = ((s0.x + s0.y) + (s0.z + s0.w)) + ((s1.x + s1.y) + (s1.z + s1.w)) + ((s2.x + s2.y) + (s2.z + s2.w)) + ((s3.x + s3.y) + (s3.z + s3.w));
                rs[t] = rsqrtf(tot * (1.f / DM) + EPS);
            }
            asm volatile("s_waitcnt vmcnt(0) lgkmcnt(0)" ::: "memory"); __builtin_amdgcn_s_barrier(); asm volatile("" ::: "memory");
        }
#pragma unroll
        for (int ai = 0; ai < 2; ++ai)
#pragma unroll
            for (int m = 0; m < 4; ++m) {
                const int row = u.pm * 256 + ai * 128 + wr * 64 + m * 16 + fr;
                const float rstd = rs[ai * 128 + wr * 64 + m * 16 + fr];
                float v[16];
#pragma unroll
                for (int bj = 0; bj < 2; ++bj)
#pragma unroll
                    for (int n = 0; n < 2; ++n)
#pragma unroll
                        for (int e = 0; e < 4; ++e) v[bj * 8 + n * 4 + e] = acc[ai][bj][m][n][e] * rstd;
                if (op == 1) {
#pragma unroll
                    for (int i = 0; i < 16; ++i) v[i] = silu_f(v[i]);
                } else if (op == 2 || op == 3) {
#pragma unroll
                    for (int i = 0; i < 16; i += 2) { const pg8::f32x2 r = pg8::gelu_pk((pg8::f32x2){v[i], v[i + 1]}); v[i] = r.x; v[i + 1] = r.y; }
                }
                if (op == 3 || op == 5) {
                    float ss = 0.f;
#pragma unroll
                    for (int i = 0; i < 16; ++i) ss += v[i] * v[i];
                    ss = xsum16(ss); ss = xsum32(ss);
                    const float sc = rsqrtf(ss * (1.f / 64) + EPS);
#pragma unroll
                    for (int i = 0; i < 16; ++i) v[i] *= sc * gn[i];
                } else if (op == 4) {
#pragma unroll
                    for (int bj = 0; bj < 2; ++bj) {
                        float ss = 0.f;
#pragma unroll
                        for (int i = 0; i < 8; ++i) ss += v[bj * 8 + i] * v[bj * 8 + i];
                        ss = xsum16(ss); ss = xsum32(ss);
                        const float sc = rsqrtf(ss * (1.f / 32) + EPS);
#pragma unroll
                        for (int i = 0; i < 8; ++i) v[bj * 8 + i] *= sc * gn[bj * 8 + i];
                    }
                }
                bf16_t* rowp = Y + (size_t)row * YP + colb;
#pragma unroll
                for (int bj = 0; bj < 2; ++bj) {
                    u32x4 w; w.x = pg8::cvt_pk_bf16(v[bj * 8 + 0], v[bj * 8 + 1]); w.y = pg8::cvt_pk_bf16(v[bj * 8 + 2], v[bj * 8 + 3]);
                    w.z = pg8::cvt_pk_bf16(v[bj * 8 + 4], v[bj * 8 + 5]); w.w = pg8::cvt_pk_bf16(v[bj * 8 + 6], v[bj * 8 + 7]);
                    *(GAS u32x4*)(uintptr_t)(rowp + 32 * bj) = w;
                }
            }
    }
};
struct EpiOut {
    static constexpr bool PERM = false, AFTER_DRAIN = false;
    float* xout; unsigned char* ws;
    __device__ __forceinline__ void operator()(const f32x4 (&acc)[2][2][4][2], const Unit& u, int wr, int wc, int fr_, int fq_) const {
        int fr = fr_, fq = fq_; asm volatile("" : "+v"(fr), "+v"(fq));
        const int col0 = u.pn * 256 + wc * 32 + 4 * fq;
        bf16_t* xb = (bf16_t*)(ws + WS_XB); float* ssq = (float*)(ws + WS_SSQ);
#pragma unroll
        for (int ai = 0; ai < 2; ++ai)
#pragma unroll
            for (int m = 0; m < 4; ++m) {
                const int row = u.pm * 256 + ai * 128 + wr * 64 + m * 16 + fr;
                float sq = 0.f;
#pragma unroll
                for (int bj = 0; bj < 2; ++bj)
#pragma unroll
                    for (int n = 0; n < 2; ++n) {
                        const size_t off = (size_t)row * DM + col0 + bj * 128 + n * 16;
                        const unsigned long long xo = *(const GAS unsigned long long*)(uintptr_t)(xb + off);
                        f32x4 v = acc[ai][bj][m][n];
                        v.x += __uint_as_float((unsigned)xo << 16); v.y += __uint_as_float((unsigned)xo & 0xffff0000u);
                        v.z += __uint_as_float((unsigned)(xo >> 32) << 16); v.w += __uint_as_float((unsigned)(xo >> 32) & 0xffff0000u);
                        sq += (v.x * v.x + v.y * v.y) + (v.z * v.z + v.w * v.w);
                        if (xout) *(GAS f32x4*)(uintptr_t)(xout + off) = v;
                        else *(GAS unsigned long long*)(uintptr_t)(xb + off) = (unsigned long long)pg8::cvt_pk_bf16(v.x, v.y) | ((unsigned long long)pg8::cvt_pk_bf16(v.z, v.w) << 32);
                    }
                sq = xsum16(sq); sq = xsum32(sq);
                if (fq == 0) ssq[(size_t)row * 16 + u.pn * 4 + wc] = sq;
                if (m == 3) asm volatile("" ::: "memory");
            }
    }
};
#define XB_TMO      128
#define XB_XCNT(j)  (256  + 64 * (j))
#define XB_XSUB(j)  (1280 + 64 * (j))
#define XB_XGEN(j)  (2304 + 64 * (j))
#define XB_TOP      3328
#define XB_TOPGEN   3392
#define XCD_BAR_WORDS 3456
#define XB_SPIN_CAP (1u << 18)

__device__ __forceinline__ unsigned xb_ld(unsigned* p)              { return __hip_atomic_load(p, __ATOMIC_RELAXED, __HIP_MEMORY_SCOPE_AGENT); }
__device__ __forceinline__ unsigned xb_add(unsigned* p, unsigned v) { return __hip_atomic_fetch_add(p, v, __ATOMIC_RELAXED, __HIP_MEMORY_SCOPE_AGENT); }
__device__ __forceinline__ unsigned xb_xcc_id() { return (unsigned)__builtin_amdgcn_s_getreg((3 << 11) | 20) & 0xFu; }
#define XB_SPIN(cond, bar) do { unsigned _sp = 0; while (cond) { __builtin_amdgcn_s_sleep(1); \
    if ((++_sp & 255u) == 0u) { if (xb_ld(&(bar)[XB_TMO])) break; if (_sp > XB_SPIN_CAP) { atomicAdd(&(bar)[XB_TMO], 1u); break; } } } } while (0)

struct XcdBarrier {
    unsigned* bar; unsigned x;
    volatile LAS unsigned* st;
};

__device__ __forceinline__ XcdBarrier xcd_barrier_post(unsigned* bar, volatile LAS unsigned* st) {
    XcdBarrier b; b.bar = bar; b.x = xb_xcc_id(); b.st = st;
    if (threadIdx.x == 0) (void)xb_add(&bar[XB_XCNT(b.x)], 1u);
    return b;
}
__device__ __forceinline__ void xcd_barrier_complete(unsigned* bar, unsigned x, unsigned& nloc, unsigned& nx) {
    const unsigned G = gridDim.x * gridDim.y * gridDim.z;
    unsigned sum, cnt, mine, sp = 0u;
    for (;;) {
        sum = 0u; cnt = 0u; mine = 0u;
#pragma unroll
        for (unsigned j = 0; j < 16; ++j) { const unsigned c = xb_ld(&bar[XB_XCNT(j)]); sum += c; cnt += (c > 0u) ? 1u : 0u; mine = (j == x) ? c : mine; }
        if (sum == G) break;
        __builtin_amdgcn_s_sleep(1);
        if ((++sp & 255u) == 0u) { if (xb_ld(&bar[XB_TMO])) break; if (sp > XB_SPIN_CAP) { atomicAdd(&bar[XB_TMO], 1u); break; } }
    }
    nloc = mine > 0u ? mine : 1u; nx = cnt > 0u ? cnt : 1u;
}

__device__ __forceinline__ void xcd_barrier(const XcdBarrier& b, int tid_in) {
    asm volatile("s_waitcnt vmcnt(0)" ::: "memory");
    __syncthreads();
    int t0_ = tid_in; asm volatile("" : "+v"(t0_));
    if (t0_ == 0) {
        unsigned* bar = b.bar;
        __builtin_amdgcn_s_waitcnt(0);
        unsigned nloc = b.st[0], nx = b.st[1];
        if (nloc == 0u) { xcd_barrier_complete(bar, b.x, nloc, nx); b.st[0] = nloc; b.st[1] = nx; }
        const unsigned old = xb_add(&bar[XB_XSUB(b.x)], 1u);
        const unsigned gen = old / nloc;
        if (old + 1u == (gen + 1u) * nloc) {
            __builtin_amdgcn_fence(__ATOMIC_RELEASE, "agent");
            asm volatile("s_waitcnt vmcnt(0)" ::: "memory");
            const unsigned og = xb_add(&bar[XB_TOP], 1u);
            const unsigned tg = og / nx;
            if (og + 1u == (tg + 1u) * nx) xb_add(&bar[XB_TOPGEN], 1u);
            else XB_SPIN(xb_ld(&bar[XB_TOPGEN]) == tg, bar);
            __builtin_amdgcn_fence(__ATOMIC_ACQUIRE, "agent");
            xb_add(&bar[XB_XGEN(b.x)], 1u);
            asm volatile("s_waitcnt vmcnt(0)" ::: "memory");
        } else {
            XB_SPIN(xb_ld(&bar[XB_XGEN(b.x)]) == gen, bar);
            __builtin_amdgcn_fence(__ATOMIC_ACQUIRE, "agent");
            asm volatile("s_waitcnt vmcnt(0)" ::: "memory");
        }
    }
    __syncthreads();
}

typedef short bf16x8_t __attribute__((ext_vector_type(8)));
typedef short s16x4_t __attribute__((ext_vector_type(4)));
typedef float f32x16 __attribute__((ext_vector_type(16)));
typedef float f32x2_t __attribute__((ext_vector_type(2)));
typedef __bf16 bf16x2_t __attribute__((ext_vector_type(2)));
#define MFMA32(a, b, c) __builtin_amdgcn_mfma_f32_32x32x16_bf16((a), (b), (c), 0, 0, 0)
__device__ __forceinline__ unsigned cvtpk(float lo, float hi) { f32x2_t v = {lo, hi}; bf16x2_t b = __builtin_convertvector(v, bf16x2_t); return __builtin_bit_cast(unsigned, b); }
__device__ __forceinline__ s16x4_t ds_tr16(const LAS unsigned char* p) { return __builtin_bit_cast(s16x4_t, __builtin_amdgcn_ds_read_tr16_b64_v4i16((LAS s16x4_t*)p)); }
__device__ __forceinline__ bf16x8_t pack_step(const f32x16& x, int s) {
    u32x4 p; p.x = cvtpk(x[8 * s], x[8 * s + 1]); p.y = cvtpk(x[8 * s + 2], x[8 * s + 3]); p.z = cvtpk(x[8 * s + 4], x[8 * s + 5]); p.w = cvtpk(x[8 * s + 6], x[8 * s + 7]);
    return __builtin_bit_cast(bf16x8_t, p);
}
constexpr int KV_STRIDE = 144;
constexpr int KV_TILE = 64 * KV_STRIDE;
__device__ __forceinline__ bf16x8_t vt_frag(const LAS unsigned char* vtile, int ks, int db, int lane) {
    const int i16 = lane & 15, q = i16 >> 2, pp = i16 & 3, blk = (lane >> 4) & 1, hh = lane >> 5;
    const LAS unsigned char* a = vtile + (16 * ks + 4 * hh + q) * KV_STRIDE + (32 * db + 16 * blk + 4 * pp) * 2;
    const s16x4_t lo = ds_tr16(a), hi = ds_tr16(a + 8 * KV_STRIDE);
    return __builtin_shufflevector(lo, hi, 0, 1, 2, 3, 4, 5, 6, 7);
}

constexpr int KVL_TILE = 64 * 128;
__device__ __forceinline__ void dma_piece(const bf16_t* src_row0, LAS unsigned char* dst, int lane) {
    const bf16_t* g = src_row0 + (size_t)(lane >> 3) * YP + (((lane & 7) ^ (lane >> 3)) * 8);
    const unsigned d = (unsigned)__builtin_amdgcn_readfirstlane((int)(unsigned)(size_t)dst);
    unsigned keep;
    asm volatile("s_mov_b32 %0, m0\n\ts_mov_b32 m0, %2\n\ts_nop 0\n\tglobal_load_lds_dwordx4 %1, off\n\ts_mov_b32 m0, %0" : "=&s"(keep) : "v"(g), "s"(d) : "memory");
}
__device__ __forceinline__ bf16x8_t vt_frag_sw(const LAS unsigned char* vtile, int ks, int db, int lane) {
    const int i16 = lane & 15, q = i16 >> 2, pp = i16 & 3, blk = (lane >> 4) & 1, hh = lane >> 5;
    const int row = 16 * ks + 4 * hh + q, ch = 4 * db + 2 * blk + (pp >> 1);
    const LAS unsigned char* a = vtile + row * 128 + ((ch ^ (row & 7)) * 16) + (pp & 1) * 8;
    const s16x4_t lo = ds_tr16(a), hi = ds_tr16(a + 8 * 128);
    return __builtin_shufflevector(lo, hi, 0, 1, 2, 3, 4, 5, 6, 7);
}

__device__ __forceinline__ void mixC_unit(const Params& p, int l, int b, int h, int qt, LAS unsigned char* lds, int wave_s) {
    const int tid = tid_now(wave_s);
    volatile LAS float* pc = (volatile LAS float*)(lds + 131072 + 2048);
    const float mfix = pc[0];
    const int lane = tid & 63, wave = __builtin_amdgcn_readfirstlane(tid >> 6), r32 = lane & 31, hh = lane >> 5;
    const size_t rowb = (size_t)b * SEQ;
    const int q0 = qt * 256 + wave * 32;
    const int cw = (q0 >> 6);
    const int jmax = 4 * qt + 3;
    const int pos = q0 + r32;
    const bf16_t* yq = p.Y() + (rowb + pos) * YP;
    bf16x8_t qf[2][2];
#pragma unroll
    for (int c = 0; c < 2; ++c)
#pragma unroll
        for (int s = 0; s < 2; ++s) qf[c][s] = *(const GAS bf16x8_t*)(uintptr_t)(yq + YC_Q + h * 64 + c * 32 + 16 * s + 8 * hh);
    const float c1 = 0.17677669529663687f * 1.4426950408889634f;
    const float sl2 = exp2f(-(float)(2 * h + 1)) * 1.4426950408889634f;
    f32x16 o[2][2];
#pragma unroll
    for (int c = 0; c < 2; ++c)
#pragma unroll
        for (int d = 0; d < 2; ++d)
#pragma unroll
            for (int i = 0; i < 16; ++i) o[c][d][i] = 0.f;
    float lrun[2] = {0.f, 0.f};
    const bf16_t* ksrc = p.Y() + (rowb + 8 * wave) * YP + YC_K + h * 64;
    const bf16_t* vsrc = p.Y() + (rowb + 8 * wave) * YP + YC_V + h * 64;
    LAS unsigned char* kring = lds;
    LAS unsigned char* vring = lds + 3 * KVL_TILE;
    asm volatile("" : "+v"(qf[0][0]), "+v"(qf[0][1]), "+v"(qf[1][0]), "+v"(qf[1][1]));
    const float mfix_r = mfix; asm volatile("" :: "v"(mfix_r));
    asm volatile("s_waitcnt lgkmcnt(0)" ::: "memory"); __builtin_amdgcn_s_barrier(); asm volatile("" ::: "memory");
    dma_piece(ksrc, kring + wave * 1024, lane); dma_piece(vsrc, vring + wave * 1024, lane);
    if (jmax >= 1) { dma_piece(ksrc + (size_t)64 * YP, kring + KVL_TILE + wave * 1024, lane); dma_piece(vsrc + (size_t)64 * YP, vring + KVL_TILE + wave * 1024, lane); }
    int slot = 0, slot2 = 2;
    for (int j = 0; j <= jmax; ++j) {
        TB(3, lds, tid);
        if (j < jmax) asm volatile("s_waitcnt vmcnt(2)" ::: "memory"); else asm volatile("s_waitcnt vmcnt(0)" ::: "memory");
        __builtin_amdgcn_s_barrier(); asm volatile("" ::: "memory");
        TE(3, lds, tid);
        TB(2, lds, tid);
        if (j + 2 <= jmax) { dma_piece(ksrc + (size_t)(j + 2) * 64 * YP, kring + slot2 * KVL_TILE + wave * 1024, lane); dma_piece(vsrc + (size_t)(j + 2) * 64 * YP, vring + slot2 * KVL_TILE + wave * 1024, lane); }
        if (j <= cw) {
            const LAS unsigned char* kt = kring + slot * KVL_TILE;
            const LAS unsigned char* vt = vring + slot * KVL_TILE;
            const float pl = (float)(pos - 64 * j - 4 * hh);
            const bool diag = (j == cw);
#pragma unroll
            for (int c = 0; c < 2; ++c) {
                f32x16 sc[2];
#pragma unroll
                for (int kb = 0; kb < 2; ++kb) {
                    f32x16 a;
#pragma unroll
                    for (int i = 0; i < 16; ++i) a[i] = 0.f;
#pragma unroll
                    for (int s = 0; s < 2; ++s) {
                        const bf16x8_t kf = *(const LAS bf16x8_t*)(kt + (32 * kb + r32) * 128 + (((4 * c + 2 * s + hh) ^ (r32 & 7)) * 16));
                        a = MFMA32(kf, qf[c][s], a);
                    }
                    sc[kb] = a;
                }
                float ls4[4] = {0.f, 0.f, 0.f, 0.f};
                if (!diag) {
                    const float rt = -sl2 * pl - mfix;
#pragma unroll
                    for (int kb = 0; kb < 2; ++kb)
#pragma unroll
                        for (int i = 0; i < 16; ++i) {
                            const float kc = (float)(32 * kb + (i & 3) + 8 * (i >> 2));
                            const float e = __builtin_amdgcn_exp2f(fmaf(sc[kb][i], c1, fmaf(sl2, kc, rt)));
                            sc[kb][i] = e; ls4[i & 3] += e;
                        }
                } else {
#pragma unroll
                    for (int kb = 0; kb < 2; ++kb)
#pragma unroll
                        for (int i = 0; i < 16; ++i) {
                            const float kc = (float)(32 * kb + (i & 3) + 8 * (i >> 2));
                            const float e = __builtin_amdgcn_exp2f(fmaf(sc[kb][i], c1, fmaf(-sl2, fabsf(pl - kc), -mfix)));
                            sc[kb][i] = e; ls4[i & 3] += e;
                        }
                }
                lrun[c] += (ls4[0] + ls4[1]) + (ls4[2] + ls4[3]);
#pragma unroll
                for (int ks = 0; ks < 4; ++ks) {
                    const bf16x8_t pf = pack_step(sc[ks >> 1], ks & 1);
#pragma unroll
                    for (int db = 0; db < 2; ++db) o[c][db] = MFMA32(vt_frag_sw(vt, ks, db, lane), pf, o[c][db]);
                }
            }
        }
        TE(2, lds, tid);
        slot = slot == 2 ? 0 : slot + 1; slot2 = slot2 == 2 ? 0 : slot2 + 1;
    }
    const float lam = pc[1], oml = pc[2];
    const int tid2 = tid_now(wave_s), lane2 = tid2 & 63, r32e = lane2 & 31, hhe = lane2 >> 5;
    const int pose = qt * 256 + wave * 32 + r32e;
    const bf16_t* yqe = p.Y() + (rowb + pose) * YP;
    const float l1 = xsum32(lrun[0]), l2 = xsum32(lrun[1]);
    const float i1 = 1.f / l1, i2 = lam / l2;
    float ss = 0.f;
#pragma unroll
    for (int d = 0; d < 2; ++d)
#pragma unroll
        for (int i = 0; i < 16; ++i) { const float v = o[0][d][i] * i1 - o[1][d][i] * i2; o[0][d][i] = v; ss += v * v; }
    ss = xsum32(ss);
    const float rn = rsqrtf(ss * (1.f / 64) + EPS) * oml;
    const GAS float* sg = p.sm(SM_SUBG) + l * 256 + h * 64;
    bf16_t* mrow = p.mix() + (rowb + pose) * DM + 512 + h * 64;
#pragma unroll
    for (int d = 0; d < 2; ++d)
#pragma unroll
        for (int g = 0; g < 4; ++g) {
            const int d0 = 32 * d + 8 * g + 4 * hhe;
            const f32x4 gv = *(const GAS f32x4*)(uintptr_t)(sg + d0);
            const unsigned long long zz = *(const GAS unsigned long long*)(uintptr_t)(yqe + YC_Z + h * 64 + d0);
            const float z0 = __uint_as_float((unsigned)(zz & 0xffffu) << 16), z1 = __uint_as_float((unsigned)((zz >> 16) & 0xffffu) << 16),
                        z2 = __uint_as_float((unsigned)((zz >> 32) & 0xffffu) << 16), z3 = __uint_as_float((unsigned)((zz >> 48) & 0xffffu) << 16);
            const float v0 = o[0][d][4 * g] * rn * gv.x * z0, v1 = o[0][d][4 * g + 1] * rn * gv.y * z1, v2 = o[0][d][4 * g + 2] * rn * gv.z * z2, v3 = o[0][d][4 * g + 3] * rn * gv.w * z3;
            *(GAS unsigned long long*)(uintptr_t)(mrow + d0) = (unsigned long long)cvtpk(v0, v1) | ((unsigned long long)cvtpk(v2, v3) << 32);
        }
}
__device__ __forceinline__ void ph_mixC(const Params& p, int l, LAS unsigned char* lds, int bid, int nb, int wave_s) {
    {
        const float lam_init = l == 0 ? 0.200000001f : l == 1 ? 0.355509068f : l == 2 ? 0.470713018f : 0.556058204f;
        const GAS float* lp = p.sm(SM_LAM) + l * 128;
        float d1 = 0.f, d2 = 0.f;
        for (int i = 0; i < 32; ++i) { d1 += lp[i] * lp[32 + i]; d2 += lp[64 + i] * lp[96 + i]; }
        float gq = 0.f, gk = 0.f;
        for (int i = 0; i < 32; ++i) { gq = fmaxf(gq, fabsf(p.sm(SM_QG)[l * 32 + i])); gk = fmaxf(gk, fabsf(p.sm(SM_KG)[l * 32 + i])); }
        volatile LAS float* pc = (volatile LAS float*)(lds + 131072 + 2048);
        if (tid_now(wave_s) == 0) {
            pc[0] = 0.17677669529663687f * 1.4426950408889634f * 32.f * gq * gk * 1.02f;
            pc[1] = expf(d1) - expf(d2) + lam_init;
            pc[2] = 1.f - lam_init;
        }
        __syncthreads();
    }
    for (int i = bid; i < 256; i += nb) {
#pragma unroll 1
        for (int k = 0; k < 2; ++k) {
            const int id = k == 0 ? i : 511 - i;
            const int qt = id < 256 ? 7 - (id >> 6) : 3 - ((id - 256) >> 6), bh = id & 63;
            mixC_unit(p, l, bh >> 2, bh & 3, qt, lds, wave_s);
        }
    }
}

constexpr int SC_STRIDE = 2052;
constexpr int SC_BYTES = 16 * SC_STRIDE * 4;
constexpr int IK_STRIDE = 80, IK_TILE = 64 * IK_STRIDE;
__device__ __forceinline__ unsigned fkey(float f) { const unsigned u = __float_as_uint(f); return (u & 0x80000000u) ? ~u : (u | 0x80000000u); }
__device__ __forceinline__ float unfkey(unsigned k) { return __uint_as_float((k & 0x80000000u) ? (k & 0x7fffffffu) : ~k); }
__device__ __forceinline__ f32x16 idx_scores(const bf16x8_t ik0, const bf16x8_t ik1, const bf16x8_t (&iqf)[4][2], const float (&w)[4]) {
    f32x16 sc;
#pragma unroll
    for (int i = 0; i < 16; ++i) sc[i] = 0.f;
#pragma unroll
    for (int hd = 0; hd < 4; ++hd) {
        f32x16 a;
#pragma unroll
        for (int i = 0; i < 16; ++i) a[i] = 0.f;
        a = MFMA32(ik0, iqf[hd][0], a);
        a = MFMA32(ik1, iqf[hd][1], a);
#pragma unroll
        for (int i = 0; i < 16; ++i) sc[i] = fmaf(w[hd], __builtin_amdgcn_fmed3f(a[i], 0.f, __builtin_inff()), sc[i]);
    }
#pragma unroll
    for (int i = 0; i < 16; ++i) sc[i] = sc[i] + 0.f;
    return sc;
}
__device__ __forceinline__ void transpose32(unsigned (&a)[32]) {
#pragma unroll
    for (int s = 0; s < 5; ++s) {
        const int j = 16 >> s;
        const unsigned mk = j == 16 ? 0x0000ffffu : j == 8 ? 0x00ff00ffu : j == 4 ? 0x0f0f0f0fu : j == 2 ? 0x33333333u : 0x55555555u;
#pragma unroll
        for (int k = 0; k < 32; ++k)
            if ((k & j) == 0) { const unsigned t = (a[k] ^ (a[k + j] >> j)) & mk; a[k] ^= t; a[k + j] ^= t << j; asm volatile("" : "+v"(a[k]), "+v"(a[k + j])); }
    }
}
__device__ __forceinline__ int rowsum16(int v) {
    v += __builtin_amdgcn_update_dpp(0, v, 0x128, 0xf, 0xf, true);
    v += __builtin_amdgcn_update_dpp(0, v, 0x124, 0xf, 0xf, true);
    v += __builtin_amdgcn_update_dpp(0, v, 0x122, 0xf, 0xf, true);
    v += __builtin_amdgcn_update_dpp(0, v, 0x121, 0xf, 0xf, true);
    return v;
}
__device__ __forceinline__ unsigned topbits(int ne) { return ne <= 0 ? 0u : ne >= 32 ? 0xffffffffu : (0xffffffffu << (32 - ne)); }
template <int ST>
__device__ __forceinline__ void rs4_row(const unsigned (&pl)[4][32], unsigned (&alive)[4], int& above, unsigned& prefix, bool& done, bool& alld, int nmr) {
    if (!alld) {
        int c11 = 0, c10 = 0, c01 = 0;
#pragma unroll
        for (int j = 0; j < 4; ++j)
            if (j < nmr) {
                const unsigned p1 = pl[j][2 * ST], p0 = pl[j][2 * ST + 1], a1 = alive[j] & p1, a0 = alive[j] & ~p1;
                c11 += __popc(a1 & p0); c10 += __popc(a1 & ~p0); c01 += __popc(a0 & p0);
            }
        const int s01 = rowsum16(c11 | (c10 << 16)), s2 = rowsum16(c01);
        if (!done) {
            const int t11 = above + (s01 & 0xffff), t10 = t11 + (int)((unsigned)s01 >> 16), t01 = t10 + s2;
            const int dg = t11 >= TOPK ? 3 : t10 >= TOPK ? 2 : t01 >= TOPK ? 1 : 0;
            const int tsel = dg == 3 ? t11 : dg == 2 ? t10 : t01;
            prefix |= (unsigned)dg << (30 - 2 * ST);
            above = dg == 3 ? above : dg == 2 ? t11 : dg == 1 ? t10 : t01;
#pragma unroll
            for (int j = 0; j < 4; ++j)
                if (j < nmr) {
                    const unsigned p1 = pl[j][2 * ST], p0 = pl[j][2 * ST + 1];
                    alive[j] &= ((dg & 2) ? p1 : ~p1) & ((dg & 1) ? p0 : ~p0);
                }
            if (dg != 0 && tsel == TOPK) done = true;
        }
        alld = __all(done);
    }
    if constexpr (ST < 15) rs4_row<ST + 1>(pl, alive, above, prefix, done, alld, nmr);
}
__device__ __forceinline__ void mixD_attend(const Params& p, int b, int c, LAS unsigned char* lds, int wave_s);
__device__ __forceinline__ void mixD_unit(const Params& p, int b, int c, LAS unsigned char* lds, int wave_s) {
    const int tid = tid_now(wave_s);
    const int lane = tid & 63, wave = __builtin_amdgcn_readfirstlane(tid >> 6), r32 = lane & 31, hh = lane >> 5;
    const size_t rowb = (size_t)b * SEQ;
    const int q0 = c * 64, ntile = c + 1;
    LAS float* thr = (LAS float*)(lds + 131072 + 1024);
    LAS int* kcs = (LAS int*)(lds + 131072 + 1280);
    const bool dosel = c >= 4;
    __syncthreads();
    if (dosel) {
        constexpr int SKS = 1028;
        LAS unsigned* sk = (LAS unsigned*)lds;
        const int nblk = 2 * ntile;
        const int nbw = (nblk - wave + 7) >> 3;
        const int nv = 4 * ntile;
        const int nmr = (nv + 31) >> 5;
#pragma unroll 1
        for (int sp = 0; sp < 2; ++sp) {
            TB(4, lds, tid); TB(5, lds, tid);
            unsigned kr[4][32];
            unsigned zopq = 0u; asm volatile("" : "+v"(zopq));
            {
                const bf16_t* yq1 = p.Y() + (rowb + q0 + 32 * sp + r32) * YP;
                bf16x8_t iqf[4][2];
#pragma unroll
                for (int hd = 0; hd < 4; ++hd)
#pragma unroll
                    for (int s = 0; s < 2; ++s) iqf[hd][s] = *(const GAS bf16x8_t*)(uintptr_t)(yq1 + YI_Q + hd * 32 + 16 * s + 8 * hh);
                float w[4];
                const unsigned long long ww = *(const GAS unsigned long long*)(uintptr_t)(yq1 + YI_W);
#pragma unroll
                for (int hd = 0; hd < 4; ++hd) w[hd] = __uint_as_float((unsigned)((ww >> (16 * hd)) & 0xffffu) << 16) * (0.17677669529663687f * 0.5f);
#pragma unroll
                for (int g = 0; g < 2; ++g) {
                    bf16x8_t ik[4][2];
#pragma unroll
                    for (int i = 0; i < 4; ++i) {
                        const int kb = 4 * g + i < nbw ? wave + 8 * (4 * g + i) : wave;
                        const bf16_t* yk = p.Y() + (rowb + 32 * kb + r32) * YP + YI_K + 8 * hh;
                        ik[i][0] = *(const GAS bf16x8_t*)(uintptr_t)yk; ik[i][1] = *(const GAS bf16x8_t*)(uintptr_t)(yk + 16);
                    }
#pragma unroll
                    for (int i = 0; i < 4; ++i) {
                        const int blk = 4 * g + i;
                        if (blk < nbw) {
                            const f32x16 sc = idx_scores(ik[i][0], ik[i][1], iqf, w);
#pragma unroll
                            for (int r = 0; r < 16; ++r) kr[blk >> 1][16 * (blk & 1) + r] = fkey(sc[r]);
                        } else {
#pragma unroll
                            for (int r = 0; r < 16; ++r) kr[blk >> 1][16 * (blk & 1) + r] = zopq;
                        }
                    }
                    asm volatile("" ::: "memory");
                }
            }
            TE(5, lds, tid); TB(20, lds, tid);
            unsigned pl[4][32];
            {
                const int rq = 4 * wave + (lane >> 4), rt = lane & 15;
#pragma unroll
                for (int rd = 0; rd < 2; ++rd) {
#pragma unroll
                    for (int i = 0; i < 4; ++i)
#pragma unroll
                        for (int g = 0; g < 4; ++g) {
                            const int blk = 4 * rd + i;
                            u32x4 v; v.x = kr[blk >> 1][16 * (blk & 1) + 4 * g]; v.y = kr[blk >> 1][16 * (blk & 1) + 4 * g + 1]; v.z = kr[blk >> 1][16 * (blk & 1) + 4 * g + 2]; v.w = kr[blk >> 1][16 * (blk & 1) + 4 * g + 3];
                            *(LAS u32x4*)(sk + r32 * SKS + 32 * wave + 256 * i + 8 * g + 4 * hh) = v;
                        }
                    __syncthreads();
#pragma unroll
                    for (int M = 0; M < 16; ++M) {
                        const u32x4 v = *(const LAS u32x4*)(sk + rq * SKS + 64 * M + 4 * rt);
                        pl[2 * rd + (M >> 3)][4 * (M & 7)] = v.x; pl[2 * rd + (M >> 3)][4 * (M & 7) + 1] = v.y; pl[2 * rd + (M >> 3)][4 * (M & 7) + 2] = v.z; pl[2 * rd + (M >> 3)][4 * (M & 7) + 3] = v.w;
                    }
                    __syncthreads();
                }
            }
            TE(20, lds, tid); TB(6, lds, tid);
#pragma unroll
            for (int j = 0; j < 4; ++j) transpose32(pl[j]);
            TE(6, lds, tid); TB(7, lds, tid);
            unsigned alive[4];
#pragma unroll
            for (int j = 0; j < 4; ++j) alive[j] = topbits(nv - 32 * j);
            int above = 0; unsigned prefix = 0u; bool done = false, alld = false;
            rs4_row<0>(pl, alive, above, prefix, done, alld, nmr);
            TE(7, lds, tid); TB(8, lds, tid);
            int kcut = 1 << 20;
            if (!__all(done)) {
                const int need = TOPK - above, rt = lane & 15;
                int posk = 0;
#pragma unroll 1
                for (int b2 = 10; b2 >= 0; --b2) {
                    const int tt = posk | (1 << b2);
                    const int R = tt - 4 * rt;
                    const int M = R <= 0 ? 0 : 4 * (R >> 6) + min(R & 63, 4);
                    int c = 0;
#pragma unroll
                    for (int j = 0; j < 4; ++j) c += __popc(alive[j] & topbits(M - 32 * j));
                    const int f = rowsum16(c);
                    if (f < need) posk = tt;
                }
                if (!done) kcut = posk;
            }
            TE(8, lds, tid); TE(4, lds, tid);
            if ((lane & 15) == 0) { thr[32 * sp + 4 * wave + (lane >> 4)] = unfkey(prefix); kcs[32 * sp + 4 * wave + (lane >> 4)] = kcut; }
            __syncthreads();
        }
    }
    mixD_attend(p, b, c, lds, wave_s);
}
__device__ __forceinline__ void mixD_attend(const Params& p, int b, int c, LAS unsigned char* lds, int wave_s) {
    const int tid = tid_now(wave_s);
    const int lane = tid & 63, wave = __builtin_amdgcn_readfirstlane(tid >> 6), r32 = lane & 31, hh = lane >> 5;
    const size_t rowb = (size_t)b * SEQ;
    const int q0 = c * 64, ntile = c + 1;
    LAS float* thr = (LAS float*)(lds + 131072 + 1024);
    LAS int* kcs = (LAS int*)(lds + 131072 + 1280);
    const bool dosel = c >= 4;
    TB(9, lds, tid);
    const int qg = wave >> 2, hd = wave & 3;
    const int pos = q0 + 32 * qg + r32;
    const bf16_t* yq = p.Y() + (rowb + pos) * YP;
    bf16x8_t qf[4];
#pragma unroll
    for (int s = 0; s < 4; ++s) qf[s] = *(const GAS bf16x8_t*)(uintptr_t)(yq + YD_Q + hd * 64 + 16 * s + 8 * hh);
    bf16x8_t iqf[4][2];
    float w[4];
    float T = -INFINITY; int kcut = 1 << 20;
    if (dosel) {
#pragma unroll
        for (int h2 = 0; h2 < 4; ++h2)
#pragma unroll
            for (int s = 0; s < 2; ++s) iqf[h2][s] = *(const GAS bf16x8_t*)(uintptr_t)(yq + YI_Q + h2 * 32 + 16 * s + 8 * hh);
        const unsigned long long ww = *(const GAS unsigned long long*)(uintptr_t)(yq + YI_W);
#pragma unroll
        for (int h2 = 0; h2 < 4; ++h2) w[h2] = __uint_as_float((unsigned)((ww >> (16 * h2)) & 0xffffu) << 16) * (0.17677669529663687f * 0.5f);
        T = thr[32 * qg + r32]; kcut = kcs[32 * qg + r32];
    } else {
#pragma unroll
        for (int h2 = 0; h2 < 4; ++h2) { w[h2] = 0.f;
#pragma unroll
            for (int s = 0; s < 2; ++s)
#pragma unroll
                for (int e = 0; e < 8; ++e) iqf[h2][s][e] = 0; }
    }
    const float c1 = 0.125f * 1.4426950408889634f;
    const float sl2 = exp2f(-(float)(2 * hd + 2)) * 1.4426950408889634f;
    f32x16 o[2];
#pragma unroll
    for (int d = 0; d < 2; ++d)
#pragma unroll
        for (int i = 0; i < 16; ++i) o[d][i] = 0.f;
    float mrun = -1e30f, lrun = 0.f;
    const int npair = (ntile + 1) >> 1;
    const int srow = tid >> 3, sch = tid & 7;
    const bf16_t* ksrc = p.Y() + (rowb + srow) * YP + YD_K + sch * 8;
    const bf16_t* vsrc = p.Y() + (rowb + srow) * YP + YD_V + sch * 8;
    const int sdst = srow * KV_STRIDE + sch * 16;
    LAS unsigned char* kbuf = lds;
    LAS unsigned char* vbuf = lds + 4 * KV_TILE;
    LAS unsigned* mbuf = (LAS unsigned*)(lds + 8 * KV_TILE);
    const int mtile = hd >> 1, mkb = hd & 1;
    u32x4 kreg[2], vreg[2];
    bf16x8_t ikn0, ikn1;
#pragma unroll
    for (int tt = 0; tt < 2; ++tt) {
        const int t = min(tt, ntile - 1);
        kreg[tt] = *(const GAS u32x4*)(uintptr_t)(ksrc + (size_t)t * 64 * YP); vreg[tt] = *(const GAS u32x4*)(uintptr_t)(vsrc + (size_t)t * 64 * YP);
    }
    {
        const bf16_t* yk = p.Y() + (rowb + 64 * min(mtile, ntile - 1) + 32 * mkb + r32) * YP + YI_K + 8 * hh;
        ikn0 = *(const GAS bf16x8_t*)(uintptr_t)yk; ikn1 = *(const GAS bf16x8_t*)(uintptr_t)(yk + 16);
    }
    __syncthreads();
#pragma unroll
    for (int tt = 0; tt < 2; ++tt) { *(LAS u32x4*)(kbuf + tt * KV_TILE + sdst) = kreg[tt]; *(LAS u32x4*)(vbuf + tt * KV_TILE + sdst) = vreg[tt]; }
    for (int pp = 0; pp < npair; ++pp) {
        const int cur = pp & 1;
        const bool more = pp + 1 < npair;
        if (more) {
#pragma unroll
            for (int tt = 0; tt < 2; ++tt) {
                const int t = min(2 * (pp + 1) + tt, ntile - 1);
                kreg[tt] = *(const GAS u32x4*)(uintptr_t)(ksrc + (size_t)t * 64 * YP); vreg[tt] = *(const GAS u32x4*)(uintptr_t)(vsrc + (size_t)t * 64 * YP);
            }
        }
        TB(10, lds, tid);
        if (dosel) {
            const int tm = 2 * pp + mtile;
            unsigned bits = 0u;
            if (tm < ntile) {
                const f32x16 ss = idx_scores(ikn0, ikn1, iqf, w);
                const int kcl = kcut - 64 * tm - 4 * hh;
#pragma unroll
                for (int i = 0; i < 16; ++i) {
                    const int kci = 32 * mkb + (i & 3) + 8 * (i >> 2);
                    const bool sel = (ss[i] > T) || (ss[i] == T && kci <= kcl);
                    bits |= sel ? (1u << i) : 0u;
                }
            }
            mbuf[((cur * 2 + qg) * 4 + hd) * 64 + lane] = bits;
            if (more) {
                const bf16_t* yk = p.Y() + (rowb + 64 * min(2 * (pp + 1) + mtile, ntile - 1) + 32 * mkb + r32) * YP + YI_K + 8 * hh;
                ikn0 = *(const GAS bf16x8_t*)(uintptr_t)yk; ikn1 = *(const GAS bf16x8_t*)(uintptr_t)(yk + 16);
            }
        }
        TE(10, lds, tid); TB(12, lds, tid);
        __syncthreads();
        TE(12, lds, tid); TB(11, lds, tid);
#pragma unroll 1
        for (int tt = 0; tt < 2; ++tt) {
            const int j = 2 * pp + tt;
            if (j < ntile) {
                const LAS unsigned char* kt = kbuf + (cur * 2 + tt) * KV_TILE;
                const LAS unsigned char* vt = vbuf + (cur * 2 + tt) * KV_TILE;
                const float pl = (float)(pos - 64 * j - 4 * hh);
                const bool diag = (j == c);
                unsigned selb[2] = {0xffffu, 0xffffu};
                if (dosel) { selb[0] = mbuf[((cur * 2 + qg) * 4 + 2 * tt) * 64 + lane]; selb[1] = mbuf[((cur * 2 + qg) * 4 + 2 * tt + 1) * 64 + lane]; }
                f32x16 sc[2];
#pragma unroll
                for (int kb = 0; kb < 2; ++kb) {
                    f32x16 a;
#pragma unroll
                    for (int i = 0; i < 16; ++i) a[i] = 0.f;
#pragma unroll
                    for (int s = 0; s < 4; ++s) {
                        const bf16x8_t kf = *(const LAS bf16x8_t*)(kt + (32 * kb + r32) * KV_STRIDE + (16 * s + 8 * hh) * 2);
                        a = MFMA32(kf, qf[s], a);
                    }
                    if (!diag) {
#pragma unroll
                        for (int i = 0; i < 16; ++i) { const float kc = (float)(32 * kb + (i & 3) + 8 * (i >> 2)); a[i] = fmaf(a[i], c1, fmaf(sl2, kc, -sl2 * pl)); }
                    } else {
#pragma unroll
                        for (int i = 0; i < 16; ++i) { const float kc = (float)(32 * kb + (i & 3) + 8 * (i >> 2)); a[i] = fmaf(a[i], c1, -sl2 * fabsf(pl - kc)); }
                    }
#pragma unroll
                    for (int i = 0; i < 16; ++i) a[i] = (selb[kb] & (1u << i)) ? a[i] : -INFINITY;
                    sc[kb] = a;
                }
                float mx = sc[0][0];
#pragma unroll
                for (int i = 1; i < 16; ++i) mx = fmaxf(mx, sc[0][i]);
#pragma unroll
                for (int i = 0; i < 16; ++i) mx = fmaxf(mx, sc[1][i]);
                mx = xmax32(mx);
                const float mnew = fmaxf(mrun, mx);
                const float alpha = __builtin_amdgcn_exp2f(mrun - mnew);
                mrun = mnew;
                float ls4[4] = {0.f, 0.f, 0.f, 0.f};
#pragma unroll
                for (int kb = 0; kb < 2; ++kb)
#pragma unroll
                    for (int i = 0; i < 16; ++i) { const float e = __builtin_amdgcn_exp2f(sc[kb][i] - mnew); sc[kb][i] = e; ls4[i & 3] += e; }
                lrun = lrun * alpha + ((ls4[0] + ls4[1]) + (ls4[2] + ls4[3]));
#pragma unroll
                for (int d = 0; d < 2; ++d)
#pragma unroll
                    for (int i = 0; i < 16; ++i) o[d][i] *= alpha;
#pragma unroll
                for (int ks = 0; ks < 4; ++ks) {
                    const bf16x8_t pf = pack_step(sc[ks >> 1], ks & 1);
#pragma unroll
                    for (int db = 0; db < 2; ++db) o[db] = MFMA32(vt_frag(vt, ks, db, lane), pf, o[db]);
                }
            }
        }
        TE(11, lds, tid);
        if (more) {
#pragma unroll
            for (int tt = 0; tt < 2; ++tt) { *(LAS u32x4*)(kbuf + ((cur ^ 1) * 2 + tt) * KV_TILE + sdst) = kreg[tt]; *(LAS u32x4*)(vbuf + ((cur ^ 1) * 2 + tt) * KV_TILE + sdst) = vreg[tt]; }
        }
        __syncthreads();
    }
    TE(9, lds, tid);
    const float inv = 1.f / xsum32(lrun);
    bf16_t* mrow = p.mix() + (rowb + pos) * DM + 768 + hd * 64;
#pragma unroll
    for (int d = 0; d < 2; ++d)
#pragma unroll
        for (int g = 0; g < 4; ++g) {
            const int d0 = 32 * d + 8 * g + 4 * hh;
            const unsigned long long zz = *(const GAS unsigned long long*)(uintptr_t)(yq + YD_Z + hd * 64 + d0);
            const float z0 = __uint_as_float((unsigned)(zz & 0xffffu) << 16), z1 = __uint_as_float((unsigned)((zz >> 16) & 0xffffu) << 16),
                        z2 = __uint_as_float((unsigned)((zz >> 32) & 0xffffu) << 16), z3 = __uint_as_float((unsigned)((zz >> 48) & 0xffffu) << 16);
            *(GAS unsigned long long*)(uintptr_t)(mrow + d0) = (unsigned long long)cvtpk(o[d][4 * g] * inv * z0, o[d][4 * g + 1] * inv * z1) | ((unsigned long long)cvtpk(o[d][4 * g + 2] * inv * z2, o[d][4 * g + 3] * inv * z3) << 32);
        }
}
__device__ __forceinline__ void ph_mixD(const Params& p, LAS unsigned char* lds, int bid, int nb, int wave_s) {
    for (int i = bid; i < 256; i += nb) {
        const int b = i & 15, cc = i >> 4;
#pragma unroll 1
        for (int k = 0; k < 2; ++k) mixD_unit(p, b, k == 0 ? 31 - cc : cc, lds, wave_s);
    }
}

constexpr int VN_STRIDE = 528;
__device__ __forceinline__ float bflo(unsigned u) { return __uint_as_float(u << 16); }
__device__ __forceinline__ float bfhi(unsigned u) { return __uint_as_float(u & 0xffff0000u); }
__device__ __forceinline__ void mixAB_unit(const Params& p, int l, int b, int n, LAS unsigned char* lds, int tid) {
    const int lane = tid & 63, wave = __builtin_amdgcn_readfirstlane(tid >> 6), r32 = lane & 31, hh = lane >> 5;
    const size_t row0 = (size_t)b * SEQ + 128 * n;
    __syncthreads();
#pragma unroll
    for (int k = 0; k < 8; ++k) {
        const int ch = tid + 512 * k, r = ch >> 5, c16 = ch & 31;
        *(LAS u32x4*)(lds + r * VN_STRIDE + c16 * 16) = *(const GAS u32x4*)(uintptr_t)(p.Y() + (row0 + r) * YP + YB_V + c16 * 8);
    }
    {
        const int cg8 = (tid & 31) * 8, t0 = (tid >> 5) * 8;
        const int pos0 = 128 * n + t0;
        const GAS float* cw = p.sm(SM_CONVW) + l * 768 + cg8;
        float w0[8], w1[8], w2[8], cb[8];
#pragma unroll
        for (int e = 0; e < 8; ++e) { w0[e] = cw[e]; w1[e] = cw[256 + e]; w2[e] = cw[512 + e]; cb[e] = p.sm(SM_CONVB)[l * 256 + cg8 + e]; }
        float um2[8], um1[8];
#pragma unroll
        for (int e = 0; e < 8; ++e) { um2[e] = 0.f; um1[e] = 0.f; }
#pragma unroll
        for (int back = 2; back >= 1; --back) {
            if (pos0 - back >= 0) {
                const bf16_t* yr = p.Y() + (row0 + t0 - back) * YP;
                const u32x4 hc = *(const GAS u32x4*)(uintptr_t)(yr + YA_H + cg8), cc = *(const GAS u32x4*)(uintptr_t)(yr + YA_C + cg8);
                float u[8] = {bflo(hc.x) * bflo(cc.x), bfhi(hc.x) * bfhi(cc.x), bflo(hc.y) * bflo(cc.y), bfhi(hc.y) * bfhi(cc.y),
                              bflo(hc.z) * bflo(cc.z), bfhi(hc.z) * bfhi(cc.z), bflo(hc.w) * bflo(cc.w), bfhi(hc.w) * bfhi(cc.w)};
#pragma unroll
                for (int e = 0; e < 8; ++e) { if (back == 2) um2[e] = u[e]; else um1[e] = u[e]; }
            }
        }
#pragma unroll
        for (int tt = 0; tt < 8; ++tt) {
            const bf16_t* yr = p.Y() + (row0 + t0 + tt) * YP;
            const u32x4 hc = *(const GAS u32x4*)(uintptr_t)(yr + YA_H + cg8), cc = *(const GAS u32x4*)(uintptr_t)(yr + YA_C + cg8), bg = *(const GAS u32x4*)(uintptr_t)(yr + YA_B + cg8), zg = *(const GAS u32x4*)(uintptr_t)(yr + YA_Z + cg8);
            const float u[8] = {bflo(hc.x) * bflo(cc.x), bfhi(hc.x) * bfhi(cc.x), bflo(hc.y) * bflo(cc.y), bfhi(hc.y) * bfhi(cc.y),
                                bflo(hc.z) * bflo(cc.z), bfhi(hc.z) * bfhi(cc.z), bflo(hc.w) * bflo(cc.w), bfhi(hc.w) * bfhi(cc.w)};
            const float bgv[8] = {bflo(bg.x), bfhi(bg.x), bflo(bg.y), bfhi(bg.y), bflo(bg.z), bfhi(bg.z), bflo(bg.w), bfhi(bg.w)};
            const float zgv[8] = {bflo(zg.x), bfhi(zg.x), bflo(zg.y), bfhi(zg.y), bflo(zg.z), bfhi(zg.z), bflo(zg.w), bfhi(zg.w)};
            float ov[8];
#pragma unroll
            for (int e = 0; e < 8; ++e) {
                const float conv = w0[e] * um2[e] + w1[e] * um1[e] + w2[e] * u[e];
                ov[e] = bgv[e] * (conv + cb[e]) * zgv[e];
                um2[e] = um1[e]; um1[e] = u[e];
            }
            u32x4 ow; ow.x = cvtpk(ov[0], ov[1]); ow.y = cvtpk(ov[2], ov[3]); ow.z = cvtpk(ov[4], ov[5]); ow.w = cvtpk(ov[6], ov[7]);
            *(GAS u32x4*)(uintptr_t)(p.mix() + (row0 + t0 + tt) * DM + cg8) = ow;
        }
    }
    __syncthreads();
    {
        const int h = wave >> 1, th = wave & 1;
        const int nks = th == 0 ? 4 : 8;
        f32x16 acc[2][2];
#pragma unroll
        for (int a = 0; a < 2; ++a)
#pragma unroll
            for (int d = 0; d < 2; ++d)
#pragma unroll
                for (int i = 0; i < 16; ++i) acc[a][d][i] = 0.f;
        const bf16_t* wb = p.wsb() + ((size_t)(l * 4 + h) * 128 + 64 * th + r32) * 128 + 8 * hh;
        const int i16 = lane & 15, q = i16 >> 2, pp = i16 & 3, blk = (lane >> 4) & 1;
        const LAS unsigned char* va = lds + (8 * hh + q) * VN_STRIDE + (h * 64 + 16 * blk + 4 * pp) * 2;
        for (int ks = 0; ks < nks; ++ks) {
            bf16x8_t bfr[2], afr[2];
#pragma unroll
            for (int tb = 0; tb < 2; ++tb) bfr[tb] = *(const GAS bf16x8_t*)(uintptr_t)(wb + (size_t)(32 * tb) * 128 + 16 * ks);
#pragma unroll
            for (int db = 0; db < 2; ++db) {
                const LAS unsigned char* a = va + (16 * ks) * VN_STRIDE + (32 * db) * 2;
                const s16x4_t lo = ds_tr16(a), hi = ds_tr16(a + 4 * VN_STRIDE);
                afr[db] = __builtin_shufflevector(lo, hi, 0, 1, 2, 3, 4, 5, 6, 7);
            }
#pragma unroll
            for (int tb = 0; tb < 2; ++tb)
#pragma unroll
                for (int db = 0; db < 2; ++db) acc[tb][db] = MFMA32(afr[db], bfr[tb], acc[tb][db]);
        }
#pragma unroll
        for (int tb = 0; tb < 2; ++tb) {
            const int t = 64 * th + 32 * tb + r32;
            const float bias = p.sm(SM_GMLPB)[(l * 4 + h) * 128 + t];
            const bf16_t* yr = p.Y() + (row0 + t) * YP;
            bf16_t* mr = p.mix() + (row0 + t) * DM + 256 + h * 64;
#pragma unroll
            for (int db = 0; db < 2; ++db)
#pragma unroll
                for (int g = 0; g < 4; ++g) {
                    const int d0 = 32 * db + 8 * g + 4 * hh;
                    const unsigned long long uu = *(const GAS unsigned long long*)(uintptr_t)(yr + YB_U + h * 64 + d0), zz = *(const GAS unsigned long long*)(uintptr_t)(yr + YB_Z + h * 64 + d0);
                    const unsigned u01 = (unsigned)uu, u23 = (unsigned)(uu >> 32), z01 = (unsigned)zz, z23 = (unsigned)(zz >> 32);
                    const float v0 = bflo(u01) * (acc[tb][db][4 * g] + bias) * bflo(z01), v1 = bfhi(u01) * (acc[tb][db][4 * g + 1] + bias) * bfhi(z01);
                    const float v2 = bflo(u23) * (acc[tb][db][4 * g + 2] + bias) * bflo(z23), v3 = bfhi(u23) * (acc[tb][db][4 * g + 3] + bias) * bfhi(z23);
                    *(GAS unsigned long long*)(uintptr_t)(mr + d0) = (unsigned long long)cvtpk(v0, v1) | ((unsigned long long)cvtpk(v2, v3) << 32);
                }
        }
    }
}
__device__ __forceinline__ void ph_mixAB(const Params& p, int l, LAS unsigned char* lds, int bid, int nb, int tid_in) {
    int tid = tid_in; asm volatile("" : "+v"(tid));
    for (int i = bid; i < 256; i += nb) mixAB_unit(p, l, i >> 4, i & 15, lds, tid);
}

__global__ void __launch_bounds__(NT, 2) k_fwd(Params p) {
    extern __shared__ __attribute__((aligned(16))) unsigned char lds[];
    cg::grid_group grid = cg::this_grid();
    LAS unsigned char* l3 = (LAS unsigned char*)lds;
    const int wave_s = __builtin_amdgcn_readfirstlane((int)threadIdx.x >> 6);
    volatile LAS unsigned* bst = (volatile LAS unsigned*)(l3 + LDS_BYTES - 16);
    if (threadIdx.x < 2) bst[threadIdx.x] = 0u;
    __syncthreads();
    const XcdBarrier bar = xcd_barrier_post(p.ctl(), bst);
    if (TSEG >= 0 && threadIdx.x == 0) *(volatile LAS unsigned*)(l3 + TCTR_OFF) = 0u;
    { TB(16, l3, tid_now(wave_s)); ph_prologue(p, l3, tid_now(wave_s)); TE(16, l3, tid_now(wave_s)); }
    grid.sync();
#pragma unroll 1
    for (int l = 0; l < DEPTH; ++l) {
        Params q = p; asm volatile("" : "+s"(q.ws), "+s"(q.out));
        int bid = blockIdx.x, nb = gridDim.x; asm volatile("" : "+s"(bid), "+s"(nb));
        {
            pg8::Gemm g{q.xb(), q.wt_in() + (size_t)l * YP * DM, NTOK, YP, DM};
            pg8::StaticOrder S; S.init(NTOK, YP, nb, bid);
            EpiIn E{q.ws, l, (LAS float*)(l3 + 131072 + 1024)};
            { TB(13, l3, tid_now(wave_s)); pg8::gemm_phase<EpiIn, pg8::StaticOrder, true, true>(l3, g, S, E, tid_now(wave_s)); TE(13, l3, tid_now(wave_s)); }
        }
        { TB(18, l3, tid_now(wave_s)); xcd_barrier(bar, tid_now(wave_s)); TE(18, l3, tid_now(wave_s)); }
        asm volatile("" : "+s"(q.ws), "+s"(bid), "+s"(nb));
        { TB(17, l3, tid_now(wave_s)); ph_mixAB(q, l, l3, bid, nb, tid_now(wave_s)); TE(17, l3, tid_now(wave_s)); }
        __syncthreads();
        { TB(1, l3, tid_now(wave_s)); ph_mixC(q, l, l3, bid, nb, wave_s); TE(1, l3, tid_now(wave_s)); }
        __syncthreads();
        { TB(19, l3, tid_now(wave_s)); ph_mixD(q, l3, bid, nb, wave_s); TE(19, l3, tid_now(wave_s)); }
        __syncthreads();
        { TB(18, l3, tid_now(wave_s)); xcd_barrier(bar, tid_now(wave_s)); TE(18, l3, tid_now(wave_s)); }
        asm volatile("" : "+s"(q.ws), "+s"(q.out), "+s"(bid), "+s"(nb));
        {
            pg8::Gemm g{q.mix(), q.wt_out() + (size_t)l * DM * DM, NTOK, DM, DM};
            pg8::StaticOrder S; S.init(NTOK, DM, nb, bid);
            EpiOut E{l == DEPTH - 1 ? q.out : nullptr, q.ws};
            { TB(15, l3, tid_now(wave_s)); pg8::gemm_phase<EpiOut, pg8::StaticOrder, true, true>(l3, g, S, E, tid_now(wave_s)); TE(15, l3, tid_now(wave_s)); }
        }
        { TB(18, l3, tid_now(wave_s)); xcd_barrier(bar, tid_now(wave_s)); TE(18, l3, tid_now(wave_s)); }
    }
    if (TSEG >= 0 && blockIdx.x == 0 && threadIdx.x == 0) {
        const unsigned long long ticks = 8ull * *(volatile LAS unsigned*)(l3 + TCTR_OFF), t0 = __builtin_amdgcn_s_memrealtime();
        while (__builtin_amdgcn_s_memrealtime() - t0 < ticks) __builtin_amdgcn_s_sleep(32);
    }
}

extern "C" void kernel_launch(void* const* d_in, const int* in_sizes, int n_in, void* d_out, int out_size, void* d_ws, size_t ws_size,
                              hipStream_t stream) {
    static int grid_blocks = 0;
    if (!grid_blocks) {
        int dev = 0, cus = 0, per_cu = 0;
        (void)hipGetDevice(&dev);
        (void)hipDeviceGetAttribute(&cus, hipDeviceAttributeMultiprocessorCount, dev);
        (void)hipFuncSetAttribute((const void*)k_fwd, hipFuncAttributeMaxDynamicSharedMemorySize, LDS_BYTES);
        (void)hipOccupancyMaxActiveBlocksPerMultiprocessor(&per_cu, (const void*)k_fwd, NT, LDS_BYTES);
        if (per_cu < 1) { fprintf(stderr, "kernel_launch: occupancy query returned %d\n", per_cu); per_cu = 1; }
        if (per_cu > 1) per_cu = 1;
        grid_blocks = cus * per_cu;
        if (ws_size < WS_END) fprintf(stderr, "kernel_launch: workspace too small (%zu < %zu)\n", ws_size, (size_t)WS_END);
    }
    (void)hipMemsetAsync(d_ws, 0, 16384, stream);
    Params p{};
    p.x = (const float*)d_in[0]; p.norm_g = (const float*)d_in[1]; p.w_in = (const float*)d_in[2]; p.i_conv_w = (const float*)d_in[3];
    p.i_conv_b = (const float*)d_in[4]; p.i_gmlp_g = (const float*)d_in[5]; p.gmlp_ws = (const float*)d_in[6]; p.i_gmlp_b = (const float*)d_in[7];
    p.i_diff_qg = (const float*)d_in[8]; p.i_diff_kg = (const float*)d_in[9]; p.i_diff_lam = (const float*)d_in[10]; p.i_diff_subg = (const float*)d_in[11];
    p.i_dsa_qg = (const float*)d_in[12]; p.i_dsa_kg = (const float*)d_in[13]; p.w_out = (const float*)d_in[14];
    p.out = (float*)d_out; p.ws = (unsigned char*)d_ws;
    void* args[] = {&p};
    hipError_t e = hipLaunchCooperativeKernel((void*)k_fwd, dim3(grid_blocks), dim3(NT), args, LDS_BYTES, stream);
    if (e != hipSuccess) fprintf(stderr, "cooperative launch failed: %s (grid %d)\n", hipGetErrorString(e), grid_blocks);
}
```

```cpp
#include <hip/hip_runtime.h>
#include <hip/hip_cooperative_groups.h>
#include <math.h>
#include <stdint.h>
#include <stdio.h>
namespace cg = cooperative_groups;
namespace pg8 {
#define PG8_LAS __attribute__((address_space(3)))
typedef unsigned short bf16_t;
typedef short bf16x8 __attribute__((ext_vector_type(8)));
typedef float f32x4 __attribute__((ext_vector_type(4)));
typedef unsigned u32x4 __attribute__((ext_vector_type(4)));
constexpr int BM = 256, BK = 64, HALF = 128, HTB = HALF * BK * 2  , STAGE_BYTES = 8 * HTB, NXCD = 8, WGM = 8;

__host__ __device__ __forceinline__ int lds_byte(int r, int c) { const int st = (r >> 4) * 2 + (c >> 5), rr = r & 15, cc = c & 31, ob = rr * 64 + cc * 2; return st * 1024 + (ob ^ (((ob >> 9) & 1) << 5)); }
__host__ __device__ __forceinline__ void stage_rc(int b, int& R, int& C) { const int st = b / 1024, sb = b % 1024, swz = sb ^ (((sb >> 9) & 1) << 5); R = (st >> 1) * 16 + swz / 64; C = (st & 1) * 32 + (swz % 64) / 2; }
__host__ __device__ __forceinline__ int perm32(int rho) { const int n = rho >> 4, i = rho & 15; return 8 * (i >> 2) + 4 * n + (i & 3); }

struct Unit { int pm, pn; };
struct Gemm { const bf16_t* A; const bf16_t* Bt; int M, N, K; };

struct StaticOrder {
    int nM, nN, nwg, G, c;
    __host__ __device__ void init(int M, int N, int G_, int c_) { nM = M / BM; nN = N / BM; nwg = nM * nN; G = G_; c = c_; }
    __host__ __device__ bool next(int i, Unit& u) const {
        const long L = (long)i * G + c; if (L >= nwg) return false;
        int wgid = (int)L; { const int q = nwg / NXCD, r = nwg % NXCD, xcd = wgid % NXCD, off = wgid / NXCD; wgid = (xcd < r ? xcd * (q + 1) : r * (q + 1) + (xcd - r) * q) + off; }
        const int nig = WGM * nN, gid = wgid / nig, fm = gid * WGM, gsz = (nM - fm) < WGM ? (nM - fm) : WGM;
        u.pm = fm + ((wgid % nig) % gsz); u.pn = (wgid % nig) / gsz; return true;
    }
    __device__ __forceinline__ void a_ready(const Unit&) const {}
    __device__ __forceinline__ void done(const Unit&) const {}
};

__device__ __forceinline__ unsigned cvt_pk_bf16(float lo, float hi) { unsigned r; asm volatile("v_cvt_pk_bf16_f32 %0, %1, %2" : "=v"(r) : "v"(lo), "v"(hi)); return r; }
typedef float f32x2 __attribute__((ext_vector_type(2)));
__device__ __forceinline__ f32x2 gelu_pk(f32x2 v) {
    const f32x2 av = __builtin_elementwise_abs(v), d = av * 0.2316418882f + 1.0f;
    f32x2 t; t.x = __builtin_amdgcn_rcpf(d.x); t.y = __builtin_amdgcn_rcpf(d.y);
    f32x2 q = t * 0.5307027145f + (-0.7265760135f); q = q * t + 0.7107068705f; q = q * t + (-0.142248368f); q = q * t + 0.127414796f; q = q * t;
    const f32x2 s = (v * v) * (-0.72134752044f);
    f32x2 e; e.x = __builtin_amdgcn_exp2f(s.x); e.y = __builtin_amdgcn_exp2f(s.y);
    const f32x2 m = v * (q * e), r = v - m;
    f32x2 o; o.x = v.x < 0.f ? m.x : r.x; o.y = v.y < 0.f ? m.y : r.y; return o;
}
template <class Epi, class Sched, bool ALIGN_EPI = false, bool SP2 = false>
__device__ __forceinline__ void gemm_phase(PG8_LAS unsigned char* lds, const Gemm g, const Sched& S, const Epi& E, int tid_in) {
    int tid_ = tid_in; asm volatile("" : "+v"(tid_));
    const int tid = tid_, wid = __builtin_amdgcn_readfirstlane(tid >> 6), lane = tid & 63, wr = wid >> 2, wc = wid & 3, fr = lane & 15, fq = lane >> 4;
    const int K = g.K, nt = K / BK;
    unsigned voffA[2], voffB[2];
#pragma unroll
    for (int i = 0; i < 2; ++i) { int R, C; stage_rc(tid * 16 + i * 8192, R, C); const int Rb = Epi::PERM ? ((R & ~31) + perm32(R & 31)) : R;
        voffA[i] = (unsigned)(R * K + C) * 2u; voffB[i] = (unsigned)(Rb * K + C) * 2u; }
    const size_t kstep = (size_t)(BK * 2);
    const size_t hstep = (size_t)HALF * K * 2;
    const size_t tstep = 2 * hstep;
    const unsigned ldsw = (unsigned)wid * 1024u;
    const int aoff = lds_byte(wr * 64 + fr, fq * 8), boff = lds_byte(wc * 32 + fr, fq * 8);
#define PG8_SA(b, h) (((b) * 2 + (h)) * HTB)
#define PG8_SB(b, h) ((4 + (b) * 2 + (h)) * HTB)
#define PG8_STAGE(bufoff, gbase, voff) do { _Pragma("unroll") for (int _i = 0; _i < 2; ++_i) \
        __builtin_amdgcn_global_load_lds((const unsigned*)((const char*)(gbase) + (voff)[_i]), (PG8_LAS unsigned*)(lds + (bufoff) + ldsw + _i * 8192), 16, 0, 0); } while (0)
#define PG8_LDA(dst, b, h) do { _Pragma("unroll") for (int m = 0; m < 4; ++m) _Pragma("unroll") for (int k = 0; k < 2; ++k) dst[m][k] = *(const PG8_LAS bf16x8*)(lds + PG8_SA(b, h) + aoff + m * 2048 + k * 1024); } while (0)
#define PG8_LDB(dst, b, h) do { _Pragma("unroll") for (int n = 0; n < 2; ++n) _Pragma("unroll") for (int k = 0; k < 2; ++k) dst[n][k] = *(const PG8_LAS bf16x8*)(lds + PG8_SB(b, h) + boff + n * 2048 + k * 1024); } while (0)
#define PG8_MMA(ai, bj, At, Bt) do { __builtin_amdgcn_s_setprio(1); _Pragma("unroll") for (int m = 0; m < 4; ++m) _Pragma("unroll") for (int n = 0; n < 2; ++n) _Pragma("unroll") for (int k = 0; k < 2; ++k) \
        acc[ai][bj][m][n] = __builtin_amdgcn_mfma_f32_16x16x32_bf16(Bt[n][k], At[m][k], acc[ai][bj][m][n], 0, 0, 0); __builtin_amdgcn_s_setprio(0); } while (0)
#define PG8_WAIT_V(n) asm volatile("s_waitcnt vmcnt(" #n ")" ::: "memory")
#define PG8_WAIT_L(n) asm volatile("s_waitcnt lgkmcnt(" #n ")" ::: "memory")
#define PG8_BAR __builtin_amdgcn_s_barrier()
#define PG8_SCHED __builtin_amdgcn_sched_barrier(0)
    Unit cur, nxt; int ui = 0;
    if (!S.next(0, cur)) return;
    f32x4 acc[2][2][4][2];
#pragma unroll
    for (int a = 0; a < 2; ++a)
#pragma unroll
        for (int b = 0; b < 2; ++b)
#pragma unroll
            for (int m = 0; m < 4; ++m)
#pragma unroll
                for (int n = 0; n < 2; ++n) acc[a][b][m][n] = (f32x4){0.f, 0.f, 0.f, 0.f};
    bf16x8 At[4][2], B0[2][2], B1[2][2];
    const char* cA = (const char*)g.A + (size_t)cur.pm * tstep; const char* cB = (const char*)g.Bt + (size_t)cur.pn * tstep;
    S.a_ready(cur);
    if constexpr (SP2) {
        PG8_STAGE(PG8_SB(0, 0), cB, voffB); PG8_STAGE(PG8_SB(0, 1), cB + hstep, voffB); PG8_STAGE(PG8_SA(0, 0), cA, voffA); PG8_STAGE(PG8_SA(0, 1), cA + hstep, voffA);
        if (wr == 1) PG8_BAR;
        PG8_WAIT_V(2); PG8_BAR;
        PG8_STAGE(PG8_SB(1, 0), cB + kstep, voffB); PG8_STAGE(PG8_SA(1, 0), cA + kstep, voffA); PG8_STAGE(PG8_SB(1, 1), cB + hstep + kstep, voffB);
        PG8_WAIT_V(6); PG8_BAR;
    } else {
        PG8_STAGE(PG8_SB(0, 0), cB, voffB); PG8_STAGE(PG8_SA(0, 0), cA, voffA); PG8_STAGE(PG8_SB(0, 1), cB + hstep, voffB); PG8_STAGE(PG8_SA(0, 1), cA + hstep, voffA);
        if (wr == 1) PG8_BAR;
        PG8_WAIT_V(4); PG8_BAR;
        PG8_STAGE(PG8_SB(1, 0), cB + kstep, voffB); PG8_STAGE(PG8_SA(1, 0), cA + kstep, voffA); PG8_STAGE(PG8_SB(1, 1), cB + hstep + kstep, voffB);
        PG8_WAIT_V(6); PG8_BAR;
    }
    for (;;) {
        const bool has_next = S.next(ui + 1, nxt);
        const char* nA = has_next ? (const char*)g.A + (size_t)nxt.pm * tstep : cA; const char* nB = has_next ? (const char*)g.Bt + (size_t)nxt.pn * tstep : cB;
        for (int t = 0; t < nt; t += 2) {
            const bool last = (t == nt - 2);
            const char* a1 = cA + (size_t)(t + 1) * kstep;
            const char* a2 = last ? nA : cA + (size_t)(t + 2) * kstep; const char* b2 = last ? nB : cB + (size_t)(t + 2) * kstep;
            const char* a3 = a2 + kstep; const char* b3 = b2 + kstep;
            if (last && has_next) S.a_ready(nxt);
            if constexpr (SP2) {
            PG8_LDB(B0, 0, 0); PG8_LDB(B1, 0, 1); PG8_SCHED; PG8_LDA(At, 0, 0); PG8_STAGE(PG8_SA(1, 1), a1 + hstep, voffA);
            PG8_WAIT_V(8); PG8_WAIT_L(0); PG8_BAR; PG8_MMA(0, 0, At, B0); PG8_MMA(0, 1, At, B1); PG8_BAR; PG8_SCHED;
            PG8_LDA(At, 0, 1); PG8_STAGE(PG8_SB(0, 0), b2, voffB); PG8_STAGE(PG8_SB(0, 1), b2 + hstep, voffB); PG8_STAGE(PG8_SA(0, 0), a2, voffA);
            PG8_WAIT_V(8); PG8_WAIT_L(0); PG8_BAR; PG8_MMA(1, 0, At, B0); PG8_MMA(1, 1, At, B1); PG8_BAR; PG8_SCHED;
            PG8_LDB(B0, 1, 0); PG8_LDB(B1, 1, 1); PG8_SCHED; PG8_LDA(At, 1, 0); PG8_STAGE(PG8_SA(0, 1), a2 + hstep, voffA);
            PG8_WAIT_V(8); PG8_WAIT_L(0); PG8_BAR; PG8_MMA(0, 0, At, B0); PG8_MMA(0, 1, At, B1); PG8_BAR; PG8_SCHED;
            PG8_LDA(At, 1, 1); PG8_STAGE(PG8_SB(1, 0), b3, voffB); PG8_STAGE(PG8_SB(1, 1), b3 + hstep, voffB); PG8_STAGE(PG8_SA(1, 0), a3, voffA);
            PG8_WAIT_V(8); PG8_WAIT_L(0); PG8_BAR; PG8_MMA(1, 0, At, B0); PG8_MMA(1, 1, At, B1); PG8_BAR; PG8_SCHED;
            } else {
            PG8_LDB(B0, 0, 0); PG8_SCHED; PG8_LDA(At, 0, 0); PG8_STAGE(PG8_SA(1, 1), a1 + hstep, voffA);
            PG8_WAIT_L(8); PG8_BAR; PG8_WAIT_L(0); PG8_MMA(0, 0, At, B0); PG8_BAR; PG8_SCHED;
            PG8_LDB(B1, 0, 1); PG8_STAGE(PG8_SB(0, 0), b2, voffB);
            PG8_BAR; PG8_WAIT_L(0); PG8_MMA(0, 1, At, B1); PG8_BAR;
            PG8_LDA(At, 0, 1); PG8_STAGE(PG8_SA(0, 0), a2, voffA);
            PG8_BAR; PG8_WAIT_L(0); PG8_MMA(1, 0, At, B0); PG8_BAR; PG8_SCHED;
            PG8_STAGE(PG8_SB(0, 1), b2 + hstep, voffB);
            PG8_WAIT_V(6); PG8_BAR; PG8_MMA(1, 1, At, B1); PG8_BAR;
            PG8_LDB(B0, 1, 0); PG8_SCHED; PG8_LDA(At, 1, 0); PG8_STAGE(PG8_SA(0, 1), a2 + hstep, voffA);
            PG8_WAIT_L(8); PG8_BAR; PG8_WAIT_L(0); PG8_MMA(0, 0, At, B0); PG8_BAR; PG8_SCHED;
            PG8_LDB(B1, 1, 1); PG8_STAGE(PG8_SB(1, 0), b3, voffB);
            PG8_BAR; PG8_WAIT_L(0); PG8_MMA(0, 1, At, B1); PG8_BAR;
            PG8_LDA(At, 1, 1); PG8_STAGE(PG8_SA(1, 0), a3, voffA);
            PG8_BAR; PG8_WAIT_L(0); PG8_MMA(1, 0, At, B0); PG8_BAR; PG8_SCHED;
            PG8_STAGE(PG8_SB(1, 1), b3 + hstep, voffB);
            PG8_WAIT_V(6); PG8_BAR; PG8_MMA(1, 1, At, B1); PG8_BAR;
            }
        }
        if constexpr (ALIGN_EPI) { if (wr == 0) PG8_BAR; }
        if constexpr (!Epi::AFTER_DRAIN) { E(acc, cur, wr, wc, fr, fq); S.done(cur); }
        if (!has_next) break;
#pragma unroll
        for (int a = 0; a < 2; ++a)
#pragma unroll
            for (int b = 0; b < 2; ++b)
#pragma unroll
                for (int m = 0; m < 4; ++m)
#pragma unroll
                    for (int n = 0; n < 2; ++n) acc[a][b][m][n] = (f32x4){0.f, 0.f, 0.f, 0.f};
        cur = nxt; cA = nA; cB = nB; ++ui;
        if constexpr (ALIGN_EPI) { if (wr == 1) PG8_BAR; }
    }
    PG8_WAIT_V(0);
    if constexpr (!ALIGN_EPI) { if (wr == 0) PG8_BAR; }
    PG8_BAR;
    if constexpr (Epi::AFTER_DRAIN) { E.fused(acc, cur, wr, wc, fr, fq, lds, wid, lane); S.done(cur); }
#undef PG8_SA
#undef PG8_SB
#undef PG8_STAGE
#undef PG8_LDA
#undef PG8_LDB
#undef PG8_MMA
#undef PG8_WAIT_V
#undef PG8_WAIT_L
#undef PG8_BAR
#undef PG8_SCHED
}
}

using pg8::bf16_t; using pg8::f32x4; using pg8::u32x4; using pg8::Unit;
#define LAS __attribute__((address_space(3)))
#define GAS __attribute__((address_space(1)))

constexpr int DM = 1024, SEQ = 2048, BATCH = 16, DEPTH = 4, NIN = 3620, NTOK = BATCH * SEQ, YP = 3840;
constexpr float EPS = 1e-6f;
constexpr int O_DZ = 3200, O_DK = 3072, O_DV = 3136;
constexpr int YA_H = 0, YA_B = 256, YA_C = 512, YA_Z = 768, YB_U = 1024, YB_V = 1280, YB_Z = 1536, YC_Q = 1792, YC_K = 2048, YC_V = 2304,
              YC_Z = 2560, YD_Q = 2816, YD_Z = 3072, YD_K = 3328, YD_V = 3392, YI_Q = 3456, YI_K = 3584, YI_W = 3616;
constexpr int TOPK = 256;
constexpr int NGEMM = 3584;
constexpr int NT = 512, NW = 8;
constexpr int LDS_BYTES = 131072 + 4096;

constexpr size_t MiB = 1u << 20;
constexpr size_t WS_WTIN = 1 * MiB;
constexpr size_t WS_WTOUT = WS_WTIN + (size_t)DEPTH * YP * DM * 2;
constexpr size_t WS_SSQ = WS_WTOUT + (size_t)DEPTH * DM * DM * 2;
constexpr size_t WS_XB = WS_SSQ + (size_t)NTOK * 16 * 4;
constexpr size_t WS_Y = WS_XB + (size_t)NTOK * DM * 2;
constexpr size_t WS_MIX = WS_Y + (size_t)NTOK * YP * 2;
constexpr size_t WS_WSB = WS_MIX + (size_t)NTOK * DM * 2;
constexpr size_t WS_END = WS_WSB + (size_t)DEPTH * 4 * 128 * 128 * 2;

constexpr size_t WS_SMALL = 65536;
constexpr int SM_CONVW = 0, SM_CONVB = 3072, SM_GMLPG = 4096, SM_GMLPB = 5120, SM_QG = 7168, SM_KG = 7296, SM_LAM = 7424, SM_SUBG = 7936, SM_DQG = 8960, SM_DKG = 9216, SM_END = 9472;
struct Params {
    const float* x; const float* norm_g; const float* w_in; const float* i_conv_w; const float* i_conv_b;
    const float* i_gmlp_g; const float* gmlp_ws; const float* i_gmlp_b; const float* i_diff_qg; const float* i_diff_kg;
    const float* i_diff_lam; const float* i_diff_subg; const float* i_dsa_qg; const float* i_dsa_kg; const float* w_out;
    float* out; unsigned char* ws;
    __device__ __forceinline__ unsigned* ctl() const { return (unsigned*)ws; }
    __device__ __forceinline__ const GAS float* sm(int off) const { return (const GAS float*)(uintptr_t)(ws + WS_SMALL) + off; }
    __device__ __forceinline__ bf16_t* wt_in() const { return (bf16_t*)(ws + WS_WTIN); }
    __device__ __forceinline__ bf16_t* wt_out() const { return (bf16_t*)(ws + WS_WTOUT); }
    __device__ __forceinline__ float* ssq() const { return (float*)(ws + WS_SSQ); }
    __device__ __forceinline__ bf16_t* xb() const { return (bf16_t*)(ws + WS_XB); }
    __device__ __forceinline__ bf16_t* Y() const { return (bf16_t*)(ws + WS_Y); }
    __device__ __forceinline__ bf16_t* mix() const { return (bf16_t*)(ws + WS_MIX); }
    __device__ __forceinline__ bf16_t* wsb() const { return (bf16_t*)(ws + WS_WSB); }
};

#ifndef TSEG
#define TSEG -1
#endif
constexpr int TCTR_OFF = 131072 + 3072;
#define TB(id, ldsbase, tidv) do { if (TSEG == (id) && blockIdx.x == 0 && (tidv) == 0) *(volatile LAS unsigned long long*)((ldsbase) + TCTR_OFF + 8) = __builtin_amdgcn_s_memrealtime(); } while (0)
#define TE(id, ldsbase, tidv) do { if (TSEG == (id) && blockIdx.x == 0 && (tidv) == 0) { const unsigned _d = (unsigned)(__builtin_amdgcn_s_memrealtime() - *(volatile LAS unsigned long long*)((ldsbase) + TCTR_OFF + 8)); *(volatile LAS unsigned*)((ldsbase) + TCTR_OFF) += _d; } } while (0)
__device__ __forceinline__ unsigned f2bf(float f) { unsigned u = __float_as_uint(f); return (u + 0x7fffu + ((u >> 16) & 1u)) >> 16; }
__device__ __forceinline__ unsigned pk2(float lo, float hi) { return f2bf(lo) | (f2bf(hi) << 16); }
__device__ __forceinline__ float bf2f(bf16_t b) { return __uint_as_float((unsigned)b << 16); }

__device__ __forceinline__ float xsum32(float v) { const auto r = __builtin_amdgcn_permlane32_swap(__float_as_uint(v), __float_as_uint(v), false, false); return __uint_as_float(r[0]) + __uint_as_float(r[1]); }
__device__ __forceinline__ float xmax32(float v) { const auto r = __builtin_amdgcn_permlane32_swap(__float_as_uint(v), __float_as_uint(v), false, false); return fmaxf(__uint_as_float(r[0]), __uint_as_float(r[1])); }
__device__ __forceinline__ int xsum32i(int v) { const auto r = __builtin_amdgcn_permlane32_swap((unsigned)v, (unsigned)v, false, false); return (int)(r[0] + r[1]); }
__device__ __forceinline__ float xsum16(float v) { const auto r = __builtin_amdgcn_permlane16_swap(__float_as_uint(v), __float_as_uint(v), false, false); return __uint_as_float(r[0]) + __uint_as_float(r[1]); }
__device__ __forceinline__ float wave_sum64(float v) {
    v += __uint_as_float(__builtin_amdgcn_update_dpp(0, __float_as_uint(v), 0x128, 0xf, 0xf, true));
    v += __uint_as_float(__builtin_amdgcn_update_dpp(0, __float_as_uint(v), 0x124, 0xf, 0xf, true));
    v += __uint_as_float(__builtin_amdgcn_update_dpp(0, __float_as_uint(v), 0x122, 0xf, 0xf, true));
    v += __uint_as_float(__builtin_amdgcn_update_dpp(0, __float_as_uint(v), 0x121, 0xf, 0xf, true));
    return xsum32(xsum16(v));
}
__device__ __forceinline__ float wave_sum(float v) {
#pragma unroll
    for (int o = 32; o > 0; o >>= 1) v += __shfl_xor(v, o);
    return v;
}
__device__ __forceinline__ float wave_max(float v) {
#pragma unroll
    for (int o = 32; o > 0; o >>= 1) v = fmaxf(v, __shfl_xor(v, o));
    return v;
}
__device__ __forceinline__ int wave_sumi(int v) {
#pragma unroll
    for (int o = 32; o > 0; o >>= 1) v += __shfl_xor(v, o);
    return v;
}
__device__ __forceinline__ float block_sum(float v, float* red) {
    v = wave_sum(v);
    __syncthreads();
    if ((threadIdx.x & 63) == 0) red[threadIdx.x >> 6] = v;
    __syncthreads();
    float s = 0.f;
#pragma unroll
    for (int i = 0; i < NW; ++i) s += red[i];
    return s;
}
__device__ __forceinline__ float block_max(float v, float* red) {
    v = wave_max(v);
    __syncthreads();
    if ((threadIdx.x & 63) == 0) red[threadIdx.x >> 6] = v;
    __syncthreads();
    float s = red[0];
#pragma unroll
    for (int i = 1; i < NW; ++i) s = fmaxf(s, red[i]);
    return s;
}
__device__ __forceinline__ int block_sumi(int v, int* red) {
    v = wave_sumi(v);
    __syncthreads();
    if ((threadIdx.x & 63) == 0) red[threadIdx.x >> 6] = v;
    __syncthreads();
    int s = 0;
#pragma unroll
    for (int i = 0; i < NW; ++i) s += red[i];
    return s;
}
__device__ __forceinline__ int block_excl_scan(int v, int* red, int* tot) {
    const int lane = threadIdx.x & 63, w = threadIdx.x >> 6;
    int inc = v;
#pragma unroll
    for (int o = 1; o < 64; o <<= 1) { int n = __shfl_up(inc, o); if (lane >= o) inc += n; }
    __syncthreads();
    if (lane == 63) red[w] = inc;
    __syncthreads();
    int base = 0, t = 0;
#pragma unroll
    for (int i = 0; i < NW; ++i) { if (i < w) base += red[i]; t += red[i]; }
    *tot = t;
    return base + inc - v;
}

__device__ __forceinline__ int phys2logical(int n) { const int p = n & 255; return (n & ~255) + 64 * ((p >> 5) & 3) + 32 * (p >> 7) + (p & 31); }
__device__ __forceinline__ int logical2orig(int n) {
    if (n < 3072) return n;
    if (n < YD_K) return n - YD_Z + O_DZ;
    if (n < YD_V) return n - YD_K + O_DK;
    if (n < YI_Q) return n - YD_V + O_DV;
    if (n < NIN) return n;
    return -1;
}
__device__ __forceinline__ void transpose_item(const float* W, int ldn, const float* gk, bf16_t* WT, int k0, int n0, int src, LAS float* scr, int lane) {
#pragma unroll
    for (int i = 0; i < 32; ++i) {
        const int kk = 2 * i + (lane >> 5);
        float v = 0.f;
        if (src >= 0) { v = W[(size_t)(k0 + kk) * ldn + src]; if (gk) v *= gk[k0 + kk]; }
        scr[kk * 33 + (lane & 31)] = v;
    }
    asm volatile("s_waitcnt lgkmcnt(0)" ::: "memory");
    const int c = lane & 7;
#pragma unroll
    for (int j = 0; j < 4; ++j) {
        const int n = (lane >> 3) + 8 * j; const LAS float* s = scr + (8 * c) * 33 + n;
        u32x4 o; o.x = pk2(s[0 * 33], s[1 * 33]); o.y = pk2(s[2 * 33], s[3 * 33]); o.z = pk2(s[4 * 33], s[5 * 33]); o.w = pk2(s[6 * 33], s[7 * 33]);
        *(GAS u32x4*)(uintptr_t)(WT + (size_t)(n0 + n) * DM + k0 + 8 * c) = o;
    }
    asm volatile("s_waitcnt lgkmcnt(0)" ::: "memory");
}
__device__ __forceinline__ int tid_now(int wave_s) { int lane; asm volatile("v_mbcnt_lo_u32_b32 %0, -1, 0\n\tv_mbcnt_hi_u32_b32 %0, -1, %0" : "=v"(lane)); return wave_s * 64 + lane; }
__device__ __forceinline__ void ph_prologue(const Params& p, LAS unsigned char* lds, int tid_in) {
    int tid = tid_in; asm volatile("" : "+v"(tid));
    const int lane = tid & 63, wave = tid >> 6;
    LAS float* scr = (LAS float*)(lds + wave * 8704);
    const int gw = blockIdx.x * NW + wave, ngw = gridDim.x * NW;
    constexpr int I_IN = DEPTH * 16 * (YP / 32), I_OUT = DEPTH * 16 * (DM / 32);
    for (int it = gw; it < I_IN + I_OUT; it += ngw) {
        if (it < I_IN) {
            const int l = it / (16 * (YP / 32)), r = it % (16 * (YP / 32)), kb = r / (YP / 32), nb = r % (YP / 32);
            const int src = logical2orig(phys2logical(nb * 32 + (lane & 31)));
            transpose_item(p.w_in + (size_t)l * DM * NIN, NIN, p.norm_g + l * DM, p.wt_in() + (size_t)l * YP * DM, kb * 64, nb * 32, src, scr, lane);
        } else {
            const int q = it - I_IN, l = q / (16 * (DM / 32)), r = q % (16 * (DM / 32)), kb = r / (DM / 32), nb = r % (DM / 32);
            transpose_item(p.w_out + (size_t)l * DM * DM, DM, nullptr, p.wt_out() + (size_t)l * DM * DM, kb * 64, nb * 32, nb * 32 + (lane & 31), scr, lane);
        }
    }
    if (blockIdx.x == 0) {
        float* sm = (float*)(p.ws + WS_SMALL);
        for (int i = tid; i < SM_END; i += NT) {
            float v;
            if (i < SM_CONVB) v = p.i_conv_w[i - SM_CONVW]; else if (i < SM_GMLPG) v = p.i_conv_b[i - SM_CONVB]; else if (i < SM_GMLPB) v = p.i_gmlp_g[i - SM_GMLPG];
            else if (i < SM_QG) v = p.i_gmlp_b[i - SM_GMLPB]; else if (i < SM_KG) v = p.i_diff_qg[i - SM_QG]; else if (i < SM_LAM) v = p.i_diff_kg[i - SM_KG];
            else if (i < SM_SUBG) v = p.i_diff_lam[i - SM_LAM]; else if (i < SM_DQG) v = p.i_diff_subg[i - SM_SUBG]; else if (i < SM_DKG) v = p.i_dsa_qg[i - SM_DQG];
            else v = p.i_dsa_kg[i - SM_DKG];
            sm[i] = v;
        }
    }
    for (int i = (blockIdx.x * NT + tid) * 4; i < DEPTH * 4 * 128 * 128; i += gridDim.x * NT * 4) {
        const f32x4 v = *(const GAS f32x4*)(uintptr_t)(p.gmlp_ws + i);
        *(GAS unsigned long long*)(uintptr_t)(p.wsb() + i) = (unsigned long long)pk2(v.x, v.y) | ((unsigned long long)pk2(v.z, v.w) << 32);
    }
    for (int r0 = gw * 4; r0 < NTOK; r0 += ngw * 4) {
        f32x4 v[4][4];
#pragma unroll
        for (int rr = 0; rr < 4; ++rr)
#pragma unroll
            for (int j = 0; j < 4; ++j) v[rr][j] = ((const GAS f32x4*)(uintptr_t)(p.x + (size_t)(r0 + rr) * DM))[lane + 64 * j];
#pragma unroll
        for (int rr = 0; rr < 4; ++rr) {
            GAS unsigned long long* o8 = (GAS unsigned long long*)(uintptr_t)(p.xb() + (size_t)(r0 + rr) * DM) + lane;
            float s = 0.f;
#pragma unroll
            for (int j = 0; j < 4; ++j) {
                const f32x4 q = v[rr][j];
                s += (q.x * q.x + q.y * q.y) + (q.z * q.z + q.w * q.w);
                o8[64 * j] = (unsigned long long)pk2(q.x, q.y) | ((unsigned long long)pk2(q.z, q.w) << 32);
            }
            s = wave_sum64(s);
            if (lane < 16) ((GAS float*)(uintptr_t)p.ssq())[(size_t)(r0 + rr) * 16 + lane] = lane == 0 ? s : 0.f;
        }
    }
}

__device__ __forceinline__ float silu_f(float v) { return v * __builtin_amdgcn_rcpf(1.f + __builtin_amdgcn_exp2f(-1.4426950408889634f * v)); }
struct EpiIn {
    static constexpr bool PERM = true, AFTER_DRAIN = false;
    unsigned char* ws; int l; LAS float* rs;
    __device__ __forceinline__ void operator()(const f32x4 (&acc)[2][2][4][2], const Unit& u, int wr, int wc, int fr_, int fq_) const {
        int fr = fr_, fq = fq_; asm volatile("" : "+v"(fr), "+v"(fq));
        const int pn = u.pn;
        bf16_t* Y = (bf16_t*)(ws + WS_Y); const float* ssq = (const float*)(ws + WS_SSQ); const float* smb = (const float*)(ws + WS_SMALL);
        const float* gmlp_g = smb + SM_GMLPG + l * 256; const float* qg = smb + SM_QG + l * 32; const float* kg = smb + SM_KG + l * 32;
        const float* dqg = smb + SM_DQG + l * 64; const float* dkg = smb + SM_DKG + l * 64;
        int op = 0; const float* g0 = nullptr; const float* g1 = nullptr;
        if (pn == 3 || pn == 6 || pn == 10 || pn == 12) op = 1;
        else if (pn == 4) op = 2;
        else if (pn == 5) { op = 3; g0 = gmlp_g + 64 * wc + 8 * fq; g1 = g0 + 32; }
        else if (pn == 7) { op = 4; g0 = qg + 8 * fq; g1 = g0; }
        else if (pn == 8) { op = 4; g0 = kg + 8 * fq; g1 = g0; }
        else if (pn == 11) { op = 5; g0 = dqg + 8 * fq; g1 = g0 + 32; }
        else if (pn == 13 && wc == 0) { op = 5; g0 = dkg + 8 * fq; g1 = g0 + 32; }
        float gn[16];
#pragma unroll
        for (int i = 0; i < 16; ++i) gn[i] = 1.f;
        if (op >= 3) {
            const f32x4 a = *(const GAS f32x4*)(uintptr_t)g0, b = *(const GAS f32x4*)(uintptr_t)(g0 + 4), c = *(const GAS f32x4*)(uintptr_t)g1, d = *(const GAS f32x4*)(uintptr_t)(g1 + 4);
            gn[0] = a.x; gn[1] = a.y; gn[2] = a.z; gn[3] = a.w; gn[4] = b.x; gn[5] = b.y; gn[6] = b.z; gn[7] = b.w;
            gn[8] = c.x; gn[9] = c.y; gn[10] = c.z; gn[11] = c.w; gn[12] = d.x; gn[13] = d.y; gn[14] = d.z; gn[15] = d.w;
        }
        const int colb = pn * 256 + 64 * wc + 8 * fq;
        {
            const int t = wr * 256 + wc * 64 + fq * 16 + fr;
            if (t < 256) {
                const f32x4* sp = (const f32x4*)(ssq + (size_t)(u.pm * 256 + t) * 16);
                const f32x4 s0 = sp[0], s1 = sp[1], s2 = sp[2], s3 = sp[3];
                const float tot = ((s0.x + s0.y) + (s0.z + s0.w)) + ((s1.x + s1.y) + (s1.z + s1.w)) + ((s2.x + s2.y) + (s2.z + s2.w)) + ((s3.x + s3.y) + (s3.z + s3.w));
                rs[t] = rsqrtf(tot * (1.f / DM) + EPS);
            }
            asm volatile("s_waitcnt vmcnt(0) lgkmcnt(0)" ::: "memory"); __builtin_amdgcn_s_barrier(); asm volatile("" ::: "memory");
        }
#pragma unroll
        for (int ai = 0; ai < 2; ++ai)
#pragma unroll
            for (int m = 0; m < 4; ++m) {
                const int row = u.pm * 256 + ai * 128 + wr * 64 + m * 16 + fr;
                const float rstd = rs[ai * 128 + wr * 64 + m * 16 + fr];
                float v[16];
#pragma unroll
                for (int bj = 0; bj < 2; ++bj)
#pragma unroll
                    for (int n = 0; n < 2; ++n)
#pragma unroll
                        for (int e = 0; e < 4; ++e) v[bj * 8 + n * 4 + e] = acc[ai][bj][m][n][e] * rstd;
                if (op == 1) {
#pragma unroll
                    for (int i = 0; i < 16; ++i) v[i] = silu_f(v[i]);
                } else if (op == 2 || op == 3) {
#pragma unroll
                    for (int i = 0; i < 16; i += 2) { const pg8::f32x2 r = pg8::gelu_pk((pg8::f32x2){v[i], v[i + 1]}); v[i] = r.x; v[i + 1] = r.y; }
                }
                if (op == 3 || op == 5) {
                    float ss = 0.f;
#pragma unroll
                    for (int i = 0; i < 16; ++i) ss += v[i] * v[i];
                    ss = xsum16(ss); ss = xsum32(ss);
                    const float sc = rsqrtf(ss * (1.f / 64) + EPS);
#pragma unroll
                    for (int i = 0; i < 16; ++i) v[i] *= sc * gn[i];
                } else if (op == 4) {
#pragma unroll
                    for (int bj = 0; bj < 2; ++bj) {
                        float ss = 0.f;
#pragma unroll
                        for (int i = 0; i < 8; ++i) ss += v[bj * 8 + i] * v[bj * 8 + i];
                        ss = xsum16(ss); ss = xsum32(ss);
                        const float sc = rsqrtf(ss * (1.f / 32) + EPS);
#pragma unroll
                        for (int i = 0; i < 8; ++i) v[bj * 8 + i] *= sc * gn[bj * 8 + i];
                    }
                }
                bf16_t* rowp = Y + (size_t)row * YP + colb;
#pragma unroll
                for (int bj = 0; bj < 2; ++bj) {
                    u32x4 w; w.x = pg8::cvt_pk_bf16(v[bj * 8 + 0], v[bj * 8 + 1]); w.y = pg8::cvt_pk_bf16(v[bj * 8 + 2], v[bj * 8 + 3]);
                    w.z = pg8::cvt_pk_bf16(v[bj * 8 + 4], v[bj * 8 + 5]); w.w = pg8::cvt_pk_bf16(v[bj * 8 + 6], v[bj * 8 + 7]);
                    *(GAS u32x4*)(uintptr_t)(rowp + 32 * bj) = w;
                }
            }
    }
};
struct EpiOut {
    static constexpr bool PERM = false, AFTER_DRAIN = false;
    float* xout; unsigned char* ws;
    __device__ __forceinline__ void operator()(const f32x4 (&acc)[2][2][4][2], const Unit& u, int wr, int wc, int fr_, int fq_) const {
        int fr = fr_, fq = fq_; asm volatile("" : "+v"(fr), "+v"(fq));
        const int col0 = u.pn * 256 + wc * 32 + 4 * fq;
        bf16_t* xb = (bf16_t*)(ws + WS_XB); float* ssq = (float*)(ws + WS_SSQ);
#pragma unroll
        for (int ai = 0; ai < 2; ++ai)
#pragma unroll
            for (int m = 0; m < 4; ++m) {
                const int row = u.pm * 256 + ai * 128 + wr * 64 + m * 16 + fr;
                float sq = 0.f;
#pragma unroll
                for (int bj = 0; bj < 2; ++bj)
#pragma unroll
                    for (int n = 0; n < 2; ++n) {
                        const size_t off = (size_t)row * DM + col0 + bj * 128 + n * 16;
                        const unsigned long long xo = *(const GAS unsigned long long*)(uintptr_t)(xb + off);
                        f32x4 v = acc[ai][bj][m][n];
                        v.x += __uint_as_float((unsigned)xo << 16); v.y += __uint_as_float((unsigned)xo & 0xffff0000u);
                        v.z += __uint_as_float((unsigned)(xo >> 32) << 16); v.w += __uint_as_float((unsigned)(xo >> 32) & 0xffff0000u);
                        sq += (v.x * v.x + v.y * v.y) + (v.z * v.z + v.w * v.w);
                        if (xout) *(GAS f32x4*)(uintptr_t)(xout + off) = v;
                        else *(GAS unsigned long long*)(uintptr_t)(xb + off) = (unsigned long long)pg8::cvt_pk_bf16(v.x, v.y) | ((unsigned long long)pg8::cvt_pk_bf16(v.z, v.w) << 32);
                    }
                sq = xsum16(sq); sq = xsum32(sq);
                if (fq == 0) ssq[(size_t)row * 16 + u.pn * 4 + wc] = sq;
                if (m == 3) asm volatile("" ::: "memory");
            }
    }
};
#define XB_TMO      128
#define XB_XCNT(j)  (256  + 64 * (j))
#define XB_XSUB(j)  (1280 + 64 * (j))
#define XB_XGEN(j)  (2304 + 64 * (j))
#define XB_TOP      3328
#define XB_TOPGEN   3392
#define XCD_BAR_WORDS 3456
#define XB_SPIN_CAP (1u << 18)

__device__ __forceinline__ unsigned xb_ld(unsigned* p)              { return __hip_atomic_load(p, __ATOMIC_RELAXED, __HIP_MEMORY_SCOPE_AGENT); }
__device__ __forceinline__ unsigned xb_add(unsigned* p, unsigned v) { return __hip_atomic_fetch_add(p, v, __ATOMIC_RELAXED, __HIP_MEMORY_SCOPE_AGENT); }
__device__ __forceinline__ unsigned xb_xcc_id() { return (unsigned)__builtin_amdgcn_s_getreg((3 << 11) | 20) & 0xFu; }
#define XB_SPIN(cond, bar) do { unsigned _sp = 0; while (cond) { __builtin_amdgcn_s_sleep(1); \
    if ((++_sp & 255u) == 0u) { if (xb_ld(&(bar)[XB_TMO])) break; if (_sp > XB_SPIN_CAP) { atomicAdd(&(bar)[XB_TMO], 1u); break; } } } } while (0)

struct XcdBarrier {
    unsigned* bar; unsigned x;
    volatile LAS unsigned* st;
};

__device__ __forceinline__ XcdBarrier xcd_barrier_post(unsigned* bar, volatile LAS unsigned* st) {
    XcdBarrier b; b.bar = bar; b.x = xb_xcc_id(); b.st = st;
    if (threadIdx.x == 0) (void)xb_add(&bar[XB_XCNT(b.x)], 1u);
    return b;
}
__device__ __forceinline__ void xcd_barrier_complete(unsigned* bar, unsigned x, unsigned& nloc, unsigned& nx) {
    const unsigned G = gridDim.x * gridDim.y * gridDim.z;
    unsigned sum, cnt, mine, sp = 0u;
    for (;;) {
        sum = 0u; cnt = 0u; mine = 0u;
#pragma unroll
        for (unsigned j = 0; j < 16; ++j) { const unsigned c = xb_ld(&bar[XB_XCNT(j)]); sum += c; cnt += (c > 0u) ? 1u : 0u; mine = (j == x) ? c : mine; }
        if (sum == G) break;
        __builtin_amdgcn_s_sleep(1);
        if ((++sp & 255u) == 0u) { if (xb_ld(&bar[XB_TMO])) break; if (sp > XB_SPIN_CAP) { atomicAdd(&bar[XB_TMO], 1u); break; } }
    }
    nloc = mine > 0u ? mine : 1u; nx = cnt > 0u ? cnt : 1u;
}

__device__ __forceinline__ void xcd_barrier(const XcdBarrier& b, int tid_in) {
    asm volatile("s_waitcnt vmcnt(0)" ::: "memory");
    __syncthreads();
    int t0_ = tid_in; asm volatile("" : "+v"(t0_));
    if (t0_ == 0) {
        unsigned* bar = b.bar; unsigned bx = b.x; asm volatile("" : "+s"(bar), "+s"(bx));
        __builtin_amdgcn_s_waitcnt(0);
        unsigned nloc = b.st[0], nx = b.st[1];
        if (nloc == 0u) { xcd_barrier_complete(bar, bx, nloc, nx); b.st[0] = nloc; b.st[1] = nx; }
        const unsigned old = xb_add(&bar[XB_XSUB(bx)], 1u);
        const unsigned gen = old / nloc;
        if (old + 1u == (gen + 1u) * nloc) {
            __builtin_amdgcn_fence(__ATOMIC_RELEASE, "agent");
            asm volatile("s_waitcnt vmcnt(0)" ::: "memory");
            const unsigned og = xb_add(&bar[XB_TOP], 1u);
            const unsigned tg = og / nx;
            if (og + 1u == (tg + 1u) * nx) xb_add(&bar[XB_TOPGEN], 1u);
            else XB_SPIN(xb_ld(&bar[XB_TOPGEN]) == tg, bar);
            __builtin_amdgcn_fence(__ATOMIC_ACQUIRE, "agent");
            xb_add(&bar[XB_XGEN(bx)], 1u);
            asm volatile("s_waitcnt vmcnt(0)" ::: "memory");
        } else {
            XB_SPIN(xb_ld(&bar[XB_XGEN(bx)]) == gen, bar);
            __builtin_amdgcn_fence(__ATOMIC_ACQUIRE, "agent");
            asm volatile("s_waitcnt vmcnt(0)" ::: "memory");
        }
    }
    __syncthreads();
}

typedef short bf16x8_t __attribute__((ext_vector_type(8)));
typedef short s16x4_t __attribute__((ext_vector_type(4)));
typedef float f32x16 __attribute__((ext_vector_type(16)));
typedef float f32x2_t __attribute__((ext_vector_type(2)));
typedef __bf16 bf16x2_t __attribute__((ext_vector_type(2)));
#define MFMA32(a, b, c) __builtin_amdgcn_mfma_f32_32x32x16_bf16((a), (b), (c), 0, 0, 0)
__device__ __forceinline__ unsigned cvtpk(float lo, float hi) { f32x2_t v = {lo, hi}; bf16x2_t b = __builtin_convertvector(v, bf16x2_t); return __builtin_bit_cast(unsigned, b); }
__device__ __forceinline__ s16x4_t ds_tr16(const LAS unsigned char* p) { return __builtin_bit_cast(s16x4_t, __builtin_amdgcn_ds_read_tr16_b64_v4i16((LAS s16x4_t*)p)); }
__device__ __forceinline__ bf16x8_t pack_step(const f32x16& x, int s) {
    u32x4 p; p.x = cvtpk(x[8 * s], x[8 * s + 1]); p.y = cvtpk(x[8 * s + 2], x[8 * s + 3]); p.z = cvtpk(x[8 * s + 4], x[8 * s + 5]); p.w = cvtpk(x[8 * s + 6], x[8 * s + 7]);
    return __builtin_bit_cast(bf16x8_t, p);
}
constexpr int KV_STRIDE = 144;
constexpr int KV_TILE = 64 * KV_STRIDE;
__device__ __forceinline__ bf16x8_t vt_frag(const LAS unsigned char* vtile, int ks, int db, int lane) {
    const int i16 = lane & 15, q = i16 >> 2, pp = i16 & 3, blk = (lane >> 4) & 1, hh = lane >> 5;
    const LAS unsigned char* a = vtile + (16 * ks + 4 * hh + q) * KV_STRIDE + (32 * db + 16 * blk + 4 * pp) * 2;
    const s16x4_t lo = ds_tr16(a), hi = ds_tr16(a + 8 * KV_STRIDE);
    return __builtin_shufflevector(lo, hi, 0, 1, 2, 3, 4, 5, 6, 7);
}

constexpr int KVL_TILE = 64 * 128;
__device__ __forceinline__ void dma_piece(const bf16_t* src_row0, LAS unsigned char* dst, int lane) {
    const bf16_t* g = src_row0 + (size_t)(lane >> 3) * YP + (((lane & 7) ^ (lane >> 3)) * 8);
    const unsigned d = (unsigned)__builtin_amdgcn_readfirstlane((int)(unsigned)(size_t)dst);
    unsigned keep;
    asm volatile("s_mov_b32 %0, m0\n\ts_mov_b32 m0, %2\n\ts_nop 0\n\tglobal_load_lds_dwordx4 %1, off\n\ts_mov_b32 m0, %0" : "=&s"(keep) : "v"(g), "s"(d) : "memory");
}
__device__ __forceinline__ bf16x8_t vt_frag_sw(const LAS unsigned char* vtile, int ks, int db, int lane) {
    const int i16 = lane & 15, q = i16 >> 2, pp = i16 & 3, blk = (lane >> 4) & 1, hh = lane >> 5;
    const int row = 16 * ks + 4 * hh + q, ch = 4 * db + 2 * blk + (pp >> 1);
    const LAS unsigned char* a = vtile + row * 128 + ((ch ^ (row & 7)) * 16) + (pp & 1) * 8;
    const s16x4_t lo = ds_tr16(a), hi = ds_tr16(a + 8 * 128);
    return __builtin_shufflevector(lo, hi, 0, 1, 2, 3, 4, 5, 6, 7);
}

__device__ __forceinline__ void mixC_unit(const Params& p, int l, int b, int h, int qt, LAS unsigned char* lds, int wave_s) {
    const int tid = tid_now(wave_s);
    volatile LAS float* pc = (volatile LAS float*)(lds + 131072 + 2048);
    const float mfix = pc[0];
    const int lane = tid & 63, wave = __builtin_amdgcn_readfirstlane(tid >> 6), r32 = lane & 31, hh = lane >> 5;
    const size_t rowb = (size_t)b * SEQ;
    const int q0 = qt * 256 + wave * 32;
    const int cw = (q0 >> 6);
    const int jmax = 4 * qt + 3;
    const int pos = q0 + r32;
    const bf16_t* yq = p.Y() + (rowb + pos) * YP;
    bf16x8_t qf[2][2];
#pragma unroll
    for (int c = 0; c < 2; ++c)
#pragma unroll
        for (int s = 0; s < 2; ++s) qf[c][s] = *(const GAS bf16x8_t*)(uintptr_t)(yq + YC_Q + h * 64 + c * 32 + 16 * s + 8 * hh);
    const float c1 = 0.17677669529663687f * 1.4426950408889634f;
    const float sl2 = exp2f(-(float)(2 * h + 1)) * 1.4426950408889634f;
    f32x16 o[2][2];
#pragma unroll
    for (int c = 0; c < 2; ++c)
#pragma unroll
        for (int d = 0; d < 2; ++d)
#pragma unroll
            for (int i = 0; i < 16; ++i) o[c][d][i] = 0.f;
    float lrun[2] = {0.f, 0.f};
    const bf16_t* ksrc = p.Y() + (rowb + 8 * wave) * YP + YC_K + h * 64;
    const bf16_t* vsrc = p.Y() + (rowb + 8 * wave) * YP + YC_V + h * 64;
    LAS unsigned char* kring = lds;
    LAS unsigned char* vring = lds + 3 * KVL_TILE;
    asm volatile("" : "+v"(qf[0][0]), "+v"(qf[0][1]), "+v"(qf[1][0]), "+v"(qf[1][1]));
    const float mfix_r = mfix; asm volatile("" :: "v"(mfix_r));
    asm volatile("s_waitcnt lgkmcnt(0)" ::: "memory"); __builtin_amdgcn_s_barrier(); asm volatile("" ::: "memory");
    dma_piece(ksrc, kring + wave * 1024, lane); dma_piece(vsrc, vring + wave * 1024, lane);
    if (jmax >= 1) { dma_piece(ksrc + (size_t)64 * YP, kring + KVL_TILE + wave * 1024, lane); dma_piece(vsrc + (size_t)64 * YP, vring + KVL_TILE + wave * 1024, lane); }
    int slot = 0, slot2 = 2;
    for (int j = 0; j <= jmax; ++j) {
        TB(3, lds, tid);
        if (j < jmax) asm volatile("s_waitcnt vmcnt(2)" ::: "memory"); else asm volatile("s_waitcnt vmcnt(0)" ::: "memory");
        __builtin_amdgcn_s_barrier(); asm volatile("" ::: "memory");
        TE(3, lds, tid);
        TB(2, lds, tid);
        if (j + 2 <= jmax) { dma_piece(ksrc + (size_t)(j + 2) * 64 * YP, kring + slot2 * KVL_TILE + wave * 1024, lane); dma_piece(vsrc + (size_t)(j + 2) * 64 * YP, vring + slot2 * KVL_TILE + wave * 1024, lane); }
        if (j <= cw) {
            const LAS unsigned char* kt = kring + slot * KVL_TILE;
            const LAS unsigned char* vt = vring + slot * KVL_TILE;
            const float pl = (float)(pos - 64 * j - 4 * hh);
            const bool diag = (j == cw);
#pragma unroll
            for (int c = 0; c < 2; ++c) {
                f32x16 sc[2];
#pragma unroll
                for (int kb = 0; kb < 2; ++kb) {
                    f32x16 a;
#pragma unroll
                    for (int i = 0; i < 16; ++i) a[i] = 0.f;
#pragma unroll
                    for (int s = 0; s < 2; ++s) {
                        const bf16x8_t kf = *(const LAS bf16x8_t*)(kt + (32 * kb + r32) * 128 + (((4 * c + 2 * s + hh) ^ (r32 & 7)) * 16));
                        a = MFMA32(kf, qf[c][s], a);
                    }
                    sc[kb] = a;
                }
                float ls4[4] = {0.f, 0.f, 0.f, 0.f};
                if (!diag) {
                    const float rt = -sl2 * pl - mfix;
#pragma unroll
                    for (int kb = 0; kb < 2; ++kb)
#pragma unroll
                        for (int i = 0; i < 16; ++i) {
                            const float kc = (float)(32 * kb + (i & 3) + 8 * (i >> 2));
                            const float e = __builtin_amdgcn_exp2f(fmaf(sc[kb][i], c1, fmaf(sl2, kc, rt)));
                            sc[kb][i] = e; ls4[i & 3] += e;
                        }
                } else {
#pragma unroll
                    for (int kb = 0; kb < 2; ++kb)
#pragma unroll
                        for (int i = 0; i < 16; ++i) {
                            const float kc = (float)(32 * kb + (i & 3) + 8 * (i >> 2));
                            const float e = __builtin_amdgcn_exp2f(fmaf(sc[kb][i], c1, fmaf(-sl2, fabsf(pl - kc), -mfix)));
                            sc[kb][i] = e; ls4[i & 3] += e;
                        }
                }
                lrun[c] += (ls4[0] + ls4[1]) + (ls4[2] + ls4[3]);
#pragma unroll
                for (int ks = 0; ks < 4; ++ks) {
                    const bf16x8_t pf = pack_step(sc[ks >> 1], ks & 1);
#pragma unroll
                    for (int db = 0; db < 2; ++db) o[c][db] = MFMA32(vt_frag_sw(vt, ks, db, lane), pf, o[c][db]);
                }
            }
        }
        TE(2, lds, tid);
        slot = slot == 2 ? 0 : slot + 1; slot2 = slot2 == 2 ? 0 : slot2 + 1;
    }
    const float lam = pc[1], oml = pc[2];
    const int tid2 = tid_now(wave_s), lane2 = tid2 & 63, r32e = lane2 & 31, hhe = lane2 >> 5;
    const int pose = qt * 256 + wave * 32 + r32e;
    const bf16_t* yqe = p.Y() + (rowb + pose) * YP;
    const float l1 = xsum32(lrun[0]), l2 = xsum32(lrun[1]);
    const float i1 = 1.f / l1, i2 = lam / l2;
    float ss = 0.f;
#pragma unroll
    for (int d = 0; d < 2; ++d)
#pragma unroll
        for (int i = 0; i < 16; ++i) { const float v = o[0][d][i] * i1 - o[1][d][i] * i2; o[0][d][i] = v; ss += v * v; }
    ss = xsum32(ss);
    const float rn = rsqrtf(ss * (1.f / 64) + EPS) * oml;
    const GAS float* sg = p.sm(SM_SUBG) + l * 256 + h * 64;
    bf16_t* mrow = p.mix() + (rowb + pose) * DM + 512 + h * 64;
#pragma unroll
    for (int d = 0; d < 2; ++d)
#pragma unroll
        for (int g = 0; g < 4; ++g) {
            const int d0 = 32 * d + 8 * g + 4 * hhe;
            const f32x4 gv = *(const GAS f32x4*)(uintptr_t)(sg + d0);
            const unsigned long long zz = *(const GAS unsigned long long*)(uintptr_t)(yqe + YC_Z + h * 64 + d0);
            const float z0 = __uint_as_float((unsigned)(zz & 0xffffu) << 16), z1 = __uint_as_float((unsigned)((zz >> 16) & 0xffffu) << 16),
                        z2 = __uint_as_float((unsigned)((zz >> 32) & 0xffffu) << 16), z3 = __uint_as_float((unsigned)((zz >> 48) & 0xffffu) << 16);
            const float v0 = o[0][d][4 * g] * rn * gv.x * z0, v1 = o[0][d][4 * g + 1] * rn * gv.y * z1, v2 = o[0][d][4 * g + 2] * rn * gv.z * z2, v3 = o[0][d][4 * g + 3] * rn * gv.w * z3;
            *(GAS unsigned long long*)(uintptr_t)(mrow + d0) = (unsigned long long)cvtpk(v0, v1) | ((unsigned long long)cvtpk(v2, v3) << 32);
        }
}
__device__ __forceinline__ void ph_mixC(const Params& p, int l, LAS unsigned char* lds, int bid, int nb, int wave_s) {
    {
        const float lam_init = l == 0 ? 0.200000001f : l == 1 ? 0.355509068f : l == 2 ? 0.470713018f : 0.556058204f;
        const GAS float* lp = p.sm(SM_LAM) + l * 128;
        float d1 = 0.f, d2 = 0.f;
        for (int i = 0; i < 32; ++i) { d1 += lp[i] * lp[32 + i]; d2 += lp[64 + i] * lp[96 + i]; }
        float gq = 0.f, gk = 0.f;
        for (int i = 0; i < 32; ++i) { gq = fmaxf(gq, fabsf(p.sm(SM_QG)[l * 32 + i])); gk = fmaxf(gk, fabsf(p.sm(SM_KG)[l * 32 + i])); }
        volatile LAS float* pc = (volatile LAS float*)(lds + 131072 + 2048);
        if (tid_now(wave_s) == 0) {
            pc[0] = 0.17677669529663687f * 1.4426950408889634f * 32.f * gq * gk * 1.02f;
            pc[1] = expf(d1) - expf(d2) + lam_init;
            pc[2] = 1.f - lam_init;
        }
        __syncthreads();
    }
    for (int i = bid; i < 256; i += nb) {
#pragma unroll 1
        for (int k = 0; k < 2; ++k) {
            const int id = k == 0 ? i : 511 - i;
            const int qt = id < 256 ? 7 - (id >> 6) : 3 - ((id - 256) >> 6), bh = id & 63;
            mixC_unit(p, l, bh >> 2, bh & 3, qt, lds, wave_s);
        }
    }
}

constexpr int SC_STRIDE = 2052;
constexpr int SC_BYTES = 16 * SC_STRIDE * 4;
constexpr int IK_STRIDE = 80, IK_TILE = 64 * IK_STRIDE;
__device__ __forceinline__ unsigned fkey(float f) { const unsigned u = __float_as_uint(f); return (u & 0x80000000u) ? ~u : (u | 0x80000000u); }
__device__ __forceinline__ float unfkey(unsigned k) { return __uint_as_float((k & 0x80000000u) ? (k & 0x7fffffffu) : ~k); }
__device__ __forceinline__ f32x16 idx_scores(const bf16x8_t ik0, const bf16x8_t ik1, const bf16x8_t (&iqf)[4][2], const float (&w)[4]) {
    f32x16 sc;
#pragma unroll
    for (int i = 0; i < 16; ++i) sc[i] = 0.f;
#pragma unroll
    for (int hd = 0; hd < 4; ++hd) {
        f32x16 a;
#pragma unroll
        for (int i = 0; i < 16; ++i) a[i] = 0.f;
        a = MFMA32(ik0, iqf[hd][0], a);
        a = MFMA32(ik1, iqf[hd][1], a);
#pragma unroll
        for (int i = 0; i < 16; ++i) sc[i] = fmaf(w[hd], __builtin_amdgcn_fmed3f(a[i], 0.f, __builtin_inff()), sc[i]);
    }
#pragma unroll
    for (int i = 0; i < 16; ++i) sc[i] = sc[i] + 0.f;
    return sc;
}
__device__ __forceinline__ void transpose32(unsigned (&a)[32]) {
#pragma unroll
    for (int s = 0; s < 5; ++s) {
        const int j = 16 >> s;
        const unsigned mk = j == 16 ? 0x0000ffffu : j == 8 ? 0x00ff00ffu : j == 4 ? 0x0f0f0f0fu : j == 2 ? 0x33333333u : 0x55555555u;
#pragma unroll
        for (int k = 0; k < 32; ++k)
            if ((k & j) == 0) { const unsigned t = (a[k] ^ (a[k + j] >> j)) & mk; a[k] ^= t; a[k + j] ^= t << j; asm volatile("" : "+v"(a[k]), "+v"(a[k + j])); }
    }
}
__device__ __forceinline__ int rowsum16(int v) {
    v += __builtin_amdgcn_update_dpp(0, v, 0x128, 0xf, 0xf, true);
    v += __builtin_amdgcn_update_dpp(0, v, 0x124, 0xf, 0xf, true);
    v += __builtin_amdgcn_update_dpp(0, v, 0x122, 0xf, 0xf, true);
    v += __builtin_amdgcn_update_dpp(0, v, 0x121, 0xf, 0xf, true);
    return v;
}
__device__ __forceinline__ unsigned topbits(int ne) { return ne <= 0 ? 0u : ne >= 32 ? 0xffffffffu : (0xffffffffu << (32 - ne)); }
template <int ST>
__device__ __forceinline__ void rs4_row(const unsigned (&pl)[4][32], unsigned (&alive)[4], int& above, unsigned& prefix, bool& done, bool& alld, int nmr) {
    if (!alld) {
        int c11 = 0, c10 = 0, c01 = 0;
#pragma unroll
        for (int j = 0; j < 4; ++j)
            if (j < nmr) {
                const unsigned p1 = pl[j][2 * ST], p0 = pl[j][2 * ST + 1], a1 = alive[j] & p1, a0 = alive[j] & ~p1;
                c11 += __popc(a1 & p0); c10 += __popc(a1 & ~p0); c01 += __popc(a0 & p0);
            }
        const int s01 = rowsum16(c11 | (c10 << 16)), s2 = rowsum16(c01);
        if (!done) {
            const int t11 = above + (s01 & 0xffff), t10 = t11 + (int)((unsigned)s01 >> 16), t01 = t10 + s2;
            const int dg = t11 >= TOPK ? 3 : t10 >= TOPK ? 2 : t01 >= TOPK ? 1 : 0;
            const int tsel = dg == 3 ? t11 : dg == 2 ? t10 : t01;
            prefix |= (unsigned)dg << (30 - 2 * ST);
            above = dg == 3 ? above : dg == 2 ? t11 : dg == 1 ? t10 : t01;
#pragma unroll
            for (int j = 0; j < 4; ++j)
                if (j < nmr) {
                    const unsigned p1 = pl[j][2 * ST], p0 = pl[j][2 * ST + 1];
                    alive[j] &= ((dg & 2) ? p1 : ~p1) & ((dg & 1) ? p0 : ~p0);
                }
            if (dg != 0 && tsel == TOPK) done = true;
        }
        alld = __all(done);
    }
    if constexpr (ST < 15) rs4_row<ST + 1>(pl, alive, above, prefix, done, alld, nmr);
}
__device__ __forceinline__ void mixD_attend(const Params& p, int b, int c, LAS unsigned char* lds, int wave_s);
__device__ __forceinline__ void mixD_unit(const Params& p, int b, int c, LAS unsigned char* lds, int wave_s) {
    const int tid = tid_now(wave_s);
    const int lane = tid & 63, wave = __builtin_amdgcn_readfirstlane(tid >> 6), r32 = lane & 31, hh = lane >> 5;
    const size_t rowb = (size_t)b * SEQ;
    const int q0 = c * 64, ntile = c + 1;
    LAS float* thr = (LAS float*)(lds + 131072 + 1024);
    LAS int* kcs = (LAS int*)(lds + 131072 + 1280);
    const bool dosel = c >= 4;
    __syncthreads();
    if (dosel) {
        constexpr int SKS = 1028;
        LAS unsigned* sk = (LAS unsigned*)lds;
        const int nblk = 2 * ntile;
        const int nbw = (nblk - wave + 7) >> 3;
        const int nv = 4 * ntile;
        const int nmr = (nv + 31) >> 5;
#pragma unroll 1
        for (int sp = 0; sp < 2; ++sp) {
            TB(4, lds, tid); TB(5, lds, tid);
            unsigned kr[4][32];
            unsigned zopq = 0u; asm volatile("" : "+v"(zopq));
            {
                const bf16_t* yq1 = p.Y() + (rowb + q0 + 32 * sp + r32) * YP;
                bf16x8_t iqf[4][2];
#pragma unroll
                for (int hd = 0; hd < 4; ++hd)
#pragma unroll
                    for (int s = 0; s < 2; ++s) iqf[hd][s] = *(const GAS bf16x8_t*)(uintptr_t)(yq1 + YI_Q + hd * 32 + 16 * s + 8 * hh);
                float w[4];
                const unsigned long long ww = *(const GAS unsigned long long*)(uintptr_t)(yq1 + YI_W);
#pragma unroll
                for (int hd = 0; hd < 4; ++hd) w[hd] = __uint_as_float((unsigned)((ww >> (16 * hd)) & 0xffffu) << 16) * (0.17677669529663687f * 0.5f);
#pragma unroll
                for (int g = 0; g < 2; ++g) {
                    bf16x8_t ik[4][2];
#pragma unroll
                    for (int i = 0; i < 4; ++i) {
                        const int kb = 4 * g + i < nbw ? wave + 8 * (4 * g + i) : wave;
                        const bf16_t* yk = p.Y() + (rowb + 32 * kb + r32) * YP + YI_K + 8 * hh;
                        ik[i][0] = *(const GAS bf16x8_t*)(uintptr_t)yk; ik[i][1] = *(const GAS bf16x8_t*)(uintptr_t)(yk + 16);
                    }
#pragma unroll
                    for (int i = 0; i < 4; ++i) {
                        const int blk = 4 * g + i;
                        if (blk < nbw) {
                            const f32x16 sc = idx_scores(ik[i][0], ik[i][1], iqf, w);
#pragma unroll
                            for (int r = 0; r < 16; ++r) kr[blk >> 1][16 * (blk & 1) + r] = fkey(sc[r]);
                        } else {
#pragma unroll
                            for (int r = 0; r < 16; ++r) kr[blk >> 1][16 * (blk & 1) + r] = zopq;
                        }
                    }
                    asm volatile("" ::: "memory");
                }
            }
            TE(5, lds, tid); TB(20, lds, tid);
            unsigned pl[4][32];
            {
                const int rq = 4 * wave + (lane >> 4), rt = lane & 15;
#pragma unroll
                for (int rd = 0; rd < 2; ++rd) {
#pragma unroll
                    for (int i = 0; i < 4; ++i)
#pragma unroll
                        for (int g = 0; g < 4; ++g) {
                            const int blk = 4 * rd + i;
                            u32x4 v; v.x = kr[blk >> 1][16 * (blk & 1) + 4 * g]; v.y = kr[blk >> 1][16 * (blk & 1) + 4 * g + 1]; v.z = kr[blk >> 1][16 * (blk & 1) + 4 * g + 2]; v.w = kr[blk >> 1][16 * (blk & 1) + 4 * g + 3];
                            *(LAS u32x4*)(sk + r32 * SKS + 32 * wave + 256 * i + 8 * g + 4 * hh) = v;
                        }
                    __syncthreads();
#pragma unroll
                    for (int M = 0; M < 16; ++M) {
                        const u32x4 v = *(const LAS u32x4*)(sk + rq * SKS + 64 * M + 4 * rt);
                        pl[2 * rd + (M >> 3)][4 * (M & 7)] = v.x; pl[2 * rd + (M >> 3)][4 * (M & 7) + 1] = v.y; pl[2 * rd + (M >> 3)][4 * (M & 7) + 2] = v.z; pl[2 * rd + (M >> 3)][4 * (M & 7) + 3] = v.w;
                    }
                    __syncthreads();
                }
            }
            TE(20, lds, tid); TB(6, lds, tid);
#pragma unroll
            for (int j = 0; j < 4; ++j) transpose32(pl[j]);
            TE(6, lds, tid); TB(7, lds, tid);
            unsigned alive[4];
#pragma unroll
            for (int j = 0; j < 4; ++j) alive[j] = topbits(nv - 32 * j);
            int above = 0; unsigned prefix = 0u; bool done = false, alld = false;
            rs4_row<0>(pl, alive, above, prefix, done, alld, nmr);
            TE(7, lds, tid); TB(8, lds, tid);
            int kcut = 1 << 20;
            if (!__all(done)) {
                const int need = TOPK - above, rt = lane & 15;
                int posk = 0;
#pragma unroll 1
                for (int b2 = 10; b2 >= 0; --b2) {
                    const int tt = posk | (1 << b2);
                    const int R = tt - 4 * rt;
                    const int M = R <= 0 ? 0 : 4 * (R >> 6) + min(R & 63, 4);
                    int c = 0;
#pragma unroll
                    for (int j = 0; j < 4; ++j) c += __popc(alive[j] & topbits(M - 32 * j));
                    const int f = rowsum16(c);
                    if (f < need) posk = tt;
                }
                if (!done) kcut = posk;
            }
            TE(8, lds, tid); TE(4, lds, tid);
            if ((lane & 15) == 0) { thr[32 * sp + 4 * wave + (lane >> 4)] = unfkey(prefix); kcs[32 * sp + 4 * wave + (lane >> 4)] = kcut; }
            __syncthreads();
        }
    }
    mixD_attend(p, b, c, lds, wave_s);
}
__device__ __forceinline__ void mixD_attend(const Params& p, int b, int c, LAS unsigned char* lds, int wave_s) {
    const int tid = tid_now(wave_s);
    const int lane = tid & 63, wave = __builtin_amdgcn_readfirstlane(tid >> 6), r32 = lane & 31, hh = lane >> 5;
    const size_t rowb = (size_t)b * SEQ;
    const int q0 = c * 64, ntile = c + 1;
    LAS float* thr = (LAS float*)(lds + 131072 + 1024);
    LAS int* kcs = (LAS int*)(lds + 131072 + 1280);
    const bool dosel = c >= 4;
    TB(9, lds, tid);
    const int qg = wave >> 2, hd = wave & 3;
    const int pos = q0 + 32 * qg + r32;
    const bf16_t* yq = p.Y() + (rowb + pos) * YP;
    bf16x8_t qf[4];
#pragma unroll
    for (int s = 0; s < 4; ++s) qf[s] = *(const GAS bf16x8_t*)(uintptr_t)(yq + YD_Q + hd * 64 + 16 * s + 8 * hh);
    bf16x8_t iqf[4][2];
    float w[4];
    float T = -INFINITY; int kcut = 1 << 20;
    if (dosel) {
#pragma unroll
        for (int h2 = 0; h2 < 4; ++h2)
#pragma unroll
            for (int s = 0; s < 2; ++s) iqf[h2][s] = *(const GAS bf16x8_t*)(uintptr_t)(yq + YI_Q + h2 * 32 + 16 * s + 8 * hh);
        const unsigned long long ww = *(const GAS unsigned long long*)(uintptr_t)(yq + YI_W);
#pragma unroll
        for (int h2 = 0; h2 < 4; ++h2) w[h2] = __uint_as_float((unsigned)((ww >> (16 * h2)) & 0xffffu) << 16) * (0.17677669529663687f * 0.5f);
        T = thr[32 * qg + r32]; kcut = kcs[32 * qg + r32];
    } else {
#pragma unroll
        for (int h2 = 0; h2 < 4; ++h2) { w[h2] = 0.f;
#pragma unroll
            for (int s = 0; s < 2; ++s)
#pragma unroll
                for (int e = 0; e < 8; ++e) iqf[h2][s][e] = 0; }
    }
    const float c1 = 0.125f * 1.4426950408889634f;
    const float sl2 = exp2f(-(float)(2 * hd + 2)) * 1.4426950408889634f;
    f32x16 o[2];
#pragma unroll
    for (int d = 0; d < 2; ++d)
#pragma unroll
        for (int i = 0; i < 16; ++i) o[d][i] = 0.f;
    float mrun = -1e30f, lrun = 0.f;
    const int npair = (ntile + 1) >> 1;
    const int srow = tid >> 3, sch = tid & 7;
    const bf16_t* ksrc = p.Y() + (rowb + srow) * YP + YD_K + sch * 8;
    const bf16_t* vsrc = p.Y() + (rowb + srow) * YP + YD_V + sch * 8;
    const int sdst = srow * KV_STRIDE + sch * 16;
    LAS unsigned char* kbuf = lds;
    LAS unsigned char* vbuf = lds + 4 * KV_TILE;
    LAS unsigned* mbuf = (LAS unsigned*)(lds + 8 * KV_TILE);
    const int mtile = hd >> 1, mkb = hd & 1;
    u32x4 kreg[2], vreg[2];
    bf16x8_t ikn0, ikn1;
#pragma unroll
    for (int tt = 0; tt < 2; ++tt) {
        const int t = min(tt, ntile - 1);
        kreg[tt] = *(const GAS u32x4*)(uintptr_t)(ksrc + (size_t)t * 64 * YP); vreg[tt] = *(const GAS u32x4*)(uintptr_t)(vsrc + (size_t)t * 64 * YP);
    }
    {
        const bf16_t* yk = p.Y() + (rowb + 64 * min(mtile, ntile - 1) + 32 * mkb + r32) * YP + YI_K + 8 * hh;
        ikn0 = *(const GAS bf16x8_t*)(uintptr_t)yk; ikn1 = *(const GAS bf16x8_t*)(uintptr_t)(yk + 16);
    }
    __syncthreads();
#pragma unroll
    for (int tt = 0; tt < 2; ++tt) { *(LAS u32x4*)(kbuf + tt * KV_TILE + sdst) = kreg[tt]; *(LAS u32x4*)(vbuf + tt * KV_TILE + sdst) = vreg[tt]; }
    for (int pp = 0; pp < npair; ++pp) {
        const int cur = pp & 1;
        const bool more = pp + 1 < npair;
        if (more) {
#pragma unroll
            for (int tt = 0; tt < 2; ++tt) {
                const int t = min(2 * (pp + 1) + tt, ntile - 1);
                kreg[tt] = *(const GAS u32x4*)(uintptr_t)(ksrc + (size_t)t * 64 * YP); vreg[tt] = *(const GAS u32x4*)(uintptr_t)(vsrc + (size_t)t * 64 * YP);
            }
        }
        TB(10, lds, tid);
        if (dosel) {
            const int tm = 2 * pp + mtile;
            unsigned bits = 0u;
            if (tm < ntile) {
                const f32x16 ss = idx_scores(ikn0, ikn1, iqf, w);
                const int kcl = kcut - 64 * tm - 4 * hh;
#pragma unroll
                for (int i = 0; i < 16; ++i) {
                    const int kci = 32 * mkb + (i & 3) + 8 * (i >> 2);
                    const bool sel = (ss[i] > T) || (ss[i] == T && kci <= kcl);
                    bits |= sel ? (1u << i) : 0u;
                }
            }
            mbuf[((cur * 2 + qg) * 4 + hd) * 64 + lane] = bits;
            if (more) {
                const bf16_t* yk = p.Y() + (rowb + 64 * min(2 * (pp + 1) + mtile, ntile - 1) + 32 * mkb + r32) * YP + YI_K + 8 * hh;
                ikn0 = *(const GAS bf16x8_t*)(uintptr_t)yk; ikn1 = *(const GAS bf16x8_t*)(uintptr_t)(yk + 16);
            }
        }
        TE(10, lds, tid); TB(12, lds, tid);
        __syncthreads();
        TE(12, lds, tid); TB(11, lds, tid);
#pragma unroll 1
        for (int tt = 0; tt < 2; ++tt) {
            const int j = 2 * pp + tt;
            if (j < ntile) {
                const LAS unsigned char* kt = kbuf + (cur * 2 + tt) * KV_TILE;
                const LAS unsigned char* vt = vbuf + (cur * 2 + tt) * KV_TILE;
                const float pl = (float)(pos - 64 * j - 4 * hh);
                const bool diag = (j == c);
                unsigned selb[2] = {0xffffu, 0xffffu};
                if (dosel) { selb[0] = mbuf[((cur * 2 + qg) * 4 + 2 * tt) * 64 + lane]; selb[1] = mbuf[((cur * 2 + qg) * 4 + 2 * tt + 1) * 64 + lane]; }
                f32x16 sc[2];
#pragma unroll
                for (int kb = 0; kb < 2; ++kb) {
                    f32x16 a;
#pragma unroll
                    for (int i = 0; i < 16; ++i) a[i] = 0.f;
#pragma unroll
                    for (int s = 0; s < 4; ++s) {
                        const bf16x8_t kf = *(const LAS bf16x8_t*)(kt + (32 * kb + r32) * KV_STRIDE + (16 * s + 8 * hh) * 2);
                        a = MFMA32(kf, qf[s], a);
                    }
                    if (!diag) {
#pragma unroll
                        for (int i = 0; i < 16; ++i) { const float kc = (float)(32 * kb + (i & 3) + 8 * (i >> 2)); a[i] = fmaf(a[i], c1, fmaf(sl2, kc, -sl2 * pl)); }
                    } else {
#pragma unroll
                        for (int i = 0; i < 16; ++i) { const float kc = (float)(32 * kb + (i & 3) + 8 * (i >> 2)); a[i] = fmaf(a[i], c1, -sl2 * fabsf(pl - kc)); }
                    }
#pragma unroll
                    for (int i = 0; i < 16; ++i) a[i] = (selb[kb] & (1u << i)) ? a[i] : -INFINITY;
                    sc[kb] = a;
                }
                float mx = sc[0][0];
#pragma unroll
                for (int i = 1; i < 16; ++i) mx = fmaxf(mx, sc[0][i]);
#pragma unroll
                for (int i = 0; i < 16; ++i) mx = fmaxf(mx, sc[1][i]);
                mx = xmax32(mx);
                const float mnew = fmaxf(mrun, mx);
                const float alpha = __builtin_amdgcn_exp2f(mrun - mnew);
                mrun = mnew;
                float ls4[4] = {0.f, 0.f, 0.f, 0.f};
#pragma unroll
                for (int kb = 0; kb < 2; ++kb)
#pragma unroll
                    for (int i = 0; i < 16; ++i) { const float e = __builtin_amdgcn_exp2f(sc[kb][i] - mnew); sc[kb][i] = e; ls4[i & 3] += e; }
                lrun = lrun * alpha + ((ls4[0] + ls4[1]) + (ls4[2] + ls4[3]));
#pragma unroll
                for (int d = 0; d < 2; ++d)
#pragma unroll
                    for (int i = 0; i < 16; ++i) o[d][i] *= alpha;
#pragma unroll
                for (int ks = 0; ks < 4; ++ks) {
                    const bf16x8_t pf = pack_step(sc[ks >> 1], ks & 1);
#pragma unroll
                    for (int db = 0; db < 2; ++db) o[db] = MFMA32(vt_frag(vt, ks, db, lane), pf, o[db]);
                }
            }
        }
        TE(11, lds, tid);
        if (more) {
#pragma unroll
            for (int tt = 0; tt < 2; ++tt) { *(LAS u32x4*)(kbuf + ((cur ^ 1) * 2 + tt) * KV_TILE + sdst) = kreg[tt]; *(LAS u32x4*)(vbuf + ((cur ^ 1) * 2 + tt) * KV_TILE + sdst) = vreg[tt]; }
        }
        __syncthreads();
    }
    TE(9, lds, tid);
    const float inv = 1.f / xsum32(lrun);
    bf16_t* mrow = p.mix() + (rowb + pos) * DM + 768 + hd * 64;
#pragma unroll
    for (int d = 0; d < 2; ++d)
#pragma unroll
        for (int g = 0; g < 4; ++g) {
            const int d0 = 32 * d + 8 * g + 4 * hh;
            const unsigned long long zz = *(const GAS unsigned long long*)(uintptr_t)(yq + YD_Z + hd * 64 + d0);
            const float z0 = __uint_as_float((unsigned)(zz & 0xffffu) << 16), z1 = __uint_as_float((unsigned)((zz >> 16) & 0xffffu) << 16),
                        z2 = __uint_as_float((unsigned)((zz >> 32) & 0xffffu) << 16), z3 = __uint_as_float((unsigned)((zz >> 48) & 0xffffu) << 16);
            *(GAS unsigned long long*)(uintptr_t)(mrow + d0) = (unsigned long long)cvtpk(o[d][4 * g] * inv * z0, o[d][4 * g + 1] * inv * z1) | ((unsigned long long)cvtpk(o[d][4 * g + 2] * inv * z2, o[d][4 * g + 3] * inv * z3) << 32);
        }
}
__device__ __forceinline__ void ph_mixD(const Params& p, LAS unsigned char* lds, int bid, int nb, int wave_s) {
    for (int i = bid; i < 256; i += nb) {
        const int b = i & 15, cc = i >> 4;
#pragma unroll 1
        for (int k = 0; k < 2; ++k) mixD_unit(p, b, k == 0 ? 31 - cc : cc, lds, wave_s);
    }
}

constexpr int VN_STRIDE = 528;
__device__ __forceinline__ float bflo(unsigned u) { return __uint_as_float(u << 16); }
__device__ __forceinline__ float bfhi(unsigned u) { return __uint_as_float(u & 0xffff0000u); }
__device__ __forceinline__ void mixAB_unit(const Params& p, int l, int b, int n, LAS unsigned char* lds, int tid) {
    const int lane = tid & 63, wave = __builtin_amdgcn_readfirstlane(tid >> 6), r32 = lane & 31, hh = lane >> 5;
    const size_t row0 = (size_t)b * SEQ + 128 * n;
    __syncthreads();
#pragma unroll
    for (int k = 0; k < 8; ++k) {
        const int ch = tid + 512 * k, r = ch >> 5, c16 = ch & 31;
        *(LAS u32x4*)(lds + r * VN_STRIDE + c16 * 16) = *(const GAS u32x4*)(uintptr_t)(p.Y() + (row0 + r) * YP + YB_V + c16 * 8);
    }
    {
        const int cg8 = (tid & 31) * 8, t0 = (tid >> 5) * 8;
        const int pos0 = 128 * n + t0;
        const GAS float* cw = p.sm(SM_CONVW) + l * 768 + cg8;
        float w0[8], w1[8], w2[8], cb[8];
#pragma unroll
        for (int e = 0; e < 8; ++e) { w0[e] = cw[e]; w1[e] = cw[256 + e]; w2[e] = cw[512 + e]; cb[e] = p.sm(SM_CONVB)[l * 256 + cg8 + e]; }
        float um2[8], um1[8];
#pragma unroll
        for (int e = 0; e < 8; ++e) { um2[e] = 0.f; um1[e] = 0.f; }
#pragma unroll
        for (int back = 2; back >= 1; --back) {
            if (pos0 - back >= 0) {
                const bf16_t* yr = p.Y() + (row0 + t0 - back) * YP;
                const u32x4 hc = *(const GAS u32x4*)(uintptr_t)(yr + YA_H + cg8), cc = *(const GAS u32x4*)(uintptr_t)(yr + YA_C + cg8);
                float u[8] = {bflo(hc.x) * bflo(cc.x), bfhi(hc.x) * bfhi(cc.x), bflo(hc.y) * bflo(cc.y), bfhi(hc.y) * bfhi(cc.y),
                              bflo(hc.z) * bflo(cc.z), bfhi(hc.z) * bfhi(cc.z), bflo(hc.w) * bflo(cc.w), bfhi(hc.w) * bfhi(cc.w)};
#pragma unroll
                for (int e = 0; e < 8; ++e) { if (back == 2) um2[e] = u[e]; else um1[e] = u[e]; }
            }
        }
#pragma unroll
        for (int tt = 0; tt < 8; ++tt) {
            const bf16_t* yr = p.Y() + (row0 + t0 + tt) * YP;
            const u32x4 hc = *(const GAS u32x4*)(uintptr_t)(yr + YA_H + cg8), cc = *(const GAS u32x4*)(uintptr_t)(yr + YA_C + cg8), bg = *(const GAS u32x4*)(uintptr_t)(yr + YA_B + cg8), zg = *(const GAS u32x4*)(uintptr_t)(yr + YA_Z + cg8);
            const float u[8] = {bflo(hc.x) * bflo(cc.x), bfhi(hc.x) * bfhi(cc.x), bflo(hc.y) * bflo(cc.y), bfhi(hc.y) * bfhi(cc.y),
                                bflo(hc.z) * bflo(cc.z), bfhi(hc.z) * bfhi(cc.z), bflo(hc.w) * bflo(cc.w), bfhi(hc.w) * bfhi(cc.w)};
            const float bgv[8] = {bflo(bg.x), bfhi(bg.x), bflo(bg.y), bfhi(bg.y), bflo(bg.z), bfhi(bg.z), bflo(bg.w), bfhi(bg.w)};
            const float zgv[8] = {bflo(zg.x), bfhi(zg.x), bflo(zg.y), bfhi(zg.y), bflo(zg.z), bfhi(zg.z), bflo(zg.w), bfhi(zg.w)};
            float ov[8];
#pragma unroll
            for (int e = 0; e < 8; ++e) {
                const float conv = w0[e] * um2[e] + w1[e] * um1[e] + w2[e] * u[e];
                ov[e] = bgv[e] * (conv + cb[e]) * zgv[e];
                um2[e] = um1[e]; um1[e] = u[e];
            }
            u32x4 ow; ow.x = cvtpk(ov[0], ov[1]); ow.y = cvtpk(ov[2], ov[3]); ow.z = cvtpk(ov[4], ov[5]); ow.w = cvtpk(ov[6], ov[7]);
            *(GAS u32x4*)(uintptr_t)(p.mix() + (row0 + t0 + tt) * DM + cg8) = ow;
        }
    }
    __syncthreads();
    {
        const int h = wave >> 1, th = wave & 1;
        const int nks = th == 0 ? 4 : 8;
        f32x16 acc[2][2];
#pragma unroll
        for (int a = 0; a < 2; ++a)
#pragma unroll
            for (int d = 0; d < 2; ++d)
#pragma unroll
                for (int i = 0; i < 16; ++i) acc[a][d][i] = 0.f;
        const bf16_t* wb = p.wsb() + ((size_t)(l * 4 + h) * 128 + 64 * th + r32) * 128 + 8 * hh;
        const int i16 = lane & 15, q = i16 >> 2, pp = i16 & 3, blk = (lane >> 4) & 1;
        const LAS unsigned char* va = lds + (8 * hh + q) * VN_STRIDE + (h * 64 + 16 * blk + 4 * pp) * 2;
        for (int ks = 0; ks < nks; ++ks) {
            bf16x8_t bfr[2], afr[2];
#pragma unroll
            for (int tb = 0; tb < 2; ++tb) bfr[tb] = *(const GAS bf16x8_t*)(uintptr_t)(wb + (size_t)(32 * tb) * 128 + 16 * ks);
#pragma unroll
            for (int db = 0; db < 2; ++db) {
                const LAS unsigned char* a = va + (16 * ks) * VN_STRIDE + (32 * db) * 2;
                const s16x4_t lo = ds_tr16(a), hi = ds_tr16(a + 4 * VN_STRIDE);
                afr[db] = __builtin_shufflevector(lo, hi, 0, 1, 2, 3, 4, 5, 6, 7);
            }
#pragma unroll
            for (int tb = 0; tb < 2; ++tb)
#pragma unroll
                for (int db = 0; db < 2; ++db) acc[tb][db] = MFMA32(afr[db], bfr[tb], acc[tb][db]);
        }
#pragma unroll
        for (int tb = 0; tb < 2; ++tb) {
            const int t = 64 * th + 32 * tb + r32;
            const float bias = p.sm(SM_GMLPB)[(l * 4 + h) * 128 + t];
            const bf16_t* yr = p.Y() + (row0 + t) * YP;
            bf16_t* mr = p.mix() + (row0 + t) * DM + 256 + h * 64;
#pragma unroll
            for (int db = 0; db < 2; ++db)
#pragma unroll
                for (int g = 0; g < 4; ++g) {
                    const int d0 = 32 * db + 8 * g + 4 * hh;
                    const unsigned long long uu = *(const GAS unsigned long long*)(uintptr_t)(yr + YB_U + h * 64 + d0), zz = *(const GAS unsigned long long*)(uintptr_t)(yr + YB_Z + h * 64 + d0);
                    const unsigned u01 = (unsigned)uu, u23 = (unsigned)(uu >> 32), z01 = (unsigned)zz, z23 = (unsigned)(zz >> 32);
                    const float v0 = bflo(u01) * (acc[tb][db][4 * g] + bias) * bflo(z01), v1 = bfhi(u01) * (acc[tb][db][4 * g + 1] + bias) * bfhi(z01);
                    const float v2 = bflo(u23) * (acc[tb][db][4 * g + 2] + bias) * bflo(z23), v3 = bfhi(u23) * (acc[tb][db][4 * g + 3] + bias) * bfhi(z23);
                    *(GAS unsigned long long*)(uintptr_t)(mr + d0) = (unsigned long long)cvtpk(v0, v1) | ((unsigned long long)cvtpk(v2, v3) << 32);
                }
        }
    }
}
__device__ __forceinline__ void ph_mixAB(const Params& p, int l, LAS unsigned char* lds, int bid, int nb, int tid_in) {
    int tid = tid_in; asm volatile("" : "+v"(tid));
    for (int i = bid; i < 256; i += nb) mixAB_unit(p, l, i >> 4, i & 15, lds, tid);
}

constexpr int IX_STRIDE = 528;
__device__ __forceinline__ void ph_ikiw(const Params& p, int l, LAS unsigned char* lds, int bid, int nb, int wave_s) {
    const int tid = tid_now(wave_s);
    const int lane = tid & 63, wave = __builtin_amdgcn_readfirstlane(tid >> 6), r32 = lane & 31, hh = lane >> 5;
    const int tb = wave & 3, cb = wave >> 2;
    LAS unsigned char* xs = lds;
    LAS unsigned char* ws = lds + 128 * IX_STRIDE;
    const bf16_t* wbase = p.wt_in() + (size_t)l * YP * DM;
    __syncthreads();
    { unsigned z = 0u; asm volatile("" : "+v"(z));
      for (int i = tid; i < 28 * (IX_STRIDE / 16); i += NT) *(LAS u32x4*)(ws + 36 * IX_STRIDE + i * 16) = (u32x4){z, z, z, z}; }
    for (int blk = bid; blk < NTOK / 128; blk += nb) {
        f32x16 acc;
#pragma unroll
        for (int i = 0; i < 16; ++i) acc[i] = 0.f;
#pragma unroll 1
        for (int k0 = 0; k0 < DM; k0 += 256) {
            u32x4 xv[8], wv[3];
#pragma unroll
            for (int i = 0; i < 8; ++i) { const int idx = tid + NT * i; xv[i] = *(const GAS u32x4*)(uintptr_t)(p.xb() + (size_t)(128 * blk + (idx >> 5)) * DM + k0 + 8 * (idx & 31)); }
#pragma unroll
            for (int i = 0; i < 3; ++i) {
                const int idx = tid + NT * i, n = idx >> 5;
                if (idx < 36 * 32) wv[i] = *(const GAS u32x4*)(uintptr_t)(wbase + (size_t)(n < 32 ? 3584 + n : 3712 + (n - 32)) * DM + k0 + 8 * (idx & 31));
            }
            __syncthreads();
#pragma unroll
            for (int i = 0; i < 8; ++i) { const int idx = tid + NT * i; *(LAS u32x4*)(xs + (idx >> 5) * IX_STRIDE + (idx & 31) * 16) = xv[i]; }
#pragma unroll
            for (int i = 0; i < 3; ++i) { const int idx = tid + NT * i; if (idx < 36 * 32) *(LAS u32x4*)(ws + (idx >> 5) * IX_STRIDE + (idx & 31) * 16) = wv[i]; }
            __syncthreads();
#pragma unroll
            for (int s = 0; s < 16; ++s) {
                const bf16x8_t a = *(const LAS bf16x8_t*)(ws + (32 * cb + r32) * IX_STRIDE + (16 * s + 8 * hh) * 2);
                const bf16x8_t b = *(const LAS bf16x8_t*)(xs + (32 * tb + r32) * IX_STRIDE + (16 * s + 8 * hh) * 2);
                acc = MFMA32(a, b, acc);
            }
        }
        const int tok = 128 * blk + 32 * tb + r32;
        const GAS f32x4* sp = (const GAS f32x4*)(uintptr_t)(p.ssq() + (size_t)tok * 16);
        const f32x4 s0 = sp[0], s1 = sp[1], s2 = sp[2], s3 = sp[3];
        const float tot = ((s0.x + s0.y) + (s0.z + s0.w)) + ((s1.x + s1.y) + (s1.z + s1.w)) + ((s2.x + s2.y) + (s2.z + s2.w)) + ((s3.x + s3.y) + (s3.z + s3.w));
        const float rstd = rsqrtf(tot * (1.f / DM) + EPS);
        bf16_t* yr = p.Y() + (size_t)tok * YP + YI_K + 32 * cb;
#pragma unroll
        for (int g = 0; g < 4; ++g) {
            const int c0 = 8 * g + 4 * hh;
            if (32 * cb + c0 < 36)
                *(GAS unsigned long long*)(uintptr_t)(yr + c0) = (unsigned long long)cvtpk(acc[4 * g] * rstd, acc[4 * g + 1] * rstd) | ((unsigned long long)cvtpk(acc[4 * g + 2] * rstd, acc[4 * g + 3] * rstd) << 32);
        }
    }
    __syncthreads();
}

__global__ void __launch_bounds__(NT, 2) k_fwd(Params p) {
    extern __shared__ __attribute__((aligned(16))) unsigned char lds[];
    cg::grid_group grid = cg::this_grid();
    LAS unsigned char* l3 = (LAS unsigned char*)lds;
    const int wave_s = __builtin_amdgcn_readfirstlane((int)threadIdx.x >> 6);
    volatile LAS unsigned* bst = (volatile LAS unsigned*)(l3 + LDS_BYTES - 16);
    if (threadIdx.x < 2) bst[threadIdx.x] = 0u;
    __syncthreads();
    const XcdBarrier bar = xcd_barrier_post(p.ctl(), bst);
    if (TSEG >= 0 && threadIdx.x == 0) *(volatile LAS unsigned*)(l3 + TCTR_OFF) = 0u;
    { TB(16, l3, tid_now(wave_s)); ph_prologue(p, l3, tid_now(wave_s)); TE(16, l3, tid_now(wave_s)); }
    if (p.ws == nullptr) grid.sync();
    { TB(18, l3, tid_now(wave_s)); xcd_barrier(bar, tid_now(wave_s)); TE(18, l3, tid_now(wave_s)); }
#pragma unroll 1
    for (int l = 0; l < DEPTH; ++l) {
        Params q = p; asm volatile("" : "+s"(q.ws), "+s"(q.out));
        int bid = blockIdx.x, nb = gridDim.x; asm volatile("" : "+s"(bid), "+s"(nb));
        {
            pg8::Gemm g{q.xb(), q.wt_in() + (size_t)l * YP * DM, NTOK, NGEMM, DM};
            pg8::StaticOrder S; S.init(NTOK, NGEMM, nb, bid);
            EpiIn E{q.ws, l, (LAS float*)(l3 + 131072 + 1024)};
            { TB(13, l3, tid_now(wave_s)); pg8::gemm_phase<EpiIn, pg8::StaticOrder, true, true>(l3, g, S, E, tid_now(wave_s)); TE(13, l3, tid_now(wave_s)); }
        }
        { TB(21, l3, tid_now(wave_s)); ph_ikiw(q, l, l3, bid, nb, wave_s); TE(21, l3, tid_now(wave_s)); }
        { TB(18, l3, tid_now(wave_s)); xcd_barrier(bar, tid_now(wave_s)); TE(18, l3, tid_now(wave_s)); }
        asm volatile("" : "+s"(q.ws), "+s"(bid), "+s"(nb));
        { TB(17, l3, tid_now(wave_s)); ph_mixAB(q, l, l3, bid, nb, tid_now(wave_s)); TE(17, l3, tid_now(wave_s)); }
        __syncthreads();
        { TB(1, l3, tid_now(wave_s)); ph_mixC(q, l, l3, bid, nb, wave_s); TE(1, l3, tid_now(wave_s)); }
        __syncthreads();
        { TB(19, l3, tid_now(wave_s)); ph_mixD(q, l3, bid, nb, wave_s); TE(19, l3, tid_now(wave_s)); }
        __syncthreads();
        { TB(18, l3, tid_now(wave_s)); xcd_barrier(bar, tid_now(wave_s)); TE(18, l3, tid_now(wave_s)); }
        asm volatile("" : "+s"(q.ws), "+s"(q.out), "+s"(bid), "+s"(nb));
        {
            pg8::Gemm g{q.mix(), q.wt_out() + (size_t)l * DM * DM, NTOK, DM, DM};
            pg8::StaticOrder S; S.init(NTOK, DM, nb, bid);
            EpiOut E{l == DEPTH - 1 ? q.out : nullptr, q.ws};
            { TB(15, l3, tid_now(wave_s)); pg8::gemm_phase<EpiOut, pg8::StaticOrder, true, true>(l3, g, S, E, tid_now(wave_s)); TE(15, l3, tid_now(wave_s)); }
        }
        { TB(18, l3, tid_now(wave_s)); xcd_barrier(bar, tid_now(wave_s)); TE(18, l3, tid_now(wave_s)); }
    }
    if (TSEG >= 0 && blockIdx.x == 0 && threadIdx.x == 0) {
        const unsigned long long ticks = 8ull * *(volatile LAS unsigned*)(l3 + TCTR_OFF), t0 = __builtin_amdgcn_s_memrealtime();
        while (__builtin_amdgcn_s_memrealtime() - t0 < ticks) __builtin_amdgcn_s_sleep(32);
    }
}

extern "C" void kernel_launch(void* const* d_in, const int* in_sizes, int n_in, void* d_out, int out_size, void* d_ws, size_t ws_size,
                              hipStream_t stream) {
    static int grid_blocks = 0;
    if (!grid_blocks) {
        int dev = 0, cus = 0, per_cu = 0;
        (void)hipGetDevice(&dev);
        (void)hipDeviceGetAttribute(&cus, hipDeviceAttributeMultiprocessorCount, dev);
        (void)hipFuncSetAttribute((const void*)k_fwd, hipFuncAttributeMaxDynamicSharedMemorySize, LDS_BYTES);
        (void)hipOccupancyMaxActiveBlocksPerMultiprocessor(&per_cu, (const void*)k_fwd, NT, LDS_BYTES);
        if (per_cu < 1) { fprintf(stderr, "kernel_launch: occupancy query returned %d\n", per_cu); per_cu = 1; }
        if (per_cu > 1) per_cu = 1;
        grid_blocks = cus * per_cu;
        if (ws_size < WS_END) fprintf(stderr, "kernel_launch: workspace too small (%zu < %zu)\n", ws_size, (size_t)WS_END);
    }
    (void)hipMemsetAsync(d_ws, 0, 16384, stream);
    Params p{};
    p.x = (const float*)d_in[0]; p.norm_g = (const float*)d_in[1]; p.w_in = (const float*)d_in[2]; p.i_conv_w = (const float*)d_in[3];
    p.i_conv_b = (const float*)d_in[4]; p.i_gmlp_g = (const float*)d_in[5]; p.gmlp_ws = (const float*)d_in[6]; p.i_gmlp_b = (const float*)d_in[7];
    p.i_diff_qg = (const float*)d_in[8]; p.i_diff_kg = (const float*)d_in[9]; p.i_diff_lam = (const float*)d_in[10]; p.i_diff_subg = (const float*)d_in[11];
    p.i_dsa_qg = (const float*)d_in[12]; p.i_dsa_kg = (const float*)d_in[13]; p.w_out = (const float*)d_in[14];
    p.out = (float*)d_out; p.ws = (unsigned char*)d_ws;
    void* args[] = {&p};
    hipError_t e = hipLaunchCooperativeKernel((void*)k_fwd, dim3(grid_blocks), dim3(NT), args, LDS_BYTES, stream);
    if (e != hipSuccess) fprintf(stderr, "cooperative launch failed: %s (grid %d)\n", hipGetErrorString(e), grid_blocks);
}
```

```cpp
#include <hip/hip_runtime.h>
#include <hip/hip_cooperative_groups.h>
#include <math.h>
#include <stdint.h>
#include <stdio.h>
namespace cg = cooperative_groups;
namespace pg8 {
#define PG8_LAS __attribute__((address_space(3)))
typedef unsigned short bf16_t;
typedef short bf16x8 __attribute__((ext_vector_type(8)));
typedef float f32x4 __attribute__((ext_vector_type(4)));
typedef unsigned u32x4 __attribute__((ext_vector_type(4)));
constexpr int BM = 256, BK = 64, HALF = 128, HTB = HALF * BK * 2  , STAGE_BYTES = 8 * HTB, NXCD = 8, WGM = 8;

__host__ __device__ __forceinline__ int lds_byte(int r, int c) { const int st = (r >> 4) * 2 + (c >> 5), rr = r & 15, cc = c & 31, ob = rr * 64 + cc * 2; return st * 1024 + (ob ^ (((ob >> 9) & 1) << 5)); }
__host__ __device__ __forceinline__ void stage_rc(int b, int& R, int& C) { const int st = b / 1024, sb = b % 1024, swz = sb ^ (((sb >> 9) & 1) << 5); R = (st >> 1) * 16 + swz / 64; C = (st & 1) * 32 + (swz % 64) / 2; }
__host__ __device__ __forceinline__ int perm32(int rho) { const int n = rho >> 4, i = rho & 15; return 8 * (i >> 2) + 4 * n + (i & 3); }

struct Unit { int pm, pn; };
struct Gemm { const bf16_t* A; const bf16_t* Bt; int M, N, K; };

struct StaticOrder {
    int nM, nN, nwg, G, c;
    __host__ __device__ void init(int M, int N, int G_, int c_) { nM = M / BM; nN = N / BM; nwg = nM * nN; G = G_; c = c_; }
    __host__ __device__ bool next(int i, Unit& u) const {
        const long L = (long)i * G + c; if (L >= nwg) return false;
        int wgid = (int)L; { const int q = nwg / NXCD, r = nwg % NXCD, xcd = wgid % NXCD, off = wgid / NXCD; wgid = (xcd < r ? xcd * (q + 1) : r * (q + 1) + (xcd - r) * q) + off; }
        const int nig = WGM * nN, gid = wgid / nig, fm = gid * WGM, gsz = (nM - fm) < WGM ? (nM - fm) : WGM;
        u.pm = fm + ((wgid % nig) % gsz); u.pn = (wgid % nig) / gsz; return true;
    }
    __device__ __forceinline__ void a_ready(const Unit&) const {}
    __device__ __forceinline__ void done(const Unit&) const {}
};

__device__ __forceinline__ unsigned cvt_pk_bf16(float lo, float hi) { unsigned r; asm volatile("v_cvt_pk_bf16_f32 %0, %1, %2" : "=v"(r) : "v"(lo), "v"(hi)); return r; }
typedef float f32x2 __attribute__((ext_vector_type(2)));
__device__ __forceinline__ f32x2 gelu_pk(f32x2 v) {
    const f32x2 av = __builtin_elementwise_abs(v), d = av * 0.2316418882f + 1.0f;
    f32x2 t; t.x = __builtin_amdgcn_rcpf(d.x); t.y = __builtin_amdgcn_rcpf(d.y);
    f32x2 q = t * 0.5307027145f + (-0.7265760135f); q = q * t + 0.7107068705f; q = q * t + (-0.142248368f); q = q * t + 0.127414796f; q = q * t;
    const f32x2 s = (v * v) * (-0.72134752044f);
    f32x2 e; e.x = __builtin_amdgcn_exp2f(s.x); e.y = __builtin_amdgcn_exp2f(s.y);
    const f32x2 m = v * (q * e), r = v - m;
    f32x2 o; o.x = v.x < 0.f ? m.x : r.x; o.y = v.y < 0.f ? m.y : r.y; return o;
}
template <class Epi, class Sched, bool ALIGN_EPI = false, bool SP2 = false>
__device__ __forceinline__ void gemm_phase(PG8_LAS unsigned char* lds, const Gemm g, const Sched& S, const Epi& E, int tid_in) {
    int tid_ = tid_in; asm volatile("" : "+v"(tid_));
    const int tid = tid_, wid = __builtin_amdgcn_readfirstlane(tid >> 6), lane = tid & 63, wr = wid >> 2, wc = wid & 3, fr = lane & 15, fq = lane >> 4;
    const int K = g.K, nt = K / BK;
    unsigned voffA[2], voffB[2];
#pragma unroll
    for (int i = 0; i < 2; ++i) { int R, C; stage_rc(tid * 16 + i * 8192, R, C); const int Rb = Epi::PERM ? ((R & ~31) + perm32(R & 31)) : R;
        voffA[i] = (unsigned)(R * K + C) * 2u; voffB[i] = (unsigned)(Rb * K + C) * 2u; }
    const size_t kstep = (size_t)(BK * 2);
    const size_t hstep = (size_t)HALF * K * 2;
    const size_t tstep = 2 * hstep;
    const unsigned ldsw = (unsigned)wid * 1024u;
    const int aoff = lds_byte(wr * 64 + fr, fq * 8), boff = lds_byte(wc * 32 + fr, fq * 8);
#define PG8_SA(b, h) (((b) * 2 + (h)) * HTB)
#define PG8_SB(b, h) ((4 + (b) * 2 + (h)) * HTB)
#define PG8_STAGE(bufoff, gbase, voff) do { _Pragma("unroll") for (int _i = 0; _i < 2; ++_i) \
        __builtin_amdgcn_global_load_lds((const unsigned*)((const char*)(gbase) + (voff)[_i]), (PG8_LAS unsigned*)(lds + (bufoff) + ldsw + _i * 8192), 16, 0, 0); } while (0)
#define PG8_LDA(dst, b, h) do { _Pragma("unroll") for (int m = 0; m < 4; ++m) _Pragma("unroll") for (int k = 0; k < 2; ++k) dst[m][k] = *(const PG8_LAS bf16x8*)(lds + PG8_SA(b, h) + aoff + m * 2048 + k * 1024); } while (0)
#define PG8_LDB(dst, b, h) do { _Pragma("unroll") for (int n = 0; n < 2; ++n) _Pragma("unroll") for (int k = 0; k < 2; ++k) dst[n][k] = *(const PG8_LAS bf16x8*)(lds + PG8_SB(b, h) + boff + n * 2048 + k * 1024); } while (0)
#define PG8_MMA(ai, bj, At, Bt) do { __builtin_amdgcn_s_setprio(1); _Pragma("unroll") for (int m = 0; m < 4; ++m) _Pragma("unroll") for (int n = 0; n < 2; ++n) _Pragma("unroll") for (int k = 0; k < 2; ++k) \
        acc[ai][bj][m][n] = __builtin_amdgcn_mfma_f32_16x16x32_bf16(Bt[n][k], At[m][k], acc[ai][bj][m][n], 0, 0, 0); __builtin_amdgcn_s_setprio(0); } while (0)
#define PG8_WAIT_V(n) asm volatile("s_waitcnt vmcnt(" #n ")" ::: "memory")
#define PG8_WAIT_L(n) asm volatile("s_waitcnt lgkmcnt(" #n ")" ::: "memory")
#define PG8_BAR __builtin_amdgcn_s_barrier()
#define PG8_SCHED __builtin_amdgcn_sched_barrier(0)
    Unit cur, nxt; int ui = 0;
    if (!S.next(0, cur)) return;
    f32x4 acc[2][2][4][2];
#pragma unroll
    for (int a = 0; a < 2; ++a)
#pragma unroll
        for (int b = 0; b < 2; ++b)
#pragma unroll
            for (int m = 0; m < 4; ++m)
#pragma unroll
                for (int n = 0; n < 2; ++n) acc[a][b][m][n] = (f32x4){0.f, 0.f, 0.f, 0.f};
    bf16x8 At[4][2], B0[2][2], B1[2][2];
    const char* cA = (const char*)g.A + (size_t)cur.pm * tstep; const char* cB = (const char*)g.Bt + (size_t)cur.pn * tstep;
    S.a_ready(cur);
    if constexpr (SP2) {
        PG8_STAGE(PG8_SB(0, 0), cB, voffB); PG8_STAGE(PG8_SB(0, 1), cB + hstep, voffB); PG8_STAGE(PG8_SA(0, 0), cA, voffA); PG8_STAGE(PG8_SA(0, 1), cA + hstep, voffA);
        if (wr == 1) PG8_BAR;
        PG8_WAIT_V(2); PG8_BAR;
        PG8_STAGE(PG8_SB(1, 0), cB + kstep, voffB); PG8_STAGE(PG8_SA(1, 0), cA + kstep, voffA); PG8_STAGE(PG8_SB(1, 1), cB + hstep + kstep, voffB);
        PG8_WAIT_V(6); PG8_BAR;
    } else {
        PG8_STAGE(PG8_SB(0, 0), cB, voffB); PG8_STAGE(PG8_SA(0, 0), cA, voffA); PG8_STAGE(PG8_SB(0, 1), cB + hstep, voffB); PG8_STAGE(PG8_SA(0, 1), cA + hstep, voffA);
        if (wr == 1) PG8_BAR;
        PG8_WAIT_V(4); PG8_BAR;
        PG8_STAGE(PG8_SB(1, 0), cB + kstep, voffB); PG8_STAGE(PG8_SA(1, 0), cA + kstep, voffA); PG8_STAGE(PG8_SB(1, 1), cB + hstep + kstep, voffB);
        PG8_WAIT_V(6); PG8_BAR;
    }
    for (;;) {
        const bool has_next = S.next(ui + 1, nxt);
        const char* nA = has_next ? (const char*)g.A + (size_t)nxt.pm * tstep : cA; const char* nB = has_next ? (const char*)g.Bt + (size_t)nxt.pn * tstep : cB;
        for (int t = 0; t < nt; t += 2) {
            const bool last = (t == nt - 2);
            const char* a1 = cA + (size_t)(t + 1) * kstep;
            const char* a2 = last ? nA : cA + (size_t)(t + 2) * kstep; const char* b2 = last ? nB : cB + (size_t)(t + 2) * kstep;
            const char* a3 = a2 + kstep; const char* b3 = b2 + kstep;
            if (last && has_next) S.a_ready(nxt);
            if constexpr (SP2) {
            PG8_LDB(B0, 0, 0); PG8_LDB(B1, 0, 1); PG8_SCHED; PG8_LDA(At, 0, 0); PG8_STAGE(PG8_SA(1, 1), a1 + hstep, voffA);
            PG8_WAIT_V(8); PG8_WAIT_L(0); PG8_BAR; PG8_MMA(0, 0, At, B0); PG8_MMA(0, 1, At, B1); PG8_BAR; PG8_SCHED;
            PG8_LDA(At, 0, 1); PG8_STAGE(PG8_SB(0, 0), b2, voffB); PG8_STAGE(PG8_SB(0, 1), b2 + hstep, voffB); PG8_STAGE(PG8_SA(0, 0), a2, voffA);
            PG8_WAIT_V(8); PG8_WAIT_L(0); PG8_BAR; PG8_MMA(1, 0, At, B0); PG8_MMA(1, 1, At, B1); PG8_BAR; PG8_SCHED;
            PG8_LDB(B0, 1, 0); PG8_LDB(B1, 1, 1); PG8_SCHED; PG8_LDA(At, 1, 0); PG8_STAGE(PG8_SA(0, 1), a2 + hstep, voffA);
            PG8_WAIT_V(8); PG8_WAIT_L(0); PG8_BAR; PG8_MMA(0, 0, At, B0); PG8_MMA(0, 1, At, B1); PG8_BAR; PG8_SCHED;
            PG8_LDA(At, 1, 1); PG8_STAGE(PG8_SB(1, 0), b3, voffB); PG8_STAGE(PG8_SB(1, 1), b3 + hstep, voffB); PG8_STAGE(PG8_SA(1, 0), a3, voffA);
            PG8_WAIT_V(8); PG8_WAIT_L(0); PG8_BAR; PG8_MMA(1, 0, At, B0); PG8_MMA(1, 1, At, B1); PG8_BAR; PG8_SCHED;
            } else {
            PG8_LDB(B0, 0, 0); PG8_SCHED; PG8_LDA(At, 0, 0); PG8_STAGE(PG8_SA(1, 1), a1 + hstep, voffA);
            PG8_WAIT_L(8); PG8_BAR; PG8_WAIT_L(0); PG8_MMA(0, 0, At, B0); PG8_BAR; PG8_SCHED;
            PG8_LDB(B1, 0, 1); PG8_STAGE(PG8_SB(0, 0), b2, voffB);
            PG8_BAR; PG8_WAIT_L(0); PG8_MMA(0, 1, At, B1); PG8_BAR;
            PG8_LDA(At, 0, 1); PG8_STAGE(PG8_SA(0, 0), a2, voffA);
            PG8_BAR; PG8_WAIT_L(0); PG8_MMA(1, 0, At, B0); PG8_BAR; PG8_SCHED;
            PG8_STAGE(PG8_SB(0, 1), b2 + hstep, voffB);
            PG8_WAIT_V(6); PG8_BAR; PG8_MMA(1, 1, At, B1); PG8_BAR;
            PG8_LDB(B0, 1, 0); PG8_SCHED; PG8_LDA(At, 1, 0); PG8_STAGE(PG8_SA(0, 1), a2 + hstep, voffA);
            PG8_WAIT_L(8); PG8_BAR; PG8_WAIT_L(0); PG8_MMA(0, 0, At, B0); PG8_BAR; PG8_SCHED;
            PG8_LDB(B1, 1, 1); PG8_STAGE(PG8_SB(1, 0), b3, voffB);
            PG8_BAR; PG8_WAIT_L(0); PG8_MMA(0, 1, At, B1); PG8_BAR;
            PG8_LDA(At, 1, 1); PG8_STAGE(PG8_SA(1, 0), a3, voffA);
            PG8_BAR; PG8_WAIT_L(0); PG8_MMA(1, 0, At, B0); PG8_BAR; PG8_SCHED;
            PG8_STAGE(PG8_SB(1, 1), b3 + hstep, voffB);
            PG8_WAIT_V(6); PG8_BAR; PG8_MMA(1, 1, At, B1); PG8_BAR;
            }
        }
        if constexpr (ALIGN_EPI) { if (wr == 0) PG8_BAR; }
        if constexpr (!Epi::AFTER_DRAIN) { E(acc, cur, wr, wc, fr, fq); S.done(cur); }
        if (!has_next) break;
#pragma unroll
        for (int a = 0; a < 2; ++a)
#pragma unroll
            for (int b = 0; b < 2; ++b)
#pragma unroll
                for (int m = 0; m < 4; ++m)
#pragma unroll
                    for (int n = 0; n < 2; ++n) acc[a][b][m][n] = (f32x4){0.f, 0.f, 0.f, 0.f};
        cur = nxt; cA = nA; cB = nB; ++ui;
        if constexpr (ALIGN_EPI) { if (wr == 1) PG8_BAR; }
    }
    PG8_WAIT_V(0);
    if constexpr (!ALIGN_EPI) { if (wr == 0) PG8_BAR; }
    PG8_BAR;
    if constexpr (Epi::AFTER_DRAIN) { E.fused(acc, cur, wr, wc, fr, fq, lds, wid, lane); S.done(cur); }
#undef PG8_SA
#undef PG8_SB
#undef PG8_STAGE
#undef PG8_LDA
#undef PG8_LDB
#undef PG8_MMA
#undef PG8_WAIT_V
#undef PG8_WAIT_L
#undef PG8_BAR
#undef PG8_SCHED
}
}

using pg8::bf16_t; using pg8::f32x4; using pg8::u32x4; using pg8::Unit;
#define LAS __attribute__((address_space(3)))
#define GAS __attribute__((address_space(1)))

constexpr int DM = 1024, SEQ = 2048, BATCH = 16, DEPTH = 4, NIN = 3620, NTOK = BATCH * SEQ, YP = 3840;
constexpr float EPS = 1e-6f;
constexpr int O_DZ = 3200, O_DK = 3072, O_DV = 3136;
constexpr int YA_H = 0, YA_B = 256, YA_C = 512, YA_Z = 768, YB_U = 1024, YB_V = 1280, YB_Z = 1536, YC_Q = 1792, YC_K = 2048, YC_V = 2304,
              YC_Z = 2560, YD_Q = 2816, YD_Z = 3072, YD_K = 3328, YD_V = 3392, YI_Q = 3456, YI_K = 3584, YI_W = 3616;
constexpr int TOPK = 256;
constexpr int NGEMM = 3584;
constexpr int NT = 512, NW = 8;
constexpr int LDS_BYTES = 131072 + 4096;

constexpr size_t MiB = 1u << 20;
constexpr size_t WS_WTIN = 1 * MiB;
constexpr size_t WS_WTOUT = WS_WTIN + (size_t)DEPTH * YP * DM * 2;
constexpr size_t WS_SSQ = WS_WTOUT + (size_t)DEPTH * DM * DM * 2;
constexpr size_t WS_XB = WS_SSQ + (size_t)NTOK * 16 * 4;
constexpr size_t WS_Y = WS_XB + (size_t)NTOK * DM * 2;
constexpr size_t WS_MIX = WS_Y + (size_t)NTOK * YP * 2;
constexpr size_t WS_WSB = WS_MIX + (size_t)NTOK * DM * 2;
constexpr size_t WS_END = WS_WSB + (size_t)DEPTH * 4 * 128 * 128 * 2;

constexpr size_t WS_SMALL = 65536;
constexpr int SM_CONVW = 0, SM_CONVB = 3072, SM_GMLPG = 4096, SM_GMLPB = 5120, SM_QG = 7168, SM_KG = 7296, SM_LAM = 7424, SM_SUBG = 7936, SM_DQG = 8960, SM_DKG = 9216, SM_END = 9472;
struct Params {
    const float* x; const float* norm_g; const float* w_in; const float* i_conv_w; const float* i_conv_b;
    const float* i_gmlp_g; const float* gmlp_ws; const float* i_gmlp_b; const float* i_diff_qg; const float* i_diff_kg;
    const float* i_diff_lam; const float* i_diff_subg; const float* i_dsa_qg; const float* i_dsa_kg; const float* w_out;
    float* out; unsigned char* ws;
    __device__ __forceinline__ unsigned* ctl() const { return (unsigned*)ws; }
    __device__ __forceinline__ const GAS float* sm(int off) const { return (const GAS float*)(uintptr_t)(ws + WS_SMALL) + off; }
    __device__ __forceinline__ bf16_t* wt_in() const { return (bf16_t*)(ws + WS_WTIN); }
    __device__ __forceinline__ bf16_t* wt_out() const { return (bf16_t*)(ws + WS_WTOUT); }
    __device__ __forceinline__ float* ssq() const { return (float*)(ws + WS_SSQ); }
    __device__ __forceinline__ bf16_t* xb() const { return (bf16_t*)(ws + WS_XB); }
    __device__ __forceinline__ bf16_t* Y() const { return (bf16_t*)(ws + WS_Y); }
    __device__ __forceinline__ bf16_t* mix() const { return (bf16_t*)(ws + WS_MIX); }
    __device__ __forceinline__ bf16_t* wsb() const { return (bf16_t*)(ws + WS_WSB); }
};

#ifndef TSEG
#define TSEG -1
#endif
constexpr int TCTR_OFF = 131072 + 3072;
#define TB(id, ldsbase, tidv) do { if (TSEG == (id) && blockIdx.x == 0 && (tidv) == 0) *(volatile LAS unsigned long long*)((ldsbase) + TCTR_OFF + 8) = __builtin_amdgcn_s_memrealtime(); } while (0)
#define TE(id, ldsbase, tidv) do { if (TSEG == (id) && blockIdx.x == 0 && (tidv) == 0) { const unsigned _d = (unsigned)(__builtin_amdgcn_s_memrealtime() - *(volatile LAS unsigned long long*)((ldsbase) + TCTR_OFF + 8)); *(volatile LAS unsigned*)((ldsbase) + TCTR_OFF) += _d; } } while (0)
__device__ __forceinline__ unsigned f2bf(float f) { unsigned u = __float_as_uint(f); return (u + 0x7fffu + ((u >> 16) & 1u)) >> 16; }
__device__ __forceinline__ unsigned pk2(float lo, float hi) { return f2bf(lo) | (f2bf(hi) << 16); }
__device__ __forceinline__ float bf2f(bf16_t b) { return __uint_as_float((unsigned)b << 16); }

__device__ __forceinline__ float xsum32(float v) { const auto r = __builtin_amdgcn_permlane32_swap(__float_as_uint(v), __float_as_uint(v), false, false); return __uint_as_float(r[0]) + __uint_as_float(r[1]); }
__device__ __forceinline__ float xmax32(float v) { const auto r = __builtin_amdgcn_permlane32_swap(__float_as_uint(v), __float_as_uint(v), false, false); return fmaxf(__uint_as_float(r[0]), __uint_as_float(r[1])); }
__device__ __forceinline__ int xsum32i(int v) { const auto r = __builtin_amdgcn_permlane32_swap((unsigned)v, (unsigned)v, false, false); return (int)(r[0] + r[1]); }
__device__ __forceinline__ float xsum16(float v) { const auto r = __builtin_amdgcn_permlane16_swap(__float_as_uint(v), __float_as_uint(v), false, false); return __uint_as_float(r[0]) + __uint_as_float(r[1]); }
__device__ __forceinline__ float wave_sum64(float v) {
    v += __uint_as_float(__builtin_amdgcn_update_dpp(0, __float_as_uint(v), 0x128, 0xf, 0xf, true));
    v += __uint_as_float(__builtin_amdgcn_update_dpp(0, __float_as_uint(v), 0x124, 0xf, 0xf, true));
    v += __uint_as_float(__builtin_amdgcn_update_dpp(0, __float_as_uint(v), 0x122, 0xf, 0xf, true));
    v += __uint_as_float(__builtin_amdgcn_update_dpp(0, __float_as_uint(v), 0x121, 0xf, 0xf, true));
    return xsum32(xsum16(v));
}
__device__ __forceinline__ float wave_sum(float v) {
#pragma unroll
    for (int o = 32; o > 0; o >>= 1) v += __shfl_xor(v, o);
    return v;
}
__device__ __forceinline__ float wave_max(float v) {
#pragma unroll
    for (int o = 32; o > 0; o >>= 1) v = fmaxf(v, __shfl_xor(v, o));
    return v;
}
__device__ __forceinline__ int wave_sumi(int v) {
#pragma unroll
    for (int o = 32; o > 0; o >>= 1) v += __shfl_xor(v, o);
    return v;
}
__device__ __forceinline__ float block_sum(float v, float* red) {
    v = wave_sum(v);
    __syncthreads();
    if ((threadIdx.x & 63) == 0) red[threadIdx.x >> 6] = v;
    __syncthreads();
    float s = 0.f;
#pragma unroll
    for (int i = 0; i < NW; ++i) s += red[i];
    return s;
}
__device__ __forceinline__ float block_max(float v, float* red) {
    v = wave_max(v);
    __syncthreads();
    if ((threadIdx.x & 63) == 0) red[threadIdx.x >> 6] = v;
    __syncthreads();
    float s = red[0];
#pragma unroll
    for (int i = 1; i < NW; ++i) s = fmaxf(s, red[i]);
    return s;
}
__device__ __forceinline__ int block_sumi(int v, int* red) {
    v = wave_sumi(v);
    __syncthreads();
    if ((threadIdx.x & 63) == 0) red[threadIdx.x >> 6] = v;
    __syncthreads();
    int s = 0;
#pragma unroll
    for (int i = 0; i < NW; ++i) s += red[i];
    return s;
}
__device__ __forceinline__ int block_excl_scan(int v, int* red, int* tot) {
    const int lane = threadIdx.x & 63, w = threadIdx.x >> 6;
    int inc = v;
#pragma unroll
    for (int o = 1; o < 64; o <<= 1) { int n = __shfl_up(inc, o); if (lane >= o) inc += n; }
    __syncthreads();
    if (lane == 63) red[w] = inc;
    __syncthreads();
    int base = 0, t = 0;
#pragma unroll
    for (int i = 0; i < NW; ++i) { if (i < w) base += red[i]; t += red[i]; }
    *tot = t;
    return base + inc - v;
}

__device__ __forceinline__ int phys2logical(int n) { const int p = n & 255; return (n & ~255) + 64 * ((p >> 5) & 3) + 32 * (p >> 7) + (p & 31); }
__device__ __forceinline__ int logical2orig(int n) {
    if (n < 3072) return n;
    if (n < YD_K) return n - YD_Z + O_DZ;
    if (n < YD_V) return n - YD_K + O_DK;
    if (n < YI_Q) return n - YD_V + O_DV;
    if (n < NIN) return n;
    return -1;
}
__device__ __forceinline__ void transpose_item(const float* W, int ldn, const float* gk, bf16_t* WT, int k0, int n0, int src, LAS float* scr, int lane) {
#pragma unroll
    for (int i = 0; i < 32; ++i) {
        const int kk = 2 * i + (lane >> 5);
        float v = 0.f;
        if (src >= 0) { v = W[(size_t)(k0 + kk) * ldn + src]; if (gk) v *= gk[k0 + kk]; }
        scr[kk * 33 + (lane & 31)] = v;
    }
    asm volatile("s_waitcnt lgkmcnt(0)" ::: "memory");
    const int c = lane & 7;
#pragma unroll
    for (int j = 0; j < 4; ++j) {
        const int n = (lane >> 3) + 8 * j; const LAS float* s = scr + (8 * c) * 33 + n;
        u32x4 o; o.x = pk2(s[0 * 33], s[1 * 33]); o.y = pk2(s[2 * 33], s[3 * 33]); o.z = pk2(s[4 * 33], s[5 * 33]); o.w = pk2(s[6 * 33], s[7 * 33]);
        *(GAS u32x4*)(uintptr_t)(WT + (size_t)(n0 + n) * DM + k0 + 8 * c) = o;
    }
    asm volatile("s_waitcnt lgkmcnt(0)" ::: "memory");
}
__device__ __forceinline__ int tid_now(int wave_s) { int lane; asm volatile("v_mbcnt_lo_u32_b32 %0, -1, 0\n\tv_mbcnt_hi_u32_b32 %0, -1, %0" : "=v"(lane)); return wave_s * 64 + lane; }
__device__ __forceinline__ void ph_prologue(const Params& p, LAS unsigned char* lds, int tid_in) {
    int tid = tid_in; asm volatile("" : "+v"(tid));
    const int lane = tid & 63, wave = tid >> 6;
    LAS float* scr = (LAS float*)(lds + wave * 8704);
    const int gw = blockIdx.x * NW + wave, ngw = gridDim.x * NW;
    constexpr int I_IN = DEPTH * 16 * (YP / 32), I_OUT = DEPTH * 16 * (DM / 32);
    for (int it = gw; it < I_IN + I_OUT; it += ngw) {
        if (it < I_IN) {
            const int l = it / (16 * (YP / 32)), r = it % (16 * (YP / 32)), kb = r / (YP / 32), nb = r % (YP / 32);
            const int src = logical2orig(phys2logical(nb * 32 + (lane & 31)));
            transpose_item(p.w_in + (size_t)l * DM * NIN, NIN, p.norm_g + l * DM, p.wt_in() + (size_t)l * YP * DM, kb * 64, nb * 32, src, scr, lane);
        } else {
            const int q = it - I_IN, l = q / (16 * (DM / 32)), r = q % (16 * (DM / 32)), kb = r / (DM / 32), nb = r % (DM / 32);
            transpose_item(p.w_out + (size_t)l * DM * DM, DM, nullptr, p.wt_out() + (size_t)l * DM * DM, kb * 64, nb * 32, nb * 32 + (lane & 31), scr, lane);
        }
    }
    if (blockIdx.x == 0) {
        float* sm = (float*)(p.ws + WS_SMALL);
        for (int i = tid; i < SM_END; i += NT) {
            float v;
            if (i < SM_CONVB) v = p.i_conv_w[i - SM_CONVW]; else if (i < SM_GMLPG) v = p.i_conv_b[i - SM_CONVB]; else if (i < SM_GMLPB) v = p.i_gmlp_g[i - SM_GMLPG];
            else if (i < SM_QG) v = p.i_gmlp_b[i - SM_GMLPB]; else if (i < SM_KG) v = p.i_diff_qg[i - SM_QG]; else if (i < SM_LAM) v = p.i_diff_kg[i - SM_KG];
            else if (i < SM_SUBG) v = p.i_diff_lam[i - SM_LAM]; else if (i < SM_DQG) v = p.i_diff_subg[i - SM_SUBG]; else if (i < SM_DKG) v = p.i_dsa_qg[i - SM_DQG];
            else v = p.i_dsa_kg[i - SM_DKG];
            sm[i] = v;
        }
    }
    for (int i = (blockIdx.x * NT + tid) * 4; i < DEPTH * 4 * 128 * 128; i += gridDim.x * NT * 4) {
        const f32x4 v = *(const GAS f32x4*)(uintptr_t)(p.gmlp_ws + i);
        *(GAS unsigned long long*)(uintptr_t)(p.wsb() + i) = (unsigned long long)pk2(v.x, v.y) | ((unsigned long long)pk2(v.z, v.w) << 32);
    }
    for (int r0 = gw * 4; r0 < NTOK; r0 += ngw * 4) {
        f32x4 v[4][4];
#pragma unroll
        for (int rr = 0; rr < 4; ++rr)
#pragma unroll
            for (int j = 0; j < 4; ++j) v[rr][j] = ((const GAS f32x4*)(uintptr_t)(p.x + (size_t)(r0 + rr) * DM))[lane + 64 * j];
#pragma unroll
        for (int rr = 0; rr < 4; ++rr) {
            GAS unsigned long long* o8 = (GAS unsigned long long*)(uintptr_t)(p.xb() + (size_t)(r0 + rr) * DM) + lane;
            float s = 0.f;
#pragma unroll
            for (int j = 0; j < 4; ++j) {
                const f32x4 q = v[rr][j];
                s += (q.x * q.x + q.y * q.y) + (q.z * q.z + q.w * q.w);
                o8[64 * j] = (unsigned long long)pk2(q.x, q.y) | ((unsigned long long)pk2(q.z, q.w) << 32);
            }
            s = wave_sum64(s);
            if (lane < 16) ((GAS float*)(uintptr_t)p.ssq())[(size_t)(r0 + rr) * 16 + lane] = lane == 0 ? s : 0.f;
        }
    }
}

__device__ __forceinline__ float silu_f(float v) { return v * __builtin_amdgcn_rcpf(1.f + __builtin_amdgcn_exp2f(-1.4426950408889634f * v)); }
struct EpiIn {
    static constexpr bool PERM = true, AFTER_DRAIN = false;
    unsigned char* ws; int l; LAS float* rs;
    __device__ __forceinline__ void operator()(const f32x4 (&acc)[2][2][4][2], const Unit& u, int wr, int wc, int fr_, int fq_) const {
        int fr = fr_, fq = fq_; asm volatile("" : "+v"(fr), "+v"(fq));
        const int pn = u.pn;
        bf16_t* Y = (bf16_t*)(ws + WS_Y); const float* ssq = (const float*)(ws + WS_SSQ); const float* smb = (const float*)(ws + WS_SMALL);
        const float* gmlp_g = smb + SM_GMLPG + l * 256; const float* qg = smb + SM_QG + l * 32; const float* kg = smb + SM_KG + l * 32;
        const float* dqg = smb + SM_DQG + l * 64; const float* dkg = smb + SM_DKG + l * 64;
        int op = 0; const float* g0 = nullptr; const float* g1 = nullptr;
        if (pn == 3 || pn == 6 || pn == 10 || pn == 12) op = 1;
        else if (pn == 4) op = 2;
        else if (pn == 5) { op = 3; g0 = gmlp_g + 64 * wc + 8 * fq; g1 = g0 + 32; }
        else if (pn == 7) { op = 4; g0 = qg + 8 * fq; g1 = g0; }
        else if (pn == 8) { op = 4; g0 = kg + 8 * fq; g1 = g0; }
        else if (pn == 11) { op = 5; g0 = dqg + 8 * fq; g1 = g0 + 32; }
        else if (pn == 13 && wc == 0) { op = 5; g0 = dkg + 8 * fq; g1 = g0 + 32; }
        float gn[16];
#pragma unroll
        for (int i = 0; i < 16; ++i) gn[i] = 1.f;
        if (op >= 3) {
            const f32x4 a = *(const GAS f32x4*)(uintptr_t)g0, b = *(const GAS f32x4*)(uintptr_t)(g0 + 4), c = *(const GAS f32x4*)(uintptr_t)g1, d = *(const GAS f32x4*)(uintptr_t)(g1 + 4);
            gn[0] = a.x; gn[1] = a.y; gn[2] = a.z; gn[3] = a.w; gn[4] = b.x; gn[5] = b.y; gn[6] = b.z; gn[7] = b.w;
            gn[8] = c.x; gn[9] = c.y; gn[10] = c.z; gn[11] = c.w; gn[12] = d.x; gn[13] = d.y; gn[14] = d.z; gn[15] = d.w;
        }
        const int colb = pn * 256 + 64 * wc + 8 * fq;
        {
            const int t = wr * 256 + wc * 64 + fq * 16 + fr;
            if (t < 256) {
                const f32x4* sp = (const f32x4*)(ssq + (size_t)(u.pm * 256 + t) * 16);
                const f32x4 s0 = sp[0], s1 = sp[1], s2 = sp[2], s3 = sp[3];
                const float tot = ((s0.x + s0.y) + (s0.z + s0.w)) + ((s1.x + s1.y) + (s1.z + s1.w)) + ((s2.x + s2.y) + (s2.z + s2.w)) + ((s3.x + s3.y) + (s3.z + s3.w));
                rs[t] = rsqrtf(tot * (1.f / DM) + EPS);
            }
            asm volatile("s_waitcnt vmcnt(0) lgkmcnt(0)" ::: "memory"); __builtin_amdgcn_s_barrier(); asm volatile("" ::: "memory");
        }
#pragma unroll
        for (int ai = 0; ai < 2; ++ai)
#pragma unroll
            for (int m = 0; m < 4; ++m) {
                const int row = u.pm * 256 + ai * 128 + wr * 64 + m * 16 + fr;
                const float rstd = rs[ai * 128 + wr * 64 + m * 16 + fr];
                float v[16];
#pragma unroll
                for (int bj = 0; bj < 2; ++bj)
#pragma unroll
                    for (int n = 0; n < 2; ++n)
#pragma unroll
                        for (int e = 0; e < 4; ++e) v[bj * 8 + n * 4 + e] = acc[ai][bj][m][n][e] * rstd;
                if (op == 1) {
#pragma unroll
                    for (int i = 0; i < 16; ++i) v[i] = silu_f(v[i]);
                } else if (op == 2 || op == 3) {
#pragma unroll
                    for (int i = 0; i < 16; i += 2) { const pg8::f32x2 r = pg8::gelu_pk((pg8::f32x2){v[i], v[i + 1]}); v[i] = r.x; v[i + 1] = r.y; }
                }
                if (op == 3 || op == 5) {
                    float ss = 0.f;
#pragma unroll
                    for (int i = 0; i < 16; ++i) ss += v[i] * v[i];
                    ss = xsum16(ss); ss = xsum32(ss);
                    const float sc = rsqrtf(ss * (1.f / 64) + EPS);
#pragma unroll
                    for (int i = 0; i < 16; ++i) v[i] *= sc * gn[i];
                } else if (op == 4) {
#pragma unroll
                    for (int bj = 0; bj < 2; ++bj) {
                        float ss = 0.f;
#pragma unroll
                        for (int i = 0; i < 8; ++i) ss += v[bj * 8 + i] * v[bj * 8 + i];
                        ss = xsum16(ss); ss = xsum32(ss);
                        const float sc = rsqrtf(ss * (1.f / 32) + EPS);
#pragma unroll
                        for (int i = 0; i < 8; ++i) v[bj * 8 + i] *= sc * gn[bj * 8 + i];
                    }
                }
                bf16_t* rowp = Y + (size_t)row * YP + colb;
#pragma unroll
                for (int bj = 0; bj < 2; ++bj) {
                    u32x4 w; w.x = pg8::cvt_pk_bf16(v[bj * 8 + 0], v[bj * 8 + 1]); w.y = pg8::cvt_pk_bf16(v[bj * 8 + 2], v[bj * 8 + 3]);
                    w.z = pg8::cvt_pk_bf16(v[bj * 8 + 4], v[bj * 8 + 5]); w.w = pg8::cvt_pk_bf16(v[bj * 8 + 6], v[bj * 8 + 7]);
                    *(GAS u32x4*)(uintptr_t)(rowp + 32 * bj) = w;
                }
            }
    }
};
struct EpiOut {
    static constexpr bool PERM = false, AFTER_DRAIN = false;
    float* xout; unsigned char* ws;
    __device__ __forceinline__ void operator()(const f32x4 (&acc)[2][2][4][2], const Unit& u, int wr, int wc, int fr_, int fq_) const {
        int fr = fr_, fq = fq_; asm volatile("" : "+v"(fr), "+v"(fq));
        const int col0 = u.pn * 256 + wc * 32 + 4 * fq;
        bf16_t* xb = (bf16_t*)(ws + WS_XB); float* ssq = (float*)(ws + WS_SSQ);
#pragma unroll
        for (int ai = 0; ai < 2; ++ai)
#pragma unroll
            for (int m = 0; m < 4; ++m) {
                const int row = u.pm * 256 + ai * 128 + wr * 64 + m * 16 + fr;
                float sq = 0.f;
#pragma unroll
                for (int bj = 0; bj < 2; ++bj)
#pragma unroll
                    for (int n = 0; n < 2; ++n) {
                        const size_t off = (size_t)row * DM + col0 + bj * 128 + n * 16;
                        const unsigned long long xo = *(const GAS unsigned long long*)(uintptr_t)(xb + off);
                        f32x4 v = acc[ai][bj][m][n];
                        v.x += __uint_as_float((unsigned)xo << 16); v.y += __uint_as_float((unsigned)xo & 0xffff0000u);
                        v.z += __uint_as_float((unsigned)(xo >> 32) << 16); v.w += __uint_as_float((unsigned)(xo >> 32) & 0xffff0000u);
                        sq += (v.x * v.x + v.y * v.y) + (v.z * v.z + v.w * v.w);
                        if (xout) *(GAS f32x4*)(uintptr_t)(xout + off) = v;
                        else *(GAS unsigned long long*)(uintptr_t)(xb + off) = (unsigned long long)pg8::cvt_pk_bf16(v.x, v.y) | ((unsigned long long)pg8::cvt_pk_bf16(v.z, v.w) << 32);
                    }
                sq = xsum16(sq); sq = xsum32(sq);
                if (fq == 0) ssq[(size_t)row * 16 + u.pn * 4 + wc] = sq;
                if (m == 3) asm volatile("" ::: "memory");
            }
    }
};
#define XB_TMO      128
#define XB_XCNT(j)  (256  + 64 * (j))
#define XB_XSUB(j)  (1280 + 64 * (j))
#define XB_XGEN(j)  (2304 + 64 * (j))
#define XB_TOP      3328
#define XB_TOPGEN   3392
#define XCD_BAR_WORDS 3456
#define XB_SPIN_CAP (1u << 18)

__device__ __forceinline__ unsigned xb_ld(unsigned* p)              { return __hip_atomic_load(p, __ATOMIC_RELAXED, __HIP_MEMORY_SCOPE_AGENT); }
__device__ __forceinline__ unsigned xb_add(unsigned* p, unsigned v) { return __hip_atomic_fetch_add(p, v, __ATOMIC_RELAXED, __HIP_MEMORY_SCOPE_AGENT); }
__device__ __forceinline__ unsigned xb_xcc_id() { return (unsigned)__builtin_amdgcn_s_getreg((3 << 11) | 20) & 0xFu; }
#define XB_SPIN(cond, bar) do { unsigned _sp = 0; while (cond) { __builtin_amdgcn_s_sleep(1); \
    if ((++_sp & 255u) == 0u) { if (xb_ld(&(bar)[XB_TMO])) break; if (_sp > XB_SPIN_CAP) { atomicAdd(&(bar)[XB_TMO], 1u); break; } } } } while (0)

struct XcdBarrier {
    unsigned* bar; unsigned x;
    volatile LAS unsigned* st;
};

__device__ __forceinline__ XcdBarrier xcd_barrier_post(unsigned* bar, volatile LAS unsigned* st) {
    XcdBarrier b; b.bar = bar; b.x = xb_xcc_id(); b.st = st;
    if (threadIdx.x == 0) (void)xb_add(&bar[XB_XCNT(b.x)], 1u);
    return b;
}
__device__ __forceinline__ void xcd_barrier_complete(unsigned* bar, unsigned x, unsigned& nloc, unsigned& nx) {
    const unsigned G = gridDim.x * gridDim.y * gridDim.z;
    unsigned sum, cnt, mine, sp = 0u;
    for (;;) {
        sum = 0u; cnt = 0u; mine = 0u;
#pragma unroll
        for (unsigned j = 0; j < 16; ++j) { const unsigned c = xb_ld(&bar[XB_XCNT(j)]); sum += c; cnt += (c > 0u) ? 1u : 0u; mine = (j == x) ? c : mine; }
        if (sum == G) break;
        __builtin_amdgcn_s_sleep(1);
        if ((++sp & 255u) == 0u) { if (xb_ld(&bar[XB_TMO])) break; if (sp > XB_SPIN_CAP) { atomicAdd(&bar[XB_TMO], 1u); break; } }
    }
    nloc = mine > 0u ? mine : 1u; nx = cnt > 0u ? cnt : 1u;
}

__device__ __forceinline__ void xcd_barrier(const XcdBarrier& b, int tid_in) {
    asm volatile("s_waitcnt vmcnt(0)" ::: "memory");
    __syncthreads();
    int t0_ = tid_in; asm volatile("" : "+v"(t0_));
    if (t0_ == 0) {
        unsigned* bar = b.bar; unsigned bx = b.x; asm volatile("" : "+s"(bar), "+s"(bx));
        __builtin_amdgcn_s_waitcnt(0);
        unsigned nloc = b.st[0], nx = b.st[1];
        if (nloc == 0u) { xcd_barrier_complete(bar, bx, nloc, nx); b.st[0] = nloc; b.st[1] = nx; }
        const unsigned old = xb_add(&bar[XB_XSUB(bx)], 1u);
        const unsigned gen = old / nloc;
        if (old + 1u == (gen + 1u) * nloc) {
            __builtin_amdgcn_fence(__ATOMIC_RELEASE, "agent");
            asm volatile("s_waitcnt vmcnt(0)" ::: "memory");
            const unsigned og = xb_add(&bar[XB_TOP], 1u);
            const unsigned tg = og / nx;
            if (og + 1u == (tg + 1u) * nx) xb_add(&bar[XB_TOPGEN], 1u);
            else XB_SPIN(xb_ld(&bar[XB_TOPGEN]) == tg, bar);
            __builtin_amdgcn_fence(__ATOMIC_ACQUIRE, "agent");
            xb_add(&bar[XB_XGEN(bx)], 1u);
            asm volatile("s_waitcnt vmcnt(0)" ::: "memory");
        } else {
            XB_SPIN(xb_ld(&bar[XB_XGEN(bx)]) == gen, bar);
            __builtin_amdgcn_fence(__ATOMIC_ACQUIRE, "agent");
            asm volatile("s_waitcnt vmcnt(0)" ::: "memory");
        }
    }
    __syncthreads();
}

typedef short bf16x8_t __attribute__((ext_vector_type(8)));
typedef short s16x4_t __attribute__((ext_vector_type(4)));
typedef float f32x16 __attribute__((ext_vector_type(16)));
typedef float f32x2_t __attribute__((ext_vector_type(2)));
typedef __bf16 bf16x2_t __attribute__((ext_vector_type(2)));
#define MFMA32(a, b, c) __builtin_amdgcn_mfma_f32_32x32x16_bf16((a), (b), (c), 0, 0, 0)
__device__ __forceinline__ unsigned cvtpk(float lo, float hi) { f32x2_t v = {lo, hi}; bf16x2_t b = __builtin_convertvector(v, bf16x2_t); return __builtin_bit_cast(unsigned, b); }
__device__ __forceinline__ s16x4_t ds_tr16(const LAS unsigned char* p) { return __builtin_bit_cast(s16x4_t, __builtin_amdgcn_ds_read_tr16_b64_v4i16((LAS s16x4_t*)p)); }
__device__ __forceinline__ bf16x8_t pack_step(const f32x16& x, int s) {
    u32x4 p; p.x = cvtpk(x[8 * s], x[8 * s + 1]); p.y = cvtpk(x[8 * s + 2], x[8 * s + 3]); p.z = cvtpk(x[8 * s + 4], x[8 * s + 5]); p.w = cvtpk(x[8 * s + 6], x[8 * s + 7]);
    return __builtin_bit_cast(bf16x8_t, p);
}
constexpr int KV_STRIDE = 144;
constexpr int KV_TILE = 64 * KV_STRIDE;
__device__ __forceinline__ bf16x8_t vt_frag(const LAS unsigned char* vtile, int ks, int db, int lane) {
    const int i16 = lane & 15, q = i16 >> 2, pp = i16 & 3, blk = (lane >> 4) & 1, hh = lane >> 5;
    const LAS unsigned char* a = vtile + (16 * ks + 4 * hh + q) * KV_STRIDE + (32 * db + 16 * blk + 4 * pp) * 2;
    const s16x4_t lo = ds_tr16(a), hi = ds_tr16(a + 8 * KV_STRIDE);
    return __builtin_shufflevector(lo, hi, 0, 1, 2, 3, 4, 5, 6, 7);
}

constexpr int KVL_TILE = 64 * 128;
__device__ __forceinline__ void dma_piece(const bf16_t* src_row0, LAS unsigned char* dst, int lane) {
    const bf16_t* g = src_row0 + (size_t)(lane >> 3) * YP + (((lane & 7) ^ (lane >> 3)) * 8);
    const unsigned d = (unsigned)__builtin_amdgcn_readfirstlane((int)(unsigned)(size_t)dst);
    unsigned keep;
    asm volatile("s_mov_b32 %0, m0\n\ts_mov_b32 m0, %2\n\ts_nop 0\n\tglobal_load_lds_dwordx4 %1, off\n\ts_mov_b32 m0, %0" : "=&s"(keep) : "v"(g), "s"(d) : "memory");
}
__device__ __forceinline__ bf16x8_t vt_frag_sw(const LAS unsigned char* vtile, int ks, int db, int lane) {
    const int i16 = lane & 15, q = i16 >> 2, pp = i16 & 3, blk = (lane >> 4) & 1, hh = lane >> 5;
    const int row = 16 * ks + 4 * hh + q, ch = 4 * db + 2 * blk + (pp >> 1);
    const LAS unsigned char* a = vtile + row * 128 + ((ch ^ (row & 7)) * 16) + (pp & 1) * 8;
    const s16x4_t lo = ds_tr16(a), hi = ds_tr16(a + 8 * 128);
    return __builtin_shufflevector(lo, hi, 0, 1, 2, 3, 4, 5, 6, 7);
}

__device__ __forceinline__ void mixC_unit(const Params& p, int l, int b, int h, int qt, LAS unsigned char* lds, int wave_s) {
    const int tid = tid_now(wave_s);
    volatile LAS float* pc = (volatile LAS float*)(lds + 131072 + 2048);
    const float mfix = pc[0];
    const int lane = tid & 63, wave = __builtin_amdgcn_readfirstlane(tid >> 6), r32 = lane & 31, hh = lane >> 5;
    const size_t rowb = (size_t)b * SEQ;
    const int q0 = qt * 256 + wave * 32;
    const int cw = (q0 >> 6);
    const int jmax = 4 * qt + 3;
    const int pos = q0 + r32;
    const bf16_t* yq = p.Y() + (rowb + pos) * YP;
    bf16x8_t qf[2][2];
#pragma unroll
    for (int c = 0; c < 2; ++c)
#pragma unroll
        for (int s = 0; s < 2; ++s) qf[c][s] = *(const GAS bf16x8_t*)(uintptr_t)(yq + YC_Q + h * 64 + c * 32 + 16 * s + 8 * hh);
    const float c1 = 0.17677669529663687f * 1.4426950408889634f;
    const float sl2 = exp2f(-(float)(2 * h + 1)) * 1.4426950408889634f;
    f32x16 o[2][2];
#pragma unroll
    for (int c = 0; c < 2; ++c)
#pragma unroll
        for (int d = 0; d < 2; ++d)
#pragma unroll
            for (int i = 0; i < 16; ++i) o[c][d][i] = 0.f;
    float lrun[2] = {0.f, 0.f};
    const bf16_t* ksrc = p.Y() + (rowb + 8 * wave) * YP + YC_K + h * 64;
    const bf16_t* vsrc = p.Y() + (rowb + 8 * wave) * YP + YC_V + h * 64;
    LAS unsigned char* kring = lds;
    LAS unsigned char* vring = lds + 6 * KVL_TILE;
    asm volatile("" : "+v"(qf[0][0]), "+v"(qf[0][1]), "+v"(qf[1][0]), "+v"(qf[1][1]));
    const float mfix_r = mfix; asm volatile("" :: "v"(mfix_r));
    asm volatile("s_waitcnt lgkmcnt(0)" ::: "memory"); __builtin_amdgcn_s_barrier(); asm volatile("" ::: "memory");
#pragma unroll
    for (int t = 0; t < 4; ++t) { dma_piece(ksrc + (size_t)t * 64 * YP, kring + t * KVL_TILE + wave * 1024, lane); dma_piece(vsrc + (size_t)t * 64 * YP, vring + t * KVL_TILE + wave * 1024, lane); }
    int slot = 0, slot2 = 4;
    for (int j = 0; j <= jmax; ++j) {
        if ((j & 1) == 0) {
            TB(3, lds, tid);
            if (j + 2 <= jmax) asm volatile("s_waitcnt vmcnt(4)" ::: "memory"); else asm volatile("s_waitcnt vmcnt(0)" ::: "memory");
            __builtin_amdgcn_s_barrier(); asm volatile("" ::: "memory");
            if (j + 4 <= jmax) {
#pragma unroll
                for (int t = 0; t < 2; ++t) {
                    const int sl = slot2 + t >= 6 ? slot2 + t - 6 : slot2 + t;
                    dma_piece(ksrc + (size_t)(j + 4 + t) * 64 * YP, kring + sl * KVL_TILE + wave * 1024, lane); dma_piece(vsrc + (size_t)(j + 4 + t) * 64 * YP, vring + sl * KVL_TILE + wave * 1024, lane);
                }
            }
            TE(3, lds, tid);
        }
        TB(2, lds, tid);
        if (j <= cw) {
            const LAS unsigned char* kt = kring + slot * KVL_TILE;
            const LAS unsigned char* vt = vring + slot * KVL_TILE;
            const float pl = (float)(pos - 64 * j - 4 * hh);
            const bool diag = (j == cw);
#pragma unroll
            for (int c = 0; c < 2; ++c) {
                f32x16 sc[2];
#pragma unroll
                for (int kb = 0; kb < 2; ++kb) {
                    f32x16 a;
#pragma unroll
                    for (int i = 0; i < 16; ++i) a[i] = 0.f;
#pragma unroll
                    for (int s = 0; s < 2; ++s) {
                        const bf16x8_t kf = *(const LAS bf16x8_t*)(kt + (32 * kb + r32) * 128 + (((4 * c + 2 * s + hh) ^ (r32 & 7)) * 16));
                        a = MFMA32(kf, qf[c][s], a);
                    }
                    sc[kb] = a;
                }
                float ls4[4] = {0.f, 0.f, 0.f, 0.f};
                if (!diag) {
                    const float rt = -sl2 * pl - mfix;
                    const f32x2_t d01 = {0.f, sl2}, d23 = {2.f * sl2, 3.f * sl2}, c1v = {c1, c1};
                    f32x2_t lsv0 = {0.f, 0.f}, lsv1 = {0.f, 0.f};
#pragma unroll
                    for (int kb = 0; kb < 2; ++kb)
#pragma unroll
                        for (int g = 0; g < 4; ++g) {
                            const float bs = fmaf(sl2, (float)(32 * kb + 8 * g), rt);
                            const f32x2_t bv = {bs, bs};
                            const f32x2_t t01 = (f32x2_t){sc[kb][4 * g], sc[kb][4 * g + 1]} * c1v + (bv + d01);
                            const f32x2_t t23 = (f32x2_t){sc[kb][4 * g + 2], sc[kb][4 * g + 3]} * c1v + (bv + d23);
                            const f32x2_t e01 = {__builtin_amdgcn_exp2f(t01.x), __builtin_amdgcn_exp2f(t01.y)}, e23 = {__builtin_amdgcn_exp2f(t23.x), __builtin_amdgcn_exp2f(t23.y)};
                            sc[kb][4 * g] = e01.x; sc[kb][4 * g + 1] = e01.y; sc[kb][4 * g + 2] = e23.x; sc[kb][4 * g + 3] = e23.y;
                            lsv0 += e01; lsv1 += e23;
                        }
                    ls4[0] = lsv0.x; ls4[1] = lsv0.y; ls4[2] = lsv1.x; ls4[3] = lsv1.y;
                } else {
#pragma unroll
                    for (int kb = 0; kb < 2; ++kb)
#pragma unroll
                        for (int i = 0; i < 16; ++i) {
                            const float kc = (float)(32 * kb + (i & 3) + 8 * (i >> 2));
                            const float e = __builtin_amdgcn_exp2f(fmaf(sc[kb][i], c1, fmaf(-sl2, fabsf(pl - kc), -mfix)));
                            sc[kb][i] = e; ls4[i & 3] += e;
                        }
                }
                lrun[c] += (ls4[0] + ls4[1]) + (ls4[2] + ls4[3]);
#pragma unroll
                for (int ks = 0; ks < 4; ++ks) {
                    const bf16x8_t pf = pack_step(sc[ks >> 1], ks & 1);
#pragma unroll
                    for (int db = 0; db < 2; ++db) o[c][db] = MFMA32(vt_frag_sw(vt, ks, db, lane), pf, o[c][db]);
                }
            }
        }
        TE(2, lds, tid);
        slot = slot == 5 ? 0 : slot + 1; slot2 = slot2 == 5 ? 0 : slot2 + 1;
    }
    const float lam = pc[1], oml = pc[2];
    const int tid2 = tid_now(wave_s), lane2 = tid2 & 63, r32e = lane2 & 31, hhe = lane2 >> 5;
    const int pose = qt * 256 + wave * 32 + r32e;
    const bf16_t* yqe = p.Y() + (rowb + pose) * YP;
    const float l1 = xsum32(lrun[0]), l2 = xsum32(lrun[1]);
    const float i1 = 1.f / l1, i2 = lam / l2;
    float ss = 0.f;
#pragma unroll
    for (int d = 0; d < 2; ++d)
#pragma unroll
        for (int i = 0; i < 16; ++i) { const float v = o[0][d][i] * i1 - o[1][d][i] * i2; o[0][d][i] = v; ss += v * v; }
    ss = xsum32(ss);
    const float rn = rsqrtf(ss * (1.f / 64) + EPS) * oml;
    const GAS float* sg = p.sm(SM_SUBG) + l * 256 + h * 64;
    bf16_t* mrow = p.mix() + (rowb + pose) * DM + 512 + h * 64;
#pragma unroll
    for (int d = 0; d < 2; ++d)
#pragma unroll
        for (int g = 0; g < 4; ++g) {
            const int d0 = 32 * d + 8 * g + 4 * hhe;
            const f32x4 gv = *(const GAS f32x4*)(uintptr_t)(sg + d0);
            const unsigned long long zz = *(const GAS unsigned long long*)(uintptr_t)(yqe + YC_Z + h * 64 + d0);
            const float z0 = __uint_as_float((unsigned)(zz & 0xffffu) << 16), z1 = __uint_as_float((unsigned)((zz >> 16) & 0xffffu) << 16),
                        z2 = __uint_as_float((unsigned)((zz >> 32) & 0xffffu) << 16), z3 = __uint_as_float((unsigned)((zz >> 48) & 0xffffu) << 16);
            const float v0 = o[0][d][4 * g] * rn * gv.x * z0, v1 = o[0][d][4 * g + 1] * rn * gv.y * z1, v2 = o[0][d][4 * g + 2] * rn * gv.z * z2, v3 = o[0][d][4 * g + 3] * rn * gv.w * z3;
            *(GAS unsigned long long*)(uintptr_t)(mrow + d0) = (unsigned long long)cvtpk(v0, v1) | ((unsigned long long)cvtpk(v2, v3) << 32);
        }
}
__device__ __forceinline__ void ph_mixC(const Params& p, int l, LAS unsigned char* lds, int bid, int nb, int wave_s) {
    {
        const float lam_init = l == 0 ? 0.200000001f : l == 1 ? 0.355509068f : l == 2 ? 0.470713018f : 0.556058204f;
        const GAS float* lp = p.sm(SM_LAM) + l * 128;
        float d1 = 0.f, d2 = 0.f;
        for (int i = 0; i < 32; ++i) { d1 += lp[i] * lp[32 + i]; d2 += lp[64 + i] * lp[96 + i]; }
        float gq = 0.f, gk = 0.f;
        for (int i = 0; i < 32; ++i) { gq = fmaxf(gq, fabsf(p.sm(SM_QG)[l * 32 + i])); gk = fmaxf(gk, fabsf(p.sm(SM_KG)[l * 32 + i])); }
        volatile LAS float* pc = (volatile LAS float*)(lds + 131072 + 2048);
        if (tid_now(wave_s) == 0) {
            pc[0] = 0.17677669529663687f * 1.4426950408889634f * 32.f * gq * gk * 1.02f;
            pc[1] = expf(d1) - expf(d2) + lam_init;
            pc[2] = 1.f - lam_init;
        }
        __syncthreads();
    }
    for (int i = bid; i < 256; i += nb) {
#pragma unroll 1
        for (int k = 0; k < 2; ++k) {
            const int id = k == 0 ? i : 511 - i;
            const int qt = id < 256 ? 7 - (id >> 6) : 3 - ((id - 256) >> 6), bh = id & 63;
            mixC_unit(p, l, bh >> 2, bh & 3, qt, lds, wave_s);
        }
    }
}

constexpr int SC_STRIDE = 2052;
constexpr int SC_BYTES = 16 * SC_STRIDE * 4;
constexpr int IK_STRIDE = 80, IK_TILE = 64 * IK_STRIDE;
__device__ __forceinline__ unsigned fkey(float f) { const unsigned u = __float_as_uint(f); return (u & 0x80000000u) ? ~u : (u | 0x80000000u); }
__device__ __forceinline__ float unfkey(unsigned k) { return __uint_as_float((k & 0x80000000u) ? (k & 0x7fffffffu) : ~k); }
__device__ __forceinline__ f32x16 idx_scores(const bf16x8_t ik0, const bf16x8_t ik1, const bf16x8_t (&iqf)[4][2], const float (&w)[4]) {
    f32x16 sc;
#pragma unroll
    for (int i = 0; i < 16; ++i) sc[i] = 0.f;
#pragma unroll
    for (int hd = 0; hd < 4; ++hd) {
        f32x16 a;
#pragma unroll
        for (int i = 0; i < 16; ++i) a[i] = 0.f;
        a = MFMA32(ik0, iqf[hd][0], a);
        a = MFMA32(ik1, iqf[hd][1], a);
#pragma unroll
        for (int i = 0; i < 16; ++i) sc[i] = fmaf(w[hd], __builtin_amdgcn_fmed3f(a[i], 0.f, __builtin_inff()), sc[i]);
    }
#pragma unroll
    for (int i = 0; i < 16; ++i) sc[i] = sc[i] + 0.f;
    return sc;
}
__device__ __forceinline__ void transpose32(unsigned (&a)[32]) {
#pragma unroll
    for (int s = 0; s < 5; ++s) {
        const int j = 16 >> s;
        const unsigned mk = j == 16 ? 0x0000ffffu : j == 8 ? 0x00ff00ffu : j == 4 ? 0x0f0f0f0fu : j == 2 ? 0x33333333u : 0x55555555u;
#pragma unroll
        for (int k = 0; k < 32; ++k)
            if ((k & j) == 0) { const unsigned t = (a[k] ^ (a[k + j] >> j)) & mk; a[k] ^= t; a[k + j] ^= t << j; asm volatile("" : "+v"(a[k]), "+v"(a[k + j])); }
    }
}
__device__ __forceinline__ int rowsum16(int v) {
    v += __builtin_amdgcn_update_dpp(0, v, 0x128, 0xf, 0xf, true);
    v += __builtin_amdgcn_update_dpp(0, v, 0x124, 0xf, 0xf, true);
    v += __builtin_amdgcn_update_dpp(0, v, 0x122, 0xf, 0xf, true);
    v += __builtin_amdgcn_update_dpp(0, v, 0x121, 0xf, 0xf, true);
    return v;
}
__device__ __forceinline__ unsigned topbits(int ne) { return ne <= 0 ? 0u : ne >= 32 ? 0xffffffffu : (0xffffffffu << (32 - ne)); }
template <int ST>
__device__ __forceinline__ void rs4_row(const unsigned (&pl)[4][32], unsigned (&alive)[4], int& above, unsigned& prefix, bool& done, bool& alld, int nmr) {
    if (!alld) {
        int c11 = 0, c10 = 0, c01 = 0;
#pragma unroll
        for (int j = 0; j < 4; ++j)
            if (j < nmr) {
                const unsigned p1 = pl[j][2 * ST], p0 = pl[j][2 * ST + 1], a1 = alive[j] & p1, a0 = alive[j] & ~p1;
                c11 += __popc(a1 & p0); c10 += __popc(a1 & ~p0); c01 += __popc(a0 & p0);
            }
        const int s01 = rowsum16(c11 | (c10 << 16)), s2 = rowsum16(c01);
        if (!done) {
            const int t11 = above + (s01 & 0xffff), t10 = t11 + (int)((unsigned)s01 >> 16), t01 = t10 + s2;
            const int dg = t11 >= TOPK ? 3 : t10 >= TOPK ? 2 : t01 >= TOPK ? 1 : 0;
            const int tsel = dg == 3 ? t11 : dg == 2 ? t10 : t01;
            prefix |= (unsigned)dg << (30 - 2 * ST);
            above = dg == 3 ? above : dg == 2 ? t11 : dg == 1 ? t10 : t01;
#pragma unroll
            for (int j = 0; j < 4; ++j)
                if (j < nmr) {
                    const unsigned p1 = pl[j][2 * ST], p0 = pl[j][2 * ST + 1];
                    alive[j] &= ((dg & 2) ? p1 : ~p1) & ((dg & 1) ? p0 : ~p0);
                }
            if (dg != 0 && tsel == TOPK) done = true;
        }
        alld = __all(done);
    }
    if constexpr (ST < 15) rs4_row<ST + 1>(pl, alive, above, prefix, done, alld, nmr);
}
__device__ __forceinline__ void mixD_attend(const Params& p, int b, int c, LAS unsigned char* lds, int wave_s);
__device__ __forceinline__ void mixD_unit(const Params& p, int b, int c, LAS unsigned char* lds, int wave_s) {
    const int tid = tid_now(wave_s);
    const int lane = tid & 63, wave = __builtin_amdgcn_readfirstlane(tid >> 6), r32 = lane & 31, hh = lane >> 5;
    const size_t rowb = (size_t)b * SEQ;
    const int q0 = c * 64, ntile = c + 1;
    LAS float* thr = (LAS float*)(lds + 131072 + 1024);
    LAS int* kcs = (LAS int*)(lds + 131072 + 1280);
    const bool dosel = c >= 4;
    __syncthreads();
    if (dosel) {
        constexpr int SKS = 1028;
        LAS unsigned* sk = (LAS unsigned*)lds;
        const int nblk = 2 * ntile;
        const int nbw = (nblk - wave + 7) >> 3;
        const int nv = 4 * ntile;
        const int nmr = (nv + 31) >> 5;
#pragma unroll 1
        for (int sp = 0; sp < 2; ++sp) {
            TB(4, lds, tid); TB(5, lds, tid);
            unsigned kr[4][32];
            unsigned zopq = 0u; asm volatile("" : "+v"(zopq));
            {
                const bf16_t* yq1 = p.Y() + (rowb + q0 + 32 * sp + r32) * YP;
                bf16x8_t iqf[4][2];
#pragma unroll
                for (int hd = 0; hd < 4; ++hd)
#pragma unroll
                    for (int s = 0; s < 2; ++s) iqf[hd][s] = *(const GAS bf16x8_t*)(uintptr_t)(yq1 + YI_Q + hd * 32 + 16 * s + 8 * hh);
                float w[4];
                const unsigned long long ww = *(const GAS unsigned long long*)(uintptr_t)(yq1 + YI_W);
#pragma unroll
                for (int hd = 0; hd < 4; ++hd) w[hd] = __uint_as_float((unsigned)((ww >> (16 * hd)) & 0xffffu) << 16) * (0.17677669529663687f * 0.5f);
#pragma unroll
                for (int g = 0; g < 2; ++g) {
                    bf16x8_t ik[4][2];
#pragma unroll
                    for (int i = 0; i < 4; ++i) {
                        const int kb = 4 * g + i < nbw ? wave + 8 * (4 * g + i) : wave;
                        const bf16_t* yk = p.Y() + (rowb + 32 * kb + r32) * YP + YI_K + 8 * hh;
                        ik[i][0] = *(const GAS bf16x8_t*)(uintptr_t)yk; ik[i][1] = *(const GAS bf16x8_t*)(uintptr_t)(yk + 16);
                    }
#pragma unroll
                    for (int i = 0; i < 4; ++i) {
                        const int blk = 4 * g + i;
                        if (blk < nbw) {
                            const f32x16 sc = idx_scores(ik[i][0], ik[i][1], iqf, w);
#pragma unroll
                            for (int r = 0; r < 16; ++r) kr[blk >> 1][16 * (blk & 1) + r] = fkey(sc[r]);
                        } else {
#pragma unroll
                            for (int r = 0; r < 16; ++r) kr[blk >> 1][16 * (blk & 1) + r] = zopq;
                        }
                    }
                    asm volatile("" ::: "memory");
                }
            }
            TE(5, lds, tid); TB(20, lds, tid);
            unsigned pl[4][32];
            {
                const int rq = 4 * wave + (lane >> 4), rt = lane & 15;
#pragma unroll
                for (int rd = 0; rd < 2; ++rd) {
#pragma unroll
                    for (int i = 0; i < 4; ++i)
#pragma unroll
                        for (int g = 0; g < 4; ++g) {
                            const int blk = 4 * rd + i;
                            u32x4 v; v.x = kr[blk >> 1][16 * (blk & 1) + 4 * g]; v.y = kr[blk >> 1][16 * (blk & 1) + 4 * g + 1]; v.z = kr[blk >> 1][16 * (blk & 1) + 4 * g + 2]; v.w = kr[blk >> 1][16 * (blk & 1) + 4 * g + 3];
                            *(LAS u32x4*)(sk + r32 * SKS + 32 * wave + 256 * i + 8 * g + 4 * hh) = v;
                        }
                    __syncthreads();
#pragma unroll
                    for (int M = 0; M < 16; ++M) {
                        const u32x4 v = *(const LAS u32x4*)(sk + rq * SKS + 64 * M + 4 * rt);
                        pl[2 * rd + (M >> 3)][4 * (M & 7)] = v.x; pl[2 * rd + (M >> 3)][4 * (M & 7) + 1] = v.y; pl[2 * rd + (M >> 3)][4 * (M & 7) + 2] = v.z; pl[2 * rd + (M >> 3)][4 * (M & 7) + 3] = v.w;
                    }
                    __syncthreads();
                }
            }
            TE(20, lds, tid); TB(6, lds, tid);
#pragma unroll
            for (int j = 0; j < 4; ++j) transpose32(pl[j]);
            TE(6, lds, tid); TB(7, lds, tid);
            unsigned alive[4];
#pragma unroll
            for (int j = 0; j < 4; ++j) alive[j] = topbits(nv - 32 * j);
            int above = 0; unsigned prefix = 0u; bool done = false, alld = false;
            rs4_row<0>(pl, alive, above, prefix, done, alld, nmr);
            TE(7, lds, tid); TB(8, lds, tid);
            int kcut = 1 << 20;
            if (!__all(done)) {
                const int need = TOPK - above, rt = lane & 15;
                int posk = 0;
#pragma unroll 1
                for (int b2 = 10; b2 >= 0; --b2) {
                    const int tt = posk | (1 << b2);
                    const int R = tt - 4 * rt;
                    const int M = R <= 0 ? 0 : 4 * (R >> 6) + min(R & 63, 4);
                    int c = 0;
#pragma unroll
                    for (int j = 0; j < 4; ++j) c += __popc(alive[j] & topbits(M - 32 * j));
                    const int f = rowsum16(c);
                    if (f < need) posk = tt;
                }
                if (!done) kcut = posk;
            }
            TE(8, lds, tid); TE(4, lds, tid);
            if ((lane & 15) == 0) { thr[32 * sp + 4 * wave + (lane >> 4)] = unfkey(prefix); kcs[32 * sp + 4 * wave + (lane >> 4)] = kcut; }
            __syncthreads();
        }
    }
    mixD_attend(p, b, c, lds, wave_s);
}
__device__ __forceinline__ void mixD_attend(const Params& p, int b, int c, LAS unsigned char* lds, int wave_s) {
    const int tid = tid_now(wave_s);
    const int lane = tid & 63, wave = __builtin_amdgcn_readfirstlane(tid >> 6), r32 = lane & 31, hh = lane >> 5;
    const size_t rowb = (size_t)b * SEQ;
    const int q0 = c * 64, ntile = c + 1;
    LAS float* thr = (LAS float*)(lds + 131072 + 1024);
    LAS int* kcs = (LAS int*)(lds + 131072 + 1280);
    const bool dosel = c >= 4;
    TB(9, lds, tid);
    const int qg = wave >> 2, hd = wave & 3;
    const int pos = q0 + 32 * qg + r32;
    const bf16_t* yq = p.Y() + (rowb + pos) * YP;
    bf16x8_t qf[4];
#pragma unroll
    for (int s = 0; s < 4; ++s) qf[s] = *(const GAS bf16x8_t*)(uintptr_t)(yq + YD_Q + hd * 64 + 16 * s + 8 * hh);
    bf16x8_t iqf[4][2];
    float w[4];
    float T = -INFINITY; int kcut = 1 << 20;
    if (dosel) {
#pragma unroll
        for (int h2 = 0; h2 < 4; ++h2)
#pragma unroll
            for (int s = 0; s < 2; ++s) iqf[h2][s] = *(const GAS bf16x8_t*)(uintptr_t)(yq + YI_Q + h2 * 32 + 16 * s + 8 * hh);
        const unsigned long long ww = *(const GAS unsigned long long*)(uintptr_t)(yq + YI_W);
#pragma unroll
        for (int h2 = 0; h2 < 4; ++h2) w[h2] = __uint_as_float((unsigned)((ww >> (16 * h2)) & 0xffffu) << 16) * (0.17677669529663687f * 0.5f);
        T = thr[32 * qg + r32]; kcut = kcs[32 * qg + r32];
    } else {
#pragma unroll
        for (int h2 = 0; h2 < 4; ++h2) { w[h2] = 0.f;
#pragma unroll
            for (int s = 0; s < 2; ++s)
#pragma unroll
                for (int e = 0; e < 8; ++e) iqf[h2][s][e] = 0; }
    }
    const float c1 = 0.125f * 1.4426950408889634f;
    const float sl2 = exp2f(-(float)(2 * hd + 2)) * 1.4426950408889634f;
    f32x16 o[2];
#pragma unroll
    for (int d = 0; d < 2; ++d)
#pragma unroll
        for (int i = 0; i < 16; ++i) o[d][i] = 0.f;
    float mrun = -1e30f, lrun = 0.f;
    const int npair = (ntile + 1) >> 1;
    const bf16_t* ksrc = p.Y() + (rowb + 8 * wave) * YP + YD_K;
    const bf16_t* vsrc = p.Y() + (rowb + 8 * wave) * YP + YD_V;
    LAS unsigned char* kring = lds;
    LAS unsigned char* vring = lds + 4 * KVL_TILE;
    LAS unsigned* mbuf = (LAS unsigned*)(lds + 8 * KVL_TILE);
    const int mtile = hd >> 1, mkb = hd & 1;
    bf16x8_t ikn0, ikn1;
    {
        const bf16_t* yk = p.Y() + (rowb + 64 * min(mtile, ntile - 1) + 32 * mkb + r32) * YP + YI_K + 8 * hh;
        ikn0 = *(const GAS bf16x8_t*)(uintptr_t)yk; ikn1 = *(const GAS bf16x8_t*)(uintptr_t)(yk + 16);
    }
#define D2_MASK(pq, sl) do { \
        const int tm_ = 2 * (pq) + mtile; unsigned bits_ = 0u; \
        if (tm_ < ntile) { \
            const f32x16 ss_ = idx_scores(ikn0, ikn1, iqf, w); \
            const int kcl_ = kcut - 64 * tm_ - 4 * hh; \
            _Pragma("unroll") for (int i = 0; i < 16; ++i) { const int kci_ = 32 * mkb + (i & 3) + 8 * (i >> 2); \
                const bool sel_ = (ss_[i] > T) || (ss_[i] == T && kci_ <= kcl_); bits_ |= sel_ ? (1u << i) : 0u; } \
        } \
        mbuf[(((sl) * 2 + qg) * 4 + hd) * 64 + lane] = bits_; } while (0)
    asm volatile("" : "+v"(qf[0]), "+v"(qf[1]), "+v"(qf[2]), "+v"(qf[3]));
    __syncthreads();
#pragma unroll
    for (int tt = 0; tt < 2; ++tt) {
        const int t = min(tt, ntile - 1);
        dma_piece(ksrc + (size_t)t * 64 * YP, kring + tt * KVL_TILE + wave * 1024, lane); dma_piece(vsrc + (size_t)t * 64 * YP, vring + tt * KVL_TILE + wave * 1024, lane);
    }
    if (dosel) D2_MASK(0, 0);
    for (int pp = 0; pp < npair; ++pp) {
        const int cur = pp & 1;
        const bool more = pp + 1 < npair;
        TB(12, lds, tid);
        asm volatile("s_waitcnt vmcnt(0) lgkmcnt(0)" ::: "memory"); __builtin_amdgcn_s_barrier(); asm volatile("" ::: "memory");
        TE(12, lds, tid);
        if (more) {
#pragma unroll
            for (int tt = 0; tt < 2; ++tt) {
                const int t = min(2 * (pp + 1) + tt, ntile - 1);
                dma_piece(ksrc + (size_t)t * 64 * YP, kring + ((cur ^ 1) * 2 + tt) * KVL_TILE + wave * 1024, lane); dma_piece(vsrc + (size_t)t * 64 * YP, vring + ((cur ^ 1) * 2 + tt) * KVL_TILE + wave * 1024, lane);
            }
            if (dosel) {
                const bf16_t* yk = p.Y() + (rowb + 64 * min(2 * (pp + 1) + mtile, ntile - 1) + 32 * mkb + r32) * YP + YI_K + 8 * hh;
                ikn0 = *(const GAS bf16x8_t*)(uintptr_t)yk; ikn1 = *(const GAS bf16x8_t*)(uintptr_t)(yk + 16);
            }
        }
        TB(11, lds, tid);
#pragma unroll 1
        for (int tt = 0; tt < 2; ++tt) {
            const int j = 2 * pp + tt;
            if (j < ntile) {
                const LAS unsigned char* kt = kring + (cur * 2 + tt) * KVL_TILE;
                const LAS unsigned char* vt = vring + (cur * 2 + tt) * KVL_TILE;
                const float pl = (float)(pos - 64 * j - 4 * hh);
                const bool diag = (j == c);
                unsigned selb[2] = {0xffffu, 0xffffu};
                if (dosel) { selb[0] = mbuf[((cur * 2 + qg) * 4 + 2 * tt) * 64 + lane]; selb[1] = mbuf[((cur * 2 + qg) * 4 + 2 * tt + 1) * 64 + lane]; }
                f32x16 sc[2];
#pragma unroll
                for (int kb = 0; kb < 2; ++kb) {
                    f32x16 a;
#pragma unroll
                    for (int i = 0; i < 16; ++i) a[i] = 0.f;
#pragma unroll
                    for (int s = 0; s < 4; ++s) {
                        const bf16x8_t kf = *(const LAS bf16x8_t*)(kt + (32 * kb + r32) * 128 + (((2 * s + hh) ^ (r32 & 7)) * 16));
                        a = MFMA32(kf, qf[s], a);
                    }
                    if (!diag) {
#pragma unroll
                        for (int i = 0; i < 16; ++i) { const float kc = (float)(32 * kb + (i & 3) + 8 * (i >> 2)); a[i] = fmaf(a[i], c1, fmaf(sl2, kc, -sl2 * pl)); }
                    } else {
#pragma unroll
                        for (int i = 0; i < 16; ++i) { const float kc = (float)(32 * kb + (i & 3) + 8 * (i >> 2)); a[i] = fmaf(a[i], c1, -sl2 * fabsf(pl - kc)); }
                    }
#pragma unroll
                    for (int i = 0; i < 16; ++i) a[i] = (selb[kb] & (1u << i)) ? a[i] : -INFINITY;
                    sc[kb] = a;
                }
                float mx = sc[0][0];
#pragma unroll
                for (int i = 1; i < 16; ++i) mx = fmaxf(mx, sc[0][i]);
#pragma unroll
                for (int i = 0; i < 16; ++i) mx = fmaxf(mx, sc[1][i]);
                mx = xmax32(mx);
                const float mnew = fmaxf(mrun, mx);
                const float alpha = __builtin_amdgcn_exp2f(mrun - mnew);
                mrun = mnew;
                float ls4[4] = {0.f, 0.f, 0.f, 0.f};
#pragma unroll
                for (int kb = 0; kb < 2; ++kb)
#pragma unroll
                    for (int i = 0; i < 16; ++i) { const float e = __builtin_amdgcn_exp2f(sc[kb][i] - mnew); sc[kb][i] = e; ls4[i & 3] += e; }
                lrun = lrun * alpha + ((ls4[0] + ls4[1]) + (ls4[2] + ls4[3]));
#pragma unroll
                for (int d = 0; d < 2; ++d)
#pragma unroll
                    for (int i = 0; i < 16; ++i) o[d][i] *= alpha;
#pragma unroll
                for (int ks = 0; ks < 4; ++ks) {
                    const bf16x8_t pf = pack_step(sc[ks >> 1], ks & 1);
#pragma unroll
                    for (int db = 0; db < 2; ++db) o[db] = MFMA32(vt_frag_sw(vt, ks, db, lane), pf, o[db]);
                }
            }
        }
        TE(11, lds, tid);
        TB(10, lds, tid);
        if (more && dosel) D2_MASK(pp + 1, cur ^ 1);
        TE(10, lds, tid);
    }
#undef D2_MASK
    TE(9, lds, tid);
    const float inv = 1.f / xsum32(lrun);
    bf16_t* mrow = p.mix() + (rowb + pos) * DM + 768 + hd * 64;
#pragma unroll
    for (int d = 0; d < 2; ++d)
#pragma unroll
        for (int g = 0; g < 4; ++g) {
            const int d0 = 32 * d + 8 * g + 4 * hh;
            const unsigned long long zz = *(const GAS unsigned long long*)(uintptr_t)(yq + YD_Z + hd * 64 + d0);
            const float z0 = __uint_as_float((unsigned)(zz & 0xffffu) << 16), z1 = __uint_as_float((unsigned)((zz >> 16) & 0xffffu) << 16),
                        z2 = __uint_as_float((unsigned)((zz >> 32) & 0xffffu) << 16), z3 = __uint_as_float((unsigned)((zz >> 48) & 0xffffu) << 16);
            *(GAS unsigned long long*)(uintptr_t)(mrow + d0) = (unsigned long long)cvtpk(o[d][4 * g] * inv * z0, o[d][4 * g + 1] * inv * z1) | ((unsigned long long)cvtpk(o[d][4 * g + 2] * inv * z2, o[d][4 * g + 3] * inv * z3) << 32);
        }
}
__device__ __forceinline__ void ph_mixD(const Params& p, LAS unsigned char* lds, int bid, int nb, int wave_s) {
    for (int i = bid; i < 256; i += nb) {
        const int b = i & 15, cc = i >> 4;
#pragma unroll 1
        for (int k = 0; k < 2; ++k) mixD_unit(p, b, k == 0 ? 31 - cc : cc, lds, wave_s);
    }
}

constexpr int VN_STRIDE = 528;
__device__ __forceinline__ float bflo(unsigned u) { return __uint_as_float(u << 16); }
__device__ __forceinline__ float bfhi(unsigned u) { return __uint_as_float(u & 0xffff0000u); }
__device__ __forceinline__ void mixAB_unit(const Params& p, int l, int b, int n, LAS unsigned char* lds, int tid) {
    const int lane = tid & 63, wave = __builtin_amdgcn_readfirstlane(tid >> 6), r32 = lane & 31, hh = lane >> 5;
    const size_t row0 = (size_t)b * SEQ + 128 * n;
    __syncthreads();
#pragma unroll
    for (int k = 0; k < 8; ++k) {
        const int ch = tid + 512 * k, r = ch >> 5, c16 = ch & 31;
        *(LAS u32x4*)(lds + r * VN_STRIDE + c16 * 16) = *(const GAS u32x4*)(uintptr_t)(p.Y() + (row0 + r) * YP + YB_V + c16 * 8);
    }
    {
        const int cg8 = (tid & 31) * 8, t0 = (tid >> 5) * 8;
        const int pos0 = 128 * n + t0;
        const GAS float* cw = p.sm(SM_CONVW) + l * 768 + cg8;
        float w0[8], w1[8], w2[8], cb[8];
#pragma unroll
        for (int e = 0; e < 8; ++e) { w0[e] = cw[e]; w1[e] = cw[256 + e]; w2[e] = cw[512 + e]; cb[e] = p.sm(SM_CONVB)[l * 256 + cg8 + e]; }
        float um2[8], um1[8];
#pragma unroll
        for (int e = 0; e < 8; ++e) { um2[e] = 0.f; um1[e] = 0.f; }
#pragma unroll
        for (int back = 2; back >= 1; --back) {
            if (pos0 - back >= 0) {
                const bf16_t* yr = p.Y() + (row0 + t0 - back) * YP;
                const u32x4 hc = *(const GAS u32x4*)(uintptr_t)(yr + YA_H + cg8), cc = *(const GAS u32x4*)(uintptr_t)(yr + YA_C + cg8);
                float u[8] = {bflo(hc.x) * bflo(cc.x), bfhi(hc.x) * bfhi(cc.x), bflo(hc.y) * bflo(cc.y), bfhi(hc.y) * bfhi(cc.y),
                              bflo(hc.z) * bflo(cc.z), bfhi(hc.z) * bfhi(cc.z), bflo(hc.w) * bflo(cc.w), bfhi(hc.w) * bfhi(cc.w)};
#pragma unroll
                for (int e = 0; e < 8; ++e) { if (back == 2) um2[e] = u[e]; else um1[e] = u[e]; }
            }
        }
#pragma unroll
        for (int tt = 0; tt < 8; ++tt) {
            const bf16_t* yr = p.Y() + (row0 + t0 + tt) * YP;
            const u32x4 hc = *(const GAS u32x4*)(uintptr_t)(yr + YA_H + cg8), cc = *(const GAS u32x4*)(uintptr_t)(yr + YA_C + cg8), bg = *(const GAS u32x4*)(uintptr_t)(yr + YA_B + cg8), zg = *(const GAS u32x4*)(uintptr_t)(yr + YA_Z + cg8);
            const float u[8] = {bflo(hc.x) * bflo(cc.x), bfhi(hc.x) * bfhi(cc.x), bflo(hc.y) * bflo(cc.y), bfhi(hc.y) * bfhi(cc.y),
                                bflo(hc.z) * bflo(cc.z), bfhi(hc.z) * bfhi(cc.z), bflo(hc.w) * bflo(cc.w), bfhi(hc.w) * bfhi(cc.w)};
            const float bgv[8] = {bflo(bg.x), bfhi(bg.x), bflo(bg.y), bfhi(bg.y), bflo(bg.z), bfhi(bg.z), bflo(bg.w), bfhi(bg.w)};
            const float zgv[8] = {bflo(zg.x), bfhi(zg.x), bflo(zg.y), bfhi(zg.y), bflo(zg.z), bfhi(zg.z), bflo(zg.w), bfhi(zg.w)};
            float ov[8];
#pragma unroll
            for (int e = 0; e < 8; ++e) {
                const float conv = w0[e] * um2[e] + w1[e] * um1[e] + w2[e] * u[e];
                ov[e] = bgv[e] * (conv + cb[e]) * zgv[e];
                um2[e] = um1[e]; um1[e] = u[e];
            }
            u32x4 ow; ow.x = cvtpk(ov[0], ov[1]); ow.y = cvtpk(ov[2], ov[3]); ow.z = cvtpk(ov[4], ov[5]); ow.w = cvtpk(ov[6], ov[7]);
            *(GAS u32x4*)(uintptr_t)(p.mix() + (row0 + t0 + tt) * DM + cg8) = ow;
        }
    }
    __syncthreads();
    {
        const int h = wave >> 1, th = wave & 1;
        const int nks = th == 0 ? 4 : 8;
        f32x16 acc[2][2];
#pragma unroll
        for (int a = 0; a < 2; ++a)
#pragma unroll
            for (int d = 0; d < 2; ++d)
#pragma unroll
                for (int i = 0; i < 16; ++i) acc[a][d][i] = 0.f;
        const bf16_t* wb = p.wsb() + ((size_t)(l * 4 + h) * 128 + 64 * th + r32) * 128 + 8 * hh;
        const int i16 = lane & 15, q = i16 >> 2, pp = i16 & 3, blk = (lane >> 4) & 1;
        const LAS unsigned char* va = lds + (8 * hh + q) * VN_STRIDE + (h * 64 + 16 * blk + 4 * pp) * 2;
        for (int ks = 0; ks < nks; ++ks) {
            bf16x8_t bfr[2], afr[2];
#pragma unroll
            for (int tb = 0; tb < 2; ++tb) bfr[tb] = *(const GAS bf16x8_t*)(uintptr_t)(wb + (size_t)(32 * tb) * 128 + 16 * ks);
#pragma unroll
            for (int db = 0; db < 2; ++db) {
                const LAS unsigned char* a = va + (16 * ks) * VN_STRIDE + (32 * db) * 2;
                const s16x4_t lo = ds_tr16(a), hi = ds_tr16(a + 4 * VN_STRIDE);
                afr[db] = __builtin_shufflevector(lo, hi, 0, 1, 2, 3, 4, 5, 6, 7);
            }
#pragma unroll
            for (int tb = 0; tb < 2; ++tb)
#pragma unroll
                for (int db = 0; db < 2; ++db) acc[tb][db] = MFMA32(afr[db], bfr[tb], acc[tb][db]);
        }
#pragma unroll
        for (int tb = 0; tb < 2; ++tb) {
            const int t = 64 * th + 32 * tb + r32;
            const float bias = p.sm(SM_GMLPB)[(l * 4 + h) * 128 + t];
            const bf16_t* yr = p.Y() + (row0 + t) * YP;
            bf16_t* mr = p.mix() + (row0 + t) * DM + 256 + h * 64;
#pragma unroll
            for (int db = 0; db < 2; ++db)
#pragma unroll
                for (int g = 0; g < 4; ++g) {
                    const int d0 = 32 * db + 8 * g + 4 * hh;
                    const unsigned long long uu = *(const GAS unsigned long long*)(uintptr_t)(yr + YB_U + h * 64 + d0), zz = *(const GAS unsigned long long*)(uintptr_t)(yr + YB_Z + h * 64 + d0);
                    const unsigned u01 = (unsigned)uu, u23 = (unsigned)(uu >> 32), z01 = (unsigned)zz, z23 = (unsigned)(zz >> 32);
                    const float v0 = bflo(u01) * (acc[tb][db][4 * g] + bias) * bflo(z01), v1 = bfhi(u01) * (acc[tb][db][4 * g + 1] + bias) * bfhi(z01);
                    const float v2 = bflo(u23) * (acc[tb][db][4 * g + 2] + bias) * bflo(z23), v3 = bfhi(u23) * (acc[tb][db][4 * g + 3] + bias) * bfhi(z23);
                    *(GAS unsigned long long*)(uintptr_t)(mr + d0) = (unsigned long long)cvtpk(v0, v1) | ((unsigned long long)cvtpk(v2, v3) << 32);
                }
        }
    }
}
__device__ __forceinline__ void ph_mixAB(const Params& p, int l, LAS unsigned char* lds, int bid, int nb, int tid_in) {
    int tid = tid_in; asm volatile("" : "+v"(tid));
    for (int i = bid; i < 256; i += nb) mixAB_unit(p, l, i >> 4, i & 15, lds, tid);
}

constexpr int IX_STRIDE = 528;
__device__ __forceinline__ void ph_ikiw(const Params& p, int l, LAS unsigned char* lds, int bid, int nb, int wave_s) {
    const int tid = tid_now(wave_s);
    const int lane = tid & 63, wave = __builtin_amdgcn_readfirstlane(tid >> 6), r32 = lane & 31, hh = lane >> 5;
    const int tb = wave & 3, cb = wave >> 2;
    LAS unsigned char* xs = lds;
    LAS unsigned char* ws = lds + 128 * IX_STRIDE;
    const bf16_t* wbase = p.wt_in() + (size_t)l * YP * DM;
    __syncthreads();
    { unsigned z = 0u; asm volatile("" : "+v"(z));
      for (int i = tid; i < 28 * (IX_STRIDE / 16); i += NT) *(LAS u32x4*)(ws + 36 * IX_STRIDE + i * 16) = (u32x4){z, z, z, z}; }
    for (int blk = bid; blk < NTOK / 128; blk += nb) {
        f32x16 acc;
#pragma unroll
        for (int i = 0; i < 16; ++i) acc[i] = 0.f;
#pragma unroll 1
        for (int k0 = 0; k0 < DM; k0 += 256) {
            u32x4 xv[8], wv[3];
#pragma unroll
            for (int i = 0; i < 8; ++i) { const int idx = tid + NT * i; xv[i] = *(const GAS u32x4*)(uintptr_t)(p.xb() + (size_t)(128 * blk + (idx >> 5)) * DM + k0 + 8 * (idx & 31)); }
#pragma unroll
            for (int i = 0; i < 3; ++i) {
                const int idx = tid + NT * i, n = idx >> 5;
                if (idx < 36 * 32) wv[i] = *(const GAS u32x4*)(uintptr_t)(wbase + (size_t)(n < 32 ? 3584 + n : 3712 + (n - 32)) * DM + k0 + 8 * (idx & 31));
            }
            __syncthreads();
#pragma unroll
            for (int i = 0; i < 8; ++i) { const int idx = tid + NT * i; *(LAS u32x4*)(xs + (idx >> 5) * IX_STRIDE + (idx & 31) * 16) = xv[i]; }
#pragma unroll
            for (int i = 0; i < 3; ++i) { const int idx = tid + NT * i; if (idx < 36 * 32) *(LAS u32x4*)(ws + (idx >> 5) * IX_STRIDE + (idx & 31) * 16) = wv[i]; }
            __syncthreads();
#pragma unroll
            for (int s = 0; s < 16; ++s) {
                const bf16x8_t a = *(const LAS bf16x8_t*)(ws + (32 * cb + r32) * IX_STRIDE + (16 * s + 8 * hh) * 2);
                const bf16x8_t b = *(const LAS bf16x8_t*)(xs + (32 * tb + r32) * IX_STRIDE + (16 * s + 8 * hh) * 2);
                acc = MFMA32(a, b, acc);
            }
        }
        const int tok = 128 * blk + 32 * tb + r32;
        const GAS f32x4* sp = (const GAS f32x4*)(uintptr_t)(p.ssq() + (size_t)tok * 16);
        const f32x4 s0 = sp[0], s1 = sp[1], s2 = sp[2], s3 = sp[3];
        const float tot = ((s0.x + s0.y) + (s0.z + s0.w)) + ((s1.x + s1.y) + (s1.z + s1.w)) + ((s2.x + s2.y) + (s2.z + s2.w)) + ((s3.x + s3.y) + (s3.z + s3.w));
        const float rstd = rsqrtf(tot * (1.f / DM) + EPS);
        bf16_t* yr = p.Y() + (size_t)tok * YP + YI_K + 32 * cb;
#pragma unroll
        for (int g = 0; g < 4; ++g) {
            const int c0 = 8 * g + 4 * hh;
            if (32 * cb + c0 < 36)
                *(GAS unsigned long long*)(uintptr_t)(yr + c0) = (unsigned long long)cvtpk(acc[4 * g] * rstd, acc[4 * g + 1] * rstd) | ((unsigned long long)cvtpk(acc[4 * g + 2] * rstd, acc[4 * g + 3] * rstd) << 32);
        }
    }
    __syncthreads();
}

__global__ void __launch_bounds__(NT, 2) k_fwd(Params p) {
    extern __shared__ __attribute__((aligned(16))) unsigned char lds[];
    cg::grid_group grid = cg::this_grid();
    LAS unsigned char* l3 = (LAS unsigned char*)lds;
    const int wave_s = __builtin_amdgcn_readfirstlane((int)threadIdx.x >> 6);
    volatile LAS unsigned* bst = (volatile LAS unsigned*)(l3 + LDS_BYTES - 16);
    if (threadIdx.x < 2) bst[threadIdx.x] = 0u;
    __syncthreads();
    const XcdBarrier bar = xcd_barrier_post(p.ctl(), bst);
    if (TSEG >= 0 && threadIdx.x == 0) *(volatile LAS unsigned*)(l3 + TCTR_OFF) = 0u;
    { TB(16, l3, tid_now(wave_s)); ph_prologue(p, l3, tid_now(wave_s)); TE(16, l3, tid_now(wave_s)); }
    if (p.ws == nullptr) grid.sync();
    { TB(18, l3, tid_now(wave_s)); xcd_barrier(bar, tid_now(wave_s)); TE(18, l3, tid_now(wave_s)); }
#pragma unroll 1
    for (int l = 0; l < DEPTH; ++l) {
        Params q = p; asm volatile("" : "+s"(q.ws), "+s"(q.out));
        int bid = blockIdx.x, nb = gridDim.x; asm volatile("" : "+s"(bid), "+s"(nb));
        {
            pg8::Gemm g{q.xb(), q.wt_in() + (size_t)l * YP * DM, NTOK, NGEMM, DM};
            pg8::StaticOrder S; S.init(NTOK, NGEMM, nb, bid);
            EpiIn E{q.ws, l, (LAS float*)(l3 + 131072 + 1024)};
            { TB(13, l3, tid_now(wave_s)); pg8::gemm_phase<EpiIn, pg8::StaticOrder, true, true>(l3, g, S, E, tid_now(wave_s)); TE(13, l3, tid_now(wave_s)); }
        }
        { TB(21, l3, tid_now(wave_s)); ph_ikiw(q, l, l3, bid, nb, wave_s); TE(21, l3, tid_now(wave_s)); }
        { TB(18, l3, tid_now(wave_s)); xcd_barrier(bar, tid_now(wave_s)); TE(18, l3, tid_now(wave_s)); }
        asm volatile("" : "+s"(q.ws), "+s"(bid), "+s"(nb));
        { TB(17, l3, tid_now(wave_s)); ph_mixAB(q, l, l3, bid, nb, tid_now(wave_s)); TE(17, l3, tid_now(wave_s)); }
        __syncthreads();
        { TB(1, l3, tid_now(wave_s)); ph_mixC(q, l, l3, bid, nb, wave_s); TE(1, l3, tid_now(wave_s)); }
        __syncthreads();
        { TB(19, l3, tid_now(wave_s)); ph_mixD(q, l3, bid, nb, wave_s); TE(19, l3, tid_now(wave_s)); }
        __syncthreads();
        { TB(18, l3, tid_now(wave_s)); xcd_barrier(bar, tid_now(wave_s)); TE(18, l3, tid_now(wave_s)); }
        asm volatile("" : "+s"(q.ws), "+s"(q.out), "+s"(bid), "+s"(nb));
        {
            pg8::Gemm g{q.mix(), q.wt_out() + (size_t)l * DM * DM, NTOK, DM, DM};
            pg8::StaticOrder S; S.init(NTOK, DM, nb, bid);
            EpiOut E{l == DEPTH - 1 ? q.out : nullptr, q.ws};
            { TB(15, l3, tid_now(wave_s)); pg8::gemm_phase<EpiOut, pg8::StaticOrder, true, true>(l3, g, S, E, tid_now(wave_s)); TE(15, l3, tid_now(wave_s)); }
        }
        { TB(18, l3, tid_now(wave_s)); xcd_barrier(bar, tid_now(wave_s)); TE(18, l3, tid_now(wave_s)); }
    }
    if (TSEG >= 0 && blockIdx.x == 0 && threadIdx.x == 0) {
        const unsigned long long ticks = 8ull * *(volatile LAS unsigned*)(l3 + TCTR_OFF), t0 = __builtin_amdgcn_s_memrealtime();
        while (__builtin_amdgcn_s_memrealtime() - t0 < ticks) __builtin_amdgcn_s_sleep(32);
    }
}

extern "C" void kernel_launch(void* const* d_in, const int* in_sizes, int n_in, void* d_out, int out_size, void* d_ws, size_t ws_size,
                              hipStream_t stream) {
    static int grid_blocks = 0;
    if (!grid_blocks) {
        int dev = 0, cus = 0, per_cu = 0;
        (void)hipGetDevice(&dev);
        (void)hipDeviceGetAttribute(&cus, hipDeviceAttributeMultiprocessorCount, dev);
        (void)hipFuncSetAttribute((const void*)k_fwd, hipFuncAttributeMaxDynamicSharedMemorySize, LDS_BYTES);
        (void)hipOccupancyMaxActiveBlocksPerMultiprocessor(&per_cu, (const void*)k_fwd, NT, LDS_BYTES);
        if (per_cu < 1) { fprintf(stderr, "kernel_launch: occupancy query returned %d\n", per_cu); per_cu = 1; }
        if (per_cu > 1) per_cu = 1;
        grid_blocks = cus * per_cu;
        if (ws_size < WS_END) fprintf(stderr, "kernel_launch: workspace too small (%zu < %zu)\n", ws_size, (size_t)WS_END);
    }
    (void)hipMemsetAsync(d_ws, 0, 16384, stream);
    Params p{};
    p.x = (const float*)d_in[0]; p.norm_g = (const float*)d_in[1]; p.w_in = (const float*)d_in[2]; p.i_conv_w = (const float*)d_in[3];
    p.i_conv_b = (const float*)d_in[4]; p.i_gmlp_g = (const float*)d_in[5]; p.gmlp_ws = (const float*)d_in[6]; p.i_gmlp_b = (const float*)d_in[7];
    p.i_diff_qg = (const float*)d_in[8]; p.i_diff_kg = (const float*)d_in[9]; p.i_diff_lam = (const float*)d_in[10]; p.i_diff_subg = (const float*)d_in[11];
    p.i_dsa_qg = (const float*)d_in[12]; p.i_dsa_kg = (const float*)d_in[13]; p.w_out = (const float*)d_in[14];
    p.out = (float*)d_out; p.ws = (unsigned char*)d_ws;
    void* args[] = {&p};
    hipError_t e = hipLaunchCooperativeKernel((void*)k_fwd, dim3(grid_blocks), dim3(NT), args, LDS_BYTES, stream);
    if (e != hipSuccess) fprintf(stderr, "cooperative launch failed: %s (grid %d)\n", hipGetErrorString(e), grid_blocks);
}
```

```cpp
#include <hip/hip_runtime.h>
#include <hip/hip_cooperative_groups.h>
#include <math.h>
#include <stdint.h>
#include <stdio.h>
namespace cg = cooperative_groups;
namespace pg8 {
#define PG8_LAS __attribute__((address_space(3)))
typedef unsigned short bf16_t;
typedef short bf16x8 __attribute__((ext_vector_type(8)));
typedef float f32x4 __attribute__((ext_vector_type(4)));
typedef unsigned u32x4 __attribute__((ext_vector_type(4)));
constexpr int BM = 256, BK = 64, HALF = 128, HTB = HALF * BK * 2  , STAGE_BYTES = 8 * HTB, NXCD = 8, WGM = 8;

__host__ __device__ __forceinline__ int lds_byte(int r, int c) { const int st = (r >> 4) * 2 + (c >> 5), rr = r & 15, cc = c & 31, ob = rr * 64 + cc * 2; return st * 1024 + (ob ^ (((ob >> 9) & 1) << 5)); }
__host__ __device__ __forceinline__ void stage_rc(int b, int& R, int& C) { const int st = b / 1024, sb = b % 1024, swz = sb ^ (((sb >> 9) & 1) << 5); R = (st >> 1) * 16 + swz / 64; C = (st & 1) * 32 + (swz % 64) / 2; }
__host__ __device__ __forceinline__ int perm32(int rho) { const int n = rho >> 4, i = rho & 15; return 8 * (i >> 2) + 4 * n + (i & 3); }

struct Unit { int pm, pn; };
struct Gemm { const bf16_t* A; const bf16_t* Bt; int M, N, K; };

struct StaticOrder {
    int nM, nN, nwg, G, c;
    __host__ __device__ void init(int M, int N, int G_, int c_) { nM = M / BM; nN = N / BM; nwg = nM * nN; G = G_; c = c_; }
    __host__ __device__ bool next(int i, Unit& u) const {
        const long L = (long)i * G + c; if (L >= nwg) return false;
        int wgid = (int)L; { const int q = nwg / NXCD, r = nwg % NXCD, xcd = wgid % NXCD, off = wgid / NXCD; wgid = (xcd < r ? xcd * (q + 1) : r * (q + 1) + (xcd - r) * q) + off; }
        const int nig = WGM * nN, gid = wgid / nig, fm = gid * WGM, gsz = (nM - fm) < WGM ? (nM - fm) : WGM;
        u.pm = fm + ((wgid % nig) % gsz); u.pn = (wgid % nig) / gsz; return true;
    }
    __device__ __forceinline__ void a_ready(const Unit&) const {}
    __device__ __forceinline__ void done(const Unit&) const {}
};

__device__ __forceinline__ unsigned cvt_pk_bf16(float lo, float hi) { unsigned r; asm volatile("v_cvt_pk_bf16_f32 %0, %1, %2" : "=v"(r) : "v"(lo), "v"(hi)); return r; }
typedef float f32x2 __attribute__((ext_vector_type(2)));
__device__ __forceinline__ f32x2 gelu_pk(f32x2 v) {
    const f32x2 av = __builtin_elementwise_abs(v), d = av * 0.2316418882f + 1.0f;
    f32x2 t; t.x = __builtin_amdgcn_rcpf(d.x); t.y = __builtin_amdgcn_rcpf(d.y);
    f32x2 q = t * 0.5307027145f + (-0.7265760135f); q = q * t + 0.7107068705f; q = q * t + (-0.142248368f); q = q * t + 0.127414796f; q = q * t;
    const f32x2 s = (v * v) * (-0.72134752044f);
    f32x2 e; e.x = __builtin_amdgcn_exp2f(s.x); e.y = __builtin_amdgcn_exp2f(s.y);
    const f32x2 m = v * (q * e), r = v - m;
    f32x2 o; o.x = v.x < 0.f ? m.x : r.x; o.y = v.y < 0.f ? m.y : r.y; return o;
}
template <class Epi, class Sched, bool ALIGN_EPI = false, bool SP2 = false>
__device__ __forceinline__ void gemm_phase(PG8_LAS unsigned char* lds, const Gemm g, const Sched& S, const Epi& E, int tid_in) {
    int tid_ = tid_in; asm volatile("" : "+v"(tid_));
    const int tid = tid_, wid = __builtin_amdgcn_readfirstlane(tid >> 6), lane = tid & 63, wr = wid >> 2, wc = wid & 3, fr = lane & 15, fq = lane >> 4;
    const int K = g.K, nt = K / BK;
    unsigned voffA[2], voffB[2];
#pragma unroll
    for (int i = 0; i < 2; ++i) { int R, C; stage_rc(tid * 16 + i * 8192, R, C); const int Rb = Epi::PERM ? ((R & ~31) + perm32(R & 31)) : R;
        voffA[i] = (unsigned)(R * K + C) * 2u; voffB[i] = (unsigned)(Rb * K + C) * 2u; }
    const size_t kstep = (size_t)(BK * 2);
    const size_t hstep = (size_t)HALF * K * 2;
    const size_t tstep = 2 * hstep;
    const unsigned ldsw = (unsigned)wid * 1024u;
    const int aoff = lds_byte(wr * 64 + fr, fq * 8), boff = lds_byte(wc * 32 + fr, fq * 8);
#define PG8_SA(b, h) (((b) * 2 + (h)) * HTB)
#define PG8_SB(b, h) ((4 + (b) * 2 + (h)) * HTB)
#define PG8_STAGE(bufoff, gbase, voff) do { _Pragma("unroll") for (int _i = 0; _i < 2; ++_i) \
        __builtin_amdgcn_global_load_lds((const unsigned*)((const char*)(gbase) + (voff)[_i]), (PG8_LAS unsigned*)(lds + (bufoff) + ldsw + _i * 8192), 16, 0, 0); } while (0)
#define PG8_LDA(dst, b, h) do { _Pragma("unroll") for (int m = 0; m < 4; ++m) _Pragma("unroll") for (int k = 0; k < 2; ++k) dst[m][k] = *(const PG8_LAS bf16x8*)(lds + PG8_SA(b, h) + aoff + m * 2048 + k * 1024); } while (0)
#define PG8_LDB(dst, b, h) do { _Pragma("unroll") for (int n = 0; n < 2; ++n) _Pragma("unroll") for (int k = 0; k < 2; ++k) dst[n][k] = *(const PG8_LAS bf16x8*)(lds + PG8_SB(b, h) + boff + n * 2048 + k * 1024); } while (0)
#define PG8_MMA(ai, bj, At, Bt) do { __builtin_amdgcn_s_setprio(1); _Pragma("unroll") for (int m = 0; m < 4; ++m) _Pragma("unroll") for (int n = 0; n < 2; ++n) _Pragma("unroll") for (int k = 0; k < 2; ++k) \
        acc[ai][bj][m][n] = __builtin_amdgcn_mfma_f32_16x16x32_bf16(Bt[n][k], At[m][k], acc[ai][bj][m][n], 0, 0, 0); __builtin_amdgcn_s_setprio(0); } while (0)
#define PG8_WAIT_V(n) asm volatile("s_waitcnt vmcnt(" #n ")" ::: "memory")
#define PG8_WAIT_L(n) asm volatile("s_waitcnt lgkmcnt(" #n ")" ::: "memory")
#define PG8_BAR __builtin_amdgcn_s_barrier()
#define PG8_SCHED __builtin_amdgcn_sched_barrier(0)
    Unit cur, nxt; int ui = 0;
    if (!S.next(0, cur)) return;
    f32x4 acc[2][2][4][2];
#pragma unroll
    for (int a = 0; a < 2; ++a)
#pragma unroll
        for (int b = 0; b < 2; ++b)
#pragma unroll
            for (int m = 0; m < 4; ++m)
#pragma unroll
                for (int n = 0; n < 2; ++n) acc[a][b][m][n] = (f32x4){0.f, 0.f, 0.f, 0.f};
    bf16x8 At[4][2], B0[2][2], B1[2][2];
    const char* cA = (const char*)g.A + (size_t)cur.pm * tstep; const char* cB = (const char*)g.Bt + (size_t)cur.pn * tstep;
    S.a_ready(cur);
    if constexpr (SP2) {
        PG8_STAGE(PG8_SB(0, 0), cB, voffB); PG8_STAGE(PG8_SB(0, 1), cB + hstep, voffB); PG8_STAGE(PG8_SA(0, 0), cA, voffA); PG8_STAGE(PG8_SA(0, 1), cA + hstep, voffA);
        if (wr == 1) PG8_BAR;
        PG8_WAIT_V(2); PG8_BAR;
        PG8_STAGE(PG8_SB(1, 0), cB + kstep, voffB); PG8_STAGE(PG8_SA(1, 0), cA + kstep, voffA); PG8_STAGE(PG8_SB(1, 1), cB + hstep + kstep, voffB);
        PG8_WAIT_V(6); PG8_BAR;
    } else {
        PG8_STAGE(PG8_SB(0, 0), cB, voffB); PG8_STAGE(PG8_SA(0, 0), cA, voffA); PG8_STAGE(PG8_SB(0, 1), cB + hstep, voffB); PG8_STAGE(PG8_SA(0, 1), cA + hstep, voffA);
        if (wr == 1) PG8_BAR;
        PG8_WAIT_V(4); PG8_BAR;
        PG8_STAGE(PG8_SB(1, 0), cB + kstep, voffB); PG8_STAGE(PG8_SA(1, 0), cA + kstep, voffA); PG8_STAGE(PG8_SB(1, 1), cB + hstep + kstep, voffB);
        PG8_WAIT_V(6); PG8_BAR;
    }
    for (;;) {
        const bool has_next = S.next(ui + 1, nxt);
        const char* nA = has_next ? (const char*)g.A + (size_t)nxt.pm * tstep : cA; const char* nB = has_next ? (const char*)g.Bt + (size_t)nxt.pn * tstep : cB;
        for (int t = 0; t < nt; t += 2) {
            const bool last = (t == nt - 2);
            const char* a1 = cA + (size_t)(t + 1) * kstep;
            const char* a2 = last ? nA : cA + (size_t)(t + 2) * kstep; const char* b2 = last ? nB : cB + (size_t)(t + 2) * kstep;
            const char* a3 = a2 + kstep; const char* b3 = b2 + kstep;
            if (last && has_next) S.a_ready(nxt);
            if constexpr (SP2) {
            PG8_LDB(B0, 0, 0); PG8_LDB(B1, 0, 1); PG8_SCHED; PG8_LDA(At, 0, 0); PG8_STAGE(PG8_SA(1, 1), a1 + hstep, voffA);
            PG8_WAIT_V(8); PG8_WAIT_L(0); PG8_BAR; PG8_MMA(0, 0, At, B0); PG8_MMA(0, 1, At, B1); PG8_BAR; PG8_SCHED;
            PG8_LDA(At, 0, 1); PG8_STAGE(PG8_SB(0, 0), b2, voffB); PG8_STAGE(PG8_SB(0, 1), b2 + hstep, voffB); PG8_STAGE(PG8_SA(0, 0), a2, voffA);
            PG8_WAIT_V(8); PG8_WAIT_L(0); PG8_BAR; PG8_MMA(1, 0, At, B0); PG8_MMA(1, 1, At, B1); PG8_BAR; PG8_SCHED;
            PG8_LDB(B0, 1, 0); PG8_LDB(B1, 1, 1); PG8_SCHED; PG8_LDA(At, 1, 0); PG8_STAGE(PG8_SA(0, 1), a2 + hstep, voffA);
            PG8_WAIT_V(8); PG8_WAIT_L(0); PG8_BAR; PG8_MMA(0, 0, At, B0); PG8_MMA(0, 1, At, B1); PG8_BAR; PG8_SCHED;
            PG8_LDA(At, 1, 1); PG8_STAGE(PG8_SB(1, 0), b3, voffB); PG8_STAGE(PG8_SB(1, 1), b3 + hstep, voffB); PG8_STAGE(PG8_SA(1, 0), a3, voffA);
            PG8_WAIT_V(8); PG8_WAIT_L(0); PG8_BAR; PG8_MMA(1, 0, At, B0); PG8_MMA(1, 1, At, B1); PG8_BAR; PG8_SCHED;
            } else {
            PG8_LDB(B0, 0, 0); PG8_SCHED; PG8_LDA(At, 0, 0); PG8_STAGE(PG8_SA(1, 1), a1 + hstep, voffA);
            PG8_WAIT_L(8); PG8_BAR; PG8_WAIT_L(0); PG8_MMA(0, 0, At, B0); PG8_BAR; PG8_SCHED;
            PG8_LDB(B1, 0, 1); PG8_STAGE(PG8_SB(0, 0), b2, voffB);
            PG8_BAR; PG8_WAIT_L(0); PG8_MMA(0, 1, At, B1); PG8_BAR;
            PG8_LDA(At, 0, 1); PG8_STAGE(PG8_SA(0, 0), a2, voffA);
            PG8_BAR; PG8_WAIT_L(0); PG8_MMA(1, 0, At, B0); PG8_BAR; PG8_SCHED;
            PG8_STAGE(PG8_SB(0, 1), b2 + hstep, voffB);
            PG8_WAIT_V(6); PG8_BAR; PG8_MMA(1, 1, At, B1); PG8_BAR;
            PG8_LDB(B0, 1, 0); PG8_SCHED; PG8_LDA(At, 1, 0); PG8_STAGE(PG8_SA(0, 1), a2 + hstep, voffA);
            PG8_WAIT_L(8); PG8_BAR; PG8_WAIT_L(0); PG8_MMA(0, 0, At, B0); PG8_BAR; PG8_SCHED;
            PG8_LDB(B1, 1, 1); PG8_STAGE(PG8_SB(1, 0), b3, voffB);
            PG8_BAR; PG8_WAIT_L(0); PG8_MMA(0, 1, At, B1); PG8_BAR;
            PG8_LDA(At, 1, 1); PG8_STAGE(PG8_SA(1, 0), a3, voffA);
            PG8_BAR; PG8_WAIT_L(0); PG8_MMA(1, 0, At, B0); PG8_BAR; PG8_SCHED;
            PG8_STAGE(PG8_SB(1, 1), b3 + hstep, voffB);
            PG8_WAIT_V(6); PG8_BAR; PG8_MMA(1, 1, At, B1); PG8_BAR;
            }
        }
        if constexpr (ALIGN_EPI) { if (wr == 0) PG8_BAR; }
        if constexpr (!Epi::AFTER_DRAIN) { E(acc, cur, wr, wc, fr, fq); S.done(cur); }
        if (!has_next) break;
#pragma unroll
        for (int a = 0; a < 2; ++a)
#pragma unroll
            for (int b = 0; b < 2; ++b)
#pragma unroll
                for (int m = 0; m < 4; ++m)
#pragma unroll
                    for (int n = 0; n < 2; ++n) acc[a][b][m][n] = (f32x4){0.f, 0.f, 0.f, 0.f};
        cur = nxt; cA = nA; cB = nB; ++ui;
        if constexpr (ALIGN_EPI) { if (wr == 1) PG8_BAR; }
    }
    PG8_WAIT_V(0);
    if constexpr (!ALIGN_EPI) { if (wr == 0) PG8_BAR; }
    PG8_BAR;
    if constexpr (Epi::AFTER_DRAIN) { E.fused(acc, cur, wr, wc, fr, fq, lds, wid, lane); S.done(cur); }
#undef PG8_SA
#undef PG8_SB
#undef PG8_STAGE
#undef PG8_LDA
#undef PG8_LDB
#undef PG8_MMA
#undef PG8_WAIT_V
#undef PG8_WAIT_L
#undef PG8_BAR
#undef PG8_SCHED
}
}

using pg8::bf16_t; using pg8::f32x4; using pg8::u32x4; using pg8::Unit;
#define LAS __attribute__((address_space(3)))
#define GAS __attribute__((address_space(1)))

constexpr int DM = 1024, SEQ = 2048, BATCH = 16, DEPTH = 4, NIN = 3620, NTOK = BATCH * SEQ, YP = 3840;
constexpr float EPS = 1e-6f;
constexpr int O_DZ = 3200, O_DK = 3072, O_DV = 3136;
constexpr int YA_H = 0, YA_B = 256, YA_C = 512, YA_Z = 768, YB_U = 1024, YB_V = 1280, YB_Z = 1536, YC_Q = 1792, YC_K = 2048, YC_V = 2304,
              YC_Z = 2560, YD_Q = 2816, YD_Z = 3072, YD_K = 3328, YD_V = 3392, YI_Q = 3456, YI_K = 3584, YI_W = 3616;
constexpr int TOPK = 256;
constexpr int NGEMM = 3584;
constexpr int NT = 512, NW = 8;
constexpr int LDS_BYTES = 131072 + 4096;

constexpr size_t MiB = 1u << 20;
constexpr size_t WS_WTIN = 1 * MiB;
constexpr size_t WS_WTOUT = WS_WTIN + (size_t)DEPTH * YP * DM * 2;
constexpr size_t WS_SSQ = WS_WTOUT + (size_t)DEPTH * DM * DM * 2;
constexpr size_t WS_XB = WS_SSQ + (size_t)NTOK * 16 * 4;
constexpr size_t WS_Y = WS_XB + (size_t)NTOK * DM * 2;
constexpr size_t WS_MIX = WS_Y + (size_t)NTOK * YP * 2;
constexpr size_t WS_WSB = WS_MIX + (size_t)NTOK * DM * 2;
constexpr size_t WS_END = WS_WSB + (size_t)DEPTH * 4 * 128 * 128 * 2;

constexpr size_t WS_SMALL = 65536;
constexpr int SM_CONVW = 0, SM_CONVB = 3072, SM_GMLPG = 4096, SM_GMLPB = 5120, SM_QG = 7168, SM_KG = 7296, SM_LAM = 7424, SM_SUBG = 7936, SM_DQG = 8960, SM_DKG = 9216, SM_END = 9472;
struct Params {
    const float* x; const float* norm_g; const float* w_in; const float* i_conv_w; const float* i_conv_b;
    const float* i_gmlp_g; const float* gmlp_ws; const float* i_gmlp_b; const float* i_diff_qg; const float* i_diff_kg;
    const float* i_diff_lam; const float* i_diff_subg; const float* i_dsa_qg; const float* i_dsa_kg; const float* w_out;
    float* out; unsigned char* ws;
    __device__ __forceinline__ unsigned* ctl() const { return (unsigned*)ws; }
    __device__ __forceinline__ const GAS float* sm(int off) const { return (const GAS float*)(uintptr_t)(ws + WS_SMALL) + off; }
    __device__ __forceinline__ bf16_t* wt_in() const { return (bf16_t*)(ws + WS_WTIN); }
    __device__ __forceinline__ bf16_t* wt_out() const { return (bf16_t*)(ws + WS_WTOUT); }
    __device__ __forceinline__ float* ssq() const { return (float*)(ws + WS_SSQ); }
    __device__ __forceinline__ bf16_t* xb() const { return (bf16_t*)(ws + WS_XB); }
    __device__ __forceinline__ bf16_t* Y() const { return (bf16_t*)(ws + WS_Y); }
    __device__ __forceinline__ bf16_t* mix() const { return (bf16_t*)(ws + WS_MIX); }
    __device__ __forceinline__ bf16_t* wsb() const { return (bf16_t*)(ws + WS_WSB); }
};

#ifndef TSEG
#define TSEG -1
#endif
constexpr int TCTR_OFF = 131072 + 3072;
#define TB(id, ldsbase, tidv) do { if (TSEG == (id) && blockIdx.x == 0 && (tidv) == 0) *(volatile LAS unsigned long long*)((ldsbase) + TCTR_OFF + 8) = __builtin_amdgcn_s_memrealtime(); } while (0)
#define TE(id, ldsbase, tidv) do { if (TSEG == (id) && blockIdx.x == 0 && (tidv) == 0) { const unsigned _d = (unsigned)(__builtin_amdgcn_s_memrealtime() - *(volatile LAS unsigned long long*)((ldsbase) + TCTR_OFF + 8)); *(volatile LAS unsigned*)((ldsbase) + TCTR_OFF) += _d; } } while (0)
__device__ __forceinline__ unsigned f2bf(float f) { unsigned u = __float_as_uint(f); return (u + 0x7fffu + ((u >> 16) & 1u)) >> 16; }
__device__ __forceinline__ unsigned pk2(float lo, float hi) { return f2bf(lo) | (f2bf(hi) << 16); }
__device__ __forceinline__ float bf2f(bf16_t b) { return __uint_as_float((unsigned)b << 16); }

__device__ __forceinline__ float xsum32(float v) { const auto r = __builtin_amdgcn_permlane32_swap(__float_as_uint(v), __float_as_uint(v), false, false); return __uint_as_float(r[0]) + __uint_as_float(r[1]); }
__device__ __forceinline__ float xmax32(float v) { const auto r = __builtin_amdgcn_permlane32_swap(__float_as_uint(v), __float_as_uint(v), false, false); return fmaxf(__uint_as_float(r[0]), __uint_as_float(r[1])); }
__device__ __forceinline__ int xsum32i(int v) { const auto r = __builtin_amdgcn_permlane32_swap((unsigned)v, (unsigned)v, false, false); return (int)(r[0] + r[1]); }
__device__ __forceinline__ float xsum16(float v) { const auto r = __builtin_amdgcn_permlane16_swap(__float_as_uint(v), __float_as_uint(v), false, false); return __uint_as_float(r[0]) + __uint_as_float(r[1]); }
__device__ __forceinline__ float wave_sum64(float v) {
    v += __uint_as_float(__builtin_amdgcn_update_dpp(0, __float_as_uint(v), 0x128, 0xf, 0xf, true));
    v += __uint_as_float(__builtin_amdgcn_update_dpp(0, __float_as_uint(v), 0x124, 0xf, 0xf, true));
    v += __uint_as_float(__builtin_amdgcn_update_dpp(0, __float_as_uint(v), 0x122, 0xf, 0xf, true));
    v += __uint_as_float(__builtin_amdgcn_update_dpp(0, __float_as_uint(v), 0x121, 0xf, 0xf, true));
    return xsum32(xsum16(v));
}
__device__ __forceinline__ float wave_sum(float v) {
#pragma unroll
    for (int o = 32; o > 0; o >>= 1) v += __shfl_xor(v, o);
    return v;
}
__device__ __forceinline__ float wave_max(float v) {
#pragma unroll
    for (int o = 32; o > 0; o >>= 1) v = fmaxf(v, __shfl_xor(v, o));
    return v;
}
__device__ __forceinline__ int wave_sumi(int v) {
#pragma unroll
    for (int o = 32; o > 0; o >>= 1) v += __shfl_xor(v, o);
    return v;
}
__device__ __forceinline__ float block_sum(float v, float* red) {
    v = wave_sum(v);
    __syncthreads();
    if ((threadIdx.x & 63) == 0) red[threadIdx.x >> 6] = v;
    __syncthreads();
    float s = 0.f;
#pragma unroll
    for (int i = 0; i < NW; ++i) s += red[i];
    return s;
}
__device__ __forceinline__ float block_max(float v, float* red) {
    v = wave_max(v);
    __syncthreads();
    if ((threadIdx.x & 63) == 0) red[threadIdx.x >> 6] = v;
    __syncthreads();
    float s = red[0];
#pragma unroll
    for (int i = 1; i < NW; ++i) s = fmaxf(s, red[i]);
    return s;
}
__device__ __forceinline__ int block_sumi(int v, int* red) {
    v = wave_sumi(v);
    __syncthreads();
    if ((threadIdx.x & 63) == 0) red[threadIdx.x >> 6] = v;
    __syncthreads();
    int s = 0;
#pragma unroll
    for (int i = 0; i < NW; ++i) s += red[i];
    return s;
}
__device__ __forceinline__ int block_excl_scan(int v, int* red, int* tot) {
    const int lane = threadIdx.x & 63, w = threadIdx.x >> 6;
    int inc = v;
#pragma unroll
    for (int o = 1; o < 64; o <<= 1) { int n = __shfl_up(inc, o); if (lane >= o) inc += n; }
    __syncthreads();
    if (lane == 63) red[w] = inc;
    __syncthreads();
    int base = 0, t = 0;
#pragma unroll
    for (int i = 0; i < NW; ++i) { if (i < w) base += red[i]; t += red[i]; }
    *tot = t;
    return base + inc - v;
}

__device__ __forceinline__ int phys2logical(int n) { const int p = n & 255; return (n & ~255) + 64 * ((p >> 5) & 3) + 32 * (p >> 7) + (p & 31); }
__device__ __forceinline__ int logical2orig(int n) {
    if (n < 3072) return n;
    if (n < YD_K) return n - YD_Z + O_DZ;
    if (n < YD_V) return n - YD_K + O_DK;
    if (n < YI_Q) return n - YD_V + O_DV;
    if (n < NIN) return n;
    return -1;
}
__device__ __forceinline__ void transpose_item(const float* W, int ldn, const float* gk, bf16_t* WT, int k0, int n0, int src, LAS float* scr, int lane) {
#pragma unroll
    for (int i = 0; i < 32; ++i) {
        const int kk = 2 * i + (lane >> 5);
        float v = 0.f;
        if (src >= 0) { v = W[(size_t)(k0 + kk) * ldn + src]; if (gk) v *= gk[k0 + kk]; }
        scr[kk * 33 + (lane & 31)] = v;
    }
    asm volatile("s_waitcnt lgkmcnt(0)" ::: "memory");
    const int c = lane & 7;
#pragma unroll
    for (int j = 0; j < 4; ++j) {
        const int n = (lane >> 3) + 8 * j; const LAS float* s = scr + (8 * c) * 33 + n;
        u32x4 o; o.x = pk2(s[0 * 33], s[1 * 33]); o.y = pk2(s[2 * 33], s[3 * 33]); o.z = pk2(s[4 * 33], s[5 * 33]); o.w = pk2(s[6 * 33], s[7 * 33]);
        *(GAS u32x4*)(uintptr_t)(WT + (size_t)(n0 + n) * DM + k0 + 8 * c) = o;
    }
    asm volatile("s_waitcnt lgkmcnt(0)" ::: "memory");
}
__device__ __forceinline__ int tid_now(int wave_s) { int lane; asm volatile("v_mbcnt_lo_u32_b32 %0, -1, 0\n\tv_mbcnt_hi_u32_b32 %0, -1, %0" : "=v"(lane)); return wave_s * 64 + lane; }
__device__ __forceinline__ void ph_prologue(const Params& p, LAS unsigned char* lds, int tid_in) {
    int tid = tid_in; asm volatile("" : "+v"(tid));
    const int lane = tid & 63, wave = tid >> 6;
    LAS float* scr = (LAS float*)(lds + wave * 8704);
    const int gw = blockIdx.x * NW + wave, ngw = gridDim.x * NW;
    constexpr int I_IN = DEPTH * 16 * (YP / 32), I_OUT = DEPTH * 16 * (DM / 32);
    for (int it = gw; it < I_IN + I_OUT; it += ngw) {
        if (it < I_IN) {
            const int l = it / (16 * (YP / 32)), r = it % (16 * (YP / 32)), kb = r / (YP / 32), nb = r % (YP / 32);
            const int src = logical2orig(phys2logical(nb * 32 + (lane & 31)));
            transpose_item(p.w_in + (size_t)l * DM * NIN, NIN, p.norm_g + l * DM, p.wt_in() + (size_t)l * YP * DM, kb * 64, nb * 32, src, scr, lane);
        } else {
            const int q = it - I_IN, l = q / (16 * (DM / 32)), r = q % (16 * (DM / 32)), kb = r / (DM / 32), nb = r % (DM / 32);
            transpose_item(p.w_out + (size_t)l * DM * DM, DM, nullptr, p.wt_out() + (size_t)l * DM * DM, kb * 64, nb * 32, nb * 32 + (lane & 31), scr, lane);
        }
    }
    if (blockIdx.x == 0) {
        float* sm = (float*)(p.ws + WS_SMALL);
        for (int i = tid; i < SM_END; i += NT) {
            float v;
            if (i < SM_CONVB) v = p.i_conv_w[i - SM_CONVW]; else if (i < SM_GMLPG) v = p.i_conv_b[i - SM_CONVB]; else if (i < SM_GMLPB) v = p.i_gmlp_g[i - SM_GMLPG];
            else if (i < SM_QG) v = p.i_gmlp_b[i - SM_GMLPB]; else if (i < SM_KG) v = p.i_diff_qg[i - SM_QG]; else if (i < SM_LAM) v = p.i_diff_kg[i - SM_KG];
            else if (i < SM_SUBG) v = p.i_diff_lam[i - SM_LAM]; else if (i < SM_DQG) v = p.i_diff_subg[i - SM_SUBG]; else if (i < SM_DKG) v = p.i_dsa_qg[i - SM_DQG];
            else v = p.i_dsa_kg[i - SM_DKG];
            sm[i] = v;
        }
    }
    for (int i = (blockIdx.x * NT + tid) * 4; i < DEPTH * 4 * 128 * 128; i += gridDim.x * NT * 4) {
        const f32x4 v = *(const GAS f32x4*)(uintptr_t)(p.gmlp_ws + i);
        *(GAS unsigned long long*)(uintptr_t)(p.wsb() + i) = (unsigned long long)pk2(v.x, v.y) | ((unsigned long long)pk2(v.z, v.w) << 32);
    }
    for (int r0 = gw * 4; r0 < NTOK; r0 += ngw * 4) {
        f32x4 v[4][4];
#pragma unroll
        for (int rr = 0; rr < 4; ++rr)
#pragma unroll
            for (int j = 0; j < 4; ++j) v[rr][j] = ((const GAS f32x4*)(uintptr_t)(p.x + (size_t)(r0 + rr) * DM))[lane + 64 * j];
#pragma unroll
        for (int rr = 0; rr < 4; ++rr) {
            GAS unsigned long long* o8 = (GAS unsigned long long*)(uintptr_t)(p.xb() + (size_t)(r0 + rr) * DM) + lane;
            float s = 0.f;
#pragma unroll
            for (int j = 0; j < 4; ++j) {
                const f32x4 q = v[rr][j];
                s += (q.x * q.x + q.y * q.y) + (q.z * q.z + q.w * q.w);
                o8[64 * j] = (unsigned long long)pk2(q.x, q.y) | ((unsigned long long)pk2(q.z, q.w) << 32);
            }
            s = wave_sum64(s);
            if (lane < 16) ((GAS float*)(uintptr_t)p.ssq())[(size_t)(r0 + rr) * 16 + lane] = lane == 0 ? s : 0.f;
        }
    }
}

__device__ __forceinline__ float silu_f(float v) { return v * __builtin_amdgcn_rcpf(1.f + __builtin_amdgcn_exp2f(-1.4426950408889634f * v)); }
struct EpiIn {
    static constexpr bool PERM = true, AFTER_DRAIN = false;
    unsigned char* ws; int l; LAS float* rs;
    __device__ __forceinline__ void operator()(const f32x4 (&acc)[2][2][4][2], const Unit& u, int wr, int wc, int fr_, int fq_) const {
        int fr = fr_, fq = fq_; asm volatile("" : "+v"(fr), "+v"(fq));
        const int pn = u.pn;
        bf16_t* Y = (bf16_t*)(ws + WS_Y); const float* ssq = (const float*)(ws + WS_SSQ); const float* smb = (const float*)(ws + WS_SMALL);
        const float* gmlp_g = smb + SM_GMLPG + l * 256; const float* qg = smb + SM_QG + l * 32; const float* kg = smb + SM_KG + l * 32;
        const float* dqg = smb + SM_DQG + l * 64; const float* dkg = smb + SM_DKG + l * 64;
        int op = 0; const float* g0 = nullptr; const float* g1 = nullptr;
        if (pn == 3 || pn == 6 || pn == 10 || pn == 12) op = 1;
        else if (pn == 4) op = 2;
        else if (pn == 5) { op = 3; g0 = gmlp_g + 64 * wc + 8 * fq; g1 = g0 + 32; }
        else if (pn == 7) { op = 4; g0 = qg + 8 * fq; g1 = g0; }
        else if (pn == 8) { op = 4; g0 = kg + 8 * fq; g1 = g0; }
        else if (pn == 11) { op = 5; g0 = dqg + 8 * fq; g1 = g0 + 32; }
        else if (pn == 13 && wc == 0) { op = 5; g0 = dkg + 8 * fq; g1 = g0 + 32; }
        float gn[16];
#pragma unroll
        for (int i = 0; i < 16; ++i) gn[i] = 1.f;
        if (op >= 3) {
            const f32x4 a = *(const GAS f32x4*)(uintptr_t)g0, b = *(const GAS f32x4*)(uintptr_t)(g0 + 4), c = *(const GAS f32x4*)(uintptr_t)g1, d = *(const GAS f32x4*)(uintptr_t)(g1 + 4);
            gn[0] = a.x; gn[1] = a.y; gn[2] = a.z; gn[3] = a.w; gn[4] = b.x; gn[5] = b.y; gn[6] = b.z; gn[7] = b.w;
            gn[8] = c.x; gn[9] = c.y; gn[10] = c.z; gn[11] = c.w; gn[12] = d.x; gn[13] = d.y; gn[14] = d.z; gn[15] = d.w;
        }
        const int colb = pn * 256 + 64 * wc + 8 * fq;
        TB(14, (LAS unsigned char*)rs - (131072 + 1024), wr * 256 + wc * 64 + fq * 16 + fr);
        {
            const int t = wr * 256 + wc * 64 + fq * 16 + fr;
            if (t < 256) {
                const f32x4* sp = (const f32x4*)(ssq + (size_t)(u.pm * 256 + t) * 16);
                const f32x4 s0 = sp[0], s1 = sp[1], s2 = sp[2], s3 = sp[3];
                const float tot = ((s0.x + s0.y) + (s0.z + s0.w)) + ((s1.x + s1.y) + (s1.z + s1.w)) + ((s2.x + s2.y) + (s2.z + s2.w)) + ((s3.x + s3.y) + (s3.z + s3.w));
                rs[t] = rsqrtf(tot * (1.f / DM) + EPS);
            }
            asm volatile("s_waitcnt vmcnt(0) lgkmcnt(0)" ::: "memory"); __builtin_amdgcn_s_barrier(); asm volatile("" ::: "memory");
        }
#pragma unroll
        for (int ai = 0; ai < 2; ++ai)
#pragma unroll
            for (int m = 0; m < 4; ++m) {
                const int row = u.pm * 256 + ai * 128 + wr * 64 + m * 16 + fr;
                const float rstd = rs[ai * 128 + wr * 64 + m * 16 + fr];
                float v[16];
#pragma unroll
                for (int bj = 0; bj < 2; ++bj)
#pragma unroll
                    for (int n = 0; n < 2; ++n)
#pragma unroll
                        for (int e = 0; e < 4; ++e) v[bj * 8 + n * 4 + e] = acc[ai][bj][m][n][e] * rstd;
                if (op == 1) {
#pragma unroll
                    for (int i = 0; i < 16; ++i) v[i] = silu_f(v[i]);
                } else if (op == 2 || op == 3) {
#pragma unroll
                    for (int i = 0; i < 16; i += 2) { const pg8::f32x2 r = pg8::gelu_pk((pg8::f32x2){v[i], v[i + 1]}); v[i] = r.x; v[i + 1] = r.y; }
                }
                if (op == 3 || op == 5) {
                    float ss = 0.f;
#pragma unroll
                    for (int i = 0; i < 16; ++i) ss += v[i] * v[i];
                    ss = xsum16(ss); ss = xsum32(ss);
                    const float sc = rsqrtf(ss * (1.f / 64) + EPS);
#pragma unroll
                    for (int i = 0; i < 16; ++i) v[i] *= sc * gn[i];
                } else if (op == 4) {
#pragma unroll
                    for (int bj = 0; bj < 2; ++bj) {
                        float ss = 0.f;
#pragma unroll
                        for (int i = 0; i < 8; ++i) ss += v[bj * 8 + i] * v[bj * 8 + i];
                        ss = xsum16(ss); ss = xsum32(ss);
                        const float sc = rsqrtf(ss * (1.f / 32) + EPS);
#pragma unroll
                        for (int i = 0; i < 8; ++i) v[bj * 8 + i] *= sc * gn[bj * 8 + i];
                    }
                }
                bf16_t* rowp = Y + (size_t)row * YP + colb;
#pragma unroll
                for (int bj = 0; bj < 2; ++bj) {
                    u32x4 w; w.x = pg8::cvt_pk_bf16(v[bj * 8 + 0], v[bj * 8 + 1]); w.y = pg8::cvt_pk_bf16(v[bj * 8 + 2], v[bj * 8 + 3]);
                    w.z = pg8::cvt_pk_bf16(v[bj * 8 + 4], v[bj * 8 + 5]); w.w = pg8::cvt_pk_bf16(v[bj * 8 + 6], v[bj * 8 + 7]);
                    *(GAS u32x4*)(uintptr_t)(rowp + 32 * bj) = w;
                }
            }
        TE(14, (LAS unsigned char*)rs - (131072 + 1024), wr * 256 + wc * 64 + fq * 16 + fr);
    }
};
struct EpiOut {
    static constexpr bool PERM = false, AFTER_DRAIN = false;
    float* xout; unsigned char* ws;
    __device__ __forceinline__ void operator()(const f32x4 (&acc)[2][2][4][2], const Unit& u, int wr, int wc, int fr_, int fq_) const {
        int fr = fr_, fq = fq_; asm volatile("" : "+v"(fr), "+v"(fq));
        const int col0 = u.pn * 256 + wc * 32 + 4 * fq;
        bf16_t* xb = (bf16_t*)(ws + WS_XB); float* ssq = (float*)(ws + WS_SSQ);
#pragma unroll
        for (int ai = 0; ai < 2; ++ai)
#pragma unroll
            for (int m = 0; m < 4; ++m) {
                const int row = u.pm * 256 + ai * 128 + wr * 64 + m * 16 + fr;
                float sq = 0.f;
#pragma unroll
                for (int bj = 0; bj < 2; ++bj)
#pragma unroll
                    for (int n = 0; n < 2; ++n) {
                        const size_t off = (size_t)row * DM + col0 + bj * 128 + n * 16;
                        const unsigned long long xo = *(const GAS unsigned long long*)(uintptr_t)(xb + off);
                        f32x4 v = acc[ai][bj][m][n];
                        v.x += __uint_as_float((unsigned)xo << 16); v.y += __uint_as_float((unsigned)xo & 0xffff0000u);
                        v.z += __uint_as_float((unsigned)(xo >> 32) << 16); v.w += __uint_as_float((unsigned)(xo >> 32) & 0xffff0000u);
                        sq += (v.x * v.x + v.y * v.y) + (v.z * v.z + v.w * v.w);
                        if (xout) *(GAS f32x4*)(uintptr_t)(xout + off) = v;
                        else *(GAS unsigned long long*)(uintptr_t)(xb + off) = (unsigned long long)pg8::cvt_pk_bf16(v.x, v.y) | ((unsigned long long)pg8::cvt_pk_bf16(v.z, v.w) << 32);
                    }
                sq = xsum16(sq); sq = xsum32(sq);
                if (fq == 0) ssq[(size_t)row * 16 + u.pn * 4 + wc] = sq;
                if (m == 3) asm volatile("" ::: "memory");
            }
    }
};
#define XB_TMO      128
#define XB_XCNT(j)  (256  + 64 * (j))
#define XB_XSUB(j)  (1280 + 64 * (j))
#define XB_XGEN(j)  (2304 + 64 * (j))
#define XB_TOP      3328
#define XB_TOPGEN   3392
#define XCD_BAR_WORDS 3456
#define XB_SPIN_CAP (1u << 18)

__device__ __forceinline__ unsigned xb_ld(unsigned* p)              { return __hip_atomic_load(p, __ATOMIC_RELAXED, __HIP_MEMORY_SCOPE_AGENT); }
__device__ __forceinline__ unsigned xb_add(unsigned* p, unsigned v) { return __hip_atomic_fetch_add(p, v, __ATOMIC_RELAXED, __HIP_MEMORY_SCOPE_AGENT); }
__device__ __forceinline__ unsigned xb_xcc_id() { return (unsigned)__builtin_amdgcn_s_getreg((3 << 11) | 20) & 0xFu; }
#define XB_SPIN(cond, bar) do { unsigned _sp = 0; while (cond) { __builtin_amdgcn_s_sleep(1); \
    if ((++_sp & 255u) == 0u) { if (xb_ld(&(bar)[XB_TMO])) break; if (_sp > XB_SPIN_CAP) { atomicAdd(&(bar)[XB_TMO], 1u); break; } } } } while (0)

struct XcdBarrier {
    unsigned* bar; unsigned x;
    volatile LAS unsigned* st;
};

__device__ __forceinline__ XcdBarrier xcd_barrier_post(unsigned* bar, volatile LAS unsigned* st) {
    XcdBarrier b; b.bar = bar; b.x = xb_xcc_id(); b.st = st;
    if (threadIdx.x == 0) (void)xb_add(&bar[XB_XCNT(b.x)], 1u);
    return b;
}
__device__ __forceinline__ void xcd_barrier_complete(unsigned* bar, unsigned x, unsigned& nloc, unsigned& nx) {
    const unsigned G = gridDim.x * gridDim.y * gridDim.z;
    unsigned sum, cnt, mine, sp = 0u;
    for (;;) {
        sum = 0u; cnt = 0u; mine = 0u;
#pragma unroll
        for (unsigned j = 0; j < 16; ++j) { const unsigned c = xb_ld(&bar[XB_XCNT(j)]); sum += c; cnt += (c > 0u) ? 1u : 0u; mine = (j == x) ? c : mine; }
        if (sum == G) break;
        __builtin_amdgcn_s_sleep(1);
        if ((++sp & 255u) == 0u) { if (xb_ld(&bar[XB_TMO])) break; if (sp > XB_SPIN_CAP) { atomicAdd(&bar[XB_TMO], 1u); break; } }
    }
    nloc = mine > 0u ? mine : 1u; nx = cnt > 0u ? cnt : 1u;
}

__device__ __forceinline__ void xcd_barrier(const XcdBarrier& b, int tid_in) {
    asm volatile("s_waitcnt vmcnt(0)" ::: "memory");
    __syncthreads();
    int t0_ = tid_in; asm volatile("" : "+v"(t0_));
    if (t0_ == 0) {
        unsigned* bar = b.bar; unsigned bx = b.x; asm volatile("" : "+s"(bar), "+s"(bx));
        __builtin_amdgcn_s_waitcnt(0);
        unsigned nloc = b.st[0], nx = b.st[1];
        if (nloc == 0u) { xcd_barrier_complete(bar, bx, nloc, nx); b.st[0] = nloc; b.st[1] = nx; }
        const unsigned old = xb_add(&bar[XB_XSUB(bx)], 1u);
        const unsigned gen = old / nloc;
        if (old + 1u == (gen + 1u) * nloc) {
            __builtin_amdgcn_fence(__ATOMIC_RELEASE, "agent");
            asm volatile("s_waitcnt vmcnt(0)" ::: "memory");
            const unsigned og = xb_add(&bar[XB_TOP], 1u);
            const unsigned tg = og / nx;
            if (og + 1u == (tg + 1u) * nx) xb_add(&bar[XB_TOPGEN], 1u);
            else XB_SPIN(xb_ld(&bar[XB_TOPGEN]) == tg, bar);
            __builtin_amdgcn_fence(__ATOMIC_ACQUIRE, "agent");
            xb_add(&bar[XB_XGEN(bx)], 1u);
            asm volatile("s_waitcnt vmcnt(0)" ::: "memory");
        } else {
            XB_SPIN(xb_ld(&bar[XB_XGEN(bx)]) == gen, bar);
            __builtin_amdgcn_fence(__ATOMIC_ACQUIRE, "agent");
            asm volatile("s_waitcnt vmcnt(0)" ::: "memory");
        }
    }
    __syncthreads();
}

typedef short bf16x8_t __attribute__((ext_vector_type(8)));
typedef short s16x4_t __attribute__((ext_vector_type(4)));
typedef float f32x16 __attribute__((ext_vector_type(16)));
typedef float f32x2_t __attribute__((ext_vector_type(2)));
typedef __bf16 bf16x2_t __attribute__((ext_vector_type(2)));
#define MFMA32(a, b, c) __builtin_amdgcn_mfma_f32_32x32x16_bf16((a), (b), (c), 0, 0, 0)
__device__ __forceinline__ unsigned cvtpk(float lo, float hi) { f32x2_t v = {lo, hi}; bf16x2_t b = __builtin_convertvector(v, bf16x2_t); return __builtin_bit_cast(unsigned, b); }
__device__ __forceinline__ s16x4_t ds_tr16(const LAS unsigned char* p) { return __builtin_bit_cast(s16x4_t, __builtin_amdgcn_ds_read_tr16_b64_v4i16((LAS s16x4_t*)p)); }
__device__ __forceinline__ bf16x8_t pack_step(const f32x16& x, int s) {
    u32x4 p; p.x = cvtpk(x[8 * s], x[8 * s + 1]); p.y = cvtpk(x[8 * s + 2], x[8 * s + 3]); p.z = cvtpk(x[8 * s + 4], x[8 * s + 5]); p.w = cvtpk(x[8 * s + 6], x[8 * s + 7]);
    return __builtin_bit_cast(bf16x8_t, p);
}
constexpr int KV_STRIDE = 144;
constexpr int KV_TILE = 64 * KV_STRIDE;
__device__ __forceinline__ bf16x8_t vt_frag(const LAS unsigned char* vtile, int ks, int db, int lane) {
    const int i16 = lane & 15, q = i16 >> 2, pp = i16 & 3, blk = (lane >> 4) & 1, hh = lane >> 5;
    const LAS unsigned char* a = vtile + (16 * ks + 4 * hh + q) * KV_STRIDE + (32 * db + 16 * blk + 4 * pp) * 2;
    const s16x4_t lo = ds_tr16(a), hi = ds_tr16(a + 8 * KV_STRIDE);
    return __builtin_shufflevector(lo, hi, 0, 1, 2, 3, 4, 5, 6, 7);
}

constexpr int KVL_TILE = 64 * 128;
__device__ __forceinline__ void dma_piece(const bf16_t* src_row0, LAS unsigned char* dst, int lane) {
    const bf16_t* g = src_row0 + (size_t)(lane >> 3) * YP + (((lane & 7) ^ (lane >> 3)) * 8);
    const unsigned d = (unsigned)__builtin_amdgcn_readfirstlane((int)(unsigned)(size_t)dst);
    unsigned keep;
    asm volatile("s_mov_b32 %0, m0\n\ts_mov_b32 m0, %2\n\ts_nop 0\n\tglobal_load_lds_dwordx4 %1, off\n\ts_mov_b32 m0, %0" : "=&s"(keep) : "v"(g), "s"(d) : "memory");
}
__device__ __forceinline__ bf16x8_t vt_frag_sw(const LAS unsigned char* vtile, int ks, int db, int lane) {
    const int i16 = lane & 15, q = i16 >> 2, pp = i16 & 3, blk = (lane >> 4) & 1, hh = lane >> 5;
    const int row = 16 * ks + 4 * hh + q, ch = 4 * db + 2 * blk + (pp >> 1);
    const LAS unsigned char* a = vtile + row * 128 + ((ch ^ (row & 7)) * 16) + (pp & 1) * 8;
    const s16x4_t lo = ds_tr16(a), hi = ds_tr16(a + 8 * 128);
    return __builtin_shufflevector(lo, hi, 0, 1, 2, 3, 4, 5, 6, 7);
}

__device__ __forceinline__ void mixC_unit(const Params& p, int l, int b, int h, int qt, LAS unsigned char* lds, int wave_s) {
    const int tid = tid_now(wave_s);
    volatile LAS float* pc = (volatile LAS float*)(lds + 131072 + 2048);
    const float mfix = pc[0];
    const int lane = tid & 63, wave = __builtin_amdgcn_readfirstlane(tid >> 6), r32 = lane & 31, hh = lane >> 5;
    const size_t rowb = (size_t)b * SEQ;
    const int q0 = qt * 256 + wave * 32;
    const int cw = (q0 >> 6);
    const int jmax = 4 * qt + 3;
    const int pos = q0 + r32;
    const bf16_t* yq = p.Y() + (rowb + pos) * YP;
    bf16x8_t qf[2][2];
#pragma unroll
    for (int c = 0; c < 2; ++c)
#pragma unroll
        for (int s = 0; s < 2; ++s) qf[c][s] = *(const GAS bf16x8_t*)(uintptr_t)(yq + YC_Q + h * 64 + c * 32 + 16 * s + 8 * hh);
    const float c1 = 0.17677669529663687f * 1.4426950408889634f;
    const float sl2 = exp2f(-(float)(2 * h + 1)) * 1.4426950408889634f;
    f32x16 o[2][2];
#pragma unroll
    for (int c = 0; c < 2; ++c)
#pragma unroll
        for (int d = 0; d < 2; ++d)
#pragma unroll
            for (int i = 0; i < 16; ++i) o[c][d][i] = 0.f;
    float lrun[2] = {0.f, 0.f};
    const bf16_t* ksrc = p.Y() + (rowb + 8 * wave) * YP + YC_K + h * 64;
    const bf16_t* vsrc = p.Y() + (rowb + 8 * wave) * YP + YC_V + h * 64;
    LAS unsigned char* kring = lds;
    LAS unsigned char* vring = lds + 6 * KVL_TILE;
    asm volatile("" : "+v"(qf[0][0]), "+v"(qf[0][1]), "+v"(qf[1][0]), "+v"(qf[1][1]));
    const float mfix_r = mfix; asm volatile("" :: "v"(mfix_r));
    asm volatile("s_waitcnt lgkmcnt(0)" ::: "memory"); __builtin_amdgcn_s_barrier(); asm volatile("" ::: "memory");
#pragma unroll
    for (int t = 0; t < 4; ++t) { dma_piece(ksrc + (size_t)t * 64 * YP, kring + t * KVL_TILE + wave * 1024, lane); dma_piece(vsrc + (size_t)t * 64 * YP, vring + t * KVL_TILE + wave * 1024, lane); }
    int slot = 0, slot2 = 4;
    for (int j = 0; j <= jmax; ++j) {
        if ((j & 1) == 0) {
            TB(3, lds, tid);
            if (j + 2 <= jmax) asm volatile("s_waitcnt vmcnt(4)" ::: "memory"); else asm volatile("s_waitcnt vmcnt(0)" ::: "memory");
            __builtin_amdgcn_s_barrier(); asm volatile("" ::: "memory");
            if (j + 4 <= jmax) {
#pragma unroll
                for (int t = 0; t < 2; ++t) {
                    const int sl = slot2 + t >= 6 ? slot2 + t - 6 : slot2 + t;
                    dma_piece(ksrc + (size_t)(j + 4 + t) * 64 * YP, kring + sl * KVL_TILE + wave * 1024, lane); dma_piece(vsrc + (size_t)(j + 4 + t) * 64 * YP, vring + sl * KVL_TILE + wave * 1024, lane);
                }
            }
            TE(3, lds, tid);
        }
        TB(2, lds, tid);
        if (j <= cw) {
            const LAS unsigned char* kt = kring + slot * KVL_TILE;
            const LAS unsigned char* vt = vring + slot * KVL_TILE;
            const float pl = (float)(pos - 64 * j - 4 * hh);
            const bool diag = (j == cw);
#pragma unroll
            for (int c = 0; c < 2; ++c) {
                f32x16 sc[2];
#pragma unroll
                for (int kb = 0; kb < 2; ++kb) {
                    f32x16 a;
#pragma unroll
                    for (int i = 0; i < 16; ++i) a[i] = 0.f;
#pragma unroll
                    for (int s = 0; s < 2; ++s) {
                        const bf16x8_t kf = *(const LAS bf16x8_t*)(kt + (32 * kb + r32) * 128 + (((4 * c + 2 * s + hh) ^ (r32 & 7)) * 16));
                        a = MFMA32(kf, qf[c][s], a);
                    }
                    sc[kb] = a;
                }
                float ls4[4] = {0.f, 0.f, 0.f, 0.f};
                if (!diag) {
                    const float rt = -sl2 * pl - mfix;
                    const f32x2_t d01 = {0.f, sl2}, d23 = {2.f * sl2, 3.f * sl2}, c1v = {c1, c1};
                    f32x2_t lsv0 = {0.f, 0.f}, lsv1 = {0.f, 0.f};
#pragma unroll
                    for (int kb = 0; kb < 2; ++kb)
#pragma unroll
                        for (int g = 0; g < 4; ++g) {
                            const float bs = fmaf(sl2, (float)(32 * kb + 8 * g), rt);
                            const f32x2_t bv = {bs, bs};
                            const f32x2_t t01 = (f32x2_t){sc[kb][4 * g], sc[kb][4 * g + 1]} * c1v + (bv + d01);
                            const f32x2_t t23 = (f32x2_t){sc[kb][4 * g + 2], sc[kb][4 * g + 3]} * c1v + (bv + d23);
                            const f32x2_t e01 = {__builtin_amdgcn_exp2f(t01.x), __builtin_amdgcn_exp2f(t01.y)}, e23 = {__builtin_amdgcn_exp2f(t23.x), __builtin_amdgcn_exp2f(t23.y)};
                            sc[kb][4 * g] = e01.x; sc[kb][4 * g + 1] = e01.y; sc[kb][4 * g + 2] = e23.x; sc[kb][4 * g + 3] = e23.y;
                            lsv0 += e01; lsv1 += e23;
                        }
                    ls4[0] = lsv0.x; ls4[1] = lsv0.y; ls4[2] = lsv1.x; ls4[3] = lsv1.y;
                } else {
#pragma unroll
                    for (int kb = 0; kb < 2; ++kb)
#pragma unroll
                        for (int i = 0; i < 16; ++i) {
                            const float kc = (float)(32 * kb + (i & 3) + 8 * (i >> 2));
                            const float e = __builtin_amdgcn_exp2f(fmaf(sc[kb][i], c1, fmaf(-sl2, fabsf(pl - kc), -mfix)));
                            sc[kb][i] = e; ls4[i & 3] += e;
                        }
                }
                lrun[c] += (ls4[0] + ls4[1]) + (ls4[2] + ls4[3]);
#pragma unroll
                for (int ks = 0; ks < 4; ++ks) {
                    const bf16x8_t pf = pack_step(sc[ks >> 1], ks & 1);
#pragma unroll
                    for (int db = 0; db < 2; ++db) o[c][db] = MFMA32(vt_frag_sw(vt, ks, db, lane), pf, o[c][db]);
                }
            }
        }
        TE(2, lds, tid);
        slot = slot == 5 ? 0 : slot + 1; slot2 = slot2 == 5 ? 0 : slot2 + 1;
    }
    const float lam = pc[1], oml = pc[2];
    const int tid2 = tid_now(wave_s), lane2 = tid2 & 63, r32e = lane2 & 31, hhe = lane2 >> 5;
    const int pose = qt * 256 + wave * 32 + r32e;
    const bf16_t* yqe = p.Y() + (rowb + pose) * YP;
    const float l1 = xsum32(lrun[0]), l2 = xsum32(lrun[1]);
    const float i1 = 1.f / l1, i2 = lam / l2;
    float ss = 0.f;
#pragma unroll
    for (int d = 0; d < 2; ++d)
#pragma unroll
        for (int i = 0; i < 16; ++i) { const float v = o[0][d][i] * i1 - o[1][d][i] * i2; o[0][d][i] = v; ss += v * v; }
    ss = xsum32(ss);
    const float rn = rsqrtf(ss * (1.f / 64) + EPS) * oml;
    const GAS float* sg = p.sm(SM_SUBG) + l * 256 + h * 64;
    bf16_t* mrow = p.mix() + (rowb + pose) * DM + 512 + h * 64;
#pragma unroll
    for (int d = 0; d < 2; ++d)
#pragma unroll
        for (int g = 0; g < 4; ++g) {
            const int d0 = 32 * d + 8 * g + 4 * hhe;
            const f32x4 gv = *(const GAS f32x4*)(uintptr_t)(sg + d0);
            const unsigned long long zz = *(const GAS unsigned long long*)(uintptr_t)(yqe + YC_Z + h * 64 + d0);
            const float z0 = __uint_as_float((unsigned)(zz & 0xffffu) << 16), z1 = __uint_as_float((unsigned)((zz >> 16) & 0xffffu) << 16),
                        z2 = __uint_as_float((unsigned)((zz >> 32) & 0xffffu) << 16), z3 = __uint_as_float((unsigned)((zz >> 48) & 0xffffu) << 16);
            const float v0 = o[0][d][4 * g] * rn * gv.x * z0, v1 = o[0][d][4 * g + 1] * rn * gv.y * z1, v2 = o[0][d][4 * g + 2] * rn * gv.z * z2, v3 = o[0][d][4 * g + 3] * rn * gv.w * z3;
            *(GAS unsigned long long*)(uintptr_t)(mrow + d0) = (unsigned long long)cvtpk(v0, v1) | ((unsigned long long)cvtpk(v2, v3) << 32);
        }
}
__device__ __forceinline__ void ph_mixC(const Params& p, int l, LAS unsigned char* lds, int bid, int nb, int wave_s) {
    {
        const float lam_init = l == 0 ? 0.200000001f : l == 1 ? 0.355509068f : l == 2 ? 0.470713018f : 0.556058204f;
        const GAS float* lp = p.sm(SM_LAM) + l * 128;
        float d1 = 0.f, d2 = 0.f;
        for (int i = 0; i < 32; ++i) { d1 += lp[i] * lp[32 + i]; d2 += lp[64 + i] * lp[96 + i]; }
        float gq = 0.f, gk = 0.f;
        for (int i = 0; i < 32; ++i) { gq = fmaxf(gq, fabsf(p.sm(SM_QG)[l * 32 + i])); gk = fmaxf(gk, fabsf(p.sm(SM_KG)[l * 32 + i])); }
        volatile LAS float* pc = (volatile LAS float*)(lds + 131072 + 2048);
        if (tid_now(wave_s) == 0) {
            pc[0] = 0.17677669529663687f * 1.4426950408889634f * 32.f * gq * gk * 1.02f;
            pc[1] = expf(d1) - expf(d2) + lam_init;
            pc[2] = 1.f - lam_init;
        }
        __syncthreads();
    }
    for (int i = bid; i < 256; i += nb) {
#pragma unroll 1
        for (int k = 0; k < 2; ++k) {
            const int id = k == 0 ? i : 511 - i;
            const int qt = id < 256 ? 7 - (id >> 6) : 3 - ((id - 256) >> 6), bh = id & 63;
            mixC_unit(p, l, bh >> 2, bh & 3, qt, lds, wave_s);
        }
    }
}

constexpr int SC_STRIDE = 2052;
constexpr int SC_BYTES = 16 * SC_STRIDE * 4;
constexpr int IK_STRIDE = 80, IK_TILE = 64 * IK_STRIDE;
__device__ __forceinline__ unsigned fkey(float f) { const unsigned u = __float_as_uint(f); return (u & 0x80000000u) ? ~u : (u | 0x80000000u); }
__device__ __forceinline__ float unfkey(unsigned k) { return __uint_as_float((k & 0x80000000u) ? (k & 0x7fffffffu) : ~k); }
__device__ __forceinline__ f32x16 idx_scores(const bf16x8_t ik0, const bf16x8_t ik1, const bf16x8_t (&iqf)[4][2], const float (&w)[4]) {
    f32x16 sc;
#pragma unroll
    for (int i = 0; i < 16; ++i) sc[i] = 0.f;
#pragma unroll
    for (int hd = 0; hd < 4; ++hd) {
        f32x16 a;
#pragma unroll
        for (int i = 0; i < 16; ++i) a[i] = 0.f;
        a = MFMA32(ik0, iqf[hd][0], a);
        a = MFMA32(ik1, iqf[hd][1], a);
#pragma unroll
        for (int i = 0; i < 16; ++i) sc[i] = fmaf(w[hd], fmaxf(a[i], 0.f), sc[i]);
    }
#pragma unroll
    for (int i = 0; i < 16; ++i) sc[i] = sc[i] + 0.f;
    return sc;
}
__device__ __forceinline__ void transpose32(unsigned (&a)[32]) {
#pragma unroll
    for (int s = 0; s < 5; ++s) {
        const int j = 16 >> s;
        const unsigned mk = j == 16 ? 0x0000ffffu : j == 8 ? 0x00ff00ffu : j == 4 ? 0x0f0f0f0fu : j == 2 ? 0x33333333u : 0x55555555u;
#pragma unroll
        for (int k = 0; k < 32; ++k)
            if ((k & j) == 0) { const unsigned t = (a[k] ^ (a[k + j] >> j)) & mk; a[k] ^= t; a[k + j] ^= t << j; asm volatile("" : "+v"(a[k]), "+v"(a[k + j])); }
    }
}
__device__ __forceinline__ int rowsum16(int v) {
    v += __builtin_amdgcn_update_dpp(0, v, 0x128, 0xf, 0xf, true);
    v += __builtin_amdgcn_update_dpp(0, v, 0x124, 0xf, 0xf, true);
    v += __builtin_amdgcn_update_dpp(0, v, 0x122, 0xf, 0xf, true);
    v += __builtin_amdgcn_update_dpp(0, v, 0x121, 0xf, 0xf, true);
    return v;
}
__device__ __forceinline__ unsigned topbits(int ne) { return ne <= 0 ? 0u : ne >= 32 ? 0xffffffffu : (0xffffffffu << (32 - ne)); }
template <int ST>
__device__ __forceinline__ void rs4_row(const unsigned (&pl)[4][32], unsigned (&alive)[4], int& above, unsigned& prefix, bool& done, bool& alld, int nmr) {
    if (!alld) {
        int c11 = 0, c10 = 0, c01 = 0;
#pragma unroll
        for (int j = 0; j < 4; ++j)
            if (j < nmr) {
                const unsigned p1 = pl[j][2 * ST], p0 = pl[j][2 * ST + 1], a1 = alive[j] & p1, a0 = alive[j] & ~p1;
                c11 += __popc(a1 & p0); c10 += __popc(a1 & ~p0); c01 += __popc(a0 & p0);
            }
        const int s01 = rowsum16(c11 | (c10 << 16)), s2 = rowsum16(c01);
        if (!done) {
            const int t11 = above + (s01 & 0xffff), t10 = t11 + (int)((unsigned)s01 >> 16), t01 = t10 + s2;
            const int dg = t11 >= TOPK ? 3 : t10 >= TOPK ? 2 : t01 >= TOPK ? 1 : 0;
            const int tsel = dg == 3 ? t11 : dg == 2 ? t10 : t01;
            prefix |= (unsigned)dg << (30 - 2 * ST);
            above = dg == 3 ? above : dg == 2 ? t11 : dg == 1 ? t10 : t01;
#pragma unroll
            for (int j = 0; j < 4; ++j)
                if (j < nmr) {
                    const unsigned p1 = pl[j][2 * ST], p0 = pl[j][2 * ST + 1];
                    alive[j] &= ((dg & 2) ? p1 : ~p1) & ((dg & 1) ? p0 : ~p0);
                }
            if (dg != 0 && tsel == TOPK) done = true;
        }
        alld = __all(done);
    }
    if constexpr (ST < 15) rs4_row<ST + 1>(pl, alive, above, prefix, done, alld, nmr);
}
__device__ __forceinline__ void mixD_attend(const Params& p, int b, int c, LAS unsigned char* lds, int wave_s);
__device__ __forceinline__ void mixD_unit(const Params& p, int b, int c, LAS unsigned char* lds, int wave_s) {
    const int tid = tid_now(wave_s);
    const int lane = tid & 63, wave = __builtin_amdgcn_readfirstlane(tid >> 6), r32 = lane & 31, hh = lane >> 5;
    const size_t rowb = (size_t)b * SEQ;
    const int q0 = c * 64, ntile = c + 1;
    LAS float* thr = (LAS float*)(lds + 131072 + 1024);
    LAS int* kcs = (LAS int*)(lds + 131072 + 1280);
    const bool dosel = c >= 4;
    __syncthreads();
    if (dosel) {
        constexpr int SKS = 1028;
        LAS unsigned* sk = (LAS unsigned*)lds;
        const int nblk = 2 * ntile;
        const int nbw = (nblk - wave + 7) >> 3;
        const int nv = 4 * ntile;
        const int nmr = (nv + 31) >> 5;
#pragma unroll 1
        for (int sp = 0; sp < 2; ++sp) {
            TB(4, lds, tid); TB(5, lds, tid);
            unsigned kr[4][32];
            unsigned zopq = 0u; asm volatile("" : "+v"(zopq));
            {
                const bf16_t* yq1 = p.Y() + (rowb + q0 + 32 * sp + r32) * YP;
                bf16x8_t iqf[4][2];
#pragma unroll
                for (int hd = 0; hd < 4; ++hd)
#pragma unroll
                    for (int s = 0; s < 2; ++s) iqf[hd][s] = *(const GAS bf16x8_t*)(uintptr_t)(yq1 + YI_Q + hd * 32 + 16 * s + 8 * hh);
                float w[4];
                const unsigned long long ww = *(const GAS unsigned long long*)(uintptr_t)(yq1 + YI_W);
#pragma unroll
                for (int hd = 0; hd < 4; ++hd) w[hd] = __uint_as_float((unsigned)((ww >> (16 * hd)) & 0xffffu) << 16) * (0.17677669529663687f * 0.5f);
#pragma unroll
                for (int g = 0; g < 2; ++g) {
                    bf16x8_t ik[4][2];
#pragma unroll
                    for (int i = 0; i < 4; ++i) {
                        const int kb = 4 * g + i < nbw ? wave + 8 * (4 * g + i) : wave;
                        const bf16_t* yk = p.Y() + (rowb + 32 * kb + r32) * YP + YI_K + 8 * hh;
                        ik[i][0] = *(const GAS bf16x8_t*)(uintptr_t)yk; ik[i][1] = *(const GAS bf16x8_t*)(uintptr_t)(yk + 16);
                    }
#pragma unroll
                    for (int i = 0; i < 4; ++i) {
                        const int blk = 4 * g + i;
                        if (blk < nbw) {
                            const f32x16 sc = idx_scores(ik[i][0], ik[i][1], iqf, w);
#pragma unroll
                            for (int r = 0; r < 16; ++r) kr[blk >> 1][16 * (blk & 1) + r] = fkey(sc[r]);
                        } else {
#pragma unroll
                            for (int r = 0; r < 16; ++r) kr[blk >> 1][16 * (blk & 1) + r] = zopq;
                        }
                    }
                    asm volatile("" ::: "memory");
                }
            }
            TE(5, lds, tid); TB(20, lds, tid);
            unsigned pl[4][32];
            {
                const int rq = 4 * wave + (lane >> 4), rt = lane & 15;
#pragma unroll
                for (int rd = 0; rd < 2; ++rd) {
#pragma unroll
                    for (int i = 0; i < 4; ++i)
#pragma unroll
                        for (int g = 0; g < 4; ++g) {
                            const int blk = 4 * rd + i;
                            u32x4 v; v.x = kr[blk >> 1][16 * (blk & 1) + 4 * g]; v.y = kr[blk >> 1][16 * (blk & 1) + 4 * g + 1]; v.z = kr[blk >> 1][16 * (blk & 1) + 4 * g + 2]; v.w = kr[blk >> 1][16 * (blk & 1) + 4 * g + 3];
                            *(LAS u32x4*)(sk + r32 * SKS + 32 * wave + 256 * i + 8 * g + 4 * hh) = v;
                        }
                    __syncthreads();
#pragma unroll
                    for (int M = 0; M < 16; ++M) {
                        const u32x4 v = *(const LAS u32x4*)(sk + rq * SKS + 64 * M + 4 * rt);
                        pl[2 * rd + (M >> 3)][4 * (M & 7)] = v.x; pl[2 * rd + (M >> 3)][4 * (M & 7) + 1] = v.y; pl[2 * rd + (M >> 3)][4 * (M & 7) + 2] = v.z; pl[2 * rd + (M >> 3)][4 * (M & 7) + 3] = v.w;
                    }
                    __syncthreads();
                }
            }
            TE(20, lds, tid); TB(6, lds, tid);
#pragma unroll
            for (int j = 0; j < 4; ++j) transpose32(pl[j]);
            TE(6, lds, tid); TB(7, lds, tid);
            unsigned alive[4];
#pragma unroll
            for (int j = 0; j < 4; ++j) alive[j] = topbits(nv - 32 * j);
            int above = 0; unsigned prefix = 0u; bool done = false, alld = false;
            rs4_row<0>(pl, alive, above, prefix, done, alld, nmr);
            TE(7, lds, tid); TB(8, lds, tid);
            int kcut = 1 << 20;
            if (!__all(done)) {
                const int need = TOPK - above, rt = lane & 15;
                int posk = 0;
#pragma unroll 1
                for (int b2 = 10; b2 >= 0; --b2) {
                    const int tt = posk | (1 << b2);
                    const int R = tt - 4 * rt;
                    const int M = R <= 0 ? 0 : 4 * (R >> 6) + min(R & 63, 4);
                    int c = 0;
#pragma unroll
                    for (int j = 0; j < 4; ++j) c += __popc(alive[j] & topbits(M - 32 * j));
                    const int f = rowsum16(c);
                    if (f < need) posk = tt;
                }
                if (!done) kcut = posk;
            }
            TE(8, lds, tid); TE(4, lds, tid);
            if ((lane & 15) == 0) { thr[32 * sp + 4 * wave + (lane >> 4)] = unfkey(prefix); kcs[32 * sp + 4 * wave + (lane >> 4)] = kcut; }
            __syncthreads();
        }
    }
    mixD_attend(p, b, c, lds, wave_s);
}
__device__ __forceinline__ void mixD_attend(const Params& p, int b, int c, LAS unsigned char* lds, int wave_s) {
    const int tid = tid_now(wave_s);
    const int lane = tid & 63, wave = __builtin_amdgcn_readfirstlane(tid >> 6), r32 = lane & 31, hh = lane >> 5;
    const size_t rowb = (size_t)b * SEQ;
    const int q0 = c * 64, ntile = c + 1;
    LAS float* thr = (LAS float*)(lds + 131072 + 1024);
    LAS int* kcs = (LAS int*)(lds + 131072 + 1280);
    const bool dosel = c >= 4;
    TB(9, lds, tid);
    const int qg = wave >> 2, hd = wave & 3;
    const int pos = q0 + 32 * qg + r32;
    const bf16_t* yq = p.Y() + (rowb + pos) * YP;
    bf16x8_t qf[4];
#pragma unroll
    for (int s = 0; s < 4; ++s) qf[s] = *(const GAS bf16x8_t*)(uintptr_t)(yq + YD_Q + hd * 64 + 16 * s + 8 * hh);
    bf16x8_t iqf[4][2];
    float w[4];
    float T = -INFINITY; int kcut = 1 << 20;
    if (dosel) {
#pragma unroll
        for (int h2 = 0; h2 < 4; ++h2)
#pragma unroll
            for (int s = 0; s < 2; ++s) iqf[h2][s] = *(const GAS bf16x8_t*)(uintptr_t)(yq + YI_Q + h2 * 32 + 16 * s + 8 * hh);
        const unsigned long long ww = *(const GAS unsigned long long*)(uintptr_t)(yq + YI_W);
#pragma unroll
        for (int h2 = 0; h2 < 4; ++h2) w[h2] = __uint_as_float((unsigned)((ww >> (16 * h2)) & 0xffffu) << 16) * (0.17677669529663687f * 0.5f);
        T = thr[32 * qg + r32]; kcut = kcs[32 * qg + r32];
    } else {
#pragma unroll
        for (int h2 = 0; h2 < 4; ++h2) { w[h2] = 0.f;
#pragma unroll
            for (int s = 0; s < 2; ++s)
#pragma unroll
                for (int e = 0; e < 8; ++e) iqf[h2][s][e] = 0; }
    }
    const float c1 = 0.125f * 1.4426950408889634f;
    const float sl2 = exp2f(-(float)(2 * hd + 2)) * 1.4426950408889634f;
    f32x16 o[2];
#pragma unroll
    for (int d = 0; d < 2; ++d)
#pragma unroll
        for (int i = 0; i < 16; ++i) o[d][i] = 0.f;
    float mrun = -1e30f, lrun = 0.f;
    const int npair = (ntile + 1) >> 1;
    const bf16_t* ksrc = p.Y() + (rowb + 8 * wave) * YP + YD_K;
    const bf16_t* vsrc = p.Y() + (rowb + 8 * wave) * YP + YD_V;
    LAS unsigned char* kring = lds;
    LAS unsigned char* vring = lds + 4 * KVL_TILE;
    LAS unsigned* mbuf = (LAS unsigned*)(lds + 8 * KVL_TILE);
    const int mtile = hd >> 1, mkb = hd & 1;
    bf16x8_t ikn0, ikn1;
    {
        const bf16_t* yk = p.Y() + (rowb + 64 * min(mtile, ntile - 1) + 32 * mkb + r32) * YP + YI_K + 8 * hh;
        ikn0 = *(const GAS bf16x8_t*)(uintptr_t)yk; ikn1 = *(const GAS bf16x8_t*)(uintptr_t)(yk + 16);
    }
#define D2_MASK(pq, sl) do { \
        const int tm_ = 2 * (pq) + mtile; unsigned bits_ = 0u; \
        if (tm_ < ntile) { \
            const f32x16 ss_ = idx_scores(ikn0, ikn1, iqf, w); \
            const int kcl_ = kcut - 64 * tm_ - 4 * hh; \
            _Pragma("unroll") for (int i = 0; i < 16; ++i) { const int kci_ = 32 * mkb + (i & 3) + 8 * (i >> 2); \
                const bool sel_ = (ss_[i] > T) || (ss_[i] == T && kci_ <= kcl_); bits_ |= sel_ ? (1u << i) : 0u; } \
        } \
        mbuf[(((sl) * 2 + qg) * 4 + hd) * 64 + lane] = bits_; } while (0)
    asm volatile("" : "+v"(qf[0]), "+v"(qf[1]), "+v"(qf[2]), "+v"(qf[3]));
    __syncthreads();
#pragma unroll
    for (int tt = 0; tt < 2; ++tt) {
        const int t = min(tt, ntile - 1);
        dma_piece(ksrc + (size_t)t * 64 * YP, kring + tt * KVL_TILE + wave * 1024, lane); dma_piece(vsrc + (size_t)t * 64 * YP, vring + tt * KVL_TILE + wave * 1024, lane);
    }
    if (dosel) D2_MASK(0, 0);
    for (int pp = 0; pp < npair; ++pp) {
        const int cur = pp & 1;
        const bool more = pp + 1 < npair;
        TB(12, lds, tid);
        asm volatile("s_waitcnt vmcnt(0) lgkmcnt(0)" ::: "memory"); __builtin_amdgcn_s_barrier(); asm volatile("" ::: "memory");
        TE(12, lds, tid);
        if (more) {
#pragma unroll
            for (int tt = 0; tt < 2; ++tt) {
                const int t = min(2 * (pp + 1) + tt, ntile - 1);
                dma_piece(ksrc + (size_t)t * 64 * YP, kring + ((cur ^ 1) * 2 + tt) * KVL_TILE + wave * 1024, lane); dma_piece(vsrc + (size_t)t * 64 * YP, vring + ((cur ^ 1) * 2 + tt) * KVL_TILE + wave * 1024, lane);
            }
            if (dosel) {
                const bf16_t* yk = p.Y() + (rowb + 64 * min(2 * (pp + 1) + mtile, ntile - 1) + 32 * mkb + r32) * YP + YI_K + 8 * hh;
                ikn0 = *(const GAS bf16x8_t*)(uintptr_t)yk; ikn1 = *(const GAS bf16x8_t*)(uintptr_t)(yk + 16);
            }
        }
        TB(11, lds, tid);
#pragma unroll 1
        for (int tt = 0; tt < 2; ++tt) {
            const int j = 2 * pp + tt;
            if (j < ntile) {
                const LAS unsigned char* kt = kring + (cur * 2 + tt) * KVL_TILE;
                const LAS unsigned char* vt = vring + (cur * 2 + tt) * KVL_TILE;
                const float pl = (float)(pos - 64 * j - 4 * hh);
                const bool diag = (j == c);
                unsigned selb[2] = {0xffffu, 0xffffu};
                if (dosel) { selb[0] = mbuf[((cur * 2 + qg) * 4 + 2 * tt) * 64 + lane]; selb[1] = mbuf[((cur * 2 + qg) * 4 + 2 * tt + 1) * 64 + lane]; }
                f32x16 sc[2];
#pragma unroll
                for (int kb = 0; kb < 2; ++kb) {
                    f32x16 a;
#pragma unroll
                    for (int i = 0; i < 16; ++i) a[i] = 0.f;
#pragma unroll
                    for (int s = 0; s < 4; ++s) {
                        const bf16x8_t kf = *(const LAS bf16x8_t*)(kt + (32 * kb + r32) * 128 + (((2 * s + hh) ^ (r32 & 7)) * 16));
                        a = MFMA32(kf, qf[s], a);
                    }
                    if (!diag) {
#pragma unroll
                        for (int i = 0; i < 16; ++i) { const float kc = (float)(32 * kb + (i & 3) + 8 * (i >> 2)); a[i] = fmaf(a[i], c1, fmaf(sl2, kc, -sl2 * pl)); }
                    } else {
#pragma unroll
                        for (int i = 0; i < 16; ++i) { const float kc = (float)(32 * kb + (i & 3) + 8 * (i >> 2)); a[i] = fmaf(a[i], c1, -sl2 * fabsf(pl - kc)); }
                    }
#pragma unroll
                    for (int i = 0; i < 16; ++i) {
                        const unsigned t = (unsigned)__builtin_amdgcn_sbfe((int)selb[kb], i, 1);
                        a[i] = __uint_as_float((__float_as_uint(a[i]) & t) | (0xff800000u & ~t));
                    }
                    sc[kb] = a;
                }
                float mx = sc[0][0];
#pragma unroll
                for (int i = 1; i < 16; ++i) mx = fmaxf(mx, sc[0][i]);
#pragma unroll
                for (int i = 0; i < 16; ++i) mx = fmaxf(mx, sc[1][i]);
                mx = xmax32(mx);
                const float mnew = fmaxf(mrun, mx);
                const float alpha = __builtin_amdgcn_exp2f(mrun - mnew);
                mrun = mnew;
                float ls4[4] = {0.f, 0.f, 0.f, 0.f};
#pragma unroll
                for (int kb = 0; kb < 2; ++kb)
#pragma unroll
                    for (int i = 0; i < 16; ++i) { const float e = __builtin_amdgcn_exp2f(sc[kb][i] - mnew); sc[kb][i] = e; ls4[i & 3] += e; }
                lrun = lrun * alpha + ((ls4[0] + ls4[1]) + (ls4[2] + ls4[3]));
#pragma unroll
                for (int d = 0; d < 2; ++d)
#pragma unroll
                    for (int i = 0; i < 16; ++i) o[d][i] *= alpha;
#pragma unroll
                for (int ks = 0; ks < 4; ++ks) {
                    const bf16x8_t pf = pack_step(sc[ks >> 1], ks & 1);
#pragma unroll
                    for (int db = 0; db < 2; ++db) o[db] = MFMA32(vt_frag_sw(vt, ks, db, lane), pf, o[db]);
                }
            }
        }
        TE(11, lds, tid);
        TB(10, lds, tid);
        if (more && dosel) D2_MASK(pp + 1, cur ^ 1);
        TE(10, lds, tid);
    }
#undef D2_MASK
    TE(9, lds, tid);
    const float inv = 1.f / xsum32(lrun);
    bf16_t* mrow = p.mix() + (rowb + pos) * DM + 768 + hd * 64;
#pragma unroll
    for (int d = 0; d < 2; ++d)
#pragma unroll
        for (int g = 0; g < 4; ++g) {
            const int d0 = 32 * d + 8 * g + 4 * hh;
            const unsigned long long zz = *(const GAS unsigned long long*)(uintptr_t)(yq + YD_Z + hd * 64 + d0);
            const float z0 = __uint_as_float((unsigned)(zz & 0xffffu) << 16), z1 = __uint_as_float((unsigned)((zz >> 16) & 0xffffu) << 16),
                        z2 = __uint_as_float((unsigned)((zz >> 32) & 0xffffu) << 16), z3 = __uint_as_float((unsigned)((zz >> 48) & 0xffffu) << 16);
            *(GAS unsigned long long*)(uintptr_t)(mrow + d0) = (unsigned long long)cvtpk(o[d][4 * g] * inv * z0, o[d][4 * g + 1] * inv * z1) | ((unsigned long long)cvtpk(o[d][4 * g + 2] * inv * z2, o[d][4 * g + 3] * inv * z3) << 32);
        }
}
__device__ __forceinline__ void ph_mixD(const Params& p, LAS unsigned char* lds, int bid, int nb, int wave_s) {
    for (int i = bid; i < 256; i += nb) {
        const int b = i & 15, cc = i >> 4;
#pragma unroll 1
        for (int k = 0; k < 2; ++k) mixD_unit(p, b, k == 0 ? 31 - cc : cc, lds, wave_s);
    }
}

constexpr int VN_STRIDE = 528;
__device__ __forceinline__ float bflo(unsigned u) { return __uint_as_float(u << 16); }
__device__ __forceinline__ float bfhi(unsigned u) { return __uint_as_float(u & 0xffff0000u); }
__device__ __forceinline__ void mixAB_unit(const Params& p, int l, int b, int n, LAS unsigned char* lds, int tid) {
    const int lane = tid & 63, wave = __builtin_amdgcn_readfirstlane(tid >> 6), r32 = lane & 31, hh = lane >> 5;
    const size_t row0 = (size_t)b * SEQ + 128 * n;
    __syncthreads();
#pragma unroll
    for (int k = 0; k < 8; ++k) {
        const int ch = tid + 512 * k, r = ch >> 5, c16 = ch & 31;
        *(LAS u32x4*)(lds + r * VN_STRIDE + c16 * 16) = *(const GAS u32x4*)(uintptr_t)(p.Y() + (row0 + r) * YP + YB_V + c16 * 8);
    }
    {
        const int cg8 = (tid & 31) * 8, t0 = (tid >> 5) * 8;
        const int pos0 = 128 * n + t0;
        const GAS float* cw = p.sm(SM_CONVW) + l * 768 + cg8;
        float w0[8], w1[8], w2[8], cb[8];
#pragma unroll
        for (int e = 0; e < 8; ++e) { w0[e] = cw[e]; w1[e] = cw[256 + e]; w2[e] = cw[512 + e]; cb[e] = p.sm(SM_CONVB)[l * 256 + cg8 + e]; }
        float um2[8], um1[8];
#pragma unroll
        for (int e = 0; e < 8; ++e) { um2[e] = 0.f; um1[e] = 0.f; }
#pragma unroll
        for (int back = 2; back >= 1; --back) {
            if (pos0 - back >= 0) {
                const bf16_t* yr = p.Y() + (row0 + t0 - back) * YP;
                const u32x4 hc = *(const GAS u32x4*)(uintptr_t)(yr + YA_H + cg8), cc = *(const GAS u32x4*)(uintptr_t)(yr + YA_C + cg8);
                float u[8] = {bflo(hc.x) * bflo(cc.x), bfhi(hc.x) * bfhi(cc.x), bflo(hc.y) * bflo(cc.y), bfhi(hc.y) * bfhi(cc.y),
                              bflo(hc.z) * bflo(cc.z), bfhi(hc.z) * bfhi(cc.z), bflo(hc.w) * bflo(cc.w), bfhi(hc.w) * bfhi(cc.w)};
#pragma unroll
                for (int e = 0; e < 8; ++e) { if (back == 2) um2[e] = u[e]; else um1[e] = u[e]; }
            }
        }
#pragma unroll
        for (int tt = 0; tt < 8; ++tt) {
            const bf16_t* yr = p.Y() + (row0 + t0 + tt) * YP;
            const u32x4 hc = *(const GAS u32x4*)(uintptr_t)(yr + YA_H + cg8), cc = *(const GAS u32x4*)(uintptr_t)(yr + YA_C + cg8), bg = *(const GAS u32x4*)(uintptr_t)(yr + YA_B + cg8), zg = *(const GAS u32x4*)(uintptr_t)(yr + YA_Z + cg8);
            const float u[8] = {bflo(hc.x) * bflo(cc.x), bfhi(hc.x) * bfhi(cc.x), bflo(hc.y) * bflo(cc.y), bfhi(hc.y) * bfhi(cc.y),
                                bflo(hc.z) * bflo(cc.z), bfhi(hc.z) * bfhi(cc.z), bflo(hc.w) * bflo(cc.w), bfhi(hc.w) * bfhi(cc.w)};
            const float bgv[8] = {bflo(bg.x), bfhi(bg.x), bflo(bg.y), bfhi(bg.y), bflo(bg.z), bfhi(bg.z), bflo(bg.w), bfhi(bg.w)};
            const float zgv[8] = {bflo(zg.x), bfhi(zg.x), bflo(zg.y), bfhi(zg.y), bflo(zg.z), bfhi(zg.z), bflo(zg.w), bfhi(zg.w)};
            float ov[8];
#pragma unroll
            for (int e = 0; e < 8; ++e) {
                const float conv = w0[e] * um2[e] + w1[e] * um1[e] + w2[e] * u[e];
                ov[e] = bgv[e] * (conv + cb[e]) * zgv[e];
                um2[e] = um1[e]; um1[e] = u[e];
            }
            u32x4 ow; ow.x = cvtpk(ov[0], ov[1]); ow.y = cvtpk(ov[2], ov[3]); ow.z = cvtpk(ov[4], ov[5]); ow.w = cvtpk(ov[6], ov[7]);
            *(GAS u32x4*)(uintptr_t)(p.mix() + (row0 + t0 + tt) * DM + cg8) = ow;
        }
    }
    __syncthreads();
    {
        const int h = wave >> 1, th = wave & 1;
        const int nks = th == 0 ? 4 : 8;
        f32x16 acc[2][2];
#pragma unroll
        for (int a = 0; a < 2; ++a)
#pragma unroll
            for (int d = 0; d < 2; ++d)
#pragma unroll
                for (int i = 0; i < 16; ++i) acc[a][d][i] = 0.f;
        const bf16_t* wb = p.wsb() + ((size_t)(l * 4 + h) * 128 + 64 * th + r32) * 128 + 8 * hh;
        const int i16 = lane & 15, q = i16 >> 2, pp = i16 & 3, blk = (lane >> 4) & 1;
        const LAS unsigned char* va = lds + (8 * hh + q) * VN_STRIDE + (h * 64 + 16 * blk + 4 * pp) * 2;
        for (int ks = 0; ks < nks; ++ks) {
            bf16x8_t bfr[2], afr[2];
#pragma unroll
            for (int tb = 0; tb < 2; ++tb) bfr[tb] = *(const GAS bf16x8_t*)(uintptr_t)(wb + (size_t)(32 * tb) * 128 + 16 * ks);
#pragma unroll
            for (int db = 0; db < 2; ++db) {
                const LAS unsigned char* a = va + (16 * ks) * VN_STRIDE + (32 * db) * 2;
                const s16x4_t lo = ds_tr16(a), hi = ds_tr16(a + 4 * VN_STRIDE);
                afr[db] = __builtin_shufflevector(lo, hi, 0, 1, 2, 3, 4, 5, 6, 7);
            }
#pragma unroll
            for (int tb = 0; tb < 2; ++tb)
#pragma unroll
                for (int db = 0; db < 2; ++db) acc[tb][db] = MFMA32(afr[db], bfr[tb], acc[tb][db]);
        }
#pragma unroll
        for (int tb = 0; tb < 2; ++tb) {
            const int t = 64 * th + 32 * tb + r32;
            const float bias = p.sm(SM_GMLPB)[(l * 4 + h) * 128 + t];
            const bf16_t* yr = p.Y() + (row0 + t) * YP;
            bf16_t* mr = p.mix() + (row0 + t) * DM + 256 + h * 64;
#pragma unroll
            for (int db = 0; db < 2; ++db)
#pragma unroll
                for (int g = 0; g < 4; ++g) {
                    const int d0 = 32 * db + 8 * g + 4 * hh;
                    const unsigned long long uu = *(const GAS unsigned long long*)(uintptr_t)(yr + YB_U + h * 64 + d0), zz = *(const GAS unsigned long long*)(uintptr_t)(yr + YB_Z + h * 64 + d0);
                    const unsigned u01 = (unsigned)uu, u23 = (unsigned)(uu >> 32), z01 = (unsigned)zz, z23 = (unsigned)(zz >> 32);
                    const float v0 = bflo(u01) * (acc[tb][db][4 * g] + bias) * bflo(z01), v1 = bfhi(u01) * (acc[tb][db][4 * g + 1] + bias) * bfhi(z01);
                    const float v2 = bflo(u23) * (acc[tb][db][4 * g + 2] + bias) * bflo(z23), v3 = bfhi(u23) * (acc[tb][db][4 * g + 3] + bias) * bfhi(z23);
                    *(GAS unsigned long long*)(uintptr_t)(mr + d0) = (unsigned long long)cvtpk(v0, v1) | ((unsigned long long)cvtpk(v2, v3) << 32);
                }
        }
    }
}
__device__ __forceinline__ void ph_mixAB(const Params& p, int l, LAS unsigned char* lds, int bid, int nb, int tid_in) {
    int tid = tid_in; asm volatile("" : "+v"(tid));
    for (int i = bid; i < 256; i += nb) mixAB_unit(p, l, i >> 4, i & 15, lds, tid);
}

constexpr int IX_STRIDE = 528;
__device__ __forceinline__ void ph_ikiw(const Params& p, int l, LAS unsigned char* lds, int bid, int nb, int wave_s) {
    const int tid = tid_now(wave_s);
    const int lane = tid & 63, wave = __builtin_amdgcn_readfirstlane(tid >> 6), r32 = lane & 31, hh = lane >> 5;
    const int tb = wave & 3, cb = wave >> 2;
    LAS unsigned char* xs = lds;
    LAS unsigned char* ws = lds + 128 * IX_STRIDE;
    const bf16_t* wbase = p.wt_in() + (size_t)l * YP * DM;
    __syncthreads();
    { unsigned z = 0u; asm volatile("" : "+v"(z));
      for (int i = tid; i < 28 * (IX_STRIDE / 16); i += NT) *(LAS u32x4*)(ws + 36 * IX_STRIDE + i * 16) = (u32x4){z, z, z, z}; }
    for (int blk = bid; blk < NTOK / 128; blk += nb) {
        f32x16 acc;
#pragma unroll
        for (int i = 0; i < 16; ++i) acc[i] = 0.f;
#pragma unroll 1
        for (int k0 = 0; k0 < DM; k0 += 256) {
            u32x4 xv[8], wv[3];
#pragma unroll
            for (int i = 0; i < 8; ++i) { const int idx = tid + NT * i; xv[i] = *(const GAS u32x4*)(uintptr_t)(p.xb() + (size_t)(128 * blk + (idx >> 5)) * DM + k0 + 8 * (idx & 31)); }
#pragma unroll
            for (int i = 0; i < 3; ++i) {
                const int idx = tid + NT * i, n = idx >> 5;
                if (idx < 36 * 32) wv[i] = *(const GAS u32x4*)(uintptr_t)(wbase + (size_t)(n < 32 ? 3584 + n : 3712 + (n - 32)) * DM + k0 + 8 * (idx & 31));
            }
            __syncthreads();
#pragma unroll
            for (int i = 0; i < 8; ++i) { const int idx = tid + NT * i; *(LAS u32x4*)(xs + (idx >> 5) * IX_STRIDE + (idx & 31) * 16) = xv[i]; }
#pragma unroll
            for (int i = 0; i < 3; ++i) { const int idx = tid + NT * i; if (idx < 36 * 32) *(LAS u32x4*)(ws + (idx >> 5) * IX_STRIDE + (idx & 31) * 16) = wv[i]; }
            __syncthreads();
#pragma unroll
            for (int s = 0; s < 16; ++s) {
                const bf16x8_t a = *(const LAS bf16x8_t*)(ws + (32 * cb + r32) * IX_STRIDE + (16 * s + 8 * hh) * 2);
                const bf16x8_t b = *(const LAS bf16x8_t*)(xs + (32 * tb + r32) * IX_STRIDE + (16 * s + 8 * hh) * 2);
                acc = MFMA32(a, b, acc);
            }
        }
        const int tok = 128 * blk + 32 * tb + r32;
        const GAS f32x4* sp = (const GAS f32x4*)(uintptr_t)(p.ssq() + (size_t)tok * 16);
        const f32x4 s0 = sp[0], s1 = sp[1], s2 = sp[2], s3 = sp[3];
        const float tot = ((s0.x + s0.y) + (s0.z + s0.w)) + ((s1.x + s1.y) + (s1.z + s1.w)) + ((s2.x + s2.y) + (s2.z + s2.w)) + ((s3.x + s3.y) + (s3.z + s3.w));
        const float rstd = rsqrtf(tot * (1.f / DM) + EPS);
        bf16_t* yr = p.Y() + (size_t)tok * YP + YI_K + 32 * cb;
#pragma unroll
        for (int g = 0; g < 4; ++g) {
            const int c0 = 8 * g + 4 * hh;
            if (32 * cb + c0 < 36)
                *(GAS unsigned long long*)(uintptr_t)(yr + c0) = (unsigned long long)cvtpk(acc[4 * g] * rstd, acc[4 * g + 1] * rstd) | ((unsigned long long)cvtpk(acc[4 * g + 2] * rstd, acc[4 * g + 3] * rstd) << 32);
        }
    }
    __syncthreads();
}

__global__ void __launch_bounds__(NT, 2) k_fwd(Params p) {
    extern __shared__ __attribute__((aligned(16))) unsigned char lds[];
    cg::grid_group grid = cg::this_grid();
    LAS unsigned char* l3 = (LAS unsigned char*)lds;
    const int wave_s = __builtin_amdgcn_readfirstlane((int)threadIdx.x >> 6);
    volatile LAS unsigned* bst = (volatile LAS unsigned*)(l3 + LDS_BYTES - 16);
    if (threadIdx.x < 2) bst[threadIdx.x] = 0u;
    __syncthreads();
    const XcdBarrier bar = xcd_barrier_post(p.ctl(), bst);
    if (TSEG >= 0 && threadIdx.x == 0) *(volatile LAS unsigned*)(l3 + TCTR_OFF) = 0u;
    { TB(16, l3, tid_now(wave_s)); ph_prologue(p, l3, tid_now(wave_s)); TE(16, l3, tid_now(wave_s)); }
    if (p.ws == nullptr) grid.sync();
    { TB(18, l3, tid_now(wave_s)); xcd_barrier(bar, tid_now(wave_s)); TE(18, l3, tid_now(wave_s)); }
#pragma unroll 1
    for (int l = 0; l < DEPTH; ++l) {
        Params q = p; asm volatile("" : "+s"(q.ws), "+s"(q.out));
        int bid = blockIdx.x, nb = gridDim.x; asm volatile("" : "+s"(bid), "+s"(nb));
        {
            pg8::Gemm g{q.xb(), q.wt_in() + (size_t)l * YP * DM, NTOK, NGEMM, DM};
            pg8::StaticOrder S; S.init(NTOK, NGEMM, nb, bid);
            EpiIn E{q.ws, l, (LAS float*)(l3 + 131072 + 1024)};
            { TB(13, l3, tid_now(wave_s)); pg8::gemm_phase<EpiIn, pg8::StaticOrder, true, true>(l3, g, S, E, tid_now(wave_s)); TE(13, l3, tid_now(wave_s)); }
        }
        { TB(21, l3, tid_now(wave_s)); ph_ikiw(q, l, l3, bid, nb, wave_s); TE(21, l3, tid_now(wave_s)); }
        { TB(18, l3, tid_now(wave_s)); xcd_barrier(bar, tid_now(wave_s)); TE(18, l3, tid_now(wave_s)); }
        asm volatile("" : "+s"(q.ws), "+s"(bid), "+s"(nb));
        { TB(17, l3, tid_now(wave_s)); ph_mixAB(q, l, l3, bid, nb, tid_now(wave_s)); TE(17, l3, tid_now(wave_s)); }
        __syncthreads();
        { TB(1, l3, tid_now(wave_s)); ph_mixC(q, l, l3, bid, nb, wave_s); TE(1, l3, tid_now(wave_s)); }
        __syncthreads();
        { TB(19, l3, tid_now(wave_s)); ph_mixD(q, l3, bid, nb, wave_s); TE(19, l3, tid_now(wave_s)); }
        __syncthreads();
        { TB(18, l3, tid_now(wave_s)); xcd_barrier(bar, tid_now(wave_s)); TE(18, l3, tid_now(wave_s)); }
        asm volatile("" : "+s"(q.ws), "+s"(q.out), "+s"(bid), "+s"(nb));
        {
            pg8::Gemm g{q.mix(), q.wt_out() + (size_t)l * DM * DM, NTOK, DM, DM};
            pg8::StaticOrder S; S.init(NTOK, DM, nb, bid);
            EpiOut E{l == DEPTH - 1 ? q.out : nullptr, q.ws};
            { TB(15, l3, tid_now(wave_s)); pg8::gemm_phase<EpiOut, pg8::StaticOrder, true, true>(l3, g, S, E, tid_now(wave_s)); TE(15, l3, tid_now(wave_s)); }
        }
        { TB(18, l3, tid_now(wave_s)); xcd_barrier(bar, tid_now(wave_s)); TE(18, l3, tid_now(wave_s)); }
    }
    if (TSEG >= 0 && blockIdx.x == 0 && threadIdx.x == 0) {
        const unsigned long long ticks = 8ull * *(volatile LAS unsigned*)(l3 + TCTR_OFF), t0 = __builtin_amdgcn_s_memrealtime();
        while (__builtin_amdgcn_s_memrealtime() - t0 < ticks) __builtin_amdgcn_s_sleep(32);
    }
}

extern "C" void kernel_launch(void* const* d_in, const int* in_sizes, int n_in, void* d_out, int out_size, void* d_ws, size_t ws_size,
                              hipStream_t stream) {
    static int grid_blocks = 0;
    if (!grid_blocks) {
        int dev = 0, cus = 0, per_cu = 0;
        (void)hipGetDevice(&dev);
        (void)hipDeviceGetAttribute(&cus, hipDeviceAttributeMultiprocessorCount, dev);
        (void)hipFuncSetAttribute((const void*)k_fwd, hipFuncAttributeMaxDynamicSharedMemorySize, LDS_BYTES);
        (void)hipOccupancyMaxActiveBlocksPerMultiprocessor(&per_cu, (const void*)k_fwd, NT, LDS_BYTES);
        if (per_cu < 1) { fprintf(stderr, "kernel_launch: occupancy query returned %d\n", per_cu); per_cu = 1; }
        if (per_cu > 1) per_cu = 1;
        grid_blocks = cus * per_cu;
        if (ws_size < WS_END) fprintf(stderr, "kernel_launch: workspace too small (%zu < %zu)\n", ws_size, (size_t)WS_END);
    }
    (void)hipMemsetAsync(d_ws, 0, 16384, stream);
    Params p{};
    p.x = (const float*)d_in[0]; p.norm_g = (const float*)d_in[1]; p.w_in = (const float*)d_in[2]; p.i_conv_w = (const float*)d_in[3];
    p.i_conv_b = (const float*)d_in[4]; p.i_gmlp_g = (const float*)d_in[5]; p.gmlp_ws = (const float*)d_in[6]; p.i_gmlp_b = (const float*)d_in[7];
    p.i_diff_qg = (const float*)d_in[8]; p.i_diff_kg = (const float*)d_in[9]; p.i_diff_lam = (const float*)d_in[10]; p.i_diff_subg = (const float*)d_in[11];
    p.i_dsa_qg = (const float*)d_in[12]; p.i_dsa_kg = (const float*)d_in[13]; p.w_out = (const float*)d_in[14];
    p.out = (float*)d_out; p.ws = (unsigned char*)d_ws;
    void* args[] = {&p};
    hipError_t e = hipLaunchCooperativeKernel((void*)k_fwd, dim3(grid_blocks), dim3(NT), args, LDS_BYTES, stream);
    if (e != hipSuccess) fprintf(stderr, "cooperative launch failed: %s (grid %d)\n", hipGetErrorString(e), grid_blocks);
}
```

```cpp
#include <hip/hip_runtime.h>
#include <hip/hip_cooperative_groups.h>
#include <math.h>
#include <stdint.h>
#include <stdio.h>
namespace cg = cooperative_groups;
namespace pg8 {
#define PG8_LAS __attribute__((address_space(3)))
typedef unsigned short bf16_t;
typedef short bf16x8 __attribute__((ext_vector_type(8)));
typedef float f32x4 __attribute__((ext_vector_type(4)));
typedef unsigned u32x4 __attribute__((ext_vector_type(4)));
constexpr int BM = 256, BK = 64, HALF = 128, HTB = HALF * BK * 2  , STAGE_BYTES = 8 * HTB, NXCD = 8, WGM = 8;

__host__ __device__ __forceinline__ int lds_byte(int r, int c) { const int st = (r >> 4) * 2 + (c >> 5), rr = r & 15, cc = c & 31, ob = rr * 64 + cc * 2; return st * 1024 + (ob ^ (((ob >> 9) & 1) << 5)); }
__host__ __device__ __forceinline__ void stage_rc(int b, int& R, int& C) { const int st = b / 1024, sb = b % 1024, swz = sb ^ (((sb >> 9) & 1) << 5); R = (st >> 1) * 16 + swz / 64; C = (st & 1) * 32 + (swz % 64) / 2; }
__host__ __device__ __forceinline__ int perm32(int rho) { const int n = rho >> 4, i = rho & 15; return 8 * (i >> 2) + 4 * n + (i & 3); }

struct Unit { int pm, pn; };
struct Gemm { const bf16_t* A; const bf16_t* Bt; int M, N, K; };

struct StaticOrder {
    int nM, nN, nwg, G, c;
    __host__ __device__ void init(int M, int N, int G_, int c_) { nM = M / BM; nN = N / BM; nwg = nM * nN; G = G_; c = c_; }
    __host__ __device__ bool next(int i, Unit& u) const {
        const long L = (long)i * G + c; if (L >= nwg) return false;
        int wgid = (int)L; { const int q = nwg / NXCD, r = nwg % NXCD, xcd = wgid % NXCD, off = wgid / NXCD; wgid = (xcd < r ? xcd * (q + 1) : r * (q + 1) + (xcd - r) * q) + off; }
        const int nig = WGM * nN, gid = wgid / nig, fm = gid * WGM, gsz = (nM - fm) < WGM ? (nM - fm) : WGM;
        u.pm = fm + ((wgid % nig) % gsz); u.pn = (wgid % nig) / gsz; return true;
    }
    __device__ __forceinline__ void a_ready(const Unit&) const {}
    __device__ __forceinline__ void done(const Unit&) const {}
};

__device__ __forceinline__ unsigned cvt_pk_bf16(float lo, float hi) { unsigned r; asm volatile("v_cvt_pk_bf16_f32 %0, %1, %2" : "=v"(r) : "v"(lo), "v"(hi)); return r; }
typedef float f32x2 __attribute__((ext_vector_type(2)));
__device__ __forceinline__ f32x2 gelu_pk(f32x2 v) {
    const f32x2 av = __builtin_elementwise_abs(v), d = av * 0.2316418882f + 1.0f;
    f32x2 t; t.x = __builtin_amdgcn_rcpf(d.x); t.y = __builtin_amdgcn_rcpf(d.y);
    f32x2 q = t * 0.5307027145f + (-0.7265760135f); q = q * t + 0.7107068705f; q = q * t + (-0.142248368f); q = q * t + 0.127414796f; q = q * t;
    const f32x2 s = (v * v) * (-0.72134752044f);
    f32x2 e; e.x = __builtin_amdgcn_exp2f(s.x); e.y = __builtin_amdgcn_exp2f(s.y);
    const f32x2 m = v * (q * e), r = v - m;
    f32x2 o; o.x = v.x < 0.f ? m.x : r.x; o.y = v.y < 0.f ? m.y : r.y; return o;
}
template <class Epi, class Sched, bool ALIGN_EPI = false, bool SP2 = false>
__device__ __forceinline__ void gemm_phase(PG8_LAS unsigned char* lds, const Gemm g, const Sched& S, const Epi& E, int tid_in) {
    int tid_ = tid_in; asm volatile("" : "+v"(tid_));
    const int tid = tid_, wid = __builtin_amdgcn_readfirstlane(tid >> 6), lane = tid & 63, wr = wid >> 2, wc = wid & 3, fr = lane & 15, fq = lane >> 4;
    const int K = g.K, nt = K / BK;
    unsigned voffA[2], voffB[2];
#pragma unroll
    for (int i = 0; i < 2; ++i) { int R, C; stage_rc(tid * 16 + i * 8192, R, C); const int Rb = Epi::PERM ? ((R & ~31) + perm32(R & 31)) : R;
        voffA[i] = (unsigned)(R * K + C) * 2u; voffB[i] = (unsigned)(Rb * K + C) * 2u; }
    const size_t kstep = (size_t)(BK * 2);
    const size_t hstep = (size_t)HALF * K * 2;
    const size_t tstep = 2 * hstep;
    const unsigned ldsw = (unsigned)wid * 1024u;
    const int aoff = lds_byte(wr * 64 + fr, fq * 8), boff = lds_byte(wc * 32 + fr, fq * 8);
#define PG8_SA(b, h) (((b) * 2 + (h)) * HTB)
#define PG8_SB(b, h) ((4 + (b) * 2 + (h)) * HTB)
#define PG8_STAGE(bufoff, gbase, voff) do { _Pragma("unroll") for (int _i = 0; _i < 2; ++_i) \
        __builtin_amdgcn_global_load_lds((const unsigned*)((const char*)(gbase) + (voff)[_i]), (PG8_LAS unsigned*)(lds + (bufoff) + ldsw + _i * 8192), 16, 0, 0); } while (0)
#define PG8_LDA(dst, b, h) do { _Pragma("unroll") for (int m = 0; m < 4; ++m) _Pragma("unroll") for (int k = 0; k < 2; ++k) dst[m][k] = *(const PG8_LAS bf16x8*)(lds + PG8_SA(b, h) + aoff + m * 2048 + k * 1024); } while (0)
#define PG8_LDB(dst, b, h) do { _Pragma("unroll") for (int n = 0; n < 2; ++n) _Pragma("unroll") for (int k = 0; k < 2; ++k) dst[n][k] = *(const PG8_LAS bf16x8*)(lds + PG8_SB(b, h) + boff + n * 2048 + k * 1024); } while (0)
#define PG8_MMA(ai, bj, At, Bt) do { __builtin_amdgcn_s_setprio(1); _Pragma("unroll") for (int m = 0; m < 4; ++m) _Pragma("unroll") for (int n = 0; n < 2; ++n) _Pragma("unroll") for (int k = 0; k < 2; ++k) \
        acc[ai][bj][m][n] = __builtin_amdgcn_mfma_f32_16x16x32_bf16(Bt[n][k], At[m][k], acc[ai][bj][m][n], 0, 0, 0); __builtin_amdgcn_s_setprio(0); } while (0)
#define PG8_WAIT_V(n) asm volatile("s_waitcnt vmcnt(" #n ")" ::: "memory")
#define PG8_WAIT_L(n) asm volatile("s_waitcnt lgkmcnt(" #n ")" ::: "memory")
#define PG8_BAR __builtin_amdgcn_s_barrier()
#define PG8_SCHED __builtin_amdgcn_sched_barrier(0)
    Unit cur, nxt; int ui = 0;
    if (!S.next(0, cur)) return;
    f32x4 acc[2][2][4][2];
#pragma unroll
    for (int a = 0; a < 2; ++a)
#pragma unroll
        for (int b = 0; b < 2; ++b)
#pragma unroll
            for (int m = 0; m < 4; ++m)
#pragma unroll
                for (int n = 0; n < 2; ++n) acc[a][b][m][n] = (f32x4){0.f, 0.f, 0.f, 0.f};
    bf16x8 At[4][2], B0[2][2], B1[2][2];
    const char* cA = (const char*)g.A + (size_t)cur.pm * tstep; const char* cB = (const char*)g.Bt + (size_t)cur.pn * tstep;
    S.a_ready(cur);
    if constexpr (SP2) {
        PG8_STAGE(PG8_SB(0, 0), cB, voffB); PG8_STAGE(PG8_SB(0, 1), cB + hstep, voffB); PG8_STAGE(PG8_SA(0, 0), cA, voffA); PG8_STAGE(PG8_SA(0, 1), cA + hstep, voffA);
        if (wr == 1) PG8_BAR;
        PG8_WAIT_V(2); PG8_BAR;
        PG8_STAGE(PG8_SB(1, 0), cB + kstep, voffB); PG8_STAGE(PG8_SA(1, 0), cA + kstep, voffA); PG8_STAGE(PG8_SB(1, 1), cB + hstep + kstep, voffB);
        PG8_WAIT_V(6); PG8_BAR;
    } else {
        PG8_STAGE(PG8_SB(0, 0), cB, voffB); PG8_STAGE(PG8_SA(0, 0), cA, voffA); PG8_STAGE(PG8_SB(0, 1), cB + hstep, voffB); PG8_STAGE(PG8_SA(0, 1), cA + hstep, voffA);
        if (wr == 1) PG8_BAR;
        PG8_WAIT_V(4); PG8_BAR;
        PG8_STAGE(PG8_SB(1, 0), cB + kstep, voffB); PG8_STAGE(PG8_SA(1, 0), cA + kstep, voffA); PG8_STAGE(PG8_SB(1, 1), cB + hstep + kstep, voffB);
        PG8_WAIT_V(6); PG8_BAR;
    }
    for (;;) {
        const bool has_next = S.next(ui + 1, nxt);
        const char* nA = has_next ? (const char*)g.A + (size_t)nxt.pm * tstep : cA; const char* nB = has_next ? (const char*)g.Bt + (size_t)nxt.pn * tstep : cB;
        for (int t = 0; t < nt; t += 2) {
            const bool last = (t == nt - 2);
            const char* a1 = cA + (size_t)(t + 1) * kstep;
            const char* a2 = last ? nA : cA + (size_t)(t + 2) * kstep; const char* b2 = last ? nB : cB + (size_t)(t + 2) * kstep;
            const char* a3 = a2 + kstep; const char* b3 = b2 + kstep;
            if (last && has_next) S.a_ready(nxt);
            if constexpr (SP2) {
            PG8_LDB(B0, 0, 0); PG8_LDB(B1, 0, 1); PG8_SCHED; PG8_LDA(At, 0, 0); PG8_STAGE(PG8_SA(1, 1), a1 + hstep, voffA);
            PG8_WAIT_V(8); PG8_WAIT_L(0); PG8_BAR; PG8_MMA(0, 0, At, B0); PG8_MMA(0, 1, At, B1); PG8_BAR; PG8_SCHED;
            PG8_LDA(At, 0, 1); PG8_STAGE(PG8_SB(0, 0), b2, voffB); PG8_STAGE(PG8_SB(0, 1), b2 + hstep, voffB); PG8_STAGE(PG8_SA(0, 0), a2, voffA);
            PG8_WAIT_V(8); PG8_WAIT_L(0); PG8_BAR; PG8_MMA(1, 0, At, B0); PG8_MMA(1, 1, At, B1); PG8_BAR; PG8_SCHED;
            PG8_LDB(B0, 1, 0); PG8_LDB(B1, 1, 1); PG8_SCHED; PG8_LDA(At, 1, 0); PG8_STAGE(PG8_SA(0, 1), a2 + hstep, voffA);
            PG8_WAIT_V(8); PG8_WAIT_L(0); PG8_BAR; PG8_MMA(0, 0, At, B0); PG8_MMA(0, 1, At, B1); PG8_BAR; PG8_SCHED;
            PG8_LDA(At, 1, 1); PG8_STAGE(PG8_SB(1, 0), b3, voffB); PG8_STAGE(PG8_SB(1, 1), b3 + hstep, voffB); PG8_STAGE(PG8_SA(1, 0), a3, voffA);
            PG8_WAIT_V(8); PG8_WAIT_L(0); PG8_BAR; PG8_MMA(1, 0, At, B0); PG8_MMA(1, 1, At, B1); PG8_BAR; PG8_SCHED;
            } else {
            PG8_LDB(B0, 0, 0); PG8_SCHED; PG8_LDA(At, 0, 0); PG8_STAGE(PG8_SA(1, 1), a1 + hstep, voffA);
            PG8_WAIT_L(8); PG8_BAR; PG8_WAIT_L(0); PG8_MMA(0, 0, At, B0); PG8_BAR; PG8_SCHED;
            PG8_LDB(B1, 0, 1); PG8_STAGE(PG8_SB(0, 0), b2, voffB);
            PG8_BAR; PG8_WAIT_L(0); PG8_MMA(0, 1, At, B1); PG8_BAR;
            PG8_LDA(At, 0, 1); PG8_STAGE(PG8_SA(0, 0), a2, voffA);
            PG8_BAR; PG8_WAIT_L(0); PG8_MMA(1, 0, At, B0); PG8_BAR; PG8_SCHED;
            PG8_STAGE(PG8_SB(0, 1), b2 + hstep, voffB);
            PG8_WAIT_V(6); PG8_BAR; PG8_MMA(1, 1, At, B1); PG8_BAR;
            PG8_LDB(B0, 1, 0); PG8_SCHED; PG8_LDA(At, 1, 0); PG8_STAGE(PG8_SA(0, 1), a2 + hstep, voffA);
            PG8_WAIT_L(8); PG8_BAR; PG8_WAIT_L(0); PG8_MMA(0, 0, At, B0); PG8_BAR; PG8_SCHED;
            PG8_LDB(B1, 1, 1); PG8_STAGE(PG8_SB(1, 0), b3, voffB);
            PG8_BAR; PG8_WAIT_L(0); PG8_MMA(0, 1, At, B1); PG8_BAR;
            PG8_LDA(At, 1, 1); PG8_STAGE(PG8_SA(1, 0), a3, voffA);
            PG8_BAR; PG8_WAIT_L(0); PG8_MMA(1, 0, At, B0); PG8_BAR; PG8_SCHED;
            PG8_STAGE(PG8_SB(1, 1), b3 + hstep, voffB);
            PG8_WAIT_V(6); PG8_BAR; PG8_MMA(1, 1, At, B1); PG8_BAR;
            }
        }
        if constexpr (ALIGN_EPI) { if (wr == 0) PG8_BAR; }
        if constexpr (!Epi::AFTER_DRAIN) { E(acc, cur, wr, wc, fr, fq); S.done(cur); }
        if (!has_next) break;
#pragma unroll
        for (int a = 0; a < 2; ++a)
#pragma unroll
            for (int b = 0; b < 2; ++b)
#pragma unroll
                for (int m = 0; m < 4; ++m)
#pragma unroll
                    for (int n = 0; n < 2; ++n) acc[a][b][m][n] = (f32x4){0.f, 0.f, 0.f, 0.f};
        cur = nxt; cA = nA; cB = nB; ++ui;
        if constexpr (ALIGN_EPI) { if (wr == 1) PG8_BAR; }
    }
    PG8_WAIT_V(0);
    if constexpr (!ALIGN_EPI) { if (wr == 0) PG8_BAR; }
    PG8_BAR;
    if constexpr (Epi::AFTER_DRAIN) { E.fused(acc, cur, wr, wc, fr, fq, lds, wid, lane); S.done(cur); }
#undef PG8_SA
#undef PG8_SB
#undef PG8_STAGE
#undef PG8_LDA
#undef PG8_LDB
#undef PG8_MMA
#undef PG8_WAIT_V
#undef PG8_WAIT_L
#undef PG8_BAR
#undef PG8_SCHED
}
}

using pg8::bf16_t; using pg8::f32x4; using pg8::u32x4; using pg8::Unit;
#define LAS __attribute__((address_space(3)))
#define GAS __attribute__((address_space(1)))

constexpr int DM = 1024, SEQ = 2048, BATCH = 16, DEPTH = 4, NIN = 3620, NTOK = BATCH * SEQ, YP = 3840;
constexpr float EPS = 1e-6f;
constexpr int O_DZ = 3200, O_DK = 3072, O_DV = 3136;
constexpr int YA_H = 0, YA_B = 256, YA_C = 512, YA_Z = 768, YB_U = 1024, YB_V = 1280, YB_Z = 1536, YC_Q = 1792, YC_K = 2048, YC_V = 2304,
              YC_Z = 2560, YD_Q = 2816, YD_Z = 3072, YD_K = 3328, YD_V = 3392, YI_Q = 3456, YI_K = 3584, YI_W = 3616;
constexpr int TOPK = 256;
constexpr int NGEMM = 3584;
constexpr int NT = 512, NW = 8;
constexpr int LDS_BYTES = 131072 + 4096;

constexpr size_t MiB = 1u << 20;
constexpr size_t WS_WTIN = 1 * MiB;
constexpr size_t WS_WTOUT = WS_WTIN + (size_t)DEPTH * YP * DM * 2;
constexpr size_t WS_SSQ = WS_WTOUT + (size_t)DEPTH * DM * DM * 2;
constexpr size_t WS_XB = WS_SSQ + (size_t)NTOK * 16 * 4;
constexpr size_t WS_Y = WS_XB + (size_t)NTOK * DM * 2;
constexpr size_t WS_MIX = WS_Y + (size_t)NTOK * YP * 2;
constexpr size_t WS_WSB = WS_MIX + (size_t)NTOK * DM * 2;
constexpr size_t WS_END = WS_WSB + (size_t)DEPTH * 4 * 128 * 128 * 2;

constexpr size_t WS_SMALL = 65536;
constexpr int SM_CONVW = 0, SM_CONVB = 3072, SM_GMLPG = 4096, SM_GMLPB = 5120, SM_QG = 7168, SM_KG = 7296, SM_LAM = 7424, SM_SUBG = 7936, SM_DQG = 8960, SM_DKG = 9216, SM_END = 9472;
struct Params {
    const float* x; const float* norm_g; const float* w_in; const float* i_conv_w; const float* i_conv_b;
    const float* i_gmlp_g; const float* gmlp_ws; const float* i_gmlp_b; const float* i_diff_qg; const float* i_diff_kg;
    const float* i_diff_lam; const float* i_diff_subg; const float* i_dsa_qg; const float* i_dsa_kg; const float* w_out;
    float* out; unsigned char* ws;
    __device__ __forceinline__ unsigned* ctl() const { return (unsigned*)ws; }
    __device__ __forceinline__ const GAS float* sm(int off) const { return (const GAS float*)(uintptr_t)(ws + WS_SMALL) + off; }
    __device__ __forceinline__ bf16_t* wt_in() const { return (bf16_t*)(ws + WS_WTIN); }
    __device__ __forceinline__ bf16_t* wt_out() const { return (bf16_t*)(ws + WS_WTOUT); }
    __device__ __forceinline__ float* ssq() const { return (float*)(ws + WS_SSQ); }
    __device__ __forceinline__ bf16_t* xb() const { return (bf16_t*)(ws + WS_XB); }
    __device__ __forceinline__ bf16_t* Y() const { return (bf16_t*)(ws + WS_Y); }
    __device__ __forceinline__ bf16_t* mix() const { return (bf16_t*)(ws + WS_MIX); }
    __device__ __forceinline__ bf16_t* wsb() const { return (bf16_t*)(ws + WS_WSB); }
};

#ifndef TSEG
#define TSEG -1
#endif
constexpr int TCTR_OFF = 131072 + 3072;
#define TB(id, ldsbase, tidv) do { if (TSEG == (id) && blockIdx.x == 0 && (tidv) == 0) *(volatile LAS unsigned long long*)((ldsbase) + TCTR_OFF + 8) = __builtin_amdgcn_s_memrealtime(); } while (0)
#define TE(id, ldsbase, tidv) do { if (TSEG == (id) && blockIdx.x == 0 && (tidv) == 0) { const unsigned _d = (unsigned)(__builtin_amdgcn_s_memrealtime() - *(volatile LAS unsigned long long*)((ldsbase) + TCTR_OFF + 8)); *(volatile LAS unsigned*)((ldsbase) + TCTR_OFF) += _d; } } while (0)
__device__ __forceinline__ unsigned f2bf(float f) { unsigned u = __float_as_uint(f); return (u + 0x7fffu + ((u >> 16) & 1u)) >> 16; }
__device__ __forceinline__ unsigned pk2(float lo, float hi) { return f2bf(lo) | (f2bf(hi) << 16); }
__device__ __forceinline__ float bf2f(bf16_t b) { return __uint_as_float((unsigned)b << 16); }

__device__ __forceinline__ float xsum32(float v) { const auto r = __builtin_amdgcn_permlane32_swap(__float_as_uint(v), __float_as_uint(v), false, false); return __uint_as_float(r[0]) + __uint_as_float(r[1]); }
__device__ __forceinline__ float xmax32(float v) { const auto r = __builtin_amdgcn_permlane32_swap(__float_as_uint(v), __float_as_uint(v), false, false); return fmaxf(__uint_as_float(r[0]), __uint_as_float(r[1])); }
__device__ __forceinline__ int xsum32i(int v) { const auto r = __builtin_amdgcn_permlane32_swap((unsigned)v, (unsigned)v, false, false); return (int)(r[0] + r[1]); }
__device__ __forceinline__ float xsum16(float v) { const auto r = __builtin_amdgcn_permlane16_swap(__float_as_uint(v), __float_as_uint(v), false, false); return __uint_as_float(r[0]) + __uint_as_float(r[1]); }
__device__ __forceinline__ float wave_sum64(float v) {
    v += __uint_as_float(__builtin_amdgcn_update_dpp(0, __float_as_uint(v), 0x128, 0xf, 0xf, true));
    v += __uint_as_float(__builtin_amdgcn_update_dpp(0, __float_as_uint(v), 0x124, 0xf, 0xf, true));
    v += __uint_as_float(__builtin_amdgcn_update_dpp(0, __float_as_uint(v), 0x122, 0xf, 0xf, true));
    v += __uint_as_float(__builtin_amdgcn_update_dpp(0, __float_as_uint(v), 0x121, 0xf, 0xf, true));
    return xsum32(xsum16(v));
}
__device__ __forceinline__ float wave_sum(float v) {
#pragma unroll
    for (int o = 32; o > 0; o >>= 1) v += __shfl_xor(v, o);
    return v;
}
__device__ __forceinline__ float wave_max(float v) {
#pragma unroll
    for (int o = 32; o > 0; o >>= 1) v = fmaxf(v, __shfl_xor(v, o));
    return v;
}
__device__ __forceinline__ int wave_sumi(int v) {
#pragma unroll
    for (int o = 32; o > 0; o >>= 1) v += __shfl_xor(v, o);
    return v;
}
__device__ __forceinline__ float block_sum(float v, float* red) {
    v = wave_sum(v);
    __syncthreads();
    if ((threadIdx.x & 63) == 0) red[threadIdx.x >> 6] = v;
    __syncthreads();
    float s = 0.f;
#pragma unroll
    for (int i = 0; i < NW; ++i) s += red[i];
    return s;
}
__device__ __forceinline__ float block_max(float v, float* red) {
    v = wave_max(v);
    __syncthreads();
    if ((threadIdx.x & 63) == 0) red[threadIdx.x >> 6] = v;
    __syncthreads();
    float s = red[0];
#pragma unroll
    for (int i = 1; i < NW; ++i) s = fmaxf(s, red[i]);
    return s;
}
__device__ __forceinline__ int block_sumi(int v, int* red) {
    v = wave_sumi(v);
    __syncthreads();
    if ((threadIdx.x & 63) == 0) red[threadIdx.x >> 6] = v;
    __syncthreads();
    int s = 0;
#pragma unroll
    for (int i = 0; i < NW; ++i) s += red[i];
    return s;
}
__device__ __forceinline__ int block_excl_scan(int v, int* red, int* tot) {
    const int lane = threadIdx.x & 63, w = threadIdx.x >> 6;
    int inc = v;
#pragma unroll
    for (int o = 1; o < 64; o <<= 1) { int n = __shfl_up(inc, o); if (lane >= o) inc += n; }
    __syncthreads();
    if (lane == 63) red[w] = inc;
    __syncthreads();
    int base = 0, t = 0;
#pragma unroll
    for (int i = 0; i < NW; ++i) { if (i < w) base += red[i]; t += red[i]; }
    *tot = t;
    return base + inc - v;
}

__device__ __forceinline__ int phys2logical(int n) { const int p = n & 255; return (n & ~255) + 64 * ((p >> 5) & 3) + 32 * (p >> 7) + (p & 31); }
__device__ __forceinline__ int logical2orig(int n) {
    if (n < 3072) return n;
    if (n < YD_K) return n - YD_Z + O_DZ;
    if (n < YD_V) return n - YD_K + O_DK;
    if (n < YI_Q) return n - YD_V + O_DV;
    if (n < NIN) return n;
    return -1;
}
__device__ __forceinline__ void transpose_item(const float* W, int ldn, const float* gk, bf16_t* WT, int k0, int r0, int r1, int src, LAS float* scr, int lane) {
    float v[64];
#pragma unroll
    for (int i = 0; i < 64; ++i) v[i] = src >= 0 ? *(const GAS float*)(uintptr_t)(W + (size_t)(k0 + i) * ldn + src) : 0.f;
#pragma unroll
    for (int i = 0; i < 64; ++i) scr[i * 65 + lane] = gk ? v[i] * gk[k0 + i] : v[i];
    asm volatile("s_waitcnt lgkmcnt(0)" ::: "memory");
#pragma unroll
    for (int q = 0; q < 8; ++q) {
        const int id = lane + 64 * q, j = id >> 3, c = id & 7;
        const LAS float* s = scr + (8 * c) * 65 + j;
        u32x4 o; o.x = pk2(s[0 * 65], s[1 * 65]); o.y = pk2(s[2 * 65], s[3 * 65]); o.z = pk2(s[4 * 65], s[5 * 65]); o.w = pk2(s[6 * 65], s[7 * 65]);
        *(GAS u32x4*)(uintptr_t)(WT + (size_t)((j < 32 ? r0 : r1 - 32) + j) * DM + k0 + 8 * c) = o;
    }
    asm volatile("s_waitcnt lgkmcnt(0)" ::: "memory");
}
__device__ __forceinline__ int tid_now(int wave_s) { int lane; asm volatile("v_mbcnt_lo_u32_b32 %0, -1, 0\n\tv_mbcnt_hi_u32_b32 %0, -1, %0" : "=v"(lane)); return wave_s * 64 + lane; }
__device__ __forceinline__ void ph_prologue(const Params& p, LAS unsigned char* lds, int tid_in) {
    int tid = tid_in; asm volatile("" : "+v"(tid));
    const int lane = tid & 63, wave = tid >> 6;
    LAS float* scr = (LAS float*)(lds + wave * 16640);
    const int gw = blockIdx.x * NW + wave, ngw = gridDim.x * NW;
    constexpr int I_IN = DEPTH * 16 * (YP / 64), I_OUT = DEPTH * 16 * (DM / 64);
    TB(22, lds, tid);
    for (int it = gw; it < I_IN + I_OUT; it += ngw) {
        if (it < I_IN) {
            const int l = it / (16 * (YP / 64)), r = it % (16 * (YP / 64)), kb = r / (YP / 64), g = r % (YP / 64), tile = g >> 2, wc = g & 3;
            const int src = logical2orig(256 * tile + 64 * wc + lane);
            transpose_item(p.w_in + (size_t)l * DM * NIN, NIN, p.norm_g + l * DM, p.wt_in() + (size_t)l * YP * DM, kb * 64, 256 * tile + 32 * wc, 256 * tile + 128 + 32 * wc, src, scr, lane);
        } else {
            const int q = it - I_IN, l = q / (16 * (DM / 64)), r = q % (16 * (DM / 64)), kb = r / (DM / 64), g = r % (DM / 64);
            transpose_item(p.w_out + (size_t)l * DM * DM, DM, nullptr, p.wt_out() + (size_t)l * DM * DM, kb * 64, 64 * g, 64 * g + 32, 64 * g + lane, scr, lane);
        }
    }
    {
        float* sm = (float*)(p.ws + WS_SMALL);
        for (int i = blockIdx.x * NT + tid; i < SM_END; i += gridDim.x * NT) {
            float v;
            if (i < SM_CONVB) v = p.i_conv_w[i - SM_CONVW]; else if (i < SM_GMLPG) v = p.i_conv_b[i - SM_CONVB]; else if (i < SM_GMLPB) v = p.i_gmlp_g[i - SM_GMLPG];
            else if (i < SM_QG) v = p.i_gmlp_b[i - SM_GMLPB]; else if (i < SM_KG) v = p.i_diff_qg[i - SM_QG]; else if (i < SM_LAM) v = p.i_diff_kg[i - SM_KG];
            else if (i < SM_SUBG) v = p.i_diff_lam[i - SM_LAM]; else if (i < SM_DQG) v = p.i_diff_subg[i - SM_SUBG]; else if (i < SM_DKG) v = p.i_dsa_qg[i - SM_DQG];
            else v = p.i_dsa_kg[i - SM_DKG];
            sm[i] = v;
        }
    }
    for (int i = (blockIdx.x * NT + tid) * 4; i < DEPTH * 4 * 128 * 128; i += gridDim.x * NT * 4) {
        const f32x4 v = *(const GAS f32x4*)(uintptr_t)(p.gmlp_ws + i);
        *(GAS unsigned long long*)(uintptr_t)(p.wsb() + i) = (unsigned long long)pk2(v.x, v.y) | ((unsigned long long)pk2(v.z, v.w) << 32);
    }
    TE(22, lds, tid);
    TB(23, lds, tid);
    for (int r0 = gw * 4; r0 < NTOK; r0 += ngw * 4) {
        f32x4 v[4][4];
#pragma unroll
        for (int rr = 0; rr < 4; ++rr)
#pragma unroll
            for (int j = 0; j < 4; ++j) v[rr][j] = ((const GAS f32x4*)(uintptr_t)(p.x + (size_t)(r0 + rr) * DM))[lane + 64 * j];
#pragma unroll
        for (int rr = 0; rr < 4; ++rr) {
            GAS unsigned long long* o8 = (GAS unsigned long long*)(uintptr_t)(p.xb() + (size_t)(r0 + rr) * DM) + lane;
            float s = 0.f;
#pragma unroll
            for (int j = 0; j < 4; ++j) {
                const f32x4 q = v[rr][j];
                s += (q.x * q.x + q.y * q.y) + (q.z * q.z + q.w * q.w);
                o8[64 * j] = (unsigned long long)pk2(q.x, q.y) | ((unsigned long long)pk2(q.z, q.w) << 32);
            }
            s = wave_sum64(s);
            if (lane < 16) ((GAS float*)(uintptr_t)p.ssq())[(size_t)(r0 + rr) * 16 + lane] = lane == 0 ? s : 0.f;
        }
    }
    TE(23, lds, tid);
}

__device__ __forceinline__ float silu_f(float v) { return v * __builtin_amdgcn_rcpf(1.f + __builtin_amdgcn_exp2f(-1.4426950408889634f * v)); }
struct EpiIn {
    static constexpr bool PERM = true, AFTER_DRAIN = false;
    unsigned char* ws; int l; LAS float* rs;
    __device__ __forceinline__ void operator()(const f32x4 (&acc)[2][2][4][2], const Unit& u, int wr, int wc, int fr_, int fq_) const {
        int fr = fr_, fq = fq_; asm volatile("" : "+v"(fr), "+v"(fq));
        const int pn = u.pn;
        bf16_t* Y = (bf16_t*)(ws + WS_Y); const float* ssq = (const float*)(ws + WS_SSQ); const float* smb = (const float*)(ws + WS_SMALL);
        const float* gmlp_g = smb + SM_GMLPG + l * 256; const float* qg = smb + SM_QG + l * 32; const float* kg = smb + SM_KG + l * 32;
        const float* dqg = smb + SM_DQG + l * 64; const float* dkg = smb + SM_DKG + l * 64;
        int op = 0; const float* g0 = nullptr; const float* g1 = nullptr;
        if (pn == 3 || pn == 6 || pn == 10 || pn == 12) op = 1;
        else if (pn == 4) op = 2;
        else if (pn == 5) { op = 3; g0 = gmlp_g + 64 * wc + 8 * fq; g1 = g0 + 32; }
        else if (pn == 7) { op = 4; g0 = qg + 8 * fq; g1 = g0; }
        else if (pn == 8) { op = 4; g0 = kg + 8 * fq; g1 = g0; }
        else if (pn == 11) { op = 5; g0 = dqg + 8 * fq; g1 = g0 + 32; }
        else if (pn == 13 && wc == 0) { op = 5; g0 = dkg + 8 * fq; g1 = g0 + 32; }
        float gn[16];
#pragma unroll
        for (int i = 0; i < 16; ++i) gn[i] = 1.f;
        if (op >= 3) {
            const f32x4 a = *(const GAS f32x4*)(uintptr_t)g0, b = *(const GAS f32x4*)(uintptr_t)(g0 + 4), c = *(const GAS f32x4*)(uintptr_t)g1, d = *(const GAS f32x4*)(uintptr_t)(g1 + 4);
            gn[0] = a.x; gn[1] = a.y; gn[2] = a.z; gn[3] = a.w; gn[4] = b.x; gn[5] = b.y; gn[6] = b.z; gn[7] = b.w;
            gn[8] = c.x; gn[9] = c.y; gn[10] = c.z; gn[11] = c.w; gn[12] = d.x; gn[13] = d.y; gn[14] = d.z; gn[15] = d.w;
        }
        const int colb = pn * 256 + 64 * wc + 8 * fq;
        TB(14, (LAS unsigned char*)rs - (131072 + 1024), wr * 256 + wc * 64 + fq * 16 + fr);
        {
            const int t = wr * 256 + wc * 64 + fq * 16 + fr;
            if (t < 256) {
                const f32x4* sp = (const f32x4*)(ssq + (size_t)(u.pm * 256 + t) * 16);
                const f32x4 s0 = sp[0], s1 = sp[1], s2 = sp[2], s3 = sp[3];
                const float tot = ((s0.x + s0.y) + (s0.z + s0.w)) + ((s1.x + s1.y) + (s1.z + s1.w)) + ((s2.x + s2.y) + (s2.z + s2.w)) + ((s3.x + s3.y) + (s3.z + s3.w));
                rs[t] = rsqrtf(tot * (1.f / DM) + EPS);
            }
            asm volatile("s_waitcnt vmcnt(0) lgkmcnt(0)" ::: "memory"); __builtin_amdgcn_s_barrier(); asm volatile("" ::: "memory");
        }
#pragma unroll
        for (int ai = 0; ai < 2; ++ai)
#pragma unroll
            for (int m = 0; m < 4; ++m) {
                const int row = u.pm * 256 + ai * 128 + wr * 64 + m * 16 + fr;
                const float rstd = rs[ai * 128 + wr * 64 + m * 16 + fr];
                float v[16];
#pragma unroll
                for (int bj = 0; bj < 2; ++bj)
#pragma unroll
                    for (int n = 0; n < 2; ++n)
#pragma unroll
                        for (int e = 0; e < 4; ++e) v[bj * 8 + n * 4 + e] = acc[ai][bj][m][n][e] * rstd;
                if (op == 1) {
#pragma unroll
                    for (int i = 0; i < 16; ++i) v[i] = silu_f(v[i]);
                } else if (op == 2 || op == 3) {
#pragma unroll
                    for (int i = 0; i < 16; i += 2) { const pg8::f32x2 r = pg8::gelu_pk((pg8::f32x2){v[i], v[i + 1]}); v[i] = r.x; v[i + 1] = r.y; }
                }
                if (op == 3 || op == 5) {
                    float ss = 0.f;
#pragma unroll
                    for (int i = 0; i < 16; ++i) ss += v[i] * v[i];
                    ss = xsum16(ss); ss = xsum32(ss);
                    const float sc = rsqrtf(ss * (1.f / 64) + EPS);
#pragma unroll
                    for (int i = 0; i < 16; ++i) v[i] *= sc * gn[i];
                } else if (op == 4) {
#pragma unroll
                    for (int bj = 0; bj < 2; ++bj) {
                        float ss = 0.f;
#pragma unroll
                        for (int i = 0; i < 8; ++i) ss += v[bj * 8 + i] * v[bj * 8 + i];
                        ss = xsum16(ss); ss = xsum32(ss);
                        const float sc = rsqrtf(ss * (1.f / 32) + EPS);
#pragma unroll
                        for (int i = 0; i < 8; ++i) v[bj * 8 + i] *= sc * gn[bj * 8 + i];
                    }
                }
                bf16_t* rowp = Y + (size_t)row * YP + colb;
#pragma unroll
                for (int bj = 0; bj < 2; ++bj) {
                    u32x4 w; w.x = pg8::cvt_pk_bf16(v[bj * 8 + 0], v[bj * 8 + 1]); w.y = pg8::cvt_pk_bf16(v[bj * 8 + 2], v[bj * 8 + 3]);
                    w.z = pg8::cvt_pk_bf16(v[bj * 8 + 4], v[bj * 8 + 5]); w.w = pg8::cvt_pk_bf16(v[bj * 8 + 6], v[bj * 8 + 7]);
                    *(GAS u32x4*)(uintptr_t)(rowp + 32 * bj) = w;
                }
            }
        TE(14, (LAS unsigned char*)rs - (131072 + 1024), wr * 256 + wc * 64 + fq * 16 + fr);
    }
};
struct EpiOut {
    static constexpr bool PERM = false, AFTER_DRAIN = false;
    float* xout; unsigned char* ws;
    __device__ __forceinline__ void operator()(const f32x4 (&acc)[2][2][4][2], const Unit& u, int wr, int wc, int fr_, int fq_) const {
        int fr = fr_, fq = fq_; asm volatile("" : "+v"(fr), "+v"(fq));
        const int col0 = u.pn * 256 + wc * 32 + 4 * fq;
        bf16_t* xb = (bf16_t*)(ws + WS_XB); float* ssq = (float*)(ws + WS_SSQ);
#pragma unroll
        for (int ai = 0; ai < 2; ++ai)
#pragma unroll
            for (int m = 0; m < 4; ++m) {
                const int row = u.pm * 256 + ai * 128 + wr * 64 + m * 16 + fr;
                float sq = 0.f;
#pragma unroll
                for (int bj = 0; bj < 2; ++bj)
#pragma unroll
                    for (int n = 0; n < 2; ++n) {
                        const size_t off = (size_t)row * DM + col0 + bj * 128 + n * 16;
                        const unsigned long long xo = *(const GAS unsigned long long*)(uintptr_t)(xb + off);
                        f32x4 v = acc[ai][bj][m][n];
                        v.x += __uint_as_float((unsigned)xo << 16); v.y += __uint_as_float((unsigned)xo & 0xffff0000u);
                        v.z += __uint_as_float((unsigned)(xo >> 32) << 16); v.w += __uint_as_float((unsigned)(xo >> 32) & 0xffff0000u);
                        sq += (v.x * v.x + v.y * v.y) + (v.z * v.z + v.w * v.w);
                        if (xout) *(GAS f32x4*)(uintptr_t)(xout + off) = v;
                        else *(GAS unsigned long long*)(uintptr_t)(xb + off) = (unsigned long long)pg8::cvt_pk_bf16(v.x, v.y) | ((unsigned long long)pg8::cvt_pk_bf16(v.z, v.w) << 32);
                    }
                sq = xsum16(sq); sq = xsum32(sq);
                if (fq == 0) ssq[(size_t)row * 16 + u.pn * 4 + wc] = sq;
                if (m == 3) asm volatile("" ::: "memory");
            }
    }
};
#define XB_TMO      128
#define XB_XCNT(j)  (256  + 64 * (j))
#define XB_XSUB(j)  (1280 + 64 * (j))
#define XB_XGEN(j)  (2304 + 64 * (j))
#define XB_TOP      3328
#define XB_TOPGEN   3392
#define XCD_BAR_WORDS 3456
#define XB_SPIN_CAP (1u << 18)

__device__ __forceinline__ unsigned xb_ld(unsigned* p)              { return __hip_atomic_load(p, __ATOMIC_RELAXED, __HIP_MEMORY_SCOPE_AGENT); }
__device__ __forceinline__ unsigned xb_add(unsigned* p, unsigned v) { return __hip_atomic_fetch_add(p, v, __ATOMIC_RELAXED, __HIP_MEMORY_SCOPE_AGENT); }
__device__ __forceinline__ unsigned xb_xcc_id() { return (unsigned)__builtin_amdgcn_s_getreg((3 << 11) | 20) & 0xFu; }
#define XB_SPIN(cond, bar) do { unsigned _sp = 0; while (cond) { __builtin_amdgcn_s_sleep(1); \
    if ((++_sp & 255u) == 0u) { if (xb_ld(&(bar)[XB_TMO])) break; if (_sp > XB_SPIN_CAP) { atomicAdd(&(bar)[XB_TMO], 1u); break; } } } } while (0)

struct XcdBarrier {
    unsigned* bar; unsigned x;
    volatile LAS unsigned* st;
};

__device__ __forceinline__ XcdBarrier xcd_barrier_post(unsigned* bar, volatile LAS unsigned* st) {
    XcdBarrier b; b.bar = bar; b.x = xb_xcc_id(); b.st = st;
    if (threadIdx.x == 0) (void)xb_add(&bar[XB_XCNT(b.x)], 1u);
    return b;
}
__device__ __forceinline__ void xcd_barrier_complete(unsigned* bar, unsigned x, unsigned& nloc, unsigned& nx) {
    const unsigned G = gridDim.x * gridDim.y * gridDim.z;
    unsigned sum, cnt, mine, sp = 0u;
    for (;;) {
        sum = 0u; cnt = 0u; mine = 0u;
#pragma unroll
        for (unsigned j = 0; j < 16; ++j) { const unsigned c = xb_ld(&bar[XB_XCNT(j)]); sum += c; cnt += (c > 0u) ? 1u : 0u; mine = (j == x) ? c : mine; }
        if (sum == G) break;
        __builtin_amdgcn_s_sleep(1);
        if ((++sp & 255u) == 0u) { if (xb_ld(&bar[XB_TMO])) break; if (sp > XB_SPIN_CAP) { atomicAdd(&bar[XB_TMO], 1u); break; } }
    }
    nloc = mine > 0u ? mine : 1u; nx = cnt > 0u ? cnt : 1u;
}

__device__ __forceinline__ void xcd_barrier(const XcdBarrier& b, int tid_in) {
    asm volatile("s_waitcnt vmcnt(0)" ::: "memory");
    __syncthreads();
    int t0_ = tid_in; asm volatile("" : "+v"(t0_));
    if (t0_ == 0) {
        unsigned* bar = b.bar; unsigned bx = b.x; asm volatile("" : "+s"(bar), "+s"(bx));
        __builtin_amdgcn_s_waitcnt(0);
        unsigned nloc = b.st[0], nx = b.st[1];
        if (nloc == 0u) { xcd_barrier_complete(bar, bx, nloc, nx); b.st[0] = nloc; b.st[1] = nx; }
        const unsigned old = xb_add(&bar[XB_XSUB(bx)], 1u);
        const unsigned gen = old / nloc;
        if (old + 1u == (gen + 1u) * nloc) {
            __builtin_amdgcn_fence(__ATOMIC_RELEASE, "agent");
            asm volatile("s_waitcnt vmcnt(0)" ::: "memory");
            const unsigned og = xb_add(&bar[XB_TOP], 1u);
            const unsigned tg = og / nx;
            if (og + 1u == (tg + 1u) * nx) xb_add(&bar[XB_TOPGEN], 1u);
            else XB_SPIN(xb_ld(&bar[XB_TOPGEN]) == tg, bar);
            __builtin_amdgcn_fence(__ATOMIC_ACQUIRE, "agent");
            xb_add(&bar[XB_XGEN(bx)], 1u);
            asm volatile("s_waitcnt vmcnt(0)" ::: "memory");
        } else {
            XB_SPIN(xb_ld(&bar[XB_XGEN(bx)]) == gen, bar);
            __builtin_amdgcn_fence(__ATOMIC_ACQUIRE, "agent");
            asm volatile("s_waitcnt vmcnt(0)" ::: "memory");
        }
    }
    __syncthreads();
}

typedef short bf16x8_t __attribute__((ext_vector_type(8)));
typedef short s16x4_t __attribute__((ext_vector_type(4)));
typedef float f32x16 __attribute__((ext_vector_type(16)));
typedef float f32x2_t __attribute__((ext_vector_type(2)));
typedef __bf16 bf16x2_t __attribute__((ext_vector_type(2)));
#define MFMA32(a, b, c) __builtin_amdgcn_mfma_f32_32x32x16_bf16((a), (b), (c), 0, 0, 0)
__device__ __forceinline__ unsigned cvtpk(float lo, float hi) { f32x2_t v = {lo, hi}; bf16x2_t b = __builtin_convertvector(v, bf16x2_t); return __builtin_bit_cast(unsigned, b); }
__device__ __forceinline__ s16x4_t ds_tr16(const LAS unsigned char* p) { return __builtin_bit_cast(s16x4_t, __builtin_amdgcn_ds_read_tr16_b64_v4i16((LAS s16x4_t*)p)); }
__device__ __forceinline__ bf16x8_t pack_step(const f32x16& x, int s) {
    u32x4 p; p.x = cvtpk(x[8 * s], x[8 * s + 1]); p.y = cvtpk(x[8 * s + 2], x[8 * s + 3]); p.z = cvtpk(x[8 * s + 4], x[8 * s + 5]); p.w = cvtpk(x[8 * s + 6], x[8 * s + 7]);
    return __builtin_bit_cast(bf16x8_t, p);
}
constexpr int KV_STRIDE = 144;
constexpr int KV_TILE = 64 * KV_STRIDE;
__device__ __forceinline__ bf16x8_t vt_frag(const LAS unsigned char* vtile, int ks, int db, int lane) {
    const int i16 = lane & 15, q = i16 >> 2, pp = i16 & 3, blk = (lane >> 4) & 1, hh = lane >> 5;
    const LAS unsigned char* a = vtile + (16 * ks + 4 * hh + q) * KV_STRIDE + (32 * db + 16 * blk + 4 * pp) * 2;
    const s16x4_t lo = ds_tr16(a), hi = ds_tr16(a + 8 * KV_STRIDE);
    return __builtin_shufflevector(lo, hi, 0, 1, 2, 3, 4, 5, 6, 7);
}

constexpr int KVL_TILE = 64 * 128;
__device__ __forceinline__ void dma_piece(const bf16_t* src_row0, LAS unsigned char* dst, int lane) {
    const bf16_t* g = src_row0 + (size_t)(lane >> 3) * YP + (((lane & 7) ^ (lane >> 3)) * 8);
    const unsigned d = (unsigned)__builtin_amdgcn_readfirstlane((int)(unsigned)(size_t)dst);
    unsigned keep;
    asm volatile("s_mov_b32 %0, m0\n\ts_mov_b32 m0, %2\n\ts_nop 0\n\tglobal_load_lds_dwordx4 %1, off\n\ts_mov_b32 m0, %0" : "=&s"(keep) : "v"(g), "s"(d) : "memory");
}
__device__ __forceinline__ bf16x8_t vt_frag_sw(const LAS unsigned char* vtile, int ks, int db, int lane) {
    const int i16 = lane & 15, q = i16 >> 2, pp = i16 & 3, blk = (lane >> 4) & 1, hh = lane >> 5;
    const int row = 16 * ks + 4 * hh + q, ch = 4 * db + 2 * blk + (pp >> 1);
    const LAS unsigned char* a = vtile + row * 128 + ((ch ^ (row & 7)) * 16) + (pp & 1) * 8;
    const s16x4_t lo = ds_tr16(a), hi = ds_tr16(a + 8 * 128);
    return __builtin_shufflevector(lo, hi, 0, 1, 2, 3, 4, 5, 6, 7);
}

__device__ __forceinline__ void mixC_unit(const Params& p, int l, int b, int h, int qt, LAS unsigned char* lds, int wave_s) {
    const int tid = tid_now(wave_s);
    volatile LAS float* pc = (volatile LAS float*)(lds + 131072 + 2048);
    const float mfix = pc[0];
    const int lane = tid & 63, wave = __builtin_amdgcn_readfirstlane(tid >> 6), r32 = lane & 31, hh = lane >> 5;
    const size_t rowb = (size_t)b * SEQ;
    const int q0 = qt * 256 + wave * 32;
    const int cw = (q0 >> 6);
    const int jmax = 4 * qt + 3;
    const int pos = q0 + r32;
    const bf16_t* yq = p.Y() + (rowb + pos) * YP;
    bf16x8_t qf[2][2];
#pragma unroll
    for (int c = 0; c < 2; ++c)
#pragma unroll
        for (int s = 0; s < 2; ++s) qf[c][s] = *(const GAS bf16x8_t*)(uintptr_t)(yq + YC_Q + h * 64 + c * 32 + 16 * s + 8 * hh);
    const float c1 = 0.17677669529663687f * 1.4426950408889634f;
    const float sl2 = exp2f(-(float)(2 * h + 1)) * 1.4426950408889634f;
    f32x16 o[2][2];
#pragma unroll
    for (int c = 0; c < 2; ++c)
#pragma unroll
        for (int d = 0; d < 2; ++d)
#pragma unroll
            for (int i = 0; i < 16; ++i) o[c][d][i] = 0.f;
    float lrun[2] = {0.f, 0.f};
    const bf16_t* ksrc = p.Y() + (rowb + 8 * wave) * YP + YC_K + h * 64;
    const bf16_t* vsrc = p.Y() + (rowb + 8 * wave) * YP + YC_V + h * 64;
    LAS unsigned char* kring = lds;
    LAS unsigned char* vring = lds + 6 * KVL_TILE;
    asm volatile("" : "+v"(qf[0][0]), "+v"(qf[0][1]), "+v"(qf[1][0]), "+v"(qf[1][1]));
    const float mfix_r = mfix; asm volatile("" :: "v"(mfix_r));
    asm volatile("s_waitcnt lgkmcnt(0)" ::: "memory"); __builtin_amdgcn_s_barrier(); asm volatile("" ::: "memory");
#pragma unroll
    for (int t = 0; t < 4; ++t) { dma_piece(ksrc + (size_t)t * 64 * YP, kring + t * KVL_TILE + wave * 1024, lane); dma_piece(vsrc + (size_t)t * 64 * YP, vring + t * KVL_TILE + wave * 1024, lane); }
    int slot = 0, slot2 = 4;
    for (int j = 0; j <= jmax; ++j) {
        if ((j & 1) == 0) {
            TB(3, lds, tid);
            if (j + 2 <= jmax) asm volatile("s_waitcnt vmcnt(4)" ::: "memory"); else asm volatile("s_waitcnt vmcnt(0)" ::: "memory");
            __builtin_amdgcn_s_barrier(); asm volatile("" ::: "memory");
            if (j + 4 <= jmax) {
#pragma unroll
                for (int t = 0; t < 2; ++t) {
                    const int sl = slot2 + t >= 6 ? slot2 + t - 6 : slot2 + t;
                    dma_piece(ksrc + (size_t)(j + 4 + t) * 64 * YP, kring + sl * KVL_TILE + wave * 1024, lane); dma_piece(vsrc + (size_t)(j + 4 + t) * 64 * YP, vring + sl * KVL_TILE + wave * 1024, lane);
                }
            }
            TE(3, lds, tid);
        }
        TB(2, lds, tid);
        if (j <= cw) {
            const LAS unsigned char* kt = kring + slot * KVL_TILE;
            const LAS unsigned char* vt = vring + slot * KVL_TILE;
            const float pl = (float)(pos - 64 * j - 4 * hh);
            const bool diag = (j == cw);
#pragma unroll
            for (int c = 0; c < 2; ++c) {
                f32x16 sc[2];
#pragma unroll
                for (int kb = 0; kb < 2; ++kb) {
                    f32x16 a;
#pragma unroll
                    for (int i = 0; i < 16; ++i) a[i] = 0.f;
#pragma unroll
                    for (int s = 0; s < 2; ++s) {
                        const bf16x8_t kf = *(const LAS bf16x8_t*)(kt + (32 * kb + r32) * 128 + (((4 * c + 2 * s + hh) ^ (r32 & 7)) * 16));
                        a = MFMA32(kf, qf[c][s], a);
                    }
                    sc[kb] = a;
                }
                float ls4[4] = {0.f, 0.f, 0.f, 0.f};
                if (!diag) {
                    const float rt = -sl2 * pl - mfix;
                    const f32x2_t d01 = {0.f, sl2}, d23 = {2.f * sl2, 3.f * sl2}, c1v = {c1, c1};
                    f32x2_t lsv0 = {0.f, 0.f}, lsv1 = {0.f, 0.f};
#pragma unroll
                    for (int kb = 0; kb < 2; ++kb)
#pragma unroll
                        for (int g = 0; g < 4; ++g) {
                            const float bs = fmaf(sl2, (float)(32 * kb + 8 * g), rt);
                            const f32x2_t bv = {bs, bs};
                            const f32x2_t t01 = (f32x2_t){sc[kb][4 * g], sc[kb][4 * g + 1]} * c1v + (bv + d01);
                            const f32x2_t t23 = (f32x2_t){sc[kb][4 * g + 2], sc[kb][4 * g + 3]} * c1v + (bv + d23);
                            const f32x2_t e01 = {__builtin_amdgcn_exp2f(t01.x), __builtin_amdgcn_exp2f(t01.y)}, e23 = {__builtin_amdgcn_exp2f(t23.x), __builtin_amdgcn_exp2f(t23.y)};
                            sc[kb][4 * g] = e01.x; sc[kb][4 * g + 1] = e01.y; sc[kb][4 * g + 2] = e23.x; sc[kb][4 * g + 3] = e23.y;
                            lsv0 += e01; lsv1 += e23;
                        }
                    ls4[0] = lsv0.x; ls4[1] = lsv0.y; ls4[2] = lsv1.x; ls4[3] = lsv1.y;
                } else {
#pragma unroll
                    for (int kb = 0; kb < 2; ++kb)
#pragma unroll
                        for (int i = 0; i < 16; ++i) {
                            const float kc = (float)(32 * kb + (i & 3) + 8 * (i >> 2));
                            const float e = __builtin_amdgcn_exp2f(fmaf(sc[kb][i], c1, fmaf(-sl2, fabsf(pl - kc), -mfix)));
                            sc[kb][i] = e; ls4[i & 3] += e;
                        }
                }
                lrun[c] += (ls4[0] + ls4[1]) + (ls4[2] + ls4[3]);
#pragma unroll
                for (int ks = 0; ks < 4; ++ks) {
                    const bf16x8_t pf = pack_step(sc[ks >> 1], ks & 1);
#pragma unroll
                    for (int db = 0; db < 2; ++db) o[c][db] = MFMA32(vt_frag_sw(vt, ks, db, lane), pf, o[c][db]);
                }
            }
        }
        TE(2, lds, tid);
        slot = slot == 5 ? 0 : slot + 1; slot2 = slot2 == 5 ? 0 : slot2 + 1;
    }
    const float lam = pc[1], oml = pc[2];
    const int tid2 = tid_now(wave_s), lane2 = tid2 & 63, r32e = lane2 & 31, hhe = lane2 >> 5;
    const int pose = qt * 256 + wave * 32 + r32e;
    const bf16_t* yqe = p.Y() + (rowb + pose) * YP;
    const float l1 = xsum32(lrun[0]), l2 = xsum32(lrun[1]);
    const float i1 = 1.f / l1, i2 = lam / l2;
    float ss = 0.f;
#pragma unroll
    for (int d = 0; d < 2; ++d)
#pragma unroll
        for (int i = 0; i < 16; ++i) { const float v = o[0][d][i] * i1 - o[1][d][i] * i2; o[0][d][i] = v; ss += v * v; }
    ss = xsum32(ss);
    const float rn = rsqrtf(ss * (1.f / 64) + EPS) * oml;
    const GAS float* sg = p.sm(SM_SUBG) + l * 256 + h * 64;
    bf16_t* mrow = p.mix() + (rowb + pose) * DM + 512 + h * 64;
#pragma unroll
    for (int d = 0; d < 2; ++d)
#pragma unroll
        for (int g = 0; g < 4; ++g) {
            const int d0 = 32 * d + 8 * g + 4 * hhe;
            const f32x4 gv = *(const GAS f32x4*)(uintptr_t)(sg + d0);
            const unsigned long long zz = *(const GAS unsigned long long*)(uintptr_t)(yqe + YC_Z + h * 64 + d0);
            const float z0 = __uint_as_float((unsigned)(zz & 0xffffu) << 16), z1 = __uint_as_float((unsigned)((zz >> 16) & 0xffffu) << 16),
                        z2 = __uint_as_float((unsigned)((zz >> 32) & 0xffffu) << 16), z3 = __uint_as_float((unsigned)((zz >> 48) & 0xffffu) << 16);
            const float v0 = o[0][d][4 * g] * rn * gv.x * z0, v1 = o[0][d][4 * g + 1] * rn * gv.y * z1, v2 = o[0][d][4 * g + 2] * rn * gv.z * z2, v3 = o[0][d][4 * g + 3] * rn * gv.w * z3;
            *(GAS unsigned long long*)(uintptr_t)(mrow + d0) = (unsigned long long)cvtpk(v0, v1) | ((unsigned long long)cvtpk(v2, v3) << 32);
        }
}
__device__ __forceinline__ void ph_mixC(const Params& p, int l, LAS unsigned char* lds, int bid, int nb, int wave_s) {
    {
        const float lam_init = l == 0 ? 0.200000001f : l == 1 ? 0.355509068f : l == 2 ? 0.470713018f : 0.556058204f;
        const GAS float* lp = p.sm(SM_LAM) + l * 128;
        float d1 = 0.f, d2 = 0.f;
        for (int i = 0; i < 32; ++i) { d1 += lp[i] * lp[32 + i]; d2 += lp[64 + i] * lp[96 + i]; }
        float gq = 0.f, gk = 0.f;
        for (int i = 0; i < 32; ++i) { gq = fmaxf(gq, fabsf(p.sm(SM_QG)[l * 32 + i])); gk = fmaxf(gk, fabsf(p.sm(SM_KG)[l * 32 + i])); }
        volatile LAS float* pc = (volatile LAS float*)(lds + 131072 + 2048);
        if (tid_now(wave_s) == 0) {
            pc[0] = 0.17677669529663687f * 1.4426950408889634f * 32.f * gq * gk * 1.02f;
            pc[1] = expf(d1) - expf(d2) + lam_init;
            pc[2] = 1.f - lam_init;
        }
        __syncthreads();
    }
    for (int i = bid; i < 256; i += nb) {
#pragma unroll 1
        for (int k = 0; k < 2; ++k) {
            const int id = k == 0 ? i : 511 - i;
            const int qt = id < 256 ? 7 - (id >> 6) : 3 - ((id - 256) >> 6), bh = id & 63;
            mixC_unit(p, l, bh >> 2, bh & 3, qt, lds, wave_s);
        }
    }
}

constexpr int SC_STRIDE = 2052;
constexpr int SC_BYTES = 16 * SC_STRIDE * 4;
constexpr int IK_STRIDE = 80, IK_TILE = 64 * IK_STRIDE;
__device__ __forceinline__ unsigned fkey(float f) { const unsigned u = __float_as_uint(f); return (u & 0x80000000u) ? ~u : (u | 0x80000000u); }
__device__ __forceinline__ float unfkey(unsigned k) { return __uint_as_float((k & 0x80000000u) ? (k & 0x7fffffffu) : ~k); }
__device__ __forceinline__ f32x16 idx_scores(const bf16x8_t ik0, const bf16x8_t ik1, const bf16x8_t (&iqf)[4][2], const float (&w)[4]) {
    f32x16 sc;
#pragma unroll
    for (int i = 0; i < 16; ++i) sc[i] = 0.f;
#pragma unroll
    for (int hd = 0; hd < 4; ++hd) {
        f32x16 a;
#pragma unroll
        for (int i = 0; i < 16; ++i) a[i] = 0.f;
        a = MFMA32(ik0, iqf[hd][0], a);
        a = MFMA32(ik1, iqf[hd][1], a);
#pragma unroll
        for (int i = 0; i < 16; ++i) sc[i] = fmaf(w[hd], fmaxf(a[i], 0.f), sc[i]);
    }
#pragma unroll
    for (int i = 0; i < 16; ++i) sc[i] = sc[i] + 0.f;
    return sc;
}
__device__ __forceinline__ void transpose32(unsigned (&a)[32]) {
#pragma unroll
    for (int s = 0; s < 5; ++s) {
        const int j = 16 >> s;
        const unsigned mk = j == 16 ? 0x0000ffffu : j == 8 ? 0x00ff00ffu : j == 4 ? 0x0f0f0f0fu : j == 2 ? 0x33333333u : 0x55555555u;
#pragma unroll
        for (int k = 0; k < 32; ++k)
            if ((k & j) == 0) { const unsigned t = (a[k] ^ (a[k + j] >> j)) & mk; a[k] ^= t; a[k + j] ^= t << j; asm volatile("" : "+v"(a[k]), "+v"(a[k + j])); }
    }
}
__device__ __forceinline__ int rowsum16(int v) {
    v += __builtin_amdgcn_update_dpp(0, v, 0x128, 0xf, 0xf, true);
    v += __builtin_amdgcn_update_dpp(0, v, 0x124, 0xf, 0xf, true);
    v += __builtin_amdgcn_update_dpp(0, v, 0x122, 0xf, 0xf, true);
    v += __builtin_amdgcn_update_dpp(0, v, 0x121, 0xf, 0xf, true);
    return v;
}
__device__ __forceinline__ unsigned topbits(int ne) { return ne <= 0 ? 0u : ne >= 32 ? 0xffffffffu : (0xffffffffu << (32 - ne)); }
template <int ST>
__device__ __forceinline__ void rs4_row(const unsigned (&pl)[4][32], unsigned (&alive)[4], int& above, unsigned& prefix, bool& done, bool& alld, int nmr) {
    if (!alld) {
        int c11 = 0, c10 = 0, c01 = 0;
#pragma unroll
        for (int j = 0; j < 4; ++j)
            if (j < nmr) {
                const unsigned p1 = pl[j][2 * ST], p0 = pl[j][2 * ST + 1], a1 = alive[j] & p1, a0 = alive[j] & ~p1;
                c11 += __popc(a1 & p0); c10 += __popc(a1 & ~p0); c01 += __popc(a0 & p0);
            }
        const int s01 = rowsum16(c11 | (c10 << 16)), s2 = rowsum16(c01);
        if (!done) {
            const int t11 = above + (s01 & 0xffff), t10 = t11 + (int)((unsigned)s01 >> 16), t01 = t10 + s2;
            const int dg = t11 >= TOPK ? 3 : t10 >= TOPK ? 2 : t01 >= TOPK ? 1 : 0;
            const int tsel = dg == 3 ? t11 : dg == 2 ? t10 : t01;
            prefix |= (unsigned)dg << (30 - 2 * ST);
            above = dg == 3 ? above : dg == 2 ? t11 : dg == 1 ? t10 : t01;
#pragma unroll
            for (int j = 0; j < 4; ++j)
                if (j < nmr) {
                    const unsigned p1 = pl[j][2 * ST], p0 = pl[j][2 * ST + 1];
                    alive[j] &= ((dg & 2) ? p1 : ~p1) & ((dg & 1) ? p0 : ~p0);
                }
            if (dg != 0 && tsel == TOPK) done = true;
        }
        alld = __all(done);
    }
    if constexpr (ST < 15) rs4_row<ST + 1>(pl, alive, above, prefix, done, alld, nmr);
}
__device__ __forceinline__ void mixD_attend(const Params& p, int b, int c, LAS unsigned char* lds, int wave_s);
__device__ __forceinline__ void mixD_unit(const Params& p, int b, int c, LAS unsigned char* lds, int wave_s) {
    const int tid = tid_now(wave_s);
    const int lane = tid & 63, wave = __builtin_amdgcn_readfirstlane(tid >> 6), r32 = lane & 31, hh = lane >> 5;
    const size_t rowb = (size_t)b * SEQ;
    const int q0 = c * 64, ntile = c + 1;
    LAS float* thr = (LAS float*)(lds + 131072 + 1024);
    LAS int* kcs = (LAS int*)(lds + 131072 + 1280);
    const bool dosel = c >= 4;
    __syncthreads();
    if (dosel) {
        constexpr int SKS = 1028;
        LAS unsigned* sk = (LAS unsigned*)lds;
        const int nblk = 2 * ntile;
        const int nbw = (nblk - wave + 7) >> 3;
        const int nv = 4 * ntile;
        const int nmr = (nv + 31) >> 5;
#pragma unroll 1
        for (int sp = 0; sp < 2; ++sp) {
            TB(4, lds, tid); TB(5, lds, tid);
            unsigned kr[4][32];
            unsigned zopq = 0u; asm volatile("" : "+v"(zopq));
            {
                const bf16_t* yq1 = p.Y() + (rowb + q0 + 32 * sp + r32) * YP;
                bf16x8_t iqf[4][2];
#pragma unroll
                for (int hd = 0; hd < 4; ++hd)
#pragma unroll
                    for (int s = 0; s < 2; ++s) iqf[hd][s] = *(const GAS bf16x8_t*)(uintptr_t)(yq1 + YI_Q + hd * 32 + 16 * s + 8 * hh);
                float w[4];
                const unsigned long long ww = *(const GAS unsigned long long*)(uintptr_t)(yq1 + YI_W);
#pragma unroll
                for (int hd = 0; hd < 4; ++hd) w[hd] = __uint_as_float((unsigned)((ww >> (16 * hd)) & 0xffffu) << 16) * (0.17677669529663687f * 0.5f);
#pragma unroll
                for (int g = 0; g < 2; ++g) {
                    bf16x8_t ik[4][2];
#pragma unroll
                    for (int i = 0; i < 4; ++i) {
                        const int kb = 4 * g + i < nbw ? wave + 8 * (4 * g + i) : wave;
                        const bf16_t* yk = p.Y() + (rowb + 32 * kb + r32) * YP + YI_K + 8 * hh;
                        ik[i][0] = *(const GAS bf16x8_t*)(uintptr_t)yk; ik[i][1] = *(const GAS bf16x8_t*)(uintptr_t)(yk + 16);
                    }
#pragma unroll
                    for (int i = 0; i < 4; ++i) {
                        const int blk = 4 * g + i;
                        if (blk < nbw) {
                            const f32x16 sc = idx_scores(ik[i][0], ik[i][1], iqf, w);
#pragma unroll
                            for (int r = 0; r < 16; ++r) kr[blk >> 1][16 * (blk & 1) + r] = fkey(sc[r]);
                        } else {
#pragma unroll
                            for (int r = 0; r < 16; ++r) kr[blk >> 1][16 * (blk & 1) + r] = zopq;
                        }
                    }
                    asm volatile("" ::: "memory");
                }
            }
            TE(5, lds, tid); TB(20, lds, tid);
            unsigned pl[4][32];
            {
                const int rq = 4 * wave + (lane >> 4), rt = lane & 15;
#pragma unroll
                for (int rd = 0; rd < 2; ++rd) {
#pragma unroll
                    for (int i = 0; i < 4; ++i)
#pragma unroll
                        for (int g = 0; g < 4; ++g) {
                            const int blk = 4 * rd + i;
                            u32x4 v; v.x = kr[blk >> 1][16 * (blk & 1) + 4 * g]; v.y = kr[blk >> 1][16 * (blk & 1) + 4 * g + 1]; v.z = kr[blk >> 1][16 * (blk & 1) + 4 * g + 2]; v.w = kr[blk >> 1][16 * (blk & 1) + 4 * g + 3];
                            *(LAS u32x4*)(sk + r32 * SKS + 32 * wave + 256 * i + 8 * g + 4 * hh) = v;
                        }
                    __syncthreads();
#pragma unroll
                    for (int M = 0; M < 16; ++M) {
                        const u32x4 v = *(const LAS u32x4*)(sk + rq * SKS + 64 * M + 4 * rt);
                        pl[2 * rd + (M >> 3)][4 * (M & 7)] = v.x; pl[2 * rd + (M >> 3)][4 * (M & 7) + 1] = v.y; pl[2 * rd + (M >> 3)][4 * (M & 7) + 2] = v.z; pl[2 * rd + (M >> 3)][4 * (M & 7) + 3] = v.w;
                    }
                    __syncthreads();
                }
            }
            TE(20, lds, tid); TB(6, lds, tid);
#pragma unroll
            for (int j = 0; j < 4; ++j) transpose32(pl[j]);
            TE(6, lds, tid); TB(7, lds, tid);
            unsigned alive[4];
#pragma unroll
            for (int j = 0; j < 4; ++j) alive[j] = topbits(nv - 32 * j);
            int above = 0; unsigned prefix = 0u; bool done = false, alld = false;
            rs4_row<0>(pl, alive, above, prefix, done, alld, nmr);
            TE(7, lds, tid); TB(8, lds, tid);
            int kcut = 1 << 20;
            if (!__all(done)) {
                const int need = TOPK - above, rt = lane & 15;
                int posk = 0;
#pragma unroll 1
                for (int b2 = 10; b2 >= 0; --b2) {
                    const int tt = posk | (1 << b2);
                    const int R = tt - 4 * rt;
                    const int M = R <= 0 ? 0 : 4 * (R >> 6) + min(R & 63, 4);
                    int c = 0;
#pragma unroll
                    for (int j = 0; j < 4; ++j) c += __popc(alive[j] & topbits(M - 32 * j));
                    const int f = rowsum16(c);
                    if (f < need) posk = tt;
                }
                if (!done) kcut = posk;
            }
            TE(8, lds, tid); TE(4, lds, tid);
            if ((lane & 15) == 0) { thr[32 * sp + 4 * wave + (lane >> 4)] = unfkey(prefix); kcs[32 * sp + 4 * wave + (lane >> 4)] = kcut; }
            __syncthreads();
        }
    }
    mixD_attend(p, b, c, lds, wave_s);
}
__device__ __forceinline__ void mixD_attend(const Params& p, int b, int c, LAS unsigned char* lds, int wave_s) {
    const int tid = tid_now(wave_s);
    const int lane = tid & 63, wave = __builtin_amdgcn_readfirstlane(tid >> 6), r32 = lane & 31, hh = lane >> 5;
    const size_t rowb = (size_t)b * SEQ;
    const int q0 = c * 64, ntile = c + 1;
    LAS float* thr = (LAS float*)(lds + 131072 + 1024);
    LAS int* kcs = (LAS int*)(lds + 131072 + 1280);
    const bool dosel = c >= 4;
    TB(9, lds, tid);
    const int qg = wave >> 2, hd = wave & 3;
    const int pos = q0 + 32 * qg + r32;
    const bf16_t* yq = p.Y() + (rowb + pos) * YP;
    bf16x8_t qf[4];
#pragma unroll
    for (int s = 0; s < 4; ++s) qf[s] = *(const GAS bf16x8_t*)(uintptr_t)(yq + YD_Q + hd * 64 + 16 * s + 8 * hh);
    bf16x8_t iqf[4][2];
    float w[4];
    float T = -INFINITY; int kcut = 1 << 20;
    if (dosel) {
#pragma unroll
        for (int h2 = 0; h2 < 4; ++h2)
#pragma unroll
            for (int s = 0; s < 2; ++s) iqf[h2][s] = *(const GAS bf16x8_t*)(uintptr_t)(yq + YI_Q + h2 * 32 + 16 * s + 8 * hh);
        const unsigned long long ww = *(const GAS unsigned long long*)(uintptr_t)(yq + YI_W);
#pragma unroll
        for (int h2 = 0; h2 < 4; ++h2) w[h2] = __uint_as_float((unsigned)((ww >> (16 * h2)) & 0xffffu) << 16) * (0.17677669529663687f * 0.5f);
        T = thr[32 * qg + r32]; kcut = kcs[32 * qg + r32];
    } else {
#pragma unroll
        for (int h2 = 0; h2 < 4; ++h2) { w[h2] = 0.f;
#pragma unroll
            for (int s = 0; s < 2; ++s)
#pragma unroll
                for (int e = 0; e < 8; ++e) iqf[h2][s][e] = 0; }
    }
    const float c1 = 0.125f * 1.4426950408889634f;
    const float sl2 = exp2f(-(float)(2 * hd + 2)) * 1.4426950408889634f;
    f32x16 o[2];
#pragma unroll
    for (int d = 0; d < 2; ++d)
#pragma unroll
        for (int i = 0; i < 16; ++i) o[d][i] = 0.f;
    float mrun = -1e30f, lrun = 0.f;
    const int npair = (ntile + 1) >> 1;
    const bf16_t* ksrc = p.Y() + (rowb + 8 * wave) * YP + YD_K;
    const bf16_t* vsrc = p.Y() + (rowb + 8 * wave) * YP + YD_V;
    LAS unsigned char* kring = lds;
    LAS unsigned char* vring = lds + 4 * KVL_TILE;
    LAS unsigned* mbuf = (LAS unsigned*)(lds + 8 * KVL_TILE);
    const int mtile = hd >> 1, mkb = hd & 1;
    bf16x8_t ikn0, ikn1;
    {
        const bf16_t* yk = p.Y() + (rowb + 64 * min(mtile, ntile - 1) + 32 * mkb + r32) * YP + YI_K + 8 * hh;
        ikn0 = *(const GAS bf16x8_t*)(uintptr_t)yk; ikn1 = *(const GAS bf16x8_t*)(uintptr_t)(yk + 16);
    }
#define D2_MASK(pq, sl) do { \
        const int tm_ = 2 * (pq) + mtile; unsigned bits_ = 0u; \
        if (tm_ < ntile) { \
            const f32x16 ss_ = idx_scores(ikn0, ikn1, iqf, w); \
            const int kcl_ = kcut - 64 * tm_ - 4 * hh; \
            _Pragma("unroll") for (int i = 0; i < 16; ++i) { const int kci_ = 32 * mkb + (i & 3) + 8 * (i >> 2); \
                const bool sel_ = (ss_[i] > T) || (ss_[i] == T && kci_ <= kcl_); bits_ |= sel_ ? (1u << i) : 0u; } \
        } \
        mbuf[(((sl) * 2 + qg) * 4 + hd) * 64 + lane] = bits_; } while (0)
    asm volatile("" : "+v"(qf[0]), "+v"(qf[1]), "+v"(qf[2]), "+v"(qf[3]));
    __syncthreads();
#pragma unroll
    for (int tt = 0; tt < 2; ++tt) {
        const int t = min(tt, ntile - 1);
        dma_piece(ksrc + (size_t)t * 64 * YP, kring + tt * KVL_TILE + wave * 1024, lane); dma_piece(vsrc + (size_t)t * 64 * YP, vring + tt * KVL_TILE + wave * 1024, lane);
    }
    if (dosel) D2_MASK(0, 0);
    for (int pp = 0; pp < npair; ++pp) {
        const int cur = pp & 1;
        const bool more = pp + 1 < npair;
        TB(12, lds, tid);
        asm volatile("s_waitcnt vmcnt(0) lgkmcnt(0)" ::: "memory"); __builtin_amdgcn_s_barrier(); asm volatile("" ::: "memory");
        TE(12, lds, tid);
        if (more) {
#pragma unroll
            for (int tt = 0; tt < 2; ++tt) {
                const int t = min(2 * (pp + 1) + tt, ntile - 1);
                dma_piece(ksrc + (size_t)t * 64 * YP, kring + ((cur ^ 1) * 2 + tt) * KVL_TILE + wave * 1024, lane); dma_piece(vsrc + (size_t)t * 64 * YP, vring + ((cur ^ 1) * 2 + tt) * KVL_TILE + wave * 1024, lane);
            }
            if (dosel) {
                const bf16_t* yk = p.Y() + (rowb + 64 * min(2 * (pp + 1) + mtile, ntile - 1) + 32 * mkb + r32) * YP + YI_K + 8 * hh;
                ikn0 = *(const GAS bf16x8_t*)(uintptr_t)yk; ikn1 = *(const GAS bf16x8_t*)(uintptr_t)(yk + 16);
            }
        }
        TB(11, lds, tid);
#pragma unroll 1
        for (int tt = 0; tt < 2; ++tt) {
            const int j = 2 * pp + tt;
            if (j < ntile) {
                const LAS unsigned char* kt = kring + (cur * 2 + tt) * KVL_TILE;
                const LAS unsigned char* vt = vring + (cur * 2 + tt) * KVL_TILE;
                const float pl = (float)(pos - 64 * j - 4 * hh);
                const bool diag = (j == c);
                unsigned selb[2] = {0xffffu, 0xffffu};
                if (dosel) { selb[0] = mbuf[((cur * 2 + qg) * 4 + 2 * tt) * 64 + lane]; selb[1] = mbuf[((cur * 2 + qg) * 4 + 2 * tt + 1) * 64 + lane]; }
                f32x16 sc[2];
#pragma unroll
                for (int kb = 0; kb < 2; ++kb) {
                    f32x16 a;
#pragma unroll
                    for (int i = 0; i < 16; ++i) a[i] = 0.f;
#pragma unroll
                    for (int s = 0; s < 4; ++s) {
                        const bf16x8_t kf = *(const LAS bf16x8_t*)(kt + (32 * kb + r32) * 128 + (((2 * s + hh) ^ (r32 & 7)) * 16));
                        a = MFMA32(kf, qf[s], a);
                    }
                    if (!diag) {
#pragma unroll
                        for (int i = 0; i < 16; ++i) { const float kc = (float)(32 * kb + (i & 3) + 8 * (i >> 2)); a[i] = fmaf(a[i], c1, fmaf(sl2, kc, -sl2 * pl)); }
                    } else {
#pragma unroll
                        for (int i = 0; i < 16; ++i) { const float kc = (float)(32 * kb + (i & 3) + 8 * (i >> 2)); a[i] = fmaf(a[i], c1, -sl2 * fabsf(pl - kc)); }
                    }
#pragma unroll
                    for (int i = 0; i < 16; ++i) {
                        const unsigned t = (unsigned)__builtin_amdgcn_sbfe((int)selb[kb], i, 1);
                        a[i] = __uint_as_float((__float_as_uint(a[i]) & t) | (0xff800000u & ~t));
                    }
                    sc[kb] = a;
                }
                float mx = sc[0][0];
#pragma unroll
                for (int i = 1; i < 16; ++i) mx = fmaxf(mx, sc[0][i]);
#pragma unroll
                for (int i = 0; i < 16; ++i) mx = fmaxf(mx, sc[1][i]);
                mx = xmax32(mx);
                const float mnew = fmaxf(mrun, mx);
                const float alpha = __builtin_amdgcn_exp2f(mrun - mnew);
                mrun = mnew;
                float ls4[4] = {0.f, 0.f, 0.f, 0.f};
#pragma unroll
                for (int kb = 0; kb < 2; ++kb)
#pragma unroll
                    for (int i = 0; i < 16; ++i) { const float e = __builtin_amdgcn_exp2f(sc[kb][i] - mnew); sc[kb][i] = e; ls4[i & 3] += e; }
                lrun = lrun * alpha + ((ls4[0] + ls4[1]) + (ls4[2] + ls4[3]));
#pragma unroll
                for (int d = 0; d < 2; ++d)
#pragma unroll
                    for (int i = 0; i < 16; ++i) o[d][i] *= alpha;
#pragma unroll
                for (int ks = 0; ks < 4; ++ks) {
                    const bf16x8_t pf = pack_step(sc[ks >> 1], ks & 1);
#pragma unroll
                    for (int db = 0; db < 2; ++db) o[db] = MFMA32(vt_frag_sw(vt, ks, db, lane), pf, o[db]);
                }
            }
        }
        TE(11, lds, tid);
        TB(10, lds, tid);
        if (more && dosel) D2_MASK(pp + 1, cur ^ 1);
        TE(10, lds, tid);
    }
#undef D2_MASK
    TE(9, lds, tid);
    const float inv = 1.f / xsum32(lrun);
    bf16_t* mrow = p.mix() + (rowb + pos) * DM + 768 + hd * 64;
#pragma unroll
    for (int d = 0; d < 2; ++d)
#pragma unroll
        for (int g = 0; g < 4; ++g) {
            const int d0 = 32 * d + 8 * g + 4 * hh;
            const unsigned long long zz = *(const GAS unsigned long long*)(uintptr_t)(yq + YD_Z + hd * 64 + d0);
            const float z0 = __uint_as_float((unsigned)(zz & 0xffffu) << 16), z1 = __uint_as_float((unsigned)((zz >> 16) & 0xffffu) << 16),
                        z2 = __uint_as_float((unsigned)((zz >> 32) & 0xffffu) << 16), z3 = __uint_as_float((unsigned)((zz >> 48) & 0xffffu) << 16);
            *(GAS unsigned long long*)(uintptr_t)(mrow + d0) = (unsigned long long)cvtpk(o[d][4 * g] * inv * z0, o[d][4 * g + 1] * inv * z1) | ((unsigned long long)cvtpk(o[d][4 * g + 2] * inv * z2, o[d][4 * g + 3] * inv * z3) << 32);
        }
}
__device__ __forceinline__ void ph_mixD(const Params& p, LAS unsigned char* lds, int bid, int nb, int wave_s) {
    for (int i = bid; i < 256; i += nb) {
        const int b = i & 15, cc = i >> 4;
#pragma unroll 1
        for (int k = 0; k < 2; ++k) mixD_unit(p, b, k == 0 ? 31 - cc : cc, lds, wave_s);
    }
}

constexpr int VN_STRIDE = 528;
__device__ __forceinline__ float bflo(unsigned u) { return __uint_as_float(u << 16); }
__device__ __forceinline__ float bfhi(unsigned u) { return __uint_as_float(u & 0xffff0000u); }
__device__ __forceinline__ void mixAB_unit(const Params& p, int l, int b, int n, LAS unsigned char* lds, int tid) {
    const int lane = tid & 63, wave = __builtin_amdgcn_readfirstlane(tid >> 6), r32 = lane & 31, hh = lane >> 5;
    const size_t row0 = (size_t)b * SEQ + 128 * n;
    __syncthreads();
#pragma unroll
    for (int k = 0; k < 8; ++k) {
        const int ch = tid + 512 * k, r = ch >> 5, c16 = ch & 31;
        *(LAS u32x4*)(lds + r * VN_STRIDE + c16 * 16) = *(const GAS u32x4*)(uintptr_t)(p.Y() + (row0 + r) * YP + YB_V + c16 * 8);
    }
    {
        const int cg8 = (tid & 31) * 8, t0 = (tid >> 5) * 8;
        const int pos0 = 128 * n + t0;
        const GAS float* cw = p.sm(SM_CONVW) + l * 768 + cg8;
        float w0[8], w1[8], w2[8], cb[8];
#pragma unroll
        for (int e = 0; e < 8; ++e) { w0[e] = cw[e]; w1[e] = cw[256 + e]; w2[e] = cw[512 + e]; cb[e] = p.sm(SM_CONVB)[l * 256 + cg8 + e]; }
        float um2[8], um1[8];
#pragma unroll
        for (int e = 0; e < 8; ++e) { um2[e] = 0.f; um1[e] = 0.f; }
#pragma unroll
        for (int back = 2; back >= 1; --back) {
            if (pos0 - back >= 0) {
                const bf16_t* yr = p.Y() + (row0 + t0 - back) * YP;
                const u32x4 hc = *(const GAS u32x4*)(uintptr_t)(yr + YA_H + cg8), cc = *(const GAS u32x4*)(uintptr_t)(yr + YA_C + cg8);
                float u[8] = {bflo(hc.x) * bflo(cc.x), bfhi(hc.x) * bfhi(cc.x), bflo(hc.y) * bflo(cc.y), bfhi(hc.y) * bfhi(cc.y),
                              bflo(hc.z) * bflo(cc.z), bfhi(hc.z) * bfhi(cc.z), bflo(hc.w) * bflo(cc.w), bfhi(hc.w) * bfhi(cc.w)};
#pragma unroll
                for (int e = 0; e < 8; ++e) { if (back == 2) um2[e] = u[e]; else um1[e] = u[e]; }
            }
        }
#pragma unroll
        for (int tt = 0; tt < 8; ++tt) {
            const bf16_t* yr = p.Y() + (row0 + t0 + tt) * YP;
            const u32x4 hc = *(const GAS u32x4*)(uintptr_t)(yr + YA_H + cg8), cc = *(const GAS u32x4*)(uintptr_t)(yr + YA_C + cg8), bg = *(const GAS u32x4*)(uintptr_t)(yr + YA_B + cg8), zg = *(const GAS u32x4*)(uintptr_t)(yr + YA_Z + cg8);
            const float u[8] = {bflo(hc.x) * bflo(cc.x), bfhi(hc.x) * bfhi(cc.x), bflo(hc.y) * bflo(cc.y), bfhi(hc.y) * bfhi(cc.y),
                                bflo(hc.z) * bflo(cc.z), bfhi(hc.z) * bfhi(cc.z), bflo(hc.w) * bflo(cc.w), bfhi(hc.w) * bfhi(cc.w)};
            const float bgv[8] = {bflo(bg.x), bfhi(bg.x), bflo(bg.y), bfhi(bg.y), bflo(bg.z), bfhi(bg.z), bflo(bg.w), bfhi(bg.w)};
            const float zgv[8] = {bflo(zg.x), bfhi(zg.x), bflo(zg.y), bfhi(zg.y), bflo(zg.z), bfhi(zg.z), bflo(zg.w), bfhi(zg.w)};
            float ov[8];
#pragma unroll
            for (int e = 0; e < 8; ++e) {
                const float conv = w0[e] * um2[e] + w1[e] * um1[e] + w2[e] * u[e];
                ov[e] = bgv[e] * (conv + cb[e]) * zgv[e];
                um2[e] = um1[e]; um1[e] = u[e];
            }
            u32x4 ow; ow.x = cvtpk(ov[0], ov[1]); ow.y = cvtpk(ov[2], ov[3]); ow.z = cvtpk(ov[4], ov[5]); ow.w = cvtpk(ov[6], ov[7]);
            *(GAS u32x4*)(uintptr_t)(p.mix() + (row0 + t0 + tt) * DM + cg8) = ow;
        }
    }
    __syncthreads();
    {
        const int h = wave >> 1, th = wave & 1;
        const int nks = th == 0 ? 4 : 8;
        f32x16 acc[2][2];
#pragma unroll
        for (int a = 0; a < 2; ++a)
#pragma unroll
            for (int d = 0; d < 2; ++d)
#pragma unroll
                for (int i = 0; i < 16; ++i) acc[a][d][i] = 0.f;
        const bf16_t* wb = p.wsb() + ((size_t)(l * 4 + h) * 128 + 64 * th + r32) * 128 + 8 * hh;
        const int i16 = lane & 15, q = i16 >> 2, pp = i16 & 3, blk = (lane >> 4) & 1;
        const LAS unsigned char* va = lds + (8 * hh + q) * VN_STRIDE + (h * 64 + 16 * blk + 4 * pp) * 2;
        for (int ks = 0; ks < nks; ++ks) {
            bf16x8_t bfr[2], afr[2];
#pragma unroll
            for (int tb = 0; tb < 2; ++tb) bfr[tb] = *(const GAS bf16x8_t*)(uintptr_t)(wb + (size_t)(32 * tb) * 128 + 16 * ks);
#pragma unroll
            for (int db = 0; db < 2; ++db) {
                const LAS unsigned char* a = va + (16 * ks) * VN_STRIDE + (32 * db) * 2;
                const s16x4_t lo = ds_tr16(a), hi = ds_tr16(a + 4 * VN_STRIDE);
                afr[db] = __builtin_shufflevector(lo, hi, 0, 1, 2, 3, 4, 5, 6, 7);
            }
#pragma unroll
            for (int tb = 0; tb < 2; ++tb)
#pragma unroll
                for (int db = 0; db < 2; ++db) acc[tb][db] = MFMA32(afr[db], bfr[tb], acc[tb][db]);
        }
#pragma unroll
        for (int tb = 0; tb < 2; ++tb) {
            const int t = 64 * th + 32 * tb + r32;
            const float bias = p.sm(SM_GMLPB)[(l * 4 + h) * 128 + t];
            const bf16_t* yr = p.Y() + (row0 + t) * YP;
            bf16_t* mr = p.mix() + (row0 + t) * DM + 256 + h * 64;
#pragma unroll
            for (int db = 0; db < 2; ++db)
#pragma unroll
                for (int g = 0; g < 4; ++g) {
                    const int d0 = 32 * db + 8 * g + 4 * hh;
                    const unsigned long long uu = *(const GAS unsigned long long*)(uintptr_t)(yr + YB_U + h * 64 + d0), zz = *(const GAS unsigned long long*)(uintptr_t)(yr + YB_Z + h * 64 + d0);
                    const unsigned u01 = (unsigned)uu, u23 = (unsigned)(uu >> 32), z01 = (unsigned)zz, z23 = (unsigned)(zz >> 32);
                    const float v0 = bflo(u01) * (acc[tb][db][4 * g] + bias) * bflo(z01), v1 = bfhi(u01) * (acc[tb][db][4 * g + 1] + bias) * bfhi(z01);
                    const float v2 = bflo(u23) * (acc[tb][db][4 * g + 2] + bias) * bflo(z23), v3 = bfhi(u23) * (acc[tb][db][4 * g + 3] + bias) * bfhi(z23);
                    *(GAS unsigned long long*)(uintptr_t)(mr + d0) = (unsigned long long)cvtpk(v0, v1) | ((unsigned long long)cvtpk(v2, v3) << 32);
                }
        }
    }
}
__device__ __forceinline__ void ph_mixAB(const Params& p, int l, LAS unsigned char* lds, int bid, int nb, int tid_in) {
    int tid = tid_in; asm volatile("" : "+v"(tid));
    for (int i = bid; i < 256; i += nb) mixAB_unit(p, l, i >> 4, i & 15, lds, tid);
}

constexpr int IX_STRIDE = 528;
__device__ __forceinline__ void ph_ikiw(const Params& p, int l, LAS unsigned char* lds, int bid, int nb, int wave_s) {
    const int tid = tid_now(wave_s);
    const int lane = tid & 63, wave = __builtin_amdgcn_readfirstlane(tid >> 6), r32 = lane & 31, hh = lane >> 5;
    const int tb = wave & 3, cb = wave >> 2;
    LAS unsigned char* xs = lds;
    LAS unsigned char* ws = lds + 128 * IX_STRIDE;
    const bf16_t* wbase = p.wt_in() + (size_t)l * YP * DM;
    __syncthreads();
    { unsigned z = 0u; asm volatile("" : "+v"(z));
      for (int i = tid; i < 28 * (IX_STRIDE / 16); i += NT) *(LAS u32x4*)(ws + 36 * IX_STRIDE + i * 16) = (u32x4){z, z, z, z}; }
    for (int blk = bid; blk < NTOK / 128; blk += nb) {
        f32x16 acc;
#pragma unroll
        for (int i = 0; i < 16; ++i) acc[i] = 0.f;
#pragma unroll 1
        for (int k0 = 0; k0 < DM; k0 += 256) {
            u32x4 xv[8], wv[3];
#pragma unroll
            for (int i = 0; i < 8; ++i) { const int idx = tid + NT * i; xv[i] = *(const GAS u32x4*)(uintptr_t)(p.xb() + (size_t)(128 * blk + (idx >> 5)) * DM + k0 + 8 * (idx & 31)); }
#pragma unroll
            for (int i = 0; i < 3; ++i) {
                const int idx = tid + NT * i, n = idx >> 5;
                if (idx < 36 * 32) wv[i] = *(const GAS u32x4*)(uintptr_t)(wbase + (size_t)(n < 32 ? 3584 + n : 3712 + (n - 32)) * DM + k0 + 8 * (idx & 31));
            }
            __syncthreads();
#pragma unroll
            for (int i = 0; i < 8; ++i) { const int idx = tid + NT * i; *(LAS u32x4*)(xs + (idx >> 5) * IX_STRIDE + (idx & 31) * 16) = xv[i]; }
#pragma unroll
            for (int i = 0; i < 3; ++i) { const int idx = tid + NT * i; if (idx < 36 * 32) *(LAS u32x4*)(ws + (idx >> 5) * IX_STRIDE + (idx & 31) * 16) = wv[i]; }
            __syncthreads();
#pragma unroll
            for (int s = 0; s < 16; ++s) {
                const bf16x8_t a = *(const LAS bf16x8_t*)(ws + (32 * cb + r32) * IX_STRIDE + (16 * s + 8 * hh) * 2);
                const bf16x8_t b = *(const LAS bf16x8_t*)(xs + (32 * tb + r32) * IX_STRIDE + (16 * s + 8 * hh) * 2);
                acc = MFMA32(a, b, acc);
            }
        }
        const int tok = 128 * blk + 32 * tb + r32;
        const GAS f32x4* sp = (const GAS f32x4*)(uintptr_t)(p.ssq() + (size_t)tok * 16);
        const f32x4 s0 = sp[0], s1 = sp[1], s2 = sp[2], s3 = sp[3];
        const float tot = ((s0.x + s0.y) + (s0.z + s0.w)) + ((s1.x + s1.y) + (s1.z + s1.w)) + ((s2.x + s2.y) + (s2.z + s2.w)) + ((s3.x + s3.y) + (s3.z + s3.w));
        const float rstd = rsqrtf(tot * (1.f / DM) + EPS);
        bf16_t* yr = p.Y() + (size_t)tok * YP + YI_K + 32 * cb;
#pragma unroll
        for (int g = 0; g < 4; ++g) {
            const int c0 = 8 * g + 4 * hh;
            if (32 * cb + c0 < 36)
                *(GAS unsigned long long*)(uintptr_t)(yr + c0) = (unsigned long long)cvtpk(acc[4 * g] * rstd, acc[4 * g + 1] * rstd) | ((unsigned long long)cvtpk(acc[4 * g + 2] * rstd, acc[4 * g + 3] * rstd) << 32);
        }
    }
    __syncthreads();
}

__global__ void __launch_bounds__(NT, 2) k_fwd(Params p) {
    extern __shared__ __attribute__((aligned(16))) unsigned char lds[];
    cg::grid_group grid = cg::this_grid();
    LAS unsigned char* l3 = (LAS unsigned char*)lds;
    const int wave_s = __builtin_amdgcn_readfirstlane((int)threadIdx.x >> 6);
    volatile LAS unsigned* bst = (volatile LAS unsigned*)(l3 + LDS_BYTES - 16);
    if (threadIdx.x < 2) bst[threadIdx.x] = 0u;
    __syncthreads();
    const XcdBarrier bar = xcd_barrier_post(p.ctl(), bst);
    if (TSEG >= 0 && threadIdx.x == 0) *(volatile LAS unsigned*)(l3 + TCTR_OFF) = 0u;
    { TB(16, l3, tid_now(wave_s)); ph_prologue(p, l3, tid_now(wave_s)); TE(16, l3, tid_now(wave_s)); }
    if (p.ws == nullptr) grid.sync();
    { TB(18, l3, tid_now(wave_s)); xcd_barrier(bar, tid_now(wave_s)); TE(18, l3, tid_now(wave_s)); }
#pragma unroll 1
    for (int l = 0; l < DEPTH; ++l) {
        Params q = p; asm volatile("" : "+s"(q.ws), "+s"(q.out));
        int bid = blockIdx.x, nb = gridDim.x; asm volatile("" : "+s"(bid), "+s"(nb));
        {
            pg8::Gemm g{q.xb(), q.wt_in() + (size_t)l * YP * DM, NTOK, NGEMM, DM};
            pg8::StaticOrder S; S.init(NTOK, NGEMM, nb, bid);
            EpiIn E{q.ws, l, (LAS float*)(l3 + 131072 + 1024)};
            { TB(13, l3, tid_now(wave_s)); pg8::gemm_phase<EpiIn, pg8::StaticOrder, true, true>(l3, g, S, E, tid_now(wave_s)); TE(13, l3, tid_now(wave_s)); }
        }
        { TB(21, l3, tid_now(wave_s)); ph_ikiw(q, l, l3, bid, nb, wave_s); TE(21, l3, tid_now(wave_s)); }
        { TB(18, l3, tid_now(wave_s)); xcd_barrier(bar, tid_now(wave_s)); TE(18, l3, tid_now(wave_s)); }
        asm volatile("" : "+s"(q.ws), "+s"(bid), "+s"(nb));
        { TB(17, l3, tid_now(wave_s)); ph_mixAB(q, l, l3, bid, nb, tid_now(wave_s)); TE(17, l3, tid_now(wave_s)); }
        __syncthreads();
        { TB(1, l3, tid_now(wave_s)); ph_mixC(q, l, l3, bid, nb, wave_s); TE(1, l3, tid_now(wave_s)); }
        __syncthreads();
        { TB(19, l3, tid_now(wave_s)); ph_mixD(q, l3, bid, nb, wave_s); TE(19, l3, tid_now(wave_s)); }
        __syncthreads();
        { TB(18, l3, tid_now(wave_s)); xcd_barrier(bar, tid_now(wave_s)); TE(18, l3, tid_now(wave_s)); }
        asm volatile("" : "+s"(q.ws), "+s"(q.out), "+s"(bid), "+s"(nb));
        {
            pg8::Gemm g{q.mix(), q.wt_out() + (size_t)l * DM * DM, NTOK, DM, DM};
            pg8::StaticOrder S; S.init(NTOK, DM, nb, bid);
            EpiOut E{l == DEPTH - 1 ? q.out : nullptr, q.ws};
            { TB(15, l3, tid_now(wave_s)); pg8::gemm_phase<EpiOut, pg8::StaticOrder, true, true>(l3, g, S, E, tid_now(wave_s)); TE(15, l3, tid_now(wave_s)); }
        }
        { TB(18, l3, tid_now(wave_s)); xcd_barrier(bar, tid_now(wave_s)); TE(18, l3, tid_now(wave_s)); }
    }
    if (TSEG >= 0 && blockIdx.x == 0 && threadIdx.x == 0) {
        const unsigned long long ticks = 8ull * *(volatile LAS unsigned*)(l3 + TCTR_OFF), t0 = __builtin_amdgcn_s_memrealtime();
        while (__builtin_amdgcn_s_memrealtime() - t0 < ticks) __builtin_amdgcn_s_sleep(32);
    }
}

extern "C" void kernel_launch(void* const* d_in, const int* in_sizes, int n_in, void* d_out, int out_size, void* d_ws, size_t ws_size,
                              hipStream_t stream) {
    static int grid_blocks = 0;
    if (!grid_blocks) {
        int dev = 0, cus = 0, per_cu = 0;
        (void)hipGetDevice(&dev);
        (void)hipDeviceGetAttribute(&cus, hipDeviceAttributeMultiprocessorCount, dev);
        (void)hipFuncSetAttribute((const void*)k_fwd, hipFuncAttributeMaxDynamicSharedMemorySize, LDS_BYTES);
        (void)hipOccupancyMaxActiveBlocksPerMultiprocessor(&per_cu, (const void*)k_fwd, NT, LDS_BYTES);
        if (per_cu < 1) { fprintf(stderr, "kernel_launch: occupancy query returned %d\n", per_cu); per_cu = 1; }
        if (per_cu > 1) per_cu = 1;
        grid_blocks = cus * per_cu;
        if (ws_size < WS_END) fprintf(stderr, "kernel_launch: workspace too small (%zu < %zu)\n", ws_size, (size_t)WS_END);
    }
    (void)hipMemsetAsync(d_ws, 0, 16384, stream);
    Params p{};
    p.x = (const float*)d_in[0]; p.norm_g = (const float*)d_in[1]; p.w_in = (const float*)d_in[2]; p.i_conv_w = (const float*)d_in[3];
    p.i_conv_b = (const float*)d_in[4]; p.i_gmlp_g = (const float*)d_in[5]; p.gmlp_ws = (const float*)d_in[6]; p.i_gmlp_b = (const float*)d_in[7];
    p.i_diff_qg = (const float*)d_in[8]; p.i_diff_kg = (const float*)d_in[9]; p.i_diff_lam = (const float*)d_in[10]; p.i_diff_subg = (const float*)d_in[11];
    p.i_dsa_qg = (const float*)d_in[12]; p.i_dsa_kg = (const float*)d_in[13]; p.w_out = (const float*)d_in[14];
    p.out = (float*)d_out; p.ws = (unsigned char*)d_ws;
    void* args[] = {&p};
    hipError_t e = hipLaunchCooperativeKernel((void*)k_fwd, dim3(grid_blocks), dim3(NT), args, LDS_BYTES, stream);
    if (e != hipSuccess) fprintf(stderr, "cooperative launch failed: %s (grid %d)\n", hipGetErrorString(e), grid_blocks);
}
```

```cpp
#include <hip/hip_runtime.h>
#include <hip/hip_cooperative_groups.h>
#include <math.h>
#include <stdint.h>
#include <stdio.h>
namespace cg = cooperative_groups;
namespace pg8 {
#define PG8_LAS __attribute__((address_space(3)))
typedef unsigned short bf16_t;
typedef short bf16x8 __attribute__((ext_vector_type(8)));
typedef float f32x4 __attribute__((ext_vector_type(4)));
typedef unsigned u32x4 __attribute__((ext_vector_type(4)));
constexpr int BM = 256, BK = 64, HALF = 128, HTB = HALF * BK * 2  , STAGE_BYTES = 8 * HTB, NXCD = 8, WGM = 8;

__host__ __device__ __forceinline__ int lds_byte(int r, int c) { const int st = (r >> 4) * 2 + (c >> 5), rr = r & 15, cc = c & 31, ob = rr * 64 + cc * 2; return st * 1024 + (ob ^ (((ob >> 9) & 1) << 5)); }
__host__ __device__ __forceinline__ void stage_rc(int b, int& R, int& C) { const int st = b / 1024, sb = b % 1024, swz = sb ^ (((sb >> 9) & 1) << 5); R = (st >> 1) * 16 + swz / 64; C = (st & 1) * 32 + (swz % 64) / 2; }
__host__ __device__ __forceinline__ int perm32(int rho) { const int n = rho >> 4, i = rho & 15; return 8 * (i >> 2) + 4 * n + (i & 3); }

struct Unit { int pm, pn; };
struct Gemm { const bf16_t* A; const bf16_t* Bt; int M, N, K; };

struct StaticOrder {
    int nM, nN, nwg, G, c;
    __host__ __device__ void init(int M, int N, int G_, int c_) { nM = M / BM; nN = N / BM; nwg = nM * nN; G = G_; c = c_; }
    __host__ __device__ bool next(int i, Unit& u) const {
        const long L = (long)i * G + c; if (L >= nwg) return false;
        int wgid = (int)L; { const int q = nwg / NXCD, r = nwg % NXCD, xcd = wgid % NXCD, off = wgid / NXCD; wgid = (xcd < r ? xcd * (q + 1) : r * (q + 1) + (xcd - r) * q) + off; }
        const int nig = WGM * nN, gid = wgid / nig, fm = gid * WGM, gsz = (nM - fm) < WGM ? (nM - fm) : WGM;
        u.pm = fm + ((wgid % nig) % gsz); u.pn = (wgid % nig) / gsz; return true;
    }
    __device__ __forceinline__ void a_ready(const Unit&) const {}
    __device__ __forceinline__ void done(const Unit&) const {}
};

__device__ __forceinline__ unsigned cvt_pk_bf16(float lo, float hi) { unsigned r; asm volatile("v_cvt_pk_bf16_f32 %0, %1, %2" : "=v"(r) : "v"(lo), "v"(hi)); return r; }
typedef float f32x2 __attribute__((ext_vector_type(2)));
__device__ __forceinline__ f32x2 gelu_pk(f32x2 v) {
    const f32x2 av = __builtin_elementwise_abs(v), d = av * 0.2316418882f + 1.0f;
    f32x2 t; t.x = __builtin_amdgcn_rcpf(d.x); t.y = __builtin_amdgcn_rcpf(d.y);
    f32x2 q = t * 0.5307027145f + (-0.7265760135f); q = q * t + 0.7107068705f; q = q * t + (-0.142248368f); q = q * t + 0.127414796f; q = q * t;
    const f32x2 s = (v * v) * (-0.72134752044f);
    f32x2 e; e.x = __builtin_amdgcn_exp2f(s.x); e.y = __builtin_amdgcn_exp2f(s.y);
    const f32x2 m = v * (q * e), r = v - m;
    f32x2 o; o.x = v.x < 0.f ? m.x : r.x; o.y = v.y < 0.f ? m.y : r.y; return o;
}
template <class Epi, class Sched, bool ALIGN_EPI = false, bool SP2 = false>
__device__ __forceinline__ void gemm_phase(PG8_LAS unsigned char* lds, const Gemm g, const Sched& S, const Epi& E, int tid_in) {
    int tid_ = tid_in; asm volatile("" : "+v"(tid_));
    const int tid = tid_, wid = __builtin_amdgcn_readfirstlane(tid >> 6), lane = tid & 63, wr = wid >> 2, wc = wid & 3, fr = lane & 15, fq = lane >> 4;
    const int K = g.K, nt = K / BK;
    unsigned voffA[2], voffB[2];
#pragma unroll
    for (int i = 0; i < 2; ++i) { int R, C; stage_rc(tid * 16 + i * 8192, R, C); const int Rb = Epi::PERM ? ((R & ~31) + perm32(R & 31)) : R;
        voffA[i] = (unsigned)(R * K + C) * 2u; voffB[i] = (unsigned)(Rb * K + C) * 2u; }
    const size_t kstep = (size_t)(BK * 2);
    const size_t hstep = (size_t)HALF * K * 2;
    const size_t tstep = 2 * hstep;
    const unsigned ldsw = (unsigned)wid * 1024u;
    const int aoff = lds_byte(wr * 64 + fr, fq * 8), boff = lds_byte(wc * 32 + fr, fq * 8);
#define PG8_SA(b, h) (((b) * 2 + (h)) * HTB)
#define PG8_SB(b, h) ((4 + (b) * 2 + (h)) * HTB)
#define PG8_STAGE(bufoff, gbase, voff) do { _Pragma("unroll") for (int _i = 0; _i < 2; ++_i) \
        __builtin_amdgcn_global_load_lds((const unsigned*)((const char*)(gbase) + (voff)[_i]), (PG8_LAS unsigned*)(lds + (bufoff) + ldsw + _i * 8192), 16, 0, 0); } while (0)
#define PG8_LDA(dst, b, h) do { _Pragma("unroll") for (int m = 0; m < 4; ++m) _Pragma("unroll") for (int k = 0; k < 2; ++k) dst[m][k] = *(const PG8_LAS bf16x8*)(lds + PG8_SA(b, h) + aoff + m * 2048 + k * 1024); } while (0)
#define PG8_LDB(dst, b, h) do { _Pragma("unroll") for (int n = 0; n < 2; ++n) _Pragma("unroll") for (int k = 0; k < 2; ++k) dst[n][k] = *(const PG8_LAS bf16x8*)(lds + PG8_SB(b, h) + boff + n * 2048 + k * 1024); } while (0)
#define PG8_MMA(ai, bj, At, Bt) do { __builtin_amdgcn_s_setprio(1); _Pragma("unroll") for (int m = 0; m < 4; ++m) _Pragma("unroll") for (int n = 0; n < 2; ++n) _Pragma("unroll") for (int k = 0; k < 2; ++k) \
        acc[ai][bj][m][n] = __builtin_amdgcn_mfma_f32_16x16x32_bf16(Bt[n][k], At[m][k], acc[ai][bj][m][n], 0, 0, 0); __builtin_amdgcn_s_setprio(0); } while (0)
#define PG8_WAIT_V(n) asm volatile("s_waitcnt vmcnt(" #n ")" ::: "memory")
#define PG8_WAIT_L(n) asm volatile("s_waitcnt lgkmcnt(" #n ")" ::: "memory")
#define PG8_BAR __builtin_amdgcn_s_barrier()
#define PG8_SCHED __builtin_amdgcn_sched_barrier(0)
    Unit cur, nxt; int ui = 0;
    if (!S.next(0, cur)) return;
    f32x4 acc[2][2][4][2];
#pragma unroll
    for (int a = 0; a < 2; ++a)
#pragma unroll
        for (int b = 0; b < 2; ++b)
#pragma unroll
            for (int m = 0; m < 4; ++m)
#pragma unroll
                for (int n = 0; n < 2; ++n) acc[a][b][m][n] = (f32x4){0.f, 0.f, 0.f, 0.f};
    bf16x8 At[4][2], B0[2][2], B1[2][2];
    const char* cA = (const char*)g.A + (size_t)cur.pm * tstep; const char* cB = (const char*)g.Bt + (size_t)cur.pn * tstep;
    S.a_ready(cur);
    if constexpr (SP2) {
        PG8_STAGE(PG8_SB(0, 0), cB, voffB); PG8_STAGE(PG8_SB(0, 1), cB + hstep, voffB); PG8_STAGE(PG8_SA(0, 0), cA, voffA); PG8_STAGE(PG8_SA(0, 1), cA + hstep, voffA);
        if (wr == 1) PG8_BAR;
        PG8_WAIT_V(2); PG8_BAR;
        PG8_STAGE(PG8_SB(1, 0), cB + kstep, voffB); PG8_STAGE(PG8_SA(1, 0), cA + kstep, voffA); PG8_STAGE(PG8_SB(1, 1), cB + hstep + kstep, voffB);
        PG8_WAIT_V(6); PG8_BAR;
    } else {
        PG8_STAGE(PG8_SB(0, 0), cB, voffB); PG8_STAGE(PG8_SA(0, 0), cA, voffA); PG8_STAGE(PG8_SB(0, 1), cB + hstep, voffB); PG8_STAGE(PG8_SA(0, 1), cA + hstep, voffA);
        if (wr == 1) PG8_BAR;
        PG8_WAIT_V(4); PG8_BAR;
        PG8_STAGE(PG8_SB(1, 0), cB + kstep, voffB); PG8_STAGE(PG8_SA(1, 0), cA + kstep, voffA); PG8_STAGE(PG8_SB(1, 1), cB + hstep + kstep, voffB);
        PG8_WAIT_V(6); PG8_BAR;
    }
    for (;;) {
        const bool has_next = S.next(ui + 1, nxt);
        const char* nA = has_next ? (const char*)g.A + (size_t)nxt.pm * tstep : cA; const char* nB = has_next ? (const char*)g.Bt + (size_t)nxt.pn * tstep : cB;
        for (int t = 0; t < nt; t += 2) {
            const bool last = (t == nt - 2);
            const char* a1 = cA + (size_t)(t + 1) * kstep;
            const char* a2 = last ? nA : cA + (size_t)(t + 2) * kstep; const char* b2 = last ? nB : cB + (size_t)(t + 2) * kstep;
            const char* a3 = a2 + kstep; const char* b3 = b2 + kstep;
            if (last && has_next) S.a_ready(nxt);
            if constexpr (SP2) {
            PG8_LDB(B0, 0, 0); PG8_LDB(B1, 0, 1); PG8_SCHED; PG8_LDA(At, 0, 0); PG8_STAGE(PG8_SA(1, 1), a1 + hstep, voffA);
            PG8_WAIT_V(8); PG8_WAIT_L(0); PG8_BAR; PG8_MMA(0, 0, At, B0); PG8_MMA(0, 1, At, B1); PG8_BAR; PG8_SCHED;
            PG8_LDA(At, 0, 1); PG8_STAGE(PG8_SB(0, 0), b2, voffB); PG8_STAGE(PG8_SB(0, 1), b2 + hstep, voffB); PG8_STAGE(PG8_SA(0, 0), a2, voffA);
            PG8_WAIT_V(8); PG8_WAIT_L(0); PG8_BAR; PG8_MMA(1, 0, At, B0); PG8_MMA(1, 1, At, B1); PG8_BAR; PG8_SCHED;
            PG8_LDB(B0, 1, 0); PG8_LDB(B1, 1, 1); PG8_SCHED; PG8_LDA(At, 1, 0); PG8_STAGE(PG8_SA(0, 1), a2 + hstep, voffA);
            PG8_WAIT_V(8); PG8_WAIT_L(0); PG8_BAR; PG8_MMA(0, 0, At, B0); PG8_MMA(0, 1, At, B1); PG8_BAR; PG8_SCHED;
            PG8_LDA(At, 1, 1); PG8_STAGE(PG8_SB(1, 0), b3, voffB); PG8_STAGE(PG8_SB(1, 1), b3 + hstep, voffB); PG8_STAGE(PG8_SA(1, 0), a3, voffA);
            PG8_WAIT_V(8); PG8_WAIT_L(0); PG8_BAR; PG8_MMA(1, 0, At, B0); PG8_MMA(1, 1, At, B1); PG8_BAR; PG8_SCHED;
            } else {
            PG8_LDB(B0, 0, 0); PG8_SCHED; PG8_LDA(At, 0, 0); PG8_STAGE(PG8_SA(1, 1), a1 + hstep, voffA);
            PG8_WAIT_L(8); PG8_BAR; PG8_WAIT_L(0); PG8_MMA(0, 0, At, B0); PG8_BAR; PG8_SCHED;
            PG8_LDB(B1, 0, 1); PG8_STAGE(PG8_SB(0, 0), b2, voffB);
            PG8_BAR; PG8_WAIT_L(0); PG8_MMA(0, 1, At, B1); PG8_BAR;
            PG8_LDA(At, 0, 1); PG8_STAGE(PG8_SA(0, 0), a2, voffA);
            PG8_BAR; PG8_WAIT_L(0); PG8_MMA(1, 0, At, B0); PG8_BAR; PG8_SCHED;
            PG8_STAGE(PG8_SB(0, 1), b2 + hstep, voffB);
            PG8_WAIT_V(6); PG8_BAR; PG8_MMA(1, 1, At, B1); PG8_BAR;
            PG8_LDB(B0, 1, 0); PG8_SCHED; PG8_LDA(At, 1, 0); PG8_STAGE(PG8_SA(0, 1), a2 + hstep, voffA);
            PG8_WAIT_L(8); PG8_BAR; PG8_WAIT_L(0); PG8_MMA(0, 0, At, B0); PG8_BAR; PG8_SCHED;
            PG8_LDB(B1, 1, 1); PG8_STAGE(PG8_SB(1, 0), b3, voffB);
            PG8_BAR; PG8_WAIT_L(0); PG8_MMA(0, 1, At, B1); PG8_BAR;
            PG8_LDA(At, 1, 1); PG8_STAGE(PG8_SA(1, 0), a3, voffA);
            PG8_BAR; PG8_WAIT_L(0); PG8_MMA(1, 0, At, B0); PG8_BAR; PG8_SCHED;
            PG8_STAGE(PG8_SB(1, 1), b3 + hstep, voffB);
            PG8_WAIT_V(6); PG8_BAR; PG8_MMA(1, 1, At, B1); PG8_BAR;
            }
        }
        if constexpr (ALIGN_EPI) { if (wr == 0) PG8_BAR; }
        if constexpr (!Epi::AFTER_DRAIN) { E(acc, cur, wr, wc, fr, fq); S.done(cur); }
        if (!has_next) break;
#pragma unroll
        for (int a = 0; a < 2; ++a)
#pragma unroll
            for (int b = 0; b < 2; ++b)
#pragma unroll
                for (int m = 0; m < 4; ++m)
#pragma unroll
                    for (int n = 0; n < 2; ++n) acc[a][b][m][n] = (f32x4){0.f, 0.f, 0.f, 0.f};
        cur = nxt; cA = nA; cB = nB; ++ui;
        if constexpr (ALIGN_EPI) { if (wr == 1) PG8_BAR; }
    }
    PG8_WAIT_V(0);
    if constexpr (!ALIGN_EPI) { if (wr == 0) PG8_BAR; }
    PG8_BAR;
    if constexpr (Epi::AFTER_DRAIN) { E.fused(acc, cur, wr, wc, fr, fq, lds, wid, lane); S.done(cur); }
#undef PG8_SA
#undef PG8_SB
#undef PG8_STAGE
#undef PG8_LDA
#undef PG8_LDB
#undef PG8_MMA
#undef PG8_WAIT_V
#undef PG8_WAIT_L
#undef PG8_BAR
#undef PG8_SCHED
}
}

using pg8::bf16_t; using pg8::f32x4; using pg8::u32x4; using pg8::Unit;
#define LAS __attribute__((address_space(3)))
#define GAS __attribute__((address_space(1)))

constexpr int DM = 1024, SEQ = 2048, BATCH = 16, DEPTH = 4, NIN = 3620, NTOK = BATCH * SEQ, YP = 3840;
constexpr float EPS = 1e-6f;
constexpr int O_DZ = 3200, O_DK = 3072, O_DV = 3136;
constexpr int YA_H = 0, YA_B = 256, YA_C = 512, YA_Z = 768, YB_U = 1024, YB_V = 1280, YB_Z = 1536, YC_Q = 1792, YC_K = 2048, YC_V = 2304,
              YC_Z = 2560, YD_Q = 2816, YD_Z = 3072, YD_K = 3328, YD_V = 3392, YI_Q = 3456, YI_K = 3584, YI_W = 3616;
constexpr int TOPK = 256;
constexpr int NGEMM = 3584;
constexpr int NT = 512, NW = 8;
constexpr int LDS_BYTES = 131072 + 4096;

constexpr size_t MiB = 1u << 20;
constexpr size_t WS_WTIN = 1 * MiB;
constexpr size_t WS_WTOUT = WS_WTIN + (size_t)DEPTH * YP * DM * 2;
constexpr size_t WS_SSQ = WS_WTOUT + (size_t)DEPTH * DM * DM * 2;
constexpr size_t WS_XB = WS_SSQ + (size_t)NTOK * 16 * 4;
constexpr size_t WS_Y = WS_XB + (size_t)NTOK * DM * 2;
constexpr size_t WS_MIX = WS_Y + (size_t)NTOK * YP * 2;
constexpr size_t WS_WSB = WS_MIX + (size_t)NTOK * DM * 2;
constexpr size_t WS_END = WS_WSB + (size_t)DEPTH * 4 * 128 * 128 * 2;

constexpr size_t WS_SMALL = 65536;
constexpr int SM_CONVW = 0, SM_CONVB = 3072, SM_GMLPG = 4096, SM_GMLPB = 5120, SM_QG = 7168, SM_KG = 7296, SM_LAM = 7424, SM_SUBG = 7936, SM_DQG = 8960, SM_DKG = 9216, SM_END = 9472;
struct Params {
    const float* x; const float* norm_g; const float* w_in; const float* i_conv_w; const float* i_conv_b;
    const float* i_gmlp_g; const float* gmlp_ws; const float* i_gmlp_b; const float* i_diff_qg; const float* i_diff_kg;
    const float* i_diff_lam; const float* i_diff_subg; const float* i_dsa_qg; const float* i_dsa_kg; const float* w_out;
    float* out; unsigned char* ws;
    __device__ __forceinline__ unsigned* ctl() const { return (unsigned*)ws; }
    __device__ __forceinline__ const GAS float* sm(int off) const { return (const GAS float*)(uintptr_t)(ws + WS_SMALL) + off; }
    __device__ __forceinline__ bf16_t* wt_in() const { return (bf16_t*)(ws + WS_WTIN); }
    __device__ __forceinline__ bf16_t* wt_out() const { return (bf16_t*)(ws + WS_WTOUT); }
    __device__ __forceinline__ float* ssq() const { return (float*)(ws + WS_SSQ); }
    __device__ __forceinline__ bf16_t* xb() const { return (bf16_t*)(ws + WS_XB); }
    __device__ __forceinline__ bf16_t* Y() const { return (bf16_t*)(ws + WS_Y); }
    __device__ __forceinline__ bf16_t* mix() const { return (bf16_t*)(ws + WS_MIX); }
    __device__ __forceinline__ bf16_t* wsb() const { return (bf16_t*)(ws + WS_WSB); }
};

#ifndef TSEG
#define TSEG -1
#endif
constexpr int TCTR_OFF = 131072 + 3072;
#define TB(id, ldsbase, tidv) do { if (TSEG == (id) && blockIdx.x == 0 && (tidv) == 0) *(volatile LAS unsigned long long*)((ldsbase) + TCTR_OFF + 8) = __builtin_amdgcn_s_memrealtime(); } while (0)
#define TE(id, ldsbase, tidv) do { if (TSEG == (id) && blockIdx.x == 0 && (tidv) == 0) { const unsigned _d = (unsigned)(__builtin_amdgcn_s_memrealtime() - *(volatile LAS unsigned long long*)((ldsbase) + TCTR_OFF + 8)); *(volatile LAS unsigned*)((ldsbase) + TCTR_OFF) += _d; } } while (0)
__device__ __forceinline__ unsigned f2bf(float f) { unsigned u = __float_as_uint(f); return (u + 0x7fffu + ((u >> 16) & 1u)) >> 16; }
__device__ __forceinline__ unsigned pk2(float lo, float hi) { return f2bf(lo) | (f2bf(hi) << 16); }
__device__ __forceinline__ float bf2f(bf16_t b) { return __uint_as_float((unsigned)b << 16); }

__device__ __forceinline__ float xsum32(float v) { const auto r = __builtin_amdgcn_permlane32_swap(__float_as_uint(v), __float_as_uint(v), false, false); return __uint_as_float(r[0]) + __uint_as_float(r[1]); }
__device__ __forceinline__ float xmax32(float v) { const auto r = __builtin_amdgcn_permlane32_swap(__float_as_uint(v), __float_as_uint(v), false, false); return fmaxf(__uint_as_float(r[0]), __uint_as_float(r[1])); }
__device__ __forceinline__ int xsum32i(int v) { const auto r = __builtin_amdgcn_permlane32_swap((unsigned)v, (unsigned)v, false, false); return (int)(r[0] + r[1]); }
__device__ __forceinline__ float xsum16(float v) { const auto r = __builtin_amdgcn_permlane16_swap(__float_as_uint(v), __float_as_uint(v), false, false); return __uint_as_float(r[0]) + __uint_as_float(r[1]); }
__device__ __forceinline__ float wave_sum64(float v) {
    v += __uint_as_float(__builtin_amdgcn_update_dpp(0, __float_as_uint(v), 0x128, 0xf, 0xf, true));
    v += __uint_as_float(__builtin_amdgcn_update_dpp(0, __float_as_uint(v), 0x124, 0xf, 0xf, true));
    v += __uint_as_float(__builtin_amdgcn_update_dpp(0, __float_as_uint(v), 0x122, 0xf, 0xf, true));
    v += __uint_as_float(__builtin_amdgcn_update_dpp(0, __float_as_uint(v), 0x121, 0xf, 0xf, true));
    return xsum32(xsum16(v));
}
__device__ __forceinline__ float wave_sum(float v) {
#pragma unroll
    for (int o = 32; o > 0; o >>= 1) v += __shfl_xor(v, o);
    return v;
}
__device__ __forceinline__ float wave_max(float v) {
#pragma unroll
    for (int o = 32; o > 0; o >>= 1) v = fmaxf(v, __shfl_xor(v, o));
    return v;
}
__device__ __forceinline__ int wave_sumi(int v) {
#pragma unroll
    for (int o = 32; o > 0; o >>= 1) v += __shfl_xor(v, o);
    return v;
}
__device__ __forceinline__ float block_sum(float v, float* red) {
    v = wave_sum(v);
    __syncthreads();
    if ((threadIdx.x & 63) == 0) red[threadIdx.x >> 6] = v;
    __syncthreads();
    float s = 0.f;
#pragma unroll
    for (int i = 0; i < NW; ++i) s += red[i];
    return s;
}
__device__ __forceinline__ float block_max(float v, float* red) {
    v = wave_max(v);
    __syncthreads();
    if ((threadIdx.x & 63) == 0) red[threadIdx.x >> 6] = v;
    __syncthreads();
    float s = red[0];
#pragma unroll
    for (int i = 1; i < NW; ++i) s = fmaxf(s, red[i]);
    return s;
}
__device__ __forceinline__ int block_sumi(int v, int* red) {
    v = wave_sumi(v);
    __syncthreads();
    if ((threadIdx.x & 63) == 0) red[threadIdx.x >> 6] = v;
    __syncthreads();
    int s = 0;
#pragma unroll
    for (int i = 0; i < NW; ++i) s += red[i];
    return s;
}
__device__ __forceinline__ int block_excl_scan(int v, int* red, int* tot) {
    const int lane = threadIdx.x & 63, w = threadIdx.x >> 6;
    int inc = v;
#pragma unroll
    for (int o = 1; o < 64; o <<= 1) { int n = __shfl_up(inc, o); if (lane >= o) inc += n; }
    __syncthreads();
    if (lane == 63) red[w] = inc;
    __syncthreads();
    int base = 0, t = 0;
#pragma unroll
    for (int i = 0; i < NW; ++i) { if (i < w) base += red[i]; t += red[i]; }
    *tot = t;
    return base + inc - v;
}

__device__ __forceinline__ int phys2logical(int n) { const int p = n & 255; return (n & ~255) + 64 * ((p >> 5) & 3) + 32 * (p >> 7) + (p & 31); }
__device__ __forceinline__ int logical2orig(int n) {
    if (n < 3072) return n;
    if (n < YD_K) return n - YD_Z + O_DZ;
    if (n < YD_V) return n - YD_K + O_DK;
    if (n < YI_Q) return n - YD_V + O_DV;
    if (n < NIN) return n;
    return -1;
}
__device__ __forceinline__ void transpose_item(const float* W, int ldn, const float* gk, bf16_t* WT, int k0, int r0, int r1, int src, LAS float* scr, int lane) {
    float v[64];
#pragma unroll
    for (int i = 0; i < 64; ++i) v[i] = src >= 0 ? *(const GAS float*)(uintptr_t)(W + (size_t)(k0 + i) * ldn + src) : 0.f;
#pragma unroll
    for (int i = 0; i < 64; ++i) scr[i * 65 + lane] = gk ? v[i] * gk[k0 + i] : v[i];
    asm volatile("s_waitcnt lgkmcnt(0)" ::: "memory");
#pragma unroll
    for (int q = 0; q < 8; ++q) {
        const int id = lane + 64 * q, j = id >> 3, c = id & 7;
        const LAS float* s = scr + (8 * c) * 65 + j;
        u32x4 o; o.x = pk2(s[0 * 65], s[1 * 65]); o.y = pk2(s[2 * 65], s[3 * 65]); o.z = pk2(s[4 * 65], s[5 * 65]); o.w = pk2(s[6 * 65], s[7 * 65]);
        *(GAS u32x4*)(uintptr_t)(WT + (size_t)((j < 32 ? r0 : r1 - 32) + j) * DM + k0 + 8 * c) = o;
    }
    asm volatile("s_waitcnt lgkmcnt(0)" ::: "memory");
}
__device__ __forceinline__ int tid_now(int wave_s) { int lane; asm volatile("v_mbcnt_lo_u32_b32 %0, -1, 0\n\tv_mbcnt_hi_u32_b32 %0, -1, %0" : "=v"(lane)); return wave_s * 64 + lane; }
__device__ __forceinline__ void ph_prologue(const Params& p, LAS unsigned char* lds, int tid_in) {
    int tid = tid_in; asm volatile("" : "+v"(tid));
    const int lane = tid & 63, wave = tid >> 6;
    LAS float* scr = (LAS float*)(lds + wave * 16640);
    const int gw = blockIdx.x * NW + wave, ngw = gridDim.x * NW;
    constexpr int I_IN = DEPTH * 16 * (YP / 64), I_OUT = DEPTH * 16 * (DM / 64);
    TB(22, lds, tid);
    for (int it = gw; it < I_IN + I_OUT; it += ngw) {
        if (it < I_IN) {
            const int l = it / (16 * (YP / 64)), r = it % (16 * (YP / 64)), kb = r / (YP / 64), g = r % (YP / 64), tile = g >> 2, wc = g & 3;
            const int src = logical2orig(256 * tile + 64 * wc + lane);
            transpose_item(p.w_in + (size_t)l * DM * NIN, NIN, p.norm_g + l * DM, p.wt_in() + (size_t)l * YP * DM, kb * 64, 256 * tile + 32 * wc, 256 * tile + 128 + 32 * wc, src, scr, lane);
        } else {
            const int q = it - I_IN, l = q / (16 * (DM / 64)), r = q % (16 * (DM / 64)), kb = r / (DM / 64), g = r % (DM / 64);
            transpose_item(p.w_out + (size_t)l * DM * DM, DM, nullptr, p.wt_out() + (size_t)l * DM * DM, kb * 64, 64 * g, 64 * g + 32, 64 * g + lane, scr, lane);
        }
    }
    {
        float* sm = (float*)(p.ws + WS_SMALL);
        for (int i = blockIdx.x * NT + tid; i < SM_END; i += gridDim.x * NT) {
            float v;
            if (i < SM_CONVB) v = p.i_conv_w[i - SM_CONVW]; else if (i < SM_GMLPG) v = p.i_conv_b[i - SM_CONVB]; else if (i < SM_GMLPB) v = p.i_gmlp_g[i - SM_GMLPG];
            else if (i < SM_QG) v = p.i_gmlp_b[i - SM_GMLPB]; else if (i < SM_KG) v = p.i_diff_qg[i - SM_QG]; else if (i < SM_LAM) v = p.i_diff_kg[i - SM_KG];
            else if (i < SM_SUBG) v = p.i_diff_lam[i - SM_LAM]; else if (i < SM_DQG) v = p.i_diff_subg[i - SM_SUBG]; else if (i < SM_DKG) v = p.i_dsa_qg[i - SM_DQG];
            else v = p.i_dsa_kg[i - SM_DKG];
            sm[i] = v;
        }
    }
    for (int i = (blockIdx.x * NT + tid) * 4; i < DEPTH * 4 * 128 * 128; i += gridDim.x * NT * 4) {
        const f32x4 v = *(const GAS f32x4*)(uintptr_t)(p.gmlp_ws + i);
        *(GAS unsigned long long*)(uintptr_t)(p.wsb() + i) = (unsigned long long)pk2(v.x, v.y) | ((unsigned long long)pk2(v.z, v.w) << 32);
    }
    TE(22, lds, tid);
    TB(23, lds, tid);
    for (int r0 = gw * 4; r0 < NTOK; r0 += ngw * 4) {
        f32x4 v[4][4];
#pragma unroll
        for (int rr = 0; rr < 4; ++rr)
#pragma unroll
            for (int j = 0; j < 4; ++j) v[rr][j] = ((const GAS f32x4*)(uintptr_t)(p.x + (size_t)(r0 + rr) * DM))[lane + 64 * j];
#pragma unroll
        for (int rr = 0; rr < 4; ++rr) {
            GAS unsigned long long* o8 = (GAS unsigned long long*)(uintptr_t)(p.xb() + (size_t)(r0 + rr) * DM) + lane;
            float s = 0.f;
#pragma unroll
            for (int j = 0; j < 4; ++j) {
                const f32x4 q = v[rr][j];
                s += (q.x * q.x + q.y * q.y) + (q.z * q.z + q.w * q.w);
                o8[64 * j] = (unsigned long long)pk2(q.x, q.y) | ((unsigned long long)pk2(q.z, q.w) << 32);
            }
            s = wave_sum64(s);
            if (lane < 16) ((GAS float*)(uintptr_t)p.ssq())[(size_t)(r0 + rr) * 16 + lane] = lane == 0 ? s : 0.f;
        }
    }
    TE(23, lds, tid);
}

__device__ __forceinline__ float silu_f(float v) { return v * __builtin_amdgcn_rcpf(1.f + __builtin_amdgcn_exp2f(-1.4426950408889634f * v)); }
struct EpiIn {
    static constexpr bool PERM = true, AFTER_DRAIN = false;
    unsigned char* ws; int l; LAS float* rs;
    __device__ __forceinline__ void operator()(const f32x4 (&acc)[2][2][4][2], const Unit& u, int wr, int wc, int fr_, int fq_) const {
        int fr = fr_, fq = fq_; asm volatile("" : "+v"(fr), "+v"(fq));
        const int pn = u.pn;
        bf16_t* Y = (bf16_t*)(ws + WS_Y); const float* ssq = (const float*)(ws + WS_SSQ); const float* smb = (const float*)(ws + WS_SMALL);
        const float* gmlp_g = smb + SM_GMLPG + l * 256; const float* qg = smb + SM_QG + l * 32; const float* kg = smb + SM_KG + l * 32;
        const float* dqg = smb + SM_DQG + l * 64; const float* dkg = smb + SM_DKG + l * 64;
        int op = 0; const float* g0 = nullptr; const float* g1 = nullptr;
        if (pn == 3 || pn == 6 || pn == 10 || pn == 12) op = 1;
        else if (pn == 4) op = 2;
        else if (pn == 5) { op = 3; g0 = gmlp_g + 64 * wc + 8 * fq; g1 = g0 + 32; }
        else if (pn == 7) { op = 4; g0 = qg + 8 * fq; g1 = g0; }
        else if (pn == 8) { op = 4; g0 = kg + 8 * fq; g1 = g0; }
        else if (pn == 11) { op = 5; g0 = dqg + 8 * fq; g1 = g0 + 32; }
        else if (pn == 13 && wc == 0) { op = 5; g0 = dkg + 8 * fq; g1 = g0 + 32; }
        float gn[16];
#pragma unroll
        for (int i = 0; i < 16; ++i) gn[i] = 1.f;
        if (op >= 3) {
            const f32x4 a = *(const GAS f32x4*)(uintptr_t)g0, b = *(const GAS f32x4*)(uintptr_t)(g0 + 4), c = *(const GAS f32x4*)(uintptr_t)g1, d = *(const GAS f32x4*)(uintptr_t)(g1 + 4);
            gn[0] = a.x; gn[1] = a.y; gn[2] = a.z; gn[3] = a.w; gn[4] = b.x; gn[5] = b.y; gn[6] = b.z; gn[7] = b.w;
            gn[8] = c.x; gn[9] = c.y; gn[10] = c.z; gn[11] = c.w; gn[12] = d.x; gn[13] = d.y; gn[14] = d.z; gn[15] = d.w;
        }
        const int colb = pn * 256 + 64 * wc + 8 * fq;
        TB(14, (LAS unsigned char*)rs - (131072 + 1024), wr * 256 + wc * 64 + fq * 16 + fr);
        {
            const int t = wr * 256 + wc * 64 + fq * 16 + fr;
            if (t < 256) {
                const f32x4* sp = (const f32x4*)(ssq + (size_t)(u.pm * 256 + t) * 16);
                const f32x4 s0 = sp[0], s1 = sp[1], s2 = sp[2], s3 = sp[3];
                const float tot = ((s0.x + s0.y) + (s0.z + s0.w)) + ((s1.x + s1.y) + (s1.z + s1.w)) + ((s2.x + s2.y) + (s2.z + s2.w)) + ((s3.x + s3.y) + (s3.z + s3.w));
                rs[t] = rsqrtf(tot * (1.f / DM) + EPS);
            }
            asm volatile("s_waitcnt vmcnt(0) lgkmcnt(0)" ::: "memory"); __builtin_amdgcn_s_barrier(); asm volatile("" ::: "memory");
        }
#pragma unroll
        for (int ai = 0; ai < 2; ++ai)
#pragma unroll
            for (int m = 0; m < 4; ++m) {
                const int row = u.pm * 256 + ai * 128 + wr * 64 + m * 16 + fr;
                const float rstd = rs[ai * 128 + wr * 64 + m * 16 + fr];
                float v[16];
#pragma unroll
                for (int bj = 0; bj < 2; ++bj)
#pragma unroll
                    for (int n = 0; n < 2; ++n)
#pragma unroll
                        for (int e = 0; e < 4; ++e) v[bj * 8 + n * 4 + e] = acc[ai][bj][m][n][e] * rstd;
                if (op == 1) {
#pragma unroll
                    for (int i = 0; i < 16; ++i) v[i] = silu_f(v[i]);
                } else if (op == 2 || op == 3) {
#pragma unroll
                    for (int i = 0; i < 16; i += 2) { const pg8::f32x2 r = pg8::gelu_pk((pg8::f32x2){v[i], v[i + 1]}); v[i] = r.x; v[i + 1] = r.y; }
                }
                if (op == 3 || op == 5) {
                    float ss = 0.f;
#pragma unroll
                    for (int i = 0; i < 16; ++i) ss += v[i] * v[i];
                    ss = xsum16(ss); ss = xsum32(ss);
                    const float sc = rsqrtf(ss * (1.f / 64) + EPS);
#pragma unroll
                    for (int i = 0; i < 16; ++i) v[i] *= sc * gn[i];
                } else if (op == 4) {
#pragma unroll
                    for (int bj = 0; bj < 2; ++bj) {
                        float ss = 0.f;
#pragma unroll
                        for (int i = 0; i < 8; ++i) ss += v[bj * 8 + i] * v[bj * 8 + i];
                        ss = xsum16(ss); ss = xsum32(ss);
                        const float sc = rsqrtf(ss * (1.f / 32) + EPS);
#pragma unroll
                        for (int i = 0; i < 8; ++i) v[bj * 8 + i] *= sc * gn[bj * 8 + i];
                    }
                }
                bf16_t* rowp = Y + (size_t)row * YP + colb;
#pragma unroll
                for (int bj = 0; bj < 2; ++bj) {
                    u32x4 w; w.x = pg8::cvt_pk_bf16(v[bj * 8 + 0], v[bj * 8 + 1]); w.y = pg8::cvt_pk_bf16(v[bj * 8 + 2], v[bj * 8 + 3]);
                    w.z = pg8::cvt_pk_bf16(v[bj * 8 + 4], v[bj * 8 + 5]); w.w = pg8::cvt_pk_bf16(v[bj * 8 + 6], v[bj * 8 + 7]);
                    *(GAS u32x4*)(uintptr_t)(rowp + 32 * bj) = w;
                }
            }
        TE(14, (LAS unsigned char*)rs - (131072 + 1024), wr * 256 + wc * 64 + fq * 16 + fr);
    }
};
struct EpiOut {
    static constexpr bool PERM = false, AFTER_DRAIN = false;
    float* xout; unsigned char* ws;
    __device__ __forceinline__ void operator()(const f32x4 (&acc)[2][2][4][2], const Unit& u, int wr, int wc, int fr_, int fq_) const {
        int fr = fr_, fq = fq_; asm volatile("" : "+v"(fr), "+v"(fq));
        const int col0 = u.pn * 256 + wc * 32 + 4 * fq;
        bf16_t* xb = (bf16_t*)(ws + WS_XB); float* ssq = (float*)(ws + WS_SSQ);
#pragma unroll
        for (int ai = 0; ai < 2; ++ai)
#pragma unroll
            for (int m = 0; m < 4; ++m) {
                const int row = u.pm * 256 + ai * 128 + wr * 64 + m * 16 + fr;
                float sq = 0.f;
#pragma unroll
                for (int bj = 0; bj < 2; ++bj)
#pragma unroll
                    for (int n = 0; n < 2; ++n) {
                        const size_t off = (size_t)row * DM + col0 + bj * 128 + n * 16;
                        const unsigned long long xo = *(const GAS unsigned long long*)(uintptr_t)(xb + off);
                        f32x4 v = acc[ai][bj][m][n];
                        v.x += __uint_as_float((unsigned)xo << 16); v.y += __uint_as_float((unsigned)xo & 0xffff0000u);
                        v.z += __uint_as_float((unsigned)(xo >> 32) << 16); v.w += __uint_as_float((unsigned)(xo >> 32) & 0xffff0000u);
                        sq += (v.x * v.x + v.y * v.y) + (v.z * v.z + v.w * v.w);
                        if (xout) *(GAS f32x4*)(uintptr_t)(xout + off) = v;
                        else *(GAS unsigned long long*)(uintptr_t)(xb + off) = (unsigned long long)pg8::cvt_pk_bf16(v.x, v.y) | ((unsigned long long)pg8::cvt_pk_bf16(v.z, v.w) << 32);
                    }
                sq = xsum16(sq); sq = xsum32(sq);
                if (fq == 0) ssq[(size_t)row * 16 + u.pn * 4 + wc] = sq;
                if (m == 3) asm volatile("" ::: "memory");
            }
    }
};
#define XB_TMO      128
#define XB_XCNT(j)  (256  + 64 * (j))
#define XB_XSUB(j)  (1280 + 64 * (j))
#define XB_XGEN(j)  (2304 + 64 * (j))
#define XB_TOP      3328
#define XB_TOPGEN   3392
#define XCD_BAR_WORDS 3456
#define XB_SPIN_CAP (1u << 18)

__device__ __forceinline__ unsigned xb_ld(unsigned* p)              { return __hip_atomic_load(p, __ATOMIC_RELAXED, __HIP_MEMORY_SCOPE_AGENT); }
__device__ __forceinline__ unsigned xb_add(unsigned* p, unsigned v) { return __hip_atomic_fetch_add(p, v, __ATOMIC_RELAXED, __HIP_MEMORY_SCOPE_AGENT); }
__device__ __forceinline__ unsigned xb_xcc_id() { return (unsigned)__builtin_amdgcn_s_getreg((3 << 11) | 20) & 0xFu; }
#define XB_SPIN(cond, bar) do { unsigned _sp = 0; while (cond) { __builtin_amdgcn_s_sleep(1); \
    if ((++_sp & 255u) == 0u) { if (xb_ld(&(bar)[XB_TMO])) break; if (_sp > XB_SPIN_CAP) { atomicAdd(&(bar)[XB_TMO], 1u); break; } } } } while (0)

struct XcdBarrier {
    unsigned* bar; unsigned x;
    volatile LAS unsigned* st;
};

__device__ __forceinline__ XcdBarrier xcd_barrier_post(unsigned* bar, volatile LAS unsigned* st) {
    XcdBarrier b; b.bar = bar; b.x = xb_xcc_id(); b.st = st;
    if (threadIdx.x == 0) (void)xb_add(&bar[XB_XCNT(b.x)], 1u);
    return b;
}
__device__ __forceinline__ void xcd_barrier_complete(unsigned* bar, unsigned x, unsigned& nloc, unsigned& nx) {
    const unsigned G = gridDim.x * gridDim.y * gridDim.z;
    unsigned sum, cnt, mine, sp = 0u;
    for (;;) {
        sum = 0u; cnt = 0u; mine = 0u;
#pragma unroll
        for (unsigned j = 0; j < 16; ++j) { const unsigned c = xb_ld(&bar[XB_XCNT(j)]); sum += c; cnt += (c > 0u) ? 1u : 0u; mine = (j == x) ? c : mine; }
        if (sum == G) break;
        __builtin_amdgcn_s_sleep(1);
        if ((++sp & 255u) == 0u) { if (xb_ld(&bar[XB_TMO])) break; if (sp > XB_SPIN_CAP) { atomicAdd(&bar[XB_TMO], 1u); break; } }
    }
    nloc = mine > 0u ? mine : 1u; nx = cnt > 0u ? cnt : 1u;
}

__device__ __forceinline__ void xcd_barrier(const XcdBarrier& b, int tid_in) {
    asm volatile("s_waitcnt vmcnt(0)" ::: "memory");
    __syncthreads();
    int t0_ = tid_in; asm volatile("" : "+v"(t0_));
    if (t0_ == 0) {
        unsigned* bar = b.bar; unsigned bx = b.x; asm volatile("" : "+s"(bar), "+s"(bx));
        __builtin_amdgcn_s_waitcnt(0);
        unsigned nloc = b.st[0], nx = b.st[1];
        if (nloc == 0u) { xcd_barrier_complete(bar, bx, nloc, nx); b.st[0] = nloc; b.st[1] = nx; }
        const unsigned old = xb_add(&bar[XB_XSUB(bx)], 1u);
        const unsigned gen = old / nloc;
        if (old + 1u == (gen + 1u) * nloc) {
            __builtin_amdgcn_fence(__ATOMIC_RELEASE, "agent");
            asm volatile("s_waitcnt vmcnt(0)" ::: "memory");
            const unsigned og = xb_add(&bar[XB_TOP], 1u);
            const unsigned tg = og / nx;
            if (og + 1u == (tg + 1u) * nx) xb_add(&bar[XB_TOPGEN], 1u);
            else XB_SPIN(xb_ld(&bar[XB_TOPGEN]) == tg, bar);
            __builtin_amdgcn_fence(__ATOMIC_ACQUIRE, "agent");
            xb_add(&bar[XB_XGEN(bx)], 1u);
            asm volatile("s_waitcnt vmcnt(0)" ::: "memory");
        } else {
            XB_SPIN(xb_ld(&bar[XB_XGEN(bx)]) == gen, bar);
            __builtin_amdgcn_fence(__ATOMIC_ACQUIRE, "agent");
            asm volatile("s_waitcnt vmcnt(0)" ::: "memory");
        }
    }
    __syncthreads();
}

typedef short bf16x8_t __attribute__((ext_vector_type(8)));
typedef short s16x4_t __attribute__((ext_vector_type(4)));
typedef float f32x16 __attribute__((ext_vector_type(16)));
typedef float f32x2_t __attribute__((ext_vector_type(2)));
typedef __bf16 bf16x2_t __attribute__((ext_vector_type(2)));
#define MFMA32(a, b, c) __builtin_amdgcn_mfma_f32_32x32x16_bf16((a), (b), (c), 0, 0, 0)
__device__ __forceinline__ unsigned cvtpk(float lo, float hi) { f32x2_t v = {lo, hi}; bf16x2_t b = __builtin_convertvector(v, bf16x2_t); return __builtin_bit_cast(unsigned, b); }
__device__ __forceinline__ s16x4_t ds_tr16(const LAS unsigned char* p) { return __builtin_bit_cast(s16x4_t, __builtin_amdgcn_ds_read_tr16_b64_v4i16((LAS s16x4_t*)p)); }
__device__ __forceinline__ bf16x8_t pack_step(const f32x16& x, int s) {
    u32x4 p; p.x = cvtpk(x[8 * s], x[8 * s + 1]); p.y = cvtpk(x[8 * s + 2], x[8 * s + 3]); p.z = cvtpk(x[8 * s + 4], x[8 * s + 5]); p.w = cvtpk(x[8 * s + 6], x[8 * s + 7]);
    return __builtin_bit_cast(bf16x8_t, p);
}
constexpr int KV_STRIDE = 144;
constexpr int KV_TILE = 64 * KV_STRIDE;
__device__ __forceinline__ bf16x8_t vt_frag(const LAS unsigned char* vtile, int ks, int db, int lane) {
    const int i16 = lane & 15, q = i16 >> 2, pp = i16 & 3, blk = (lane >> 4) & 1, hh = lane >> 5;
    const LAS unsigned char* a = vtile + (16 * ks + 4 * hh + q) * KV_STRIDE + (32 * db + 16 * blk + 4 * pp) * 2;
    const s16x4_t lo = ds_tr16(a), hi = ds_tr16(a + 8 * KV_STRIDE);
    return __builtin_shufflevector(lo, hi, 0, 1, 2, 3, 4, 5, 6, 7);
}

constexpr int KVL_TILE = 64 * 128;
__device__ __forceinline__ void dma_piece(const bf16_t* src_row0, LAS unsigned char* dst, int lane) {
    const bf16_t* g = src_row0 + (size_t)(lane >> 3) * YP + (((lane & 7) ^ (lane >> 3)) * 8);
    const unsigned d = (unsigned)__builtin_amdgcn_readfirstlane((int)(unsigned)(size_t)dst);
    unsigned keep;
    asm volatile("s_mov_b32 %0, m0\n\ts_mov_b32 m0, %2\n\ts_nop 0\n\tglobal_load_lds_dwordx4 %1, off\n\ts_mov_b32 m0, %0" : "=&s"(keep) : "v"(g), "s"(d) : "memory");
}
__device__ __forceinline__ bf16x8_t vt_frag_sw(const LAS unsigned char* vtile, int ks, int db, int lane) {
    const int i16 = lane & 15, q = i16 >> 2, pp = i16 & 3, blk = (lane >> 4) & 1, hh = lane >> 5;
    const int row = 16 * ks + 4 * hh + q, ch = 4 * db + 2 * blk + (pp >> 1);
    const LAS unsigned char* a = vtile + row * 128 + ((ch ^ (row & 7)) * 16) + (pp & 1) * 8;
    const s16x4_t lo = ds_tr16(a), hi = ds_tr16(a + 8 * 128);
    return __builtin_shufflevector(lo, hi, 0, 1, 2, 3, 4, 5, 6, 7);
}

__device__ __forceinline__ void mixC_unit(const Params& p, int l, int b, int h, int qt, LAS unsigned char* lds, int wave_s) {
    const int tid = tid_now(wave_s);
    volatile LAS float* pc = (volatile LAS float*)(lds + 131072 + 2048);
    const float mfix = pc[0];
    const int lane = tid & 63, wave = __builtin_amdgcn_readfirstlane(tid >> 6), r32 = lane & 31, hh = lane >> 5;
    const size_t rowb = (size_t)b * SEQ;
    const int q0 = qt * 256 + wave * 32;
    const int cw = (q0 >> 6);
    const int jmax = 4 * qt + 3;
    const int pos = q0 + r32;
    const bf16_t* yq = p.Y() + (rowb + pos) * YP;
    bf16x8_t qf[2][2];
#pragma unroll
    for (int c = 0; c < 2; ++c)
#pragma unroll
        for (int s = 0; s < 2; ++s) qf[c][s] = *(const GAS bf16x8_t*)(uintptr_t)(yq + YC_Q + h * 64 + c * 32 + 16 * s + 8 * hh);
    const float c1 = 0.17677669529663687f * 1.4426950408889634f;
    const float sl2 = exp2f(-(float)(2 * h + 1)) * 1.4426950408889634f;
    f32x16 o[2][2];
#pragma unroll
    for (int c = 0; c < 2; ++c)
#pragma unroll
        for (int d = 0; d < 2; ++d)
#pragma unroll
            for (int i = 0; i < 16; ++i) o[c][d][i] = 0.f;
    float lrun[2] = {0.f, 0.f};
    const bf16_t* ksrc = p.Y() + (rowb + 8 * wave) * YP + YC_K + h * 64;
    const bf16_t* vsrc = p.Y() + (rowb + 8 * wave) * YP + YC_V + h * 64;
    LAS unsigned char* kring = lds;
    LAS unsigned char* vring = lds + 6 * KVL_TILE;
    asm volatile("" : "+v"(qf[0][0]), "+v"(qf[0][1]), "+v"(qf[1][0]), "+v"(qf[1][1]));
    const float mfix_r = mfix; asm volatile("" :: "v"(mfix_r));
    asm volatile("s_waitcnt lgkmcnt(0)" ::: "memory"); __builtin_amdgcn_s_barrier(); asm volatile("" ::: "memory");
#pragma unroll
    for (int t = 0; t < 4; ++t) { dma_piece(ksrc + (size_t)t * 64 * YP, kring + t * KVL_TILE + wave * 1024, lane); dma_piece(vsrc + (size_t)t * 64 * YP, vring + t * KVL_TILE + wave * 1024, lane); }
    int slot = 0, slot2 = 4;
    for (int j = 0; j <= jmax; ++j) {
        if ((j & 1) == 0) {
            TB(3, lds, tid);
            if (j + 2 <= jmax) asm volatile("s_waitcnt vmcnt(4)" ::: "memory"); else asm volatile("s_waitcnt vmcnt(0)" ::: "memory");
            __builtin_amdgcn_s_barrier(); asm volatile("" ::: "memory");
            if (j + 4 <= jmax) {
#pragma unroll
                for (int t = 0; t < 2; ++t) {
                    const int sl = slot2 + t >= 6 ? slot2 + t - 6 : slot2 + t;
                    dma_piece(ksrc + (size_t)(j + 4 + t) * 64 * YP, kring + sl * KVL_TILE + wave * 1024, lane); dma_piece(vsrc + (size_t)(j + 4 + t) * 64 * YP, vring + sl * KVL_TILE + wave * 1024, lane);
                }
            }
            TE(3, lds, tid);
        }
        TB(2, lds, tid);
        if (j <= cw) {
            const LAS unsigned char* kt = kring + slot * KVL_TILE;
            const LAS unsigned char* vt = vring + slot * KVL_TILE;
            const float pl = (float)(pos - 64 * j - 4 * hh);
            const bool diag = (j == cw);
#pragma unroll
            for (int c = 0; c < 2; ++c) {
                f32x16 sc[2];
#pragma unroll
                for (int kb = 0; kb < 2; ++kb) {
                    f32x16 a;
#pragma unroll
                    for (int i = 0; i < 16; ++i) a[i] = 0.f;
#pragma unroll
                    for (int s = 0; s < 2; ++s) {
                        const bf16x8_t kf = *(const LAS bf16x8_t*)(kt + (32 * kb + r32) * 128 + (((4 * c + 2 * s + hh) ^ (r32 & 7)) * 16));
                        a = MFMA32(kf, qf[c][s], a);
                    }
                    sc[kb] = a;
                }
                float ls4[4] = {0.f, 0.f, 0.f, 0.f};
                if (!diag) {
                    const float rt = -sl2 * pl - mfix;
                    const f32x2_t d01 = {0.f, sl2}, d23 = {2.f * sl2, 3.f * sl2}, c1v = {c1, c1};
                    f32x2_t lsv0 = {0.f, 0.f}, lsv1 = {0.f, 0.f};
#pragma unroll
                    for (int kb = 0; kb < 2; ++kb)
#pragma unroll
                        for (int g = 0; g < 4; ++g) {
                            const float bs = fmaf(sl2, (float)(32 * kb + 8 * g), rt);
                            const f32x2_t bv = {bs, bs};
                            const f32x2_t t01 = (f32x2_t){sc[kb][4 * g], sc[kb][4 * g + 1]} * c1v + (bv + d01);
                            const f32x2_t t23 = (f32x2_t){sc[kb][4 * g + 2], sc[kb][4 * g + 3]} * c1v + (bv + d23);
                            const f32x2_t e01 = {__builtin_amdgcn_exp2f(t01.x), __builtin_amdgcn_exp2f(t01.y)}, e23 = {__builtin_amdgcn_exp2f(t23.x), __builtin_amdgcn_exp2f(t23.y)};
                            sc[kb][4 * g] = e01.x; sc[kb][4 * g + 1] = e01.y; sc[kb][4 * g + 2] = e23.x; sc[kb][4 * g + 3] = e23.y;
                            lsv0 += e01; lsv1 += e23;
                        }
                    ls4[0] = lsv0.x; ls4[1] = lsv0.y; ls4[2] = lsv1.x; ls4[3] = lsv1.y;
                } else {
#pragma unroll
                    for (int kb = 0; kb < 2; ++kb)
#pragma unroll
                        for (int i = 0; i < 16; ++i) {
                            const float kc = (float)(32 * kb + (i & 3) + 8 * (i >> 2));
                            const float e = __builtin_amdgcn_exp2f(fmaf(sc[kb][i], c1, fmaf(-sl2, fabsf(pl - kc), -mfix)));
                            sc[kb][i] = e; ls4[i & 3] += e;
                        }
                }
                lrun[c] += (ls4[0] + ls4[1]) + (ls4[2] + ls4[3]);
#pragma unroll
                for (int ks = 0; ks < 4; ++ks) {
                    const bf16x8_t pf = pack_step(sc[ks >> 1], ks & 1);
#pragma unroll
                    for (int db = 0; db < 2; ++db) o[c][db] = MFMA32(vt_frag_sw(vt, ks, db, lane), pf, o[c][db]);
                }
            }
        }
        TE(2, lds, tid);
        slot = slot == 5 ? 0 : slot + 1; slot2 = slot2 == 5 ? 0 : slot2 + 1;
    }
    const float lam = pc[1], oml = pc[2];
    const int tid2 = tid_now(wave_s), lane2 = tid2 & 63, r32e = lane2 & 31, hhe = lane2 >> 5;
    const int pose = qt * 256 + wave * 32 + r32e;
    const bf16_t* yqe = p.Y() + (rowb + pose) * YP;
    const float l1 = xsum32(lrun[0]), l2 = xsum32(lrun[1]);
    const float i1 = 1.f / l1, i2 = lam / l2;
    float ss = 0.f;
#pragma unroll
    for (int d = 0; d < 2; ++d)
#pragma unroll
        for (int i = 0; i < 16; ++i) { const float v = o[0][d][i] * i1 - o[1][d][i] * i2; o[0][d][i] = v; ss += v * v; }
    ss = xsum32(ss);
    const float rn = rsqrtf(ss * (1.f / 64) + EPS) * oml;
    const GAS float* sg = p.sm(SM_SUBG) + l * 256 + h * 64;
    bf16_t* mrow = p.mix() + (rowb + pose) * DM + 512 + h * 64;
#pragma unroll
    for (int d = 0; d < 2; ++d)
#pragma unroll
        for (int g = 0; g < 4; ++g) {
            const int d0 = 32 * d + 8 * g + 4 * hhe;
            const f32x4 gv = *(const GAS f32x4*)(uintptr_t)(sg + d0);
            const unsigned long long zz = *(const GAS unsigned long long*)(uintptr_t)(yqe + YC_Z + h * 64 + d0);
            const float z0 = __uint_as_float((unsigned)(zz & 0xffffu) << 16), z1 = __uint_as_float((unsigned)((zz >> 16) & 0xffffu) << 16),
                        z2 = __uint_as_float((unsigned)((zz >> 32) & 0xffffu) << 16), z3 = __uint_as_float((unsigned)((zz >> 48) & 0xffffu) << 16);
            const float v0 = o[0][d][4 * g] * rn * gv.x * z0, v1 = o[0][d][4 * g + 1] * rn * gv.y * z1, v2 = o[0][d][4 * g + 2] * rn * gv.z * z2, v3 = o[0][d][4 * g + 3] * rn * gv.w * z3;
            *(GAS unsigned long long*)(uintptr_t)(mrow + d0) = (unsigned long long)cvtpk(v0, v1) | ((unsigned long long)cvtpk(v2, v3) << 32);
        }
}
__device__ __forceinline__ void ph_mixC(const Params& p, int l, LAS unsigned char* lds, int bid, int nb, int wave_s) {
    {
        const float lam_init = l == 0 ? 0.200000001f : l == 1 ? 0.355509068f : l == 2 ? 0.470713018f : 0.556058204f;
        const GAS float* lp = p.sm(SM_LAM) + l * 128;
        float d1 = 0.f, d2 = 0.f;
        for (int i = 0; i < 32; ++i) { d1 += lp[i] * lp[32 + i]; d2 += lp[64 + i] * lp[96 + i]; }
        float gq = 0.f, gk = 0.f;
        for (int i = 0; i < 32; ++i) { gq = fmaxf(gq, fabsf(p.sm(SM_QG)[l * 32 + i])); gk = fmaxf(gk, fabsf(p.sm(SM_KG)[l * 32 + i])); }
        volatile LAS float* pc = (volatile LAS float*)(lds + 131072 + 2048);
        if (tid_now(wave_s) == 0) {
            pc[0] = 0.17677669529663687f * 1.4426950408889634f * 32.f * gq * gk * 1.02f;
            pc[1] = expf(d1) - expf(d2) + lam_init;
            pc[2] = 1.f - lam_init;
        }
        __syncthreads();
    }
    for (int i = bid; i < 256; i += nb) {
#pragma unroll 1
        for (int k = 0; k < 2; ++k) {
            const int id = k == 0 ? i : 511 - i;
            const int qt = id < 256 ? 7 - (id >> 6) : 3 - ((id - 256) >> 6), bh = id & 63;
            mixC_unit(p, l, bh >> 2, bh & 3, qt, lds, wave_s);
        }
    }
}

constexpr int SC_STRIDE = 2052;
constexpr int SC_BYTES = 16 * SC_STRIDE * 4;
constexpr int IK_STRIDE = 80, IK_TILE = 64 * IK_STRIDE;
__device__ __forceinline__ unsigned fkey(float f) { const unsigned u = __float_as_uint(f); return (u & 0x80000000u) ? ~u : (u | 0x80000000u); }
__device__ __forceinline__ float unfkey(unsigned k) { return __uint_as_float((k & 0x80000000u) ? (k & 0x7fffffffu) : ~k); }
__device__ __forceinline__ f32x16 idx_scores(const bf16x8_t ik0, const bf16x8_t ik1, const bf16x8_t (&iqf)[4][2], const float (&w)[4]) {
    f32x16 sc;
#pragma unroll
    for (int i = 0; i < 16; ++i) sc[i] = 0.f;
#pragma unroll
    for (int hd = 0; hd < 4; ++hd) {
        f32x16 a;
#pragma unroll
        for (int i = 0; i < 16; ++i) a[i] = 0.f;
        a = MFMA32(ik0, iqf[hd][0], a);
        a = MFMA32(ik1, iqf[hd][1], a);
#pragma unroll
        for (int i = 0; i < 16; ++i) sc[i] = fmaf(w[hd], __builtin_amdgcn_fmed3f(a[i], 0.f, 3.0e38f), sc[i]);
    }
#pragma unroll
    for (int i = 0; i < 16; ++i) sc[i] = sc[i] + 0.f;
    return sc;
}
__device__ __forceinline__ void transpose32(unsigned (&a)[32]) {
#pragma unroll
    for (int s = 0; s < 5; ++s) {
        const int j = 16 >> s;
        const unsigned mk = j == 16 ? 0x0000ffffu : j == 8 ? 0x00ff00ffu : j == 4 ? 0x0f0f0f0fu : j == 2 ? 0x33333333u : 0x55555555u;
#pragma unroll
        for (int k = 0; k < 32; ++k)
            if ((k & j) == 0) { const unsigned t = (a[k] ^ (a[k + j] >> j)) & mk; a[k] ^= t; a[k + j] ^= t << j; asm volatile("" : "+v"(a[k]), "+v"(a[k + j])); }
    }
}
__device__ __forceinline__ int rowsum16(int v) {
    v += __builtin_amdgcn_update_dpp(0, v, 0x128, 0xf, 0xf, true);
    v += __builtin_amdgcn_update_dpp(0, v, 0x124, 0xf, 0xf, true);
    v += __builtin_amdgcn_update_dpp(0, v, 0x122, 0xf, 0xf, true);
    v += __builtin_amdgcn_update_dpp(0, v, 0x121, 0xf, 0xf, true);
    return v;
}
__device__ __forceinline__ unsigned topbits(int ne) { return ne <= 0 ? 0u : ne >= 32 ? 0xffffffffu : (0xffffffffu << (32 - ne)); }
template <int ST>
__device__ __forceinline__ void rs4_row(const unsigned (&pl)[4][32], unsigned (&alive)[4], int& above, unsigned& prefix, bool& done, bool& alld, int nmr) {
    if (!alld) {
        int c11 = 0, c10 = 0, c01 = 0;
#pragma unroll
        for (int j = 0; j < 4; ++j)
            if (j < nmr) {
                const unsigned p1 = pl[j][2 * ST], p0 = pl[j][2 * ST + 1], a1 = alive[j] & p1, a0 = alive[j] & ~p1;
                c11 += __popc(a1 & p0); c10 += __popc(a1 & ~p0); c01 += __popc(a0 & p0);
            }
        const int s01 = rowsum16(c11 | (c10 << 16)), s2 = rowsum16(c01);
        if (!done) {
            const int t11 = above + (s01 & 0xffff), t10 = t11 + (int)((unsigned)s01 >> 16), t01 = t10 + s2;
            const int dg = t11 >= TOPK ? 3 : t10 >= TOPK ? 2 : t01 >= TOPK ? 1 : 0;
            const int tsel = dg == 3 ? t11 : dg == 2 ? t10 : t01;
            prefix |= (unsigned)dg << (30 - 2 * ST);
            above = dg == 3 ? above : dg == 2 ? t11 : dg == 1 ? t10 : t01;
#pragma unroll
            for (int j = 0; j < 4; ++j)
                if (j < nmr) {
                    const unsigned p1 = pl[j][2 * ST], p0 = pl[j][2 * ST + 1];
                    alive[j] &= ((dg & 2) ? p1 : ~p1) & ((dg & 1) ? p0 : ~p0);
                }
            if (dg != 0 && tsel == TOPK) done = true;
        }
        alld = __all(done);
    }
    if constexpr (ST < 15) rs4_row<ST + 1>(pl, alive, above, prefix, done, alld, nmr);
}
__device__ __forceinline__ void mixD_attend(const Params& p, int b, int c, LAS unsigned char* lds, int wave_s);
__device__ __forceinline__ void mixD_unit(const Params& p, int b, int c, LAS unsigned char* lds, int wave_s) {
    const int tid = tid_now(wave_s);
    const int lane = tid & 63, wave = __builtin_amdgcn_readfirstlane(tid >> 6), r32 = lane & 31, hh = lane >> 5;
    const size_t rowb = (size_t)b * SEQ;
    const int q0 = c * 64, ntile = c + 1;
    LAS float* thr = (LAS float*)(lds + 131072 + 1024);
    LAS int* kcs = (LAS int*)(lds + 131072 + 1280);
    const bool dosel = c >= 4;
    __syncthreads();
    if (dosel) {
        constexpr int SKS = 1028;
        LAS unsigned* sk = (LAS unsigned*)lds;
        const int nblk = 2 * ntile;
        const int nbw = (nblk - wave + 7) >> 3;
        const int nv = 4 * ntile;
        const int nmr = (nv + 31) >> 5;
#pragma unroll 1
        for (int sp = 0; sp < 2; ++sp) {
            TB(4, lds, tid); TB(5, lds, tid);
            unsigned kr[4][32];
            unsigned zopq = 0u; asm volatile("" : "+v"(zopq));
            {
                const bf16_t* yq1 = p.Y() + (rowb + q0 + 32 * sp + r32) * YP;
                bf16x8_t iqf[4][2];
#pragma unroll
                for (int hd = 0; hd < 4; ++hd)
#pragma unroll
                    for (int s = 0; s < 2; ++s) iqf[hd][s] = *(const GAS bf16x8_t*)(uintptr_t)(yq1 + YI_Q + hd * 32 + 16 * s + 8 * hh);
                float w[4];
                const unsigned long long ww = *(const GAS unsigned long long*)(uintptr_t)(yq1 + YI_W);
#pragma unroll
                for (int hd = 0; hd < 4; ++hd) w[hd] = __uint_as_float((unsigned)((ww >> (16 * hd)) & 0xffffu) << 16) * (0.17677669529663687f * 0.5f);
#pragma unroll
                for (int g = 0; g < 2; ++g) {
                    bf16x8_t ik[4][2];
#pragma unroll
                    for (int i = 0; i < 4; ++i) {
                        const int kb = 4 * g + i < nbw ? wave + 8 * (4 * g + i) : wave;
                        const bf16_t* yk = p.Y() + (rowb + 32 * kb + r32) * YP + YI_K + 8 * hh;
                        ik[i][0] = *(const GAS bf16x8_t*)(uintptr_t)yk; ik[i][1] = *(const GAS bf16x8_t*)(uintptr_t)(yk + 16);
                    }
#pragma unroll
                    for (int i = 0; i < 4; ++i) {
                        const int blk = 4 * g + i;
                        if (blk < nbw) {
                            const f32x16 sc = idx_scores(ik[i][0], ik[i][1], iqf, w);
#pragma unroll
                            for (int r = 0; r < 16; ++r) kr[blk >> 1][16 * (blk & 1) + r] = fkey(sc[r]);
                        } else {
#pragma unroll
                            for (int r = 0; r < 16; ++r) kr[blk >> 1][16 * (blk & 1) + r] = zopq;
                        }
                    }
                    asm volatile("" ::: "memory");
                }
            }
            TE(5, lds, tid); TB(20, lds, tid);
            unsigned pl[4][32];
            {
                const int rq = 4 * wave + (lane >> 4), rt = lane & 15;
#pragma unroll
                for (int rd = 0; rd < 2; ++rd) {
#pragma unroll
                    for (int i = 0; i < 4; ++i)
#pragma unroll
                        for (int g = 0; g < 4; ++g) {
                            const int blk = 4 * rd + i;
                            u32x4 v; v.x = kr[blk >> 1][16 * (blk & 1) + 4 * g]; v.y = kr[blk >> 1][16 * (blk & 1) + 4 * g + 1]; v.z = kr[blk >> 1][16 * (blk & 1) + 4 * g + 2]; v.w = kr[blk >> 1][16 * (blk & 1) + 4 * g + 3];
                            *(LAS u32x4*)(sk + r32 * SKS + 32 * wave + 256 * i + 8 * g + 4 * hh) = v;
                        }
                    __syncthreads();
#pragma unroll
                    for (int M = 0; M < 16; ++M) {
                        const u32x4 v = *(const LAS u32x4*)(sk + rq * SKS + 64 * M + 4 * rt);
                        pl[2 * rd + (M >> 3)][4 * (M & 7)] = v.x; pl[2 * rd + (M >> 3)][4 * (M & 7) + 1] = v.y; pl[2 * rd + (M >> 3)][4 * (M & 7) + 2] = v.z; pl[2 * rd + (M >> 3)][4 * (M & 7) + 3] = v.w;
                    }
                    __syncthreads();
                }
            }
            TE(20, lds, tid); TB(6, lds, tid);
#pragma unroll
            for (int j = 0; j < 4; ++j) transpose32(pl[j]);
            TE(6, lds, tid); TB(7, lds, tid);
            unsigned alive[4];
#pragma unroll
            for (int j = 0; j < 4; ++j) alive[j] = topbits(nv - 32 * j);
            int above = 0; unsigned prefix = 0u; bool done = false, alld = false;
            rs4_row<0>(pl, alive, above, prefix, done, alld, nmr);
            TE(7, lds, tid); TB(8, lds, tid);
            int kcut = 1 << 20;
            if (!__all(done)) {
                const int need = TOPK - above, rt = lane & 15;
                int posk = 0;
#pragma unroll 1
                for (int b2 = 10; b2 >= 0; --b2) {
                    const int tt = posk | (1 << b2);
                    const int R = tt - 4 * rt;
                    const int M = R <= 0 ? 0 : 4 * (R >> 6) + min(R & 63, 4);
                    int c = 0;
#pragma unroll
                    for (int j = 0; j < 4; ++j) c += __popc(alive[j] & topbits(M - 32 * j));
                    const int f = rowsum16(c);
                    if (f < need) posk = tt;
                }
                if (!done) kcut = posk;
            }
            TE(8, lds, tid); TE(4, lds, tid);
            if ((lane & 15) == 0) { thr[32 * sp + 4 * wave + (lane >> 4)] = unfkey(prefix); kcs[32 * sp + 4 * wave + (lane >> 4)] = kcut; }
            __syncthreads();
        }
    }
    mixD_attend(p, b, c, lds, wave_s);
}
__device__ __forceinline__ void mixD_attend(const Params& p, int b, int c, LAS unsigned char* lds, int wave_s) {
    const int tid = tid_now(wave_s);
    const int lane = tid & 63, wave = __builtin_amdgcn_readfirstlane(tid >> 6), r32 = lane & 31, hh = lane >> 5;
    const size_t rowb = (size_t)b * SEQ;
    const int q0 = c * 64, ntile = c + 1;
    LAS float* thr = (LAS float*)(lds + 131072 + 1024);
    LAS int* kcs = (LAS int*)(lds + 131072 + 1280);
    const bool dosel = c >= 4;
    TB(9, lds, tid);
    const int qg = wave >> 2, hd = wave & 3;
    const int pos = q0 + 32 * qg + r32;
    const bf16_t* yq = p.Y() + (rowb + pos) * YP;
    bf16x8_t qf[4];
#pragma unroll
    for (int s = 0; s < 4; ++s) qf[s] = *(const GAS bf16x8_t*)(uintptr_t)(yq + YD_Q + hd * 64 + 16 * s + 8 * hh);
    bf16x8_t iqf[4][2];
    float w[4];
    float T = -INFINITY; int kcut = 1 << 20;
    if (dosel) {
#pragma unroll
        for (int h2 = 0; h2 < 4; ++h2)
#pragma unroll
            for (int s = 0; s < 2; ++s) iqf[h2][s] = *(const GAS bf16x8_t*)(uintptr_t)(yq + YI_Q + h2 * 32 + 16 * s + 8 * hh);
        const unsigned long long ww = *(const GAS unsigned long long*)(uintptr_t)(yq + YI_W);
#pragma unroll
        for (int h2 = 0; h2 < 4; ++h2) w[h2] = __uint_as_float((unsigned)((ww >> (16 * h2)) & 0xffffu) << 16) * (0.17677669529663687f * 0.5f);
        T = thr[32 * qg + r32]; kcut = kcs[32 * qg + r32];
    } else {
#pragma unroll
        for (int h2 = 0; h2 < 4; ++h2) { w[h2] = 0.f;
#pragma unroll
            for (int s = 0; s < 2; ++s)
#pragma unroll
                for (int e = 0; e < 8; ++e) iqf[h2][s][e] = 0; }
    }
    const float c1 = 0.125f * 1.4426950408889634f;
    const float sl2 = exp2f(-(float)(2 * hd + 2)) * 1.4426950408889634f;
    f32x16 o[2];
#pragma unroll
    for (int d = 0; d < 2; ++d)
#pragma unroll
        for (int i = 0; i < 16; ++i) o[d][i] = 0.f;
    float mrun = -1e30f, lrun = 0.f;
    const int npair = (ntile + 1) >> 1;
    const bf16_t* ksrc = p.Y() + (rowb + 8 * wave) * YP + YD_K;
    const bf16_t* vsrc = p.Y() + (rowb + 8 * wave) * YP + YD_V;
    LAS unsigned char* kring = lds;
    LAS unsigned char* vring = lds + 4 * KVL_TILE;
    LAS unsigned* mbuf = (LAS unsigned*)(lds + 8 * KVL_TILE);
    const int mtile = hd >> 1, mkb = hd & 1;
    bf16x8_t ikn0, ikn1;
    {
        const bf16_t* yk = p.Y() + (rowb + 64 * min(mtile, ntile - 1) + 32 * mkb + r32) * YP + YI_K + 8 * hh;
        ikn0 = *(const GAS bf16x8_t*)(uintptr_t)yk; ikn1 = *(const GAS bf16x8_t*)(uintptr_t)(yk + 16);
    }
#define D2_MASK(pq, sl) do { \
        const int tm_ = 2 * (pq) + mtile; unsigned bits_ = 0u; \
        if (tm_ < ntile) { \
            const f32x16 ss_ = idx_scores(ikn0, ikn1, iqf, w); \
            const int kcl_ = kcut - 64 * tm_ - 4 * hh; \
            _Pragma("unroll") for (int i = 0; i < 16; ++i) { const int kci_ = 32 * mkb + (i & 3) + 8 * (i >> 2); \
                const bool sel_ = (ss_[i] > T) || (ss_[i] == T && kci_ <= kcl_); bits_ |= sel_ ? (1u << i) : 0u; } \
        } \
        mbuf[(((sl) * 2 + qg) * 4 + hd) * 64 + lane] = bits_; } while (0)
    asm volatile("" : "+v"(qf[0]), "+v"(qf[1]), "+v"(qf[2]), "+v"(qf[3]));
    __syncthreads();
#pragma unroll
    for (int tt = 0; tt < 2; ++tt) {
        const int t = min(tt, ntile - 1);
        dma_piece(ksrc + (size_t)t * 64 * YP, kring + tt * KVL_TILE + wave * 1024, lane); dma_piece(vsrc + (size_t)t * 64 * YP, vring + tt * KVL_TILE + wave * 1024, lane);
    }
    if (dosel) D2_MASK(0, 0);
    for (int pp = 0; pp < npair; ++pp) {
        const int cur = pp & 1;
        const bool more = pp + 1 < npair;
        TB(12, lds, tid);
        asm volatile("s_waitcnt vmcnt(0) lgkmcnt(0)" ::: "memory"); __builtin_amdgcn_s_barrier(); asm volatile("" ::: "memory");
        TE(12, lds, tid);
        if (more) {
#pragma unroll
            for (int tt = 0; tt < 2; ++tt) {
                const int t = min(2 * (pp + 1) + tt, ntile - 1);
                dma_piece(ksrc + (size_t)t * 64 * YP, kring + ((cur ^ 1) * 2 + tt) * KVL_TILE + wave * 1024, lane); dma_piece(vsrc + (size_t)t * 64 * YP, vring + ((cur ^ 1) * 2 + tt) * KVL_TILE + wave * 1024, lane);
            }
            if (dosel) {
                const bf16_t* yk = p.Y() + (rowb + 64 * min(2 * (pp + 1) + mtile, ntile - 1) + 32 * mkb + r32) * YP + YI_K + 8 * hh;
                ikn0 = *(const GAS bf16x8_t*)(uintptr_t)yk; ikn1 = *(const GAS bf16x8_t*)(uintptr_t)(yk + 16);
            }
        }
        TB(11, lds, tid);
#pragma unroll 1
        for (int tt = 0; tt < 2; ++tt) {
            const int j = 2 * pp + tt;
            if (j < ntile) {
                const LAS unsigned char* kt = kring + (cur * 2 + tt) * KVL_TILE;
                const LAS unsigned char* vt = vring + (cur * 2 + tt) * KVL_TILE;
                const float pl = (float)(pos - 64 * j - 4 * hh);
                const bool diag = (j == c);
                unsigned selb[2] = {0xffffu, 0xffffu};
                if (dosel) { selb[0] = mbuf[((cur * 2 + qg) * 4 + 2 * tt) * 64 + lane]; selb[1] = mbuf[((cur * 2 + qg) * 4 + 2 * tt + 1) * 64 + lane]; }
                f32x16 sc[2];
#pragma unroll
                for (int kb = 0; kb < 2; ++kb) {
                    f32x16 a;
#pragma unroll
                    for (int i = 0; i < 16; ++i) a[i] = 0.f;
#pragma unroll
                    for (int s = 0; s < 4; ++s) {
                        const bf16x8_t kf = *(const LAS bf16x8_t*)(kt + (32 * kb + r32) * 128 + (((2 * s + hh) ^ (r32 & 7)) * 16));
                        a = MFMA32(kf, qf[s], a);
                    }
                    if (!diag) {
#pragma unroll
                        for (int i = 0; i < 16; ++i) { const float kc = (float)(32 * kb + (i & 3) + 8 * (i >> 2)); a[i] = fmaf(a[i], c1, fmaf(sl2, kc, -sl2 * pl)); }
                    } else {
#pragma unroll
                        for (int i = 0; i < 16; ++i) { const float kc = (float)(32 * kb + (i & 3) + 8 * (i >> 2)); a[i] = fmaf(a[i], c1, -sl2 * fabsf(pl - kc)); }
                    }
#pragma unroll
                    for (int i = 0; i < 16; ++i) {
                        const unsigned t = (unsigned)__builtin_amdgcn_sbfe((int)selb[kb], i, 1);
                        a[i] = __uint_as_float((__float_as_uint(a[i]) & t) | (0xff800000u & ~t));
                    }
                    sc[kb] = a;
                }
                float mx = sc[0][0];
#pragma unroll
                for (int i = 1; i < 16; ++i) mx = fmaxf(mx, sc[0][i]);
#pragma unroll
                for (int i = 0; i < 16; ++i) mx = fmaxf(mx, sc[1][i]);
                mx = xmax32(mx);
                const float mnew = fmaxf(mrun, mx);
                const float alpha = __builtin_amdgcn_exp2f(mrun - mnew);
                mrun = mnew;
                float ls4[4] = {0.f, 0.f, 0.f, 0.f};
#pragma unroll
                for (int kb = 0; kb < 2; ++kb)
#pragma unroll
                    for (int i = 0; i < 16; ++i) { const float e = __builtin_amdgcn_exp2f(sc[kb][i] - mnew); sc[kb][i] = e; ls4[i & 3] += e; }
                lrun = lrun * alpha + ((ls4[0] + ls4[1]) + (ls4[2] + ls4[3]));
#pragma unroll
                for (int d = 0; d < 2; ++d)
#pragma unroll
                    for (int i = 0; i < 16; ++i) o[d][i] *= alpha;
#pragma unroll
                for (int ks = 0; ks < 4; ++ks) {
                    const bf16x8_t pf = pack_step(sc[ks >> 1], ks & 1);
#pragma unroll
                    for (int db = 0; db < 2; ++db) o[db] = MFMA32(vt_frag_sw(vt, ks, db, lane), pf, o[db]);
                }
            }
        }
        TE(11, lds, tid);
        TB(10, lds, tid);
        if (more && dosel) D2_MASK(pp + 1, cur ^ 1);
        TE(10, lds, tid);
    }
#undef D2_MASK
    TE(9, lds, tid);
    const float inv = 1.f / xsum32(lrun);
    bf16_t* mrow = p.mix() + (rowb + pos) * DM + 768 + hd * 64;
#pragma unroll
    for (int d = 0; d < 2; ++d)
#pragma unroll
        for (int g = 0; g < 4; ++g) {
            const int d0 = 32 * d + 8 * g + 4 * hh;
            const unsigned long long zz = *(const GAS unsigned long long*)(uintptr_t)(yq + YD_Z + hd * 64 + d0);
            const float z0 = __uint_as_float((unsigned)(zz & 0xffffu) << 16), z1 = __uint_as_float((unsigned)((zz >> 16) & 0xffffu) << 16),
                        z2 = __uint_as_float((unsigned)((zz >> 32) & 0xffffu) << 16), z3 = __uint_as_float((unsigned)((zz >> 48) & 0xffffu) << 16);
            *(GAS unsigned long long*)(uintptr_t)(mrow + d0) = (unsigned long long)cvtpk(o[d][4 * g] * inv * z0, o[d][4 * g + 1] * inv * z1) | ((unsigned long long)cvtpk(o[d][4 * g + 2] * inv * z2, o[d][4 * g + 3] * inv * z3) << 32);
        }
}
__device__ __forceinline__ void ph_mixD(const Params& p, LAS unsigned char* lds, int bid, int nb, int wave_s) {
    for (int i = bid; i < 256; i += nb) {
        const int b = i & 15, cc = i >> 4;
#pragma unroll 1
        for (int k = 0; k < 2; ++k) mixD_unit(p, b, k == 0 ? 31 - cc : cc, lds, wave_s);
    }
}

constexpr int VN_STRIDE = 528;
__device__ __forceinline__ float bflo(unsigned u) { return __uint_as_float(u << 16); }
__device__ __forceinline__ float bfhi(unsigned u) { return __uint_as_float(u & 0xffff0000u); }
__device__ __forceinline__ void mixAB_unit(const Params& p, int l, int b, int n, LAS unsigned char* lds, int tid) {
    const int lane = tid & 63, wave = __builtin_amdgcn_readfirstlane(tid >> 6), r32 = lane & 31, hh = lane >> 5;
    const size_t row0 = (size_t)b * SEQ + 128 * n;
    __syncthreads();
#pragma unroll
    for (int k = 0; k < 8; ++k) {
        const int ch = tid + 512 * k, r = ch >> 5, c16 = ch & 31;
        *(LAS u32x4*)(lds + r * VN_STRIDE + c16 * 16) = *(const GAS u32x4*)(uintptr_t)(p.Y() + (row0 + r) * YP + YB_V + c16 * 8);
    }
    {
        const int cg8 = (tid & 31) * 8, t0 = (tid >> 5) * 8;
        const int pos0 = 128 * n + t0;
        const GAS float* cw = p.sm(SM_CONVW) + l * 768 + cg8;
        float w0[8], w1[8], w2[8], cb[8];
#pragma unroll
        for (int e = 0; e < 8; ++e) { w0[e] = cw[e]; w1[e] = cw[256 + e]; w2[e] = cw[512 + e]; cb[e] = p.sm(SM_CONVB)[l * 256 + cg8 + e]; }
        float um2[8], um1[8];
#pragma unroll
        for (int e = 0; e < 8; ++e) { um2[e] = 0.f; um1[e] = 0.f; }
#pragma unroll
        for (int back = 2; back >= 1; --back) {
            if (pos0 - back >= 0) {
                const bf16_t* yr = p.Y() + (row0 + t0 - back) * YP;
                const u32x4 hc = *(const GAS u32x4*)(uintptr_t)(yr + YA_H + cg8), cc = *(const GAS u32x4*)(uintptr_t)(yr + YA_C + cg8);
                float u[8] = {bflo(hc.x) * bflo(cc.x), bfhi(hc.x) * bfhi(cc.x), bflo(hc.y) * bflo(cc.y), bfhi(hc.y) * bfhi(cc.y),
                              bflo(hc.z) * bflo(cc.z), bfhi(hc.z) * bfhi(cc.z), bflo(hc.w) * bflo(cc.w), bfhi(hc.w) * bfhi(cc.w)};
#pragma unroll
                for (int e = 0; e < 8; ++e) { if (back == 2) um2[e] = u[e]; else um1[e] = u[e]; }
            }
        }
        u32x4 hcv[8], ccv[8], bgq[8], zgq[8];
#pragma unroll
        for (int tt = 0; tt < 8; ++tt) {
            const bf16_t* yr = p.Y() + (row0 + t0 + tt) * YP;
            hcv[tt] = *(const GAS u32x4*)(uintptr_t)(yr + YA_H + cg8); ccv[tt] = *(const GAS u32x4*)(uintptr_t)(yr + YA_C + cg8);
            bgq[tt] = *(const GAS u32x4*)(uintptr_t)(yr + YA_B + cg8); zgq[tt] = *(const GAS u32x4*)(uintptr_t)(yr + YA_Z + cg8);
        }
#pragma unroll
        for (int tt = 0; tt < 8; ++tt) {
            const u32x4 hc = hcv[tt], cc = ccv[tt], bg = bgq[tt], zg = zgq[tt];
            const float u[8] = {bflo(hc.x) * bflo(cc.x), bfhi(hc.x) * bfhi(cc.x), bflo(hc.y) * bflo(cc.y), bfhi(hc.y) * bfhi(cc.y),
                                bflo(hc.z) * bflo(cc.z), bfhi(hc.z) * bfhi(cc.z), bflo(hc.w) * bflo(cc.w), bfhi(hc.w) * bfhi(cc.w)};
            const float bgv[8] = {bflo(bg.x), bfhi(bg.x), bflo(bg.y), bfhi(bg.y), bflo(bg.z), bfhi(bg.z), bflo(bg.w), bfhi(bg.w)};
            const float zgv[8] = {bflo(zg.x), bfhi(zg.x), bflo(zg.y), bfhi(zg.y), bflo(zg.z), bfhi(zg.z), bflo(zg.w), bfhi(zg.w)};
            float ov[8];
#pragma unroll
            for (int e = 0; e < 8; ++e) {
                const float conv = w0[e] * um2[e] + w1[e] * um1[e] + w2[e] * u[e];
                ov[e] = bgv[e] * (conv + cb[e]) * zgv[e];
                um2[e] = um1[e]; um1[e] = u[e];
            }
            u32x4 ow; ow.x = cvtpk(ov[0], ov[1]); ow.y = cvtpk(ov[2], ov[3]); ow.z = cvtpk(ov[4], ov[5]); ow.w = cvtpk(ov[6], ov[7]);
            *(GAS u32x4*)(uintptr_t)(p.mix() + (row0 + t0 + tt) * DM + cg8) = ow;
        }
    }
    __syncthreads();
    {
        const int h = wave >> 1, th = wave & 1;
        const int nks = th == 0 ? 4 : 8;
        f32x16 acc[2][2];
#pragma unroll
        for (int a = 0; a < 2; ++a)
#pragma unroll
            for (int d = 0; d < 2; ++d)
#pragma unroll
                for (int i = 0; i < 16; ++i) acc[a][d][i] = 0.f;
        const bf16_t* wb = p.wsb() + ((size_t)(l * 4 + h) * 128 + 64 * th + r32) * 128 + 8 * hh;
        const int i16 = lane & 15, q = i16 >> 2, pp = i16 & 3, blk = (lane >> 4) & 1;
        const LAS unsigned char* va = lds + (8 * hh + q) * VN_STRIDE + (h * 64 + 16 * blk + 4 * pp) * 2;
        bf16x8_t bfr[8][2];
#pragma unroll
        for (int ks = 0; ks < 8; ++ks)
#pragma unroll
            for (int tb = 0; tb < 2; ++tb) bfr[ks][tb] = *(const GAS bf16x8_t*)(uintptr_t)(wb + (size_t)(32 * tb) * 128 + 16 * (ks < nks ? ks : 0));
        unsigned long long uu[2][2][4], zz[2][2][4]; float bias[2];
#pragma unroll
        for (int tb = 0; tb < 2; ++tb) {
            const int t = 64 * th + 32 * tb + r32;
            bias[tb] = p.sm(SM_GMLPB)[(l * 4 + h) * 128 + t];
            const bf16_t* yr = p.Y() + (row0 + t) * YP;
#pragma unroll
            for (int db = 0; db < 2; ++db)
#pragma unroll
                for (int g = 0; g < 4; ++g) {
                    const int d0 = 32 * db + 8 * g + 4 * hh;
                    uu[tb][db][g] = *(const GAS unsigned long long*)(uintptr_t)(yr + YB_U + h * 64 + d0); zz[tb][db][g] = *(const GAS unsigned long long*)(uintptr_t)(yr + YB_Z + h * 64 + d0);
                }
        }
#pragma unroll
        for (int ks = 0; ks < 8; ++ks) {
            if (ks < nks) {
                bf16x8_t afr[2];
#pragma unroll
                for (int db = 0; db < 2; ++db) {
                    const LAS unsigned char* a = va + (16 * ks) * VN_STRIDE + (32 * db) * 2;
                    const s16x4_t lo = ds_tr16(a), hi = ds_tr16(a + 4 * VN_STRIDE);
                    afr[db] = __builtin_shufflevector(lo, hi, 0, 1, 2, 3, 4, 5, 6, 7);
                }
#pragma unroll
                for (int tb = 0; tb < 2; ++tb)
#pragma unroll
                    for (int db = 0; db < 2; ++db) acc[tb][db] = MFMA32(afr[db], bfr[ks][tb], acc[tb][db]);
            }
        }
#pragma unroll
        for (int tb = 0; tb < 2; ++tb) {
            const int t = 64 * th + 32 * tb + r32;
            bf16_t* mr = p.mix() + (row0 + t) * DM + 256 + h * 64;
#pragma unroll
            for (int db = 0; db < 2; ++db)
#pragma unroll
                for (int g = 0; g < 4; ++g) {
                    const int d0 = 32 * db + 8 * g + 4 * hh;
                    const unsigned u01 = (unsigned)uu[tb][db][g], u23 = (unsigned)(uu[tb][db][g] >> 32), z01 = (unsigned)zz[tb][db][g], z23 = (unsigned)(zz[tb][db][g] >> 32);
                    const float v0 = bflo(u01) * (acc[tb][db][4 * g] + bias[tb]) * bflo(z01), v1 = bfhi(u01) * (acc[tb][db][4 * g + 1] + bias[tb]) * bfhi(z01);
                    const float v2 = bflo(u23) * (acc[tb][db][4 * g + 2] + bias[tb]) * bflo(z23), v3 = bfhi(u23) * (acc[tb][db][4 * g + 3] + bias[tb]) * bfhi(z23);
                    *(GAS unsigned long long*)(uintptr_t)(mr + d0) = (unsigned long long)cvtpk(v0, v1) | ((unsigned long long)cvtpk(v2, v3) << 32);
                }
        }
    }
}
__device__ __forceinline__ void ph_mixAB(const Params& p, int l, LAS unsigned char* lds, int bid, int nb, int tid_in) {
    int tid = tid_in; asm volatile("" : "+v"(tid));
    for (int i = bid; i < 256; i += nb) mixAB_unit(p, l, i >> 4, i & 15, lds, tid);
}

constexpr int IX_STRIDE = 528;
__device__ __forceinline__ void ph_ikiw(const Params& p, int l, LAS unsigned char* lds, int bid, int nb, int wave_s) {
    const int tid = tid_now(wave_s);
    const int lane = tid & 63, wave = __builtin_amdgcn_readfirstlane(tid >> 6), r32 = lane & 31, hh = lane >> 5;
    const int tb = wave & 3, cb = wave >> 2;
    LAS unsigned char* xs = lds;
    LAS unsigned char* ws = lds + 128 * IX_STRIDE;
    const bf16_t* wbase = p.wt_in() + (size_t)l * YP * DM;
    __syncthreads();
    { unsigned z = 0u; asm volatile("" : "+v"(z));
      for (int i = tid; i < 28 * (IX_STRIDE / 16); i += NT) *(LAS u32x4*)(ws + 36 * IX_STRIDE + i * 16) = (u32x4){z, z, z, z}; }
    for (int blk = bid; blk < NTOK / 128; blk += nb) {
        f32x16 acc;
#pragma unroll
        for (int i = 0; i < 16; ++i) acc[i] = 0.f;
#pragma unroll 1
        for (int k0 = 0; k0 < DM; k0 += 256) {
            u32x4 xv[8], wv[3];
#pragma unroll
            for (int i = 0; i < 8; ++i) { const int idx = tid + NT * i; xv[i] = *(const GAS u32x4*)(uintptr_t)(p.xb() + (size_t)(128 * blk + (idx >> 5)) * DM + k0 + 8 * (idx & 31)); }
#pragma unroll
            for (int i = 0; i < 3; ++i) {
                const int idx = tid + NT * i, n = idx >> 5;
                if (idx < 36 * 32) wv[i] = *(const GAS u32x4*)(uintptr_t)(wbase + (size_t)(n < 32 ? 3584 + n : 3712 + (n - 32)) * DM + k0 + 8 * (idx & 31));
            }
            __syncthreads();
#pragma unroll
            for (int i = 0; i < 8; ++i) { const int idx = tid + NT * i; *(LAS u32x4*)(xs + (idx >> 5) * IX_STRIDE + (idx & 31) * 16) = xv[i]; }
#pragma unroll
            for (int i = 0; i < 3; ++i) { const int idx = tid + NT * i; if (idx < 36 * 32) *(LAS u32x4*)(ws + (idx >> 5) * IX_STRIDE + (idx & 31) * 16) = wv[i]; }
            __syncthreads();
#pragma unroll
            for (int s = 0; s < 16; ++s) {
                const bf16x8_t a = *(const LAS bf16x8_t*)(ws + (32 * cb + r32) * IX_STRIDE + (16 * s + 8 * hh) * 2);
                const bf16x8_t b = *(const LAS bf16x8_t*)(xs + (32 * tb + r32) * IX_STRIDE + (16 * s + 8 * hh) * 2);
                acc = MFMA32(a, b, acc);
            }
        }
        const int tok = 128 * blk + 32 * tb + r32;
        const GAS f32x4* sp = (const GAS f32x4*)(uintptr_t)(p.ssq() + (size_t)tok * 16);
        const f32x4 s0 = sp[0], s1 = sp[1], s2 = sp[2], s3 = sp[3];
        const float tot = ((s0.x + s0.y) + (s0.z + s0.w)) + ((s1.x + s1.y) + (s1.z + s1.w)) + ((s2.x + s2.y) + (s2.z + s2.w)) + ((s3.x + s3.y) + (s3.z + s3.w));
        const float rstd = rsqrtf(tot * (1.f / DM) + EPS);
        bf16_t* yr = p.Y() + (size_t)tok * YP + YI_K + 32 * cb;
#pragma unroll
        for (int g = 0; g < 4; ++g) {
            const int c0 = 8 * g + 4 * hh;
            if (32 * cb + c0 < 36)
                *(GAS unsigned long long*)(uintptr_t)(yr + c0) = (unsigned long long)cvtpk(acc[4 * g] * rstd, acc[4 * g + 1] * rstd) | ((unsigned long long)cvtpk(acc[4 * g + 2] * rstd, acc[4 * g + 3] * rstd) << 32);
        }
    }
    __syncthreads();
}

__global__ void __launch_bounds__(NT, 2) k_fwd(Params p) {
    extern __shared__ __attribute__((aligned(16))) unsigned char lds[];
    cg::grid_group grid = cg::this_grid();
    LAS unsigned char* l3 = (LAS unsigned char*)lds;
    const int wave_s = __builtin_amdgcn_readfirstlane((int)threadIdx.x >> 6);
    volatile LAS unsigned* bst = (volatile LAS unsigned*)(l3 + LDS_BYTES - 16);
    if (threadIdx.x < 2) bst[threadIdx.x] = 0u;
    __syncthreads();
    const XcdBarrier bar = xcd_barrier_post(p.ctl(), bst);
    if (TSEG >= 0 && threadIdx.x == 0) *(volatile LAS unsigned*)(l3 + TCTR_OFF) = 0u;
    { TB(16, l3, tid_now(wave_s)); ph_prologue(p, l3, tid_now(wave_s)); TE(16, l3, tid_now(wave_s)); }
    if (p.ws == nullptr) grid.sync();
    { TB(18, l3, tid_now(wave_s)); xcd_barrier(bar, tid_now(wave_s)); TE(18, l3, tid_now(wave_s)); }
#pragma unroll 1
    for (int l = 0; l < DEPTH; ++l) {
        Params q = p; asm volatile("" : "+s"(q.ws), "+s"(q.out));
        int bid = blockIdx.x, nb = gridDim.x; asm volatile("" : "+s"(bid), "+s"(nb));
        {
            pg8::Gemm g{q.xb(), q.wt_in() + (size_t)l * YP * DM, NTOK, NGEMM, DM};
            pg8::StaticOrder S; S.init(NTOK, NGEMM, nb, bid);
            EpiIn E{q.ws, l, (LAS float*)(l3 + 131072 + 1024)};
            { TB(13, l3, tid_now(wave_s)); pg8::gemm_phase<EpiIn, pg8::StaticOrder, true, true>(l3, g, S, E, tid_now(wave_s)); TE(13, l3, tid_now(wave_s)); }
        }
        { TB(21, l3, tid_now(wave_s)); ph_ikiw(q, l, l3, bid, nb, wave_s); TE(21, l3, tid_now(wave_s)); }
        { TB(18, l3, tid_now(wave_s)); xcd_barrier(bar, tid_now(wave_s)); TE(18, l3, tid_now(wave_s)); }
        asm volatile("" : "+s"(q.ws), "+s"(bid), "+s"(nb));
        { TB(17, l3, tid_now(wave_s)); ph_mixAB(q, l, l3, bid, nb, tid_now(wave_s)); TE(17, l3, tid_now(wave_s)); }
        __syncthreads();
        { TB(1, l3, tid_now(wave_s)); ph_mixC(q, l, l3, bid, nb, wave_s); TE(1, l3, tid_now(wave_s)); }
        __syncthreads();
        { TB(19, l3, tid_now(wave_s)); ph_mixD(q, l3, bid, nb, wave_s); TE(19, l3, tid_now(wave_s)); }
        __syncthreads();
        { TB(18, l3, tid_now(wave_s)); xcd_barrier(bar, tid_now(wave_s)); TE(18, l3, tid_now(wave_s)); }
        asm volatile("" : "+s"(q.ws), "+s"(q.out), "+s"(bid), "+s"(nb));
        {
            pg8::Gemm g{q.mix(), q.wt_out() + (size_t)l * DM * DM, NTOK, DM, DM};
            pg8::StaticOrder S; S.init(NTOK, DM, nb, bid);
            EpiOut E{l == DEPTH - 1 ? q.out : nullptr, q.ws};
            { TB(15, l3, tid_now(wave_s)); pg8::gemm_phase<EpiOut, pg8::StaticOrder, true, true>(l3, g, S, E, tid_now(wave_s)); TE(15, l3, tid_now(wave_s)); }
        }
        { TB(18, l3, tid_now(wave_s)); xcd_barrier(bar, tid_now(wave_s)); TE(18, l3, tid_now(wave_s)); }
    }
    if (TSEG >= 0 && blockIdx.x == 0 && threadIdx.x == 0) {
        const unsigned long long ticks = 8ull * *(volatile LAS unsigned*)(l3 + TCTR_OFF), t0 = __builtin_amdgcn_s_memrealtime();
        while (__builtin_amdgcn_s_memrealtime() - t0 < ticks) __builtin_amdgcn_s_sleep(32);
    }
}

extern "C" void kernel_launch(void* const* d_in, const int* in_sizes, int n_in, void* d_out, int out_size, void* d_ws, size_t ws_size,
                              hipStream_t stream) {
    static int grid_blocks = 0;
    if (!grid_blocks) {
        int dev = 0, cus = 0, per_cu = 0;
        (void)hipGetDevice(&dev);
        (void)hipDeviceGetAttribute(&cus, hipDeviceAttributeMultiprocessorCount, dev);
        (void)hipFuncSetAttribute((const void*)k_fwd, hipFuncAttributeMaxDynamicSharedMemorySize, LDS_BYTES);
        (void)hipOccupancyMaxActiveBlocksPerMultiprocessor(&per_cu, (const void*)k_fwd, NT, LDS_BYTES);
        if (per_cu < 1) { fprintf(stderr, "kernel_launch: occupancy query returned %d\n", per_cu); per_cu = 1; }
        if (per_cu > 1) per_cu = 1;
        grid_blocks = cus * per_cu;
        if (ws_size < WS_END) fprintf(stderr, "kernel_launch: workspace too small (%zu < %zu)\n", ws_size, (size_t)WS_END);
    }
    (void)hipMemsetAsync(d_ws, 0, 16384, stream);
    Params p{};
    p.x = (const float*)d_in[0]; p.norm_g = (const float*)d_in[1]; p.w_in = (const float*)d_in[2]; p.i_conv_w = (const float*)d_in[3];
    p.i_conv_b = (const float*)d_in[4]; p.i_gmlp_g = (const float*)d_in[5]; p.gmlp_ws = (const float*)d_in[6]; p.i_gmlp_b = (const float*)d_in[7];
    p.i_diff_qg = (const float*)d_in[8]; p.i_diff_kg = (const float*)d_in[9]; p.i_diff_lam = (const float*)d_in[10]; p.i_diff_subg = (const float*)d_in[11];
    p.i_dsa_qg = (const float*)d_in[12]; p.i_dsa_kg = (const float*)d_in[13]; p.w_out = (const float*)d_in[14];
    p.out = (float*)d_out; p.ws = (unsigned char*)d_ws;
    void* args[] = {&p};
    hipError_t e = hipLaunchCooperativeKernel((void*)k_fwd, dim3(grid_blocks), dim3(NT), args, LDS_BYTES, stream);
    if (e != hipSuccess) fprintf(stderr, "cooperative launch failed: %s (grid %d)\n", hipGetErrorString(e), grid_blocks);
}
```

```cpp
#include <hip/hip_runtime.h>
#include <hip/hip_cooperative_groups.h>
#include <math.h>
#include <stdint.h>
#include <stdio.h>
namespace cg = cooperative_groups;
namespace pg8 {
#define PG8_LAS __attribute__((address_space(3)))
typedef unsigned short bf16_t;
typedef short bf16x8 __attribute__((ext_vector_type(8)));
typedef float f32x4 __attribute__((ext_vector_type(4)));
typedef unsigned u32x4 __attribute__((ext_vector_type(4)));
constexpr int BM = 256, BK = 64, HALF = 128, HTB = HALF * BK * 2  , STAGE_BYTES = 8 * HTB, NXCD = 8, WGM = 8;

__host__ __device__ __forceinline__ int lds_byte(int r, int c) { const int st = (r >> 4) * 2 + (c >> 5), rr = r & 15, cc = c & 31, ob = rr * 64 + cc * 2; return st * 1024 + (ob ^ (((ob >> 9) & 1) << 5)); }
__host__ __device__ __forceinline__ void stage_rc(int b, int& R, int& C) { const int st = b / 1024, sb = b % 1024, swz = sb ^ (((sb >> 9) & 1) << 5); R = (st >> 1) * 16 + swz / 64; C = (st & 1) * 32 + (swz % 64) / 2; }
__host__ __device__ __forceinline__ int perm32(int rho) { const int n = rho >> 4, i = rho & 15; return 8 * (i >> 2) + 4 * n + (i & 3); }

struct Unit { int pm, pn; };
struct Gemm { const bf16_t* A; const bf16_t* Bt; int M, N, K; };

struct StaticOrder {
    int nM, nN, nwg, G, c;
    __host__ __device__ void init(int M, int N, int G_, int c_) { nM = M / BM; nN = N / BM; nwg = nM * nN; G = G_; c = c_; }
    __host__ __device__ bool next(int i, Unit& u) const {
        const long L = (long)i * G + c; if (L >= nwg) return false;
        int wgid = (int)L; { const int q = nwg / NXCD, r = nwg % NXCD, xcd = wgid % NXCD, off = wgid / NXCD; wgid = (xcd < r ? xcd * (q + 1) : r * (q + 1) + (xcd - r) * q) + off; }
        const int nig = WGM * nN, gid = wgid / nig, fm = gid * WGM, gsz = (nM - fm) < WGM ? (nM - fm) : WGM;
        u.pm = fm + ((wgid % nig) % gsz); u.pn = (wgid % nig) / gsz; return true;
    }
    __device__ __forceinline__ void a_ready(const Unit&) const {}
    __device__ __forceinline__ void done(const Unit&) const {}
};

__device__ __forceinline__ unsigned cvt_pk_bf16(float lo, float hi) { unsigned r; asm volatile("v_cvt_pk_bf16_f32 %0, %1, %2" : "=v"(r) : "v"(lo), "v"(hi)); return r; }
typedef float f32x2 __attribute__((ext_vector_type(2)));
__device__ __forceinline__ f32x2 gelu_pk(f32x2 v) {
    const f32x2 av = __builtin_elementwise_abs(v), d = av * 0.2316418882f + 1.0f;
    f32x2 t; t.x = __builtin_amdgcn_rcpf(d.x); t.y = __builtin_amdgcn_rcpf(d.y);
    f32x2 q = t * 0.5307027145f + (-0.7265760135f); q = q * t + 0.7107068705f; q = q * t + (-0.142248368f); q = q * t + 0.127414796f; q = q * t;
    const f32x2 s = (v * v) * (-0.72134752044f);
    f32x2 e; e.x = __builtin_amdgcn_exp2f(s.x); e.y = __builtin_amdgcn_exp2f(s.y);
    const f32x2 m = v * (q * e), r = v - m;
    f32x2 o; o.x = v.x < 0.f ? m.x : r.x; o.y = v.y < 0.f ? m.y : r.y; return o;
}
template <class Epi, class Sched, bool ALIGN_EPI = false, bool SP2 = false>
__device__ __forceinline__ void gemm_phase(PG8_LAS unsigned char* lds, const Gemm g, const Sched& S, const Epi& E, int tid_in) {
    int tid_ = tid_in; asm volatile("" : "+v"(tid_));
    const int tid = tid_, wid = __builtin_amdgcn_readfirstlane(tid >> 6), lane = tid & 63, wr = wid >> 2, wc = wid & 3, fr = lane & 15, fq = lane >> 4;
    const int K = g.K, nt = K / BK;
    unsigned voffA[2], voffB[2];
#pragma unroll
    for (int i = 0; i < 2; ++i) { int R, C; stage_rc(tid * 16 + i * 8192, R, C); const int Rb = Epi::PERM ? ((R & ~31) + perm32(R & 31)) : R;
        voffA[i] = (unsigned)(R * K + C) * 2u; voffB[i] = (unsigned)(Rb * K + C) * 2u; }
    const size_t kstep = (size_t)(BK * 2);
    const size_t hstep = (size_t)HALF * K * 2;
    const size_t tstep = 2 * hstep;
    const unsigned ldsw = (unsigned)wid * 1024u;
    const int aoff = lds_byte(wr * 64 + fr, fq * 8), boff = lds_byte(wc * 32 + fr, fq * 8);
#define PG8_SA(b, h) (((b) * 2 + (h)) * HTB)
#define PG8_SB(b, h) ((4 + (b) * 2 + (h)) * HTB)
#define PG8_STAGE(bufoff, gbase, voff) do { _Pragma("unroll") for (int _i = 0; _i < 2; ++_i) \
        __builtin_amdgcn_global_load_lds((const unsigned*)((const char*)(gbase) + (voff)[_i]), (PG8_LAS unsigned*)(lds + (bufoff) + ldsw + _i * 8192), 16, 0, 0); } while (0)
#define PG8_LDA(dst, b, h) do { _Pragma("unroll") for (int m = 0; m < 4; ++m) _Pragma("unroll") for (int k = 0; k < 2; ++k) dst[m][k] = *(const PG8_LAS bf16x8*)(lds + PG8_SA(b, h) + aoff + m * 2048 + k * 1024); } while (0)
#define PG8_LDB(dst, b, h) do { _Pragma("unroll") for (int n = 0; n < 2; ++n) _Pragma("unroll") for (int k = 0; k < 2; ++k) dst[n][k] = *(const PG8_LAS bf16x8*)(lds + PG8_SB(b, h) + boff + n * 2048 + k * 1024); } while (0)
#define PG8_MMA(ai, bj, At, Bt) do { __builtin_amdgcn_s_setprio(1); _Pragma("unroll") for (int m = 0; m < 4; ++m) _Pragma("unroll") for (int n = 0; n < 2; ++n) _Pragma("unroll") for (int k = 0; k < 2; ++k) \
        acc[ai][bj][m][n] = __builtin_amdgcn_mfma_f32_16x16x32_bf16(Bt[n][k], At[m][k], acc[ai][bj][m][n], 0, 0, 0); __builtin_amdgcn_s_setprio(0); } while (0)
#define PG8_WAIT_V(n) asm volatile("s_waitcnt vmcnt(" #n ")" ::: "memory")
#define PG8_WAIT_L(n) asm volatile("s_waitcnt lgkmcnt(" #n ")" ::: "memory")
#define PG8_BAR __builtin_amdgcn_s_barrier()
#define PG8_SCHED __builtin_amdgcn_sched_barrier(0)
    Unit cur, nxt; int ui = 0;
    if (!S.next(0, cur)) return;
    f32x4 acc[2][2][4][2];
#pragma unroll
    for (int a = 0; a < 2; ++a)
#pragma unroll
        for (int b = 0; b < 2; ++b)
#pragma unroll
            for (int m = 0; m < 4; ++m)
#pragma unroll
                for (int n = 0; n < 2; ++n) acc[a][b][m][n] = (f32x4){0.f, 0.f, 0.f, 0.f};
    bf16x8 At[4][2], B0[2][2], B1[2][2];
    const char* cA = (const char*)g.A + (size_t)cur.pm * tstep; const char* cB = (const char*)g.Bt + (size_t)cur.pn * tstep;
    S.a_ready(cur);
    if constexpr (SP2) {
        PG8_STAGE(PG8_SB(0, 0), cB, voffB); PG8_STAGE(PG8_SB(0, 1), cB + hstep, voffB); PG8_STAGE(PG8_SA(0, 0), cA, voffA); PG8_STAGE(PG8_SA(0, 1), cA + hstep, voffA);
        if (wr == 1) PG8_BAR;
        PG8_WAIT_V(2); PG8_BAR;
        PG8_STAGE(PG8_SB(1, 0), cB + kstep, voffB); PG8_STAGE(PG8_SA(1, 0), cA + kstep, voffA); PG8_STAGE(PG8_SB(1, 1), cB + hstep + kstep, voffB);
        PG8_WAIT_V(6); PG8_BAR;
    } else {
        PG8_STAGE(PG8_SB(0, 0), cB, voffB); PG8_STAGE(PG8_SA(0, 0), cA, voffA); PG8_STAGE(PG8_SB(0, 1), cB + hstep, voffB); PG8_STAGE(PG8_SA(0, 1), cA + hstep, voffA);
        if (wr == 1) PG8_BAR;
        PG8_WAIT_V(4); PG8_BAR;
        PG8_STAGE(PG8_SB(1, 0), cB + kstep, voffB); PG8_STAGE(PG8_SA(1, 0), cA + kstep, voffA); PG8_STAGE(PG8_SB(1, 1), cB + hstep + kstep, voffB);
        PG8_WAIT_V(6); PG8_BAR;
    }
    for (;;) {
        const bool has_next = S.next(ui + 1, nxt);
        const char* nA = has_next ? (const char*)g.A + (size_t)nxt.pm * tstep : cA; const char* nB = has_next ? (const char*)g.Bt + (size_t)nxt.pn * tstep : cB;
        for (int t = 0; t < nt; t += 2) {
            const bool last = (t == nt - 2);
            const char* a1 = cA + (size_t)(t + 1) * kstep;
            const char* a2 = last ? nA : cA + (size_t)(t + 2) * kstep; const char* b2 = last ? nB : cB + (size_t)(t + 2) * kstep;
            const char* a3 = a2 + kstep; const char* b3 = b2 + kstep;
            if (last && has_next) S.a_ready(nxt);
            if constexpr (SP2) {
            PG8_LDB(B0, 0, 0); PG8_LDB(B1, 0, 1); PG8_SCHED; PG8_LDA(At, 0, 0); PG8_STAGE(PG8_SA(1, 1), a1 + hstep, voffA);
            PG8_WAIT_V(8); PG8_WAIT_L(0); PG8_BAR; PG8_MMA(0, 0, At, B0); PG8_MMA(0, 1, At, B1); PG8_BAR; PG8_SCHED;
            PG8_LDA(At, 0, 1); PG8_STAGE(PG8_SB(0, 0), b2, voffB); PG8_STAGE(PG8_SB(0, 1), b2 + hstep, voffB); PG8_STAGE(PG8_SA(0, 0), a2, voffA);
            PG8_WAIT_V(8); PG8_WAIT_L(0); PG8_BAR; PG8_MMA(1, 0, At, B0); PG8_MMA(1, 1, At, B1); PG8_BAR; PG8_SCHED;
            PG8_LDB(B0, 1, 0); PG8_LDB(B1, 1, 1); PG8_SCHED; PG8_LDA(At, 1, 0); PG8_STAGE(PG8_SA(0, 1), a2 + hstep, voffA);
            PG8_WAIT_V(8); PG8_WAIT_L(0); PG8_BAR; PG8_MMA(0, 0, At, B0); PG8_MMA(0, 1, At, B1); PG8_BAR; PG8_SCHED;
            PG8_LDA(At, 1, 1); PG8_STAGE(PG8_SB(1, 0), b3, voffB); PG8_STAGE(PG8_SB(1, 1), b3 + hstep, voffB); PG8_STAGE(PG8_SA(1, 0), a3, voffA);
            PG8_WAIT_V(8); PG8_WAIT_L(0); PG8_BAR; PG8_MMA(1, 0, At, B0); PG8_MMA(1, 1, At, B1); PG8_BAR; PG8_SCHED;
            } else {
            PG8_LDB(B0, 0, 0); PG8_SCHED; PG8_LDA(At, 0, 0); PG8_STAGE(PG8_SA(1, 1), a1 + hstep, voffA);
            PG8_WAIT_L(8); PG8_BAR; PG8_WAIT_L(0); PG8_MMA(0, 0, At, B0); PG8_BAR; PG8_SCHED;
            PG8_LDB(B1, 0, 1); PG8_STAGE(PG8_SB(0, 0), b2, voffB);
            PG8_BAR; PG8_WAIT_L(0); PG8_MMA(0, 1, At, B1); PG8_BAR;
            PG8_LDA(At, 0, 1); PG8_STAGE(PG8_SA(0, 0), a2, voffA);
            PG8_BAR; PG8_WAIT_L(0); PG8_MMA(1, 0, At, B0); PG8_BAR; PG8_SCHED;
            PG8_STAGE(PG8_SB(0, 1), b2 + hstep, voffB);
            PG8_WAIT_V(6); PG8_BAR; PG8_MMA(1, 1, At, B1); PG8_BAR;
            PG8_LDB(B0, 1, 0); PG8_SCHED; PG8_LDA(At, 1, 0); PG8_STAGE(PG8_SA(0, 1), a2 + hstep, voffA);
            PG8_WAIT_L(8); PG8_BAR; PG8_WAIT_L(0); PG8_MMA(0, 0, At, B0); PG8_BAR; PG8_SCHED;
            PG8_LDB(B1, 1, 1); PG8_STAGE(PG8_SB(1, 0), b3, voffB);
            PG8_BAR; PG8_WAIT_L(0); PG8_MMA(0, 1, At, B1); PG8_BAR;
            PG8_LDA(At, 1, 1); PG8_STAGE(PG8_SA(1, 0), a3, voffA);
            PG8_BAR; PG8_WAIT_L(0); PG8_MMA(1, 0, At, B0); PG8_BAR; PG8_SCHED;
            PG8_STAGE(PG8_SB(1, 1), b3 + hstep, voffB);
            PG8_WAIT_V(6); PG8_BAR; PG8_MMA(1, 1, At, B1); PG8_BAR;
            }
        }
        if constexpr (ALIGN_EPI) { if (wr == 0) PG8_BAR; }
        if constexpr (!Epi::AFTER_DRAIN) { E(acc, cur, wr, wc, fr, fq); S.done(cur); }
        if (!has_next) break;
#pragma unroll
        for (int a = 0; a < 2; ++a)
#pragma unroll
            for (int b = 0; b < 2; ++b)
#pragma unroll
                for (int m = 0; m < 4; ++m)
#pragma unroll
                    for (int n = 0; n < 2; ++n) acc[a][b][m][n] = (f32x4){0.f, 0.f, 0.f, 0.f};
        cur = nxt; cA = nA; cB = nB; ++ui;
        if constexpr (ALIGN_EPI) { if (wr == 1) PG8_BAR; }
    }
    PG8_WAIT_V(0);
    if constexpr (!ALIGN_EPI) { if (wr == 0) PG8_BAR; }
    PG8_BAR;
    if constexpr (Epi::AFTER_DRAIN) { E.fused(acc, cur, wr, wc, fr, fq, lds, wid, lane); S.done(cur); }
#undef PG8_SA
#undef PG8_SB
#undef PG8_STAGE
#undef PG8_LDA
#undef PG8_LDB
#undef PG8_MMA
#undef PG8_WAIT_V
#undef PG8_WAIT_L
#undef PG8_BAR
#undef PG8_SCHED
}
}

using pg8::bf16_t; using pg8::f32x4; using pg8::u32x4; using pg8::Unit;
#define LAS __attribute__((address_space(3)))
#define GAS __attribute__((address_space(1)))

constexpr int DM = 1024, SEQ = 2048, BATCH = 16, DEPTH = 4, NIN = 3620, NTOK = BATCH * SEQ, YP = 3840;
constexpr float EPS = 1e-6f;
constexpr int O_DZ = 3200, O_DK = 3072, O_DV = 3136;
constexpr int YA_H = 0, YA_B = 256, YA_C = 512, YA_Z = 768, YB_U = 1024, YB_V = 1280, YB_Z = 1536, YC_Q = 1792, YC_K = 2048, YC_V = 2304,
              YC_Z = 2560, YD_Q = 2816, YD_Z = 3072, YD_K = 3328, YD_V = 3392, YI_Q = 3456, YI_K = 3584, YI_W = 3616;
constexpr int TOPK = 256;
constexpr int NGEMM = 3584;
constexpr int NT = 512, NW = 8;
constexpr int LDS_BYTES = 131072 + 4096 + 20480;

constexpr size_t MiB = 1u << 20;
constexpr size_t WS_WTIN = 1 * MiB;
constexpr size_t WS_WTOUT = WS_WTIN + (size_t)DEPTH * YP * DM * 2;
constexpr size_t WS_SSQ = WS_WTOUT + (size_t)DEPTH * DM * DM * 2;
constexpr size_t WS_XB = WS_SSQ + (size_t)NTOK * 16 * 4;
constexpr size_t WS_Y = WS_XB + (size_t)NTOK * DM * 2;
constexpr size_t WS_MIX = WS_Y + (size_t)NTOK * YP * 2;
constexpr size_t WS_WSB = WS_MIX + (size_t)NTOK * DM * 2;
constexpr size_t WS_END = WS_WSB + (size_t)DEPTH * 4 * 128 * 128 * 2;

constexpr size_t WS_SMALL = 65536;
constexpr int SM_CONVW = 0, SM_CONVB = 3072, SM_GMLPG = 4096, SM_GMLPB = 5120, SM_QG = 7168, SM_KG = 7296, SM_LAM = 7424, SM_SUBG = 7936, SM_DQG = 8960, SM_DKG = 9216, SM_END = 9472;
struct Params {
    const float* x; const float* norm_g; const float* w_in; const float* i_conv_w; const float* i_conv_b;
    const float* i_gmlp_g; const float* gmlp_ws; const float* i_gmlp_b; const float* i_diff_qg; const float* i_diff_kg;
    const float* i_diff_lam; const float* i_diff_subg; const float* i_dsa_qg; const float* i_dsa_kg; const float* w_out;
    float* out; unsigned char* ws;
    __device__ __forceinline__ unsigned* ctl() const { return (unsigned*)ws; }
    __device__ __forceinline__ const GAS float* sm(int off) const { return (const GAS float*)(uintptr_t)(ws + WS_SMALL) + off; }
    __device__ __forceinline__ bf16_t* wt_in() const { return (bf16_t*)(ws + WS_WTIN); }
    __device__ __forceinline__ bf16_t* wt_out() const { return (bf16_t*)(ws + WS_WTOUT); }
    __device__ __forceinline__ float* ssq() const { return (float*)(ws + WS_SSQ); }
    __device__ __forceinline__ bf16_t* xb() const { return (bf16_t*)(ws + WS_XB); }
    __device__ __forceinline__ bf16_t* Y() const { return (bf16_t*)(ws + WS_Y); }
    __device__ __forceinline__ bf16_t* mix() const { return (bf16_t*)(ws + WS_MIX); }
    __device__ __forceinline__ bf16_t* wsb() const { return (bf16_t*)(ws + WS_WSB); }
};

#ifndef TSEG
#define TSEG -1
#endif
constexpr int TCTR_OFF = 131072 + 3072;
#define TB(id, ldsbase, tidv) do { if (TSEG == (id) && blockIdx.x == 0 && (tidv) == 0) *(volatile LAS unsigned long long*)((ldsbase) + TCTR_OFF + 8) = __builtin_amdgcn_s_memrealtime(); } while (0)
#define TE(id, ldsbase, tidv) do { if (TSEG == (id) && blockIdx.x == 0 && (tidv) == 0) { const unsigned _d = (unsigned)(__builtin_amdgcn_s_memrealtime() - *(volatile LAS unsigned long long*)((ldsbase) + TCTR_OFF + 8)); *(volatile LAS unsigned*)((ldsbase) + TCTR_OFF) += _d; } } while (0)
__device__ __forceinline__ unsigned f2bf(float f) { unsigned u = __float_as_uint(f); return (u + 0x7fffu + ((u >> 16) & 1u)) >> 16; }
__device__ __forceinline__ unsigned pk2(float lo, float hi) { return f2bf(lo) | (f2bf(hi) << 16); }
__device__ __forceinline__ float bf2f(bf16_t b) { return __uint_as_float((unsigned)b << 16); }

__device__ __forceinline__ float xsum32(float v) { const auto r = __builtin_amdgcn_permlane32_swap(__float_as_uint(v), __float_as_uint(v), false, false); return __uint_as_float(r[0]) + __uint_as_float(r[1]); }
__device__ __forceinline__ float xmax32(float v) { const auto r = __builtin_amdgcn_permlane32_swap(__float_as_uint(v), __float_as_uint(v), false, false); return fmaxf(__uint_as_float(r[0]), __uint_as_float(r[1])); }
__device__ __forceinline__ int xsum32i(int v) { const auto r = __builtin_amdgcn_permlane32_swap((unsigned)v, (unsigned)v, false, false); return (int)(r[0] + r[1]); }
__device__ __forceinline__ float xsum16(float v) { const auto r = __builtin_amdgcn_permlane16_swap(__float_as_uint(v), __float_as_uint(v), false, false); return __uint_as_float(r[0]) + __uint_as_float(r[1]); }
__device__ __forceinline__ float wave_sum64(float v) {
    v += __uint_as_float(__builtin_amdgcn_update_dpp(0, __float_as_uint(v), 0x128, 0xf, 0xf, true));
    v += __uint_as_float(__builtin_amdgcn_update_dpp(0, __float_as_uint(v), 0x124, 0xf, 0xf, true));
    v += __uint_as_float(__builtin_amdgcn_update_dpp(0, __float_as_uint(v), 0x122, 0xf, 0xf, true));
    v += __uint_as_float(__builtin_amdgcn_update_dpp(0, __float_as_uint(v), 0x121, 0xf, 0xf, true));
    return xsum32(xsum16(v));
}
__device__ __forceinline__ float wave_sum(float v) {
#pragma unroll
    for (int o = 32; o > 0; o >>= 1) v += __shfl_xor(v, o);
    return v;
}
__device__ __forceinline__ float wave_max(float v) {
#pragma unroll
    for (int o = 32; o > 0; o >>= 1) v = fmaxf(v, __shfl_xor(v, o));
    return v;
}
__device__ __forceinline__ int wave_sumi(int v) {
#pragma unroll
    for (int o = 32; o > 0; o >>= 1) v += __shfl_xor(v, o);
    return v;
}
__device__ __forceinline__ float block_sum(float v, float* red) {
    v = wave_sum(v);
    __syncthreads();
    if ((threadIdx.x & 63) == 0) red[threadIdx.x >> 6] = v;
    __syncthreads();
    float s = 0.f;
#pragma unroll
    for (int i = 0; i < NW; ++i) s += red[i];
    return s;
}
__device__ __forceinline__ float block_max(float v, float* red) {
    v = wave_max(v);
    __syncthreads();
    if ((threadIdx.x & 63) == 0) red[threadIdx.x >> 6] = v;
    __syncthreads();
    float s = red[0];
#pragma unroll
    for (int i = 1; i < NW; ++i) s = fmaxf(s, red[i]);
    return s;
}
__device__ __forceinline__ int block_sumi(int v, int* red) {
    v = wave_sumi(v);
    __syncthreads();
    if ((threadIdx.x & 63) == 0) red[threadIdx.x >> 6] = v;
    __syncthreads();
    int s = 0;
#pragma unroll
    for (int i = 0; i < NW; ++i) s += red[i];
    return s;
}
__device__ __forceinline__ int block_excl_scan(int v, int* red, int* tot) {
    const int lane = threadIdx.x & 63, w = threadIdx.x >> 6;
    int inc = v;
#pragma unroll
    for (int o = 1; o < 64; o <<= 1) { int n = __shfl_up(inc, o); if (lane >= o) inc += n; }
    __syncthreads();
    if (lane == 63) red[w] = inc;
    __syncthreads();
    int base = 0, t = 0;
#pragma unroll
    for (int i = 0; i < NW; ++i) { if (i < w) base += red[i]; t += red[i]; }
    *tot = t;
    return base + inc - v;
}

__device__ __forceinline__ int phys2logical(int n) { const int p = n & 255; return (n & ~255) + 64 * ((p >> 5) & 3) + 32 * (p >> 7) + (p & 31); }
__device__ __forceinline__ int logical2orig(int n) {
    if (n < 3072) return n;
    if (n < YD_K) return n - YD_Z + O_DZ;
    if (n < YD_V) return n - YD_K + O_DK;
    if (n < YI_Q) return n - YD_V + O_DV;
    if (n < NIN) return n;
    return -1;
}
__device__ __forceinline__ void transpose_item(const float* W, int ldn, const float* gk, bf16_t* WT, int k0, int r0, int r1, int src, LAS float* scr, int lane) {
    float v[64];
#pragma unroll
    for (int i = 0; i < 64; ++i) v[i] = src >= 0 ? *(const GAS float*)(uintptr_t)(W + (size_t)(k0 + i) * ldn + src) : 0.f;
#pragma unroll
    for (int i = 0; i < 64; ++i) scr[i * 65 + lane] = gk ? v[i] * gk[k0 + i] : v[i];
    asm volatile("s_waitcnt lgkmcnt(0)" ::: "memory");
#pragma unroll
    for (int q = 0; q < 8; ++q) {
        const int id = lane + 64 * q, j = id >> 3, c = id & 7;
        const LAS float* s = scr + (8 * c) * 65 + j;
        u32x4 o; o.x = pk2(s[0 * 65], s[1 * 65]); o.y = pk2(s[2 * 65], s[3 * 65]); o.z = pk2(s[4 * 65], s[5 * 65]); o.w = pk2(s[6 * 65], s[7 * 65]);
        *(GAS u32x4*)(uintptr_t)(WT + (size_t)((j < 32 ? r0 : r1 - 32) + j) * DM + k0 + 8 * c) = o;
    }
    asm volatile("s_waitcnt lgkmcnt(0)" ::: "memory");
}
__device__ __forceinline__ int tid_now(int wave_s) { int lane; asm volatile("v_mbcnt_lo_u32_b32 %0, -1, 0\n\tv_mbcnt_hi_u32_b32 %0, -1, %0" : "=v"(lane)); return wave_s * 64 + lane; }
__device__ __forceinline__ void convert_layer_weights(const Params& p, int l, LAS unsigned char* lds, int tid, int gw, int ngw) {
    const int lane = tid & 63, wave = tid >> 6;
    LAS float* scr = (LAS float*)(lds + wave * 16640);
    constexpr int I_IN = 16 * (YP / 64), I_OUT = 16 * (DM / 64);
    for (int it = gw; it < I_IN + I_OUT; it += ngw) {
        if (it < I_IN) {
            const int kb = it / (YP / 64), g = it % (YP / 64), tile = g >> 2, wc = g & 3;
            const int src = logical2orig(256 * tile + 64 * wc + lane);
            transpose_item(p.w_in + (size_t)l * DM * NIN, NIN, p.norm_g + l * DM, p.wt_in() + (size_t)l * YP * DM, kb * 64, 256 * tile + 32 * wc, 256 * tile + 128 + 32 * wc, src, scr, lane);
        } else {
            const int q = it - I_IN, kb = q / (DM / 64), g = q % (DM / 64);
            transpose_item(p.w_out + (size_t)l * DM * DM, DM, nullptr, p.wt_out() + (size_t)l * DM * DM, kb * 64, 64 * g, 64 * g + 32, 64 * g + lane, scr, lane);
        }
    }
}
__device__ __forceinline__ void ph_prologue(const Params& p, LAS unsigned char* lds, int tid_in) {
    int tid = tid_in; asm volatile("" : "+v"(tid));
    const int lane = tid & 63, wave = tid >> 6;
    const int gw = blockIdx.x * NW + wave, ngw = gridDim.x * NW;
    TB(22, lds, tid);
    convert_layer_weights(p, 0, lds, tid, gw, ngw);
    {
        float* sm = (float*)(p.ws + WS_SMALL);
        for (int i = blockIdx.x * NT + tid; i < SM_END; i += gridDim.x * NT) {
            float v;
            if (i < SM_CONVB) v = p.i_conv_w[i - SM_CONVW]; else if (i < SM_GMLPG) v = p.i_conv_b[i - SM_CONVB]; else if (i < SM_GMLPB) v = p.i_gmlp_g[i - SM_GMLPG];
            else if (i < SM_QG) v = p.i_gmlp_b[i - SM_GMLPB]; else if (i < SM_KG) v = p.i_diff_qg[i - SM_QG]; else if (i < SM_LAM) v = p.i_diff_kg[i - SM_KG];
            else if (i < SM_SUBG) v = p.i_diff_lam[i - SM_LAM]; else if (i < SM_DQG) v = p.i_diff_subg[i - SM_SUBG]; else if (i < SM_DKG) v = p.i_dsa_qg[i - SM_DQG];
            else v = p.i_dsa_kg[i - SM_DKG];
            sm[i] = v;
        }
    }
    for (int i = (blockIdx.x * NT + tid) * 4; i < DEPTH * 4 * 128 * 128; i += gridDim.x * NT * 4) {
        const f32x4 v = *(const GAS f32x4*)(uintptr_t)(p.gmlp_ws + i);
        *(GAS unsigned long long*)(uintptr_t)(p.wsb() + i) = (unsigned long long)pk2(v.x, v.y) | ((unsigned long long)pk2(v.z, v.w) << 32);
    }
    TE(22, lds, tid);
    TB(23, lds, tid);
    for (int r0 = gw * 4; r0 < NTOK; r0 += ngw * 4) {
        f32x4 v[4][4];
#pragma unroll
        for (int rr = 0; rr < 4; ++rr)
#pragma unroll
            for (int j = 0; j < 4; ++j) v[rr][j] = ((const GAS f32x4*)(uintptr_t)(p.x + (size_t)(r0 + rr) * DM))[lane + 64 * j];
#pragma unroll
        for (int rr = 0; rr < 4; ++rr) {
            GAS unsigned long long* o8 = (GAS unsigned long long*)(uintptr_t)(p.xb() + (size_t)(r0 + rr) * DM) + lane;
            float s = 0.f;
#pragma unroll
            for (int j = 0; j < 4; ++j) {
                const f32x4 q = v[rr][j];
                s += (q.x * q.x + q.y * q.y) + (q.z * q.z + q.w * q.w);
                o8[64 * j] = (unsigned long long)pk2(q.x, q.y) | ((unsigned long long)pk2(q.z, q.w) << 32);
            }
            s = wave_sum64(s);
            if (lane < 16) ((GAS float*)(uintptr_t)p.ssq())[(size_t)(r0 + rr) * 16 + lane] = lane == 0 ? s : 0.f;
        }
    }
    TE(23, lds, tid);
}

__device__ __forceinline__ float silu_f(float v) { return v * __builtin_amdgcn_rcpf(1.f + __builtin_amdgcn_exp2f(-1.4426950408889634f * v)); }
struct EpiIn {
    static constexpr bool PERM = true, AFTER_DRAIN = false;
    unsigned char* ws; int l; LAS float* rs;
    __device__ __forceinline__ void operator()(const f32x4 (&acc)[2][2][4][2], const Unit& u, int wr, int wc, int fr_, int fq_) const {
        int fr = fr_, fq = fq_; asm volatile("" : "+v"(fr), "+v"(fq));
        const int pn = u.pn;
        bf16_t* Y = (bf16_t*)(ws + WS_Y); const float* ssq = (const float*)(ws + WS_SSQ); const float* smb = (const float*)(ws + WS_SMALL);
        const float* gmlp_g = smb + SM_GMLPG + l * 256; const float* qg = smb + SM_QG + l * 32; const float* kg = smb + SM_KG + l * 32;
        const float* dqg = smb + SM_DQG + l * 64; const float* dkg = smb + SM_DKG + l * 64;
        int op = 0; const float* g0 = nullptr; const float* g1 = nullptr; float qs = 1.f;
        if (pn == 3 || pn == 6 || pn == 10 || pn == 12) op = 1;
        else if (pn == 4) op = 2;
        else if (pn == 5) { op = 3; g0 = gmlp_g + 64 * wc + 8 * fq; g1 = g0 + 32; }
        else if (pn == 7) { op = 4; g0 = qg + 8 * fq; g1 = g0; qs = 0.17677669529663687f * 1.4426950408889634f; }
        else if (pn == 8) { op = 4; g0 = kg + 8 * fq; g1 = g0; }
        else if (pn == 11) { op = 5; g0 = dqg + 8 * fq; g1 = g0 + 32; qs = 0.125f * 1.4426950408889634f; }
        else if (pn == 13 && wc == 0) { op = 5; g0 = dkg + 8 * fq; g1 = g0 + 32; }
        float gn[16];
#pragma unroll
        for (int i = 0; i < 16; ++i) gn[i] = 1.f;
        if (op >= 3) {
            const f32x4 a = *(const GAS f32x4*)(uintptr_t)g0, b = *(const GAS f32x4*)(uintptr_t)(g0 + 4), c = *(const GAS f32x4*)(uintptr_t)g1, d = *(const GAS f32x4*)(uintptr_t)(g1 + 4);
            gn[0] = a.x; gn[1] = a.y; gn[2] = a.z; gn[3] = a.w; gn[4] = b.x; gn[5] = b.y; gn[6] = b.z; gn[7] = b.w;
            gn[8] = c.x; gn[9] = c.y; gn[10] = c.z; gn[11] = c.w; gn[12] = d.x; gn[13] = d.y; gn[14] = d.z; gn[15] = d.w;
        }
        const int colb = pn * 256 + 64 * wc + 8 * fq;
        TB(14, (LAS unsigned char*)rs - (131072 + 1024), wr * 256 + wc * 64 + fq * 16 + fr);
        {
            const int t = wr * 256 + wc * 64 + fq * 16 + fr;
            if (t < 256) {
                const f32x4* sp = (const f32x4*)(ssq + (size_t)(u.pm * 256 + t) * 16);
                const f32x4 s0 = sp[0], s1 = sp[1], s2 = sp[2], s3 = sp[3];
                const float tot = ((s0.x + s0.y) + (s0.z + s0.w)) + ((s1.x + s1.y) + (s1.z + s1.w)) + ((s2.x + s2.y) + (s2.z + s2.w)) + ((s3.x + s3.y) + (s3.z + s3.w));
                rs[t] = rsqrtf(tot * (1.f / DM) + EPS);
            }
            asm volatile("s_waitcnt vmcnt(0) lgkmcnt(0)" ::: "memory"); __builtin_amdgcn_s_barrier(); asm volatile("" ::: "memory");
        }
#pragma unroll
        for (int ai = 0; ai < 2; ++ai)
#pragma unroll
            for (int m = 0; m < 4; ++m) {
                const int row = u.pm * 256 + ai * 128 + wr * 64 + m * 16 + fr;
                const float rstd = rs[ai * 128 + wr * 64 + m * 16 + fr];
                float v[16];
#pragma unroll
                for (int bj = 0; bj < 2; ++bj)
#pragma unroll
                    for (int n = 0; n < 2; ++n)
#pragma unroll
                        for (int e = 0; e < 4; ++e) v[bj * 8 + n * 4 + e] = acc[ai][bj][m][n][e] * rstd;
                if (op == 1) {
#pragma unroll
                    for (int i = 0; i < 16; ++i) v[i] = silu_f(v[i]);
                } else if (op == 2 || op == 3) {
#pragma unroll
                    for (int i = 0; i < 16; i += 2) { const pg8::f32x2 r = pg8::gelu_pk((pg8::f32x2){v[i], v[i + 1]}); v[i] = r.x; v[i + 1] = r.y; }
                }
                if (op == 3 || op == 5) {
                    float ss = 0.f;
#pragma unroll
                    for (int i = 0; i < 16; ++i) ss += v[i] * v[i];
                    ss = xsum16(ss); ss = xsum32(ss);
                    const float sc = rsqrtf(ss * (1.f / 64) + EPS) * qs;
#pragma unroll
                    for (int i = 0; i < 16; ++i) v[i] *= sc * gn[i];
                } else if (op == 4) {
#pragma unroll
                    for (int bj = 0; bj < 2; ++bj) {
                        float ss = 0.f;
#pragma unroll
                        for (int i = 0; i < 8; ++i) ss += v[bj * 8 + i] * v[bj * 8 + i];
                        ss = xsum16(ss); ss = xsum32(ss);
                        const float sc = rsqrtf(ss * (1.f / 32) + EPS) * qs;
#pragma unroll
                        for (int i = 0; i < 8; ++i) v[bj * 8 + i] *= sc * gn[bj * 8 + i];
                    }
                }
                bf16_t* rowp = Y + (size_t)row * YP + colb;
#pragma unroll
                for (int bj = 0; bj < 2; ++bj) {
                    u32x4 w; w.x = pg8::cvt_pk_bf16(v[bj * 8 + 0], v[bj * 8 + 1]); w.y = pg8::cvt_pk_bf16(v[bj * 8 + 2], v[bj * 8 + 3]);
                    w.z = pg8::cvt_pk_bf16(v[bj * 8 + 4], v[bj * 8 + 5]); w.w = pg8::cvt_pk_bf16(v[bj * 8 + 6], v[bj * 8 + 7]);
                    *(GAS u32x4*)(uintptr_t)(rowp + 32 * bj) = w;
                }
            }
        TE(14, (LAS unsigned char*)rs - (131072 + 1024), wr * 256 + wc * 64 + fq * 16 + fr);
    }
};
struct EpiOut {
    static constexpr bool PERM = false, AFTER_DRAIN = false;
    float* xout; unsigned char* ws;
    __device__ __forceinline__ void operator()(const f32x4 (&acc)[2][2][4][2], const Unit& u, int wr, int wc, int fr_, int fq_) const {
        int fr = fr_, fq = fq_; asm volatile("" : "+v"(fr), "+v"(fq));
        const int col0 = u.pn * 256 + wc * 32 + 4 * fq;
        bf16_t* xb = (bf16_t*)(ws + WS_XB); float* ssq = (float*)(ws + WS_SSQ);
#pragma unroll
        for (int ai = 0; ai < 2; ++ai)
#pragma unroll
            for (int m = 0; m < 4; ++m) {
                const int row = u.pm * 256 + ai * 128 + wr * 64 + m * 16 + fr;
                float sq = 0.f;
#pragma unroll
                for (int bj = 0; bj < 2; ++bj)
#pragma unroll
                    for (int n = 0; n < 2; ++n) {
                        const size_t off = (size_t)row * DM + col0 + bj * 128 + n * 16;
                        const unsigned long long xo = *(const GAS unsigned long long*)(uintptr_t)(xb + off);
                        f32x4 v = acc[ai][bj][m][n];
                        v.x += __uint_as_float((unsigned)xo << 16); v.y += __uint_as_float((unsigned)xo & 0xffff0000u);
                        v.z += __uint_as_float((unsigned)(xo >> 32) << 16); v.w += __uint_as_float((unsigned)(xo >> 32) & 0xffff0000u);
                        sq += (v.x * v.x + v.y * v.y) + (v.z * v.z + v.w * v.w);
                        if (xout) *(GAS f32x4*)(uintptr_t)(xout + off) = v;
                        else *(GAS unsigned long long*)(uintptr_t)(xb + off) = (unsigned long long)pg8::cvt_pk_bf16(v.x, v.y) | ((unsigned long long)pg8::cvt_pk_bf16(v.z, v.w) << 32);
                    }
                sq = xsum16(sq); sq = xsum32(sq);
                if (fq == 0) ssq[(size_t)row * 16 + u.pn * 4 + wc] = sq;
                if (m == 3) asm volatile("" ::: "memory");
            }
    }
};
#define XB_TMO      128
#define XB_XCNT(j)  (256  + 64 * (j))
#define XB_XSUB(j)  (1280 + 64 * (j))
#define XB_XGEN(j)  (2304 + 64 * (j))
#define XB_TOP      3328
#define XB_TOPGEN   3392
#define XCD_BAR_WORDS 3456
#define XB_SPIN_CAP (1u << 18)

__device__ __forceinline__ unsigned xb_ld(unsigned* p)              { return __hip_atomic_load(p, __ATOMIC_RELAXED, __HIP_MEMORY_SCOPE_AGENT); }
__device__ __forceinline__ unsigned xb_add(unsigned* p, unsigned v) { return __hip_atomic_fetch_add(p, v, __ATOMIC_RELAXED, __HIP_MEMORY_SCOPE_AGENT); }
__device__ __forceinline__ unsigned xb_xcc_id() { return (unsigned)__builtin_amdgcn_s_getreg((3 << 11) | 20) & 0xFu; }
#define XB_SPIN(cond, bar) do { unsigned _sp = 0; while (cond) { __builtin_amdgcn_s_sleep(1); \
    if ((++_sp & 255u) == 0u) { if (xb_ld(&(bar)[XB_TMO])) break; if (_sp > XB_SPIN_CAP) { atomicAdd(&(bar)[XB_TMO], 1u); break; } } } } while (0)

struct XcdBarrier {
    unsigned* bar; unsigned x;
    volatile LAS unsigned* st;
};

__device__ __forceinline__ XcdBarrier xcd_barrier_post(unsigned* bar, volatile LAS unsigned* st) {
    XcdBarrier b; b.bar = bar; b.x = xb_xcc_id(); b.st = st;
    if (threadIdx.x == 0) (void)xb_add(&bar[XB_XCNT(b.x)], 1u);
    return b;
}
__device__ __forceinline__ void xcd_barrier_complete(unsigned* bar, unsigned x, unsigned& nloc, unsigned& nx) {
    const unsigned G = gridDim.x * gridDim.y * gridDim.z;
    unsigned sum, cnt, mine, sp = 0u;
    for (;;) {
        sum = 0u; cnt = 0u; mine = 0u;
#pragma unroll
        for (unsigned j = 0; j < 16; ++j) { const unsigned c = xb_ld(&bar[XB_XCNT(j)]); sum += c; cnt += (c > 0u) ? 1u : 0u; mine = (j == x) ? c : mine; }
        if (sum == G) break;
        __builtin_amdgcn_s_sleep(1);
        if ((++sp & 255u) == 0u) { if (xb_ld(&bar[XB_TMO])) break; if (sp > XB_SPIN_CAP) { atomicAdd(&bar[XB_TMO], 1u); break; } }
    }
    nloc = mine > 0u ? mine : 1u; nx = cnt > 0u ? cnt : 1u;
}

__device__ __forceinline__ void xcd_barrier(const XcdBarrier& b, int tid_in) {
    asm volatile("s_waitcnt vmcnt(0)" ::: "memory");
    __syncthreads();
    int t0_ = tid_in; asm volatile("" : "+v"(t0_));
    if (t0_ == 0) {
        unsigned* bar = b.bar; unsigned bx = b.x; asm volatile("" : "+s"(bar), "+s"(bx));
        __builtin_amdgcn_s_waitcnt(0);
        unsigned nloc = b.st[0], nx = b.st[1];
        if (nloc == 0u) { xcd_barrier_complete(bar, bx, nloc, nx); b.st[0] = nloc; b.st[1] = nx; }
        const unsigned old = xb_add(&bar[XB_XSUB(bx)], 1u);
        const unsigned gen = old / nloc;
        if (old + 1u == (gen + 1u) * nloc) {
            __builtin_amdgcn_fence(__ATOMIC_RELEASE, "agent");
            asm volatile("s_waitcnt vmcnt(0)" ::: "memory");
            const unsigned og = xb_add(&bar[XB_TOP], 1u);
            const unsigned tg = og / nx;
            if (og + 1u == (tg + 1u) * nx) xb_add(&bar[XB_TOPGEN], 1u);
            else XB_SPIN(xb_ld(&bar[XB_TOPGEN]) == tg, bar);
            __builtin_amdgcn_fence(__ATOMIC_ACQUIRE, "agent");
            xb_add(&bar[XB_XGEN(bx)], 1u);
            asm volatile("s_waitcnt vmcnt(0)" ::: "memory");
        } else {
            XB_SPIN(xb_ld(&bar[XB_XGEN(bx)]) == gen, bar);
            __builtin_amdgcn_fence(__ATOMIC_ACQUIRE, "agent");
            asm volatile("s_waitcnt vmcnt(0)" ::: "memory");
        }
    }
    __syncthreads();
}

typedef short bf16x8_t __attribute__((ext_vector_type(8)));
typedef short s16x4_t __attribute__((ext_vector_type(4)));
typedef float f32x16 __attribute__((ext_vector_type(16)));
typedef float f32x2_t __attribute__((ext_vector_type(2)));
typedef __bf16 bf16x2_t __attribute__((ext_vector_type(2)));
#define MFMA32(a, b, c) __builtin_amdgcn_mfma_f32_32x32x16_bf16((a), (b), (c), 0, 0, 0)
__device__ __forceinline__ unsigned cvtpk(float lo, float hi) { f32x2_t v = {lo, hi}; bf16x2_t b = __builtin_convertvector(v, bf16x2_t); return __builtin_bit_cast(unsigned, b); }
__device__ __forceinline__ s16x4_t ds_tr16(const LAS unsigned char* p) { return __builtin_bit_cast(s16x4_t, __builtin_amdgcn_ds_read_tr16_b64_v4i16((LAS s16x4_t*)p)); }
__device__ __forceinline__ bf16x8_t pack_step(const f32x16& x, int s) {
    u32x4 p; p.x = cvtpk(x[8 * s], x[8 * s + 1]); p.y = cvtpk(x[8 * s + 2], x[8 * s + 3]); p.z = cvtpk(x[8 * s + 4], x[8 * s + 5]); p.w = cvtpk(x[8 * s + 6], x[8 * s + 7]);
    return __builtin_bit_cast(bf16x8_t, p);
}
constexpr int KV_STRIDE = 144;
constexpr int KV_TILE = 64 * KV_STRIDE;
__device__ __forceinline__ bf16x8_t vt_frag(const LAS unsigned char* vtile, int ks, int db, int lane) {
    const int i16 = lane & 15, q = i16 >> 2, pp = i16 & 3, blk = (lane >> 4) & 1, hh = lane >> 5;
    const LAS unsigned char* a = vtile + (16 * ks + 4 * hh + q) * KV_STRIDE + (32 * db + 16 * blk + 4 * pp) * 2;
    const s16x4_t lo = ds_tr16(a), hi = ds_tr16(a + 8 * KV_STRIDE);
    return __builtin_shufflevector(lo, hi, 0, 1, 2, 3, 4, 5, 6, 7);
}

constexpr int KVL_TILE = 64 * 128;
__device__ __forceinline__ void dma_piece(const bf16_t* src_row0, LAS unsigned char* dst, int lane) {
    const bf16_t* g = src_row0 + (size_t)(lane >> 3) * YP + (((lane & 7) ^ (lane >> 3)) * 8);
    const unsigned d = (unsigned)__builtin_amdgcn_readfirstlane((int)(unsigned)(size_t)dst);
    unsigned keep;
    asm volatile("s_mov_b32 %0, m0\n\ts_mov_b32 m0, %2\n\ts_nop 0\n\tglobal_load_lds_dwordx4 %1, off\n\ts_mov_b32 m0, %0" : "=&s"(keep) : "v"(g), "s"(d) : "memory");
}
__device__ __forceinline__ bf16x8_t vt_frag_sw(const LAS unsigned char* vtile, int ks, int db, int lane) {
    const int i16 = lane & 15, q = i16 >> 2, pp = i16 & 3, blk = (lane >> 4) & 1, hh = lane >> 5;
    const int row = 16 * ks + 4 * hh + q, ch = 4 * db + 2 * blk + (pp >> 1);
    const LAS unsigned char* a = vtile + row * 128 + ((ch ^ (row & 7)) * 16) + (pp & 1) * 8;
    const s16x4_t lo = ds_tr16(a), hi = ds_tr16(a + 8 * 128);
    return __builtin_shufflevector(lo, hi, 0, 1, 2, 3, 4, 5, 6, 7);
}

__device__ __forceinline__ void store_pair16(bf16_t* rowp, int g0, unsigned a0, unsigned a1, unsigned b0, unsigned b1, int hh) {
    const unsigned s0 = hh ? a0 : b0, s1 = hh ? a1 : b1;
    const auto r0 = __builtin_amdgcn_permlane32_swap(s0, s0, false, false), r1 = __builtin_amdgcn_permlane32_swap(s1, s1, false, false);
    const unsigned q0 = hh ? r0[0] : r0[1], q1 = hh ? r1[0] : r1[1];
    u32x4 w;
    w.x = hh ? q0 : a0; w.y = hh ? q1 : a1; w.z = hh ? b0 : q0; w.w = hh ? b1 : q1;
    *(GAS u32x4*)(uintptr_t)(rowp + 8 * (g0 + (hh ? 1 : 0))) = w;
}

__device__ __forceinline__ void mixC_unit(const Params& p, int l, int b, int h, int qt, LAS unsigned char* lds, int wave_s) {
    const int tid = tid_now(wave_s);
    volatile LAS float* pc = (volatile LAS float*)(lds + 131072 + 2048);
    const float mfix = pc[0];
    const int lane = tid & 63, wave = __builtin_amdgcn_readfirstlane(tid >> 6), r32 = lane & 31, hh = lane >> 5;
    const size_t rowb = (size_t)b * SEQ;
    const int q0 = qt * 256 + wave * 32;
    const int cw = (q0 >> 6);
    const int jmax = 4 * qt + 3;
    const int pos = q0 + r32;
    const bf16_t* yq = p.Y() + (rowb + pos) * YP;
    bf16x8_t qf[2][2];
#pragma unroll
    for (int c = 0; c < 2; ++c)
#pragma unroll
        for (int s = 0; s < 2; ++s) qf[c][s] = *(const GAS bf16x8_t*)(uintptr_t)(yq + YC_Q + h * 64 + c * 32 + 16 * s + 8 * hh);
    const float sl2 = exp2f(-(float)(2 * h + 1)) * 1.4426950408889634f;
    f32x16 o[2][2];
#pragma unroll
    for (int c = 0; c < 2; ++c)
#pragma unroll
        for (int d = 0; d < 2; ++d)
#pragma unroll
            for (int i = 0; i < 16; ++i) o[c][d][i] = 0.f;
    f32x16 lacc;
#pragma unroll
    for (int i = 0; i < 16; ++i) lacc[i] = 0.f;
    bf16x8_t one0, one1;
    { const unsigned lo = r32 < 16 ? 0x3f803f80u : 0u, hi = r32 < 16 ? 0u : 0x3f803f80u;
      one0 = __builtin_bit_cast(bf16x8_t, (u32x4){lo, lo, lo, lo}); one1 = __builtin_bit_cast(bf16x8_t, (u32x4){hi, hi, hi, hi}); }
    bf16x8_t kext;
    {
        const float t = sl2 * (float)r32;
        const unsigned u = cvtpk(t, 0.f), v = cvtpk(t - __uint_as_float(u << 16), 0.f);
        u32x4 w; w.x = hh ? 0u : (u | (v << 16)); w.y = hh ? 0u : 0x3f803f80u; w.z = hh ? 0u : 0x00003f80u; w.w = 0u;
        kext = __builtin_bit_cast(bf16x8_t, w);
    }
    const bf16_t* ksrc = p.Y() + (rowb + 8 * wave) * YP + YC_K + h * 64;
    const bf16_t* vsrc = p.Y() + (rowb + 8 * wave) * YP + YC_V + h * 64;
    LAS unsigned char* kring = lds;
    LAS unsigned char* vring = lds + 6 * KVL_TILE;
    asm volatile("" : "+v"(qf[0][0]), "+v"(qf[0][1]), "+v"(qf[1][0]), "+v"(qf[1][1]));
    LAS unsigned char* qpark = lds + 12 * KVL_TILE + wave * 4096 + lane * 16;
    const float mfix_r = mfix; asm volatile("" :: "v"(mfix_r));
    asm volatile("s_waitcnt lgkmcnt(0)" ::: "memory"); __builtin_amdgcn_s_barrier(); asm volatile("" ::: "memory");
#pragma unroll
    for (int t = 0; t < 4; ++t) { dma_piece(ksrc + (size_t)t * 64 * YP, kring + t * KVL_TILE + wave * 1024, lane); dma_piece(vsrc + (size_t)t * 64 * YP, vring + t * KVL_TILE + wave * 1024, lane); }
#pragma unroll
    for (int f = 0; f < 4; ++f) *(LAS bf16x8_t*)(qpark + f * 1024) = qf[f >> 1][f & 1];
    int slot = 0, slot2 = 4;
    if (wave >= 4) __builtin_amdgcn_s_setprio(1);
    for (int j = 0; j <= jmax; ++j) {
        if ((j & 1) == 0) {
            TB(3, lds, tid);
            if (j + 2 <= jmax) asm volatile("s_waitcnt vmcnt(4)" ::: "memory"); else asm volatile("s_waitcnt vmcnt(0)" ::: "memory");
            __builtin_amdgcn_s_barrier(); asm volatile("" ::: "memory");
            if (j + 4 <= jmax) {
#pragma unroll
                for (int t = 0; t < 2; ++t) {
                    const int sl = slot2 + t >= 6 ? slot2 + t - 6 : slot2 + t;
                    dma_piece(ksrc + (size_t)(j + 4 + t) * 64 * YP, kring + sl * KVL_TILE + wave * 1024, lane); dma_piece(vsrc + (size_t)(j + 4 + t) * 64 * YP, vring + sl * KVL_TILE + wave * 1024, lane);
                }
            }
            TE(3, lds, tid);
        }
        TB(2, lds, tid);
        if (j <= cw) {
            const LAS unsigned char* kt = kring + slot * KVL_TILE;
            const LAS unsigned char* vt = vring + slot * KVL_TILE;
            const bool diag = (j == cw);
            bf16x8_t qext[2];
#pragma unroll
            for (int kb = 0; kb < 2; ++kb) {
                const float cj = fmaf(sl2, (float)(64 * j + 32 * kb - pos), -mfix);
                const unsigned u = cvtpk(cj, 0.f); const float r1 = cj - __uint_as_float(u << 16);
                const unsigned v = cvtpk(r1, 0.f), x = cvtpk(r1 - __uint_as_float(v << 16), 0.f);
                const bool off = hh != 0 || diag;
                u32x4 w; w.x = off ? 0u : 0x3f803f80u; w.y = off ? 0u : (u | (v << 16)); w.z = off ? 0u : x; w.w = 0u;
                qext[kb] = __builtin_bit_cast(bf16x8_t, w);
            }
            unsigned ka = (unsigned)(size_t)kt + (unsigned)(r32 * 128 + ((hh ^ (r32 & 7)) * 16)); asm volatile("" : "+v"(ka));
            f32x16 sc[2][2];
            {
                bf16x8_t kfa[2][2], kfb[2][2], qa[2], qb[2];
#pragma unroll
                for (int s = 0; s < 2; ++s) qa[s] = *(const LAS bf16x8_t*)(qpark + s * 1024);
#pragma unroll
                for (int kb = 0; kb < 2; ++kb)
#pragma unroll
                    for (int s = 0; s < 2; ++s) kfa[kb][s] = *(const LAS bf16x8_t*)(size_t)((ka ^ (unsigned)(32 * s)) + 4096u * kb);
                __builtin_amdgcn_sched_barrier(0);
#pragma unroll
                for (int kb = 0; kb < 2; ++kb)
#pragma unroll
                    for (int s = 0; s < 2; ++s) kfb[kb][s] = *(const LAS bf16x8_t*)(size_t)((ka ^ (unsigned)(64 + 32 * s)) + 4096u * kb);
#pragma unroll
                for (int s = 0; s < 2; ++s) qb[s] = *(const LAS bf16x8_t*)(qpark + (2 + s) * 1024);
#pragma unroll
                for (int c = 0; c < 2; ++c)
#pragma unroll
                    for (int kb = 0; kb < 2; ++kb) {
                        f32x16 z;
#pragma unroll
                        for (int i = 0; i < 16; ++i) z[i] = 0.f;
                        sc[c][kb] = MFMA32(kext, qext[kb], z);
                    }
#pragma unroll
                for (int s = 0; s < 2; ++s)
#pragma unroll
                    for (int kb = 0; kb < 2; ++kb) sc[0][kb] = MFMA32(kfa[kb][s], qa[s], sc[0][kb]);
                __builtin_amdgcn_sched_barrier(0);
#pragma unroll
                for (int s = 0; s < 2; ++s)
#pragma unroll
                    for (int kb = 0; kb < 2; ++kb) sc[1][kb] = MFMA32(kfb[kb][s], qb[s], sc[1][kb]);
            }
            __builtin_amdgcn_sched_barrier(0);
            const float pl = (float)(pos - 64 * j - 4 * hh);
            bf16x8_t pf0[4], pf1[4];
            if (!diag) {
#pragma unroll
                for (int kb = 0; kb < 2; ++kb)
#pragma unroll
                    for (int i = 0; i < 16; ++i) sc[0][kb][i] = __builtin_amdgcn_exp2f(sc[0][kb][i]);
            } else {
#pragma unroll
                for (int kb = 0; kb < 2; ++kb)
#pragma unroll
                    for (int i = 0; i < 16; ++i) {
                        const float kc = (float)(32 * kb + (i & 3) + 8 * (i >> 2));
                        sc[0][kb][i] = __builtin_amdgcn_exp2f(sc[0][kb][i] + fmaf(-sl2, fabsf(pl - kc), -mfix));
                    }
            }
#pragma unroll
            for (int ks = 0; ks < 4; ++ks) pf0[ks] = pack_step(sc[0][ks >> 1], ks & 1);
            __builtin_amdgcn_sched_barrier(0);
#pragma unroll
            for (int ks = 0; ks < 4; ++ks) {
                const bf16x8_t a0 = vt_frag_sw(vt, ks, 0, lane), a1 = vt_frag_sw(vt, ks, 1, lane);
                o[0][0] = MFMA32(a0, pf0[ks], o[0][0]); o[0][1] = MFMA32(a1, pf0[ks], o[0][1]); lacc = MFMA32(one0, pf0[ks], lacc);
                const int kb = ks >> 1;
                if (!diag) {
#pragma unroll
                    for (int i = 8 * (ks & 1); i < 8 * (ks & 1) + 8; ++i) sc[1][kb][i] = __builtin_amdgcn_exp2f(sc[1][kb][i]);
                } else {
#pragma unroll
                    for (int i = 8 * (ks & 1); i < 8 * (ks & 1) + 8; ++i) {
                        const float kc = (float)(32 * kb + (i & 3) + 8 * (i >> 2));
                        sc[1][kb][i] = __builtin_amdgcn_exp2f(sc[1][kb][i] + fmaf(-sl2, fabsf(pl - kc), -mfix));
                    }
                }
                pf1[ks] = pack_step(sc[1][kb], ks & 1);
                __builtin_amdgcn_sched_barrier(0);
            }
#pragma unroll
            for (int ks = 0; ks < 4; ++ks) {
                const bf16x8_t a0 = vt_frag_sw(vt, ks, 0, lane), a1 = vt_frag_sw(vt, ks, 1, lane);
                o[1][0] = MFMA32(a0, pf1[ks], o[1][0]); o[1][1] = MFMA32(a1, pf1[ks], o[1][1]); lacc = MFMA32(one1, pf1[ks], lacc);
                __builtin_amdgcn_sched_barrier(0);
            }
        }
        TE(2, lds, tid);
        slot = slot == 5 ? 0 : slot + 1; slot2 = slot2 == 5 ? 0 : slot2 + 1;
    }
    __builtin_amdgcn_s_setprio(0);
    const float lam = pc[1], oml = pc[2];
    const int tid2 = tid_now(wave_s), lane2 = tid2 & 63, r32e = lane2 & 31, hhe = lane2 >> 5;
    const int pose = qt * 256 + wave * 32 + r32e;
    const bf16_t* yqe = p.Y() + (rowb + pose) * YP;
    const float l1 = lacc[0], l2 = lacc[8];
    const float i1 = 1.f / l1, i2 = lam / l2;
    float ss = 0.f;
#pragma unroll
    for (int d = 0; d < 2; ++d)
#pragma unroll
        for (int i = 0; i < 16; ++i) { const float v = o[0][d][i] * i1 - o[1][d][i] * i2; o[0][d][i] = v; ss += v * v; }
    ss = xsum32(ss);
    const float rn = rsqrtf(ss * (1.f / 64) + EPS) * oml;
    const GAS float* sg = p.sm(SM_SUBG) + l * 256 + h * 64;
    bf16_t* mrow = p.mix() + (rowb + pose) * DM + 512 + h * 64;
#pragma unroll
    for (int d = 0; d < 2; ++d) {
        unsigned pk00, pk01, pk10, pk11, pk20, pk21, pk30, pk31;
#pragma unroll
        for (int g = 0; g < 4; ++g) {
            const int d0 = 32 * d + 8 * g + 4 * hhe;
            const f32x4 gv = *(const GAS f32x4*)(uintptr_t)(sg + d0);
            const unsigned long long zz = *(const GAS unsigned long long*)(uintptr_t)(yqe + YC_Z + h * 64 + d0);
            const float z0 = __uint_as_float((unsigned)(zz & 0xffffu) << 16), z1 = __uint_as_float((unsigned)((zz >> 16) & 0xffffu) << 16),
                        z2 = __uint_as_float((unsigned)((zz >> 32) & 0xffffu) << 16), z3 = __uint_as_float((unsigned)((zz >> 48) & 0xffffu) << 16);
            const float v0 = o[0][d][4 * g] * rn * gv.x * z0, v1 = o[0][d][4 * g + 1] * rn * gv.y * z1, v2 = o[0][d][4 * g + 2] * rn * gv.z * z2, v3 = o[0][d][4 * g + 3] * rn * gv.w * z3;
            const unsigned pa = cvtpk(v0, v1), pb = cvtpk(v2, v3);
            if (g == 0) { pk00 = pa; pk01 = pb; } else if (g == 1) { pk10 = pa; pk11 = pb; } else if (g == 2) { pk20 = pa; pk21 = pb; } else { pk30 = pa; pk31 = pb; }
        }
        store_pair16(mrow + 32 * d, 0, pk00, pk01, pk10, pk11, hhe);
        store_pair16(mrow + 32 * d, 2, pk20, pk21, pk30, pk31, hhe);
    }
}
__device__ __forceinline__ void ph_mixC(const Params& p, int l, LAS unsigned char* lds, int bid, int nb, int wave_s) {
    {
        const float lam_init = l == 0 ? 0.200000001f : l == 1 ? 0.355509068f : l == 2 ? 0.470713018f : 0.556058204f;
        const GAS float* lp = p.sm(SM_LAM) + l * 128;
        float d1 = 0.f, d2 = 0.f;
        for (int i = 0; i < 32; ++i) { d1 += lp[i] * lp[32 + i]; d2 += lp[64 + i] * lp[96 + i]; }
        float gq = 0.f, gk = 0.f;
        for (int i = 0; i < 32; ++i) { gq = fmaxf(gq, fabsf(p.sm(SM_QG)[l * 32 + i])); gk = fmaxf(gk, fabsf(p.sm(SM_KG)[l * 32 + i])); }
        volatile LAS float* pc = (volatile LAS float*)(lds + 131072 + 2048);
        if (tid_now(wave_s) == 0) {
            pc[0] = 0.17677669529663687f * 1.4426950408889634f * 32.f * gq * gk * 1.02f;
            pc[1] = expf(d1) - expf(d2) + lam_init;
            pc[2] = 1.f - lam_init;
        }
        __syncthreads();
    }
    for (int i = bid; i < 256; i += nb) {
#pragma unroll 1
        for (int k = 0; k < 2; ++k) {
            const int id = k == 0 ? i : 511 - i;
            const int qt = id < 256 ? 7 - (id >> 6) : 3 - ((id - 256) >> 6), bh = id & 63;
            mixC_unit(p, l, bh >> 2, bh & 3, qt, lds, wave_s);
        }
    }
}

constexpr int SC_STRIDE = 2052;
constexpr int SC_BYTES = 16 * SC_STRIDE * 4;
constexpr int IK_STRIDE = 80, IK_TILE = 64 * IK_STRIDE;
constexpr int MSK_QSTRIDE = 520;
constexpr int DMN_OFF = 131072 + 1024, DB2_OFF = 131072 + 2048 + 16;
constexpr int MSK_OFF0 = 131072 + 4096, MSK_OFF1 = 65536;
__device__ __forceinline__ unsigned fkey(float f) { const unsigned u = __float_as_uint(f); return u ^ ((unsigned)((int)u >> 31) | 0x80000000u); }
__device__ __forceinline__ float unfkey(unsigned k) { return __uint_as_float((k & 0x80000000u) ? (k & 0x7fffffffu) : ~k); }
__device__ __forceinline__ f32x16 idx_scores(const bf16x8_t ik0, const bf16x8_t ik1, const bf16x8_t (&iqf)[4][2], const float (&w)[4]) {
    f32x16 sc;
#pragma unroll
    for (int i = 0; i < 16; ++i) sc[i] = 0.f;
#pragma unroll
    for (int hd = 0; hd < 4; ++hd) {
        f32x16 a;
#pragma unroll
        for (int i = 0; i < 16; ++i) a[i] = 0.f;
        a = MFMA32(ik0, iqf[hd][0], a);
        a = MFMA32(ik1, iqf[hd][1], a);
#pragma unroll
        for (int i = 0; i < 16; ++i) sc[i] = fmaf(w[hd], __builtin_amdgcn_fmed3f(a[i], 0.f, 3.0e38f), sc[i]);
    }
#pragma unroll
    for (int i = 0; i < 16; ++i) sc[i] = sc[i] + 0.f;
    return sc;
}
__device__ __forceinline__ void transpose32(unsigned (&a)[32]) {
#pragma unroll
    for (int s = 0; s < 5; ++s) {
        const int j = 16 >> s;
        const unsigned mk = j == 16 ? 0x0000ffffu : j == 8 ? 0x00ff00ffu : j == 4 ? 0x0f0f0f0fu : j == 2 ? 0x33333333u : 0x55555555u;
#pragma unroll
        for (int k = 0; k < 32; ++k)
            if ((k & j) == 0) { const unsigned t = (a[k] ^ (a[k + j] >> j)) & mk; a[k] ^= t; a[k + j] ^= t << j; asm volatile("" : "+v"(a[k]), "+v"(a[k + j])); }
    }
}
__device__ __forceinline__ int rowsum16(int v) {
    v += __builtin_amdgcn_update_dpp(0, v, 0x128, 0xf, 0xf, true);
    v += __builtin_amdgcn_update_dpp(0, v, 0x124, 0xf, 0xf, true);
    v += __builtin_amdgcn_update_dpp(0, v, 0x122, 0xf, 0xf, true);
    v += __builtin_amdgcn_update_dpp(0, v, 0x121, 0xf, 0xf, true);
    return v;
}
__device__ __forceinline__ unsigned topbits(int ne) { return ne <= 0 ? 0u : ne >= 32 ? 0xffffffffu : (0xffffffffu << (32 - ne)); }
template <int NG, int ST>
__device__ __forceinline__ void rs4_row(const unsigned (&pl)[NG][32], unsigned (&alive)[NG], unsigned (&gt)[NG], int& above, unsigned& prefix, bool& done, bool& alld) {
    if (!alld) {
        int c11 = 0, c10 = 0, c01 = 0;
#pragma unroll
        for (int j = 0; j < NG; ++j) {
            const unsigned p1 = pl[j][2 * ST], p0 = pl[j][2 * ST + 1], a1 = alive[j] & p1, a0 = alive[j] & ~p1;
            c11 += __popc(a1 & p0); c10 += __popc(a1 & ~p0); c01 += __popc(a0 & p0);
        }
        const int s01 = rowsum16(c11 | (c10 << 16)), s2 = rowsum16(c01);
        if (!done) {
            const int t11 = above + (s01 & 0xffff), t10 = t11 + (int)((unsigned)s01 >> 16), t01 = t10 + s2;
            const int dg = t11 >= TOPK ? 3 : t10 >= TOPK ? 2 : t01 >= TOPK ? 1 : 0;
            const int tsel = dg == 3 ? t11 : dg == 2 ? t10 : t01;
            prefix |= (unsigned)dg << (30 - 2 * ST);
            above = dg == 3 ? above : dg == 2 ? t11 : dg == 1 ? t10 : t01;
            const unsigned m1 = (dg & 2) ? 0xffffffffu : 0u, m0 = (dg & 1) ? 0xffffffffu : 0u;
#pragma unroll
            for (int j = 0; j < NG; ++j) {
                const unsigned p1 = pl[j][2 * ST], p0 = pl[j][2 * ST + 1], x1 = p1 ^ m1, x0 = p0 ^ m0;
                gt[j] |= alive[j] & ((x1 & p1) | (~x1 & x0 & p0));
                alive[j] &= ~(x1 | x0);
            }
            if (dg != 0 && tsel == TOPK) done = true;
        }
        alld = __all(done);
    }
    if constexpr (ST < 15) rs4_row<NG, ST + 1>(pl, alive, gt, above, prefix, done, alld);
}
template <int NG>
__device__ __forceinline__ void d1_pass(const Params& p, size_t rowb, int c, int sp, LAS unsigned char* lds, int wave_s) {
    const int tid = tid_now(wave_s);
    const int lane = tid & 63, wave = __builtin_amdgcn_readfirstlane(tid >> 6), r32 = lane & 31, hh = lane >> 5;
    const int q0 = c * 64, ntile = c + 1;
    constexpr int SKS = 1028;
    constexpr int NRD = (NG + 1) / 2;
    LAS unsigned* sk = (LAS unsigned*)lds;
    const int nblk = 2 * ntile;
    const int nbw = (nblk - wave + 7) >> 3;
    const int nv = 4 * ntile;
    TB(4, lds, tid); TB(5, lds, tid);
    unsigned kr[NG][32];
    unsigned zopq = 0u; asm volatile("" : "+v"(zopq));
    {
        const bf16_t* yq1 = p.Y() + (rowb + q0 + 32 * sp + r32) * YP;
        bf16x8_t iqf[4][2];
#pragma unroll
        for (int hd = 0; hd < 4; ++hd)
#pragma unroll
            for (int s = 0; s < 2; ++s) iqf[hd][s] = *(const GAS bf16x8_t*)(uintptr_t)(yq1 + YI_Q + hd * 32 + 16 * s + 8 * hh);
        float w[4];
        const unsigned long long ww = *(const GAS unsigned long long*)(uintptr_t)(yq1 + YI_W);
#pragma unroll
        for (int hd = 0; hd < 4; ++hd) w[hd] = __uint_as_float((unsigned)((ww >> (16 * hd)) & 0xffffu) << 16) * (0.17677669529663687f * 0.5f);
        bf16x8_t ik[2 * NG][2];
#pragma unroll
        for (int i = 0; i < 2 * NG; ++i) {
            const int kb = i < nbw ? wave + 8 * i : wave;
            const bf16_t* yk = p.Y() + (rowb + 32 * kb + r32) * YP + YI_K + 8 * hh;
            ik[i][0] = *(const GAS bf16x8_t*)(uintptr_t)yk; ik[i][1] = *(const GAS bf16x8_t*)(uintptr_t)(yk + 16);
        }
#pragma unroll
        for (int blk = 0; blk < 2 * NG; ++blk) {
            if (blk < nbw) {
                const f32x16 sc = idx_scores(ik[blk][0], ik[blk][1], iqf, w);
#pragma unroll
                for (int r = 0; r < 16; ++r) kr[blk >> 1][16 * (blk & 1) + r] = fkey(sc[r]);
            } else {
#pragma unroll
                for (int r = 0; r < 16; ++r) kr[blk >> 1][16 * (blk & 1) + r] = zopq;
            }
        }
    }
    TE(5, lds, tid); TB(20, lds, tid);
    unsigned pl[NG][32];
    {
        const int rq = 4 * wave + (lane >> 4), rt = lane & 15;
#pragma unroll
        for (int rd = 0; rd < NRD; ++rd) {
#pragma unroll
            for (int i = 0; i < 4; ++i)
                if (4 * rd + i < 2 * NG) {
#pragma unroll
                    for (int g = 0; g < 4; ++g) {
                        const int blk = 4 * rd + i;
                        u32x4 v; v.x = kr[blk >> 1][16 * (blk & 1) + 4 * g]; v.y = kr[blk >> 1][16 * (blk & 1) + 4 * g + 1]; v.z = kr[blk >> 1][16 * (blk & 1) + 4 * g + 2]; v.w = kr[blk >> 1][16 * (blk & 1) + 4 * g + 3];
                        *(LAS u32x4*)(sk + r32 * SKS + 32 * wave + 256 * i + 8 * g + 4 * hh) = v;
                    }
                }
            __syncthreads();
#pragma unroll
            for (int M = 0; M < 16; ++M)
                if (2 * rd + (M >> 3) < NG) {
                    const u32x4 v = *(const LAS u32x4*)(sk + rq * SKS + 64 * M + 4 * rt);
                    pl[2 * rd + (M >> 3)][4 * (M & 7)] = v.x; pl[2 * rd + (M >> 3)][4 * (M & 7) + 1] = v.y; pl[2 * rd + (M >> 3)][4 * (M & 7) + 2] = v.z; pl[2 * rd + (M >> 3)][4 * (M & 7) + 3] = v.w;
                }
            __syncthreads();
        }
    }
    TE(20, lds, tid); TB(6, lds, tid);
#pragma unroll
    for (int j = 0; j < NG; ++j) transpose32(pl[j]);
    TE(6, lds, tid); TB(7, lds, tid);
    unsigned alive[NG], gt[NG];
#pragma unroll
    for (int j = 0; j < NG; ++j) { alive[j] = topbits(nv - 32 * j); gt[j] = 0u; }
    int above = 0; unsigned prefix = 0u; bool done = false, alld = false;
    rs4_row<NG, 0>(pl, alive, gt, above, prefix, done, alld);
    TE(7, lds, tid); TB(8, lds, tid);
    int kcut = 1 << 20;
    if (!__all(done)) {
        const int need = TOPK - above, rt = lane & 15;
        int posk = 0;
#pragma unroll 1
        for (int b2 = 10; b2 >= 0; --b2) {
            const int tt = posk | (1 << b2);
            const int R = tt - 4 * rt;
            const int M = R <= 0 ? 0 : 4 * (R >> 6) + min(R & 63, 4);
            int cnt = 0;
#pragma unroll
            for (int j = 0; j < NG; ++j) cnt += __popc(alive[j] & topbits(M - 32 * j));
            const int f = rowsum16(cnt);
            if (f < need) posk = tt;
        }
        if (!done) kcut = posk;
    }
    {
        const int rt = lane & 15, R = kcut + 1 - 4 * rt;
        const int Mc = R <= 0 ? 0 : 4 * (R >> 6) + min(R & 63, 4);
        LAS unsigned char* mq = lds + (sp == 0 ? MSK_OFF0 : MSK_OFF1) + (4 * wave + (lane >> 4)) * MSK_QSTRIDE + ((rt >> 3) * 2 + (rt & 1)) * 4 + ((rt >> 1) & 3);
        unsigned sel[NG];
#pragma unroll
        for (int j = 0; j < NG; ++j) sel[j] = __builtin_bitreverse32(gt[j] | (alive[j] & topbits(Mc - 32 * j)));
#pragma unroll
        for (int j = 0; j < NG; ++j)
#pragma unroll
            for (int n = 0; n < 8; ++n) *(LAS unsigned char*)(mq + (8 * j + n) * 16) = (unsigned char)(sel[j] >> (4 * n));
        const int rq = 32 * sp + 4 * wave + (lane >> 4);
        int dmin = 1 << 20;
#pragma unroll
        for (int j = 0; j < NG; ++j) {
            const int nlo = 4 * c - 32 * j;
            const unsigned w = sel[j] & (nlo <= 0 ? 0u : nlo >= 32 ? 0xffffffffu : ((1u << nlo) - 1u));
            if (w) { const int s = 32 * j + 31 - __builtin_clz(w); dmin = 64 * c + rq - (64 * (s >> 2) + 4 * rt + (s & 3)); }
        }
        const unsigned nib = (sel[NG - 1] >> (4 * (c & 7))) & 15u;
#pragma unroll
        for (int e = 0; e < 4; ++e) if (nib & (1u << e)) dmin = min(dmin, abs(rq - 4 * rt - e));
        dmin = min(dmin, __builtin_amdgcn_update_dpp(0, dmin, 0x128, 0xf, 0xf, true));
        dmin = min(dmin, __builtin_amdgcn_update_dpp(0, dmin, 0x124, 0xf, 0xf, true));
        dmin = min(dmin, __builtin_amdgcn_update_dpp(0, dmin, 0x122, 0xf, 0xf, true));
        dmin = min(dmin, __builtin_amdgcn_update_dpp(0, dmin, 0x121, 0xf, 0xf, true));
        if (rt == 0) *(LAS float*)(lds + DMN_OFF + 4 * rq) = (float)dmin;
    }
    TE(8, lds, tid); TE(4, lds, tid);
    __syncthreads();
}
__device__ __forceinline__ void mixD_attend(const Params& p, int b, int c, LAS unsigned char* lds, int wave_s);
__device__ __forceinline__ void mixD_unit(const Params& p, int b, int c, LAS unsigned char* lds, int wave_s) {
    const size_t rowb = (size_t)b * SEQ;
    __syncthreads();
    if (c >= 4) {
#pragma unroll 1
        for (int sp = 0; sp < 2; ++sp) {
            const int ng = (c >> 3) + 1;
            if (ng == 1) d1_pass<1>(p, rowb, c, sp, lds, wave_s);
            else if (ng == 2) d1_pass<2>(p, rowb, c, sp, lds, wave_s);
            else if (ng == 3) d1_pass<3>(p, rowb, c, sp, lds, wave_s);
            else d1_pass<4>(p, rowb, c, sp, lds, wave_s);
        }
    }
    mixD_attend(p, b, c, lds, wave_s);
}
__device__ __forceinline__ void mixD_attend(const Params& p, int b, int c, LAS unsigned char* lds, int wave_s) {
    const int tid = tid_now(wave_s);
    const int lane = tid & 63, wave = __builtin_amdgcn_readfirstlane(tid >> 6), r32 = lane & 31, hh = lane >> 5;
    const size_t rowb = (size_t)b * SEQ;
    const int q0 = c * 64, ntile = c + 1;
    const bool dosel = c >= 4;
    TB(9, lds, tid);
    const int qg = wave >> 2, hd = wave & 3;
    const int pos = q0 + 32 * qg + r32;
    const bf16_t* yq = p.Y() + (rowb + pos) * YP;
    bf16x8_t qf[4];
#pragma unroll
    for (int s = 0; s < 4; ++s) qf[s] = *(const GAS bf16x8_t*)(uintptr_t)(yq + YD_Q + hd * 64 + 16 * s + 8 * hh);
    const float sl2 = exp2f(-(float)(2 * hd + 2)) * 1.4426950408889634f;
    f32x16 o[2];
#pragma unroll
    for (int d = 0; d < 2; ++d)
#pragma unroll
        for (int i = 0; i < 16; ++i) o[d][i] = 0.f;
    const float mref = fmaf(-sl2, dosel ? *(volatile LAS float*)(lds + DMN_OFF + 4 * (32 * qg + r32)) : 0.f, *(volatile LAS float*)(lds + DB2_OFF));
    float lrun = 0.f;
    bf16x8_t kext[2];
#pragma unroll
    for (int kb = 0; kb < 2; ++kb) {
        const float t = sl2 * (float)(32 * kb + r32);
        const unsigned u = cvtpk(t, 0.f), v = cvtpk(t - __uint_as_float(u << 16), 0.f);
        u32x4 w; w.x = hh ? 0u : (u | (v << 16)); w.y = hh ? 0u : 0x3f803f80u; w.z = hh ? 0u : 0x00003f80u; w.w = 0u;
        kext[kb] = __builtin_bit_cast(bf16x8_t, w);
    }
    const int npair = (ntile + 1) >> 1;
    const bf16_t* ksrc = p.Y() + (rowb + 8 * wave) * YP + YD_K;
    const bf16_t* vsrc = p.Y() + (rowb + 8 * wave) * YP + YD_V;
    LAS unsigned char* kring = lds;
    LAS unsigned char* vring = lds + 4 * KVL_TILE;
    const LAS unsigned char* mq = lds + (qg == 0 ? MSK_OFF0 : MSK_OFF1) + r32 * MSK_QSTRIDE + 4 * hh;
    asm volatile("" : "+v"(qf[0]), "+v"(qf[1]), "+v"(qf[2]), "+v"(qf[3]));
    __syncthreads();
#pragma unroll
    for (int tt = 0; tt < 2; ++tt) {
        const int t = min(tt, ntile - 1);
        dma_piece(ksrc + (size_t)t * 64 * YP, kring + tt * KVL_TILE + wave * 1024, lane); dma_piece(vsrc + (size_t)t * 64 * YP, vring + tt * KVL_TILE + wave * 1024, lane);
    }
    if (wave >= 4) __builtin_amdgcn_s_setprio(1);
    for (int pp = 0; pp < npair; ++pp) {
        const int cur = pp & 1;
        const bool more = pp + 1 < npair;
        TB(12, lds, tid);
        asm volatile("s_waitcnt vmcnt(0) lgkmcnt(0)" ::: "memory"); __builtin_amdgcn_s_barrier(); asm volatile("" ::: "memory");
        TE(12, lds, tid);
        if (more) {
#pragma unroll
            for (int tt = 0; tt < 2; ++tt) {
                const int t = min(2 * (pp + 1) + tt, ntile - 1);
                dma_piece(ksrc + (size_t)t * 64 * YP, kring + ((cur ^ 1) * 2 + tt) * KVL_TILE + wave * 1024, lane); dma_piece(vsrc + (size_t)t * 64 * YP, vring + ((cur ^ 1) * 2 + tt) * KVL_TILE + wave * 1024, lane);
            }
        }
        TB(11, lds, tid);
#pragma unroll 1
        for (int tt = 0; tt < 2; ++tt) {
            const int j = 2 * pp + tt;
            if (j < ntile) {
                const LAS unsigned char* kt = kring + (cur * 2 + tt) * KVL_TILE;
                const LAS unsigned char* vt = vring + (cur * 2 + tt) * KVL_TILE;
                const bool diag = (j == c);
                unsigned selb[2] = {0xffffffffu, 0xffffffffu};
                if (dosel) { selb[0] = *(const LAS unsigned*)(mq + 16 * j); selb[1] = *(const LAS unsigned*)(mq + 16 * j + 8); }
                bf16x8_t qext;
                {
                    const float cj = fmaf(sl2, (float)(64 * j - pos), -mref);
                    const unsigned u = cvtpk(cj, 0.f); const float r1 = cj - __uint_as_float(u << 16);
                    const unsigned v = cvtpk(r1, 0.f), x = cvtpk(r1 - __uint_as_float(v << 16), 0.f);
                    const bool off = hh != 0 || diag;
                    u32x4 w; w.x = off ? 0u : 0x3f803f80u; w.y = off ? 0u : (u | (v << 16)); w.z = off ? 0u : x; w.w = 0u;
                    qext = __builtin_bit_cast(bf16x8_t, w);
                }
                bf16x8_t kf[2][4];
#pragma unroll
                for (int kb = 0; kb < 2; ++kb)
#pragma unroll
                    for (int s = 0; s < 4; ++s) kf[kb][s] = *(const LAS bf16x8_t*)(kt + (32 * kb + r32) * 128 + (((2 * s + hh) ^ (r32 & 7)) * 16));
                __builtin_amdgcn_sched_barrier(0);
                f32x16 sc[2];
#pragma unroll
                for (int kb = 0; kb < 2; ++kb) {
                    f32x16 z;
#pragma unroll
                    for (int i = 0; i < 16; ++i) z[i] = 0.f;
                    sc[kb] = MFMA32(kext[kb], qext, z);
                }
#pragma unroll
                for (int s = 0; s < 4; ++s)
#pragma unroll
                    for (int kb = 0; kb < 2; ++kb) sc[kb] = MFMA32(kf[kb][s], qf[s], sc[kb]);
                bf16x8_t vf0 = vt_frag_sw(vt, 0, 0, lane), vf1 = vt_frag_sw(vt, 0, 1, lane);
                __builtin_amdgcn_sched_barrier(0);
#pragma unroll
                for (int kb = 0; kb < 2; ++kb) {
                    if (diag) {
                        const float pl = (float)(pos - 64 * j - 4 * hh);
#pragma unroll
                        for (int i = 0; i < 16; ++i) { const float kc = (float)(32 * kb + (i & 3) + 8 * (i >> 2)); sc[kb][i] += fmaf(-sl2, fabsf(pl - kc), -mref); }
                    }
#pragma unroll
                    for (int i = 0; i < 16; ++i) {
                        const unsigned t = (unsigned)__builtin_amdgcn_sbfe((int)selb[kb], 8 * (i >> 2) + (i & 3), 1);
                        sc[kb][i] = __uint_as_float(__float_as_uint(__builtin_amdgcn_exp2f(sc[kb][i])) & t);
                    }
                }
                f32x2_t l01 = {0.f, 0.f}, l23 = {0.f, 0.f};
#pragma unroll
                for (int kb = 0; kb < 2; ++kb)
#pragma unroll
                    for (int g = 0; g < 4; ++g) { l01 += (f32x2_t){sc[kb][4 * g], sc[kb][4 * g + 1]}; l23 += (f32x2_t){sc[kb][4 * g + 2], sc[kb][4 * g + 3]}; }
                lrun += (l01.x + l01.y) + (l23.x + l23.y);
                bf16x8_t pf[4];
#pragma unroll
                for (int ks = 0; ks < 4; ++ks) pf[ks] = pack_step(sc[ks >> 1], ks & 1);
                __builtin_amdgcn_sched_barrier(0);
#pragma unroll
                for (int ks = 0; ks < 4; ++ks) {
                    const bf16x8_t a0 = vf0, a1 = vf1;
                    if (ks < 3) { vf0 = vt_frag_sw(vt, ks + 1, 0, lane); vf1 = vt_frag_sw(vt, ks + 1, 1, lane); }
                    o[0] = MFMA32(a0, pf[ks], o[0]); o[1] = MFMA32(a1, pf[ks], o[1]);
                    __builtin_amdgcn_sched_barrier(0);
                }
            }
        }
        TE(11, lds, tid);
    }
    __builtin_amdgcn_s_setprio(0);
    TE(9, lds, tid);
    const float inv = 1.f / xsum32(lrun);
    bf16_t* mrow = p.mix() + (rowb + pos) * DM + 768 + hd * 64;
#pragma unroll
    for (int d = 0; d < 2; ++d) {
        unsigned pk00, pk01, pk10, pk11, pk20, pk21, pk30, pk31;
#pragma unroll
        for (int g = 0; g < 4; ++g) {
            const int d0 = 32 * d + 8 * g + 4 * hh;
            const unsigned long long zz = *(const GAS unsigned long long*)(uintptr_t)(yq + YD_Z + hd * 64 + d0);
            const float z0 = __uint_as_float((unsigned)(zz & 0xffffu) << 16), z1 = __uint_as_float((unsigned)((zz >> 16) & 0xffffu) << 16),
                        z2 = __uint_as_float((unsigned)((zz >> 32) & 0xffffu) << 16), z3 = __uint_as_float((unsigned)((zz >> 48) & 0xffffu) << 16);
            const unsigned pa = cvtpk(o[d][4 * g] * inv * z0, o[d][4 * g + 1] * inv * z1), pb = cvtpk(o[d][4 * g + 2] * inv * z2, o[d][4 * g + 3] * inv * z3);
            if (g == 0) { pk00 = pa; pk01 = pb; } else if (g == 1) { pk10 = pa; pk11 = pb; } else if (g == 2) { pk20 = pa; pk21 = pb; } else { pk30 = pa; pk31 = pb; }
        }
        store_pair16(mrow + 32 * d, 0, pk00, pk01, pk10, pk11, hh);
        store_pair16(mrow + 32 * d, 2, pk20, pk21, pk30, pk31, hh);
    }
}
__device__ __forceinline__ void ph_mixD(const Params& p, int l, LAS unsigned char* lds, int bid, int nb, int wave_s) {
    {
        float gq = 0.f, gk = 0.f;
        for (int i = 0; i < 64; ++i) { gq = fmaxf(gq, fabsf(p.sm(SM_DQG)[l * 64 + i])); gk = fmaxf(gk, fabsf(p.sm(SM_DKG)[l * 64 + i])); }
        if (tid_now(wave_s) == 0) *(volatile LAS float*)(lds + DB2_OFF) = 0.125f * 1.4426950408889634f * 64.f * gq * gk * 1.02f;
        __syncthreads();
    }
    for (int i = bid; i < 256; i += nb) {
        const int b = i & 15, cc = i >> 4;
#pragma unroll 1
        for (int k = 0; k < 2; ++k) mixD_unit(p, b, k == 0 ? 31 - cc : cc, lds, wave_s);
    }
}

constexpr int VN_STRIDE = 528;
__device__ __forceinline__ float bflo(unsigned u) { return __uint_as_float(u << 16); }
__device__ __forceinline__ float bfhi(unsigned u) { return __uint_as_float(u & 0xffff0000u); }
__device__ __forceinline__ void mixAB_unit(const Params& p, int l, int b, int n, LAS unsigned char* lds, int tid) {
    const int lane = tid & 63, wave = __builtin_amdgcn_readfirstlane(tid >> 6), r32 = lane & 31, hh = lane >> 5;
    const size_t row0 = (size_t)b * SEQ + 128 * n;
    __syncthreads();
#pragma unroll
    for (int k = 0; k < 8; ++k) {
        const int ch = tid + 512 * k, r = ch >> 5, c16 = ch & 31;
        *(LAS u32x4*)(lds + r * VN_STRIDE + c16 * 16) = *(const GAS u32x4*)(uintptr_t)(p.Y() + (row0 + r) * YP + YB_V + c16 * 8);
    }
    {
        const int cg8 = (tid & 31) * 8, t0 = (tid >> 5) * 8;
        const int pos0 = 128 * n + t0;
        const GAS float* cw = p.sm(SM_CONVW) + l * 768 + cg8;
        float w0[8], w1[8], w2[8], cb[8];
#pragma unroll
        for (int e = 0; e < 8; ++e) { w0[e] = cw[e]; w1[e] = cw[256 + e]; w2[e] = cw[512 + e]; cb[e] = p.sm(SM_CONVB)[l * 256 + cg8 + e]; }
        float um2[8], um1[8];
#pragma unroll
        for (int e = 0; e < 8; ++e) { um2[e] = 0.f; um1[e] = 0.f; }
#pragma unroll
        for (int back = 2; back >= 1; --back) {
            if (pos0 - back >= 0) {
                const bf16_t* yr = p.Y() + (row0 + t0 - back) * YP;
                const u32x4 hc = *(const GAS u32x4*)(uintptr_t)(yr + YA_H + cg8), cc = *(const GAS u32x4*)(uintptr_t)(yr + YA_C + cg8);
                float u[8] = {bflo(hc.x) * bflo(cc.x), bfhi(hc.x) * bfhi(cc.x), bflo(hc.y) * bflo(cc.y), bfhi(hc.y) * bfhi(cc.y),
                              bflo(hc.z) * bflo(cc.z), bfhi(hc.z) * bfhi(cc.z), bflo(hc.w) * bflo(cc.w), bfhi(hc.w) * bfhi(cc.w)};
#pragma unroll
                for (int e = 0; e < 8; ++e) { if (back == 2) um2[e] = u[e]; else um1[e] = u[e]; }
            }
        }
        u32x4 hcv[8], ccv[8], bgq[8], zgq[8];
#pragma unroll
        for (int tt = 0; tt < 8; ++tt) {
            const bf16_t* yr = p.Y() + (row0 + t0 + tt) * YP;
            hcv[tt] = *(const GAS u32x4*)(uintptr_t)(yr + YA_H + cg8); ccv[tt] = *(const GAS u32x4*)(uintptr_t)(yr + YA_C + cg8);
            bgq[tt] = *(const GAS u32x4*)(uintptr_t)(yr + YA_B + cg8); zgq[tt] = *(const GAS u32x4*)(uintptr_t)(yr + YA_Z + cg8);
        }
#pragma unroll
        for (int tt = 0; tt < 8; ++tt) {
            const u32x4 hc = hcv[tt], cc = ccv[tt], bg = bgq[tt], zg = zgq[tt];
            const float u[8] = {bflo(hc.x) * bflo(cc.x), bfhi(hc.x) * bfhi(cc.x), bflo(hc.y) * bflo(cc.y), bfhi(hc.y) * bfhi(cc.y),
                                bflo(hc.z) * bflo(cc.z), bfhi(hc.z) * bfhi(cc.z), bflo(hc.w) * bflo(cc.w), bfhi(hc.w) * bfhi(cc.w)};
            const float bgv[8] = {bflo(bg.x), bfhi(bg.x), bflo(bg.y), bfhi(bg.y), bflo(bg.z), bfhi(bg.z), bflo(bg.w), bfhi(bg.w)};
            const float zgv[8] = {bflo(zg.x), bfhi(zg.x), bflo(zg.y), bfhi(zg.y), bflo(zg.z), bfhi(zg.z), bflo(zg.w), bfhi(zg.w)};
            float ov[8];
#pragma unroll
            for (int e = 0; e < 8; ++e) {
                const float conv = w0[e] * um2[e] + w1[e] * um1[e] + w2[e] * u[e];
                ov[e] = bgv[e] * (conv + cb[e]) * zgv[e];
                um2[e] = um1[e]; um1[e] = u[e];
            }
            u32x4 ow; ow.x = cvtpk(ov[0], ov[1]); ow.y = cvtpk(ov[2], ov[3]); ow.z = cvtpk(ov[4], ov[5]); ow.w = cvtpk(ov[6], ov[7]);
            *(GAS u32x4*)(uintptr_t)(p.mix() + (row0 + t0 + tt) * DM + cg8) = ow;
        }
    }
    __syncthreads();
    {
        const int h = wave >> 1, th = wave & 1;
        const int nks = th == 0 ? 4 : 8;
        f32x16 acc[2][2];
#pragma unroll
        for (int a = 0; a < 2; ++a)
#pragma unroll
            for (int d = 0; d < 2; ++d)
#pragma unroll
                for (int i = 0; i < 16; ++i) acc[a][d][i] = 0.f;
        const bf16_t* wb = p.wsb() + ((size_t)(l * 4 + h) * 128 + 64 * th + r32) * 128 + 8 * hh;
        const int i16 = lane & 15, q = i16 >> 2, pp = i16 & 3, blk = (lane >> 4) & 1;
        const LAS unsigned char* va = lds + (8 * hh + q) * VN_STRIDE + (h * 64 + 16 * blk + 4 * pp) * 2;
        bf16x8_t bfr[8][2];
#pragma unroll
        for (int ks = 0; ks < 8; ++ks)
#pragma unroll
            for (int tb = 0; tb < 2; ++tb) bfr[ks][tb] = *(const GAS bf16x8_t*)(uintptr_t)(wb + (size_t)(32 * tb) * 128 + 16 * (ks < nks ? ks : 0));
        unsigned long long uu[2][2][4], zz[2][2][4]; float bias[2];
#pragma unroll
        for (int tb = 0; tb < 2; ++tb) {
            const int t = 64 * th + 32 * tb + r32;
            bias[tb] = p.sm(SM_GMLPB)[(l * 4 + h) * 128 + t];
            const bf16_t* yr = p.Y() + (row0 + t) * YP;
#pragma unroll
            for (int db = 0; db < 2; ++db)
#pragma unroll
                for (int g = 0; g < 4; ++g) {
                    const int d0 = 32 * db + 8 * g + 4 * hh;
                    uu[tb][db][g] = *(const GAS unsigned long long*)(uintptr_t)(yr + YB_U + h * 64 + d0); zz[tb][db][g] = *(const GAS unsigned long long*)(uintptr_t)(yr + YB_Z + h * 64 + d0);
                }
        }
#pragma unroll
        for (int ks = 0; ks < 8; ++ks) {
            if (ks < nks) {
                bf16x8_t afr[2];
#pragma unroll
                for (int db = 0; db < 2; ++db) {
                    const LAS unsigned char* a = va + (16 * ks) * VN_STRIDE + (32 * db) * 2;
                    const s16x4_t lo = ds_tr16(a), hi = ds_tr16(a + 4 * VN_STRIDE);
                    afr[db] = __builtin_shufflevector(lo, hi, 0, 1, 2, 3, 4, 5, 6, 7);
                }
#pragma unroll
                for (int tb = 0; tb < 2; ++tb)
#pragma unroll
                    for (int db = 0; db < 2; ++db) acc[tb][db] = MFMA32(afr[db], bfr[ks][tb], acc[tb][db]);
            }
        }
#pragma unroll
        for (int tb = 0; tb < 2; ++tb) {
            const int t = 64 * th + 32 * tb + r32;
            bf16_t* mr = p.mix() + (row0 + t) * DM + 256 + h * 64;
#pragma unroll
            for (int db = 0; db < 2; ++db)
#pragma unroll
                for (int g = 0; g < 4; ++g) {
                    const int d0 = 32 * db + 8 * g + 4 * hh;
                    const unsigned u01 = (unsigned)uu[tb][db][g], u23 = (unsigned)(uu[tb][db][g] >> 32), z01 = (unsigned)zz[tb][db][g], z23 = (unsigned)(zz[tb][db][g] >> 32);
                    const float v0 = bflo(u01) * (acc[tb][db][4 * g] + bias[tb]) * bflo(z01), v1 = bfhi(u01) * (acc[tb][db][4 * g + 1] + bias[tb]) * bfhi(z01);
                    const float v2 = bflo(u23) * (acc[tb][db][4 * g + 2] + bias[tb]) * bflo(z23), v3 = bfhi(u23) * (acc[tb][db][4 * g + 3] + bias[tb]) * bfhi(z23);
                    *(GAS unsigned long long*)(uintptr_t)(mr + d0) = (unsigned long long)cvtpk(v0, v1) | ((unsigned long long)cvtpk(v2, v3) << 32);
                }
        }
    }
}
__device__ __forceinline__ void ph_mixAB(const Params& p, int l, LAS unsigned char* lds, int bid, int nb, int tid_in) {
    int tid = tid_in; asm volatile("" : "+v"(tid));
    for (int i = bid; i < 256; i += nb) mixAB_unit(p, l, i >> 4, i & 15, lds, tid);
}

constexpr int IX_STRIDE = 528;
__device__ __forceinline__ void ph_ikiw(const Params& p, int l, LAS unsigned char* lds, int bid, int nb, int wave_s) {
    const int tid = tid_now(wave_s);
    const int lane = tid & 63, wave = __builtin_amdgcn_readfirstlane(tid >> 6), r32 = lane & 31, hh = lane >> 5;
    const int tb = wave & 3, cb = wave >> 2;
    LAS unsigned char* xs = lds;
    LAS unsigned char* ws = lds + 128 * IX_STRIDE;
    const bf16_t* wbase = p.wt_in() + (size_t)l * YP * DM;
    __syncthreads();
    { unsigned z = 0u; asm volatile("" : "+v"(z));
      for (int i = tid; i < 28 * (IX_STRIDE / 16); i += NT) *(LAS u32x4*)(ws + 36 * IX_STRIDE + i * 16) = (u32x4){z, z, z, z}; }
    for (int blk = bid; blk < NTOK / 128; blk += nb) {
        f32x16 acc;
#pragma unroll
        for (int i = 0; i < 16; ++i) acc[i] = 0.f;
        u32x4 xv[8], wv[3];
#define IX_LOAD(k0_) do { \
            _Pragma("unroll") for (int i = 0; i < 8; ++i) { const int idx = tid + NT * i; xv[i] = *(const GAS u32x4*)(uintptr_t)(p.xb() + (size_t)(128 * blk + (idx >> 5)) * DM + (k0_) + 8 * (idx & 31)); } \
            _Pragma("unroll") for (int i = 0; i < 3; ++i) { const int idx = tid + NT * i, n = idx >> 5; \
                if (idx < 36 * 32) wv[i] = *(const GAS u32x4*)(uintptr_t)(wbase + (size_t)(n < 32 ? 3584 + n : 3712 + (n - 32)) * DM + (k0_) + 8 * (idx & 31)); } } while (0)
        IX_LOAD(0);
#pragma unroll 1
        for (int k0 = 0; k0 < DM; k0 += 256) {
            __syncthreads();
#pragma unroll
            for (int i = 0; i < 8; ++i) { const int idx = tid + NT * i; *(LAS u32x4*)(xs + (idx >> 5) * IX_STRIDE + (idx & 31) * 16) = xv[i]; }
#pragma unroll
            for (int i = 0; i < 3; ++i) { const int idx = tid + NT * i; if (idx < 36 * 32) *(LAS u32x4*)(ws + (idx >> 5) * IX_STRIDE + (idx & 31) * 16) = wv[i]; }
            __syncthreads();
            if (k0 + 256 < DM) IX_LOAD(k0 + 256);
#pragma unroll
            for (int s = 0; s < 16; ++s) {
                const bf16x8_t a = *(const LAS bf16x8_t*)(ws + (32 * cb + r32) * IX_STRIDE + (16 * s + 8 * hh) * 2);
                const bf16x8_t b = *(const LAS bf16x8_t*)(xs + (32 * tb + r32) * IX_STRIDE + (16 * s + 8 * hh) * 2);
                acc = MFMA32(a, b, acc);
            }
        }
#undef IX_LOAD
        const int tok = 128 * blk + 32 * tb + r32;
        const GAS f32x4* sp = (const GAS f32x4*)(uintptr_t)(p.ssq() + (size_t)tok * 16);
        const f32x4 s0 = sp[0], s1 = sp[1], s2 = sp[2], s3 = sp[3];
        const float tot = ((s0.x + s0.y) + (s0.z + s0.w)) + ((s1.x + s1.y) + (s1.z + s1.w)) + ((s2.x + s2.y) + (s2.z + s2.w)) + ((s3.x + s3.y) + (s3.z + s3.w));
        const float rstd = rsqrtf(tot * (1.f / DM) + EPS);
        bf16_t* yr = p.Y() + (size_t)tok * YP + YI_K + 32 * cb;
#pragma unroll
        for (int g = 0; g < 4; ++g) {
            const int c0 = 8 * g + 4 * hh;
            if (32 * cb + c0 < 36)
                *(GAS unsigned long long*)(uintptr_t)(yr + c0) = (unsigned long long)cvtpk(acc[4 * g] * rstd, acc[4 * g + 1] * rstd) | ((unsigned long long)cvtpk(acc[4 * g + 2] * rstd, acc[4 * g + 3] * rstd) << 32);
        }
    }
    __syncthreads();
}

__global__ void __launch_bounds__(NT, 2) k_fwd(Params p) {
    extern __shared__ __attribute__((aligned(16))) unsigned char lds[];
    cg::grid_group grid = cg::this_grid();
    LAS unsigned char* l3 = (LAS unsigned char*)lds;
    const int wave_s = __builtin_amdgcn_readfirstlane((int)threadIdx.x >> 6);
    volatile LAS unsigned* bst = (volatile LAS unsigned*)(l3 + LDS_BYTES - 16);
    if (threadIdx.x < 2) bst[threadIdx.x] = 0u;
    __syncthreads();
    const XcdBarrier bar = xcd_barrier_post(p.ctl(), bst);
    if (TSEG >= 0 && threadIdx.x == 0) *(volatile LAS unsigned*)(l3 + TCTR_OFF) = 0u;
    { TB(16, l3, tid_now(wave_s)); ph_prologue(p, l3, tid_now(wave_s)); TE(16, l3, tid_now(wave_s)); }
    if (p.ws == nullptr) grid.sync();
    { TB(18, l3, tid_now(wave_s)); xcd_barrier(bar, tid_now(wave_s)); TE(18, l3, tid_now(wave_s)); }
#pragma unroll 1
    for (int l = 0; l < DEPTH; ++l) {
        Params q = p; asm volatile("" : "+s"(q.ws), "+s"(q.out));
        int bid = blockIdx.x, nb = gridDim.x; asm volatile("" : "+s"(bid), "+s"(nb));
        const bool ik_first = ((bid >> 3) & 1) != 0;
#pragma unroll 1
        for (int st = 0; st < 3; ++st) {
            if (st == 1) {
                pg8::Gemm g{q.xb(), q.wt_in() + (size_t)l * YP * DM, NTOK, NGEMM, DM};
                pg8::StaticOrder S; S.init(NTOK, NGEMM, nb, bid);
                EpiIn E{q.ws, l, (LAS float*)(l3 + 131072 + 1024)};
                { TB(13, l3, tid_now(wave_s)); pg8::gemm_phase<EpiIn, pg8::StaticOrder, true, true>(l3, g, S, E, tid_now(wave_s)); TE(13, l3, tid_now(wave_s)); }
            } else if ((st == 0) == ik_first) {
                __syncthreads();
                { TB(21, l3, tid_now(wave_s)); ph_ikiw(q, l, l3, bid, nb, wave_s); TE(21, l3, tid_now(wave_s)); }
                __syncthreads();
            }
        }
        { TB(18, l3, tid_now(wave_s)); xcd_barrier(bar, tid_now(wave_s)); TE(18, l3, tid_now(wave_s)); }
        asm volatile("" : "+s"(q.ws), "+s"(bid), "+s"(nb));
        { TB(17, l3, tid_now(wave_s)); ph_mixAB(q, l, l3, bid, nb, tid_now(wave_s)); TE(17, l3, tid_now(wave_s)); }
        __syncthreads();
        { TB(1, l3, tid_now(wave_s)); ph_mixC(q, l, l3, bid, nb, wave_s); TE(1, l3, tid_now(wave_s)); }
        __syncthreads();
        { TB(19, l3, tid_now(wave_s)); ph_mixD(q, l, l3, bid, nb, wave_s); TE(19, l3, tid_now(wave_s)); }
        __syncthreads();
        if (l + 1 < DEPTH) {
            const int nlight = nb >= 256 ? 64 : nb;
            if (bid < nlight) { const int t2 = tid_now(wave_s); convert_layer_weights(q, l + 1, l3, t2, bid * NW + (t2 >> 6), nlight * NW); }
            __syncthreads();
        }
        { TB(18, l3, tid_now(wave_s)); xcd_barrier(bar, tid_now(wave_s)); TE(18, l3, tid_now(wave_s)); }
        asm volatile("" : "+s"(q.ws), "+s"(q.out), "+s"(bid), "+s"(nb));
        {
            pg8::Gemm g{q.mix(), q.wt_out() + (size_t)l * DM * DM, NTOK, DM, DM};
            pg8::StaticOrder S; S.init(NTOK, DM, nb, bid);
            EpiOut E{l == DEPTH - 1 ? q.out : nullptr, q.ws};
            { TB(15, l3, tid_now(wave_s)); pg8::gemm_phase<EpiOut, pg8::StaticOrder, true, true>(l3, g, S, E, tid_now(wave_s)); TE(15, l3, tid_now(wave_s)); }
        }
        { TB(18, l3, tid_now(wave_s)); xcd_barrier(bar, tid_now(wave_s)); TE(18, l3, tid_now(wave_s)); }
    }
    if (TSEG >= 0 && blockIdx.x == 0 && threadIdx.x == 0) {
        const unsigned long long ticks = 8ull * *(volatile LAS unsigned*)(l3 + TCTR_OFF), t0 = __builtin_amdgcn_s_memrealtime();
        while (__builtin_amdgcn_s_memrealtime() - t0 < ticks) __builtin_amdgcn_s_sleep(32);
    }
}

extern "C" void kernel_launch(void* const* d_in, const int* in_sizes, int n_in, void* d_out, int out_size, void* d_ws, size_t ws_size,
                              hipStream_t stream) {
    static int grid_blocks = 0;
    if (!grid_blocks) {
        int dev = 0, cus = 0, per_cu = 0;
        (void)hipGetDevice(&dev);
        (void)hipDeviceGetAttribute(&cus, hipDeviceAttributeMultiprocessorCount, dev);
        (void)hipFuncSetAttribute((const void*)k_fwd, hipFuncAttributeMaxDynamicSharedMemorySize, LDS_BYTES);
        (void)hipOccupancyMaxActiveBlocksPerMultiprocessor(&per_cu, (const void*)k_fwd, NT, LDS_BYTES);
        if (per_cu < 1) { fprintf(stderr, "kernel_launch: occupancy query returned %d\n", per_cu); per_cu = 1; }
        if (per_cu > 1) per_cu = 1;
        grid_blocks = cus * per_cu;
        if (ws_size < WS_END) fprintf(stderr, "kernel_launch: workspace too small (%zu < %zu)\n", ws_size, (size_t)WS_END);
    }
    (void)hipMemsetAsync(d_ws, 0, 16384, stream);
    Params p{};
    p.x = (const float*)d_in[0]; p.norm_g = (const float*)d_in[1]; p.w_in = (const float*)d_in[2]; p.i_conv_w = (const float*)d_in[3];
    p.i_conv_b = (const float*)d_in[4]; p.i_gmlp_g = (const float*)d_in[5]; p.gmlp_ws = (const float*)d_in[6]; p.i_gmlp_b = (const float*)d_in[7];
    p.i_diff_qg = (const float*)d_in[8]; p.i_diff_kg = (const float*)d_in[9]; p.i_diff_lam = (const float*)d_in[10]; p.i_diff_subg = (const float*)d_in[11];
    p.i_dsa_qg = (const float*)d_in[12]; p.i_dsa_kg = (const float*)d_in[13]; p.w_out = (const float*)d_in[14];
    p.out = (float*)d_out; p.ws = (unsigned char*)d_ws;
    void* args[] = {&p};
    hipError_t e = hipLaunchCooperativeKernel((void*)k_fwd, dim3(grid_blocks), dim3(NT), args, LDS_BYTES, stream);
    if (e != hipSuccess) fprintf(stderr, "cooperative launch failed: %s (grid %d)\n", hipGetErrorString(e), grid_blocks);
}
```

```cpp
#include <hip/hip_runtime.h>
#include <hip/hip_cooperative_groups.h>
#include <math.h>
#include <stdint.h>
#include <stdio.h>
namespace cg = cooperative_groups;
namespace pg8 {
#define PG8_LAS __attribute__((address_space(3)))
typedef unsigned short bf16_t;
typedef short bf16x8 __attribute__((ext_vector_type(8)));
typedef float f32x4 __attribute__((ext_vector_type(4)));
typedef unsigned u32x4 __attribute__((ext_vector_type(4)));
constexpr int BM = 256, BK = 64, HALF = 128, HTB = HALF * BK * 2  , STAGE_BYTES = 8 * HTB, NXCD = 8, WGM = 8;

__host__ __device__ __forceinline__ int lds_byte(int r, int c) { const int st = (r >> 4) * 2 + (c >> 5), rr = r & 15, cc = c & 31, ob = rr * 64 + cc * 2; return st * 1024 + (ob ^ (((ob >> 9) & 1) << 5)); }
__host__ __device__ __forceinline__ void stage_rc(int b, int& R, int& C) { const int st = b / 1024, sb = b % 1024, swz = sb ^ (((sb >> 9) & 1) << 5); R = (st >> 1) * 16 + swz / 64; C = (st & 1) * 32 + (swz % 64) / 2; }
__host__ __device__ __forceinline__ int perm32(int rho) { const int n = rho >> 4, i = rho & 15; return 8 * (i >> 2) + 4 * n + (i & 3); }

struct Unit { int pm, pn; };
struct Gemm { const bf16_t* A; const bf16_t* Bt; int M, N, K; };

struct StaticOrder {
    int nM, nN, nwg, G, c;
    __host__ __device__ void init(int M, int N, int G_, int c_) { nM = M / BM; nN = N / BM; nwg = nM * nN; G = G_; c = c_; }
    __host__ __device__ bool next(int i, Unit& u) const {
        const long L = (long)i * G + c; if (L >= nwg) return false;
        int wgid = (int)L; { const int q = nwg / NXCD, r = nwg % NXCD, xcd = wgid % NXCD, off = wgid / NXCD; wgid = (xcd < r ? xcd * (q + 1) : r * (q + 1) + (xcd - r) * q) + off; }
        const int nig = WGM * nN, gid = wgid / nig, fm = gid * WGM, gsz = (nM - fm) < WGM ? (nM - fm) : WGM;
        u.pm = fm + ((wgid % nig) % gsz); u.pn = (wgid % nig) / gsz; return true;
    }
    __device__ __forceinline__ void a_ready(const Unit&) const {}
    __device__ __forceinline__ void done(const Unit&) const {}
};

__device__ __forceinline__ unsigned cvt_pk_bf16(float lo, float hi) { unsigned r; asm volatile("v_cvt_pk_bf16_f32 %0, %1, %2" : "=v"(r) : "v"(lo), "v"(hi)); return r; }
typedef float f32x2 __attribute__((ext_vector_type(2)));
__device__ __forceinline__ f32x2 gelu_pk(f32x2 v) {
    const f32x2 av = __builtin_elementwise_abs(v), d = av * 0.2316418882f + 1.0f;
    f32x2 t; t.x = __builtin_amdgcn_rcpf(d.x); t.y = __builtin_amdgcn_rcpf(d.y);
    f32x2 q = t * 0.5307027145f + (-0.7265760135f); q = q * t + 0.7107068705f; q = q * t + (-0.142248368f); q = q * t + 0.127414796f; q = q * t;
    const f32x2 s = (v * v) * (-0.72134752044f);
    f32x2 e; e.x = __builtin_amdgcn_exp2f(s.x); e.y = __builtin_amdgcn_exp2f(s.y);
    const f32x2 m = v * (q * e), r = v - m;
    f32x2 o; o.x = v.x < 0.f ? m.x : r.x; o.y = v.y < 0.f ? m.y : r.y; return o;
}
template <class Epi, class Sched, bool ALIGN_EPI = false, bool SP2 = false>
__device__ __forceinline__ void gemm_phase(PG8_LAS unsigned char* lds, const Gemm g, const Sched& S, const Epi& E, int tid_in) {
    int tid_ = tid_in; asm volatile("" : "+v"(tid_));
    const int tid = tid_, wid = __builtin_amdgcn_readfirstlane(tid >> 6), lane = tid & 63, wr = wid >> 2, wc = wid & 3, fr = lane & 15, fq = lane >> 4;
    const int K = g.K, nt = K / BK;
    unsigned voffA[2], voffB[2];
#pragma unroll
    for (int i = 0; i < 2; ++i) { int R, C; stage_rc(tid * 16 + i * 8192, R, C); const int Rb = Epi::PERM ? ((R & ~31) + perm32(R & 31)) : R;
        voffA[i] = (unsigned)(R * K + C) * 2u; voffB[i] = (unsigned)(Rb * K + C) * 2u; }
    const size_t kstep = (size_t)(BK * 2);
    const size_t hstep = (size_t)HALF * K * 2;
    const size_t tstep = 2 * hstep;
    const unsigned ldsw = (unsigned)wid * 1024u;
    const int aoff = lds_byte(wr * 64 + fr, fq * 8), boff = lds_byte(wc * 32 + fr, fq * 8);
#define PG8_SA(b, h) (((b) * 2 + (h)) * HTB)
#define PG8_SB(b, h) ((4 + (b) * 2 + (h)) * HTB)
#define PG8_STAGE(bufoff, gbase, voff) do { _Pragma("unroll") for (int _i = 0; _i < 2; ++_i) \
        __builtin_amdgcn_global_load_lds((const unsigned*)((const char*)(gbase) + (voff)[_i]), (PG8_LAS unsigned*)(lds + (bufoff) + ldsw + _i * 8192), 16, 0, 0); } while (0)
#define PG8_LDA(dst, b, h) do { _Pragma("unroll") for (int m = 0; m < 4; ++m) _Pragma("unroll") for (int k = 0; k < 2; ++k) dst[m][k] = *(const PG8_LAS bf16x8*)(lds + PG8_SA(b, h) + aoff + m * 2048 + k * 1024); } while (0)
#define PG8_LDB(dst, b, h) do { _Pragma("unroll") for (int n = 0; n < 2; ++n) _Pragma("unroll") for (int k = 0; k < 2; ++k) dst[n][k] = *(const PG8_LAS bf16x8*)(lds + PG8_SB(b, h) + boff + n * 2048 + k * 1024); } while (0)
#define PG8_MMA(ai, bj, At, Bt) do { __builtin_amdgcn_s_setprio(1); _Pragma("unroll") for (int m = 0; m < 4; ++m) _Pragma("unroll") for (int n = 0; n < 2; ++n) _Pragma("unroll") for (int k = 0; k < 2; ++k) \
        acc[ai][bj][m][n] = __builtin_amdgcn_mfma_f32_16x16x32_bf16(Bt[n][k], At[m][k], acc[ai][bj][m][n], 0, 0, 0); __builtin_amdgcn_s_setprio(0); } while (0)
#define PG8_WAIT_V(n) asm volatile("s_waitcnt vmcnt(" #n ")" ::: "memory")
#define PG8_WAIT_L(n) asm volatile("s_waitcnt lgkmcnt(" #n ")" ::: "memory")
#define PG8_BAR __builtin_amdgcn_s_barrier()
#define PG8_SCHED __builtin_amdgcn_sched_barrier(0)
    Unit cur, nxt; int ui = 0;
    if (!S.next(0, cur)) return;
    f32x4 acc[2][2][4][2];
#pragma unroll
    for (int a = 0; a < 2; ++a)
#pragma unroll
        for (int b = 0; b < 2; ++b)
#pragma unroll
            for (int m = 0; m < 4; ++m)
#pragma unroll
                for (int n = 0; n < 2; ++n) acc[a][b][m][n] = (f32x4){0.f, 0.f, 0.f, 0.f};
    bf16x8 At[4][2], B0[2][2], B1[2][2];
    const char* cA = (const char*)g.A + (size_t)cur.pm * tstep; const char* cB = (const char*)g.Bt + (size_t)cur.pn * tstep;
    S.a_ready(cur);
    if constexpr (SP2) {
        PG8_STAGE(PG8_SB(0, 0), cB, voffB); PG8_STAGE(PG8_SB(0, 1), cB + hstep, voffB); PG8_STAGE(PG8_SA(0, 0), cA, voffA); PG8_STAGE(PG8_SA(0, 1), cA + hstep, voffA);
        if (wr == 1) PG8_BAR;
        PG8_WAIT_V(2); PG8_BAR;
        PG8_STAGE(PG8_SB(1, 0), cB + kstep, voffB); PG8_STAGE(PG8_SA(1, 0), cA + kstep, voffA); PG8_STAGE(PG8_SB(1, 1), cB + hstep + kstep, voffB);
        PG8_WAIT_V(6); PG8_BAR;
    } else {
        PG8_STAGE(PG8_SB(0, 0), cB, voffB); PG8_STAGE(PG8_SA(0, 0), cA, voffA); PG8_STAGE(PG8_SB(0, 1), cB + hstep, voffB); PG8_STAGE(PG8_SA(0, 1), cA + hstep, voffA);
        if (wr == 1) PG8_BAR;
        PG8_WAIT_V(4); PG8_BAR;
        PG8_STAGE(PG8_SB(1, 0), cB + kstep, voffB); PG8_STAGE(PG8_SA(1, 0), cA + kstep, voffA); PG8_STAGE(PG8_SB(1, 1), cB + hstep + kstep, voffB);
        PG8_WAIT_V(6); PG8_BAR;
    }
    for (;;) {
        const bool has_next = S.next(ui + 1, nxt);
        const char* nA = has_next ? (const char*)g.A + (size_t)nxt.pm * tstep : cA; const char* nB = has_next ? (const char*)g.Bt + (size_t)nxt.pn * tstep : cB;
        for (int t = 0; t < nt; t += 2) {
            const bool last = (t == nt - 2);
            const char* a1 = cA + (size_t)(t + 1) * kstep;
            const char* a2 = last ? nA : cA + (size_t)(t + 2) * kstep; const char* b2 = last ? nB : cB + (size_t)(t + 2) * kstep;
            const char* a3 = a2 + kstep; const char* b3 = b2 + kstep;
            if (last && has_next) S.a_ready(nxt);
            if constexpr (SP2) {
            PG8_LDB(B0, 0, 0); PG8_LDB(B1, 0, 1); PG8_SCHED; PG8_LDA(At, 0, 0); PG8_STAGE(PG8_SA(1, 1), a1 + hstep, voffA);
            PG8_WAIT_V(8); PG8_WAIT_L(0); PG8_BAR; PG8_MMA(0, 0, At, B0); PG8_MMA(0, 1, At, B1); PG8_BAR; PG8_SCHED;
            PG8_LDA(At, 0, 1); PG8_STAGE(PG8_SB(0, 0), b2, voffB); PG8_STAGE(PG8_SB(0, 1), b2 + hstep, voffB); PG8_STAGE(PG8_SA(0, 0), a2, voffA);
            PG8_WAIT_V(8); PG8_WAIT_L(0); PG8_BAR; PG8_MMA(1, 0, At, B0); PG8_MMA(1, 1, At, B1); PG8_BAR; PG8_SCHED;
            PG8_LDB(B0, 1, 0); PG8_LDB(B1, 1, 1); PG8_SCHED; PG8_LDA(At, 1, 0); PG8_STAGE(PG8_SA(0, 1), a2 + hstep, voffA);
            PG8_WAIT_V(8); PG8_WAIT_L(0); PG8_BAR; PG8_MMA(0, 0, At, B0); PG8_MMA(0, 1, At, B1); PG8_BAR; PG8_SCHED;
            PG8_LDA(At, 1, 1); PG8_STAGE(PG8_SB(1, 0), b3, voffB); PG8_STAGE(PG8_SB(1, 1), b3 + hstep, voffB); PG8_STAGE(PG8_SA(1, 0), a3, voffA);
            PG8_WAIT_V(8); PG8_WAIT_L(0); PG8_BAR; PG8_MMA(1, 0, At, B0); PG8_MMA(1, 1, At, B1); PG8_BAR; PG8_SCHED;
            } else {
            PG8_LDB(B0, 0, 0); PG8_SCHED; PG8_LDA(At, 0, 0); PG8_STAGE(PG8_SA(1, 1), a1 + hstep, voffA);
            PG8_WAIT_L(8); PG8_BAR; PG8_WAIT_L(0); PG8_MMA(0, 0, At, B0); PG8_BAR; PG8_SCHED;
            PG8_LDB(B1, 0, 1); PG8_STAGE(PG8_SB(0, 0), b2, voffB);
            PG8_BAR; PG8_WAIT_L(0); PG8_MMA(0, 1, At, B1); PG8_BAR;
            PG8_LDA(At, 0, 1); PG8_STAGE(PG8_SA(0, 0), a2, voffA);
            PG8_BAR; PG8_WAIT_L(0); PG8_MMA(1, 0, At, B0); PG8_BAR; PG8_SCHED;
            PG8_STAGE(PG8_SB(0, 1), b2 + hstep, voffB);
            PG8_WAIT_V(6); PG8_BAR; PG8_MMA(1, 1, At, B1); PG8_BAR;
            PG8_LDB(B0, 1, 0); PG8_SCHED; PG8_LDA(At, 1, 0); PG8_STAGE(PG8_SA(0, 1), a2 + hstep, voffA);
            PG8_WAIT_L(8); PG8_BAR; PG8_WAIT_L(0); PG8_MMA(0, 0, At, B0); PG8_BAR; PG8_SCHED;
            PG8_LDB(B1, 1, 1); PG8_STAGE(PG8_SB(1, 0), b3, voffB);
            PG8_BAR; PG8_WAIT_L(0); PG8_MMA(0, 1, At, B1); PG8_BAR;
            PG8_LDA(At, 1, 1); PG8_STAGE(PG8_SA(1, 0), a3, voffA);
            PG8_BAR; PG8_WAIT_L(0); PG8_MMA(1, 0, At, B0); PG8_BAR; PG8_SCHED;
            PG8_STAGE(PG8_SB(1, 1), b3 + hstep, voffB);
            PG8_WAIT_V(6); PG8_BAR; PG8_MMA(1, 1, At, B1); PG8_BAR;
            }
        }
        if constexpr (ALIGN_EPI) { if (wr == 0) PG8_BAR; }
        if constexpr (!Epi::AFTER_DRAIN) { E(acc, cur, wr, wc, fr, fq); S.done(cur); }
        if (!has_next) break;
#pragma unroll
        for (int a = 0; a < 2; ++a)
#pragma unroll
            for (int b = 0; b < 2; ++b)
#pragma unroll
                for (int m = 0; m < 4; ++m)
#pragma unroll
                    for (int n = 0; n < 2; ++n) acc[a][b][m][n] = (f32x4){0.f, 0.f, 0.f, 0.f};
        cur = nxt; cA = nA; cB = nB; ++ui;
        if constexpr (ALIGN_EPI) { if (wr == 1) PG8_BAR; }
    }
    PG8_WAIT_V(0);
    if constexpr (!ALIGN_EPI) { if (wr == 0) PG8_BAR; }
    PG8_BAR;
    if constexpr (Epi::AFTER_DRAIN) { E.fused(acc, cur, wr, wc, fr, fq, lds, wid, lane); S.done(cur); }
#undef PG8_SA
#undef PG8_SB
#undef PG8_STAGE
#undef PG8_LDA
#undef PG8_LDB
#undef PG8_MMA
#undef PG8_WAIT_V
#undef PG8_WAIT_L
#undef PG8_BAR
#undef PG8_SCHED
}
}

using pg8::bf16_t; using pg8::f32x4; using pg8::u32x4; using pg8::Unit;
#define LAS __attribute__((address_space(3)))
#define GAS __attribute__((address_space(1)))

constexpr int DM = 1024, SEQ = 2048, BATCH = 16, DEPTH = 4, NIN = 3620, NTOK = BATCH * SEQ, YP = 3840;
constexpr float EPS = 1e-6f;
constexpr int O_DZ = 3200, O_DK = 3072, O_DV = 3136;
constexpr int YA_H = 0, YA_B = 256, YA_C = 512, YA_Z = 768, YB_U = 1024, YB_V = 1280, YB_Z = 1536, YC_Q = 1792, YC_K = 2048, YC_V = 2304,
              YC_Z = 2560, YD_Q = 2816, YD_Z = 3072, YD_K = 3328, YD_V = 3392, YI_Q = 3456, YI_K = 3584, YI_W = 3616;
constexpr int TOPK = 256;
constexpr int NGEMM = 3584;
constexpr int NT = 512, NW = 8;
constexpr int LDS_BYTES = 131072 + 4096 + 20480;

constexpr size_t MiB = 1u << 20;
constexpr size_t WS_WTIN = 1 * MiB;
constexpr size_t WS_WTOUT = WS_WTIN + (size_t)DEPTH * YP * DM * 2;
constexpr size_t WS_SSQ = WS_WTOUT + (size_t)DEPTH * DM * DM * 2;
constexpr size_t WS_XB = WS_SSQ + (size_t)NTOK * 16 * 4;
constexpr size_t WS_Y = WS_XB + (size_t)NTOK * DM * 2;
constexpr size_t WS_MIX = WS_Y + (size_t)NTOK * YP * 2;
constexpr size_t WS_WSB = WS_MIX + (size_t)NTOK * DM * 2;
constexpr size_t WS_END = WS_WSB + (size_t)DEPTH * 4 * 128 * 128 * 2;

constexpr size_t WS_SMALL = 65536;
constexpr int SM_CONVW = 0, SM_CONVB = 3072, SM_GMLPG = 4096, SM_GMLPB = 5120, SM_QG = 7168, SM_KG = 7296, SM_LAM = 7424, SM_SUBG = 7936, SM_DQG = 8960, SM_DKG = 9216, SM_END = 9472;
struct Params {
    const float* x; const float* norm_g; const float* w_in; const float* i_conv_w; const float* i_conv_b;
    const float* i_gmlp_g; const float* gmlp_ws; const float* i_gmlp_b; const float* i_diff_qg; const float* i_diff_kg;
    const float* i_diff_lam; const float* i_diff_subg; const float* i_dsa_qg; const float* i_dsa_kg; const float* w_out;
    float* out; unsigned char* ws;
    __device__ __forceinline__ unsigned* ctl() const { return (unsigned*)ws; }
    __device__ __forceinline__ const GAS float* sm(int off) const { return (const GAS float*)(uintptr_t)(ws + WS_SMALL) + off; }
    __device__ __forceinline__ bf16_t* wt_in() const { return (bf16_t*)(ws + WS_WTIN); }
    __device__ __forceinline__ bf16_t* wt_out() const { return (bf16_t*)(ws + WS_WTOUT); }
    __device__ __forceinline__ float* ssq() const { return (float*)(ws + WS_SSQ); }
    __device__ __forceinline__ bf16_t* xb() const { return (bf16_t*)(ws + WS_XB); }
    __device__ __forceinline__ bf16_t* Y() const { return (bf16_t*)(ws + WS_Y); }
    __device__ __forceinline__ bf16_t* mix() const { return (bf16_t*)(ws + WS_MIX); }
    __device__ __forceinline__ bf16_t* wsb() const { return (bf16_t*)(ws + WS_WSB); }
};

#ifndef TSEG
#define TSEG -1
#endif
constexpr int TCTR_OFF = 131072 + 3072;
#define TB(id, ldsbase, tidv) do { if (TSEG == (id) && blockIdx.x == 0 && (tidv) == 0) *(volatile LAS unsigned long long*)((ldsbase) + TCTR_OFF + 8) = __builtin_amdgcn_s_memrealtime(); } while (0)
#define TE(id, ldsbase, tidv) do { if (TSEG == (id) && blockIdx.x == 0 && (tidv) == 0) { const unsigned _d = (unsigned)(__builtin_amdgcn_s_memrealtime() - *(volatile LAS unsigned long long*)((ldsbase) + TCTR_OFF + 8)); *(volatile LAS unsigned*)((ldsbase) + TCTR_OFF) += _d; } } while (0)
__device__ __forceinline__ unsigned f2bf(float f) { unsigned u = __float_as_uint(f); return (u + 0x7fffu + ((u >> 16) & 1u)) >> 16; }
__device__ __forceinline__ unsigned pk2(float lo, float hi) { return f2bf(lo) | (f2bf(hi) << 16); }
__device__ __forceinline__ float bf2f(bf16_t b) { return __uint_as_float((unsigned)b << 16); }

__device__ __forceinline__ float xsum32(float v) { const auto r = __builtin_amdgcn_permlane32_swap(__float_as_uint(v), __float_as_uint(v), false, false); return __uint_as_float(r[0]) + __uint_as_float(r[1]); }
__device__ __forceinline__ float xmax32(float v) { const auto r = __builtin_amdgcn_permlane32_swap(__float_as_uint(v), __float_as_uint(v), false, false); return fmaxf(__uint_as_float(r[0]), __uint_as_float(r[1])); }
__device__ __forceinline__ int xsum32i(int v) { const auto r = __builtin_amdgcn_permlane32_swap((unsigned)v, (unsigned)v, false, false); return (int)(r[0] + r[1]); }
__device__ __forceinline__ float xsum16(float v) { const auto r = __builtin_amdgcn_permlane16_swap(__float_as_uint(v), __float_as_uint(v), false, false); return __uint_as_float(r[0]) + __uint_as_float(r[1]); }
__device__ __forceinline__ float wave_sum64(float v) {
    v += __uint_as_float(__builtin_amdgcn_update_dpp(0, __float_as_uint(v), 0x128, 0xf, 0xf, true));
    v += __uint_as_float(__builtin_amdgcn_update_dpp(0, __float_as_uint(v), 0x124, 0xf, 0xf, true));
    v += __uint_as_float(__builtin_amdgcn_update_dpp(0, __float_as_uint(v), 0x122, 0xf, 0xf, true));
    v += __uint_as_float(__builtin_amdgcn_update_dpp(0, __float_as_uint(v), 0x121, 0xf, 0xf, true));
    return xsum32(xsum16(v));
}
__device__ __forceinline__ float wave_sum(float v) {
#pragma unroll
    for (int o = 32; o > 0; o >>= 1) v += __shfl_xor(v, o);
    return v;
}
__device__ __forceinline__ float wave_max(float v) {
#pragma unroll
    for (int o = 32; o > 0; o >>= 1) v = fmaxf(v, __shfl_xor(v, o));
    return v;
}
__device__ __forceinline__ int wave_sumi(int v) {
#pragma unroll
    for (int o = 32; o > 0; o >>= 1) v += __shfl_xor(v, o);
    return v;
}
__device__ __forceinline__ float block_sum(float v, float* red) {
    v = wave_sum(v);
    __syncthreads();
    if ((threadIdx.x & 63) == 0) red[threadIdx.x >> 6] = v;
    __syncthreads();
    float s = 0.f;
#pragma unroll
    for (int i = 0; i < NW; ++i) s += red[i];
    return s;
}
__device__ __forceinline__ float block_max(float v, float* red) {
    v = wave_max(v);
    __syncthreads();
    if ((threadIdx.x & 63) == 0) red[threadIdx.x >> 6] = v;
    __syncthreads();
    float s = red[0];
#pragma unroll
    for (int i = 1; i < NW; ++i) s = fmaxf(s, red[i]);
    return s;
}
__device__ __forceinline__ int block_sumi(int v, int* red) {
    v = wave_sumi(v);
    __syncthreads();
    if ((threadIdx.x & 63) == 0) red[threadIdx.x >> 6] = v;
    __syncthreads();
    int s = 0;
#pragma unroll
    for (int i = 0; i < NW; ++i) s += red[i];
    return s;
}
__device__ __forceinline__ int block_excl_scan(int v, int* red, int* tot) {
    const int lane = threadIdx.x & 63, w = threadIdx.x >> 6;
    int inc = v;
#pragma unroll
    for (int o = 1; o < 64; o <<= 1) { int n = __shfl_up(inc, o); if (lane >= o) inc += n; }
    __syncthreads();
    if (lane == 63) red[w] = inc;
    __syncthreads();
    int base = 0, t = 0;
#pragma unroll
    for (int i = 0; i < NW; ++i) { if (i < w) base += red[i]; t += red[i]; }
    *tot = t;
    return base + inc - v;
}

__device__ __forceinline__ int phys2logical(int n) { const int p = n & 255; return (n & ~255) + 64 * ((p >> 5) & 3) + 32 * (p >> 7) + (p & 31); }
__device__ __forceinline__ int logical2orig(int n) {
    if (n < 3072) return n;
    if (n < YD_K) return n - YD_Z + O_DZ;
    if (n < YD_V) return n - YD_K + O_DK;
    if (n < YI_Q) return n - YD_V + O_DV;
    if (n < NIN) return n;
    return -1;
}
__device__ __forceinline__ void transpose_item(const float* W, int ldn, const float* gk, bf16_t* WT, int k0, int r0, int r1, int src, LAS float* scr, int lane) {
    float v[64];
#pragma unroll
    for (int i = 0; i < 64; ++i) v[i] = src >= 0 ? *(const GAS float*)(uintptr_t)(W + (size_t)(k0 + i) * ldn + src) : 0.f;
#pragma unroll
    for (int i = 0; i < 64; ++i) scr[i * 65 + lane] = gk ? v[i] * gk[k0 + i] : v[i];
    asm volatile("s_waitcnt lgkmcnt(0)" ::: "memory");
#pragma unroll
    for (int q = 0; q < 8; ++q) {
        const int id = lane + 64 * q, j = id >> 3, c = id & 7;
        const LAS float* s = scr + (8 * c) * 65 + j;
        u32x4 o; o.x = pk2(s[0 * 65], s[1 * 65]); o.y = pk2(s[2 * 65], s[3 * 65]); o.z = pk2(s[4 * 65], s[5 * 65]); o.w = pk2(s[6 * 65], s[7 * 65]);
        *(GAS u32x4*)(uintptr_t)(WT + (size_t)((j < 32 ? r0 : r1 - 32) + j) * DM + k0 + 8 * c) = o;
    }
    asm volatile("s_waitcnt lgkmcnt(0)" ::: "memory");
}
__device__ __forceinline__ int tid_now(int wave_s) { int lane; asm volatile("v_mbcnt_lo_u32_b32 %0, -1, 0\n\tv_mbcnt_hi_u32_b32 %0, -1, %0" : "=v"(lane)); return wave_s * 64 + lane; }
__device__ __forceinline__ void convert_layer_weights(const Params& p, int l, LAS unsigned char* lds, int tid, int gw, int ngw) {
    const int lane = tid & 63, wave = tid >> 6;
    LAS float* scr = (LAS float*)(lds + wave * 16640);
    constexpr int I_IN = 16 * (YP / 64), I_OUT = 16 * (DM / 64);
    for (int it = gw; it < I_IN + I_OUT; it += ngw) {
        if (it < I_IN) {
            const int kb = it / (YP / 64), g = it % (YP / 64), tile = g >> 2, wc = g & 3;
            const int src = logical2orig(256 * tile + 64 * wc + lane);
            transpose_item(p.w_in + (size_t)l * DM * NIN, NIN, p.norm_g + l * DM, p.wt_in() + (size_t)l * YP * DM, kb * 64, 256 * tile + 32 * wc, 256 * tile + 128 + 32 * wc, src, scr, lane);
        } else {
            const int q = it - I_IN, kb = q / (DM / 64), g = q % (DM / 64);
            transpose_item(p.w_out + (size_t)l * DM * DM, DM, nullptr, p.wt_out() + (size_t)l * DM * DM, kb * 64, 64 * g, 64 * g + 32, 64 * g + lane, scr, lane);
        }
    }
}
__device__ __forceinline__ void ph_prologue(const Params& p, LAS unsigned char* lds, int tid_in) {
    int tid = tid_in; asm volatile("" : "+v"(tid));
    const int lane = tid & 63, wave = tid >> 6;
    const int gw = blockIdx.x * NW + wave, ngw = gridDim.x * NW;
    TB(22, lds, tid);
    convert_layer_weights(p, 0, lds, tid, gw, ngw);
    {
        float* sm = (float*)(p.ws + WS_SMALL);
        for (int i = blockIdx.x * NT + tid; i < SM_END; i += gridDim.x * NT) {
            float v;
            if (i < SM_CONVB) v = p.i_conv_w[i - SM_CONVW]; else if (i < SM_GMLPG) v = p.i_conv_b[i - SM_CONVB]; else if (i < SM_GMLPB) v = p.i_gmlp_g[i - SM_GMLPG];
            else if (i < SM_QG) v = p.i_gmlp_b[i - SM_GMLPB]; else if (i < SM_KG) v = p.i_diff_qg[i - SM_QG]; else if (i < SM_LAM) v = p.i_diff_kg[i - SM_KG];
            else if (i < SM_SUBG) v = p.i_diff_lam[i - SM_LAM]; else if (i < SM_DQG) v = p.i_diff_subg[i - SM_SUBG]; else if (i < SM_DKG) v = p.i_dsa_qg[i - SM_DQG];
            else v = p.i_dsa_kg[i - SM_DKG];
            sm[i] = v;
        }
    }
    for (int i = (blockIdx.x * NT + tid) * 4; i < DEPTH * 4 * 128 * 128; i += gridDim.x * NT * 4) {
        const f32x4 v = *(const GAS f32x4*)(uintptr_t)(p.gmlp_ws + i);
        *(GAS unsigned long long*)(uintptr_t)(p.wsb() + i) = (unsigned long long)pk2(v.x, v.y) | ((unsigned long long)pk2(v.z, v.w) << 32);
    }
    TE(22, lds, tid);
    TB(23, lds, tid);
    for (int r0 = gw * 4; r0 < NTOK; r0 += ngw * 4) {
        f32x4 v[4][4];
#pragma unroll
        for (int rr = 0; rr < 4; ++rr)
#pragma unroll
            for (int j = 0; j < 4; ++j) v[rr][j] = ((const GAS f32x4*)(uintptr_t)(p.x + (size_t)(r0 + rr) * DM))[lane + 64 * j];
#pragma unroll
        for (int rr = 0; rr < 4; ++rr) {
            GAS unsigned long long* o8 = (GAS unsigned long long*)(uintptr_t)(p.xb() + (size_t)(r0 + rr) * DM) + lane;
            float s = 0.f;
#pragma unroll
            for (int j = 0; j < 4; ++j) {
                const f32x4 q = v[rr][j];
                s += (q.x * q.x + q.y * q.y) + (q.z * q.z + q.w * q.w);
                o8[64 * j] = (unsigned long long)pk2(q.x, q.y) | ((unsigned long long)pk2(q.z, q.w) << 32);
            }
            s = wave_sum64(s);
            if (lane < 16) ((GAS float*)(uintptr_t)p.ssq())[(size_t)(r0 + rr) * 16 + lane] = lane == 0 ? s : 0.f;
        }
    }
    TE(23, lds, tid);
}

__device__ __forceinline__ float silu_f(float v) { return v * __builtin_amdgcn_rcpf(1.f + __builtin_amdgcn_exp2f(-1.4426950408889634f * v)); }
struct EpiIn {
    static constexpr bool PERM = true, AFTER_DRAIN = false;
    unsigned char* ws; int l; LAS float* rs;
    __device__ __forceinline__ void operator()(const f32x4 (&acc)[2][2][4][2], const Unit& u, int wr, int wc, int fr_, int fq_) const {
        int fr = fr_, fq = fq_; asm volatile("" : "+v"(fr), "+v"(fq));
        const int pn = u.pn;
        bf16_t* Y = (bf16_t*)(ws + WS_Y); const float* ssq = (const float*)(ws + WS_SSQ); const float* smb = (const float*)(ws + WS_SMALL);
        const float* gmlp_g = smb + SM_GMLPG + l * 256; const float* qg = smb + SM_QG + l * 32; const float* kg = smb + SM_KG + l * 32;
        const float* dqg = smb + SM_DQG + l * 64; const float* dkg = smb + SM_DKG + l * 64;
        int op = 0; const float* g0 = nullptr; const float* g1 = nullptr; float qs = 1.f;
        if (pn == 3 || pn == 6 || pn == 10 || pn == 12) op = 1;
        else if (pn == 4) op = 2;
        else if (pn == 5) { op = 3; g0 = gmlp_g + 64 * wc + 8 * fq; g1 = g0 + 32; }
        else if (pn == 7) { op = 4; g0 = qg + 8 * fq; g1 = g0; qs = 0.17677669529663687f * 1.4426950408889634f; }
        else if (pn == 8) { op = 4; g0 = kg + 8 * fq; g1 = g0; }
        else if (pn == 11) { op = 5; g0 = dqg + 8 * fq; g1 = g0 + 32; qs = 0.125f * 1.4426950408889634f; }
        else if (pn == 13 && wc == 0) { op = 5; g0 = dkg + 8 * fq; g1 = g0 + 32; }
        float gn[16];
#pragma unroll
        for (int i = 0; i < 16; ++i) gn[i] = 1.f;
        if (op >= 3) {
            const f32x4 a = *(const GAS f32x4*)(uintptr_t)g0, b = *(const GAS f32x4*)(uintptr_t)(g0 + 4), c = *(const GAS f32x4*)(uintptr_t)g1, d = *(const GAS f32x4*)(uintptr_t)(g1 + 4);
            gn[0] = a.x; gn[1] = a.y; gn[2] = a.z; gn[3] = a.w; gn[4] = b.x; gn[5] = b.y; gn[6] = b.z; gn[7] = b.w;
            gn[8] = c.x; gn[9] = c.y; gn[10] = c.z; gn[11] = c.w; gn[12] = d.x; gn[13] = d.y; gn[14] = d.z; gn[15] = d.w;
        }
        const int colb = pn * 256 + 64 * wc + 8 * fq;
        TB(14, (LAS unsigned char*)rs - (131072 + 1024), wr * 256 + wc * 64 + fq * 16 + fr);
        {
            const int t = wr * 256 + wc * 64 + fq * 16 + fr;
            if (t < 256) {
                const f32x4* sp = (const f32x4*)(ssq + (size_t)(u.pm * 256 + t) * 16);
                const f32x4 s0 = sp[0], s1 = sp[1], s2 = sp[2], s3 = sp[3];
                const float tot = ((s0.x + s0.y) + (s0.z + s0.w)) + ((s1.x + s1.y) + (s1.z + s1.w)) + ((s2.x + s2.y) + (s2.z + s2.w)) + ((s3.x + s3.y) + (s3.z + s3.w));
                rs[t] = rsqrtf(tot * (1.f / DM) + EPS);
            }
            asm volatile("s_waitcnt vmcnt(0) lgkmcnt(0)" ::: "memory"); __builtin_amdgcn_s_barrier(); asm volatile("" ::: "memory");
        }
#pragma unroll
        for (int ai = 0; ai < 2; ++ai)
#pragma unroll
            for (int m = 0; m < 4; ++m) {
                const int row = u.pm * 256 + ai * 128 + wr * 64 + m * 16 + fr;
                const float rstd = rs[ai * 128 + wr * 64 + m * 16 + fr];
                float v[16];
#pragma unroll
                for (int bj = 0; bj < 2; ++bj)
#pragma unroll
                    for (int n = 0; n < 2; ++n)
#pragma unroll
                        for (int e = 0; e < 4; ++e) v[bj * 8 + n * 4 + e] = acc[ai][bj][m][n][e] * rstd;
                if (op == 1) {
#pragma unroll
                    for (int i = 0; i < 16; ++i) v[i] = silu_f(v[i]);
                } else if (op == 2 || op == 3) {
#pragma unroll
                    for (int i = 0; i < 16; i += 2) { const pg8::f32x2 r = pg8::gelu_pk((pg8::f32x2){v[i], v[i + 1]}); v[i] = r.x; v[i + 1] = r.y; }
                }
                if (op == 3 || op == 5) {
                    float ss = 0.f;
#pragma unroll
                    for (int i = 0; i < 16; ++i) ss += v[i] * v[i];
                    ss = xsum16(ss); ss = xsum32(ss);
                    const float sc = rsqrtf(ss * (1.f / 64) + EPS) * qs;
#pragma unroll
                    for (int i = 0; i < 16; ++i) v[i] *= sc * gn[i];
                } else if (op == 4) {
#pragma unroll
                    for (int bj = 0; bj < 2; ++bj) {
                        float ss = 0.f;
#pragma unroll
                        for (int i = 0; i < 8; ++i) ss += v[bj * 8 + i] * v[bj * 8 + i];
                        ss = xsum16(ss); ss = xsum32(ss);
                        const float sc = rsqrtf(ss * (1.f / 32) + EPS) * qs;
#pragma unroll
                        for (int i = 0; i < 8; ++i) v[bj * 8 + i] *= sc * gn[bj * 8 + i];
                    }
                }
                bf16_t* rowp = Y + (size_t)row * YP + colb;
#pragma unroll
                for (int bj = 0; bj < 2; ++bj) {
                    u32x4 w; w.x = pg8::cvt_pk_bf16(v[bj * 8 + 0], v[bj * 8 + 1]); w.y = pg8::cvt_pk_bf16(v[bj * 8 + 2], v[bj * 8 + 3]);
                    w.z = pg8::cvt_pk_bf16(v[bj * 8 + 4], v[bj * 8 + 5]); w.w = pg8::cvt_pk_bf16(v[bj * 8 + 6], v[bj * 8 + 7]);
                    *(GAS u32x4*)(uintptr_t)(rowp + 32 * bj) = w;
                }
            }
        TE(14, (LAS unsigned char*)rs - (131072 + 1024), wr * 256 + wc * 64 + fq * 16 + fr);
    }
};
struct EpiOut {
    static constexpr bool PERM = false, AFTER_DRAIN = false;
    float* xout; unsigned char* ws;
    __device__ __forceinline__ void operator()(const f32x4 (&acc)[2][2][4][2], const Unit& u, int wr, int wc, int fr_, int fq_) const {
        int fr = fr_, fq = fq_; asm volatile("" : "+v"(fr), "+v"(fq));
        const int col0 = u.pn * 256 + wc * 32 + 4 * fq;
        bf16_t* xb = (bf16_t*)(ws + WS_XB); float* ssq = (float*)(ws + WS_SSQ);
#pragma unroll
        for (int ai = 0; ai < 2; ++ai)
#pragma unroll
            for (int m = 0; m < 4; ++m) {
                const int row = u.pm * 256 + ai * 128 + wr * 64 + m * 16 + fr;
                float sq = 0.f;
#pragma unroll
                for (int bj = 0; bj < 2; ++bj)
#pragma unroll
                    for (int n = 0; n < 2; ++n) {
                        const size_t off = (size_t)row * DM + col0 + bj * 128 + n * 16;
                        const unsigned long long xo = *(const GAS unsigned long long*)(uintptr_t)(xb + off);
                        f32x4 v = acc[ai][bj][m][n];
                        v.x += __uint_as_float((unsigned)xo << 16); v.y += __uint_as_float((unsigned)xo & 0xffff0000u);
                        v.z += __uint_as_float((unsigned)(xo >> 32) << 16); v.w += __uint_as_float((unsigned)(xo >> 32) & 0xffff0000u);
                        sq += (v.x * v.x + v.y * v.y) + (v.z * v.z + v.w * v.w);
                        if (xout) *(GAS f32x4*)(uintptr_t)(xout + off) = v;
                        else *(GAS unsigned long long*)(uintptr_t)(xb + off) = (unsigned long long)pg8::cvt_pk_bf16(v.x, v.y) | ((unsigned long long)pg8::cvt_pk_bf16(v.z, v.w) << 32);
                    }
                sq = xsum16(sq); sq = xsum32(sq);
                if (fq == 0) ssq[(size_t)row * 16 + u.pn * 4 + wc] = sq;
                if (m == 3) asm volatile("" ::: "memory");
            }
    }
};
#define XB_TMO      128
#define XB_XCNT(j)  (256  + 64 * (j))
#define XB_XSUB(j)  (1280 + 64 * (j))
#define XB_XGEN(j)  (2304 + 64 * (j))
#define XB_TOP      3328
#define XB_TOPGEN   3392
#define XCD_BAR_WORDS 3456
#define XB_SPIN_CAP (1u << 18)

__device__ __forceinline__ unsigned xb_ld(unsigned* p)              { return __hip_atomic_load(p, __ATOMIC_RELAXED, __HIP_MEMORY_SCOPE_AGENT); }
__device__ __forceinline__ unsigned xb_add(unsigned* p, unsigned v) { return __hip_atomic_fetch_add(p, v, __ATOMIC_RELAXED, __HIP_MEMORY_SCOPE_AGENT); }
__device__ __forceinline__ unsigned xb_xcc_id() { return (unsigned)__builtin_amdgcn_s_getreg((3 << 11) | 20) & 0xFu; }
#define XB_SPIN(cond, bar) do { unsigned _sp = 0; while (cond) { __builtin_amdgcn_s_sleep(1); \
    if ((++_sp & 255u) == 0u) { if (xb_ld(&(bar)[XB_TMO])) break; if (_sp > XB_SPIN_CAP) { atomicAdd(&(bar)[XB_TMO], 1u); break; } } } } while (0)

struct XcdBarrier {
    unsigned* bar; unsigned x;
    volatile LAS unsigned* st;
};

__device__ __forceinline__ XcdBarrier xcd_barrier_post(unsigned* bar, volatile LAS unsigned* st) {
    XcdBarrier b; b.bar = bar; b.x = xb_xcc_id(); b.st = st;
    if (threadIdx.x == 0) (void)xb_add(&bar[XB_XCNT(b.x)], 1u);
    return b;
}
__device__ __forceinline__ void xcd_barrier_complete(unsigned* bar, unsigned x, unsigned& nloc, unsigned& nx) {
    const unsigned G = gridDim.x * gridDim.y * gridDim.z;
    unsigned sum, cnt, mine, sp = 0u;
    for (;;) {
        sum = 0u; cnt = 0u; mine = 0u;
#pragma unroll
        for (unsigned j = 0; j < 16; ++j) { const unsigned c = xb_ld(&bar[XB_XCNT(j)]); sum += c; cnt += (c > 0u) ? 1u : 0u; mine = (j == x) ? c : mine; }
        if (sum == G) break;
        __builtin_amdgcn_s_sleep(1);
        if ((++sp & 255u) == 0u) { if (xb_ld(&bar[XB_TMO])) break; if (sp > XB_SPIN_CAP) { atomicAdd(&bar[XB_TMO], 1u); break; } }
    }
    nloc = mine > 0u ? mine : 1u; nx = cnt > 0u ? cnt : 1u;
}

__device__ __forceinline__ void xcd_barrier(const XcdBarrier& b, int tid_in) {
    asm volatile("s_waitcnt vmcnt(0)" ::: "memory");
    __syncthreads();
    int t0_ = tid_in; asm volatile("" : "+v"(t0_));
    if (t0_ == 0) {
        unsigned* bar = b.bar; unsigned bx = b.x; asm volatile("" : "+s"(bar), "+s"(bx));
        __builtin_amdgcn_s_waitcnt(0);
        unsigned nloc = b.st[0], nx = b.st[1];
        if (nloc == 0u) { xcd_barrier_complete(bar, bx, nloc, nx); b.st[0] = nloc; b.st[1] = nx; }
        const unsigned old = xb_add(&bar[XB_XSUB(bx)], 1u);
        const unsigned gen = old / nloc;
        if (old + 1u == (gen + 1u) * nloc) {
            __builtin_amdgcn_fence(__ATOMIC_RELEASE, "agent");
            asm volatile("s_waitcnt vmcnt(0)" ::: "memory");
            const unsigned og = xb_add(&bar[XB_TOP], 1u);
            const unsigned tg = og / nx;
            if (og + 1u == (tg + 1u) * nx) xb_add(&bar[XB_TOPGEN], 1u);
            else XB_SPIN(xb_ld(&bar[XB_TOPGEN]) == tg, bar);
            __builtin_amdgcn_fence(__ATOMIC_ACQUIRE, "agent");
            xb_add(&bar[XB_XGEN(bx)], 1u);
            asm volatile("s_waitcnt vmcnt(0)" ::: "memory");
        } else {
            XB_SPIN(xb_ld(&bar[XB_XGEN(bx)]) == gen, bar);
            __builtin_amdgcn_fence(__ATOMIC_ACQUIRE, "agent");
            asm volatile("s_waitcnt vmcnt(0)" ::: "memory");
        }
    }
    __syncthreads();
}

typedef short bf16x8_t __attribute__((ext_vector_type(8)));
typedef short s16x4_t __attribute__((ext_vector_type(4)));
typedef float f32x16 __attribute__((ext_vector_type(16)));
typedef float f32x2_t __attribute__((ext_vector_type(2)));
typedef __bf16 bf16x2_t __attribute__((ext_vector_type(2)));
#define MFMA32(a, b, c) __builtin_amdgcn_mfma_f32_32x32x16_bf16((a), (b), (c), 0, 0, 0)
__device__ __forceinline__ unsigned cvtpk(float lo, float hi) { f32x2_t v = {lo, hi}; bf16x2_t b = __builtin_convertvector(v, bf16x2_t); return __builtin_bit_cast(unsigned, b); }
__device__ __forceinline__ s16x4_t ds_tr16(const LAS unsigned char* p) { return __builtin_bit_cast(s16x4_t, __builtin_amdgcn_ds_read_tr16_b64_v4i16((LAS s16x4_t*)p)); }
__device__ __forceinline__ bf16x8_t pack_step(const f32x16& x, int s) {
    u32x4 p; p.x = cvtpk(x[8 * s], x[8 * s + 1]); p.y = cvtpk(x[8 * s + 2], x[8 * s + 3]); p.z = cvtpk(x[8 * s + 4], x[8 * s + 5]); p.w = cvtpk(x[8 * s + 6], x[8 * s + 7]);
    return __builtin_bit_cast(bf16x8_t, p);
}
constexpr int KV_STRIDE = 144;
constexpr int KV_TILE = 64 * KV_STRIDE;
__device__ __forceinline__ bf16x8_t vt_frag(const LAS unsigned char* vtile, int ks, int db, int lane) {
    const int i16 = lane & 15, q = i16 >> 2, pp = i16 & 3, blk = (lane >> 4) & 1, hh = lane >> 5;
    const LAS unsigned char* a = vtile + (16 * ks + 4 * hh + q) * KV_STRIDE + (32 * db + 16 * blk + 4 * pp) * 2;
    const s16x4_t lo = ds_tr16(a), hi = ds_tr16(a + 8 * KV_STRIDE);
    return __builtin_shufflevector(lo, hi, 0, 1, 2, 3, 4, 5, 6, 7);
}

constexpr int KVL_TILE = 64 * 128;
__device__ __forceinline__ void dma_piece(const bf16_t* src_row0, LAS unsigned char* dst, int lane) {
    const bf16_t* g = src_row0 + (size_t)(lane >> 3) * YP + (((lane & 7) ^ (lane >> 3)) * 8);
    const unsigned d = (unsigned)__builtin_amdgcn_readfirstlane((int)(unsigned)(size_t)dst);
    unsigned keep;
    asm volatile("s_mov_b32 %0, m0\n\ts_mov_b32 m0, %2\n\ts_nop 0\n\tglobal_load_lds_dwordx4 %1, off\n\ts_mov_b32 m0, %0" : "=&s"(keep) : "v"(g), "s"(d) : "memory");
}
__device__ __forceinline__ bf16x8_t vt_frag_sw(const LAS unsigned char* vtile, int ks, int db, int lane) {
    const int i16 = lane & 15, q = i16 >> 2, pp = i16 & 3, blk = (lane >> 4) & 1, hh = lane >> 5;
    const int row = 16 * ks + 4 * hh + q, ch = 4 * db + 2 * blk + (pp >> 1);
    const LAS unsigned char* a = vtile + row * 128 + ((ch ^ (row & 7)) * 16) + (pp & 1) * 8;
    const s16x4_t lo = ds_tr16(a), hi = ds_tr16(a + 8 * 128);
    return __builtin_shufflevector(lo, hi, 0, 1, 2, 3, 4, 5, 6, 7);
}

__device__ __forceinline__ void store_pair16(bf16_t* rowp, int g0, unsigned a0, unsigned a1, unsigned b0, unsigned b1, int hh) {
    const unsigned s0 = hh ? a0 : b0, s1 = hh ? a1 : b1;
    const auto r0 = __builtin_amdgcn_permlane32_swap(s0, s0, false, false), r1 = __builtin_amdgcn_permlane32_swap(s1, s1, false, false);
    const unsigned q0 = hh ? r0[0] : r0[1], q1 = hh ? r1[0] : r1[1];
    u32x4 w;
    w.x = hh ? q0 : a0; w.y = hh ? q1 : a1; w.z = hh ? b0 : q0; w.w = hh ? b1 : q1;
    *(GAS u32x4*)(uintptr_t)(rowp + 8 * (g0 + (hh ? 1 : 0))) = w;
}

__device__ __forceinline__ void mixC_unit(const Params& p, int l, int b, int h, int qt, LAS unsigned char* lds, int wave_s) {
    const int tid = tid_now(wave_s);
    volatile LAS float* pc = (volatile LAS float*)(lds + 131072 + 2048);
    const float mfix = pc[0];
    const int lane = tid & 63, wave = __builtin_amdgcn_readfirstlane(tid >> 6), r32 = lane & 31, hh = lane >> 5;
    const size_t rowb = (size_t)b * SEQ;
    const int q0 = qt * 256 + wave * 32;
    const int cw = (q0 >> 6);
    const int jmax = 4 * qt + 3;
    const int pos = q0 + r32;
    const bf16_t* yq = p.Y() + (rowb + pos) * YP;
    bf16x8_t qf[2][2];
#pragma unroll
    for (int c = 0; c < 2; ++c)
#pragma unroll
        for (int s = 0; s < 2; ++s) qf[c][s] = *(const GAS bf16x8_t*)(uintptr_t)(yq + YC_Q + h * 64 + c * 32 + 16 * s + 8 * hh);
    const float sl2 = exp2f(-(float)(2 * h + 1)) * 1.4426950408889634f;
    f32x16 o[2][2];
#pragma unroll
    for (int c = 0; c < 2; ++c)
#pragma unroll
        for (int d = 0; d < 2; ++d)
#pragma unroll
            for (int i = 0; i < 16; ++i) o[c][d][i] = 0.f;
    f32x16 lacc;
#pragma unroll
    for (int i = 0; i < 16; ++i) lacc[i] = 0.f;
    bf16x8_t one0, one1;
    { const unsigned lo = r32 < 16 ? 0x3f803f80u : 0u, hi = r32 < 16 ? 0u : 0x3f803f80u;
      one0 = __builtin_bit_cast(bf16x8_t, (u32x4){lo, lo, lo, lo}); one1 = __builtin_bit_cast(bf16x8_t, (u32x4){hi, hi, hi, hi}); }
    bf16x8_t kext;
    {
        const float t = sl2 * (float)r32;
        const unsigned u = cvtpk(t, 0.f), v = cvtpk(t - __uint_as_float(u << 16), 0.f);
        u32x4 w; w.x = hh ? 0u : (u | (v << 16)); w.y = hh ? 0u : 0x3f803f80u; w.z = hh ? 0u : 0x00003f80u; w.w = 0u;
        kext = __builtin_bit_cast(bf16x8_t, w);
    }
    const bf16_t* ksrc = p.Y() + (rowb + 8 * wave) * YP + YC_K + h * 64;
    const bf16_t* vsrc = p.Y() + (rowb + 8 * wave) * YP + YC_V + h * 64;
    LAS unsigned char* kring = lds;
    LAS unsigned char* vring = lds + 6 * KVL_TILE;
    asm volatile("" : "+v"(qf[0][0]), "+v"(qf[0][1]), "+v"(qf[1][0]), "+v"(qf[1][1]));
    LAS unsigned char* qpark = lds + 12 * KVL_TILE + wave * 4096 + lane * 16;
    const float mfix_r = mfix; asm volatile("" :: "v"(mfix_r));
    asm volatile("s_waitcnt lgkmcnt(0)" ::: "memory"); __builtin_amdgcn_s_barrier(); asm volatile("" ::: "memory");
#pragma unroll
    for (int t = 0; t < 4; ++t) { dma_piece(ksrc + (size_t)t * 64 * YP, kring + t * KVL_TILE + wave * 1024, lane); dma_piece(vsrc + (size_t)t * 64 * YP, vring + t * KVL_TILE + wave * 1024, lane); }
#pragma unroll
    for (int f = 0; f < 4; ++f) *(LAS bf16x8_t*)(qpark + f * 1024) = qf[f >> 1][f & 1];
    int slot = 0, slot2 = 4;
    if (wave >= 4) __builtin_amdgcn_s_setprio(1);
    for (int j = 0; j <= jmax; ++j) {
        if ((j & 1) == 0) {
            TB(3, lds, tid);
            if (j + 2 <= jmax) asm volatile("s_waitcnt vmcnt(4)" ::: "memory"); else asm volatile("s_waitcnt vmcnt(0)" ::: "memory");
            __builtin_amdgcn_s_barrier(); asm volatile("" ::: "memory");
            if (j + 4 <= jmax) {
#pragma unroll
                for (int t = 0; t < 2; ++t) {
                    const int sl = slot2 + t >= 6 ? slot2 + t - 6 : slot2 + t;
                    dma_piece(ksrc + (size_t)(j + 4 + t) * 64 * YP, kring + sl * KVL_TILE + wave * 1024, lane); dma_piece(vsrc + (size_t)(j + 4 + t) * 64 * YP, vring + sl * KVL_TILE + wave * 1024, lane);
                }
            }
            TE(3, lds, tid);
        }
        TB(2, lds, tid);
        if (j <= cw) {
            const LAS unsigned char* kt = kring + slot * KVL_TILE;
            const LAS unsigned char* vt = vring + slot * KVL_TILE;
            const bool diag = (j == cw);
            bf16x8_t qext[2];
#pragma unroll
            for (int kb = 0; kb < 2; ++kb) {
                const float cj = fmaf(sl2, (float)(64 * j + 32 * kb - pos), -mfix);
                const unsigned u = cvtpk(cj, 0.f); const float r1 = cj - __uint_as_float(u << 16);
                const unsigned v = cvtpk(r1, 0.f), x = cvtpk(r1 - __uint_as_float(v << 16), 0.f);
                const bool off = hh != 0 || diag;
                u32x4 w; w.x = off ? 0u : 0x3f803f80u; w.y = off ? 0u : (u | (v << 16)); w.z = off ? 0u : x; w.w = 0u;
                qext[kb] = __builtin_bit_cast(bf16x8_t, w);
            }
            unsigned ka = (unsigned)(size_t)kt + (unsigned)(r32 * 128 + ((hh ^ (r32 & 7)) * 16)); asm volatile("" : "+v"(ka));
            f32x16 sc[2][2];
            {
                bf16x8_t kfa[2][2], kfb[2][2], qa[2], qb[2];
#pragma unroll
                for (int s = 0; s < 2; ++s) qa[s] = *(const LAS bf16x8_t*)(qpark + s * 1024);
#pragma unroll
                for (int kb = 0; kb < 2; ++kb)
#pragma unroll
                    for (int s = 0; s < 2; ++s) kfa[kb][s] = *(const LAS bf16x8_t*)(size_t)((ka ^ (unsigned)(32 * s)) + 4096u * kb);
                __builtin_amdgcn_sched_barrier(0);
#pragma unroll
                for (int kb = 0; kb < 2; ++kb)
#pragma unroll
                    for (int s = 0; s < 2; ++s) kfb[kb][s] = *(const LAS bf16x8_t*)(size_t)((ka ^ (unsigned)(64 + 32 * s)) + 4096u * kb);
#pragma unroll
                for (int s = 0; s < 2; ++s) qb[s] = *(const LAS bf16x8_t*)(qpark + (2 + s) * 1024);
#pragma unroll
                for (int c = 0; c < 2; ++c)
#pragma unroll
                    for (int kb = 0; kb < 2; ++kb) {
                        f32x16 z;
#pragma unroll
                        for (int i = 0; i < 16; ++i) z[i] = 0.f;
                        sc[c][kb] = MFMA32(kext, qext[kb], z);
                    }
#pragma unroll
                for (int s = 0; s < 2; ++s)
#pragma unroll
                    for (int kb = 0; kb < 2; ++kb) sc[0][kb] = MFMA32(kfa[kb][s], qa[s], sc[0][kb]);
                __builtin_amdgcn_sched_barrier(0);
#pragma unroll
                for (int s = 0; s < 2; ++s)
#pragma unroll
                    for (int kb = 0; kb < 2; ++kb) sc[1][kb] = MFMA32(kfb[kb][s], qb[s], sc[1][kb]);
            }
            __builtin_amdgcn_sched_barrier(0);
            bf16x8_t pf[2][4];
#pragma unroll
            for (int c = 0; c < 2; ++c) {
                if (!diag) {
#pragma unroll
                    for (int kb = 0; kb < 2; ++kb)
#pragma unroll
                        for (int i = 0; i < 16; ++i) sc[c][kb][i] = __builtin_amdgcn_exp2f(sc[c][kb][i]);
                } else {
                    const float pl = (float)(pos - 64 * j - 4 * hh);
#pragma unroll
                    for (int kb = 0; kb < 2; ++kb)
#pragma unroll
                        for (int i = 0; i < 16; ++i) {
                            const float kc = (float)(32 * kb + (i & 3) + 8 * (i >> 2));
                            sc[c][kb][i] = __builtin_amdgcn_exp2f(sc[c][kb][i] + fmaf(-sl2, fabsf(pl - kc), -mfix));
                        }
                }
#pragma unroll
                for (int ks = 0; ks < 4; ++ks) pf[c][ks] = pack_step(sc[c][ks >> 1], ks & 1);
            }
            __builtin_amdgcn_sched_barrier(0);
#pragma unroll
            for (int ks = 0; ks < 4; ++ks) {
                const bf16x8_t a0 = vt_frag_sw(vt, ks, 0, lane), a1 = vt_frag_sw(vt, ks, 1, lane);
                o[0][0] = MFMA32(a0, pf[0][ks], o[0][0]); o[1][0] = MFMA32(a0, pf[1][ks], o[1][0]);
                o[0][1] = MFMA32(a1, pf[0][ks], o[0][1]); o[1][1] = MFMA32(a1, pf[1][ks], o[1][1]);
                lacc = MFMA32(one0, pf[0][ks], lacc); lacc = MFMA32(one1, pf[1][ks], lacc);
                __builtin_amdgcn_sched_barrier(0);
            }
        }
        TE(2, lds, tid);
        slot = slot == 5 ? 0 : slot + 1; slot2 = slot2 == 5 ? 0 : slot2 + 1;
    }
    __builtin_amdgcn_s_setprio(0);
    const float lam = pc[1], oml = pc[2];
    const int tid2 = tid_now(wave_s), lane2 = tid2 & 63, r32e = lane2 & 31, hhe = lane2 >> 5;
    const int pose = qt * 256 + wave * 32 + r32e;
    const bf16_t* yqe = p.Y() + (rowb + pose) * YP;
    const float l1 = lacc[0], l2 = lacc[8];
    const float i1 = 1.f / l1, i2 = lam / l2;
    float ss = 0.f;
#pragma unroll
    for (int d = 0; d < 2; ++d)
#pragma unroll
        for (int i = 0; i < 16; ++i) { const float v = o[0][d][i] * i1 - o[1][d][i] * i2; o[0][d][i] = v; ss += v * v; }
    ss = xsum32(ss);
    const float rn = rsqrtf(ss * (1.f / 64) + EPS) * oml;
    const GAS float* sg = p.sm(SM_SUBG) + l * 256 + h * 64;
    bf16_t* mrow = p.mix() + (rowb + pose) * DM + 512 + h * 64;
#pragma unroll
    for (int d = 0; d < 2; ++d) {
        unsigned pk00, pk01, pk10, pk11, pk20, pk21, pk30, pk31;
#pragma unroll
        for (int g = 0; g < 4; ++g) {
            const int d0 = 32 * d + 8 * g + 4 * hhe;
            const f32x4 gv = *(const GAS f32x4*)(uintptr_t)(sg + d0);
            const unsigned long long zz = *(const GAS unsigned long long*)(uintptr_t)(yqe + YC_Z + h * 64 + d0);
            const float z0 = __uint_as_float((unsigned)(zz & 0xffffu) << 16), z1 = __uint_as_float((unsigned)((zz >> 16) & 0xffffu) << 16),
                        z2 = __uint_as_float((unsigned)((zz >> 32) & 0xffffu) << 16), z3 = __uint_as_float((unsigned)((zz >> 48) & 0xffffu) << 16);
            const float v0 = o[0][d][4 * g] * rn * gv.x * z0, v1 = o[0][d][4 * g + 1] * rn * gv.y * z1, v2 = o[0][d][4 * g + 2] * rn * gv.z * z2, v3 = o[0][d][4 * g + 3] * rn * gv.w * z3;
            const unsigned pa = cvtpk(v0, v1), pb = cvtpk(v2, v3);
            if (g == 0) { pk00 = pa; pk01 = pb; } else if (g == 1) { pk10 = pa; pk11 = pb; } else if (g == 2) { pk20 = pa; pk21 = pb; } else { pk30 = pa; pk31 = pb; }
        }
        store_pair16(mrow + 32 * d, 0, pk00, pk01, pk10, pk11, hhe);
        store_pair16(mrow + 32 * d, 2, pk20, pk21, pk30, pk31, hhe);
    }
}
__device__ __forceinline__ void ph_mixC(const Params& p, int l, LAS unsigned char* lds, int bid, int nb, int wave_s) {
    {
        const float lam_init = l == 0 ? 0.200000001f : l == 1 ? 0.355509068f : l == 2 ? 0.470713018f : 0.556058204f;
        const GAS float* lp = p.sm(SM_LAM) + l * 128;
        float d1 = 0.f, d2 = 0.f;
        for (int i = 0; i < 32; ++i) { d1 += lp[i] * lp[32 + i]; d2 += lp[64 + i] * lp[96 + i]; }
        float gq = 0.f, gk = 0.f;
        for (int i = 0; i < 32; ++i) { gq = fmaxf(gq, fabsf(p.sm(SM_QG)[l * 32 + i])); gk = fmaxf(gk, fabsf(p.sm(SM_KG)[l * 32 + i])); }
        volatile LAS float* pc = (volatile LAS float*)(lds + 131072 + 2048);
        if (tid_now(wave_s) == 0) {
            pc[0] = 0.17677669529663687f * 1.4426950408889634f * 32.f * gq * gk * 1.02f;
            pc[1] = expf(d1) - expf(d2) + lam_init;
            pc[2] = 1.f - lam_init;
        }
        __syncthreads();
    }
    for (int i = bid; i < 256; i += nb) {
#pragma unroll 1
        for (int k = 0; k < 2; ++k) {
            const int id = k == 0 ? i : 511 - i;
            const int qt = id < 256 ? 7 - (id >> 6) : 3 - ((id - 256) >> 6), bh = id & 63;
            mixC_unit(p, l, bh >> 2, bh & 3, qt, lds, wave_s);
        }
    }
}

constexpr int SC_STRIDE = 2052;
constexpr int SC_BYTES = 16 * SC_STRIDE * 4;
constexpr int IK_STRIDE = 80, IK_TILE = 64 * IK_STRIDE;
constexpr int MSK_QSTRIDE = 520;
constexpr int DMN_OFF = 131072 + 1024, DB2_OFF = 131072 + 2048 + 16;
constexpr int MSK_OFF0 = 131072 + 4096, MSK_OFF1 = 65536;
__device__ __forceinline__ unsigned fkey(float f) { const unsigned u = __float_as_uint(f); return u ^ ((unsigned)((int)u >> 31) | 0x80000000u); }
__device__ __forceinline__ float unfkey(unsigned k) { return __uint_as_float((k & 0x80000000u) ? (k & 0x7fffffffu) : ~k); }
__device__ __forceinline__ f32x16 idx_scores(const bf16x8_t ik0, const bf16x8_t ik1, const bf16x8_t (&iqf)[4][2], const float (&w)[4]) {
    f32x16 sc;
#pragma unroll
    for (int i = 0; i < 16; ++i) sc[i] = 0.f;
#pragma unroll
    for (int hd = 0; hd < 4; ++hd) {
        f32x16 a;
#pragma unroll
        for (int i = 0; i < 16; ++i) a[i] = 0.f;
        a = MFMA32(ik0, iqf[hd][0], a);
        a = MFMA32(ik1, iqf[hd][1], a);
#pragma unroll
        for (int i = 0; i < 16; ++i) sc[i] = fmaf(w[hd], __builtin_amdgcn_fmed3f(a[i], 0.f, 3.0e38f), sc[i]);
    }
#pragma unroll
    for (int i = 0; i < 16; ++i) sc[i] = sc[i] + 0.f;
    return sc;
}
__device__ __forceinline__ void transpose32(unsigned (&a)[32]) {
#pragma unroll
    for (int k = 0; k < 16; ++k) {
        const unsigned x = a[k], y = a[k + 16];
        a[k] = __builtin_amdgcn_perm(x, y, 0x07060302u); a[k + 16] = __builtin_amdgcn_perm(x, y, 0x05040100u);
        asm volatile("" : "+v"(a[k]), "+v"(a[k + 16]));
    }
#pragma unroll
    for (int k = 0; k < 32; ++k)
        if ((k & 8) == 0) {
            const unsigned x = a[k], y = a[k + 8];
            a[k] = __builtin_amdgcn_perm(x, y, 0x07030501u); a[k + 8] = __builtin_amdgcn_perm(x, y, 0x06020400u);
            asm volatile("" : "+v"(a[k]), "+v"(a[k + 8]));
        }
#pragma unroll
    for (int s = 2; s < 5; ++s) {
        const int j = 16 >> s;
        const unsigned mk = j == 4 ? 0x0f0f0f0fu : j == 2 ? 0x33333333u : 0x55555555u;
#pragma unroll
        for (int k = 0; k < 32; ++k)
            if ((k & j) == 0) { const unsigned t = (a[k] ^ (a[k + j] >> j)) & mk; a[k] ^= t; a[k + j] ^= t << j; asm volatile("" : "+v"(a[k]), "+v"(a[k + j])); }
    }
}
__device__ __forceinline__ int rowsum16(int v) {
    v += __builtin_amdgcn_update_dpp(0, v, 0x128, 0xf, 0xf, true);
    v += __builtin_amdgcn_update_dpp(0, v, 0x124, 0xf, 0xf, true);
    v += __builtin_amdgcn_update_dpp(0, v, 0x122, 0xf, 0xf, true);
    v += __builtin_amdgcn_update_dpp(0, v, 0x121, 0xf, 0xf, true);
    return v;
}
__device__ __forceinline__ unsigned topbits(int ne) { return ne <= 0 ? 0u : ne >= 32 ? 0xffffffffu : (0xffffffffu << (32 - ne)); }
template <int NG, int ST>
__device__ __forceinline__ void rs4_row(const unsigned (&pl)[NG][32], unsigned (&alive)[NG], unsigned (&gt)[NG], int& above, unsigned& prefix, bool& done, bool& alld) {
    if (!alld) {
        int c11 = 0, c10 = 0, c01 = 0;
#pragma unroll
        for (int j = 0; j < NG; ++j) {
            const unsigned p1 = pl[j][2 * ST], p0 = pl[j][2 * ST + 1], a1 = alive[j] & p1, a0 = alive[j] & ~p1;
            c11 += __popc(a1 & p0); c10 += __popc(a1 & ~p0); c01 += __popc(a0 & p0);
        }
        const int s01 = rowsum16(c11 | (c10 << 16)), s2 = rowsum16(c01);
        if (!done) {
            const int t11 = above + (s01 & 0xffff), t10 = t11 + (int)((unsigned)s01 >> 16), t01 = t10 + s2;
            const int dg = t11 >= TOPK ? 3 : t10 >= TOPK ? 2 : t01 >= TOPK ? 1 : 0;
            const int tsel = dg == 3 ? t11 : dg == 2 ? t10 : t01;
            prefix |= (unsigned)dg << (30 - 2 * ST);
            above = dg == 3 ? above : dg == 2 ? t11 : dg == 1 ? t10 : t01;
            const unsigned m1 = (dg & 2) ? 0xffffffffu : 0u, m0 = (dg & 1) ? 0xffffffffu : 0u;
#pragma unroll
            for (int j = 0; j < NG; ++j) {
                const unsigned p1 = pl[j][2 * ST], p0 = pl[j][2 * ST + 1], x1 = p1 ^ m1, x0 = p0 ^ m0;
                gt[j] |= alive[j] & ((x1 & p1) | (~x1 & x0 & p0));
                alive[j] &= ~(x1 | x0);
            }
            if (dg != 0 && tsel == TOPK) done = true;
        }
        alld = __all(done);
    }
    if constexpr (ST < 15) rs4_row<NG, ST + 1>(pl, alive, gt, above, prefix, done, alld);
}
template <int NG>
__device__ __forceinline__ void d1_pass(const Params& p, size_t rowb, int c, int sp, LAS unsigned char* lds, int wave_s) {
    const int tid = tid_now(wave_s);
    const int lane = tid & 63, wave = __builtin_amdgcn_readfirstlane(tid >> 6), r32 = lane & 31, hh = lane >> 5;
    const int q0 = c * 64, ntile = c + 1;
    constexpr int SKS = 1028;
    constexpr int NRD = (NG + 1) / 2;
    LAS unsigned* sk = (LAS unsigned*)lds;
    const int nblk = 2 * ntile;
    const int nbw = (nblk - wave + 7) >> 3;
    const int nv = 4 * ntile;
    TB(4, lds, tid); TB(5, lds, tid);
    unsigned kr[NG][32];
    unsigned zopq = 0u; asm volatile("" : "+v"(zopq));
    {
        const bf16_t* yq1 = p.Y() + (rowb + q0 + 32 * sp + r32) * YP;
        bf16x8_t iqf[4][2];
#pragma unroll
        for (int hd = 0; hd < 4; ++hd)
#pragma unroll
            for (int s = 0; s < 2; ++s) iqf[hd][s] = *(const GAS bf16x8_t*)(uintptr_t)(yq1 + YI_Q + hd * 32 + 16 * s + 8 * hh);
        float w[4];
        const unsigned long long ww = *(const GAS unsigned long long*)(uintptr_t)(yq1 + YI_W);
#pragma unroll
        for (int hd = 0; hd < 4; ++hd) w[hd] = __uint_as_float((unsigned)((ww >> (16 * hd)) & 0xffffu) << 16) * (0.17677669529663687f * 0.5f);
        bf16x8_t ik[2 * NG][2];
#pragma unroll
        for (int i = 0; i < 2 * NG; ++i) {
            const int kb = i < nbw ? wave + 8 * i : wave;
            const bf16_t* yk = p.Y() + (rowb + 32 * kb + r32) * YP + YI_K + 8 * hh;
            ik[i][0] = *(const GAS bf16x8_t*)(uintptr_t)yk; ik[i][1] = *(const GAS bf16x8_t*)(uintptr_t)(yk + 16);
        }
#pragma unroll
        for (int blk = 0; blk < 2 * NG; ++blk) {
            if (blk < nbw) {
                const f32x16 sc = idx_scores(ik[blk][0], ik[blk][1], iqf, w);
#pragma unroll
                for (int r = 0; r < 16; ++r) kr[blk >> 1][16 * (blk & 1) + r] = fkey(sc[r]);
            } else {
#pragma unroll
                for (int r = 0; r < 16; ++r) kr[blk >> 1][16 * (blk & 1) + r] = zopq;
            }
        }
    }
    TE(5, lds, tid); TB(20, lds, tid);
    unsigned pl[NG][32];
    {
        const int rq = 4 * wave + (lane >> 4), rt = lane & 15;
#pragma unroll
        for (int rd = 0; rd < NRD; ++rd) {
#pragma unroll
            for (int i = 0; i < 4; ++i)
                if (4 * rd + i < 2 * NG) {
#pragma unroll
                    for (int g = 0; g < 4; ++g) {
                        const int blk = 4 * rd + i;
                        u32x4 v; v.x = kr[blk >> 1][16 * (blk & 1) + 4 * g]; v.y = kr[blk >> 1][16 * (blk & 1) + 4 * g + 1]; v.z = kr[blk >> 1][16 * (blk & 1) + 4 * g + 2]; v.w = kr[blk >> 1][16 * (blk & 1) + 4 * g + 3];
                        *(LAS u32x4*)(sk + r32 * SKS + 32 * wave + 256 * i + 8 * g + 4 * hh) = v;
                    }
                }
            __syncthreads();
#pragma unroll
            for (int M = 0; M < 16; ++M)
                if (2 * rd + (M >> 3) < NG) {
                    const u32x4 v = *(const LAS u32x4*)(sk + rq * SKS + 64 * M + 4 * rt);
                    pl[2 * rd + (M >> 3)][4 * (M & 7)] = v.x; pl[2 * rd + (M >> 3)][4 * (M & 7) + 1] = v.y; pl[2 * rd + (M >> 3)][4 * (M & 7) + 2] = v.z; pl[2 * rd + (M >> 3)][4 * (M & 7) + 3] = v.w;
                }
            __syncthreads();
        }
    }
    TE(20, lds, tid); TB(6, lds, tid);
#pragma unroll
    for (int j = 0; j < NG; ++j) transpose32(pl[j]);
    TE(6, lds, tid); TB(7, lds, tid);
    unsigned alive[NG], gt[NG];
#pragma unroll
    for (int j = 0; j < NG; ++j) { alive[j] = topbits(nv - 32 * j); gt[j] = 0u; }
    int above = 0; unsigned prefix = 0u; bool done = false, alld = false;
    rs4_row<NG, 0>(pl, alive, gt, above, prefix, done, alld);
    TE(7, lds, tid); TB(8, lds, tid);
    int kcut = 1 << 20;
    if (!__all(done)) {
        const int need = TOPK - above, rt = lane & 15;
        int posk = 0;
#pragma unroll 1
        for (int b2 = 10; b2 >= 0; --b2) {
            const int tt = posk | (1 << b2);
            const int R = tt - 4 * rt;
            const int M = R <= 0 ? 0 : 4 * (R >> 6) + min(R & 63, 4);
            int cnt = 0;
#pragma unroll
            for (int j = 0; j < NG; ++j) cnt += __popc(alive[j] & topbits(M - 32 * j));
            const int f = rowsum16(cnt);
            if (f < need) posk = tt;
        }
        if (!done) kcut = posk;
    }
    {
        const int rt = lane & 15, R = kcut + 1 - 4 * rt;
        const int Mc = R <= 0 ? 0 : 4 * (R >> 6) + min(R & 63, 4);
        LAS unsigned char* mq = lds + (sp == 0 ? MSK_OFF0 : MSK_OFF1) + (4 * wave + (lane >> 4)) * MSK_QSTRIDE + ((rt >> 3) * 2 + (rt & 1)) * 4 + ((rt >> 1) & 3);
        unsigned sel[NG];
#pragma unroll
        for (int j = 0; j < NG; ++j) sel[j] = __builtin_bitreverse32(gt[j] | (alive[j] & topbits(Mc - 32 * j)));
#pragma unroll
        for (int j = 0; j < NG; ++j)
#pragma unroll
            for (int n = 0; n < 8; ++n) *(LAS unsigned char*)(mq + (8 * j + n) * 16) = (unsigned char)(sel[j] >> (4 * n));
        const int rq = 32 * sp + 4 * wave + (lane >> 4);
        int dmin = 1 << 20;
#pragma unroll
        for (int j = 0; j < NG; ++j) {
            const int nlo = 4 * c - 32 * j;
            const unsigned w = sel[j] & (nlo <= 0 ? 0u : nlo >= 32 ? 0xffffffffu : ((1u << nlo) - 1u));
            if (w) { const int s = 32 * j + 31 - __builtin_clz(w); dmin = 64 * c + rq - (64 * (s >> 2) + 4 * rt + (s & 3)); }
        }
        const unsigned nib = (sel[NG - 1] >> (4 * (c & 7))) & 15u;
#pragma unroll
        for (int e = 0; e < 4; ++e) if (nib & (1u << e)) dmin = min(dmin, abs(rq - 4 * rt - e));
        dmin = min(dmin, __builtin_amdgcn_update_dpp(0, dmin, 0x128, 0xf, 0xf, true));
        dmin = min(dmin, __builtin_amdgcn_update_dpp(0, dmin, 0x124, 0xf, 0xf, true));
        dmin = min(dmin, __builtin_amdgcn_update_dpp(0, dmin, 0x122, 0xf, 0xf, true));
        dmin = min(dmin, __builtin_amdgcn_update_dpp(0, dmin, 0x121, 0xf, 0xf, true));
        if (rt == 0) *(LAS float*)(lds + DMN_OFF + 4 * rq) = (float)dmin;
    }
    TE(8, lds, tid); TE(4, lds, tid);
    __syncthreads();
}
__device__ __forceinline__ void mixD_attend(const Params& p, int b, int c, LAS unsigned char* lds, int wave_s);
__device__ __forceinline__ void mixD_unit(const Params& p, int b, int c, LAS unsigned char* lds, int wave_s) {
    const size_t rowb = (size_t)b * SEQ;
    __syncthreads();
    if (c >= 4) {
#pragma unroll 1
        for (int sp = 0; sp < 2; ++sp) {
            const int ng = (c >> 3) + 1;
            if (ng == 1) d1_pass<1>(p, rowb, c, sp, lds, wave_s);
            else if (ng == 2) d1_pass<2>(p, rowb, c, sp, lds, wave_s);
            else if (ng == 3) d1_pass<3>(p, rowb, c, sp, lds, wave_s);
            else d1_pass<4>(p, rowb, c, sp, lds, wave_s);
        }
    }
    mixD_attend(p, b, c, lds, wave_s);
}
__device__ __forceinline__ void mixD_attend(const Params& p, int b, int c, LAS unsigned char* lds, int wave_s) {
    const int tid = tid_now(wave_s);
    const int lane = tid & 63, wave = __builtin_amdgcn_readfirstlane(tid >> 6), r32 = lane & 31, hh = lane >> 5;
    const size_t rowb = (size_t)b * SEQ;
    const int q0 = c * 64, ntile = c + 1;
    const bool dosel = c >= 4;
    TB(9, lds, tid);
    const int qg = wave >> 2, hd = wave & 3;
    const int pos = q0 + 32 * qg + r32;
    const bf16_t* yq = p.Y() + (rowb + pos) * YP;
    bf16x8_t qf[4];
#pragma unroll
    for (int s = 0; s < 4; ++s) qf[s] = *(const GAS bf16x8_t*)(uintptr_t)(yq + YD_Q + hd * 64 + 16 * s + 8 * hh);
    const float sl2 = exp2f(-(float)(2 * hd + 2)) * 1.4426950408889634f;
    f32x16 o[2];
#pragma unroll
    for (int d = 0; d < 2; ++d)
#pragma unroll
        for (int i = 0; i < 16; ++i) o[d][i] = 0.f;
    const float mref = fmaf(-sl2, dosel ? *(volatile LAS float*)(lds + DMN_OFF + 4 * (32 * qg + r32)) : 0.f, *(volatile LAS float*)(lds + DB2_OFF));
    float lrun = 0.f;
    bf16x8_t kext[2];
#pragma unroll
    for (int kb = 0; kb < 2; ++kb) {
        const float t = sl2 * (float)(32 * kb + r32);
        const unsigned u = cvtpk(t, 0.f), v = cvtpk(t - __uint_as_float(u << 16), 0.f);
        u32x4 w; w.x = hh ? 0u : (u | (v << 16)); w.y = hh ? 0u : 0x3f803f80u; w.z = hh ? 0u : 0x00003f80u; w.w = 0u;
        kext[kb] = __builtin_bit_cast(bf16x8_t, w);
    }
    const int npair = (ntile + 1) >> 1;
    const bf16_t* ksrc = p.Y() + (rowb + 8 * wave) * YP + YD_K;
    const bf16_t* vsrc = p.Y() + (rowb + 8 * wave) * YP + YD_V;
    LAS unsigned char* kring = lds;
    LAS unsigned char* vring = lds + 4 * KVL_TILE;
    const LAS unsigned char* mq = lds + (qg == 0 ? MSK_OFF0 : MSK_OFF1) + r32 * MSK_QSTRIDE + 4 * hh;
    asm volatile("" : "+v"(qf[0]), "+v"(qf[1]), "+v"(qf[2]), "+v"(qf[3]));
    __syncthreads();
#pragma unroll
    for (int tt = 0; tt < 2; ++tt) {
        const int t = min(tt, ntile - 1);
        dma_piece(ksrc + (size_t)t * 64 * YP, kring + tt * KVL_TILE + wave * 1024, lane); dma_piece(vsrc + (size_t)t * 64 * YP, vring + tt * KVL_TILE + wave * 1024, lane);
    }
    if (wave >= 4) __builtin_amdgcn_s_setprio(1);
    for (int pp = 0; pp < npair; ++pp) {
        const int cur = pp & 1;
        const bool more = pp + 1 < npair;
        TB(12, lds, tid);
        asm volatile("s_waitcnt vmcnt(0) lgkmcnt(0)" ::: "memory"); __builtin_amdgcn_s_barrier(); asm volatile("" ::: "memory");
        TE(12, lds, tid);
        if (more) {
#pragma unroll
            for (int tt = 0; tt < 2; ++tt) {
                const int t = min(2 * (pp + 1) + tt, ntile - 1);
                dma_piece(ksrc + (size_t)t * 64 * YP, kring + ((cur ^ 1) * 2 + tt) * KVL_TILE + wave * 1024, lane); dma_piece(vsrc + (size_t)t * 64 * YP, vring + ((cur ^ 1) * 2 + tt) * KVL_TILE + wave * 1024, lane);
            }
        }
        TB(11, lds, tid);
#pragma unroll 1
        for (int tt = 0; tt < 2; ++tt) {
            const int j = 2 * pp + tt;
            if (j < ntile) {
                const LAS unsigned char* kt = kring + (cur * 2 + tt) * KVL_TILE;
                const LAS unsigned char* vt = vring + (cur * 2 + tt) * KVL_TILE;
                const bool diag = (j == c);
                unsigned selb[2] = {0xffffffffu, 0xffffffffu};
                if (dosel) { selb[0] = *(const LAS unsigned*)(mq + 16 * j); selb[1] = *(const LAS unsigned*)(mq + 16 * j + 8); }
                bf16x8_t qext;
                {
                    const float cj = fmaf(sl2, (float)(64 * j - pos), -mref);
                    const unsigned u = cvtpk(cj, 0.f); const float r1 = cj - __uint_as_float(u << 16);
                    const unsigned v = cvtpk(r1, 0.f), x = cvtpk(r1 - __uint_as_float(v << 16), 0.f);
                    const bool off = hh != 0 || diag;
                    u32x4 w; w.x = off ? 0u : 0x3f803f80u; w.y = off ? 0u : (u | (v << 16)); w.z = off ? 0u : x; w.w = 0u;
                    qext = __builtin_bit_cast(bf16x8_t, w);
                }
                bf16x8_t kf[2][4];
#pragma unroll
                for (int kb = 0; kb < 2; ++kb)
#pragma unroll
                    for (int s = 0; s < 4; ++s) kf[kb][s] = *(const LAS bf16x8_t*)(kt + (32 * kb + r32) * 128 + (((2 * s + hh) ^ (r32 & 7)) * 16));
                __builtin_amdgcn_sched_barrier(0);
                f32x16 sc[2];
#pragma unroll
                for (int kb = 0; kb < 2; ++kb) {
                    f32x16 z;
#pragma unroll
                    for (int i = 0; i < 16; ++i) z[i] = 0.f;
                    sc[kb] = MFMA32(kext[kb], qext, z);
                }
#pragma unroll
                for (int s = 0; s < 4; ++s)
#pragma unroll
                    for (int kb = 0; kb < 2; ++kb) sc[kb] = MFMA32(kf[kb][s], qf[s], sc[kb]);
                bf16x8_t vf0 = vt_frag_sw(vt, 0, 0, lane), vf1 = vt_frag_sw(vt, 0, 1, lane);
                __builtin_amdgcn_sched_barrier(0);
#pragma unroll
                for (int kb = 0; kb < 2; ++kb) {
                    if (diag) {
                        const float pl = (float)(pos - 64 * j - 4 * hh);
#pragma unroll
                        for (int i = 0; i < 16; ++i) { const float kc = (float)(32 * kb + (i & 3) + 8 * (i >> 2)); sc[kb][i] += fmaf(-sl2, fabsf(pl - kc), -mref); }
                    }
#pragma unroll
                    for (int i = 0; i < 16; ++i) {
                        const unsigned t = (unsigned)__builtin_amdgcn_sbfe((int)selb[kb], 8 * (i >> 2) + (i & 3), 1);
                        sc[kb][i] = __uint_as_float(__float_as_uint(__builtin_amdgcn_exp2f(sc[kb][i])) & t);
                    }
                }
                f32x2_t l01 = {0.f, 0.f}, l23 = {0.f, 0.f};
#pragma unroll
                for (int kb = 0; kb < 2; ++kb)
#pragma unroll
                    for (int g = 0; g < 4; ++g) { l01 += (f32x2_t){sc[kb][4 * g], sc[kb][4 * g + 1]}; l23 += (f32x2_t){sc[kb][4 * g + 2], sc[kb][4 * g + 3]}; }
                lrun += (l01.x + l01.y) + (l23.x + l23.y);
                bf16x8_t pf[4];
#pragma unroll
                for (int ks = 0; ks < 4; ++ks) pf[ks] = pack_step(sc[ks >> 1], ks & 1);
                __builtin_amdgcn_sched_barrier(0);
#pragma unroll
                for (int ks = 0; ks < 4; ++ks) {
                    const bf16x8_t a0 = vf0, a1 = vf1;
                    if (ks < 3) { vf0 = vt_frag_sw(vt, ks + 1, 0, lane); vf1 = vt_frag_sw(vt, ks + 1, 1, lane); }
                    o[0] = MFMA32(a0, pf[ks], o[0]); o[1] = MFMA32(a1, pf[ks], o[1]);
                    __builtin_amdgcn_sched_barrier(0);
                }
            }
        }
        TE(11, lds, tid);
    }
    __builtin_amdgcn_s_setprio(0);
    TE(9, lds, tid);
    const float inv = 1.f / xsum32(lrun);
    bf16_t* mrow = p.mix() + (rowb + pos) * DM + 768 + hd * 64;
#pragma unroll
    for (int d = 0; d < 2; ++d) {
        unsigned pk00, pk01, pk10, pk11, pk20, pk21, pk30, pk31;
#pragma unroll
        for (int g = 0; g < 4; ++g) {
            const int d0 = 32 * d + 8 * g + 4 * hh;
            const unsigned long long zz = *(const GAS unsigned long long*)(uintptr_t)(yq + YD_Z + hd * 64 + d0);
            const float z0 = __uint_as_float((unsigned)(zz & 0xffffu) << 16), z1 = __uint_as_float((unsigned)((zz >> 16) & 0xffffu) << 16),
                        z2 = __uint_as_float((unsigned)((zz >> 32) & 0xffffu) << 16), z3 = __uint_as_float((unsigned)((zz >> 48) & 0xffffu) << 16);
            const unsigned pa = cvtpk(o[d][4 * g] * inv * z0, o[d][4 * g + 1] * inv * z1), pb = cvtpk(o[d][4 * g + 2] * inv * z2, o[d][4 * g + 3] * inv * z3);
            if (g == 0) { pk00 = pa; pk01 = pb; } else if (g == 1) { pk10 = pa; pk11 = pb; } else if (g == 2) { pk20 = pa; pk21 = pb; } else { pk30 = pa; pk31 = pb; }
        }
        store_pair16(mrow + 32 * d, 0, pk00, pk01, pk10, pk11, hh);
        store_pair16(mrow + 32 * d, 2, pk20, pk21, pk30, pk31, hh);
    }
}
__device__ __forceinline__ void ph_mixD(const Params& p, int l, LAS unsigned char* lds, int bid, int nb, int wave_s) {
    {
        float gq = 0.f, gk = 0.f;
        for (int i = 0; i < 64; ++i) { gq = fmaxf(gq, fabsf(p.sm(SM_DQG)[l * 64 + i])); gk = fmaxf(gk, fabsf(p.sm(SM_DKG)[l * 64 + i])); }
        if (tid_now(wave_s) == 0) *(volatile LAS float*)(lds + DB2_OFF) = 0.125f * 1.4426950408889634f * 64.f * gq * gk * 1.02f;
        __syncthreads();
    }
    for (int i = bid; i < 256; i += nb) {
        const int b = i & 15, cc = i >> 4;
#pragma unroll 1
        for (int k = 0; k < 2; ++k) mixD_unit(p, b, k == 0 ? 31 - cc : cc, lds, wave_s);
    }
}

constexpr int VN_STRIDE = 528;
__device__ __forceinline__ float bflo(unsigned u) { return __uint_as_float(u << 16); }
__device__ __forceinline__ float bfhi(unsigned u) { return __uint_as_float(u & 0xffff0000u); }
__device__ __forceinline__ void mixAB_unit(const Params& p, int l, int b, int n, LAS unsigned char* lds, int tid) {
    const int lane = tid & 63, wave = __builtin_amdgcn_readfirstlane(tid >> 6), r32 = lane & 31, hh = lane >> 5;
    const size_t row0 = (size_t)b * SEQ + 128 * n;
    __syncthreads();
#pragma unroll
    for (int k = 0; k < 8; ++k) {
        const int ch = tid + 512 * k, r = ch >> 5, c16 = ch & 31;
        *(LAS u32x4*)(lds + r * VN_STRIDE + c16 * 16) = *(const GAS u32x4*)(uintptr_t)(p.Y() + (row0 + r) * YP + YB_V + c16 * 8);
    }
    {
        const int cg8 = (tid & 31) * 8, t0 = (tid >> 5) * 8;
        const int pos0 = 128 * n + t0;
        const GAS float* cw = p.sm(SM_CONVW) + l * 768 + cg8;
        float w0[8], w1[8], w2[8], cb[8];
#pragma unroll
        for (int e = 0; e < 8; ++e) { w0[e] = cw[e]; w1[e] = cw[256 + e]; w2[e] = cw[512 + e]; cb[e] = p.sm(SM_CONVB)[l * 256 + cg8 + e]; }
        float um2[8], um1[8];
#pragma unroll
        for (int e = 0; e < 8; ++e) { um2[e] = 0.f; um1[e] = 0.f; }
#pragma unroll
        for (int back = 2; back >= 1; --back) {
            if (pos0 - back >= 0) {
                const bf16_t* yr = p.Y() + (row0 + t0 - back) * YP;
                const u32x4 hc = *(const GAS u32x4*)(uintptr_t)(yr + YA_H + cg8), cc = *(const GAS u32x4*)(uintptr_t)(yr + YA_C + cg8);
                float u[8] = {bflo(hc.x) * bflo(cc.x), bfhi(hc.x) * bfhi(cc.x), bflo(hc.y) * bflo(cc.y), bfhi(hc.y) * bfhi(cc.y),
                              bflo(hc.z) * bflo(cc.z), bfhi(hc.z) * bfhi(cc.z), bflo(hc.w) * bflo(cc.w), bfhi(hc.w) * bfhi(cc.w)};
#pragma unroll
                for (int e = 0; e < 8; ++e) { if (back == 2) um2[e] = u[e]; else um1[e] = u[e]; }
            }
        }
        u32x4 hcv[8], ccv[8], bgq[8], zgq[8];
#pragma unroll
        for (int tt = 0; tt < 8; ++tt) {
            const bf16_t* yr = p.Y() + (row0 + t0 + tt) * YP;
            hcv[tt] = *(const GAS u32x4*)(uintptr_t)(yr + YA_H + cg8); ccv[tt] = *(const GAS u32x4*)(uintptr_t)(yr + YA_C + cg8);
            bgq[tt] = *(const GAS u32x4*)(uintptr_t)(yr + YA_B + cg8); zgq[tt] = *(const GAS u32x4*)(uintptr_t)(yr + YA_Z + cg8);
        }
#pragma unroll
        for (int tt = 0; tt < 8; ++tt) {
            const u32x4 hc = hcv[tt], cc = ccv[tt], bg = bgq[tt], zg = zgq[tt];
            const float u[8] = {bflo(hc.x) * bflo(cc.x), bfhi(hc.x) * bfhi(cc.x), bflo(hc.y) * bflo(cc.y), bfhi(hc.y) * bfhi(cc.y),
                                bflo(hc.z) * bflo(cc.z), bfhi(hc.z) * bfhi(cc.z), bflo(hc.w) * bflo(cc.w), bfhi(hc.w) * bfhi(cc.w)};
            const float bgv[8] = {bflo(bg.x), bfhi(bg.x), bflo(bg.y), bfhi(bg.y), bflo(bg.z), bfhi(bg.z), bflo(bg.w), bfhi(bg.w)};
            const float zgv[8] = {bflo(zg.x), bfhi(zg.x), bflo(zg.y), bfhi(zg.y), bflo(zg.z), bfhi(zg.z), bflo(zg.w), bfhi(zg.w)};
            float ov[8];
#pragma unroll
            for (int e = 0; e < 8; ++e) {
                const float conv = w0[e] * um2[e] + w1[e] * um1[e] + w2[e] * u[e];
                ov[e] = bgv[e] * (conv + cb[e]) * zgv[e];
                um2[e] = um1[e]; um1[e] = u[e];
            }
            u32x4 ow; ow.x = cvtpk(ov[0], ov[1]); ow.y = cvtpk(ov[2], ov[3]); ow.z = cvtpk(ov[4], ov[5]); ow.w = cvtpk(ov[6], ov[7]);
            *(GAS u32x4*)(uintptr_t)(p.mix() + (row0 + t0 + tt) * DM + cg8) = ow;
        }
    }
    __syncthreads();
    {
        const int h = wave >> 1, th = wave & 1;
        const int nks = th == 0 ? 4 : 8;
        f32x16 acc[2][2];
#pragma unroll
        for (int a = 0; a < 2; ++a)
#pragma unroll
            for (int d = 0; d < 2; ++d)
#pragma unroll
                for (int i = 0; i < 16; ++i) acc[a][d][i] = 0.f;
        const bf16_t* wb = p.wsb() + ((size_t)(l * 4 + h) * 128 + 64 * th + r32) * 128 + 8 * hh;
        const int i16 = lane & 15, q = i16 >> 2, pp = i16 & 3, blk = (lane >> 4) & 1;
        const LAS unsigned char* va = lds + (8 * hh + q) * VN_STRIDE + (h * 64 + 16 * blk + 4 * pp) * 2;
        bf16x8_t bfr[8][2];
#pragma unroll
        for (int ks = 0; ks < 8; ++ks)
#pragma unroll
            for (int tb = 0; tb < 2; ++tb) bfr[ks][tb] = *(const GAS bf16x8_t*)(uintptr_t)(wb + (size_t)(32 * tb) * 128 + 16 * (ks < nks ? ks : 0));
        unsigned long long uu[2][2][4], zz[2][2][4]; float bias[2];
#pragma unroll
        for (int tb = 0; tb < 2; ++tb) {
            const int t = 64 * th + 32 * tb + r32;
            bias[tb] = p.sm(SM_GMLPB)[(l * 4 + h) * 128 + t];
            const bf16_t* yr = p.Y() + (row0 + t) * YP;
#pragma unroll
            for (int db = 0; db < 2; ++db)
#pragma unroll
                for (int g = 0; g < 4; ++g) {
                    const int d0 = 32 * db + 8 * g + 4 * hh;
                    uu[tb][db][g] = *(const GAS unsigned long long*)(uintptr_t)(yr + YB_U + h * 64 + d0); zz[tb][db][g] = *(const GAS unsigned long long*)(uintptr_t)(yr + YB_Z + h * 64 + d0);
                }
        }
#pragma unroll
        for (int ks = 0; ks < 8; ++ks) {
            if (ks < nks) {
                bf16x8_t afr[2];
#pragma unroll
                for (int db = 0; db < 2; ++db) {
                    const LAS unsigned char* a = va + (16 * ks) * VN_STRIDE + (32 * db) * 2;
                    const s16x4_t lo = ds_tr16(a), hi = ds_tr16(a + 4 * VN_STRIDE);
                    afr[db] = __builtin_shufflevector(lo, hi, 0, 1, 2, 3, 4, 5, 6, 7);
                }
#pragma unroll
                for (int tb = 0; tb < 2; ++tb)
#pragma unroll
                    for (int db = 0; db < 2; ++db) acc[tb][db] = MFMA32(afr[db], bfr[ks][tb], acc[tb][db]);
            }
        }
#pragma unroll
        for (int tb = 0; tb < 2; ++tb) {
            const int t = 64 * th + 32 * tb + r32;
            bf16_t* mr = p.mix() + (row0 + t) * DM + 256 + h * 64;
#pragma unroll
            for (int db = 0; db < 2; ++db)
#pragma unroll
                for (int g = 0; g < 4; ++g) {
                    const int d0 = 32 * db + 8 * g + 4 * hh;
                    const unsigned u01 = (unsigned)uu[tb][db][g], u23 = (unsigned)(uu[tb][db][g] >> 32), z01 = (unsigned)zz[tb][db][g], z23 = (unsigned)(zz[tb][db][g] >> 32);
                    const float v0 = bflo(u01) * (acc[tb][db][4 * g] + bias[tb]) * bflo(z01), v1 = bfhi(u01) * (acc[tb][db][4 * g + 1] + bias[tb]) * bfhi(z01);
                    const float v2 = bflo(u23) * (acc[tb][db][4 * g + 2] + bias[tb]) * bflo(z23), v3 = bfhi(u23) * (acc[tb][db][4 * g + 3] + bias[tb]) * bfhi(z23);
                    *(GAS unsigned long long*)(uintptr_t)(mr + d0) = (unsigned long long)cvtpk(v0, v1) | ((unsigned long long)cvtpk(v2, v3) << 32);
                }
        }
    }
}
__device__ __forceinline__ void ph_mixAB(const Params& p, int l, LAS unsigned char* lds, int bid, int nb, int tid_in) {
    int tid = tid_in; asm volatile("" : "+v"(tid));
    for (int i = bid; i < 256; i += nb) mixAB_unit(p, l, i >> 4, i & 15, lds, tid);
}

constexpr int IX_STRIDE = 528;
__device__ __forceinline__ void ph_ikiw(const Params& p, int l, LAS unsigned char* lds, int bid, int nb, int wave_s) {
    const int tid = tid_now(wave_s);
    const int lane = tid & 63, wave = __builtin_amdgcn_readfirstlane(tid >> 6), r32 = lane & 31, hh = lane >> 5;
    const int tb = wave & 3, cb = wave >> 2;
    LAS unsigned char* xs = lds;
    LAS unsigned char* ws = lds + 128 * IX_STRIDE;
    const bf16_t* wbase = p.wt_in() + (size_t)l * YP * DM;
    __syncthreads();
    { unsigned z = 0u; asm volatile("" : "+v"(z));
      for (int i = tid; i < 28 * (IX_STRIDE / 16); i += NT) *(LAS u32x4*)(ws + 36 * IX_STRIDE + i * 16) = (u32x4){z, z, z, z}; }
    for (int blk = bid; blk < NTOK / 128; blk += nb) {
        f32x16 acc;
#pragma unroll
        for (int i = 0; i < 16; ++i) acc[i] = 0.f;
        u32x4 xv[8], wv[3];
#define IX_LOAD(k0_) do { \
            _Pragma("unroll") for (int i = 0; i < 8; ++i) { const int idx = tid + NT * i; xv[i] = *(const GAS u32x4*)(uintptr_t)(p.xb() + (size_t)(128 * blk + (idx >> 5)) * DM + (k0_) + 8 * (idx & 31)); } \
            _Pragma("unroll") for (int i = 0; i < 3; ++i) { const int idx = tid + NT * i, n = idx >> 5; \
                if (idx < 36 * 32) wv[i] = *(const GAS u32x4*)(uintptr_t)(wbase + (size_t)(n < 32 ? 3584 + n : 3712 + (n - 32)) * DM + (k0_) + 8 * (idx & 31)); } } while (0)
        IX_LOAD(0);
#pragma unroll 1
        for (int k0 = 0; k0 < DM; k0 += 256) {
            __syncthreads();
#pragma unroll
            for (int i = 0; i < 8; ++i) { const int idx = tid + NT * i; *(LAS u32x4*)(xs + (idx >> 5) * IX_STRIDE + (idx & 31) * 16) = xv[i]; }
#pragma unroll
            for (int i = 0; i < 3; ++i) { const int idx = tid + NT * i; if (idx < 36 * 32) *(LAS u32x4*)(ws + (idx >> 5) * IX_STRIDE + (idx & 31) * 16) = wv[i]; }
            __syncthreads();
            if (k0 + 256 < DM) IX_LOAD(k0 + 256);
#pragma unroll
            for (int s = 0; s < 16; ++s) {
                const bf16x8_t a = *(const LAS bf16x8_t*)(ws + (32 * cb + r32) * IX_STRIDE + (16 * s + 8 * hh) * 2);
                const bf16x8_t b = *(const LAS bf16x8_t*)(xs + (32 * tb + r32) * IX_STRIDE + (16 * s + 8 * hh) * 2);
                acc = MFMA32(a, b, acc);
            }
        }
#undef IX_LOAD
        const int tok = 128 * blk + 32 * tb + r32;
        const GAS f32x4* sp = (const GAS f32x4*)(uintptr_t)(p.ssq() + (size_t)tok * 16);
        const f32x4 s0 = sp[0], s1 = sp[1], s2 = sp[2], s3 = sp[3];
        const float tot = ((s0.x + s0.y) + (s0.z + s0.w)) + ((s1.x + s1.y) + (s1.z + s1.w)) + ((s2.x + s2.y) + (s2.z + s2.w)) + ((s3.x + s3.y) + (s3.z + s3.w));
        const float rstd = rsqrtf(tot * (1.f / DM) + EPS);
        bf16_t* yr = p.Y() + (size_t)tok * YP + YI_K + 32 * cb;
#pragma unroll
        for (int g = 0; g < 4; ++g) {
            const int c0 = 8 * g + 4 * hh;
            if (32 * cb + c0 < 36)
                *(GAS unsigned long long*)(uintptr_t)(yr + c0) = (unsigned long long)cvtpk(acc[4 * g] * rstd, acc[4 * g + 1] * rstd) | ((unsigned long long)cvtpk(acc[4 * g + 2] * rstd, acc[4 * g + 3] * rstd) << 32);
        }
    }
    __syncthreads();
}

__global__ void __launch_bounds__(NT, 2) k_fwd(Params p) {
    extern __shared__ __attribute__((aligned(16))) unsigned char lds[];
    cg::grid_group grid = cg::this_grid();
    LAS unsigned char* l3 = (LAS unsigned char*)lds;
    const int wave_s = __builtin_amdgcn_readfirstlane((int)threadIdx.x >> 6);
    volatile LAS unsigned* bst = (volatile LAS unsigned*)(l3 + LDS_BYTES - 16);
    if (threadIdx.x < 2) bst[threadIdx.x] = 0u;
    __syncthreads();
    const XcdBarrier bar = xcd_barrier_post(p.ctl(), bst);
    if (TSEG >= 0 && threadIdx.x == 0) *(volatile LAS unsigned*)(l3 + TCTR_OFF) = 0u;
    { TB(16, l3, tid_now(wave_s)); ph_prologue(p, l3, tid_now(wave_s)); TE(16, l3, tid_now(wave_s)); }
    if (p.ws == nullptr) grid.sync();
    { TB(18, l3, tid_now(wave_s)); xcd_barrier(bar, tid_now(wave_s)); TE(18, l3, tid_now(wave_s)); }
#pragma unroll 1
    for (int l = 0; l < DEPTH; ++l) {
        Params q = p; asm volatile("" : "+s"(q.ws), "+s"(q.out));
        int bid = blockIdx.x, nb = gridDim.x; asm volatile("" : "+s"(bid), "+s"(nb));
        const bool ik_first = ((bid >> 3) & 1) != 0;
#pragma unroll 1
        for (int st = 0; st < 3; ++st) {
            if (st == 1) {
                pg8::Gemm g{q.xb(), q.wt_in() + (size_t)l * YP * DM, NTOK, NGEMM, DM};
                pg8::StaticOrder S; S.init(NTOK, NGEMM, nb, bid);
                EpiIn E{q.ws, l, (LAS float*)(l3 + 131072 + 1024)};
                { TB(13, l3, tid_now(wave_s)); pg8::gemm_phase<EpiIn, pg8::StaticOrder, true, true>(l3, g, S, E, tid_now(wave_s)); TE(13, l3, tid_now(wave_s)); }
            } else if ((st == 0) == ik_first) {
                __syncthreads();
                { TB(21, l3, tid_now(wave_s)); ph_ikiw(q, l, l3, bid, nb, wave_s); TE(21, l3, tid_now(wave_s)); }
                __syncthreads();
            }
        }
        { TB(18, l3, tid_now(wave_s)); xcd_barrier(bar, tid_now(wave_s)); TE(18, l3, tid_now(wave_s)); }
        asm volatile("" : "+s"(q.ws), "+s"(bid), "+s"(nb));
        { TB(17, l3, tid_now(wave_s)); ph_mixAB(q, l, l3, bid, nb, tid_now(wave_s)); TE(17, l3, tid_now(wave_s)); }
        __syncthreads();
        { TB(1, l3, tid_now(wave_s)); ph_mixC(q, l, l3, bid, nb, wave_s); TE(1, l3, tid_now(wave_s)); }
        __syncthreads();
        { TB(19, l3, tid_now(wave_s)); ph_mixD(q, l, l3, bid, nb, wave_s); TE(19, l3, tid_now(wave_s)); }
        __syncthreads();
        if (l + 1 < DEPTH) {
            const int nlight = nb >= 256 ? 64 : nb;
            if (bid < nlight) { const int t2 = tid_now(wave_s); convert_layer_weights(q, l + 1, l3, t2, bid * NW + (t2 >> 6), nlight * NW); }
            __syncthreads();
        }
        { TB(18, l3, tid_now(wave_s)); xcd_barrier(bar, tid_now(wave_s)); TE(18, l3, tid_now(wave_s)); }
        asm volatile("" : "+s"(q.ws), "+s"(q.out), "+s"(bid), "+s"(nb));
        {
            pg8::Gemm g{q.mix(), q.wt_out() + (size_t)l * DM * DM, NTOK, DM, DM};
            pg8::StaticOrder S; S.init(NTOK, DM, nb, bid);
            EpiOut E{l == DEPTH - 1 ? q.out : nullptr, q.ws};
            { TB(15, l3, tid_now(wave_s)); pg8::gemm_phase<EpiOut, pg8::StaticOrder, true, true>(l3, g, S, E, tid_now(wave_s)); TE(15, l3, tid_now(wave_s)); }
        }
        { TB(18, l3, tid_now(wave_s)); xcd_barrier(bar, tid_now(wave_s)); TE(18, l3, tid_now(wave_s)); }
    }
    if (TSEG >= 0 && blockIdx.x == 0 && threadIdx.x == 0) {
        const unsigned long long ticks = 8ull * *(volatile LAS unsigned*)(l3 + TCTR_OFF), t0 = __builtin_amdgcn_s_memrealtime();
        while (__builtin_amdgcn_s_memrealtime() - t0 < ticks) __builtin_amdgcn_s_sleep(32);
    }
}

extern "C" void kernel_launch(void* const* d_in, const int* in_sizes, int n_in, void* d_out, int out_size, void* d_ws, size_t ws_size,
                              hipStream_t stream) {
    static int grid_blocks = 0;
    if (!grid_blocks) {
        int dev = 0, cus = 0, per_cu = 0;
        (void)hipGetDevice(&dev);
        (void)hipDeviceGetAttribute(&cus, hipDeviceAttributeMultiprocessorCount, dev);
        (void)hipFuncSetAttribute((const void*)k_fwd, hipFuncAttributeMaxDynamicSharedMemorySize, LDS_BYTES);
        (void)hipOccupancyMaxActiveBlocksPerMultiprocessor(&per_cu, (const void*)k_fwd, NT, LDS_BYTES);
        if (per_cu < 1) { fprintf(stderr, "kernel_launch: occupancy query returned %d\n", per_cu); per_cu = 1; }
        if (per_cu > 1) per_cu = 1;
        grid_blocks = cus * per_cu;
        if (ws_size < WS_END) fprintf(stderr, "kernel_launch: workspace too small (%zu < %zu)\n", ws_size, (size_t)WS_END);
    }
    (void)hipMemsetAsync(d_ws, 0, 16384, stream);
    Params p{};
    p.x = (const float*)d_in[0]; p.norm_g = (const float*)d_in[1]; p.w_in = (const float*)d_in[2]; p.i_conv_w = (const float*)d_in[3];
    p.i_conv_b = (const float*)d_in[4]; p.i_gmlp_g = (const float*)d_in[5]; p.gmlp_ws = (const float*)d_in[6]; p.i_gmlp_b = (const float*)d_in[7];
    p.i_diff_qg = (const float*)d_in[8]; p.i_diff_kg = (const float*)d_in[9]; p.i_diff_lam = (const float*)d_in[10]; p.i_diff_subg = (const float*)d_in[11];
    p.i_dsa_qg = (const float*)d_in[12]; p.i_dsa_kg = (const float*)d_in[13]; p.w_out = (const float*)d_in[14];
    p.out = (float*)d_out; p.ws = (unsigned char*)d_ws;
    void* args[] = {&p};
    hipError_t e = hipLaunchCooperativeKernel((void*)k_fwd, dim3(grid_blocks), dim3(NT), args, LDS_BYTES, stream);
    if (e != hipSuccess) fprintf(stderr, "cooperative launch failed: %s (grid %d)\n", hipGetErrorString(e), grid_blocks);
}
```

```cpp
#include <hip/hip_runtime.h>
#include <hip/hip_cooperative_groups.h>
#include <math.h>
#include <stdint.h>
#include <stdio.h>
namespace cg = cooperative_groups;
namespace pg8 {
#define PG8_LAS __attribute__((address_space(3)))
typedef unsigned short bf16_t;
typedef short bf16x8 __attribute__((ext_vector_type(8)));
typedef float f32x4 __attribute__((ext_vector_type(4)));
typedef unsigned u32x4 __attribute__((ext_vector_type(4)));
constexpr int BM = 256, BK = 64, HALF = 128, HTB = HALF * BK * 2  , STAGE_BYTES = 8 * HTB, NXCD = 8, WGM = 8;

__host__ __device__ __forceinline__ int lds_byte(int r, int c) { const int st = (r >> 4) * 2 + (c >> 5), rr = r & 15, cc = c & 31, ob = rr * 64 + cc * 2; return st * 1024 + (ob ^ (((ob >> 9) & 1) << 5)); }
__host__ __device__ __forceinline__ void stage_rc(int b, int& R, int& C) { const int st = b / 1024, sb = b % 1024, swz = sb ^ (((sb >> 9) & 1) << 5); R = (st >> 1) * 16 + swz / 64; C = (st & 1) * 32 + (swz % 64) / 2; }
__host__ __device__ __forceinline__ int perm32(int rho) { const int n = rho >> 4, i = rho & 15; return 8 * (i >> 2) + 4 * n + (i & 3); }

struct Unit { int pm, pn; };
struct Gemm { const bf16_t* A; const bf16_t* Bt; int M, N, K; };

struct StaticOrder {
    int nM, nN, nwg, G, c;
    __host__ __device__ void init(int M, int N, int G_, int c_) { nM = M / BM; nN = N / BM; nwg = nM * nN; G = G_; c = c_; }
    __host__ __device__ bool next(int i, Unit& u) const {
        const long L = (long)i * G + c; if (L >= nwg) return false;
        int wgid = (int)L; { const int q = nwg / NXCD, r = nwg % NXCD, xcd = wgid % NXCD, off = wgid / NXCD; wgid = (xcd < r ? xcd * (q + 1) : r * (q + 1) + (xcd - r) * q) + off; }
        const int nig = WGM * nN, gid = wgid / nig, fm = gid * WGM, gsz = (nM - fm) < WGM ? (nM - fm) : WGM;
        u.pm = fm + ((wgid % nig) % gsz); u.pn = (wgid % nig) / gsz; return true;
    }
    __device__ __forceinline__ void a_ready(const Unit&) const {}
    __device__ __forceinline__ void done(const Unit&) const {}
};

__device__ __forceinline__ unsigned cvt_pk_bf16(float lo, float hi) { unsigned r; asm volatile("v_cvt_pk_bf16_f32 %0, %1, %2" : "=v"(r) : "v"(lo), "v"(hi)); return r; }
typedef float f32x2 __attribute__((ext_vector_type(2)));
__device__ __forceinline__ f32x2 gelu_pk(f32x2 v) {
    f32x2 x = v * 0.70710678118654752f;
    x.x = __builtin_amdgcn_fmed3f(x.x, -4.f, 4.f); x.y = __builtin_amdgcn_fmed3f(x.y, -4.f, 4.f);
    const f32x2 x2 = x * x;
    f32x2 al = x2 * (-2.72614225801306e-10f) + 2.77068142495902e-08f; al = al * x2 + (-2.10102402082508e-06f); al = al * x2 + (-5.69250639462346e-05f);
    al = al * x2 + (-7.34990630326855e-04f); al = al * x2 + (-2.95459980854025e-03f); al = al * x2 + (-1.60960333262415e-02f);
    f32x2 be = x2 * (-1.45660718464996e-05f) + (-2.13374055278905e-04f); be = be * x2 + (-1.68282697438203e-03f); be = be * x2 + (-7.37332916720468e-03f); be = be * x2 + (-1.42647390514189e-02f);
    f32x2 rb; rb.x = __builtin_amdgcn_rcpf(be.x); rb.y = __builtin_amdgcn_rcpf(be.y);
    const f32x2 er = (x * al) * rb, h = v * 0.5f;
    return h * er + h;
}
template <class Epi, class Sched, bool ALIGN_EPI = false, bool SP2 = false>
__device__ __forceinline__ void gemm_phase(PG8_LAS unsigned char* lds, const Gemm g, const Sched& S, const Epi& E, int tid_in) {
    int tid_ = tid_in; asm volatile("" : "+v"(tid_));
    const int tid = tid_, wid = __builtin_amdgcn_readfirstlane(tid >> 6), lane = tid & 63, wr = wid >> 2, wc = wid & 3, fr = lane & 15, fq = lane >> 4;
    const int K = g.K, nt = K / BK;
    unsigned voffA[2], voffB[2];
#pragma unroll
    for (int i = 0; i < 2; ++i) { int R, C; stage_rc(tid * 16 + i * 8192, R, C); const int Rb = Epi::PERM ? ((R & ~31) + perm32(R & 31)) : R;
        voffA[i] = (unsigned)(R * K + C) * 2u; voffB[i] = (unsigned)(Rb * K + C) * 2u; }
    const size_t kstep = (size_t)(BK * 2);
    const size_t hstep = (size_t)HALF * K * 2;
    const size_t tstep = 2 * hstep;
    const unsigned ldsw = (unsigned)wid * 1024u;
    const int aoff = lds_byte(wr * 64 + fr, fq * 8), boff = lds_byte(wc * 32 + fr, fq * 8);
#define PG8_SA(b, h) (((b) * 2 + (h)) * HTB)
#define PG8_SB(b, h) ((4 + (b) * 2 + (h)) * HTB)
#define PG8_STAGE(bufoff, gbase, voff) do { _Pragma("unroll") for (int _i = 0; _i < 2; ++_i) \
        __builtin_amdgcn_global_load_lds((const unsigned*)((const char*)(gbase) + (voff)[_i]), (PG8_LAS unsigned*)(lds + (bufoff) + ldsw + _i * 8192), 16, 0, 0); } while (0)
#define PG8_LDA(dst, b, h) do { _Pragma("unroll") for (int m = 0; m < 4; ++m) _Pragma("unroll") for (int k = 0; k < 2; ++k) dst[m][k] = *(const PG8_LAS bf16x8*)(lds + PG8_SA(b, h) + aoff + m * 2048 + k * 1024); } while (0)
#define PG8_LDB(dst, b, h) do { _Pragma("unroll") for (int n = 0; n < 2; ++n) _Pragma("unroll") for (int k = 0; k < 2; ++k) dst[n][k] = *(const PG8_LAS bf16x8*)(lds + PG8_SB(b, h) + boff + n * 2048 + k * 1024); } while (0)
#define PG8_MMA(ai, bj, At, Bt) do { __builtin_amdgcn_s_setprio(1); _Pragma("unroll") for (int m = 0; m < 4; ++m) _Pragma("unroll") for (int n = 0; n < 2; ++n) _Pragma("unroll") for (int k = 0; k < 2; ++k) \
        acc[ai][bj][m][n] = __builtin_amdgcn_mfma_f32_16x16x32_bf16(Bt[n][k], At[m][k], acc[ai][bj][m][n], 0, 0, 0); __builtin_amdgcn_s_setprio(0); } while (0)
#define PG8_WAIT_V(n) asm volatile("s_waitcnt vmcnt(" #n ")" ::: "memory")
#define PG8_WAIT_L(n) asm volatile("s_waitcnt lgkmcnt(" #n ")" ::: "memory")
#define PG8_BAR __builtin_amdgcn_s_barrier()
#define PG8_SCHED __builtin_amdgcn_sched_barrier(0)
    Unit cur, nxt; int ui = 0;
    if (!S.next(0, cur)) return;
    f32x4 acc[2][2][4][2];
#pragma unroll
    for (int a = 0; a < 2; ++a)
#pragma unroll
        for (int b = 0; b < 2; ++b)
#pragma unroll
            for (int m = 0; m < 4; ++m)
#pragma unroll
                for (int n = 0; n < 2; ++n) acc[a][b][m][n] = (f32x4){0.f, 0.f, 0.f, 0.f};
    bf16x8 At[4][2], B0[2][2], B1[2][2];
    const char* cA = (const char*)g.A + (size_t)cur.pm * tstep; const char* cB = (const char*)g.Bt + (size_t)cur.pn * tstep;
    S.a_ready(cur);
    if constexpr (SP2) {
        PG8_STAGE(PG8_SB(0, 0), cB, voffB); PG8_STAGE(PG8_SB(0, 1), cB + hstep, voffB); PG8_STAGE(PG8_SA(0, 0), cA, voffA); PG8_STAGE(PG8_SA(0, 1), cA + hstep, voffA);
        if (wr == 1) PG8_BAR;
        PG8_WAIT_V(2); PG8_BAR;
        PG8_STAGE(PG8_SB(1, 0), cB + kstep, voffB); PG8_STAGE(PG8_SA(1, 0), cA + kstep, voffA); PG8_STAGE(PG8_SB(1, 1), cB + hstep + kstep, voffB);
        PG8_WAIT_V(6); PG8_BAR;
    } else {
        PG8_STAGE(PG8_SB(0, 0), cB, voffB); PG8_STAGE(PG8_SA(0, 0), cA, voffA); PG8_STAGE(PG8_SB(0, 1), cB + hstep, voffB); PG8_STAGE(PG8_SA(0, 1), cA + hstep, voffA);
        if (wr == 1) PG8_BAR;
        PG8_WAIT_V(4); PG8_BAR;
        PG8_STAGE(PG8_SB(1, 0), cB + kstep, voffB); PG8_STAGE(PG8_SA(1, 0), cA + kstep, voffA); PG8_STAGE(PG8_SB(1, 1), cB + hstep + kstep, voffB);
        PG8_WAIT_V(6); PG8_BAR;
    }
    for (;;) {
        const bool has_next = S.next(ui + 1, nxt);
        const char* nA = has_next ? (const char*)g.A + (size_t)nxt.pm * tstep : cA; const char* nB = has_next ? (const char*)g.Bt + (size_t)nxt.pn * tstep : cB;
        for (int t = 0; t < nt; t += 2) {
            const bool last = (t == nt - 2);
            const char* a1 = cA + (size_t)(t + 1) * kstep;
            const char* a2 = last ? nA : cA + (size_t)(t + 2) * kstep; const char* b2 = last ? nB : cB + (size_t)(t + 2) * kstep;
            const char* a3 = a2 + kstep; const char* b3 = b2 + kstep;
            if (last && has_next) S.a_ready(nxt);
            if constexpr (SP2) {
            PG8_LDB(B0, 0, 0); PG8_LDB(B1, 0, 1); PG8_SCHED; PG8_LDA(At, 0, 0); PG8_STAGE(PG8_SA(1, 1), a1 + hstep, voffA);
            PG8_WAIT_V(8); PG8_WAIT_L(0); PG8_BAR; PG8_MMA(0, 0, At, B0); PG8_MMA(0, 1, At, B1); PG8_BAR; PG8_SCHED;
            PG8_LDA(At, 0, 1); PG8_STAGE(PG8_SB(0, 0), b2, voffB); PG8_STAGE(PG8_SB(0, 1), b2 + hstep, voffB); PG8_STAGE(PG8_SA(0, 0), a2, voffA);
            PG8_WAIT_V(8); PG8_WAIT_L(0); PG8_BAR; PG8_MMA(1, 0, At, B0); PG8_MMA(1, 1, At, B1); PG8_BAR; PG8_SCHED;
            PG8_LDB(B0, 1, 0); PG8_LDB(B1, 1, 1); PG8_SCHED; PG8_LDA(At, 1, 0); PG8_STAGE(PG8_SA(0, 1), a2 + hstep, voffA);
            PG8_WAIT_V(8); PG8_WAIT_L(0); PG8_BAR; PG8_MMA(0, 0, At, B0); PG8_MMA(0, 1, At, B1); PG8_BAR; PG8_SCHED;
            PG8_LDA(At, 1, 1); PG8_STAGE(PG8_SB(1, 0), b3, voffB); PG8_STAGE(PG8_SB(1, 1), b3 + hstep, voffB); PG8_STAGE(PG8_SA(1, 0), a3, voffA);
            PG8_WAIT_V(8); PG8_WAIT_L(0); PG8_BAR; PG8_MMA(1, 0, At, B0); PG8_MMA(1, 1, At, B1); PG8_BAR; PG8_SCHED;
            } else {
            PG8_LDB(B0, 0, 0); PG8_SCHED; PG8_LDA(At, 0, 0); PG8_STAGE(PG8_SA(1, 1), a1 + hstep, voffA);
            PG8_WAIT_L(8); PG8_BAR; PG8_WAIT_L(0); PG8_MMA(0, 0, At, B0); PG8_BAR; PG8_SCHED;
            PG8_LDB(B1, 0, 1); PG8_STAGE(PG8_SB(0, 0), b2, voffB);
            PG8_BAR; PG8_WAIT_L(0); PG8_MMA(0, 1, At, B1); PG8_BAR;
            PG8_LDA(At, 0, 1); PG8_STAGE(PG8_SA(0, 0), a2, voffA);
            PG8_BAR; PG8_WAIT_L(0); PG8_MMA(1, 0, At, B0); PG8_BAR; PG8_SCHED;
            PG8_STAGE(PG8_SB(0, 1), b2 + hstep, voffB);
            PG8_WAIT_V(6); PG8_BAR; PG8_MMA(1, 1, At, B1); PG8_BAR;
            PG8_LDB(B0, 1, 0); PG8_SCHED; PG8_LDA(At, 1, 0); PG8_STAGE(PG8_SA(0, 1), a2 + hstep, voffA);
            PG8_WAIT_L(8); PG8_BAR; PG8_WAIT_L(0); PG8_MMA(0, 0, At, B0); PG8_BAR; PG8_SCHED;
            PG8_LDB(B1, 1, 1); PG8_STAGE(PG8_SB(1, 0), b3, voffB);
            PG8_BAR; PG8_WAIT_L(0); PG8_MMA(0, 1, At, B1); PG8_BAR;
            PG8_LDA(At, 1, 1); PG8_STAGE(PG8_SA(1, 0), a3, voffA);
            PG8_BAR; PG8_WAIT_L(0); PG8_MMA(1, 0, At, B0); PG8_BAR; PG8_SCHED;
            PG8_STAGE(PG8_SB(1, 1), b3 + hstep, voffB);
            PG8_WAIT_V(6); PG8_BAR; PG8_MMA(1, 1, At, B1); PG8_BAR;
            }
        }
        if constexpr (ALIGN_EPI) { if (wr == 0) PG8_BAR; }
        if constexpr (!Epi::AFTER_DRAIN) { E(acc, cur, wr, wc, fr, fq); S.done(cur); }
        if (!has_next) break;
#pragma unroll
        for (int a = 0; a < 2; ++a)
#pragma unroll
            for (int b = 0; b < 2; ++b)
#pragma unroll
                for (int m = 0; m < 4; ++m)
#pragma unroll
                    for (int n = 0; n < 2; ++n) acc[a][b][m][n] = (f32x4){0.f, 0.f, 0.f, 0.f};
        cur = nxt; cA = nA; cB = nB; ++ui;
        if constexpr (ALIGN_EPI) { if (wr == 1) PG8_BAR; }
    }
    PG8_WAIT_V(0);
    if constexpr (!ALIGN_EPI) { if (wr == 0) PG8_BAR; }
    PG8_BAR;
    if constexpr (Epi::AFTER_DRAIN) { E.fused(acc, cur, wr, wc, fr, fq, lds, wid, lane); S.done(cur); }
#undef PG8_SA
#undef PG8_SB
#undef PG8_STAGE
#undef PG8_LDA
#undef PG8_LDB
#undef PG8_MMA
#undef PG8_WAIT_V
#undef PG8_WAIT_L
#undef PG8_BAR
#undef PG8_SCHED
}
}

using pg8::bf16_t; using pg8::f32x4; using pg8::u32x4; using pg8::Unit;
#define LAS __attribute__((address_space(3)))
#define GAS __attribute__((address_space(1)))

constexpr int DM = 1024, SEQ = 2048, BATCH = 16, DEPTH = 4, NIN = 3620, NTOK = BATCH * SEQ, YP = 3840;
constexpr float EPS = 1e-6f;
constexpr int O_DZ = 3200, O_DK = 3072, O_DV = 3136;
constexpr int YA_H = 0, YA_B = 256, YA_C = 512, YA_Z = 768, YB_U = 1024, YB_V = 1280, YB_Z = 1536, YC_Q = 1792, YC_K = 2048, YC_V = 2304,
              YC_Z = 2560, YD_Q = 2816, YD_Z = 3072, YD_K = 3328, YD_V = 3392, YI_Q = 3456, YI_K = 3584, YI_W = 3616;
constexpr int TOPK = 256;
constexpr int NGEMM = 3584;
constexpr int NT = 512, NW = 8;
constexpr int LDS_BYTES = 131072 + 4096 + 20480;

constexpr size_t MiB = 1u << 20;
constexpr size_t WS_WTIN = 1 * MiB;
constexpr size_t WS_WTOUT = WS_WTIN + (size_t)DEPTH * YP * DM * 2;
constexpr size_t WS_SSQ = WS_WTOUT + (size_t)DEPTH * DM * DM * 2;
constexpr size_t WS_XB = WS_SSQ + (size_t)NTOK * 16 * 4;
constexpr size_t WS_Y = WS_XB + (size_t)NTOK * DM * 2;
constexpr size_t WS_MIX = WS_Y + (size_t)NTOK * YP * 2;
constexpr size_t WS_WSB = WS_MIX + (size_t)NTOK * DM * 2;
constexpr size_t WS_END = WS_WSB + (size_t)DEPTH * 4 * 128 * 128 * 2;

constexpr size_t WS_SMALL = 65536;
constexpr int SM_CONVW = 0, SM_CONVB = 3072, SM_GMLPG = 4096, SM_GMLPB = 5120, SM_QG = 7168, SM_KG = 7296, SM_LAM = 7424, SM_SUBG = 7936, SM_DQG = 8960, SM_DKG = 9216, SM_END = 9472;
struct Params {
    const float* x; const float* norm_g; const float* w_in; const float* i_conv_w; const float* i_conv_b;
    const float* i_gmlp_g; const float* gmlp_ws; const float* i_gmlp_b; const float* i_diff_qg; const float* i_diff_kg;
    const float* i_diff_lam; const float* i_diff_subg; const float* i_dsa_qg; const float* i_dsa_kg; const float* w_out;
    float* out; unsigned char* ws;
    __device__ __forceinline__ unsigned* ctl() const { return (unsigned*)ws; }
    __device__ __forceinline__ const GAS float* sm(int off) const { return (const GAS float*)(uintptr_t)(ws + WS_SMALL) + off; }
    __device__ __forceinline__ bf16_t* wt_in() const { return (bf16_t*)(ws + WS_WTIN); }
    __device__ __forceinline__ bf16_t* wt_out() const { return (bf16_t*)(ws + WS_WTOUT); }
    __device__ __forceinline__ float* ssq() const { return (float*)(ws + WS_SSQ); }
    __device__ __forceinline__ bf16_t* xb() const { return (bf16_t*)(ws + WS_XB); }
    __device__ __forceinline__ bf16_t* Y() const { return (bf16_t*)(ws + WS_Y); }
    __device__ __forceinline__ bf16_t* mix() const { return (bf16_t*)(ws + WS_MIX); }
    __device__ __forceinline__ bf16_t* wsb() const { return (bf16_t*)(ws + WS_WSB); }
};

#ifndef TSEG
#define TSEG -1
#endif
constexpr int TCTR_OFF = 131072 + 3072;
#define TB(id, ldsbase, tidv) do { if (TSEG == (id) && blockIdx.x == 0 && (tidv) == 0) *(volatile LAS unsigned long long*)((ldsbase) + TCTR_OFF + 8) = __builtin_amdgcn_s_memrealtime(); } while (0)
#define TE(id, ldsbase, tidv) do { if (TSEG == (id) && blockIdx.x == 0 && (tidv) == 0) { const unsigned _d = (unsigned)(__builtin_amdgcn_s_memrealtime() - *(volatile LAS unsigned long long*)((ldsbase) + TCTR_OFF + 8)); *(volatile LAS unsigned*)((ldsbase) + TCTR_OFF) += _d; } } while (0)
__device__ __forceinline__ unsigned f2bf(float f) { unsigned u = __float_as_uint(f); return (u + 0x7fffu + ((u >> 16) & 1u)) >> 16; }
__device__ __forceinline__ unsigned pk2(float lo, float hi) { return f2bf(lo) | (f2bf(hi) << 16); }
__device__ __forceinline__ float bf2f(bf16_t b) { return __uint_as_float((unsigned)b << 16); }

__device__ __forceinline__ float xsum32(float v) { const auto r = __builtin_amdgcn_permlane32_swap(__float_as_uint(v), __float_as_uint(v), false, false); return __uint_as_float(r[0]) + __uint_as_float(r[1]); }
__device__ __forceinline__ float xmax32(float v) { const auto r = __builtin_amdgcn_permlane32_swap(__float_as_uint(v), __float_as_uint(v), false, false); return fmaxf(__uint_as_float(r[0]), __uint_as_float(r[1])); }
__device__ __forceinline__ int xsum32i(int v) { const auto r = __builtin_amdgcn_permlane32_swap((unsigned)v, (unsigned)v, false, false); return (int)(r[0] + r[1]); }
__device__ __forceinline__ float xsum16(float v) { const auto r = __builtin_amdgcn_permlane16_swap(__float_as_uint(v), __float_as_uint(v), false, false); return __uint_as_float(r[0]) + __uint_as_float(r[1]); }
__device__ __forceinline__ float wave_sum64(float v) {
    v += __uint_as_float(__builtin_amdgcn_update_dpp(0, __float_as_uint(v), 0x128, 0xf, 0xf, true));
    v += __uint_as_float(__builtin_amdgcn_update_dpp(0, __float_as_uint(v), 0x124, 0xf, 0xf, true));
    v += __uint_as_float(__builtin_amdgcn_update_dpp(0, __float_as_uint(v), 0x122, 0xf, 0xf, true));
    v += __uint_as_float(__builtin_amdgcn_update_dpp(0, __float_as_uint(v), 0x121, 0xf, 0xf, true));
    return xsum32(xsum16(v));
}
__device__ __forceinline__ float wave_sum(float v) {
#pragma unroll
    for (int o = 32; o > 0; o >>= 1) v += __shfl_xor(v, o);
    return v;
}
__device__ __forceinline__ float wave_max(float v) {
#pragma unroll
    for (int o = 32; o > 0; o >>= 1) v = fmaxf(v, __shfl_xor(v, o));
    return v;
}
__device__ __forceinline__ int wave_sumi(int v) {
#pragma unroll
    for (int o = 32; o > 0; o >>= 1) v += __shfl_xor(v, o);
    return v;
}
__device__ __forceinline__ float block_sum(float v, float* red) {
    v = wave_sum(v);
    __syncthreads();
    if ((threadIdx.x & 63) == 0) red[threadIdx.x >> 6] = v;
    __syncthreads();
    float s = 0.f;
#pragma unroll
    for (int i = 0; i < NW; ++i) s += red[i];
    return s;
}
__device__ __forceinline__ float block_max(float v, float* red) {
    v = wave_max(v);
    __syncthreads();
    if ((threadIdx.x & 63) == 0) red[threadIdx.x >> 6] = v;
    __syncthreads();
    float s = red[0];
#pragma unroll
    for (int i = 1; i < NW; ++i) s = fmaxf(s, red[i]);
    return s;
}
__device__ __forceinline__ int block_sumi(int v, int* red) {
    v = wave_sumi(v);
    __syncthreads();
    if ((threadIdx.x & 63) == 0) red[threadIdx.x >> 6] = v;
    __syncthreads();
    int s = 0;
#pragma unroll
    for (int i = 0; i < NW; ++i) s += red[i];
    return s;
}
__device__ __forceinline__ int block_excl_scan(int v, int* red, int* tot) {
    const int lane = threadIdx.x & 63, w = threadIdx.x >> 6;
    int inc = v;
#pragma unroll
    for (int o = 1; o < 64; o <<= 1) { int n = __shfl_up(inc, o); if (lane >= o) inc += n; }
    __syncthreads();
    if (lane == 63) red[w] = inc;
    __syncthreads();
    int base = 0, t = 0;
#pragma unroll
    for (int i = 0; i < NW; ++i) { if (i < w) base += red[i]; t += red[i]; }
    *tot = t;
    return base + inc - v;
}

__device__ __forceinline__ int phys2logical(int n) { const int p = n & 255; return (n & ~255) + 64 * ((p >> 5) & 3) + 32 * (p >> 7) + (p & 31); }
__device__ __forceinline__ int logical2orig(int n) {
    if (n < 3072) return n;
    if (n < YD_K) return n - YD_Z + O_DZ;
    if (n < YD_V) return n - YD_K + O_DK;
    if (n < YI_Q) return n - YD_V + O_DV;
    if (n < NIN) return n;
    return -1;
}
__device__ __forceinline__ void transpose_item(const float* W, int ldn, const float* gk, bf16_t* WT, int k0, int r0, int r1, int src, LAS float* scr, int lane) {
    float v[64];
#pragma unroll
    for (int i = 0; i < 64; ++i) v[i] = src >= 0 ? *(const GAS float*)(uintptr_t)(W + (size_t)(k0 + i) * ldn + src) : 0.f;
    const float gkl = gk ? *(const GAS float*)(uintptr_t)(gk + k0 + lane) : 1.f;
#pragma unroll
    for (int i = 0; i < 64; ++i) scr[i * 65 + lane] = v[i] * __uint_as_float(__builtin_amdgcn_readlane(__float_as_uint(gkl), i));
    asm volatile("s_waitcnt lgkmcnt(0)" ::: "memory");
#pragma unroll
    for (int q = 0; q < 8; ++q) {
        const int id = lane + 64 * q, j = id >> 3, c = id & 7;
        const LAS float* s = scr + (8 * c) * 65 + j;
        u32x4 o; o.x = pk2(s[0 * 65], s[1 * 65]); o.y = pk2(s[2 * 65], s[3 * 65]); o.z = pk2(s[4 * 65], s[5 * 65]); o.w = pk2(s[6 * 65], s[7 * 65]);
        *(GAS u32x4*)(uintptr_t)(WT + (size_t)((j < 32 ? r0 : r1 - 32) + j) * DM + k0 + 8 * c) = o;
    }
    asm volatile("s_waitcnt lgkmcnt(0)" ::: "memory");
}
__device__ __forceinline__ int tid_now(int wave_s) { int lane; asm volatile("v_mbcnt_lo_u32_b32 %0, -1, 0\n\tv_mbcnt_hi_u32_b32 %0, -1, %0" : "=v"(lane)); return wave_s * 64 + lane; }
__device__ __forceinline__ void convert_layer_weights(const Params& p, int l, LAS unsigned char* lds, int tid, int gw, int ngw) {
    const int lane = tid & 63, wave = tid >> 6;
    LAS float* scr = (LAS float*)(lds + wave * 16640);
    constexpr int I_IN = 16 * (YP / 64), I_OUT = 16 * (DM / 64);
    for (int itv = gw; itv < I_IN + I_OUT; itv += ngw) {
        const int it = __builtin_amdgcn_readfirstlane(itv);
        if (it < I_IN) {
            const int kb = it / (YP / 64), g = it % (YP / 64), tile = g >> 2, wc = g & 3;
            const int src = logical2orig(256 * tile + 64 * wc + lane);
            transpose_item(p.w_in + (size_t)l * DM * NIN, NIN, p.norm_g + l * DM, p.wt_in() + (size_t)l * YP * DM, kb * 64, 256 * tile + 32 * wc, 256 * tile + 128 + 32 * wc, src, scr, lane);
        } else {
            const int q = it - I_IN, kb = q / (DM / 64), g = q % (DM / 64);
            transpose_item(p.w_out + (size_t)l * DM * DM, DM, nullptr, p.wt_out() + (size_t)l * DM * DM, kb * 64, 64 * g, 64 * g + 32, 64 * g + lane, scr, lane);
        }
    }
}
__device__ __forceinline__ void ph_prologue(const Params& p, LAS unsigned char* lds, int tid_in) {
    int tid = tid_in; asm volatile("" : "+v"(tid));
    const int lane = tid & 63, wave = tid >> 6;
    const int gw = blockIdx.x * NW + wave, ngw = gridDim.x * NW;
    TB(22, lds, tid);
    convert_layer_weights(p, 0, lds, tid, gw, ngw);
    {
        float* sm = (float*)(p.ws + WS_SMALL);
        for (int i = blockIdx.x * NT + tid; i < SM_END; i += gridDim.x * NT) {
            float v;
            if (i < SM_CONVB) v = p.i_conv_w[i - SM_CONVW]; else if (i < SM_GMLPG) v = p.i_conv_b[i - SM_CONVB]; else if (i < SM_GMLPB) v = p.i_gmlp_g[i - SM_GMLPG];
            else if (i < SM_QG) v = p.i_gmlp_b[i - SM_GMLPB]; else if (i < SM_KG) v = p.i_diff_qg[i - SM_QG]; else if (i < SM_LAM) v = p.i_diff_kg[i - SM_KG];
            else if (i < SM_SUBG) v = p.i_diff_lam[i - SM_LAM]; else if (i < SM_DQG) v = p.i_diff_subg[i - SM_SUBG]; else if (i < SM_DKG) v = p.i_dsa_qg[i - SM_DQG];
            else v = p.i_dsa_kg[i - SM_DKG];
            sm[i] = v;
        }
    }
    for (int i = (blockIdx.x * NT + tid) * 4; i < DEPTH * 4 * 128 * 128; i += gridDim.x * NT * 4) {
        const f32x4 v = *(const GAS f32x4*)(uintptr_t)(p.gmlp_ws + i);
        *(GAS unsigned long long*)(uintptr_t)(p.wsb() + i) = (unsigned long long)pk2(v.x, v.y) | ((unsigned long long)pk2(v.z, v.w) << 32);
    }
    TE(22, lds, tid);
    TB(23, lds, tid);
    for (int r0 = gw * 4; r0 < NTOK; r0 += ngw * 4) {
        f32x4 v[4][4];
#pragma unroll
        for (int rr = 0; rr < 4; ++rr)
#pragma unroll
            for (int j = 0; j < 4; ++j) v[rr][j] = ((const GAS f32x4*)(uintptr_t)(p.x + (size_t)(r0 + rr) * DM))[lane + 64 * j];
#pragma unroll
        for (int rr = 0; rr < 4; ++rr) {
            GAS unsigned long long* o8 = (GAS unsigned long long*)(uintptr_t)(p.xb() + (size_t)(r0 + rr) * DM) + lane;
            float s = 0.f;
#pragma unroll
            for (int j = 0; j < 4; ++j) {
                const f32x4 q = v[rr][j];
                s += (q.x * q.x + q.y * q.y) + (q.z * q.z + q.w * q.w);
                o8[64 * j] = (unsigned long long)pk2(q.x, q.y) | ((unsigned long long)pk2(q.z, q.w) << 32);
            }
            s = wave_sum64(s);
            if (lane < 16) ((GAS float*)(uintptr_t)p.ssq())[(size_t)(r0 + rr) * 16 + lane] = lane == 0 ? s : 0.f;
        }
    }
    TE(23, lds, tid);
}

__device__ __forceinline__ float silu_f(float v) { return v * __builtin_amdgcn_rcpf(1.f + __builtin_amdgcn_exp2f(-1.4426950408889634f * v)); }
struct EpiIn {
    static constexpr bool PERM = true, AFTER_DRAIN = false;
    unsigned char* ws; int l; LAS float* rs;
    __device__ __forceinline__ void operator()(const f32x4 (&acc)[2][2][4][2], const Unit& u, int wr, int wc, int fr_, int fq_) const {
        int fr = fr_, fq = fq_; asm volatile("" : "+v"(fr), "+v"(fq));
        const int pn = u.pn;
        bf16_t* Y = (bf16_t*)(ws + WS_Y); const float* ssq = (const float*)(ws + WS_SSQ); const float* smb = (const float*)(ws + WS_SMALL);
        const float* gmlp_g = smb + SM_GMLPG + l * 256; const float* qg = smb + SM_QG + l * 32; const float* kg = smb + SM_KG + l * 32;
        const float* dqg = smb + SM_DQG + l * 64; const float* dkg = smb + SM_DKG + l * 64;
        int op = 0; const float* g0 = nullptr; const float* g1 = nullptr; float qs = 1.f;
        if (pn == 4) op = 2;
        else if (pn == 5) { op = 3; g0 = gmlp_g + 64 * wc + 8 * fq; g1 = g0 + 32; }
        else if (pn == 7) { op = 4; g0 = qg + 8 * fq; g1 = g0; qs = 0.17677669529663687f * 1.4426950408889634f; }
        else if (pn == 8) { op = 4; g0 = kg + 8 * fq; g1 = g0; }
        else if (pn == 11) { op = 5; g0 = dqg + 8 * fq; g1 = g0 + 32; qs = 0.125f * 1.4426950408889634f; }
        else if (pn == 13 && wc == 0) { op = 5; g0 = dkg + 8 * fq; g1 = g0 + 32; }
        float gn[16];
#pragma unroll
        for (int i = 0; i < 16; ++i) gn[i] = 1.f;
        if (op >= 3) {
            const f32x4 a = *(const GAS f32x4*)(uintptr_t)g0, b = *(const GAS f32x4*)(uintptr_t)(g0 + 4), c = *(const GAS f32x4*)(uintptr_t)g1, d = *(const GAS f32x4*)(uintptr_t)(g1 + 4);
            gn[0] = a.x; gn[1] = a.y; gn[2] = a.z; gn[3] = a.w; gn[4] = b.x; gn[5] = b.y; gn[6] = b.z; gn[7] = b.w;
            gn[8] = c.x; gn[9] = c.y; gn[10] = c.z; gn[11] = c.w; gn[12] = d.x; gn[13] = d.y; gn[14] = d.z; gn[15] = d.w;
        }
        const int colb = pn * 256 + 64 * wc + 8 * fq;
        TB(14, (LAS unsigned char*)rs - (131072 + 1024), wr * 256 + wc * 64 + fq * 16 + fr);
        {
            volatile LAS int* lastpm = (volatile LAS int*)((LAS unsigned char*)rs - 256);
            const bool fresh = __builtin_amdgcn_readfirstlane(*lastpm) != u.pm;
            if (fresh) {
                const int t = wr * 256 + wc * 64 + fq * 16 + fr;
                if (t < 256) {
                    const f32x4* sp = (const f32x4*)(ssq + (size_t)(u.pm * 256 + t) * 16);
                    const f32x4 s0 = sp[0], s1 = sp[1], s2 = sp[2], s3 = sp[3];
                    const float tot = ((s0.x + s0.y) + (s0.z + s0.w)) + ((s1.x + s1.y) + (s1.z + s1.w)) + ((s2.x + s2.y) + (s2.z + s2.w)) + ((s3.x + s3.y) + (s3.z + s3.w));
                    rs[t] = rsqrtf(tot * (1.f / DM) + EPS);
                }
                asm volatile("s_waitcnt vmcnt(0) lgkmcnt(0)" ::: "memory"); __builtin_amdgcn_s_barrier(); asm volatile("" ::: "memory");
                if (t == 0) *lastpm = u.pm;
            }
        }
#pragma unroll
        for (int ai = 0; ai < 2; ++ai)
#pragma unroll
            for (int m = 0; m < 4; ++m) {
                const int row = u.pm * 256 + ai * 128 + wr * 64 + m * 16 + fr;
                const float rstd = rs[ai * 128 + wr * 64 + m * 16 + fr];
                float v[16];
#pragma unroll
                for (int bj = 0; bj < 2; ++bj)
#pragma unroll
                    for (int n = 0; n < 2; ++n)
#pragma unroll
                        for (int e = 0; e < 4; ++e) v[bj * 8 + n * 4 + e] = acc[ai][bj][m][n][e] * rstd;
                if (op == 1) {
#pragma unroll
                    for (int i = 0; i < 16; ++i) v[i] = silu_f(v[i]);
                } else if (op == 2 || op == 3) {
#pragma unroll
                    for (int i = 0; i < 16; i += 2) { const pg8::f32x2 r = pg8::gelu_pk((pg8::f32x2){v[i], v[i + 1]}); v[i] = r.x; v[i + 1] = r.y; }
                }
                if (op == 3 || op == 5) {
                    float ss = 0.f;
#pragma unroll
                    for (int i = 0; i < 16; ++i) ss += v[i] * v[i];
                    ss = xsum16(ss); ss = xsum32(ss);
                    const float sc = rsqrtf(ss * (1.f / 64) + EPS) * qs;
#pragma unroll
                    for (int i = 0; i < 16; ++i) v[i] *= sc * gn[i];
                } else if (op == 4) {
#pragma unroll
                    for (int bj = 0; bj < 2; ++bj) {
                        float ss = 0.f;
#pragma unroll
                        for (int i = 0; i < 8; ++i) ss += v[bj * 8 + i] * v[bj * 8 + i];
                        ss = xsum16(ss); ss = xsum32(ss);
                        const float sc = rsqrtf(ss * (1.f / 32) + EPS) * qs;
#pragma unroll
                        for (int i = 0; i < 8; ++i) v[bj * 8 + i] *= sc * gn[bj * 8 + i];
                    }
                }
                bf16_t* rowp = Y + (size_t)row * YP + colb;
#pragma unroll
                for (int bj = 0; bj < 2; ++bj) {
                    u32x4 w; w.x = pg8::cvt_pk_bf16(v[bj * 8 + 0], v[bj * 8 + 1]); w.y = pg8::cvt_pk_bf16(v[bj * 8 + 2], v[bj * 8 + 3]);
                    w.z = pg8::cvt_pk_bf16(v[bj * 8 + 4], v[bj * 8 + 5]); w.w = pg8::cvt_pk_bf16(v[bj * 8 + 6], v[bj * 8 + 7]);
                    *(GAS u32x4*)(uintptr_t)(rowp + 32 * bj) = w;
                }
            }
        TE(14, (LAS unsigned char*)rs - (131072 + 1024), wr * 256 + wc * 64 + fq * 16 + fr);
    }
};
struct EpiOut {
    static constexpr bool PERM = false, AFTER_DRAIN = false;
    float* xout; unsigned char* ws;
    __device__ __forceinline__ void operator()(const f32x4 (&acc)[2][2][4][2], const Unit& u, int wr, int wc, int fr_, int fq_) const {
        int fr = fr_, fq = fq_; asm volatile("" : "+v"(fr), "+v"(fq));
        const int col0 = u.pn * 256 + wc * 32 + 4 * fq;
        const int pc = u.pn * 256 + wc * 32 + 4 * (fq & 2) + 16 * (fq & 1);
        bf16_t* xb = (bf16_t*)(ws + WS_XB); float* ssq = (float*)(ws + WS_SSQ);
        u32x4 Lr[2][4][2];
#pragma unroll
        for (int ai = 0; ai < 2; ++ai)
#pragma unroll
            for (int m = 0; m < 4; ++m)
#pragma unroll
                for (int bj = 0; bj < 2; ++bj)
                    Lr[ai][m][bj] = *(const GAS u32x4*)(uintptr_t)(xb + (size_t)(u.pm * 256 + ai * 128 + wr * 64 + m * 16 + fr) * DM + pc + bj * 128);
        asm volatile("" ::: "memory");
#pragma unroll
        for (int ai = 0; ai < 2; ++ai)
#pragma unroll
            for (int m = 0; m < 4; ++m) {
                const int row = u.pm * 256 + ai * 128 + wr * 64 + m * 16 + fr;
                float sq = 0.f;
#pragma unroll
                for (int bj = 0; bj < 2; ++bj) {
                    const u32x4 L = Lr[ai][m][bj];
                    const auto ra = __builtin_amdgcn_permlane16_swap(L.x, L.z, false, false), rb = __builtin_amdgcn_permlane16_swap(L.y, L.w, false, false);
                    f32x4 v0 = acc[ai][bj][m][0], v1 = acc[ai][bj][m][1];
                    v0.x += __uint_as_float(ra[0] << 16); v0.y += __uint_as_float(ra[0] & 0xffff0000u); v0.z += __uint_as_float(rb[0] << 16); v0.w += __uint_as_float(rb[0] & 0xffff0000u);
                    v1.x += __uint_as_float(ra[1] << 16); v1.y += __uint_as_float(ra[1] & 0xffff0000u); v1.z += __uint_as_float(rb[1] << 16); v1.w += __uint_as_float(rb[1] & 0xffff0000u);
                    sq += ((v0.x * v0.x + v0.y * v0.y) + (v0.z * v0.z + v0.w * v0.w)) + ((v1.x * v1.x + v1.y * v1.y) + (v1.z * v1.z + v1.w * v1.w));
                    if (xout) {
                        const size_t off = (size_t)row * DM + col0 + bj * 128;
                        *(GAS f32x4*)(uintptr_t)(xout + off) = v0; *(GAS f32x4*)(uintptr_t)(xout + off + 16) = v1;
                    } else {
                        const auto sa = __builtin_amdgcn_permlane16_swap(pg8::cvt_pk_bf16(v0.x, v0.y), pg8::cvt_pk_bf16(v1.x, v1.y), false, false),
                                   sb = __builtin_amdgcn_permlane16_swap(pg8::cvt_pk_bf16(v0.z, v0.w), pg8::cvt_pk_bf16(v1.z, v1.w), false, false);
                        *(GAS u32x4*)(uintptr_t)(xb + (size_t)row * DM + pc + bj * 128) = (u32x4){sa[0], sb[0], sa[1], sb[1]};
                    }
                }
                sq = xsum16(sq); sq = xsum32(sq);
                if (fq == 0) ssq[(size_t)row * 16 + u.pn * 4 + wc] = sq;
            }
    }
};
#define XB_TMO      128
#define XB_XCNT(j)  (256  + 64 * (j))
#define XB_XSUB(j)  (1280 + 64 * (j))
#define XB_XGEN(j)  (2304 + 64 * (j))
#define XB_TOP      3328
#define XB_TOPGEN   3392
#define XCD_BAR_WORDS 3456
#define XB_SPIN_CAP (1u << 18)

__device__ __forceinline__ unsigned xb_ld(unsigned* p)              { return __hip_atomic_load(p, __ATOMIC_RELAXED, __HIP_MEMORY_SCOPE_AGENT); }
__device__ __forceinline__ unsigned xb_add(unsigned* p, unsigned v) { return __hip_atomic_fetch_add(p, v, __ATOMIC_RELAXED, __HIP_MEMORY_SCOPE_AGENT); }
__device__ __forceinline__ unsigned xb_xcc_id() { return (unsigned)__builtin_amdgcn_s_getreg((3 << 11) | 20) & 0xFu; }
#define XB_SPIN(cond, bar) do { unsigned _sp = 0; while (cond) { __builtin_amdgcn_s_sleep(1); \
    if ((++_sp & 255u) == 0u) { if (xb_ld(&(bar)[XB_TMO])) break; if (_sp > XB_SPIN_CAP) { atomicAdd(&(bar)[XB_TMO], 1u); break; } } } } while (0)

struct XcdBarrier {
    unsigned* bar; unsigned x;
    volatile LAS unsigned* st;
};

__device__ __forceinline__ XcdBarrier xcd_barrier_post(unsigned* bar, volatile LAS unsigned* st) {
    XcdBarrier b; b.bar = bar; b.x = xb_xcc_id(); b.st = st;
    if (threadIdx.x == 0) (void)xb_add(&bar[XB_XCNT(b.x)], 1u);
    return b;
}
__device__ __forceinline__ void xcd_barrier_complete(unsigned* bar, unsigned x, unsigned& nloc, unsigned& nx) {
    const unsigned G = gridDim.x * gridDim.y * gridDim.z;
    unsigned sum, cnt, mine, sp = 0u;
    for (;;) {
        sum = 0u; cnt = 0u; mine = 0u;
#pragma unroll
        for (unsigned j = 0; j < 16; ++j) { const unsigned c = xb_ld(&bar[XB_XCNT(j)]); sum += c; cnt += (c > 0u) ? 1u : 0u; mine = (j == x) ? c : mine; }
        if (sum == G) break;
        __builtin_amdgcn_s_sleep(1);
        if ((++sp & 255u) == 0u) { if (xb_ld(&bar[XB_TMO])) break; if (sp > XB_SPIN_CAP) { atomicAdd(&bar[XB_TMO], 1u); break; } }
    }
    nloc = mine > 0u ? mine : 1u; nx = cnt > 0u ? cnt : 1u;
}

__device__ __forceinline__ void xcd_barrier(const XcdBarrier& b, int tid_in) {
    asm volatile("s_waitcnt vmcnt(0)" ::: "memory");
    __syncthreads();
    int t0_ = tid_in; asm volatile("" : "+v"(t0_));
    if (t0_ == 0) {
        unsigned* bar = b.bar; unsigned bx = b.x; asm volatile("" : "+s"(bar), "+s"(bx));
        __builtin_amdgcn_s_waitcnt(0);
        unsigned nloc = b.st[0], nx = b.st[1];
        if (nloc == 0u) { xcd_barrier_complete(bar, bx, nloc, nx); b.st[0] = nloc; b.st[1] = nx; }
        const unsigned old = xb_add(&bar[XB_XSUB(bx)], 1u);
        const unsigned gen = old / nloc;
        if (old + 1u == (gen + 1u) * nloc) {
            __builtin_amdgcn_fence(__ATOMIC_RELEASE, "agent");
            asm volatile("s_waitcnt vmcnt(0)" ::: "memory");
            const unsigned og = xb_add(&bar[XB_TOP], 1u);
            const unsigned tg = og / nx;
            if (og + 1u == (tg + 1u) * nx) xb_add(&bar[XB_TOPGEN], 1u);
            else XB_SPIN(xb_ld(&bar[XB_TOPGEN]) == tg, bar);
            __builtin_amdgcn_fence(__ATOMIC_ACQUIRE, "agent");
            xb_add(&bar[XB_XGEN(bx)], 1u);
            asm volatile("s_waitcnt vmcnt(0)" ::: "memory");
        } else {
            XB_SPIN(xb_ld(&bar[XB_XGEN(bx)]) == gen, bar);
            __builtin_amdgcn_fence(__ATOMIC_ACQUIRE, "agent");
            asm volatile("s_waitcnt vmcnt(0)" ::: "memory");
        }
    }
    __syncthreads();
}

#define XB_GCNT(g)  (3456 + 32 * (g))
#define XB_GGEN(g)  (3472 + 32 * (g))
#define XB_CONV     3712
#define XB_XT       3728
__device__ __forceinline__ void grp_barrier(unsigned* ctl, int g, volatile LAS unsigned* st, int tid_in) {
    asm volatile("s_waitcnt vmcnt(0)" ::: "memory");
    __syncthreads();
    int t0_ = tid_in; asm volatile("" : "+v"(t0_));
    if (t0_ == 0) {
        unsigned* bar = ctl; int gg = g; asm volatile("" : "+s"(bar), "+s"(gg));
        __builtin_amdgcn_s_waitcnt(0);
        if (st[2] == 0u) { __builtin_amdgcn_fence(__ATOMIC_RELEASE, "agent"); asm volatile("s_waitcnt vmcnt(0)" ::: "memory"); }
        const unsigned old = xb_add(&bar[XB_GCNT(gg)], 1u), gen = old >> 5;
        if ((old & 31u) == 31u) xb_add(&bar[XB_GGEN(gg)], 1u);
        else XB_SPIN(xb_ld(&bar[XB_GGEN(gg)]) == gen, bar);
        __builtin_amdgcn_fence(__ATOMIC_ACQUIRE, "agent");
        asm volatile("s_waitcnt vmcnt(0)" ::: "memory");
    }
    __syncthreads();
}

typedef short bf16x8_t __attribute__((ext_vector_type(8)));
typedef short s16x4_t __attribute__((ext_vector_type(4)));
typedef float f32x16 __attribute__((ext_vector_type(16)));
typedef float f32x2_t __attribute__((ext_vector_type(2)));
typedef __bf16 bf16x2_t __attribute__((ext_vector_type(2)));
#define MFMA32(a, b, c) __builtin_amdgcn_mfma_f32_32x32x16_bf16((a), (b), (c), 0, 0, 0)
__device__ __forceinline__ unsigned cvtpk(float lo, float hi) { f32x2_t v = {lo, hi}; bf16x2_t b = __builtin_convertvector(v, bf16x2_t); return __builtin_bit_cast(unsigned, b); }
__device__ __forceinline__ s16x4_t ds_tr16(const LAS unsigned char* p) { return __builtin_bit_cast(s16x4_t, __builtin_amdgcn_ds_read_tr16_b64_v4i16((LAS s16x4_t*)p)); }
__device__ __forceinline__ bf16x8_t pack_step(const f32x16& x, int s) {
    u32x4 p; p.x = cvtpk(x[8 * s], x[8 * s + 1]); p.y = cvtpk(x[8 * s + 2], x[8 * s + 3]); p.z = cvtpk(x[8 * s + 4], x[8 * s + 5]); p.w = cvtpk(x[8 * s + 6], x[8 * s + 7]);
    return __builtin_bit_cast(bf16x8_t, p);
}
constexpr int KV_STRIDE = 144;
constexpr int KV_TILE = 64 * KV_STRIDE;
__device__ __forceinline__ bf16x8_t vt_frag(const LAS unsigned char* vtile, int ks, int db, int lane) {
    const int i16 = lane & 15, q = i16 >> 2, pp = i16 & 3, blk = (lane >> 4) & 1, hh = lane >> 5;
    const LAS unsigned char* a = vtile + (16 * ks + 4 * hh + q) * KV_STRIDE + (32 * db + 16 * blk + 4 * pp) * 2;
    const s16x4_t lo = ds_tr16(a), hi = ds_tr16(a + 8 * KV_STRIDE);
    return __builtin_shufflevector(lo, hi, 0, 1, 2, 3, 4, 5, 6, 7);
}

constexpr int KVL_TILE = 64 * 128;
__device__ __forceinline__ void dma_piece(const bf16_t* src_row0, LAS unsigned char* dst, int lane) {
    const bf16_t* g = src_row0 + (size_t)(lane >> 3) * YP + (((lane & 7) ^ (lane >> 3)) * 8);
    const unsigned d = (unsigned)__builtin_amdgcn_readfirstlane((int)(unsigned)(size_t)dst);
    unsigned keep;
    asm volatile("s_mov_b32 %0, m0\n\ts_mov_b32 m0, %2\n\ts_nop 0\n\tglobal_load_lds_dwordx4 %1, off\n\ts_mov_b32 m0, %0" : "=&s"(keep) : "v"(g), "s"(d) : "memory");
}
__device__ __forceinline__ bf16x8_t vt_frag_sw(const LAS unsigned char* vtile, int ks, int db, int lane) {
    const int i16 = lane & 15, q = i16 >> 2, pp = i16 & 3, blk = (lane >> 4) & 1, hh = lane >> 5;
    const int row = 16 * ks + 4 * hh + q, ch = 4 * db + 2 * blk + (pp >> 1);
    const LAS unsigned char* a = vtile + row * 128 + ((ch ^ (row & 7)) * 16) + (pp & 1) * 8;
    const s16x4_t lo = ds_tr16(a), hi = ds_tr16(a + 8 * 128);
    return __builtin_shufflevector(lo, hi, 0, 1, 2, 3, 4, 5, 6, 7);
}

__device__ __forceinline__ void store_pair16(bf16_t* rowp, int g0, unsigned a0, unsigned a1, unsigned b0, unsigned b1, int hh) {
    const unsigned s0 = hh ? a0 : b0, s1 = hh ? a1 : b1;
    const auto r0 = __builtin_amdgcn_permlane32_swap(s0, s0, false, false), r1 = __builtin_amdgcn_permlane32_swap(s1, s1, false, false);
    const unsigned q0 = hh ? r0[0] : r0[1], q1 = hh ? r1[0] : r1[1];
    u32x4 w;
    w.x = hh ? q0 : a0; w.y = hh ? q1 : a1; w.z = hh ? b0 : q0; w.w = hh ? b1 : q1;
    *(GAS u32x4*)(uintptr_t)(rowp + 8 * (g0 + (hh ? 1 : 0))) = w;
}

__device__ __forceinline__ void mixC_unit(const Params& p, int l, int b, int h, int qt, LAS unsigned char* lds, int wave_s) {
    const int tid = tid_now(wave_s);
    volatile LAS float* pc = (volatile LAS float*)(lds + 131072 + 2048);
    const float mfix = pc[0];
    const int lane = tid & 63, wave = __builtin_amdgcn_readfirstlane(tid >> 6), r32 = lane & 31, hh = lane >> 5;
    const size_t rowb = (size_t)b * SEQ;
    const int q0 = qt * 256 + wave * 32;
    const int cw = (q0 >> 6);
    const int jmax = 4 * qt + 3;
    const int pos = q0 + r32;
    const bf16_t* yq = p.Y() + (rowb + pos) * YP;
    bf16x8_t qf[2][2];
#pragma unroll
    for (int c = 0; c < 2; ++c)
#pragma unroll
        for (int s = 0; s < 2; ++s) qf[c][s] = *(const GAS bf16x8_t*)(uintptr_t)(yq + YC_Q + h * 64 + c * 32 + 16 * s + 8 * hh);
    const float sl2 = exp2f(-(float)(2 * h + 1)) * 1.4426950408889634f;
    f32x16 o[2][2];
#pragma unroll
    for (int c = 0; c < 2; ++c)
#pragma unroll
        for (int d = 0; d < 2; ++d)
#pragma unroll
            for (int i = 0; i < 16; ++i) o[c][d][i] = 0.f;
    f32x16 lacc;
#pragma unroll
    for (int i = 0; i < 16; ++i) lacc[i] = 0.f;
    bf16x8_t one0, one1;
    { const unsigned lo = r32 < 16 ? 0x3f803f80u : 0u, hi = r32 < 16 ? 0u : 0x3f803f80u;
      one0 = __builtin_bit_cast(bf16x8_t, (u32x4){lo, lo, lo, lo}); one1 = __builtin_bit_cast(bf16x8_t, (u32x4){hi, hi, hi, hi}); }
    bf16x8_t kext;
    {
        const float t = sl2 * (float)r32;
        const unsigned u = cvtpk(t, 0.f), v = cvtpk(t - __uint_as_float(u << 16), 0.f);
        u32x4 w; w.x = hh ? 0u : (u | (v << 16)); w.y = hh ? 0u : 0x3f803f80u; w.z = hh ? 0u : 0x00003f80u; w.w = 0u;
        kext = __builtin_bit_cast(bf16x8_t, w);
    }
    const bf16_t* ksrc = p.Y() + (rowb + 8 * wave) * YP + YC_K + h * 64;
    const bf16_t* vsrc = p.Y() + (rowb + 8 * wave) * YP + YC_V + h * 64;
    LAS unsigned char* kring = lds;
    LAS unsigned char* vring = lds + 6 * KVL_TILE;
    asm volatile("" : "+v"(qf[0][0]), "+v"(qf[0][1]), "+v"(qf[1][0]), "+v"(qf[1][1]));
    LAS unsigned char* qpark = lds + 12 * KVL_TILE + wave * 4096 + lane * 16;
    const float mfix_r = mfix; asm volatile("" :: "v"(mfix_r));
    asm volatile("s_waitcnt lgkmcnt(0)" ::: "memory"); __builtin_amdgcn_s_barrier(); asm volatile("" ::: "memory");
#pragma unroll
    for (int t = 0; t < 4; ++t) { dma_piece(ksrc + (size_t)t * 64 * YP, kring + t * KVL_TILE + wave * 1024, lane); dma_piece(vsrc + (size_t)t * 64 * YP, vring + t * KVL_TILE + wave * 1024, lane); }
#pragma unroll
    for (int f = 0; f < 4; ++f) *(LAS bf16x8_t*)(qpark + f * 1024) = qf[f >> 1][f & 1];
    int slot = 0, slot2 = 4;
    if (wave >= 4) __builtin_amdgcn_s_setprio(1);
    for (int j = 0; j <= jmax; ++j) {
        if ((j & 1) == 0) {
            TB(3, lds, tid);
            if (j + 2 <= jmax) asm volatile("s_waitcnt vmcnt(4)" ::: "memory"); else asm volatile("s_waitcnt vmcnt(0)" ::: "memory");
            __builtin_amdgcn_s_barrier(); asm volatile("" ::: "memory");
            if (j + 4 <= jmax) {
#pragma unroll
                for (int t = 0; t < 2; ++t) {
                    const int sl = slot2 + t >= 6 ? slot2 + t - 6 : slot2 + t;
                    dma_piece(ksrc + (size_t)(j + 4 + t) * 64 * YP, kring + sl * KVL_TILE + wave * 1024, lane); dma_piece(vsrc + (size_t)(j + 4 + t) * 64 * YP, vring + sl * KVL_TILE + wave * 1024, lane);
                }
            }
            TE(3, lds, tid);
        }
        TB(2, lds, tid);
        if (j <= cw) {
            const LAS unsigned char* kt = kring + slot * KVL_TILE;
            const LAS unsigned char* vt = vring + slot * KVL_TILE;
            const bool diag = (j == cw);
            bf16x8_t qext[2];
#pragma unroll
            for (int kb = 0; kb < 2; ++kb) {
                const float cj = fmaf(sl2, (float)(64 * j + 32 * kb - pos), -mfix);
                const unsigned u = cvtpk(cj, 0.f); const float r1 = cj - __uint_as_float(u << 16);
                const unsigned v = cvtpk(r1, 0.f), x = cvtpk(r1 - __uint_as_float(v << 16), 0.f);
                const bool off = hh != 0 || diag;
                u32x4 w; w.x = off ? 0u : 0x3f803f80u; w.y = off ? 0u : (u | (v << 16)); w.z = off ? 0u : x; w.w = 0u;
                qext[kb] = __builtin_bit_cast(bf16x8_t, w);
            }
            unsigned ka = (unsigned)(size_t)kt + (unsigned)(r32 * 128 + ((hh ^ (r32 & 7)) * 16)); asm volatile("" : "+v"(ka));
            f32x16 sc[2][2];
            {
                bf16x8_t kfa[2][2], kfb[2][2], qa[2], qb[2];
#pragma unroll
                for (int s = 0; s < 2; ++s) qa[s] = *(const LAS bf16x8_t*)(qpark + s * 1024);
#pragma unroll
                for (int kb = 0; kb < 2; ++kb)
#pragma unroll
                    for (int s = 0; s < 2; ++s) kfa[kb][s] = *(const LAS bf16x8_t*)(size_t)((ka ^ (unsigned)(32 * s)) + 4096u * kb);
                __builtin_amdgcn_sched_barrier(0);
#pragma unroll
                for (int kb = 0; kb < 2; ++kb)
#pragma unroll
                    for (int s = 0; s < 2; ++s) kfb[kb][s] = *(const LAS bf16x8_t*)(size_t)((ka ^ (unsigned)(64 + 32 * s)) + 4096u * kb);
#pragma unroll
                for (int s = 0; s < 2; ++s) qb[s] = *(const LAS bf16x8_t*)(qpark + (2 + s) * 1024);
#pragma unroll
                for (int c = 0; c < 2; ++c)
#pragma unroll
                    for (int kb = 0; kb < 2; ++kb) {
                        f32x16 z;
#pragma unroll
                        for (int i = 0; i < 16; ++i) z[i] = 0.f;
                        sc[c][kb] = MFMA32(kext, qext[kb], z);
                    }
#pragma unroll
                for (int s = 0; s < 2; ++s)
#pragma unroll
                    for (int kb = 0; kb < 2; ++kb) sc[0][kb] = MFMA32(kfa[kb][s], qa[s], sc[0][kb]);
                __builtin_amdgcn_sched_barrier(0);
#pragma unroll
                for (int s = 0; s < 2; ++s)
#pragma unroll
                    for (int kb = 0; kb < 2; ++kb) sc[1][kb] = MFMA32(kfb[kb][s], qb[s], sc[1][kb]);
            }
            __builtin_amdgcn_sched_barrier(0);
            bf16x8_t pf[2][4];
#pragma unroll
            for (int c = 0; c < 2; ++c) {
                if (!diag) {
#pragma unroll
                    for (int kb = 0; kb < 2; ++kb)
#pragma unroll
                        for (int i = 0; i < 16; ++i) sc[c][kb][i] = __builtin_amdgcn_exp2f(sc[c][kb][i]);
                } else {
                    const float pl = (float)(pos - 64 * j - 4 * hh);
#pragma unroll
                    for (int kb = 0; kb < 2; ++kb)
#pragma unroll
                        for (int i = 0; i < 16; ++i) {
                            const float kc = (float)(32 * kb + (i & 3) + 8 * (i >> 2));
                            sc[c][kb][i] = __builtin_amdgcn_exp2f(sc[c][kb][i] + fmaf(-sl2, fabsf(pl - kc), -mfix));
                        }
                }
#pragma unroll
                for (int ks = 0; ks < 4; ++ks) pf[c][ks] = pack_step(sc[c][ks >> 1], ks & 1);
            }
            __builtin_amdgcn_sched_barrier(0);
#pragma unroll
            for (int ks = 0; ks < 4; ++ks) {
                const bf16x8_t a0 = vt_frag_sw(vt, ks, 0, lane), a1 = vt_frag_sw(vt, ks, 1, lane);
                o[0][0] = MFMA32(a0, pf[0][ks], o[0][0]); o[1][0] = MFMA32(a0, pf[1][ks], o[1][0]);
                o[0][1] = MFMA32(a1, pf[0][ks], o[0][1]); o[1][1] = MFMA32(a1, pf[1][ks], o[1][1]);
                lacc = MFMA32(one0, pf[0][ks], lacc); lacc = MFMA32(one1, pf[1][ks], lacc);
                __builtin_amdgcn_sched_barrier(0);
            }
        }
        TE(2, lds, tid);
        slot = slot == 5 ? 0 : slot + 1; slot2 = slot2 == 5 ? 0 : slot2 + 1;
    }
    __builtin_amdgcn_s_setprio(0);
    const float lam = pc[1], oml = pc[2];
    const int tid2 = tid_now(wave_s), lane2 = tid2 & 63, r32e = lane2 & 31, hhe = lane2 >> 5;
    const int pose = qt * 256 + wave * 32 + r32e;
    const bf16_t* yqe = p.Y() + (rowb + pose) * YP;
    const float l1 = lacc[0], l2 = lacc[8];
    const float i1 = 1.f / l1, i2 = lam / l2;
    float ss = 0.f;
#pragma unroll
    for (int d = 0; d < 2; ++d)
#pragma unroll
        for (int i = 0; i < 16; ++i) { const float v = o[0][d][i] * i1 - o[1][d][i] * i2; o[0][d][i] = v; ss += v * v; }
    ss = xsum32(ss);
    const float rn = rsqrtf(ss * (1.f / 64) + EPS) * oml;
    const GAS float* sg = p.sm(SM_SUBG) + l * 256 + h * 64;
    bf16_t* mrow = p.mix() + (rowb + pose) * DM + 512 + h * 64;
    f32x4 gvv[2][4]; unsigned long long zzv[2][4];
#pragma unroll
    for (int d = 0; d < 2; ++d)
#pragma unroll
        for (int g = 0; g < 4; ++g) {
            const int d0 = 32 * d + 8 * g + 4 * hhe;
            gvv[d][g] = *(const GAS f32x4*)(uintptr_t)(sg + d0);
            zzv[d][g] = *(const GAS unsigned long long*)(uintptr_t)(yqe + YC_Z + h * 64 + d0);
        }
    asm volatile("" ::: "memory");
#pragma unroll
    for (int d = 0; d < 2; ++d) {
        unsigned pk00, pk01, pk10, pk11, pk20, pk21, pk30, pk31;
#pragma unroll
        for (int g = 0; g < 4; ++g) {
            const f32x4 gv = gvv[d][g];
            const unsigned long long zz = zzv[d][g];
            const float z0 = silu_f(__uint_as_float((unsigned)(zz & 0xffffu) << 16)), z1 = silu_f(__uint_as_float((unsigned)((zz >> 16) & 0xffffu) << 16)),
                        z2 = silu_f(__uint_as_float((unsigned)((zz >> 32) & 0xffffu) << 16)), z3 = silu_f(__uint_as_float((unsigned)((zz >> 48) & 0xffffu) << 16));
            const float v0 = o[0][d][4 * g] * rn * gv.x * z0, v1 = o[0][d][4 * g + 1] * rn * gv.y * z1, v2 = o[0][d][4 * g + 2] * rn * gv.z * z2, v3 = o[0][d][4 * g + 3] * rn * gv.w * z3;
            const unsigned pa = cvtpk(v0, v1), pb = cvtpk(v2, v3);
            if (g == 0) { pk00 = pa; pk01 = pb; } else if (g == 1) { pk10 = pa; pk11 = pb; } else if (g == 2) { pk20 = pa; pk21 = pb; } else { pk30 = pa; pk31 = pb; }
        }
        store_pair16(mrow + 32 * d, 0, pk00, pk01, pk10, pk11, hhe);
        store_pair16(mrow + 32 * d, 2, pk20, pk21, pk30, pk31, hhe);
    }
}
__device__ __forceinline__ void ph_mixC(const Params& p, int l, LAS unsigned char* lds, int bid, int nb, int wave_s) {
    {
        const float lam_init = l == 0 ? 0.200000001f : l == 1 ? 0.355509068f : l == 2 ? 0.470713018f : 0.556058204f;
        const GAS float* lp = p.sm(SM_LAM) + l * 128;
        float d1 = 0.f, d2 = 0.f;
        for (int i = 0; i < 32; ++i) { d1 += lp[i] * lp[32 + i]; d2 += lp[64 + i] * lp[96 + i]; }
        float gq = 0.f, gk = 0.f;
        for (int i = 0; i < 32; ++i) { gq = fmaxf(gq, fabsf(p.sm(SM_QG)[l * 32 + i])); gk = fmaxf(gk, fabsf(p.sm(SM_KG)[l * 32 + i])); }
        volatile LAS float* pc = (volatile LAS float*)(lds + 131072 + 2048);
        if (tid_now(wave_s) == 0) {
            pc[0] = 0.17677669529663687f * 1.4426950408889634f * 32.f * gq * gk * 1.02f;
            pc[1] = expf(d1) - expf(d2) + lam_init;
            pc[2] = 1.f - lam_init;
        }
        __syncthreads();
    }
    for (int i = bid; i < 256; i += nb) {
#pragma unroll 1
        for (int k = 0; k < 2; ++k) {
            const int qa = (i >> 2) & 3;
            mixC_unit(p, l, i >> 4, i & 3, k == 0 ? 7 - qa : qa, lds, wave_s);
        }
    }
}

constexpr int SC_STRIDE = 2052;
constexpr int SC_BYTES = 16 * SC_STRIDE * 4;
constexpr int IK_STRIDE = 80, IK_TILE = 64 * IK_STRIDE;
constexpr int MSK_QSTRIDE = 520;
constexpr int DMN_OFF = 131072 + 1024, DB2_OFF = 131072 + 2048 + 16;
constexpr int MSK_OFF0 = 131072 + 4096, MSK_OFF1 = 65536;
__device__ __forceinline__ unsigned fkey(float f) { const unsigned u = __float_as_uint(f); return u ^ ((unsigned)((int)u >> 31) | 0x80000000u); }
__device__ __forceinline__ float unfkey(unsigned k) { return __uint_as_float((k & 0x80000000u) ? (k & 0x7fffffffu) : ~k); }
__device__ __forceinline__ f32x16 idx_scores(const bf16x8_t ik0, const bf16x8_t ik1, const bf16x8_t (&iqf)[4][2], const float (&w)[4]) {
    f32x16 sc;
#pragma unroll
    for (int i = 0; i < 16; ++i) sc[i] = 0.f;
#pragma unroll
    for (int hd = 0; hd < 4; ++hd) {
        f32x16 a;
#pragma unroll
        for (int i = 0; i < 16; ++i) a[i] = 0.f;
        a = MFMA32(ik0, iqf[hd][0], a);
        a = MFMA32(ik1, iqf[hd][1], a);
#pragma unroll
        for (int i = 0; i < 16; ++i) sc[i] = fmaf(w[hd], __builtin_amdgcn_fmed3f(a[i], 0.f, 3.0e38f), sc[i]);
    }
    return sc;
}
template <int K0, int K1> __device__ __forceinline__ void transpose_bits(unsigned (&a)[32]);
__device__ __forceinline__ void transpose32(unsigned (&a)[32]) {
#pragma unroll
    for (int k = 0; k < 16; ++k) {
        const unsigned x = a[k], y = a[k + 16];
        a[k] = __builtin_amdgcn_perm(x, y, 0x07060302u); a[k + 16] = __builtin_amdgcn_perm(x, y, 0x05040100u);
        asm volatile("" : "+v"(a[k]), "+v"(a[k + 16]));
    }
#pragma unroll
    for (int k = 0; k < 32; ++k)
        if ((k & 8) == 0) {
            const unsigned x = a[k], y = a[k + 8];
            a[k] = __builtin_amdgcn_perm(x, y, 0x07030501u); a[k + 8] = __builtin_amdgcn_perm(x, y, 0x06020400u);
            asm volatile("" : "+v"(a[k]), "+v"(a[k + 8]));
        }
    transpose_bits<0, 24>(a);
}
template <int K0, int K1>
__device__ __forceinline__ void transpose_bits(unsigned (&a)[32]) {
#pragma unroll
    for (int s = 2; s < 5; ++s) {
        const int j = 16 >> s;
        const unsigned mk = j == 4 ? 0x0f0f0f0fu : j == 2 ? 0x33333333u : 0x55555555u;
#pragma unroll
        for (int k = K0; k < K1; ++k)
            if ((k & j) == 0) {
                const unsigned x = a[k], y = a[k + j];
                a[k] = (mk & (y >> j)) | (~mk & x); a[k + j] = (mk & y) | (~mk & (x << j));
                asm volatile("" : "+v"(a[k]), "+v"(a[k + j]));
            }
    }
}
__device__ __forceinline__ int rowsum16(int v) {
    v += __builtin_amdgcn_update_dpp(0, v, 0x128, 0xf, 0xf, true);
    v += __builtin_amdgcn_update_dpp(0, v, 0x124, 0xf, 0xf, true);
    v += __builtin_amdgcn_update_dpp(0, v, 0x122, 0xf, 0xf, true);
    v += __builtin_amdgcn_update_dpp(0, v, 0x121, 0xf, 0xf, true);
    return v;
}
__device__ __forceinline__ unsigned topbits(int ne) { return ne <= 0 ? 0u : ne >= 32 ? 0xffffffffu : (0xffffffffu << (32 - ne)); }
template <int NG, int BT>
__device__ __forceinline__ void rs2_bit(const unsigned (&pl)[NG][32], unsigned (&alive)[NG], unsigned (&gt)[NG], int& above, unsigned long long& dmask) {
    int c1 = 0;
    unsigned cw[NG];
#pragma unroll
    for (int j = 0; j < NG; ++j) { cw[j] = alive[j] & pl[j][BT]; asm volatile("" : "+v"(cw[j])); c1 += __popc(cw[j]); }
    const int t1 = above + rowsum16(c1);
    const bool take = t1 >= TOPK;
    unsigned m = take ? 0xffffffffu : 0u; asm volatile("" : "+v"(m));
#pragma unroll
    for (int j = 0; j < NG; ++j) {
        gt[j] |= cw[j] & ~m;
        alive[j] = (alive[j] & ~m) ^ cw[j];
        asm volatile("" : "+v"(gt[j]), "+v"(alive[j]));
    }
    above = take ? above : t1;
    dmask |= __builtin_amdgcn_ballot_w64(t1 == TOPK);
}
template <int NG, int ST>
__device__ __forceinline__ void rs4_row(unsigned (&pl)[NG][32], unsigned (&alive)[NG], unsigned (&gt)[NG], int& above, unsigned long long& dmask) {
    if (dmask != ~0ull) {
        if constexpr (ST == 12) {
#pragma unroll
            for (int j = 0; j < NG; ++j) {
                transpose_bits<24, 32>(pl[j]);
                const unsigned S = ~pl[j][0];
#pragma unroll
                for (int i = 24; i < 32; ++i) pl[j][i] ^= S;
            }
        }
        rs2_bit<NG, 2 * ST>(pl, alive, gt, above, dmask);
        rs2_bit<NG, 2 * ST + 1>(pl, alive, gt, above, dmask);
    }
    if constexpr (ST < 15) rs4_row<NG, ST + 1>(pl, alive, gt, above, dmask);
}
template <int NG>
__device__ __forceinline__ void d1_pass(const Params& p, size_t rowb, int c, int sp, LAS unsigned char* lds, int wave_s) {
    const int tid = tid_now(wave_s);
    const int lane = tid & 63, wave = __builtin_amdgcn_readfirstlane(tid >> 6), r32 = lane & 31, hh = lane >> 5;
    const int q0 = c * 64, ntile = c + 1;
    constexpr int SKS = 1028;
    constexpr int NRD = (NG + 1) / 2;
    LAS unsigned* sk = (LAS unsigned*)lds;
    const int nblk = 2 * ntile;
    const int nbw = (nblk - wave + 7) >> 3;
    const int nv = 4 * ntile;
    TB(4, lds, tid); TB(5, lds, tid);
    unsigned kr[NG][32];
    unsigned zopq = 0u; asm volatile("" : "+v"(zopq));
    {
        const bf16_t* yq1 = p.Y() + (rowb + q0 + 32 * sp + r32) * YP;
        bf16x8_t iqf[4][2];
#pragma unroll
        for (int hd = 0; hd < 4; ++hd)
#pragma unroll
            for (int s = 0; s < 2; ++s) iqf[hd][s] = *(const GAS bf16x8_t*)(uintptr_t)(yq1 + YI_Q + hd * 32 + 16 * s + 8 * hh);
        float w[4];
        const unsigned long long ww = *(const GAS unsigned long long*)(uintptr_t)(yq1 + YI_W);
#pragma unroll
        for (int hd = 0; hd < 4; ++hd) w[hd] = __uint_as_float((unsigned)((ww >> (16 * hd)) & 0xffffu) << 16) * (0.17677669529663687f * 0.5f);
        bf16x8_t ik[2 * NG][2];
#pragma unroll
        for (int i = 0; i < 2 * NG; ++i) {
            const int kb = i < nbw ? wave + 8 * i : wave;
            const bf16_t* yk = p.Y() + (rowb + 32 * kb + r32) * YP + YI_K + 8 * hh;
            ik[i][0] = *(const GAS bf16x8_t*)(uintptr_t)yk; ik[i][1] = *(const GAS bf16x8_t*)(uintptr_t)(yk + 16);
        }
#pragma unroll
        for (int blk = 0; blk < 2 * NG; ++blk) {
            if (blk < nbw) {
                const f32x16 sc = idx_scores(ik[blk][0], ik[blk][1], iqf, w);
#pragma unroll
                for (int r = 0; r < 16; ++r) kr[blk >> 1][16 * (blk & 1) + r] = __float_as_uint(sc[r]);
            } else {
#pragma unroll
                for (int r = 0; r < 16; ++r) kr[blk >> 1][16 * (blk & 1) + r] = zopq;
            }
        }
    }
    TE(5, lds, tid); TB(20, lds, tid);
    unsigned pl[NG][32];
    {
        const int rq = 4 * wave + (lane >> 4), rt = lane & 15;
#pragma unroll
        for (int rd = 0; rd < NRD; ++rd) {
#pragma unroll
            for (int i = 0; i < 4; ++i)
                if (4 * rd + i < 2 * NG) {
#pragma unroll
                    for (int g = 0; g < 4; ++g) {
                        const int blk = 4 * rd + i;
                        u32x4 v; v.x = kr[blk >> 1][16 * (blk & 1) + 4 * g]; v.y = kr[blk >> 1][16 * (blk & 1) + 4 * g + 1]; v.z = kr[blk >> 1][16 * (blk & 1) + 4 * g + 2]; v.w = kr[blk >> 1][16 * (blk & 1) + 4 * g + 3];
                        *(LAS u32x4*)(sk + r32 * SKS + 32 * wave + 256 * i + 8 * g + 4 * hh) = v;
                    }
                }
            __syncthreads();
#pragma unroll
            for (int M = 0; M < 16; ++M)
                if (2 * rd + (M >> 3) < NG) {
                    const u32x4 v = *(const LAS u32x4*)(sk + rq * SKS + 64 * M + 4 * rt);
                    pl[2 * rd + (M >> 3)][4 * (M & 7)] = v.x; pl[2 * rd + (M >> 3)][4 * (M & 7) + 1] = v.y; pl[2 * rd + (M >> 3)][4 * (M & 7) + 2] = v.z; pl[2 * rd + (M >> 3)][4 * (M & 7) + 3] = v.w;
                }
            __syncthreads();
        }
    }
    TE(20, lds, tid); TB(6, lds, tid);
#pragma unroll
    for (int j = 0; j < NG; ++j) {
        transpose32(pl[j]);
        const unsigned S = pl[j][0];
#pragma unroll
        for (int i = 1; i < 24; ++i) pl[j][i] ^= S;
        pl[j][0] = ~S;
    }
    TE(6, lds, tid); TB(7, lds, tid);
    unsigned alive[NG], gt[NG];
#pragma unroll
    for (int j = 0; j < NG; ++j) { alive[j] = topbits(nv - 32 * j); gt[j] = 0u; }
    int above = 0; unsigned long long dmask = 0ull;
    rs4_row<NG, 0>(pl, alive, gt, above, dmask);
    const bool done = ((dmask >> lane) & 1ull) != 0ull;
    TE(7, lds, tid); TB(8, lds, tid);
    int kcut = 1 << 20;
    if (dmask != ~0ull) {
        const int need = TOPK - above, rt = lane & 15;
        int posk = 0;
#pragma unroll 1
        for (int b2 = 10; b2 >= 0; --b2) {
            const int tt = posk | (1 << b2);
            const int R = tt - 4 * rt;
            const int M = R <= 0 ? 0 : 4 * (R >> 6) + min(R & 63, 4);
            int cnt = 0;
#pragma unroll
            for (int j = 0; j < NG; ++j) cnt += __popc(alive[j] & topbits(M - 32 * j));
            const int f = rowsum16(cnt);
            if (f < need) posk = tt;
        }
        if (!done) kcut = posk;
    }
    {
        const int rt = lane & 15, R = kcut + 1 - 4 * rt;
        const int Mc = R <= 0 ? 0 : 4 * (R >> 6) + min(R & 63, 4);
        LAS unsigned char* mq = lds + (sp == 0 ? MSK_OFF0 : MSK_OFF1) + (4 * wave + (lane >> 4)) * MSK_QSTRIDE + ((rt >> 3) * 2 + (rt & 1)) * 4 + ((rt >> 1) & 3);
        unsigned sel[NG];
#pragma unroll
        for (int j = 0; j < NG; ++j) sel[j] = __builtin_bitreverse32(gt[j] | (alive[j] & topbits(Mc - 32 * j)));
#pragma unroll
        for (int j = 0; j < NG; ++j)
#pragma unroll
            for (int n = 0; n < 8; ++n) *(LAS unsigned char*)(mq + (8 * j + n) * 16) = (unsigned char)(sel[j] >> (4 * n));
        const int rq = 32 * sp + 4 * wave + (lane >> 4);
        int dmin = 1 << 20;
#pragma unroll
        for (int j = 0; j < NG; ++j) {
            const int nlo = 4 * c - 32 * j;
            const unsigned w = sel[j] & (nlo <= 0 ? 0u : nlo >= 32 ? 0xffffffffu : ((1u << nlo) - 1u));
            if (w) { const int s = 32 * j + 31 - __builtin_clz(w); dmin = 64 * c + rq - (64 * (s >> 2) + 4 * rt + (s & 3)); }
        }
        const unsigned nib = (sel[NG - 1] >> (4 * (c & 7))) & 15u;
#pragma unroll
        for (int e = 0; e < 4; ++e) if (nib & (1u << e)) dmin = min(dmin, abs(rq - 4 * rt - e));
        dmin = min(dmin, __builtin_amdgcn_update_dpp(0, dmin, 0x128, 0xf, 0xf, true));
        dmin = min(dmin, __builtin_amdgcn_update_dpp(0, dmin, 0x124, 0xf, 0xf, true));
        dmin = min(dmin, __builtin_amdgcn_update_dpp(0, dmin, 0x122, 0xf, 0xf, true));
        dmin = min(dmin, __builtin_amdgcn_update_dpp(0, dmin, 0x121, 0xf, 0xf, true));
        if (rt == 0) *(LAS float*)(lds + DMN_OFF + 4 * rq) = (float)dmin;
    }
    TE(8, lds, tid); TE(4, lds, tid);
    __syncthreads();
}
__device__ __forceinline__ void mixD_attend(const Params& p, int b, int c, LAS unsigned char* lds, int wave_s);
__device__ __forceinline__ void mixD_unit(const Params& p, int b, int c, LAS unsigned char* lds, int wave_s) {
    const size_t rowb = (size_t)b * SEQ;
    __syncthreads();
    if (c >= 4) {
#pragma unroll 1
        for (int sp = 0; sp < 2; ++sp) {
            const int ng = (c >> 3) + 1;
            if (ng == 1) d1_pass<1>(p, rowb, c, sp, lds, wave_s);
            else if (ng == 2) d1_pass<2>(p, rowb, c, sp, lds, wave_s);
            else if (ng == 3) d1_pass<3>(p, rowb, c, sp, lds, wave_s);
            else d1_pass<4>(p, rowb, c, sp, lds, wave_s);
        }
    }
    mixD_attend(p, b, c, lds, wave_s);
}
__device__ __forceinline__ void mixD_attend(const Params& p, int b, int c, LAS unsigned char* lds, int wave_s) {
    const int tid = tid_now(wave_s);
    const int lane = tid & 63, wave = __builtin_amdgcn_readfirstlane(tid >> 6), r32 = lane & 31, hh = lane >> 5;
    const size_t rowb = (size_t)b * SEQ;
    const int q0 = c * 64, ntile = c + 1;
    const bool dosel = c >= 4;
    TB(9, lds, tid);
    const int qg = wave >> 2, hd = wave & 3;
    const int pos = q0 + 32 * qg + r32;
    const bf16_t* yq = p.Y() + (rowb + pos) * YP;
    bf16x8_t qf[4];
#pragma unroll
    for (int s = 0; s < 4; ++s) qf[s] = *(const GAS bf16x8_t*)(uintptr_t)(yq + YD_Q + hd * 64 + 16 * s + 8 * hh);
    const float sl2 = exp2f(-(float)(2 * hd + 2)) * 1.4426950408889634f;
    f32x16 o[2];
#pragma unroll
    for (int d = 0; d < 2; ++d)
#pragma unroll
        for (int i = 0; i < 16; ++i) o[d][i] = 0.f;
    const float mref = fmaf(-sl2, dosel ? *(volatile LAS float*)(lds + DMN_OFF + 4 * (32 * qg + r32)) : 0.f, *(volatile LAS float*)(lds + DB2_OFF));
    float lrun = 0.f;
    bf16x8_t kext[2];
#pragma unroll
    for (int kb = 0; kb < 2; ++kb) {
        const float t = sl2 * (float)(32 * kb + r32);
        const unsigned u = cvtpk(t, 0.f), v = cvtpk(t - __uint_as_float(u << 16), 0.f);
        u32x4 w; w.x = hh ? 0u : (u | (v << 16)); w.y = hh ? 0u : 0x3f803f80u; w.z = hh ? 0u : 0x00003f80u; w.w = 0u;
        kext[kb] = __builtin_bit_cast(bf16x8_t, w);
    }
    const int npair = (ntile + 1) >> 1;
    const bf16_t* ksrc = p.Y() + (rowb + 8 * wave) * YP + YD_K;
    const bf16_t* vsrc = p.Y() + (rowb + 8 * wave) * YP + YD_V;
    LAS unsigned char* kring = lds;
    LAS unsigned char* vring = lds + 4 * KVL_TILE;
    const LAS unsigned char* mq = lds + (qg == 0 ? MSK_OFF0 : MSK_OFF1) + r32 * MSK_QSTRIDE + 4 * hh;
    asm volatile("" : "+v"(qf[0]), "+v"(qf[1]), "+v"(qf[2]), "+v"(qf[3]));
    __syncthreads();
#pragma unroll
    for (int tt = 0; tt < 2; ++tt) {
        const int t = min(tt, ntile - 1);
        dma_piece(ksrc + (size_t)t * 64 * YP, kring + tt * KVL_TILE + wave * 1024, lane); dma_piece(vsrc + (size_t)t * 64 * YP, vring + tt * KVL_TILE + wave * 1024, lane);
    }
    if (wave >= 4) __builtin_amdgcn_s_setprio(1);
    for (int pp = 0; pp < npair; ++pp) {
        const int cur = pp & 1;
        const bool more = pp + 1 < npair;
        TB(12, lds, tid);
        asm volatile("s_waitcnt vmcnt(0) lgkmcnt(0)" ::: "memory"); __builtin_amdgcn_s_barrier(); asm volatile("" ::: "memory");
        TE(12, lds, tid);
        if (more) {
#pragma unroll
            for (int tt = 0; tt < 2; ++tt) {
                const int t = min(2 * (pp + 1) + tt, ntile - 1);
                dma_piece(ksrc + (size_t)t * 64 * YP, kring + ((cur ^ 1) * 2 + tt) * KVL_TILE + wave * 1024, lane); dma_piece(vsrc + (size_t)t * 64 * YP, vring + ((cur ^ 1) * 2 + tt) * KVL_TILE + wave * 1024, lane);
            }
        }
        TB(11, lds, tid);
#pragma unroll 1
        for (int tt = 0; tt < 2; ++tt) {
            const int j = 2 * pp + tt;
            if (j < ntile) {
                const LAS unsigned char* kt = kring + (cur * 2 + tt) * KVL_TILE;
                const LAS unsigned char* vt = vring + (cur * 2 + tt) * KVL_TILE;
                const bool diag = (j == c);
                unsigned selb[2] = {0xffffffffu, 0xffffffffu};
                if (dosel) { selb[0] = *(const LAS unsigned*)(mq + 16 * j); selb[1] = *(const LAS unsigned*)(mq + 16 * j + 8); }
                bf16x8_t qext;
                {
                    const float cj = fmaf(sl2, (float)(64 * j - pos), -mref);
                    const unsigned u = cvtpk(cj, 0.f); const float r1 = cj - __uint_as_float(u << 16);
                    const unsigned v = cvtpk(r1, 0.f), x = cvtpk(r1 - __uint_as_float(v << 16), 0.f);
                    const bool off = hh != 0 || diag;
                    u32x4 w; w.x = off ? 0u : 0x3f803f80u; w.y = off ? 0u : (u | (v << 16)); w.z = off ? 0u : x; w.w = 0u;
                    qext = __builtin_bit_cast(bf16x8_t, w);
                }
                bf16x8_t kf[2][4];
#pragma unroll
                for (int kb = 0; kb < 2; ++kb)
#pragma unroll
                    for (int s = 0; s < 4; ++s) kf[kb][s] = *(const LAS bf16x8_t*)(kt + (32 * kb + r32) * 128 + (((2 * s + hh) ^ (r32 & 7)) * 16));
                __builtin_amdgcn_sched_barrier(0);
                f32x16 sc[2];
#pragma unroll
                for (int kb = 0; kb < 2; ++kb) {
                    f32x16 z;
#pragma unroll
                    for (int i = 0; i < 16; ++i) z[i] = 0.f;
                    sc[kb] = MFMA32(kext[kb], qext, z);
                }
#pragma unroll
                for (int s = 0; s < 4; ++s)
#pragma unroll
                    for (int kb = 0; kb < 2; ++kb) sc[kb] = MFMA32(kf[kb][s], qf[s], sc[kb]);
                bf16x8_t vf0 = vt_frag_sw(vt, 0, 0, lane), vf1 = vt_frag_sw(vt, 0, 1, lane);
                __builtin_amdgcn_sched_barrier(0);
#pragma unroll
                for (int kb = 0; kb < 2; ++kb) {
                    if (diag) {
                        const float pl = (float)(pos - 64 * j - 4 * hh);
#pragma unroll
                        for (int i = 0; i < 16; ++i) { const float kc = (float)(32 * kb + (i & 3) + 8 * (i >> 2)); sc[kb][i] += fmaf(-sl2, fabsf(pl - kc), -mref); }
                    }
#pragma unroll
                    for (int i = 0; i < 16; ++i) {
                        unsigned t; asm("v_bfe_i32 %0, %1, %2, 1" : "=v"(t) : "v"(selb[kb]), "n"(8 * (i >> 2) + (i & 3)));
                        sc[kb][i] = __uint_as_float(__float_as_uint(__builtin_amdgcn_exp2f(sc[kb][i])) & t);
                    }
                }
                f32x2_t l01 = {0.f, 0.f}, l23 = {0.f, 0.f};
#pragma unroll
                for (int kb = 0; kb < 2; ++kb)
#pragma unroll
                    for (int g = 0; g < 4; ++g) { l01 += (f32x2_t){sc[kb][4 * g], sc[kb][4 * g + 1]}; l23 += (f32x2_t){sc[kb][4 * g + 2], sc[kb][4 * g + 3]}; }
                lrun += (l01.x + l01.y) + (l23.x + l23.y);
                bf16x8_t pf[4];
#pragma unroll
                for (int ks = 0; ks < 4; ++ks) pf[ks] = pack_step(sc[ks >> 1], ks & 1);
                __builtin_amdgcn_sched_barrier(0);
#pragma unroll
                for (int ks = 0; ks < 4; ++ks) {
                    const bf16x8_t a0 = vf0, a1 = vf1;
                    if (ks < 3) { vf0 = vt_frag_sw(vt, ks + 1, 0, lane); vf1 = vt_frag_sw(vt, ks + 1, 1, lane); }
                    o[0] = MFMA32(a0, pf[ks], o[0]); o[1] = MFMA32(a1, pf[ks], o[1]);
                    __builtin_amdgcn_sched_barrier(0);
                }
            }
        }
        TE(11, lds, tid);
    }
    __builtin_amdgcn_s_setprio(0);
    TE(9, lds, tid);
    const float inv = 1.f / xsum32(lrun);
    bf16_t* mrow = p.mix() + (rowb + pos) * DM + 768 + hd * 64;
    unsigned long long zzv[2][4];
#pragma unroll
    for (int d = 0; d < 2; ++d)
#pragma unroll
        for (int g = 0; g < 4; ++g) zzv[d][g] = *(const GAS unsigned long long*)(uintptr_t)(yq + YD_Z + hd * 64 + 32 * d + 8 * g + 4 * hh);
    asm volatile("" ::: "memory");
#pragma unroll
    for (int d = 0; d < 2; ++d) {
        unsigned pk00, pk01, pk10, pk11, pk20, pk21, pk30, pk31;
#pragma unroll
        for (int g = 0; g < 4; ++g) {
            const unsigned long long zz = zzv[d][g];
            const float z0 = silu_f(__uint_as_float((unsigned)(zz & 0xffffu) << 16)), z1 = silu_f(__uint_as_float((unsigned)((zz >> 16) & 0xffffu) << 16)),
                        z2 = silu_f(__uint_as_float((unsigned)((zz >> 32) & 0xffffu) << 16)), z3 = silu_f(__uint_as_float((unsigned)((zz >> 48) & 0xffffu) << 16));
            const unsigned pa = cvtpk(o[d][4 * g] * inv * z0, o[d][4 * g + 1] * inv * z1), pb = cvtpk(o[d][4 * g + 2] * inv * z2, o[d][4 * g + 3] * inv * z3);
            if (g == 0) { pk00 = pa; pk01 = pb; } else if (g == 1) { pk10 = pa; pk11 = pb; } else if (g == 2) { pk20 = pa; pk21 = pb; } else { pk30 = pa; pk31 = pb; }
        }
        store_pair16(mrow + 32 * d, 0, pk00, pk01, pk10, pk11, hh);
        store_pair16(mrow + 32 * d, 2, pk20, pk21, pk30, pk31, hh);
    }
}
__device__ __forceinline__ void ph_mixD(const Params& p, int l, LAS unsigned char* lds, int bid, int nb, int wave_s) {
    {
        float gq = 0.f, gk = 0.f;
        for (int i = 0; i < 64; ++i) { gq = fmaxf(gq, fabsf(p.sm(SM_DQG)[l * 64 + i])); gk = fmaxf(gk, fabsf(p.sm(SM_DKG)[l * 64 + i])); }
        if (tid_now(wave_s) == 0) *(volatile LAS float*)(lds + DB2_OFF) = 0.125f * 1.4426950408889634f * 64.f * gq * gk * 1.02f;
        __syncthreads();
    }
    for (int i = bid; i < 256; i += nb) {
        const int b = i >> 4, cc = i & 15;
#pragma unroll 1
        for (int k = 0; k < 2; ++k) mixD_unit(p, b, k == 0 ? 31 - cc : cc, lds, wave_s);
    }
}

constexpr int VN_STRIDE = 528;
__device__ __forceinline__ float bflo(unsigned u) { return __uint_as_float(u << 16); }
__device__ __forceinline__ float bfhi(unsigned u) { return __uint_as_float(u & 0xffff0000u); }
__device__ __forceinline__ u32x4 unpair16(const u32x4 w, int hh) {
    const unsigned s0 = hh ? w.x : w.z, s1 = hh ? w.y : w.w;
    const auto r0 = __builtin_amdgcn_permlane32_swap(s0, s0, false, false), r1 = __builtin_amdgcn_permlane32_swap(s1, s1, false, false);
    const unsigned q0 = hh ? r0[0] : r0[1], q1 = hh ? r1[0] : r1[1];
    u32x4 o; o.x = hh ? q0 : w.x; o.y = hh ? q1 : w.y; o.z = hh ? w.z : q0; o.w = hh ? w.w : q1;
    return o;
}
__device__ __forceinline__ void mixAB_unit(const Params& p, int l, int b, int n, LAS unsigned char* lds, int tid) {
    const int lane = tid & 63, wave = __builtin_amdgcn_readfirstlane(tid >> 6), r32 = lane & 31, hh = lane >> 5;
    const size_t row0 = (size_t)b * SEQ + 128 * n;
    __syncthreads();
#pragma unroll
    for (int k = 0; k < 8; ++k) {
        const int ch = tid + 512 * k, r = ch >> 5, c16 = ch & 31;
        *(LAS u32x4*)(lds + r * VN_STRIDE + c16 * 16) = *(const GAS u32x4*)(uintptr_t)(p.Y() + (row0 + r) * YP + YB_V + c16 * 8);
    }
    {
        const int cg8 = (tid & 31) * 8, t0 = (tid >> 5) * 8;
        const int pos0 = 128 * n + t0;
        const GAS float* cw = p.sm(SM_CONVW) + l * 768 + cg8;
        float w0[8], w1[8], w2[8], cb[8];
#pragma unroll
        for (int e = 0; e < 8; ++e) { w0[e] = cw[e]; w1[e] = cw[256 + e]; w2[e] = cw[512 + e]; cb[e] = p.sm(SM_CONVB)[l * 256 + cg8 + e]; }
        float um2[8], um1[8];
#pragma unroll
        for (int e = 0; e < 8; ++e) { um2[e] = 0.f; um1[e] = 0.f; }
#pragma unroll
        for (int back = 2; back >= 1; --back) {
            if (pos0 - back >= 0) {
                const bf16_t* yr = p.Y() + (row0 + t0 - back) * YP;
                const u32x4 hc = *(const GAS u32x4*)(uintptr_t)(yr + YA_H + cg8), cc = *(const GAS u32x4*)(uintptr_t)(yr + YA_C + cg8);
                float u[8] = {bflo(hc.x) * bflo(cc.x), bfhi(hc.x) * bfhi(cc.x), bflo(hc.y) * bflo(cc.y), bfhi(hc.y) * bfhi(cc.y),
                              bflo(hc.z) * bflo(cc.z), bfhi(hc.z) * bfhi(cc.z), bflo(hc.w) * bflo(cc.w), bfhi(hc.w) * bfhi(cc.w)};
#pragma unroll
                for (int e = 0; e < 8; ++e) { if (back == 2) um2[e] = u[e]; else um1[e] = u[e]; }
            }
        }
        u32x4 hcv[8], ccv[8], bgq[8], zgq[8];
#pragma unroll
        for (int tt = 0; tt < 8; ++tt) {
            const bf16_t* yr = p.Y() + (row0 + t0 + tt) * YP;
            hcv[tt] = *(const GAS u32x4*)(uintptr_t)(yr + YA_H + cg8); ccv[tt] = *(const GAS u32x4*)(uintptr_t)(yr + YA_C + cg8);
            bgq[tt] = *(const GAS u32x4*)(uintptr_t)(yr + YA_B + cg8); zgq[tt] = *(const GAS u32x4*)(uintptr_t)(yr + YA_Z + cg8);
        }
#pragma unroll
        for (int tt = 0; tt < 8; ++tt) {
            const u32x4 hc = hcv[tt], cc = ccv[tt], bg = bgq[tt], zg = zgq[tt];
            const float u[8] = {bflo(hc.x) * bflo(cc.x), bfhi(hc.x) * bfhi(cc.x), bflo(hc.y) * bflo(cc.y), bfhi(hc.y) * bfhi(cc.y),
                                bflo(hc.z) * bflo(cc.z), bfhi(hc.z) * bfhi(cc.z), bflo(hc.w) * bflo(cc.w), bfhi(hc.w) * bfhi(cc.w)};
            const float bgv[8] = {bflo(bg.x), bfhi(bg.x), bflo(bg.y), bfhi(bg.y), bflo(bg.z), bfhi(bg.z), bflo(bg.w), bfhi(bg.w)};
            const float zgv[8] = {silu_f(bflo(zg.x)), silu_f(bfhi(zg.x)), silu_f(bflo(zg.y)), silu_f(bfhi(zg.y)), silu_f(bflo(zg.z)), silu_f(bfhi(zg.z)), silu_f(bflo(zg.w)), silu_f(bfhi(zg.w))};
            float ov[8];
#pragma unroll
            for (int e = 0; e < 8; ++e) {
                const float conv = w0[e] * um2[e] + w1[e] * um1[e] + w2[e] * u[e];
                ov[e] = bgv[e] * (conv + cb[e]) * zgv[e];
                um2[e] = um1[e]; um1[e] = u[e];
            }
            u32x4 ow; ow.x = cvtpk(ov[0], ov[1]); ow.y = cvtpk(ov[2], ov[3]); ow.z = cvtpk(ov[4], ov[5]); ow.w = cvtpk(ov[6], ov[7]);
            *(GAS u32x4*)(uintptr_t)(p.mix() + (row0 + t0 + tt) * DM + cg8) = ow;
        }
    }
    __syncthreads();
    {
        int tq = tid; asm volatile("" : "+v"(tq));
        const int lane = tq & 63, r32 = lane & 31, hh = lane >> 5;
        const int h = wave >> 1, th = wave & 1;
        const int nks = th == 0 ? 4 : 8;
        f32x16 acc[2][2];
#pragma unroll
        for (int a = 0; a < 2; ++a)
#pragma unroll
            for (int d = 0; d < 2; ++d)
#pragma unroll
                for (int i = 0; i < 16; ++i) acc[a][d][i] = 0.f;
        const bf16_t* wb = p.wsb() + ((size_t)(l * 4 + h) * 128 + 64 * th + r32) * 128 + 8 * hh;
        const int i16 = lane & 15, q = i16 >> 2, pp = i16 & 3, blk = (lane >> 4) & 1;
        const LAS unsigned char* va = lds + (8 * hh + q) * VN_STRIDE + (h * 64 + 16 * blk + 4 * pp) * 2;
        bf16x8_t bfr[8][2];
#pragma unroll
        for (int ks = 0; ks < 8; ++ks)
#pragma unroll
            for (int tb = 0; tb < 2; ++tb) bfr[ks][tb] = *(const GAS bf16x8_t*)(uintptr_t)(wb + (size_t)(32 * tb) * 128 + 16 * (ks < nks ? ks : 0));
        u32x4 uu[2][2][2], zz[2][2][2]; float bias[2];
#pragma unroll
        for (int tb = 0; tb < 2; ++tb) {
            const int t = 64 * th + 32 * tb + r32;
            bias[tb] = p.sm(SM_GMLPB)[(l * 4 + h) * 128 + t];
            const bf16_t* yr = p.Y() + (row0 + t) * YP;
#pragma unroll
            for (int db = 0; db < 2; ++db)
#pragma unroll
                for (int gp = 0; gp < 2; ++gp) {
                    uu[tb][db][gp] = *(const GAS u32x4*)(uintptr_t)(yr + YB_U + h * 64 + 32 * db + 8 * (2 * gp + hh));
                    zz[tb][db][gp] = *(const GAS u32x4*)(uintptr_t)(yr + YB_Z + h * 64 + 32 * db + 8 * (2 * gp + hh));
                }
        }
#pragma unroll
        for (int ks = 0; ks < 8; ++ks) {
            if (ks < nks) {
                bf16x8_t afr[2];
#pragma unroll
                for (int db = 0; db < 2; ++db) {
                    const LAS unsigned char* a = va + (16 * ks) * VN_STRIDE + (32 * db) * 2;
                    const s16x4_t lo = ds_tr16(a), hi = ds_tr16(a + 4 * VN_STRIDE);
                    afr[db] = __builtin_shufflevector(lo, hi, 0, 1, 2, 3, 4, 5, 6, 7);
                }
#pragma unroll
                for (int tb = 0; tb < 2; ++tb)
#pragma unroll
                    for (int db = 0; db < 2; ++db) acc[tb][db] = MFMA32(afr[db], bfr[ks][tb], acc[tb][db]);
            }
        }
#pragma unroll
        for (int tb = 0; tb < 2; ++tb) {
            const int t = 64 * th + 32 * tb + r32;
            bf16_t* mr = p.mix() + (row0 + t) * DM + 256 + h * 64;
#pragma unroll
            for (int db = 0; db < 2; ++db)
#pragma unroll
                for (int gp = 0; gp < 2; ++gp) {
                    const u32x4 uq = unpair16(uu[tb][db][gp], hh), zq = unpair16(zz[tb][db][gp], hh);
                    const int g = 2 * gp;
                    const float a0 = bflo(uq.x) * (acc[tb][db][4 * g] + bias[tb]) * silu_f(bflo(zq.x)), a1 = bfhi(uq.x) * (acc[tb][db][4 * g + 1] + bias[tb]) * silu_f(bfhi(zq.x));
                    const float a2 = bflo(uq.y) * (acc[tb][db][4 * g + 2] + bias[tb]) * silu_f(bflo(zq.y)), a3 = bfhi(uq.y) * (acc[tb][db][4 * g + 3] + bias[tb]) * silu_f(bfhi(zq.y));
                    const float b0 = bflo(uq.z) * (acc[tb][db][4 * g + 4] + bias[tb]) * silu_f(bflo(zq.z)), b1 = bfhi(uq.z) * (acc[tb][db][4 * g + 5] + bias[tb]) * silu_f(bfhi(zq.z));
                    const float b2 = bflo(uq.w) * (acc[tb][db][4 * g + 6] + bias[tb]) * silu_f(bflo(zq.w)), b3 = bfhi(uq.w) * (acc[tb][db][4 * g + 7] + bias[tb]) * silu_f(bfhi(zq.w));
                    store_pair16(mr + 32 * db, g, cvtpk(a0, a1), cvtpk(a2, a3), cvtpk(b0, b1), cvtpk(b2, b3), hh);
                }
        }
    }
}
__device__ __forceinline__ void ph_mixAB(const Params& p, int l, LAS unsigned char* lds, int bid, int nb, int tid_in) {
    int tid = tid_in; asm volatile("" : "+v"(tid));
    for (int i = bid; i < 256; i += nb) mixAB_unit(p, l, i >> 4, i & 15, lds, tid);
}

constexpr int IX_STRIDE = 528;
__device__ __forceinline__ void ph_ikiw(const Params& p, int l, LAS unsigned char* lds, int bid, int nb, int wave_s) {
    const int tid = tid_now(wave_s);
    const int lane = tid & 63, wave = __builtin_amdgcn_readfirstlane(tid >> 6), r32 = lane & 31, hh = lane >> 5;
    const int tb = wave & 3, cb = wave >> 2;
    LAS unsigned char* xs = lds;
    LAS unsigned char* ws = lds + 128 * IX_STRIDE;
    const bf16_t* wbase = p.wt_in() + (size_t)l * YP * DM;
    __syncthreads();
    { unsigned z = 0u; asm volatile("" : "+v"(z));
      for (int i = tid; i < 28 * (IX_STRIDE / 16); i += NT) *(LAS u32x4*)(ws + 36 * IX_STRIDE + i * 16) = (u32x4){z, z, z, z}; }
    for (int blk = bid; blk < NTOK / 128; blk += nb) {
        f32x16 acc;
#pragma unroll
        for (int i = 0; i < 16; ++i) acc[i] = 0.f;
        u32x4 xv[8], wv[3];
#define IX_LOAD(k0_) do { \
            _Pragma("unroll") for (int i = 0; i < 8; ++i) { const int idx = tid + NT * i; xv[i] = *(const GAS u32x4*)(uintptr_t)(p.xb() + (size_t)(128 * blk + (idx >> 5)) * DM + (k0_) + 8 * (idx & 31)); } \
            _Pragma("unroll") for (int i = 0; i < 3; ++i) { const int idx = tid + NT * i, n = idx >> 5; \
                if (idx < 36 * 32) wv[i] = *(const GAS u32x4*)(uintptr_t)(wbase + (size_t)(n < 32 ? 3584 + n : 3712 + (n - 32)) * DM + (k0_) + 8 * (idx & 31)); } } while (0)
        IX_LOAD(0);
#pragma unroll 1
        for (int k0 = 0; k0 < DM; k0 += 256) {
            __syncthreads();
#pragma unroll
            for (int i = 0; i < 8; ++i) { const int idx = tid + NT * i; *(LAS u32x4*)(xs + (idx >> 5) * IX_STRIDE + (idx & 31) * 16) = xv[i]; }
#pragma unroll
            for (int i = 0; i < 3; ++i) { const int idx = tid + NT * i; if (idx < 36 * 32) *(LAS u32x4*)(ws + (idx >> 5) * IX_STRIDE + (idx & 31) * 16) = wv[i]; }
            __syncthreads();
            if (k0 + 256 < DM) IX_LOAD(k0 + 256);
#pragma unroll
            for (int s = 0; s < 16; ++s) {
                const bf16x8_t a = *(const LAS bf16x8_t*)(ws + (32 * cb + r32) * IX_STRIDE + (16 * s + 8 * hh) * 2);
                const bf16x8_t b = *(const LAS bf16x8_t*)(xs + (32 * tb + r32) * IX_STRIDE + (16 * s + 8 * hh) * 2);
                acc = MFMA32(a, b, acc);
            }
        }
#undef IX_LOAD
        const int tok = 128 * blk + 32 * tb + r32;
        const GAS f32x4* sp = (const GAS f32x4*)(uintptr_t)(p.ssq() + (size_t)tok * 16);
        const f32x4 s0 = sp[0], s1 = sp[1], s2 = sp[2], s3 = sp[3];
        const float tot = ((s0.x + s0.y) + (s0.z + s0.w)) + ((s1.x + s1.y) + (s1.z + s1.w)) + ((s2.x + s2.y) + (s2.z + s2.w)) + ((s3.x + s3.y) + (s3.z + s3.w));
        const float rstd = rsqrtf(tot * (1.f / DM) + EPS);
        bf16_t* yr = p.Y() + (size_t)tok * YP + YI_K + 32 * cb;
#pragma unroll
        for (int g = 0; g < 4; ++g) {
            const int c0 = 8 * g + 4 * hh;
            if (32 * cb + c0 < 36)
                *(GAS unsigned long long*)(uintptr_t)(yr + c0) = (unsigned long long)cvtpk(acc[4 * g] * rstd, acc[4 * g + 1] * rstd) | ((unsigned long long)cvtpk(acc[4 * g + 2] * rstd, acc[4 * g + 3] * rstd) << 32);
        }
    }
    __syncthreads();
}

__global__ void __launch_bounds__(NT, 2) k_fwd(Params p) {
    extern __shared__ __attribute__((aligned(16))) unsigned char lds[];
    cg::grid_group grid = cg::this_grid();
    LAS unsigned char* l3 = (LAS unsigned char*)lds;
    const int wave_s = __builtin_amdgcn_readfirstlane((int)threadIdx.x >> 6);
    volatile LAS unsigned* bst = (volatile LAS unsigned*)(l3 + LDS_BYTES - 16);
    if (threadIdx.x < 4) bst[threadIdx.x] = 0u;
    __syncthreads();
    const XcdBarrier bar = xcd_barrier_post(p.ctl(), bst);
    if (threadIdx.x == 0 && blockIdx.x < 256) (void)xb_add(&p.ctl()[XB_XT + blockIdx.x], xb_xcc_id() + 1u);
    if (TSEG >= 0 && threadIdx.x == 0) *(volatile LAS unsigned*)(l3 + TCTR_OFF) = 0u;
    { TB(16, l3, tid_now(wave_s)); ph_prologue(p, l3, tid_now(wave_s)); TE(16, l3, tid_now(wave_s)); }
    if (p.ws == nullptr) grid.sync();
    { TB(18, l3, tid_now(wave_s)); xcd_barrier(bar, tid_now(wave_s)); TE(18, l3, tid_now(wave_s)); }
    if (gridDim.x == 256 && threadIdx.x == 0) {
        const unsigned mine = xb_ld(&p.ctl()[XB_XT + blockIdx.x]); unsigned same = 1u;
        for (int k = 0; k < 32; ++k) same &= (xb_ld(&p.ctl()[XB_XT + (blockIdx.x & 7) + 8 * k]) == mine) ? 1u : 0u;
        bst[2] = same;
    }
    __syncthreads();
#pragma unroll 1
    for (int l = 0; l < DEPTH; ++l) {
        Params q = p; asm volatile("" : "+s"(q.ws), "+s"(q.out));
        int bid = blockIdx.x, nb = gridDim.x; asm volatile("" : "+s"(bid), "+s"(nb));
        const bool grp = nb == 256;
        int lid = grp ? (bid & 7) * 32 + (bid >> 3) : bid;
        const int nconv = nb >= 256 ? 64 : nb;
        if (l > 0) {
            if (tid_now(wave_s) == 0) {
                unsigned* ctl = q.ctl();
                XB_SPIN(xb_ld(&ctl[XB_CONV]) < (unsigned)(nconv * l), ctl);
                __builtin_amdgcn_fence(__ATOMIC_ACQUIRE, "agent"); asm volatile("s_waitcnt vmcnt(0)" ::: "memory");
            }
            __syncthreads();
        }
        const bool ik_first = ((bid >> 3) & 1) != 0;
#pragma unroll 1
        for (int st = 0; st < 3; ++st) {
            if (st == 1) {
                if (tid_now(wave_s) == 0) *(volatile LAS int*)(l3 + 131072 + 768) = -1;
                __syncthreads();
                pg8::Gemm g{q.xb(), q.wt_in() + (size_t)l * YP * DM, NTOK, NGEMM, DM};
                pg8::StaticOrder S; S.init(NTOK, NGEMM, nb, bid);
                EpiIn E{q.ws, l, (LAS float*)(l3 + 131072 + 1024)};
                { TB(13, l3, tid_now(wave_s)); pg8::gemm_phase<EpiIn, pg8::StaticOrder, true, true>(l3, g, S, E, tid_now(wave_s)); TE(13, l3, tid_now(wave_s)); }
            } else if ((st == 0) == ik_first) {
                __syncthreads();
                { TB(21, l3, tid_now(wave_s)); ph_ikiw(q, l, l3, lid, nb, wave_s); TE(21, l3, tid_now(wave_s)); }
                __syncthreads();
            }
        }
        { TB(18, l3, tid_now(wave_s)); if (grp) grp_barrier(q.ctl(), bid & 7, bst, tid_now(wave_s)); else xcd_barrier(bar, tid_now(wave_s)); TE(18, l3, tid_now(wave_s)); }
        asm volatile("" : "+s"(q.ws), "+s"(bid), "+s"(nb), "+s"(lid));
        { TB(17, l3, tid_now(wave_s)); ph_mixAB(q, l, l3, lid, nb, tid_now(wave_s)); TE(17, l3, tid_now(wave_s)); }
        __syncthreads();
        { TB(1, l3, tid_now(wave_s)); ph_mixC(q, l, l3, lid, nb, wave_s); TE(1, l3, tid_now(wave_s)); }
        __syncthreads();
        { TB(19, l3, tid_now(wave_s)); ph_mixD(q, l, l3, lid, nb, wave_s); TE(19, l3, tid_now(wave_s)); }
        __syncthreads();
        if (l + 1 < DEPTH) {
            const bool conv = nb >= 256 ? (lid & 15) < 4 : true;
            if (conv) {
                const int ci = nb >= 256 ? (lid >> 4) * 4 + (lid & 15) : bid;
                const int t2 = tid_now(wave_s); convert_layer_weights(q, l + 1, l3, t2, ci * NW + (t2 >> 6), nconv * NW);
                asm volatile("s_waitcnt vmcnt(0)" ::: "memory");
                __syncthreads();
                if (tid_now(wave_s) == 0) { __builtin_amdgcn_fence(__ATOMIC_RELEASE, "agent"); asm volatile("s_waitcnt vmcnt(0)" ::: "memory"); (void)xb_add(&q.ctl()[XB_CONV], 1u); }
            }
        }
        { TB(18, l3, tid_now(wave_s)); if (grp) grp_barrier(q.ctl(), bid & 7, bst, tid_now(wave_s)); else xcd_barrier(bar, tid_now(wave_s)); TE(18, l3, tid_now(wave_s)); }
        asm volatile("" : "+s"(q.ws), "+s"(q.out), "+s"(bid), "+s"(nb));
        {
            pg8::Gemm g{q.mix(), q.wt_out() + (size_t)l * DM * DM, NTOK, DM, DM};
            pg8::StaticOrder S; S.init(NTOK, DM, nb, bid);
            EpiOut E{l == DEPTH - 1 ? q.out : nullptr, q.ws};
            { TB(15, l3, tid_now(wave_s)); pg8::gemm_phase<EpiOut, pg8::StaticOrder, true, true>(l3, g, S, E, tid_now(wave_s)); TE(15, l3, tid_now(wave_s)); }
        }
        { TB(18, l3, tid_now(wave_s)); if (grp) grp_barrier(q.ctl(), bid & 7, bst, tid_now(wave_s)); else xcd_barrier(bar, tid_now(wave_s)); TE(18, l3, tid_now(wave_s)); }
    }
    if (TSEG >= 0 && blockIdx.x == 0 && threadIdx.x == 0) {
        const unsigned long long ticks = 8ull * *(volatile LAS unsigned*)(l3 + TCTR_OFF), t0 = __builtin_amdgcn_s_memrealtime();
        while (__builtin_amdgcn_s_memrealtime() - t0 < ticks) __builtin_amdgcn_s_sleep(32);
    }
}

extern "C" void kernel_launch(void* const* d_in, const int* in_sizes, int n_in, void* d_out, int out_size, void* d_ws, size_t ws_size,
                              hipStream_t stream) {
    static int grid_blocks = 0;
    if (!grid_blocks) {
        int dev = 0, cus = 0, per_cu = 0;
        (void)hipGetDevice(&dev);
        (void)hipDeviceGetAttribute(&cus, hipDeviceAttributeMultiprocessorCount, dev);
        (void)hipFuncSetAttribute((const void*)k_fwd, hipFuncAttributeMaxDynamicSharedMemorySize, LDS_BYTES);
        (void)hipOccupancyMaxActiveBlocksPerMultiprocessor(&per_cu, (const void*)k_fwd, NT, LDS_BYTES);
        if (per_cu < 1) { fprintf(stderr, "kernel_launch: occupancy query returned %d\n", per_cu); per_cu = 1; }
        if (per_cu > 1) per_cu = 1;
        grid_blocks = cus * per_cu;
        if (ws_size < WS_END) fprintf(stderr, "kernel_launch: workspace too small (%zu < %zu)\n", ws_size, (size_t)WS_END);
    }
    (void)hipMemsetAsync(d_ws, 0, 16384, stream);
    Params p{};
    p.x = (const float*)d_in[0]; p.norm_g = (const float*)d_in[1]; p.w_in = (const float*)d_in[2]; p.i_conv_w = (const float*)d_in[3];
    p.i_conv_b = (const float*)d_in[4]; p.i_gmlp_g = (const float*)d_in[5]; p.gmlp_ws = (const float*)d_in[6]; p.i_gmlp_b = (const float*)d_in[7];
    p.i_diff_qg = (const float*)d_in[8]; p.i_diff_kg = (const float*)d_in[9]; p.i_diff_lam = (const float*)d_in[10]; p.i_diff_subg = (const float*)d_in[11];
    p.i_dsa_qg = (const float*)d_in[12]; p.i_dsa_kg = (const float*)d_in[13]; p.w_out = (const float*)d_in[14];
    p.out = (float*)d_out; p.ws = (unsigned char*)d_ws;
    void* args[] = {&p};
    hipError_t e = hipLaunchCooperativeKernel((void*)k_fwd, dim3(grid_blocks), dim3(NT), args, LDS_BYTES, stream);
    if (e != hipSuccess) fprintf(stderr, "cooperative launch failed: %s (grid %d)\n", hipGetErrorString(e), grid_blocks);
}
```
